# Optimizing an MI355X kernel written in HIP

```python
import numpy as np
import jax, jax.numpy as jnp
from jax import lax

D_MODEL = 1024
BATCH = 2
SEQ = 16384
DEPTH = 4

D_FF = 2816
RMS_EPS = 1e-6
ROPE_THETA = 10000.0
CHUNK = 64

GLA_H = 4
GLA_DK = 64
GLA_DV = 128
GLA_RANK = 16
GLA_GATE_NORM = 16.0

NSA_H = 8
NSA_G = 2
NSA_D = 64
CMP_LEN = 32
CMP_STRIDE = 16
CMP_HIDDEN = 256
SLC_LEN = 64
SLC_TOPK = 16
WIN = 512
Q_BLOCK = 128
FORCED_SCORE = 1e4

MLSTM_H = 4
MLSTM_DK = 64
MLSTM_DV = 128
CONV_W = 4

MIX_W = 512
N_BRANCH = 3

IN_SIZES = (
    GLA_H * GLA_DK, GLA_H * GLA_DK, GLA_H * GLA_DV, GLA_H * GLA_DV, GLA_RANK,
    NSA_H * NSA_D,
    NSA_G * NSA_D, NSA_G * NSA_D,
    NSA_G * NSA_D, NSA_G * NSA_D,
    NSA_G * NSA_D, NSA_G * NSA_D,
    NSA_H * 3,
    2 * MLSTM_H * MLSTM_DK, MLSTM_H * MLSTM_DV, MLSTM_H * MLSTM_DV, MLSTM_H, MLSTM_H,
    D_MODEL, D_MODEL, D_MODEL,
)
N_IN = sum(IN_SIZES)

kernel_name = "hybrid_gla_nsa_mlstm_macaron"


def rms_norm(x, g):
    xf = x.astype(jnp.float32)
    y = xf * lax.rsqrt(jnp.mean(xf * xf, axis=-1, keepdims=True) + RMS_EPS)
    return (y * g.astype(jnp.float32)).astype(x.dtype)


def rope(x, pos):
    half = x.shape[-1] // 2
    freqs = ROPE_THETA ** (-jnp.arange(half, dtype=jnp.float32) / half)
    ang = pos.astype(jnp.float32)[:, None] * freqs[None, :]
    cos = jnp.cos(ang)[:, None, :]
    sin = jnp.sin(ang)[:, None, :]
    xf = x.astype(jnp.float32)
    x1, x2 = xf[..., :half], xf[..., half:]
    return jnp.concatenate([x1 * cos - x2 * sin, x1 * sin + x2 * cos], axis=-1).astype(x.dtype)


def swiglu(x, w_gate, w_up, w_down):
    return (jax.nn.silu(x @ w_gate) * (x @ w_up)) @ w_down


def masked_softmax(s, mask):
    s = jnp.where(mask, s.astype(jnp.float32), -jnp.inf)
    m = jnp.max(s, axis=-1, keepdims=True)
    m = jnp.where(jnp.isfinite(m), m, 0.0)
    p = jnp.exp(s - m)
    return p / jnp.maximum(jnp.sum(p, axis=-1, keepdims=True), 1e-30)


def split_columns(z):
    parts, off = [], 0
    for w in IN_SIZES:
        parts.append(z[..., off:off + w])
        off += w
    return parts


def to_chunks(t):
    B, S, H, d = t.shape
    return t.reshape(B, S // CHUNK, CHUNK, H, d).transpose(1, 0, 3, 2, 4)


def from_chunks(t):
    C, B, H, L, d = t.shape
    return t.transpose(1, 0, 3, 2, 4).reshape(B, C * L, H, d)


def causal_conv(x, w, b):
    K, C = w.shape
    y = lax.conv_general_dilated(x, w[:, None, :].astype(x.dtype), window_strides=(1,),
                                 padding=[(K - 1, 0)], dimension_numbers=('NWC', 'WIO', 'NWC'),
                                 feature_group_count=C)
    return y + b


def gla_chunked(q, k, v, log_alpha):
    B, S, H, DK = q.shape
    DV = v.shape[-1]
    f32 = jnp.float32
    qc = to_chunks(q.astype(f32) * DK ** -0.5)
    kc = to_chunks(k.astype(f32))
    vc = to_chunks(v.astype(f32))
    gc = to_chunks(log_alpha.astype(f32))
    causal = jnp.tril(jnp.ones((CHUNK, CHUNK), dtype=bool))

    def step(state, xs):
        q_i, k_i, v_i, g_i = xs
        b = jnp.cumsum(g_i, axis=2)
        o_inter = jnp.einsum('bhld,bhde->bhle', q_i * jnp.exp(b), state)
        diff = jnp.where(causal[:, :, None], b[:, :, :, None, :] - b[:, :, None, :, :], -jnp.inf)
        attn = jnp.einsum('bhid,bhjd,bhijd->bhij', q_i, k_i, jnp.exp(diff))
        b_last = b[:, :, -1:, :]
        k_dec = k_i * jnp.exp(b_last - b)
        state = jnp.exp(b_last[:, :, 0, :, None]) * state + jnp.einsum('bhld,bhle->bhde', k_dec, v_i)
        return state, o_inter + jnp.einsum('bhij,bhje->bhie', attn, v_i)

    state0 = jnp.zeros((B, H, DK, DV), f32)
    _, o = lax.scan(step, state0, (qc, kc, vc, gc))
    return from_chunks(o)


def mlstm_chunked(q, k, v, i_pre, log_f):
    B, S, H, DK = q.shape
    DV = v.shape[-1]
    f32 = jnp.float32
    qc = to_chunks(q.astype(f32))
    kc = to_chunks(k.astype(f32) * DK ** -0.5)
    vc = to_chunks(v.astype(f32))
    ic = to_chunks(i_pre.astype(f32)[..., None])[..., 0]
    fc = to_chunks(log_f.astype(f32)[..., None])[..., 0]
    causal = jnp.tril(jnp.ones((CHUNK, CHUNK), dtype=bool))

    def step(carry, xs):
        c_st, n_st, m_st = carry
        q_i, k_i, v_i, ii, fi = xs
        b = jnp.cumsum(fi, axis=-1)
        dmat = jnp.where(causal, b[..., :, None] - b[..., None, :] + ii[..., None, :], -jnp.inf)
        inter_log = b + m_st[..., None]
        m_row = jnp.maximum(inter_log, jnp.max(dmat, axis=-1))
        w_inter = jnp.exp(inter_log - m_row)
        s_qk = jnp.einsum('bhid,bhjd->bhij', q_i, k_i) * jnp.exp(dmat - m_row[..., None])
        num = w_inter[..., None] * jnp.einsum('bhld,bhde->bhle', q_i, c_st) + jnp.einsum('bhij,bhje->bhie', s_qk, v_i)
        den = w_inter * jnp.einsum('bhld,bhd->bhl', q_i, n_st) + jnp.sum(s_qk, axis=-1)
        h = num / jnp.maximum(jnp.abs(den), jnp.exp(-m_row))[..., None]
        m_new = m_row[..., -1]
        w_k = jnp.exp(dmat[..., -1, :] - m_new[..., None])
        decay = jnp.exp(b[..., -1] + m_st - m_new)
        c_new = decay[..., None, None] * c_st + jnp.einsum('bhld,bhle->bhde', k_i * w_k[..., None], v_i)
        n_new = decay[..., None] * n_st + jnp.einsum('bhl,bhld->bhd', w_k, k_i)
        return (c_new, n_new, m_new), h

    carry0 = (jnp.zeros((B, H, DK, DV), f32), jnp.zeros((B, H, DK), f32), jnp.zeros((B, H), f32))
    _, h = lax.scan(step, carry0, (qc, kc, vc, ic, fc))
    return from_chunks(h)


def nsa_attention(q, k_cmp, v_cmp, k_slc, v_slc, k_win, v_win, gates, qk_norm, cmp_pos, cmp_w1, cmp_w2):
    B, S, H, D = q.shape
    G = NSA_G
    HPG = H // G
    pos = jnp.arange(S)
    scale = D ** -0.5
    q = rope(rms_norm(q, qk_norm[0]), pos)
    k_slc = rope(rms_norm(k_slc, qk_norm[2]), pos)
    k_win = rope(rms_norm(k_win, qk_norm[3]), pos)

    n_cmp = S // CMP_STRIDE - 1

    def compress(t, pe, w1, w2):
        tb = t.reshape(B, S // CMP_STRIDE, CMP_STRIDE, G, D)
        blocks = jnp.concatenate([tb[:, :-1], tb[:, 1:]], axis=2) + pe[None, None, :, None, :]
        flat = blocks.transpose(0, 1, 3, 2, 4).reshape(B, n_cmp, G, CMP_LEN * D)
        return jax.nn.gelu(flat @ w1) @ w2

    cmp_end = jnp.arange(n_cmp) * CMP_STRIDE + CMP_LEN - 1
    kc = rope(rms_norm(compress(k_cmp, cmp_pos[0], cmp_w1[0], cmp_w2[0]), qk_norm[1]), cmp_end)
    vc = compress(v_cmp, cmp_pos[1], cmp_w1[1], cmp_w2[1])

    n_sel = S // SLC_LEN
    topk = min(SLC_TOPK, n_sel)
    ks_blk = k_slc.reshape(B, n_sel, SLC_LEN, G, D).transpose(0, 3, 1, 2, 4)
    vs_blk = v_slc.reshape(B, n_sel, SLC_LEN, G, D).transpose(0, 3, 1, 2, 4)
    ci = np.arange(n_cmp)[:, None] * CMP_STRIDE
    sj = np.arange(n_sel)[None, :] * SLC_LEN
    overlap = jnp.asarray(((ci < sj + SLC_LEN) & (ci + CMP_LEN > sj)).astype(np.float32))
    take = jax.vmap(jax.vmap(lambda kb, ix: kb[ix]))

    kw_pad = jnp.pad(k_win, ((0, 0), (WIN, 0), (0, 0), (0, 0)))
    vw_pad = jnp.pad(v_win, ((0, 0), (WIN, 0), (0, 0), (0, 0)))

    def block(qb):
        s0 = qb * Q_BLOCK
        t = s0 + jnp.arange(Q_BLOCK)
        qq = lax.dynamic_slice_in_dim(q, s0, Q_BLOCK, axis=1).reshape(B, Q_BLOCK, G, HPG, D)
        gg = lax.dynamic_slice_in_dim(gates, s0, Q_BLOCK, axis=1).reshape(B, Q_BLOCK, G, HPG, 3)
        sc = jnp.einsum('bqghd,bcgd->bghqc', qq, kc) * scale
        p_c = masked_softmax(sc, cmp_end[None, :] <= t[:, None])
        o_c = jnp.einsum('bghqc,bcgd->bqghd', p_c, vc)
        imp = jnp.einsum('bghqc,cn->bgqn', p_c, overlap)
        blk = jnp.arange(n_sel)[None, :]
        valid = blk * SLC_LEN <= t[:, None]
        cur = (t // SLC_LEN)[:, None]
        forced = (blk == 0) | (blk == cur) | (blk == cur - 1)
        score = jnp.where(valid, jnp.where(forced, FORCED_SCORE, imp), -jnp.inf)
        top_val, top_idx = lax.top_k(score, topk)
        k_sel = take(ks_blk, top_idx).reshape(B, G, Q_BLOCK, topk * SLC_LEN, D)
        v_sel = take(vs_blk, top_idx).reshape(B, G, Q_BLOCK, topk * SLC_LEN, D)
        tok = (top_idx[..., None] * SLC_LEN + jnp.arange(SLC_LEN)).reshape(B, G, Q_BLOCK, topk * SLC_LEN)
        m_s = jnp.repeat(jnp.isfinite(top_val), SLC_LEN, axis=-1) & (tok <= t[:, None])
        ss = jnp.einsum('bqghd,bgqnd->bghqn', qq, k_sel) * scale
        p_s = masked_softmax(ss, m_s[:, :, None])
        o_s = jnp.einsum('bghqn,bgqnd->bqghd', p_s, v_sel)
        kw = lax.dynamic_slice_in_dim(kw_pad, s0, WIN + Q_BLOCK, axis=1)
        vw = lax.dynamic_slice_in_dim(vw_pad, s0, WIN + Q_BLOCK, axis=1)
        kpos = s0 - WIN + jnp.arange(WIN + Q_BLOCK)
        m_w = (kpos[None, :] <= t[:, None]) & (kpos[None, :] > t[:, None] - WIN) & (kpos[None, :] >= 0)
        sw = jnp.einsum('bqghd,bkgd->bghqk', qq, kw) * scale
        p_w = masked_softmax(sw, m_w)
        o_w = jnp.einsum('bghqk,bkgd->bqghd', p_w, vw)
        o = gg[..., 0:1] * o_c + gg[..., 1:2] * o_s + gg[..., 2:3] * o_w
        return o.reshape(B, Q_BLOCK, H * D)

    out = lax.map(block, jnp.arange(S // Q_BLOCK))
    return out.transpose(1, 0, 2, 3).reshape(B, S, H * D)


def hybrid_mixer(h, w_in, b_in, gla_w_alpha, gla_b_alpha, gla_out_norm, nsa_qk_norm, nsa_cmp_pos,
                 nsa_cmp_w1, nsa_cmp_w2, mlstm_conv_w, mlstm_conv_b, w_branch, w_out):
    B, S, _ = h.shape
    f32 = jnp.float32
    z = h @ w_in + b_in
    (a_q, a_k, a_v, a_r, a_lr, b_q, b_kc, b_vc, b_ks, b_vs, b_kw, b_vw, b_g,
     c_qk, c_v, c_o, c_i, c_f, gate_a, gate_b, gate_c) = split_columns(z)

    def heads(t, n):
        return t.reshape(B, S, n, -1)

    log_alpha = jax.nn.log_sigmoid((a_lr @ gla_w_alpha + gla_b_alpha).astype(f32)) / GLA_GATE_NORM
    o_a = gla_chunked(heads(a_q, GLA_H), heads(a_k, GLA_H), heads(a_v, GLA_H), heads(log_alpha, GLA_H))
    o_a = rms_norm(o_a, gla_out_norm) * jax.nn.silu(heads(a_r, GLA_H).astype(f32))
    o_a = o_a.reshape(B, S, MIX_W).astype(h.dtype)

    o_b = nsa_attention(heads(b_q, NSA_H), heads(b_kc, NSA_G), heads(b_vc, NSA_G), heads(b_ks, NSA_G),
                        heads(b_vs, NSA_G), heads(b_kw, NSA_G), heads(b_vw, NSA_G),
                        heads(jax.nn.sigmoid(b_g), NSA_H), nsa_qk_norm, nsa_cmp_pos, nsa_cmp_w1, nsa_cmp_w2)
    o_b = o_b.astype(h.dtype)

    qk = jax.nn.silu(causal_conv(c_qk, mlstm_conv_w, mlstm_conv_b))
    c_q, c_k = qk[..., :MLSTM_H * MLSTM_DK], qk[..., MLSTM_H * MLSTM_DK:]
    h_c = mlstm_chunked(heads(c_q, MLSTM_H), heads(c_k, MLSTM_H), heads(c_v, MLSTM_H),
                        c_i, jax.nn.log_sigmoid(c_f.astype(f32)))
    o_c = (h_c.reshape(B, S, MIX_W) * jax.nn.sigmoid(c_o.astype(f32))).astype(h.dtype)

    y = (jax.nn.sigmoid(gate_a) * (o_a @ w_branch[0])
         + jax.nn.sigmoid(gate_b) * (o_b @ w_branch[1])
         + jax.nn.sigmoid(gate_c) * (o_c @ w_branch[2]))
    return y @ w_out


def setup_inputs(seed: int = 0) -> dict:
    key = jax.random.key(seed)
    ks = jax.random.split(key, 23)
    L, D, F = DEPTH, D_MODEL, D_FF
    f32 = jnp.float32

    def nrm(k, shape, scale):
        return jax.random.normal(k, shape, f32) * scale

    def gain(k, shape):
        return 1.0 + 0.02 * jax.random.normal(k, shape, f32)

    f_start = N_IN - 3 * D_MODEL - MLSTM_H
    b_in = nrm(ks[7], (L, N_IN), 0.02)
    b_in = b_in.at[:, f_start:f_start + MLSTM_H].add(jnp.linspace(3.0, 6.0, MLSTM_H, dtype=f32))
    return {
        'x': jax.random.normal(ks[0], (BATCH, SEQ, D), f32),
        'ffn1_norm': gain(ks[1], (L, D)),
        'ffn1_w_gate': nrm(ks[2], (L, D, F), D ** -0.5),
        'ffn1_w_up': nrm(ks[3], (L, D, F), D ** -0.5),
        'ffn1_w_down': nrm(ks[4], (L, F, D), F ** -0.5),
        'mix_norm': gain(ks[5], (L, D)),
        'w_in': nrm(ks[6], (L, D, N_IN), D ** -0.5),
        'b_in': b_in,
        'gla_w_alpha': nrm(ks[8], (L, GLA_RANK, GLA_H * GLA_DK), GLA_RANK ** -0.5),
        'gla_b_alpha': nrm(ks[9], (L, GLA_H * GLA_DK), 0.1),
        'gla_out_norm': gain(ks[10], (L, GLA_DV)),
        'nsa_qk_norm': gain(ks[11], (L, 4, NSA_D)),
        'nsa_cmp_pos': nrm(ks[12], (L, 2, CMP_LEN, NSA_D), 0.1),
        'nsa_cmp_w1': nrm(ks[13], (L, 2, CMP_LEN * NSA_D, CMP_HIDDEN), (CMP_LEN * NSA_D) ** -0.5),
        'nsa_cmp_w2': nrm(ks[14], (L, 2, CMP_HIDDEN, NSA_D), CMP_HIDDEN ** -0.5),
        'mlstm_conv_w': nrm(ks[15], (L, CONV_W, 2 * MLSTM_H * MLSTM_DK), CONV_W ** -0.5),
        'mlstm_conv_b': nrm(ks[16], (L, 2 * MLSTM_H * MLSTM_DK), 0.02),
        'w_branch': nrm(ks[17], (L, N_BRANCH, MIX_W, D), MIX_W ** -0.5),
        'w_out': nrm(ks[18], (L, D, D), D ** -0.5),
        'ffn2_norm': gain(ks[19], (L, D)),
        'ffn2_w_gate': nrm(ks[20], (L, D, F), D ** -0.5),
        'ffn2_w_up': nrm(ks[21], (L, D, F), D ** -0.5),
        'ffn2_w_down': nrm(ks[22], (L, F, D), F ** -0.5),
    }


def reference(x, ffn1_norm, ffn1_w_gate, ffn1_w_up, ffn1_w_down, mix_norm, w_in, b_in, gla_w_alpha,
              gla_b_alpha, gla_out_norm, nsa_qk_norm, nsa_cmp_pos, nsa_cmp_w1, nsa_cmp_w2, mlstm_conv_w,
              mlstm_conv_b, w_branch, w_out, ffn2_norm, ffn2_w_gate, ffn2_w_up, ffn2_w_down):
    for l in range(DEPTH):
        x = x + 0.5 * swiglu(rms_norm(x, ffn1_norm[l]), ffn1_w_gate[l], ffn1_w_up[l], ffn1_w_down[l])
        x = x + hybrid_mixer(rms_norm(x, mix_norm[l]), w_in[l], b_in[l], gla_w_alpha[l], gla_b_alpha[l],
                             gla_out_norm[l], nsa_qk_norm[l], nsa_cmp_pos[l], nsa_cmp_w1[l], nsa_cmp_w2[l],
                             mlstm_conv_w[l], mlstm_conv_b[l], w_branch[l], w_out[l])
        x = x + 0.5 * swiglu(rms_norm(x, ffn2_norm[l]), ffn2_w_gate[l], ffn2_w_up[l], ffn2_w_down[l])
    return x
```

```cpp
#include <hip/hip_runtime.h>
#include <cstdio>
#include <cstdint>

#ifndef ABL_ZERO
#define ABL_ZERO 0
#endif
#ifndef SCL_A
#define SCL_A 1.0f
#define SCL_B 1.0f
#define SCL_C 1.0f
#endif
#define NAIVE_GLA 0
#define NAIVE_MLSTM 0
#define NAIVE_WIN 0
#define NAIVE_MERGE 0
#ifndef ONE_LAUNCH
#define ONE_LAUNCH 0
#endif

#define GAS __attribute__((address_space(1)))
#define LAS __attribute__((address_space(3)))
typedef unsigned short bf16;
typedef unsigned v4u __attribute__((ext_vector_type(4)));
typedef unsigned v2u __attribute__((ext_vector_type(2)));
typedef float f32x4 __attribute__((ext_vector_type(4)));
typedef float f32x2 __attribute__((ext_vector_type(2)));
typedef short bf16x8 __attribute__((ext_vector_type(8)));
typedef short bf16x4 __attribute__((ext_vector_type(4)));

constexpr int NB = 2, SEQ = 16384, T = NB * SEQ, DM = 1024, DFF = 2816, NLAYER = 4;
constexpr int N_IN = 7472;
constexpr int NWAVES = 8, NTHR = 512;
constexpr float RMS_EPS = 1e-6f;
constexpr int NCH = SEQ / 64;

constexpr size_t MiB = 1u << 20;
constexpr size_t WS_CTL = 0, CTL_ZERO_BYTES = 1 * MiB;
constexpr size_t WS_ROPE = 1 * MiB;
constexpr size_t WS_VEC = 5 * MiB;
constexpr size_t WS_WGU1 = 6 * MiB;
constexpr size_t WS_WDN1 = 17 * MiB;
constexpr size_t WS_WGU2 = 23 * MiB;
constexpr size_t WS_WDN2 = 34 * MiB;
constexpr size_t WS_WIN = 40 * MiB;
constexpr size_t WS_WGT = 49 * MiB;
constexpr size_t WS_WBR = 55 * MiB;
constexpr size_t WS_WOUT = 58 * MiB;
constexpr size_t WS_CW1 = 60 * MiB;
constexpr size_t WS_CW2 = 62 * MiB;
constexpr size_t WS_XN = 64 * MiB;
constexpr size_t WS_R = 128 * MiB;
constexpr size_t WS_HID = WS_R;
constexpr size_t WS_QKA = WS_R;
constexpr size_t WS_VA = WS_R + 32 * MiB;
constexpr size_t WS_RA = WS_R + 64 * MiB;
constexpr size_t WS_QB = WS_R + 96 * MiB;
constexpr size_t WS_KVC = WS_R + 128 * MiB;
constexpr size_t WS_KVS = WS_R + 144 * MiB;
constexpr size_t WS_KVW = WS_R + 160 * MiB;
constexpr size_t WS_QKC = WS_R + 176 * MiB;
constexpr size_t WS_VC = WS_R + 208 * MiB;
constexpr size_t WS_OC = WS_R + 240 * MiB;
constexpr size_t WS_SMALL = WS_R + 272 * MiB;
constexpr size_t WS_VST = WS_R + 280 * MiB;
constexpr size_t WS_VWT = WS_R + 288 * MiB;
constexpr size_t WS_KCMP = WS_R + 296 * MiB;
constexpr size_t WS_VCT = WS_KCMP + MiB / 2;
constexpr size_t WS_CMPH = WS_R + 297 * MiB;
constexpr size_t WS_GST = WS_R + 302 * MiB;
constexpr size_t WS_GDEC = WS_R + 334 * MiB;
constexpr size_t WS_MSC = WS_GDEC + MiB / 2;
constexpr size_t WS_MST = WS_R + 335 * MiB;
constexpr size_t WS_MN = WS_R + 367 * MiB;
constexpr size_t WS_G = WS_QKA;
constexpr size_t WS_Y = WS_QKC;
constexpr size_t WS_END = WS_R + 368 * MiB;

constexpr int VEC_BINP = 0;
constexpr int VEC_CB1 = 8192;

#define LDS_WAIT() asm volatile("s_waitcnt lgkmcnt(0)" ::: "memory")
#define VM_WAIT() asm volatile("s_waitcnt vmcnt(0)" ::: "memory")
__device__ __forceinline__ unsigned f2bf(float f) { unsigned u = __builtin_bit_cast(unsigned, f); return (u + 0x7fffu + ((u >> 16) & 1u)) >> 16; }
__device__ __forceinline__ unsigned pk2(float lo, float hi) { return f2bf(lo) | (f2bf(hi) << 16); }
__device__ __forceinline__ float bf2f(unsigned v) { return __builtin_bit_cast(float, (v & 0xffffu) << 16); }
__device__ __forceinline__ float bflo(unsigned w) { return __builtin_bit_cast(float, w << 16); }
__device__ __forceinline__ float bfhi(unsigned w) { return __builtin_bit_cast(float, w & 0xffff0000u); }
__device__ __forceinline__ float fexp(float x) { return __builtin_amdgcn_exp2f(x * 1.44269504089f); }
__device__ __forceinline__ float sigmoidf_(float x) { return 1.0f / (1.0f + __expf(-x)); }
__device__ __forceinline__ float siluf_(float x) { return x / (1.0f + __expf(-x)); }
__device__ __forceinline__ float logsigmoidf_(float x) { return fminf(x, 0.f) - log1pf(__expf(-fabsf(x))); }
__device__ __forceinline__ float wave_sum(float v) {
#pragma unroll
    for (int o = 1; o < 64; o <<= 1) v += __shfl_xor(v, o);
    return v;
}
__device__ __forceinline__ float wave_max(float v) {
#pragma unroll
    for (int o = 1; o < 64; o <<= 1) v = fmaxf(v, __shfl_xor(v, o));
    return v;
}

#define XB_TMO      128
#define XB_XCNT(j)  (256  + 64 * (j))
#define XB_XSUB(j)  (1280 + 64 * (j))
#define XB_XGEN(j)  (2304 + 64 * (j))
#define XB_TOP      3328
#define XB_TOPGEN   3392
#define XCD_BAR_WORDS 3456
#define XB_SPIN_CAP (1u << 24)

__device__ __forceinline__ unsigned xb_ld(unsigned* p)              { return __hip_atomic_load(p, __ATOMIC_RELAXED, __HIP_MEMORY_SCOPE_AGENT); }
__device__ __forceinline__ unsigned xb_add(unsigned* p, unsigned v) { return __hip_atomic_fetch_add(p, v, __ATOMIC_RELAXED, __HIP_MEMORY_SCOPE_AGENT); }
__device__ __forceinline__ unsigned xb_xcc_id() { return (unsigned)__builtin_amdgcn_s_getreg((3 << 11) | 20) & 0xFu; }
#define XB_SPIN(cond, bar) do { unsigned _sp = 0; while (cond) { __builtin_amdgcn_s_sleep(1); \
    if ((++_sp & 255u) == 0u) { if (xb_ld(&(bar)[XB_TMO])) break; if (_sp > XB_SPIN_CAP) { atomicAdd(&(bar)[XB_TMO], 1u); break; } } } } while (0)

struct XcdBarrier {
    unsigned* bar; unsigned x;
    volatile LAS unsigned* st;
};
__device__ __forceinline__ XcdBarrier xcd_barrier_post(unsigned* bar, volatile LAS unsigned* st) {
    XcdBarrier b; b.bar = bar; b.x = xb_xcc_id(); b.st = st;
    if (threadIdx.x == 0) (void)xb_add(&bar[XB_XCNT(b.x)], 1u);
    return b;
}
__device__ __forceinline__ void xcd_barrier_complete(unsigned* bar, unsigned x, unsigned& nloc, unsigned& nx) {
    const unsigned G = gridDim.x * gridDim.y * gridDim.z;
    unsigned sum, cnt, mine, sp = 0u;
    for (;;) {
        sum = 0u; cnt = 0u; mine = 0u;
#pragma unroll
        for (unsigned j = 0; j < 16; ++j) { const unsigned c = xb_ld(&bar[XB_XCNT(j)]); sum += c; cnt += (c > 0u) ? 1u : 0u; mine = (j == x) ? c : mine; }
        if (sum == G) break;
        __builtin_amdgcn_s_sleep(1);
        if ((++sp & 255u) == 0u) { if (xb_ld(&bar[XB_TMO])) break; if (sp > XB_SPIN_CAP) { atomicAdd(&bar[XB_TMO], 1u); break; } }
    }
    nloc = mine > 0u ? mine : 1u; nx = cnt > 0u ? cnt : 1u;
}
__device__ __forceinline__ void xcd_barrier(const XcdBarrier& b) {
    asm volatile("s_waitcnt vmcnt(0)" ::: "memory");
    __syncthreads();
    if (threadIdx.x == 0) {
        unsigned* bar = b.bar;
        __builtin_amdgcn_s_waitcnt(0);
        unsigned nloc = b.st[0], nx = b.st[1];
        if (nloc == 0u) { xcd_barrier_complete(bar, b.x, nloc, nx); b.st[0] = nloc; b.st[1] = nx; }
        const unsigned old = xb_add(&bar[XB_XSUB(b.x)], 1u);
        const unsigned gen = old / nloc;
        if (old + 1u == (gen + 1u) * nloc) {
            __builtin_amdgcn_fence(__ATOMIC_RELEASE, "agent");
            asm volatile("s_waitcnt vmcnt(0)" ::: "memory");
            const unsigned og = xb_add(&bar[XB_TOP], 1u);
            const unsigned tg = og / nx;
            if (og + 1u == (tg + 1u) * nx) xb_add(&bar[XB_TOPGEN], 1u);
            else XB_SPIN(xb_ld(&bar[XB_TOPGEN]) == tg, bar);
            __builtin_amdgcn_fence(__ATOMIC_ACQUIRE, "agent");
            xb_add(&bar[XB_XGEN(b.x)], 1u);
            asm volatile("s_waitcnt vmcnt(0)" ::: "memory");
        } else {
            XB_SPIN(xb_ld(&bar[XB_XGEN(b.x)]) == gen, bar);
            __builtin_amdgcn_fence(__ATOMIC_ACQUIRE, "agent");
            asm volatile("s_waitcnt vmcnt(0)" ::: "memory");
        }
    }
    __syncthreads();
}

namespace pg8 {
#define PG8_LAS __attribute__((address_space(3)))
typedef unsigned short bf16_t;
typedef short bf16x8 __attribute__((ext_vector_type(8)));
typedef float f32x4 __attribute__((ext_vector_type(4)));
typedef unsigned u32x4 __attribute__((ext_vector_type(4)));
constexpr int BM = 256, BK = 64, HALF = 128, HTB = HALF * BK * 2  , STAGE_BYTES = 8 * HTB, NXCD = 8, WGM = 8;

__host__ __device__ __forceinline__ int lds_byte(int r, int c) { const int st = (r >> 4) * 2 + (c >> 5), rr = r & 15, cc = c & 31, ob = rr * 64 + cc * 2; return st * 1024 + (ob ^ (((ob >> 9) & 1) << 5)); }
__host__ __device__ __forceinline__ void stage_rc(int b, int& R, int& C) { const int st = b / 1024, sb = b % 1024, swz = sb ^ (((sb >> 9) & 1) << 5); R = (st >> 1) * 16 + swz / 64; C = (st & 1) * 32 + (swz % 64) / 2; }
__host__ __device__ __forceinline__ int perm32(int rho) { const int n = rho >> 4, i = rho & 15; return 8 * (i >> 2) + 4 * n + (i & 3); }

struct Unit { int pm, pn; };
struct Gemm { const bf16_t* A; const bf16_t* Bt; int M, N, K; };

struct StaticOrder {
    int nM, nN, nwg, G, c;
    __host__ __device__ void init(int M, int N, int G_, int c_) { nM = M / BM; nN = N / BM; nwg = nM * nN; G = G_; c = c_; }
    __host__ __device__ bool next(int i, Unit& u) const {
        const long L = (long)i * G + c; if (L >= nwg) return false;
        int wgid = (int)L; { const int q = nwg / NXCD, r = nwg % NXCD, xcd = wgid % NXCD, off = wgid / NXCD; wgid = (xcd < r ? xcd * (q + 1) : r * (q + 1) + (xcd - r) * q) + off; }
        const int nig = WGM * nN, gid = wgid / nig, fm = gid * WGM, gsz = (nM - fm) < WGM ? (nM - fm) : WGM;
        u.pm = fm + ((wgid % nig) % gsz); u.pn = (wgid % nig) / gsz; return true;
    }
    __device__ __forceinline__ void a_ready(const Unit&) const {}
    __device__ __forceinline__ void done(const Unit&) const {}
};
struct CountedOrder : StaticOrder {
    const unsigned* ready; unsigned need; unsigned* tmo;
    __device__ __forceinline__ void a_ready(const Unit& u) const {
        if (threadIdx.x < 64) {
            const unsigned long long t0 = __builtin_amdgcn_s_memrealtime(); unsigned polls = 0;
            while ((unsigned)__builtin_amdgcn_readfirstlane(__hip_atomic_load(ready + 64 * u.pm, __ATOMIC_RELAXED, __HIP_MEMORY_SCOPE_AGENT)) < need) {
                if ((++polls & 255u) == 0u && __builtin_amdgcn_readfirstlane(__hip_atomic_load(tmo, __ATOMIC_RELAXED, __HIP_MEMORY_SCOPE_AGENT)) != 0u) break;
                if (__builtin_amdgcn_s_memrealtime() - t0 > 2000000ull) {
                    if (threadIdx.x == 0) { unsigned expect = 0u; __hip_atomic_compare_exchange_strong(tmo + 1, &expect, 0x600u | (unsigned)(u.pm & 0xff), __ATOMIC_RELAXED, __ATOMIC_RELAXED, __HIP_MEMORY_SCOPE_AGENT); __hip_atomic_store(tmo, 1u, __ATOMIC_RELAXED, __HIP_MEMORY_SCOPE_AGENT); }
                    break; }
                __builtin_amdgcn_s_sleep(2); }
            __builtin_amdgcn_fence(__ATOMIC_ACQUIRE, "agent");
            asm volatile("s_waitcnt vmcnt(0)" ::: "memory");
        }
#if !defined(BROKEN_HOOK_NO_BARRIER)
        asm volatile("" ::: "memory"); __builtin_amdgcn_s_barrier(); asm volatile("" ::: "memory");
#endif
    }
};

__device__ __forceinline__ unsigned cvt_pk_bf16(float lo, float hi) { unsigned r; asm volatile("v_cvt_pk_bf16_f32 %0, %1, %2" : "=v"(r) : "v"(lo), "v"(hi)); return r; }
typedef float f32x2 __attribute__((ext_vector_type(2)));
__device__ __forceinline__ f32x2 gelu_pk(f32x2 v) {
    const f32x2 av = __builtin_elementwise_abs(v), d = av * 0.2316418882f + 1.0f;
    f32x2 t; t.x = __builtin_amdgcn_rcpf(d.x); t.y = __builtin_amdgcn_rcpf(d.y);
    f32x2 q = t * 0.5307027145f + (-0.7265760135f); q = q * t + 0.7107068705f; q = q * t + (-0.142248368f); q = q * t + 0.127414796f; q = q * t;
    const f32x2 s = (v * v) * (-0.72134752044f);
    f32x2 e; e.x = __builtin_amdgcn_exp2f(s.x); e.y = __builtin_amdgcn_exp2f(s.y);
    const f32x2 m = v * (q * e), r = v - m;
    f32x2 o; o.x = v.x < 0.f ? m.x : r.x; o.y = v.y < 0.f ? m.y : r.y; return o;
}

struct EpiF32 {
    static constexpr bool PERM = false, AFTER_DRAIN = false;
    float* C; int ldc; const float* bias;
    __device__ __forceinline__ void operator()(const f32x4 (&acc)[2][2][4][2], const Unit& u, int wr, int wc, int fr, int fq) const {
        const int row0 = u.pm * BM + wr * 64 + fr, col0 = u.pn * BM + wc * 32 + 4 * fq;
        f32x4 bv[2][2];
#pragma unroll
        for (int bj = 0; bj < 2; ++bj)
#pragma unroll
            for (int n = 0; n < 2; ++n) bv[bj][n] = bias ? *(const f32x4*)(bias + col0 + bj * HALF + n * 16) : (f32x4){0.f, 0.f, 0.f, 0.f};
#pragma unroll
        for (int ai = 0; ai < 2; ++ai)
#pragma unroll
            for (int m = 0; m < 4; ++m) { float* rowp = C + (size_t)(row0 + ai * HALF + m * 16) * ldc + col0;
#pragma unroll
                for (int bj = 0; bj < 2; ++bj)
#pragma unroll
                    for (int n = 0; n < 2; ++n) *(f32x4*)(rowp + bj * HALF + n * 16) = acc[ai][bj][m][n] + bv[bj][n]; }
    }
};
template <int ACT  > struct EpiBf16 {
    static constexpr bool PERM = true, AFTER_DRAIN = false;
    bf16_t* O; int ldc; const float* bias; int split_cols; size_t split_stride;
    __device__ __forceinline__ void operator()(const f32x4 (&acc)[2][2][4][2], const Unit& u, int wr, int wc, int fr, int fq) const {
        const int row0 = u.pm * BM + wr * 64 + fr; int colt = u.pn * BM; bf16_t* base = O;
        if (split_cols) { const int t = colt / split_cols; base += (size_t)t * split_stride; colt -= t * split_cols; }
        const int col0 = colt + wc * 32 + 8 * fq, bcol0 = u.pn * BM + wc * 32 + 8 * fq;
        f32x4 bv[2][2];
#pragma unroll
        for (int bj = 0; bj < 2; ++bj)
#pragma unroll
            for (int n = 0; n < 2; ++n) bv[bj][n] = bias ? *(const f32x4*)(bias + bcol0 + bj * HALF + 4 * n) : (f32x4){0.f, 0.f, 0.f, 0.f};
#pragma unroll
        for (int ai = 0; ai < 2; ++ai)
#pragma unroll
            for (int m = 0; m < 4; ++m) { bf16_t* rowp = base + (size_t)(row0 + ai * HALF + m * 16) * ldc + col0;
#pragma unroll
                for (int bj = 0; bj < 2; ++bj) { f32x4 v0 = acc[ai][bj][m][0] + bv[bj][0], v1 = acc[ai][bj][m][1] + bv[bj][1];
                    if (ACT == 1) { f32x2 a = gelu_pk((f32x2){v0[0], v0[1]}), b = gelu_pk((f32x2){v0[2], v0[3]}), c = gelu_pk((f32x2){v1[0], v1[1]}), d = gelu_pk((f32x2){v1[2], v1[3]});
                        v0 = (f32x4){a.x, a.y, b.x, b.y}; v1 = (f32x4){c.x, c.y, d.x, d.y}; }
                    if (ACT == 2) {
#pragma unroll
                        for (int j = 0; j < 4; ++j) { v0[j] = 0.5f * v0[j] * (1.0f + erff(v0[j] * 0.70710678f)); v1[j] = 0.5f * v1[j] * (1.0f + erff(v1[j] * 0.70710678f)); } }
                    u32x4 w; w.x = cvt_pk_bf16(v0[0], v0[1]); w.y = cvt_pk_bf16(v0[2], v0[3]); w.z = cvt_pk_bf16(v1[0], v1[1]); w.w = cvt_pk_bf16(v1[2], v1[3]);
                    *(u32x4*)(rowp + bj * HALF) = w; } }
    }
};

struct PanelStats {
    unsigned* xbuf;
    unsigned* cnt;
    unsigned* tmo;
    int ntn; float eps;
    unsigned code;
    __device__ __forceinline__ bool run(const f32x4 (&v)[2][2][4][2], const Unit& u, int wr, int wc, int fr, int fq, PG8_LAS unsigned char* lds, int wid, int lane) const {
        typedef float f32x2v __attribute__((ext_vector_type(2)));
        PG8_LAS f32x2v* P = (PG8_LAS f32x2v*)lds;
        PG8_LAS f32x2v* S = (PG8_LAS f32x2v*)(lds + 8192);
        PG8_LAS unsigned* flag = (PG8_LAS unsigned*)(lds + 8192 + 2048);
#pragma unroll
        for (int ai = 0; ai < 2; ++ai)
#pragma unroll
            for (int m = 0; m < 4; ++m) {
                float s = 0.f;
#pragma unroll
                for (int bj = 0; bj < 2; ++bj)
#pragma unroll
                    for (int n = 0; n < 2; ++n) { const f32x4 x = v[ai][bj][m][n]; s += (x[0] + x[1]) + (x[2] + x[3]); }
                s += __shfl_xor(s, 16); s += __shfl_xor(s, 32);
                const float mw = s * (1.0f / 64.0f); float q = 0.f;
#pragma unroll
                for (int bj = 0; bj < 2; ++bj)
#pragma unroll
                    for (int n = 0; n < 2; ++n) { const f32x4 d = v[ai][bj][m][n] - mw; q += (d[0] * d[0] + d[1] * d[1]) + (d[2] * d[2] + d[3] * d[3]); }
                q += __shfl_xor(q, 16); q += __shfl_xor(q, 32);
                if (fq == 0) P[(ai * HALF + wr * 64 + m * 16 + fr) * 4 + wc] = (f32x2v){mw, q};
            }
        asm volatile("s_waitcnt lgkmcnt(0)" ::: "memory"); __builtin_amdgcn_s_barrier(); asm volatile("" ::: "memory");
#if defined(BROKEN_NO_WAIT)
        if (blockIdx.x >= 64) { const long long t0 = clock64(); while (clock64() - t0 < 60000) __builtin_amdgcn_s_sleep(8); }
#endif
        const int row = wid * 32 + (lane & 31);
        if (lane < 32) {
            const f32x2v a = P[row * 4 + 0], b = P[row * 4 + 1], c = P[row * 4 + 2], d = P[row * 4 + 3];
            const float mt = (a.x + b.x + c.x + d.x) * 0.25f;
            const float da = a.x - mt, db = b.x - mt, dc = c.x - mt, dd = d.x - mt;
            const float m2 = (a.y + b.y) + (c.y + d.y) + 64.0f * ((da * da + db * db) + (dc * dc + dd * dd));
            unsigned long long* slot = (unsigned long long*)xbuf + ((size_t)(u.pm * BM + row) * 4 + u.pn);
            __hip_atomic_store(slot, ((unsigned long long)__float_as_uint(m2) << 32) | __float_as_uint(mt), __ATOMIC_RELAXED, __HIP_MEMORY_SCOPE_AGENT);
        }
        asm volatile("s_waitcnt vmcnt(0)" ::: "memory");
        if (lane == 0) __hip_atomic_fetch_add(cnt + 64 * u.pm, 1u, __ATOMIC_RELAXED, __HIP_MEMORY_SCOPE_AGENT);
        if (wid == 0) {
            bool dead = false; const unsigned long long t0 = __builtin_amdgcn_s_memrealtime(); const unsigned want = 8u * (unsigned)ntn;
            for (;;) {
#if defined(BROKEN_NO_WAIT)
                break;
#endif
                if ((unsigned)__builtin_amdgcn_readfirstlane(__hip_atomic_load(cnt + 64 * u.pm, __ATOMIC_RELAXED, __HIP_MEMORY_SCOPE_AGENT)) >= want) break;
                if (__builtin_amdgcn_s_memrealtime() - t0 > 2000000ull) {
                    if (lane == 0) { unsigned expect = 0u; __hip_atomic_compare_exchange_strong(tmo + 1, &expect, code | (unsigned)(u.pm & 0xff), __ATOMIC_RELAXED, __ATOMIC_RELAXED, __HIP_MEMORY_SCOPE_AGENT);
                                     __hip_atomic_store(tmo, 1u, __ATOMIC_RELAXED, __HIP_MEMORY_SCOPE_AGENT); }
                    dead = true; break; }
                __builtin_amdgcn_s_sleep(2);
            }
            __builtin_amdgcn_fence(__ATOMIC_ACQUIRE, "agent");
            if (lane == 0) flag[0] = dead ? 1u : 0u;
        }
        asm volatile("s_waitcnt vmcnt(0) lgkmcnt(0)" ::: "memory"); __builtin_amdgcn_s_barrier(); asm volatile("" ::: "memory");
        const bool bad = flag[0] != 0u;
        if (lane < 32) {
            const unsigned long long* slot = (const unsigned long long*)xbuf + (size_t)(u.pm * BM + row) * 4; float mt[4], m2[4]; float ms = 0.f;
#pragma unroll
            for (int t = 0; t < 4; ++t) { if (t < ntn) { const unsigned long long w = __hip_atomic_load(slot + t, __ATOMIC_RELAXED, __HIP_MEMORY_SCOPE_AGENT); mt[t] = __uint_as_float((unsigned)w); m2[t] = __uint_as_float((unsigned)(w >> 32)); } else { mt[t] = 0.f; m2[t] = 0.f; } ms += mt[t]; }
            const float mean = ms / (float)ntn; float q = 0.f;
#pragma unroll
            for (int t = 0; t < 4; ++t) if (t < ntn) { const float dm = mt[t] - mean; q += m2[t] + 256.0f * dm * dm; }
            S[row] = (f32x2v){mean, 1.0f / sqrtf(q / (256.0f * (float)ntn) + eps)};
        }
        asm volatile("s_waitcnt lgkmcnt(0)" ::: "memory"); __builtin_amdgcn_s_barrier(); asm volatile("" ::: "memory");
        return bad;
    }
};
struct EpiLnRes {
    static constexpr bool PERM = false, AFTER_DRAIN = true;
    const float* base; float* out; int ldc; const float* bias; PanelStats st; unsigned poison;
    __device__ __forceinline__ void refuse(size_t i0, size_t stride, int M, int N) const { const float q = __builtin_nanf(""); for (size_t i = i0; i < (size_t)M * N; i += stride) out[(i / N) * ldc + i % N] = q;
        if (i0 == 0) { unsigned expect = 0u; __hip_atomic_compare_exchange_strong(st.tmo + 1, &expect, 0x7f0u, __ATOMIC_RELAXED, __ATOMIC_RELAXED, __HIP_MEMORY_SCOPE_AGENT); __hip_atomic_store(st.tmo, 1u, __ATOMIC_RELAXED, __HIP_MEMORY_SCOPE_AGENT); } }
    __device__ __forceinline__ void fused(f32x4 (&acc)[2][2][4][2], const Unit& u, int wr, int wc, int fr, int fq, PG8_LAS unsigned char* lds, int wid, int lane) const {
        typedef float f32x2v __attribute__((ext_vector_type(2)));
        const PG8_LAS f32x2v* S = (const PG8_LAS f32x2v*)(lds + 8192);
        const int col0 = u.pn * BM + wc * 32 + 4 * fq;
#pragma unroll
        for (int bj = 0; bj < 2; ++bj)
#pragma unroll
            for (int n = 0; n < 2; ++n) { const f32x4 bv = bias ? *(const f32x4*)(bias + col0 + bj * HALF + n * 16) : (f32x4){0.f, 0.f, 0.f, 0.f};
#pragma unroll
                for (int ai = 0; ai < 2; ++ai)
#pragma unroll
                    for (int m = 0; m < 4; ++m) acc[ai][bj][m][n] += bv; }
        const bool bad = st.run(acc, u, wr, wc, fr, fq, lds, wid, lane) || poison != 0u;
        const float qnan = __builtin_nanf("");
#pragma unroll
        for (int ai = 0; ai < 2; ++ai)
#pragma unroll
            for (int m = 0; m < 4; ++m) { const int r = ai * HALF + wr * 64 + m * 16 + fr; const f32x2v sr = S[r]; const size_t off = (size_t)(u.pm * BM + r) * ldc + col0;
#pragma unroll
                for (int bj = 0; bj < 2; ++bj)
#pragma unroll
                    for (int n = 0; n < 2; ++n) { const f32x4 bs = *(const f32x4*)(base + off + bj * HALF + n * 16); f32x4 o = bs + (acc[ai][bj][m][n] - sr.x) * sr.y;
                        if (bad) o = (f32x4){qnan, qnan, qnan, qnan}; *(f32x4*)(out + off + bj * HALF + n * 16) = o; }
                asm volatile("" ::: "memory"); }
    }
};
struct EpiLnResLn {
    static constexpr bool PERM = false, AFTER_DRAIN = true;
    const float* base; float* out; bf16_t* xn; int ldc; const float* bias; PanelStats st1, st2; unsigned poison;
    __device__ __forceinline__ void refuse(size_t i0, size_t stride, int M, int N) const { const float q = __builtin_nanf(""); for (size_t i = i0; i < (size_t)M * N; i += stride) { const size_t o = (i / N) * ldc + i % N; out[o] = q; xn[o] = (bf16_t)0x7fc0u; }
        if (i0 == 0) { unsigned expect = 0u; __hip_atomic_compare_exchange_strong(st1.tmo + 1, &expect, 0x7f0u, __ATOMIC_RELAXED, __ATOMIC_RELAXED, __HIP_MEMORY_SCOPE_AGENT); __hip_atomic_store(st1.tmo, 1u, __ATOMIC_RELAXED, __HIP_MEMORY_SCOPE_AGENT); } }
    __device__ __forceinline__ void fused(f32x4 (&acc)[2][2][4][2], const Unit& u, int wr, int wc, int fr, int fq, PG8_LAS unsigned char* lds, int wid, int lane) const {
        typedef float f32x2v __attribute__((ext_vector_type(2))); typedef unsigned u32x2v __attribute__((ext_vector_type(2)));
        const PG8_LAS f32x2v* S = (const PG8_LAS f32x2v*)(lds + 8192);
        const int col0 = u.pn * BM + wc * 32 + 4 * fq;
#pragma unroll
        for (int bj = 0; bj < 2; ++bj)
#pragma unroll
            for (int n = 0; n < 2; ++n) { const f32x4 bv = bias ? *(const f32x4*)(bias + col0 + bj * HALF + n * 16) : (f32x4){0.f, 0.f, 0.f, 0.f};
#pragma unroll
                for (int ai = 0; ai < 2; ++ai)
#pragma unroll
                    for (int m = 0; m < 4; ++m) acc[ai][bj][m][n] += bv; }
        bool bad = st1.run(acc, u, wr, wc, fr, fq, lds, wid, lane) || poison != 0u;
        const float qnan = __builtin_nanf("");
#pragma unroll
        for (int ai = 0; ai < 2; ++ai)
#pragma unroll
            for (int m = 0; m < 4; ++m) { const int r = ai * HALF + wr * 64 + m * 16 + fr; const f32x2v sr = S[r]; const size_t off = (size_t)(u.pm * BM + r) * ldc + col0;
#pragma unroll
                for (int bj = 0; bj < 2; ++bj)
#pragma unroll
                    for (int n = 0; n < 2; ++n) { const f32x4 bs = *(const f32x4*)(base + off + bj * HALF + n * 16); acc[ai][bj][m][n] = bs + (acc[ai][bj][m][n] - sr.x) * sr.y; }
                asm volatile("" : "+v"(acc[ai][0][m][0]), "+v"(acc[ai][0][m][1]), "+v"(acc[ai][1][m][0]), "+v"(acc[ai][1][m][1]));
                if (m & 1) asm volatile("" ::: "memory"); }
        const bool bad1 = bad;
        bad = st2.run(acc, u, wr, wc, fr, fq, lds, wid, lane) || bad;
#pragma unroll
        for (int ai = 0; ai < 2; ++ai)
#pragma unroll
            for (int m = 0; m < 4; ++m) { const int r = ai * HALF + wr * 64 + m * 16 + fr; const f32x2v sr = S[r]; const size_t off = (size_t)(u.pm * BM + r) * ldc + col0;
#pragma unroll
                for (int bj = 0; bj < 2; ++bj)
#pragma unroll
                    for (int n = 0; n < 2; ++n) { const f32x4 x1 = acc[ai][bj][m][n]; *(f32x4*)(out + off + bj * HALF + n * 16) = bad1 ? (f32x4){qnan, qnan, qnan, qnan} : x1;
                        const f32x4 o = (x1 - sr.x) * sr.y; u32x2v w; w.x = cvt_pk_bf16(o[0], o[1]); w.y = cvt_pk_bf16(o[2], o[3]);
                        if (bad) { w.x = 0x7fc07fc0u; w.y = 0x7fc07fc0u; } *(u32x2v*)(xn + off + bj * HALF + n * 16) = w; }
                asm volatile("" ::: "memory"); }
    }
};

template <class Epi, class Sched, bool STAMP = false>
__device__ __forceinline__ void gemm_phase(PG8_LAS unsigned char* lds, const Gemm g, const Sched& S, const Epi& E, unsigned long long* stamps) {
    int tid_ = threadIdx.x; asm volatile("" : "+v"(tid_));
    const int tid = tid_, wid = __builtin_amdgcn_readfirstlane(tid >> 6), lane = tid & 63, wr = wid >> 2, wc = wid & 3, fr = lane & 15, fq = lane >> 4;
    const int K = g.K, nt = K / BK;
    int ts_lo = 0, ts_hi = 0, nts = 0; const unsigned long long rt_entry = STAMP ? (unsigned long long)wall_clock64() : 0ull;
#define PG8_STAMP() do { if (STAMP && wid == 0 && nts < 64) { const unsigned long long _c = (unsigned long long)clock64(); \
        ts_lo = (lane == nts) ? (int)(unsigned)_c : ts_lo; ts_hi = (lane == nts) ? (int)(unsigned)(_c >> 32) : ts_hi; ++nts; } } while (0)
    PG8_STAMP();
    unsigned voffA[2], voffB[2];
#pragma unroll
    for (int i = 0; i < 2; ++i) { int R, C; stage_rc(tid * 16 + i * 8192, R, C); const int Rb = Epi::PERM ? ((R & ~31) + perm32(R & 31)) : R;
        voffA[i] = (unsigned)(R * K + C) * 2u; voffB[i] = (unsigned)(Rb * K + C) * 2u; }
    const size_t kstep = (size_t)(BK * 2);
    const size_t hstep = (size_t)HALF * K * 2;
    const size_t tstep = 2 * hstep;
    const unsigned ldsw = (unsigned)wid * 1024u;
    const int aoff = lds_byte(wr * 64 + fr, fq * 8), boff = lds_byte(wc * 32 + fr, fq * 8);
#define PG8_SA(b, h) (((b) * 2 + (h)) * HTB)
#define PG8_SB(b, h) ((4 + (b) * 2 + (h)) * HTB)
#define PG8_STAGE(bufoff, gbase, voff) do { _Pragma("unroll") for (int _i = 0; _i < 2; ++_i) \
        __builtin_amdgcn_global_load_lds((const unsigned*)((const char*)(gbase) + (voff)[_i]), (PG8_LAS unsigned*)(lds + (bufoff) + ldsw + _i * 8192), 16, 0, 0); } while (0)
#define PG8_LDA(dst, b, h) do { _Pragma("unroll") for (int m = 0; m < 4; ++m) _Pragma("unroll") for (int k = 0; k < 2; ++k) dst[m][k] = *(const PG8_LAS bf16x8*)(lds + PG8_SA(b, h) + aoff + m * 2048 + k * 1024); } while (0)
#define PG8_LDB(dst, b, h) do { _Pragma("unroll") for (int n = 0; n < 2; ++n) _Pragma("unroll") for (int k = 0; k < 2; ++k) dst[n][k] = *(const PG8_LAS bf16x8*)(lds + PG8_SB(b, h) + boff + n * 2048 + k * 1024); } while (0)
#define PG8_MMA(ai, bj, At, Bt) do { __builtin_amdgcn_s_setprio(1); _Pragma("unroll") for (int m = 0; m < 4; ++m) _Pragma("unroll") for (int n = 0; n < 2; ++n) _Pragma("unroll") for (int k = 0; k < 2; ++k) \
        acc[ai][bj][m][n] = __builtin_amdgcn_mfma_f32_16x16x32_bf16(Bt[n][k], At[m][k], acc[ai][bj][m][n], 0, 0, 0); __builtin_amdgcn_s_setprio(0); } while (0)
#define PG8_WAIT_V(n) asm volatile("s_waitcnt vmcnt(" #n ")" ::: "memory")
#define PG8_WAIT_L(n) asm volatile("s_waitcnt lgkmcnt(" #n ")" ::: "memory")
#define PG8_BAR __builtin_amdgcn_s_barrier()
#define PG8_SCHED __builtin_amdgcn_sched_barrier(0)
    Unit cur, nxt; int ui = 0;
    if (!S.next(0, cur)) return;
    f32x4 acc[2][2][4][2];
#pragma unroll
    for (int a = 0; a < 2; ++a)
#pragma unroll
        for (int b = 0; b < 2; ++b)
#pragma unroll
            for (int m = 0; m < 4; ++m)
#pragma unroll
                for (int n = 0; n < 2; ++n) acc[a][b][m][n] = (f32x4){0.f, 0.f, 0.f, 0.f};
    bf16x8 At[4][2], B0[2][2], B1[2][2];
    const char* cA = (const char*)g.A + (size_t)cur.pm * tstep; const char* cB = (const char*)g.Bt + (size_t)cur.pn * tstep;
    S.a_ready(cur);
    PG8_STAGE(PG8_SB(0, 0), cB, voffB); PG8_STAGE(PG8_SA(0, 0), cA, voffA); PG8_STAGE(PG8_SB(0, 1), cB + hstep, voffB); PG8_STAGE(PG8_SA(0, 1), cA + hstep, voffA);
    if (wr == 1) PG8_BAR;
    PG8_WAIT_V(4); PG8_BAR;
    PG8_STAGE(PG8_SB(1, 0), cB + kstep, voffB); PG8_STAGE(PG8_SA(1, 0), cA + kstep, voffA); PG8_STAGE(PG8_SB(1, 1), cB + hstep + kstep, voffB);
    PG8_WAIT_V(6); PG8_BAR;
    PG8_STAMP();
    for (;;) {
        const bool has_next = S.next(ui + 1, nxt);
        const char* nA = has_next ? (const char*)g.A + (size_t)nxt.pm * tstep : cA; const char* nB = has_next ? (const char*)g.Bt + (size_t)nxt.pn * tstep : cB;
        for (int t = 0; t < nt; t += 2) {
            const bool last = (t == nt - 2);
            const char* a1 = cA + (size_t)(t + 1) * kstep;
            const char* a2 = last ? nA : cA + (size_t)(t + 2) * kstep; const char* b2 = last ? nB : cB + (size_t)(t + 2) * kstep;
            const char* a3 = a2 + kstep; const char* b3 = b2 + kstep;
            if (last && has_next) S.a_ready(nxt);
            PG8_LDB(B0, 0, 0); PG8_SCHED; PG8_LDA(At, 0, 0); PG8_STAGE(PG8_SA(1, 1), a1 + hstep, voffA);
            PG8_WAIT_L(8); PG8_BAR; PG8_WAIT_L(0); PG8_MMA(0, 0, At, B0); PG8_BAR; PG8_SCHED;
            PG8_LDB(B1, 0, 1); PG8_STAGE(PG8_SB(0, 0), b2, voffB);
            PG8_BAR; PG8_WAIT_L(0); PG8_MMA(0, 1, At, B1); PG8_BAR;
            PG8_LDA(At, 0, 1); PG8_STAGE(PG8_SA(0, 0), a2, voffA);
            PG8_BAR; PG8_WAIT_L(0); PG8_MMA(1, 0, At, B0); PG8_BAR; PG8_SCHED;
            PG8_STAGE(PG8_SB(0, 1), b2 + hstep, voffB);
            PG8_WAIT_V(6); PG8_BAR; PG8_MMA(1, 1, At, B1); PG8_BAR;
            PG8_LDB(B0, 1, 0); PG8_SCHED; PG8_LDA(At, 1, 0); PG8_STAGE(PG8_SA(0, 1), a2 + hstep, voffA);
            PG8_WAIT_L(8); PG8_BAR; PG8_WAIT_L(0); PG8_MMA(0, 0, At, B0); PG8_BAR; PG8_SCHED;
            PG8_LDB(B1, 1, 1); PG8_STAGE(PG8_SB(1, 0), b3, voffB);
            PG8_BAR; PG8_WAIT_L(0); PG8_MMA(0, 1, At, B1); PG8_BAR;
            PG8_LDA(At, 1, 1); PG8_STAGE(PG8_SA(1, 0), a3, voffA);
            PG8_BAR; PG8_WAIT_L(0); PG8_MMA(1, 0, At, B0); PG8_BAR; PG8_SCHED;
            PG8_STAGE(PG8_SB(1, 1), b3 + hstep, voffB);
            PG8_WAIT_V(6); PG8_BAR; PG8_MMA(1, 1, At, B1); PG8_BAR;
        }
        PG8_STAMP();
        if constexpr (!Epi::AFTER_DRAIN) { E(acc, cur, wr, wc, fr, fq); S.done(cur); }
        PG8_STAMP();
        if (!has_next) break;
#pragma unroll
        for (int a = 0; a < 2; ++a)
#pragma unroll
            for (int b = 0; b < 2; ++b)
#pragma unroll
                for (int m = 0; m < 4; ++m)
#pragma unroll
                    for (int n = 0; n < 2; ++n) acc[a][b][m][n] = (f32x4){0.f, 0.f, 0.f, 0.f};
        cur = nxt; cA = nA; cB = nB; ++ui;
    }
    PG8_WAIT_V(0);
    if (wr == 0) PG8_BAR;
    PG8_BAR;
    if constexpr (Epi::AFTER_DRAIN) { E.fused(acc, cur, wr, wc, fr, fq, lds, wid, lane); S.done(cur); }
    PG8_STAMP();
    if (STAMP && wid == 0) { stamps[lane] = lane < nts ? (((unsigned long long)(unsigned)ts_hi << 32) | (unsigned)ts_lo) : 0ull;
        if (lane == 62) stamps[62] = rt_entry; if (lane == 63) stamps[63] = (unsigned long long)wall_clock64(); }
#undef PG8_STAMP
#undef PG8_SA
#undef PG8_SB
#undef PG8_STAGE
#undef PG8_LDA
#undef PG8_LDB
#undef PG8_MMA
#undef PG8_WAIT_V
#undef PG8_WAIT_L
#undef PG8_BAR
#undef PG8_SCHED
}
}

namespace pg8 {
__device__ __forceinline__ float fast_sigmoid(float x) { return __builtin_amdgcn_rcpf(1.0f + __builtin_amdgcn_exp2f(-1.44269504089f * x)); }
struct EpiSwiGLU {
    static constexpr bool PERM = true, AFTER_DRAIN = false;
    bf16_t* H; int ldh;
    __device__ __forceinline__ void operator()(const f32x4 (&acc)[2][2][4][2], const Unit& u, int wr, int wc, int fr, int fq) const {
        const int row0 = u.pm * BM + wr * 64 + fr, hc0 = u.pn * 128 + wc * 32 + 8 * fq;
#pragma unroll
        for (int ai = 0; ai < 2; ++ai)
#pragma unroll
            for (int m = 0; m < 4; ++m) {
                bf16_t* rowp = H + (size_t)(row0 + ai * HALF + m * 16) * ldh + hc0;
                float v[8];
#pragma unroll
                for (int n = 0; n < 2; ++n)
#pragma unroll
                    for (int j = 0; j < 4; ++j) { const float g = acc[ai][0][m][n][j], up = acc[ai][1][m][n][j]; v[n * 4 + j] = g * fast_sigmoid(g) * up; }
                u32x4 w; w.x = cvt_pk_bf16(v[0], v[1]); w.y = cvt_pk_bf16(v[2], v[3]); w.z = cvt_pk_bf16(v[4], v[5]); w.w = cvt_pk_bf16(v[6], v[7]);
                *(u32x4*)rowp = w;
            }
    }
};
struct EpiResid {
    static constexpr bool PERM = false, AFTER_DRAIN = false;
    float* X; int ldc; float alpha;
    __device__ __forceinline__ void operator()(const f32x4 (&acc)[2][2][4][2], const Unit& u, int wr, int wc, int fr, int fq) const {
        const int row0 = u.pm * BM + wr * 64 + fr, col0 = u.pn * BM + wc * 32 + 4 * fq;
#pragma unroll
        for (int ai = 0; ai < 2; ++ai)
#pragma unroll
            for (int m = 0; m < 4; ++m) { float* rowp = X + (size_t)(row0 + ai * HALF + m * 16) * ldc + col0;
#pragma unroll
                for (int bj = 0; bj < 2; ++bj)
#pragma unroll
                    for (int n = 0; n < 2; ++n) { f32x4* p = (f32x4*)(rowp + bj * HALF + n * 16); const f32x4 old = *p; *p = old + acc[ai][bj][m][n] * alpha; } }
    }
};
struct EpiWin {
    static constexpr bool PERM = true, AFTER_DRAIN = false;
    unsigned char* zbase; const float* bias; float* small_out;
    __device__ __forceinline__ void operator()(const f32x4 (&acc)[2][2][4][2], const Unit& u, int wr, int wc, int fr, int fq) const {
        const int row0 = u.pm * BM + wr * 64 + fr; const int pn = u.pn;
        const int bcol0 = pn * BM + wc * 32 + 8 * fq;
        f32x4 bv[2][2];
#pragma unroll
        for (int bj = 0; bj < 2; ++bj)
#pragma unroll
            for (int n = 0; n < 2; ++n) bv[bj][n] = *(const f32x4*)(bias + bcol0 + bj * HALF + 4 * n);
        if (pn == 17) {
            if (wc < 2) {
#pragma unroll
                for (int ai = 0; ai < 2; ++ai)
#pragma unroll
                    for (int m = 0; m < 4; ++m) { float* rowp = small_out + (size_t)(row0 + ai * HALF + m * 16) * 64 + wc * 32 + 8 * fq;
#pragma unroll
                        for (int n = 0; n < 2; ++n) *(f32x4*)(rowp + 4 * n) = acc[ai][0][m][n] + bv[0][n]; }
            }
            return;
        }
        size_t base; int ld, c0;
        if (pn < 8) { base = (size_t)(pn >> 1) * ((size_t)T * 512 * 2); ld = 512; c0 = (pn & 1) * 256; }
        else if (pn < 11) { base = (size_t)4 * T * 512 * 2 + (size_t)(pn - 8) * ((size_t)T * 256 * 2); ld = 256; c0 = 0; }
        else { base = (size_t)4 * T * 512 * 2 + (size_t)3 * T * 256 * 2 + (size_t)((pn - 11) >> 1) * ((size_t)T * 512 * 2); ld = 512; c0 = ((pn - 11) & 1) * 256; }
        bf16_t* O = (bf16_t*)(zbase + base);
        const int col0 = c0 + wc * 32 + 8 * fq;
#pragma unroll
        for (int ai = 0; ai < 2; ++ai)
#pragma unroll
            for (int m = 0; m < 4; ++m) { bf16_t* rowp = O + (size_t)(row0 + ai * HALF + m * 16) * ld + col0;
#pragma unroll
                for (int bj = 0; bj < 2; ++bj) { const f32x4 v0 = acc[ai][bj][m][0] + bv[bj][0], v1 = acc[ai][bj][m][1] + bv[bj][1];
                    u32x4 w; w.x = cvt_pk_bf16(v0[0], v0[1]); w.y = cvt_pk_bf16(v0[2], v0[3]); w.z = cvt_pk_bf16(v1[0], v1[1]); w.w = cvt_pk_bf16(v1[2], v1[3]);
                    *(u32x4*)(rowp + bj * HALF) = w; } }
    }
};
struct EpiGate {
    static constexpr bool PERM = true, AFTER_DRAIN = false;
    bf16_t* G; int ldc; const float* bias;
    __device__ __forceinline__ void operator()(const f32x4 (&acc)[2][2][4][2], const Unit& u, int wr, int wc, int fr, int fq) const {
        const int row0 = u.pm * BM + wr * 64 + fr, col0 = u.pn * BM + wc * 32 + 8 * fq;
        f32x4 bv[2][2];
#pragma unroll
        for (int bj = 0; bj < 2; ++bj)
#pragma unroll
            for (int n = 0; n < 2; ++n) bv[bj][n] = *(const f32x4*)(bias + col0 + bj * HALF + 4 * n);
#pragma unroll
        for (int ai = 0; ai < 2; ++ai)
#pragma unroll
            for (int m = 0; m < 4; ++m) { bf16_t* rowp = G + (size_t)(row0 + ai * HALF + m * 16) * ldc + col0;
#pragma unroll
                for (int bj = 0; bj < 2; ++bj) { f32x4 v0 = acc[ai][bj][m][0] + bv[bj][0], v1 = acc[ai][bj][m][1] + bv[bj][1];
                    u32x4 w; w.x = cvt_pk_bf16(v0[0], v0[1]); w.y = cvt_pk_bf16(v0[2], v0[3]); w.z = cvt_pk_bf16(v1[0], v1[1]); w.w = cvt_pk_bf16(v1[2], v1[3]);
                    *(u32x4*)(rowp + bj * HALF) = w; } }
    }
};
struct EpiBranch {
    static constexpr bool PERM = true, AFTER_DRAIN = false;
    bf16_t* Y; const bf16_t* G; int ldc; int first;
    __device__ __forceinline__ void operator()(const f32x4 (&acc)[2][2][4][2], const Unit& u, int wr, int wc, int fr, int fq) const {
        const int row0 = u.pm * BM + wr * 64 + fr, col0 = u.pn * BM + wc * 32 + 8 * fq;
#pragma unroll
        for (int ai = 0; ai < 2; ++ai)
#pragma unroll
            for (int m = 0; m < 4; ++m) { const size_t off = (size_t)(row0 + ai * HALF + m * 16) * ldc + col0;
#pragma unroll
                for (int bj = 0; bj < 2; ++bj) {
                    const u32x4 g = *(const u32x4*)(G + off + bj * HALF);
                    u32x4 y = (u32x4){0u, 0u, 0u, 0u}; if (!first) y = *(const u32x4*)(Y + off + bj * HALF);
                    const f32x4 a0 = acc[ai][bj][m][0], a1 = acc[ai][bj][m][1];
                    float o[8];
#pragma unroll
                    for (int q = 0; q < 4; ++q) { const unsigned gw = g[q], yw = y[q]; const float al = q < 2 ? a0[2 * q] : a1[2 * q - 4], ah = q < 2 ? a0[2 * q + 1] : a1[2 * q - 3];
                        o[2 * q] = __builtin_bit_cast(float, yw << 16) + fast_sigmoid(__builtin_bit_cast(float, gw << 16)) * al;
                        o[2 * q + 1] = __builtin_bit_cast(float, yw & 0xffff0000u) + fast_sigmoid(__builtin_bit_cast(float, gw & 0xffff0000u)) * ah; }
                    u32x4 w; w.x = cvt_pk_bf16(o[0], o[1]); w.y = cvt_pk_bf16(o[2], o[3]); w.z = cvt_pk_bf16(o[4], o[5]); w.w = cvt_pk_bf16(o[6], o[7]);
                    *(u32x4*)(Y + off + bj * HALF) = w; } }
    }
};
}

constexpr int RING_BYTES = 131072;
constexpr int MISC_OFF = RING_BYTES + 320;
constexpr int LDS_BYTES = 147456;

__constant__ float ROPE_FREQ[32] = {
1.000000000e+00f, 7.498942614e-01f, 5.623413324e-01f, 4.216965139e-01f, 3.162277639e-01f, 2.371373773e-01f, 1.778279394e-01f, 1.333521307e-01f, 1.000000015e-01f, 7.498941571e-02f, 5.623413250e-02f, 4.216965288e-02f, 3.162277490e-02f, 2.371373773e-02f, 1.778279431e-02f, 1.333521493e-02f, 9.999999776e-03f, 7.498941850e-03f, 5.623413250e-03f, 4.216964822e-03f, 3.162277630e-03f, 2.371373586e-03f, 1.778279431e-03f, 1.333521446e-03f, 1.000000047e-03f, 7.498942432e-04f, 5.623413017e-04f, 4.216965172e-04f, 3.162277571e-04f, 2.371373703e-04f, 1.778279402e-04f, 1.333521504e-04f};

struct Args { const float* in[23]; float* out; unsigned char* ws; int ph_lo, ph_hi; };

struct Ctx {
    LAS unsigned char* lds;
    int tid, lane, wave, G, bid;
    __device__ __forceinline__ void launder() { asm volatile("" : "+v"(tid)); lane = tid & 63; asm volatile("" : "+s"(inp));
        GAS unsigned char* g = (GAS unsigned char*)ws; asm volatile("" : "+s"(g)); ws = (unsigned char*)g;
        GAS float* gx = (GAS float*)X; asm volatile("" : "+s"(gx)); X = (float*)gx; }
    const GAS float* const __attribute__((address_space(4)))* inp; float* X; unsigned char* ws;
    __device__ __forceinline__ const float* in(int k) const { return (const float*)inp[k]; }
};

__device__ __forceinline__ void transpose_item(const float* W, int ldw, int src_col0, bf16* WT, int K, int dst_row0, int kb, LAS float* scr, int lane) {
    const int k0 = 64 * kb;
#pragma unroll 8
    for (int i = 0; i < 32; ++i) { const int kk = 2 * i + (lane >> 5); scr[kk * 33 + (lane & 31)] = W[(size_t)(k0 + kk) * ldw + src_col0 + (lane & 31)]; }
    LDS_WAIT(); asm volatile("" ::: "memory");
    const int c = lane & 7;
#pragma unroll
    for (int j = 0; j < 4; ++j) { const int n = (lane >> 3) + 8 * j; const LAS float* s = scr + (8 * c) * 33 + n;
        v4u o; o.x = pk2(s[0 * 33], s[1 * 33]); o.y = pk2(s[2 * 33], s[3 * 33]); o.z = pk2(s[4 * 33], s[5 * 33]); o.w = pk2(s[6 * 33], s[7 * 33]);
        *(v4u*)(WT + (size_t)(dst_row0 + n) * K + k0 + 8 * c) = o; }
    LDS_WAIT(); asm volatile("" ::: "memory");
}
__device__ __forceinline__ int win_small_src(int i) { return i < 16 ? 1536 + i : i < 40 ? 2832 + (i - 16) : i < 44 ? 4392 + (i - 40) : i < 48 ? 4396 + (i - 44) : -1; }
__device__ __forceinline__ int win_src_col(int n) { return n < 1536 ? n : n < 2816 ? n + 16 : n < 4352 ? n + 40 : win_small_src(n - 4352); }

__device__ __forceinline__ void phase_prep_weights(const Ctx& C, int l) {
    LAS float* scr = (LAS float*)(C.lds + C.wave * 16384);
    const int gw = C.bid * NWAVES + C.wave, NGW = C.G * NWAVES;
    unsigned char* ws = C.ws;
    constexpr int I_GU = 16 * 88, I_DN = 44 * 32, I_WIN = 16 * 136, I_GT = 16 * 96, I_BR = 3 * 8 * 32, I_OUT = 16 * 32, I_C1 = 2 * 32 * 8, I_C2 = 2 * 4 * 2;
    constexpr int I_FFN = 2 * I_GU + I_DN;
    constexpr int NITEMS = 2 * I_FFN + I_WIN + I_GT + I_BR + I_OUT + I_C1 + I_C2;
    for (int it = gw; it < NITEMS; it += NGW) {
        int r = it;
        if (r < 2 * I_FFN) {
            const int f = r / I_FFN; r -= f * I_FFN;
            const float* wg = (f ? C.in(20) : C.in(2)) + (size_t)l * DM * DFF; const float* wu = (f ? C.in(21) : C.in(3)) + (size_t)l * DM * DFF; const float* wd = (f ? C.in(22) : C.in(4)) + (size_t)l * DFF * DM;
            bf16* WGU = (bf16*)(ws + (f ? WS_WGU2 : WS_WGU1)); bf16* WDN = (bf16*)(ws + (f ? WS_WDN2 : WS_WDN1));
            if (r < I_GU) { const int kb = r / 88, col = 32 * (r % 88); transpose_item(wg, DFF, col, WGU, DM, 256 * (col >> 7) + (col & 127), kb, scr, C.lane); }
            else if (r < 2 * I_GU) { r -= I_GU; const int kb = r / 88, col = 32 * (r % 88); transpose_item(wu, DFF, col, WGU, DM, 256 * (col >> 7) + 128 + (col & 127), kb, scr, C.lane); }
            else { r -= 2 * I_GU; const int kb = r / 32, col = 32 * (r % 32); transpose_item(wd, DM, col, WDN, DFF, col, kb, scr, C.lane); }
            continue;
        }
        r -= 2 * I_FFN;
        const float* win = C.in(6) + (size_t)l * DM * N_IN;
        if (r < I_WIN) { const int kb = r / 136, n = 32 * (r % 136); transpose_item(win, N_IN, win_src_col(n), (bf16*)(ws + WS_WIN), DM, n, kb, scr, C.lane); continue; } r -= I_WIN;
        if (r < I_GT) { const int kb = r / 96, n = 32 * (r % 96); transpose_item(win, N_IN, 4400 + n, (bf16*)(ws + WS_WGT), DM, n, kb, scr, C.lane); continue; } r -= I_GT;
        if (r < I_BR) { const int i = r / 256, rr = r % 256, kb = rr / 32, n = 32 * (rr % 32);
            transpose_item(C.in(17) + ((size_t)l * 3 + i) * 512 * DM, DM, n, (bf16*)(ws + WS_WBR) + (size_t)i * DM * 512, 512, n, kb, scr, C.lane); continue; } r -= I_BR;
        if (r < I_OUT) { const int kb = r / 32, n = 32 * (r % 32); transpose_item(C.in(18) + (size_t)l * DM * DM, DM, n, (bf16*)(ws + WS_WOUT), DM, n, kb, scr, C.lane); continue; } r -= I_OUT;
        if (r < I_C1) { const int kv = r / 256, rr = r % 256, kb = rr / 8, n = 32 * (rr % 8);
            transpose_item(C.in(13) + ((size_t)l * 2 + kv) * 2048 * 256, 256, n, (bf16*)(ws + WS_CW1) + (size_t)kv * 256 * 2048, 2048, n, kb, scr, C.lane); continue; } r -= I_C1;
        { const int kv = r / 8, rr = r % 8, kb = rr / 2, n = 32 * (rr % 2);
            transpose_item(C.in(14) + ((size_t)l * 2 + kv) * 256 * 64, 64, n, (bf16*)(ws + WS_CW2) + (size_t)kv * 64 * 256, 256, n, kb, scr, C.lane); }
    }
    const int gt = C.bid * NTHR + C.tid, NGT = C.G * NTHR;
    {
        const float* win = C.in(6) + (size_t)l * DM * N_IN; bf16* WIN = (bf16*)(ws + WS_WIN);
        for (int idx = gt; idx < 256 * 128; idx += NGT) { const int i = idx & 255, kc = idx >> 8; const int sc = win_small_src(i);
            v4u o = (v4u){0u, 0u, 0u, 0u};
            if (sc >= 0) { float v[8];
#pragma unroll
                for (int j = 0; j < 8; ++j) v[j] = win[(size_t)(kc * 8 + j) * N_IN + sc];
                o.x = pk2(v[0], v[1]); o.y = pk2(v[2], v[3]); o.z = pk2(v[4], v[5]); o.w = pk2(v[6], v[7]); }
            *(v4u*)(WIN + (size_t)(4352 + i) * DM + kc * 8) = o; }
        float* vec = (float*)(ws + WS_VEC); const float* bin = C.in(7) + (size_t)l * N_IN;
        for (int n = gt; n < 4608; n += NGT) { const int sc = win_src_col(n); vec[VEC_BINP + n] = sc >= 0 ? bin[sc] : 0.f; }
        for (int it = gw; it < 512; it += NGW) { const int kv = it >> 8, n = it & 255;
            const float* pe = C.in(12) + ((size_t)l * 2 + kv) * 2048; const float* w1 = C.in(13) + ((size_t)l * 2 + kv) * 2048 * 256;
            float s = 0.f;
            for (int k = C.lane; k < 2048; k += 64) s += pe[k] * w1[(size_t)k * 256 + n];
            s = wave_sum(s);
            if (C.lane == 0) vec[VEC_CB1 + it] = s; }
    }
}

__device__ __forceinline__ void phase_init(const Ctx& C) {
    const int gt = C.bid * NTHR + C.tid, NGT = C.G * NTHR;
    const f32x4* src = (const f32x4*)C.in(0); f32x4* dst = (f32x4*)C.X;
    for (size_t i = gt; i < (size_t)T * DM / 4; i += NGT) dst[i] = src[i];
    f32x2* rope = (f32x2*)(C.ws + WS_ROPE);
    for (int i = gt; i < SEQ * 32; i += NGT) { const int pos = i >> 5, fi = i & 31;
        const float ang = (float)pos * ROPE_FREQ[fi];
        double rev = (double)ang * 0.15915494309189533577; rev -= floor(rev);
        const float rf = (float)rev;
        rope[i] = (f32x2){__builtin_amdgcn_cosf(rf), __builtin_amdgcn_sinf(rf)}; }
}

__device__ __forceinline__ void phase_norm(const Ctx& C, const float* gain) {
    const int gw = C.bid * NWAVES + C.wave, NGW = C.G * NWAVES;
    bf16* XN = (bf16*)(C.ws + WS_XN);
    f32x4 g[4];
#pragma unroll
    for (int j = 0; j < 4; ++j) g[j] = ((const f32x4*)gain)[C.lane + 64 * j];
    for (int m = gw; m < T; m += NGW) {
        const f32x4* xr = (const f32x4*)(C.X + (size_t)m * DM) + C.lane;
        f32x4 v[4]; float s = 0.f;
#pragma unroll
        for (int j = 0; j < 4; ++j) { v[j] = xr[64 * j]; s += (v[j].x * v[j].x + v[j].y * v[j].y) + (v[j].z * v[j].z + v[j].w * v[j].w); }
        const float r = 1.0f / sqrtf(wave_sum(s) * (1.f / DM) + RMS_EPS);
        unsigned long long* o8 = (unsigned long long*)(XN + (size_t)m * DM) + C.lane;
#pragma unroll
        for (int j = 0; j < 4; ++j) { const f32x4 w = v[j] * r * g[j]; o8[64 * j] = (unsigned long long)pk2(w.x, w.y) | ((unsigned long long)pk2(w.z, w.w) << 32); }
    }
}

template <int KSTEPS, class PA, class PB>
__device__ __forceinline__ f32x4 mma_tile(PA A, int lda, PB Bt, int ldb, f32x4 acc, int lane) {
    const int r = lane & 15, q = lane >> 4;
#pragma unroll
    for (int kk = 0; kk < KSTEPS; ++kk) {
        const bf16x8 a = *(const bf16x8*)(A + r * lda + kk * 32 + 8 * q);
        const bf16x8 b = *(const bf16x8*)(Bt + r * ldb + kk * 32 + 8 * q);
        acc = __builtin_amdgcn_mfma_f32_16x16x32_bf16(a, b, acc, 0, 0, 0);
    }
    return acc;
}
__device__ __forceinline__ float wave_scan_sum(float v, int lane) {
#pragma unroll
    for (int o = 1; o < 64; o <<= 1) { const float t = __shfl_up(v, o); if (lane >= o) v += t; }
    return v;
}
__device__ __forceinline__ float wave_scan_max(float v, int lane) {
#pragma unroll
    for (int o = 1; o < 64; o <<= 1) { const float t = __shfl_up(v, o); if (lane >= o) v = fmaxf(v, t); }
    return v;
}

constexpr int CU_ALR = 0;
constexpr int CU_GT = 4096;
constexpr int CU_VEC = 6144;
constexpr int CU_KT = 8192;
constexpr int CU_VT = 17408;
constexpr int CU_Q = 35840;
constexpr int CU_AT = 45056;
constexpr int CU_O = 54272;
constexpr int CU_END = 88064;

__device__ __forceinline__ void load_vt(const Ctx& C, const bf16* V, int t0, int h) {
    LAS bf16* VT = (LAS bf16*)(C.lds + CU_VT);
    const int dv = C.tid & 127, jq = C.tid >> 7;
    const bf16* src = V + (size_t)(t0 + 16 * jq) * 512 + h * 128 + dv;
    unsigned w[8];
#pragma unroll
    for (int jj = 0; jj < 8; ++jj) { const unsigned lo = src[(size_t)(2 * jj) * 512], hi = src[(size_t)(2 * jj + 1) * 512]; w[jj] = lo | (hi << 16); }
    *(LAS v4u*)(VT + dv * 72 + 16 * jq) = (v4u){w[0], w[1], w[2], w[3]};
    *(LAS v4u*)(VT + dv * 72 + 16 * jq + 8) = (v4u){w[4], w[5], w[6], w[7]};
}

__device__ __forceinline__ float gla_cumsum(const Ctx& C, int l, int t0, int h, float (&b)[8]) {
    LAS float* ALR = (LAS float*)(C.lds + CU_ALR); LAS float* GT = (LAS float*)(C.lds + CU_GT);
    const float* SMALL = (const float*)(C.ws + WS_SMALL);
    if (C.tid < 256) { const int j = C.tid >> 2, c4 = C.tid & 3; *(LAS f32x4*)(ALR + j * 16 + 4 * c4) = *(const f32x4*)(SMALL + (size_t)(t0 + j) * 64 + 4 * c4); }
    const int dk = C.tid & 63, jg = C.tid >> 6;
    float w[16]; const float* wa = C.in(8) + (size_t)l * 16 * 256 + h * 64 + dk;
#pragma unroll
    for (int r = 0; r < 16; ++r) w[r] = wa[r * 256];
    const float ba = C.in(9)[(size_t)l * 256 + h * 64 + dk];
    __syncthreads();
    float run = 0.f;
#pragma unroll
    for (int jj = 0; jj < 8; ++jj) { const int j = 8 * jg + jj; float x = ba;
#pragma unroll
        for (int r = 0; r < 16; ++r) x += ALR[j * 16 + r] * w[r];
        run += logsigmoidf_(x) * (1.0f / 16.0f); b[jj] = run; }
    GT[jg * 64 + dk] = run;
    __syncthreads();
    float pre = 0.f, tot = 0.f;
#pragma unroll
    for (int g2 = 0; g2 < 8; ++g2) { const float v = GT[g2 * 64 + dk]; tot += v; if (g2 < jg) pre += v; }
#pragma unroll
    for (int jj = 0; jj < 8; ++jj) b[jj] += pre;
    return tot;
}

__device__ __forceinline__ void gla_unit_a(const Ctx& C, int l, int ci) {
    const int bh = ci >> 8, c = ci & 255, bb = bh >> 2, h = bh & 3, t0 = bb * SEQ + c * 64;
    const bf16* QKA = (const bf16*)(C.ws + WS_QKA);
    load_vt(C, (const bf16*)(C.ws + WS_VA), t0, h);
    float b[8]; const float btot = gla_cumsum(C, l, t0, h, b);
    const int dk = C.tid & 63, jg = C.tid >> 6;
    LAS bf16* KT = (LAS bf16*)(C.lds + CU_KT);
    float kd[8];
#pragma unroll
    for (int jj = 0; jj < 8; ++jj) { const float k = bf2f(QKA[(size_t)(t0 + 8 * jg + jj) * 512 + 256 + h * 64 + dk]); kd[jj] = k * fexp(btot - b[jj]); }
    *(LAS v4u*)(KT + dk * 72 + 8 * jg) = (v4u){pk2(kd[0], kd[1]), pk2(kd[2], kd[3]), pk2(kd[4], kd[5]), pk2(kd[6], kd[7])};
    if (jg == 0) ((float*)(C.ws + WS_GDEC))[(size_t)ci * 64 + dk] = fexp(btot);
    __syncthreads();
    const LAS bf16* VT = (const LAS bf16*)(C.lds + CU_VT);
    bf16* GST = (bf16*)(C.ws + WS_GST) + (size_t)ci * 8192;
    const int q = C.lane >> 4, fr = C.lane & 15;
#pragma unroll
    for (int nt = 0; nt < 4; ++nt) {
        f32x4 acc = (f32x4){0.f, 0.f, 0.f, 0.f};
        acc = mma_tile<2>(VT + 16 * C.wave * 72, 72, (const LAS bf16*)KT + 16 * nt * 72, 72, acc, C.lane);
#pragma unroll
        for (int r = 0; r < 4; ++r) GST[(16 * C.wave + 4 * q + r) * 64 + 16 * nt + fr] = (bf16)f2bf(acc[r]);
    }
    __syncthreads();
}

__device__ __forceinline__ void gla_unit_c(const Ctx& C, int l, int ci) {
    const int bh = ci >> 8, c = ci & 255, bb = bh >> 2, h = bh & 3, t0 = bb * SEQ + c * 64;
    const bf16* QKA = (const bf16*)(C.ws + WS_QKA);
    load_vt(C, (const bf16*)(C.ws + WS_VA), t0, h);
    float b[8]; (void)gla_cumsum(C, l, t0, h, b);
    const int dk = C.tid & 63, jg = C.tid >> 6;
    LAS bf16* KT = (LAS bf16*)(C.lds + CU_KT); LAS bf16* QT = (LAS bf16*)(C.lds + CU_Q); LAS bf16* AT = (LAS bf16*)(C.lds + CU_AT);
#pragma unroll
    for (int jj = 0; jj < 8; ++jj) { const int j = 8 * jg + jj; const bf16* p = QKA + (size_t)(t0 + j) * 512 + h * 64 + dk;
        const float qv = bf2f(p[0]) * 0.125f, kv = bf2f(p[256]);
        QT[j * 72 + dk] = (bf16)f2bf(qv * fexp(b[jj])); KT[j * 72 + dk] = (bf16)f2bf(kv * fexp(fminf(-b[jj], 80.f))); }
    __syncthreads();
    const int q = C.lane >> 4, fr = C.lane & 15;
    {
        const int it = C.wave >> 1;
#pragma unroll
        for (int u = 0; u < 2; ++u) { const int jt = 2 * (C.wave & 1) + u;
            f32x4 acc = (f32x4){0.f, 0.f, 0.f, 0.f};
            if (jt <= it) acc = mma_tile<2>((const LAS bf16*)KT + 16 * jt * 72, 72, (const LAS bf16*)QT + 16 * it * 72, 72, acc, C.lane);
            const int i = 16 * it + fr;
            float v[4];
#pragma unroll
            for (int r = 0; r < 4; ++r) { const int j = 16 * jt + 4 * q + r; v[r] = (j <= i) ? acc[r] : 0.f; }
            *(LAS v2u*)(AT + i * 72 + 16 * jt + 4 * q) = (v2u){pk2(v[0], v[1]), pk2(v[2], v[3])}; }
    }
    __syncthreads();
    {
        const int it = C.wave & 3; LAS float* O = (LAS float*)(C.lds + CU_O);
        const bf16* ST = (const bf16*)(C.ws + WS_GST) + (size_t)ci * 8192;
        const LAS bf16* VT = (const LAS bf16*)(C.lds + CU_VT);
#pragma unroll
        for (int u = 0; u < 4; ++u) { const int dvt = 4 * (C.wave >> 2) + u;
            f32x4 acc = (f32x4){0.f, 0.f, 0.f, 0.f};
            if (!(ABL_ZERO & 64)) acc = mma_tile<2>((const LAS bf16*)QT + 16 * it * 72, 72, ST + 16 * dvt * 64, 64, acc, C.lane);
            acc = mma_tile<2>((const LAS bf16*)AT + 16 * it * 72, 72, VT + 16 * dvt * 72, 72, acc, C.lane);
#pragma unroll
            for (int r = 0; r < 4; ++r) O[(16 * it + 4 * q + r) * 132 + 16 * dvt + fr] = acc[r]; }
    }
    __syncthreads();
    {
        const int i = C.tid >> 3, s = C.tid & 7; const LAS float* O = (const LAS float*)(C.lds + CU_O) + i * 132 + 16 * s;
        float o[16]; float ss = 0.f;
#pragma unroll
        for (int k = 0; k < 16; ++k) { o[k] = O[k]; ss += o[k] * o[k]; }
        ss += __shfl_xor(ss, 1); ss += __shfl_xor(ss, 2); ss += __shfl_xor(ss, 4);
        const float rinv = 1.0f / sqrtf(ss * (1.0f / 128.0f) + RMS_EPS);
        bf16* RA = (bf16*)(C.ws + WS_RA) + (size_t)(t0 + i) * 512 + h * 128 + 16 * s;
        const float* gn = C.in(10) + (size_t)l * 128 + 16 * s;
        const v4u r0 = *(const v4u*)RA, r1 = *(const v4u*)(RA + 8);
        unsigned rw[8] = {r0.x, r0.y, r0.z, r0.w, r1.x, r1.y, r1.z, r1.w}; unsigned ow[8];
#pragma unroll
        for (int k = 0; k < 8; ++k) { const float a = SCL_A * o[2 * k] * rinv * gn[2 * k] * siluf_(bflo(rw[k])), bq = SCL_A * o[2 * k + 1] * rinv * gn[2 * k + 1] * siluf_(bfhi(rw[k])); ow[k] = (ABL_ZERO & 1) ? 0u : pk2(a, bq); }
        *(v4u*)RA = (v4u){ow[0], ow[1], ow[2], ow[3]}; *(v4u*)(RA + 8) = (v4u){ow[4], ow[5], ow[6], ow[7]};
    }
    __syncthreads();
}

__device__ __forceinline__ void conv_silu8(const Ctx& C, int l, int t0, int c, int ch, int jg, float (&out)[8]) {
    const bf16* X = (const bf16*)(C.ws + WS_QKC);
    const float* cw = C.in(15) + (size_t)l * 4 * 512 + ch; const float cb = C.in(16)[(size_t)l * 512 + ch];
    const float w0 = cw[0], w1 = cw[512], w2 = cw[1024], w3 = cw[1536];
    float x[11];
#pragma unroll
    for (int k = 0; k < 11; ++k) { const int j = 8 * jg + k - 3; const int s = c * 64 + j; x[k] = (s >= 0) ? bf2f(X[(size_t)(t0 + j) * 512 + ch]) : 0.f; }
#pragma unroll
    for (int jj = 0; jj < 8; ++jj) out[jj] = siluf_(cb + w0 * x[jj] + w1 * x[jj + 1] + w2 * x[jj + 2] + w3 * x[jj + 3]);
}

__device__ __forceinline__ void mlstm_unit_a(const Ctx& C, int l, int ci) {
    const int bh = ci >> 8, c = ci & 255, bb = bh >> 2, h = bh & 3, t0 = bb * SEQ + c * 64;
    LAS float* VEC = (LAS float*)(C.lds + CU_VEC); LAS float* GT = (LAS float*)(C.lds + CU_GT);
    load_vt(C, (const bf16*)(C.ws + WS_VC), t0, h);
    const int dk = C.tid & 63, jg = C.tid >> 6;
    float k[8]; conv_silu8(C, l, t0, c, 256 + h * 64 + dk, jg, k);
    if (C.wave == 0) {
        const float* sm = (const float*)(C.ws + WS_SMALL) + (size_t)(t0 + C.lane) * 64;
        const float ip = sm[40 + h], lf = logsigmoidf_(sm[44 + h]);
        const float bj = wave_scan_sum(lf, C.lane); const float a = ip - bj; const float amax = wave_max(a);
        VEC[C.lane] = fexp(a - amax);
        if (C.lane == 63) { float* msc = (float*)(C.ws + WS_MSC) + (size_t)ci * 4; msc[0] = bj; msc[1] = amax; }
    }
    __syncthreads();
    LAS bf16* KT = (LAS bf16*)(C.lds + CU_KT);
    float kw[8]; float ns = 0.f;
#pragma unroll
    for (int jj = 0; jj < 8; ++jj) { kw[jj] = k[jj] * 0.125f * VEC[8 * jg + jj]; ns += kw[jj]; }
    *(LAS v4u*)(KT + dk * 72 + 8 * jg) = (v4u){pk2(kw[0], kw[1]), pk2(kw[2], kw[3]), pk2(kw[4], kw[5]), pk2(kw[6], kw[7])};
    GT[jg * 64 + dk] = ns;
    __syncthreads();
    if (C.tid < 64) { float s = 0.f;
#pragma unroll
        for (int g2 = 0; g2 < 8; ++g2) s += GT[g2 * 64 + C.tid];
        ((float*)(C.ws + WS_MN))[(size_t)ci * 64 + C.tid] = s; }
    const LAS bf16* VT = (const LAS bf16*)(C.lds + CU_VT);
    bf16* MST = (bf16*)(C.ws + WS_MST) + (size_t)ci * 8192;
    const int q = C.lane >> 4, fr = C.lane & 15;
#pragma unroll
    for (int nt = 0; nt < 4; ++nt) {
        f32x4 acc = (f32x4){0.f, 0.f, 0.f, 0.f};
        acc = mma_tile<2>(VT + 16 * C.wave * 72, 72, (const LAS bf16*)KT + 16 * nt * 72, 72, acc, C.lane);
#pragma unroll
        for (int r = 0; r < 4; ++r) MST[(16 * C.wave + 4 * q + r) * 64 + 16 * nt + fr] = (bf16)f2bf(acc[r]);
    }
    __syncthreads();
}

__device__ __forceinline__ void mlstm_unit_c(const Ctx& C, int l, int ci) {
    const int bh = ci >> 8, c = ci & 255, bb = bh >> 2, h = bh & 3, t0 = bb * SEQ + c * 64;
    LAS float* VEC = (LAS float*)(C.lds + CU_VEC);
    LAS float* AJ = VEC + 64, *MI = VEC + 128, *WI = VEC + 192, *EM = VEC + 256, *QN = VEC + 384; LAS float* DENP = (LAS float*)(C.lds + CU_GT);
    load_vt(C, (const bf16*)(C.ws + WS_VC), t0, h);
    const int dk = C.tid & 63, jg = C.tid >> 6;
    LAS bf16* KT = (LAS bf16*)(C.lds + CU_KT); LAS bf16* QT = (LAS bf16*)(C.lds + CU_Q); LAS bf16* AT = (LAS bf16*)(C.lds + CU_AT);
    {
        float qv[8], kv[8]; conv_silu8(C, l, t0, c, h * 64 + dk, jg, qv); conv_silu8(C, l, t0, c, 256 + h * 64 + dk, jg, kv);
#pragma unroll
        for (int jj = 0; jj < 8; ++jj) { const int j = 8 * jg + jj; QT[j * 72 + dk] = (bf16)f2bf(qv[jj]); KT[j * 72 + dk] = (bf16)f2bf(kv[jj] * 0.125f); }
    }
    if (C.wave == 0) {
        const float* sm = (const float*)(C.ws + WS_SMALL) + (size_t)(t0 + C.lane) * 64;
        const float ip = sm[40 + h], lf = logsigmoidf_(sm[44 + h]);
        const float bj = wave_scan_sum(lf, C.lane); const float a = ip - bj; const float arun = wave_scan_max(a, C.lane);
        const float mst = ((const float*)(C.ws + WS_MSC))[(size_t)ci * 4 + 2];
        const float mi = fmaxf(mst, arun);
        AJ[C.lane] = a; MI[C.lane] = mi; WI[C.lane] = fexp(mst - mi); EM[C.lane] = fexp(-(bj + mi));
    }
    __syncthreads();
    const int q = C.lane >> 4, fr = C.lane & 15;
    {
        const int it = C.wave >> 1;
#pragma unroll
        for (int u = 0; u < 2; ++u) { const int jt = 2 * (C.wave & 1) + u;
            f32x4 acc = (f32x4){0.f, 0.f, 0.f, 0.f};
            if (jt <= it) acc = mma_tile<2>((const LAS bf16*)KT + 16 * jt * 72, 72, (const LAS bf16*)QT + 16 * it * 72, 72, acc, C.lane);
            const int i = 16 * it + fr; const float mi = MI[i];
            float v[4]; float ds = 0.f;
#pragma unroll
            for (int r = 0; r < 4; ++r) { const int j = 16 * jt + 4 * q + r; v[r] = (j <= i) ? acc[r] * fexp(AJ[j] - mi) : 0.f; ds += v[r]; }
            ds += __shfl_xor(ds, 16); ds += __shfl_xor(ds, 32);
            if (q == 0) DENP[jt * 64 + i] = ds;
            *(LAS v2u*)(AT + i * 72 + 16 * jt + 4 * q) = (v2u){pk2(v[0], v[1]), pk2(v[2], v[3])}; }
    }
    {
        const int i = C.tid >> 3, s = C.tid & 7; const float* nst = (const float*)(C.ws + WS_MN) + (size_t)ci * 64 + 8 * s;
        float a = 0.f;
#pragma unroll
        for (int k = 0; k < 8; ++k) a += bf2f(QT[i * 72 + 8 * s + k]) * nst[k];
        a += __shfl_xor(a, 1); a += __shfl_xor(a, 2); a += __shfl_xor(a, 4);
        if (s == 0) QN[i] = a;
    }
    __syncthreads();
    {
        const int it = C.wave & 3; LAS float* O = (LAS float*)(C.lds + CU_O);
        const bf16* ST = (const bf16*)(C.ws + WS_MST) + (size_t)ci * 8192;
        const LAS bf16* VT = (const LAS bf16*)(C.lds + CU_VT);
#pragma unroll
        for (int u = 0; u < 4; ++u) { const int dvt = 4 * (C.wave >> 2) + u;
            f32x4 a1 = (f32x4){0.f, 0.f, 0.f, 0.f}, a2 = (f32x4){0.f, 0.f, 0.f, 0.f};
            a1 = mma_tile<2>((const LAS bf16*)QT + 16 * it * 72, 72, ST + 16 * dvt * 64, 64, a1, C.lane);
            a2 = mma_tile<2>((const LAS bf16*)AT + 16 * it * 72, 72, VT + 16 * dvt * 72, 72, a2, C.lane);
#pragma unroll
            for (int r = 0; r < 4; ++r) { const int i = 16 * it + 4 * q + r; O[i * 132 + 16 * dvt + fr] = WI[i] * a1[r] + a2[r]; } }
    }
    __syncthreads();
    {
        const int i = C.tid >> 3, s = C.tid & 7; const LAS float* O = (const LAS float*)(C.lds + CU_O) + i * 132 + 16 * s;
        const float den = WI[i] * QN[i] + ((DENP[i] + DENP[64 + i]) + (DENP[128 + i] + DENP[192 + i])); const float dinv = 1.0f / fmaxf(fabsf(den), EM[i]);
        bf16* OC = (bf16*)(C.ws + WS_OC) + (size_t)(t0 + i) * 512 + h * 128 + 16 * s;
        const v4u r0 = *(const v4u*)OC, r1 = *(const v4u*)(OC + 8);
        unsigned rw[8] = {r0.x, r0.y, r0.z, r0.w, r1.x, r1.y, r1.z, r1.w}; unsigned ow[8];
#pragma unroll
        for (int k = 0; k < 8; ++k) ow[k] = (ABL_ZERO & 4) ? 0u : pk2(SCL_C * O[2 * k] * dinv * sigmoidf_(bflo(rw[k])), SCL_C * O[2 * k + 1] * dinv * sigmoidf_(bfhi(rw[k])));
        *(v4u*)OC = (v4u){ow[0], ow[1], ow[2], ow[3]}; *(v4u*)(OC + 8) = (v4u){ow[4], ow[5], ow[6], ow[7]};
    }
    __syncthreads();
}

__device__ __forceinline__ void phase_scan(const Ctx& C) {
    const int gt = C.bid * NTHR + C.tid, NGT = C.G * NTHR;
    for (int e = gt; e < 65536 + 65536 + 512; e += NGT) {
        if (e < 65536) {
            const int bh = e >> 13, el = e & 8191, dk = el & 63;
            bf16* st = (bf16*)(C.ws + WS_GST) + (size_t)bh * 256 * 8192 + el; const float* dec = (const float*)(C.ws + WS_GDEC) + (size_t)bh * 256 * 64 + dk;
            float s = 0.f;
            for (int c0 = 0; c0 < 256; c0 += 8) { float L[8], d[8];
#pragma unroll
                for (int k = 0; k < 8; ++k) { L[k] = bf2f(st[(size_t)(c0 + k) * 8192]); d[k] = dec[(c0 + k) * 64]; }
#pragma unroll
                for (int k = 0; k < 8; ++k) { st[(size_t)(c0 + k) * 8192] = (bf16)f2bf(s); s = d[k] * s + L[k]; } }
        } else {
            const bool isn = e >= 131072; const int e2 = e - (isn ? 131072 : 65536);
            const int bh = isn ? (e2 >> 6) : (e2 >> 13), el = isn ? (e2 & 63) : (e2 & 8191);
            bf16* st = (bf16*)(C.ws + WS_MST) + (size_t)bh * 256 * 8192 + el; float* nv = (float*)(C.ws + WS_MN) + (size_t)bh * 256 * 64 + el;
            float* msc = (float*)(C.ws + WS_MSC) + (size_t)bh * 256 * 4;
            float s = 0.f, m = 0.f;
            for (int c0 = 0; c0 < 256; c0 += 8) { float L[8], bl[8], am[8];
#pragma unroll
                for (int k = 0; k < 8; ++k) { L[k] = isn ? nv[(c0 + k) * 64] : bf2f(st[(size_t)(c0 + k) * 8192]); bl[k] = msc[(c0 + k) * 4]; am[k] = msc[(c0 + k) * 4 + 1]; }
#pragma unroll
                for (int k = 0; k < 8; ++k) {
                    const float mn = bl[k] + fmaxf(m, am[k]); const float al = fexp(bl[k] + m - mn), be = fexp(bl[k] + am[k] - mn);
                    if (isn) { nv[(c0 + k) * 64] = s; if (el == 0) msc[(c0 + k) * 4 + 2] = m; } else st[(size_t)(c0 + k) * 8192] = (bf16)f2bf(s);
                    s = al * s + be * L[k]; m = mn; } }
        }
    }
}

__device__ __forceinline__ float gelu_tanh(float x) { const float u = 0.7978845608f * (x + 0.044715f * x * x * x); const float e = __expf(2.0f * u); return 0.5f * x * (2.0f - 2.0f / (1.0f + e)); }

__device__ __forceinline__ void nsa_norm_rope_row(bf16* p, const float* gain, const f32x2* rope_row, float scale, int lane) {
    const float x = bf2f(p[lane]);
    const float ss = wave_sum(x * x);
    const float y = x * (1.0f / sqrtf(ss * (1.0f / 64.0f) + RMS_EPS)) * gain[lane];
    const float pr = __shfl_xor(y, 32);
    const f32x2 cs = rope_row[lane & 31];
    const float o = (lane < 32) ? (y * cs.x - pr * cs.y) : (pr * cs.y + y * cs.x);
    p[lane] = (bf16)f2bf(o * scale);
}
__device__ __forceinline__ void nsa_prep_token(const Ctx& C, int l, int t) {
    const float* gn = C.in(11) + (size_t)l * 4 * 64;
    const f32x2* rr = (const f32x2*)(C.ws + WS_ROPE) + (size_t)(t & (SEQ - 1)) * 32;
    bf16* q = (bf16*)(C.ws + WS_QB) + (size_t)t * 512;
#pragma unroll 1
    for (int hh = 0; hh < 8; ++hh) nsa_norm_rope_row(q + hh * 64, gn, rr, 0.125f, C.lane);
    bf16* ks = (bf16*)(C.ws + WS_KVS) + (size_t)t * 256; bf16* kw = (bf16*)(C.ws + WS_KVW) + (size_t)t * 256;
#pragma unroll 1
    for (int g = 0; g < 2; ++g) { nsa_norm_rope_row(ks + g * 64, gn + 128, rr, 1.0f, C.lane); nsa_norm_rope_row(kw + g * 64, gn + 192, rr, 1.0f, C.lane); }
}
__device__ __forceinline__ void nsa_vtrans_item(const Ctx& C, int item) {
    const int which = item >> 10, bg = (item >> 8) & 3, blk = item & 255, b = bg >> 1, g = bg & 1;
    const bf16* src = (const bf16*)(C.ws + (which ? WS_KVW : WS_KVS)) + (size_t)(b * SEQ + blk * 64 + C.lane) * 256 + 128 + g * 64;
    bf16* dst = (bf16*)(C.ws + (which ? WS_VWT : WS_VST)) + (size_t)(bg * 256 + blk) * 4096 + C.lane;
    v4u w[8];
#pragma unroll
    for (int k = 0; k < 8; ++k) w[k] = ((const v4u*)src)[k];
#pragma unroll
    for (int k = 0; k < 8; ++k)
#pragma unroll
        for (int e = 0; e < 4; ++e) { const unsigned x = w[k][e]; dst[(size_t)(8 * k + 2 * e) * 64] = (bf16)(x & 0xffffu); dst[(size_t)(8 * k + 2 * e + 1) * 64] = (bf16)(x >> 16); }
}
__device__ __forceinline__ void nsa_cmp1_item(const Ctx& C, int item) {
    const int kv = item >> 10, rt = (item >> 2) & 255, ng = item & 3;
    const int fr = C.lane & 15, q = C.lane >> 4;
    const int ri = rt * 16 + fr, b = ri >> 11, g = (ri >> 10) & 1, c = ri & 1023, cc = c < 1023 ? c : 1022;
    const bf16* arow = (const bf16*)(C.ws + WS_KVC) + (size_t)(b * SEQ + 16 * cc) * 256 + kv * 128 + g * 64 + 8 * q;
    const bf16* brow = (const bf16*)(C.ws + WS_CW1) + (size_t)kv * 256 * 2048 + (size_t)(ng * 64 + fr) * 2048 + 8 * q;
    f32x4 acc[4];
#pragma unroll
    for (int nt = 0; nt < 4; ++nt) acc[nt] = (f32x4){0.f, 0.f, 0.f, 0.f};
#pragma unroll 4
    for (int kk = 0; kk < 64; ++kk) {
        const bf16x8 a = *(const bf16x8*)(arow + (kk >> 1) * 256 + (kk & 1) * 32);
#pragma unroll
        for (int nt = 0; nt < 4; ++nt) { const bf16x8 bv = *(const bf16x8*)(brow + (size_t)nt * 16 * 2048 + kk * 32); acc[nt] = __builtin_amdgcn_mfma_f32_16x16x32_bf16(a, bv, acc[nt], 0, 0, 0); }
    }
    const float* cb1 = (const float*)(C.ws + WS_VEC) + VEC_CB1 + kv * 256;
    bf16* H1 = (bf16*)(C.ws + WS_CMPH) + (size_t)kv * 4096 * 256;
#pragma unroll
    for (int nt = 0; nt < 4; ++nt) { const int n = ng * 64 + nt * 16 + fr; const float bia = cb1[n];
#pragma unroll
        for (int r = 0; r < 4; ++r) H1[(size_t)(rt * 16 + 4 * q + r) * 256 + n] = (bf16)f2bf(gelu_tanh(acc[nt][r] + bia)); }
}
__device__ __forceinline__ void nsa_cmp2_item(const Ctx& C, int l, int item) {
    const int kv = item >> 8, rt = item & 255;
    const int fr = C.lane & 15, q = C.lane >> 4;
    const bf16* H1 = (const bf16*)(C.ws + WS_CMPH) + (size_t)kv * 4096 * 256 + (size_t)rt * 16 * 256;
    const bf16* W2 = (const bf16*)(C.ws + WS_CW2) + (size_t)kv * 64 * 256;
    f32x4 acc[4];
#pragma unroll
    for (int nt = 0; nt < 4; ++nt) { acc[nt] = (f32x4){0.f, 0.f, 0.f, 0.f}; acc[nt] = mma_tile<8>(H1, 256, W2 + nt * 16 * 256, 256, acc[nt], C.lane); }
    if (kv == 0) {
        const float* gn = C.in(11) + (size_t)l * 4 * 64 + 64;
        bf16* KC = (bf16*)(C.ws + WS_KCMP);
#pragma unroll
        for (int r = 0; r < 4; ++r) {
            float ss = 0.f;
#pragma unroll
            for (int nt = 0; nt < 4; ++nt) ss += acc[nt][r] * acc[nt][r];
            ss += __shfl_xor(ss, 1); ss += __shfl_xor(ss, 2); ss += __shfl_xor(ss, 4); ss += __shfl_xor(ss, 8);
            const float rinv = 1.0f / sqrtf(ss * (1.0f / 64.0f) + RMS_EPS);
            float y[4];
#pragma unroll
            for (int nt = 0; nt < 4; ++nt) y[nt] = acc[nt][r] * rinv * gn[nt * 16 + fr];
            const int ri = rt * 16 + 4 * q + r, c = ri & 1023; int pos = 16 * c + 31; pos = pos < SEQ ? pos : SEQ - 1;
            const f32x2* rr = (const f32x2*)(C.ws + WS_ROPE) + (size_t)pos * 32;
            const f32x2 c0 = rr[fr], c1 = rr[16 + fr];
            bf16* o = KC + (size_t)ri * 64;
            o[fr] = (bf16)f2bf(y[0] * c0.x - y[2] * c0.y); o[16 + fr] = (bf16)f2bf(y[1] * c1.x - y[3] * c1.y);
            o[32 + fr] = (bf16)f2bf(y[0] * c0.y + y[2] * c0.x); o[48 + fr] = (bf16)f2bf(y[1] * c1.y + y[3] * c1.x);
        }
    } else {
        bf16* VCT = (bf16*)(C.ws + WS_VCT);
        const int ri0 = rt * 16, bg = ri0 >> 10, c0 = (ri0 & 1023) + 4 * q;
#pragma unroll
        for (int nt = 0; nt < 4; ++nt) { const int d = nt * 16 + fr;
            *(v2u*)(VCT + (size_t)(bg * 64 + d) * 1024 + c0) = (v2u){pk2(acc[nt][0], acc[nt][1]), pk2(acc[nt][2], acc[nt][3])}; }
    }
}

constexpr int NU_IMP = 0;
constexpr int NU_SEL = 65536;
constexpr int NU_UM = 67584;
constexpr int NU_KV = 67840;
constexpr int NU_END = NU_KV + 2 * 18432;

struct AttnState { float m, l; f32x4 o[4]; };
constexpr int NCT = 1, NQ = 32 * NCT;

__device__ __forceinline__ void nsa_stage(const Ctx& C, int buf, const bf16* krows, int kld, const bf16* vt_tile, int vld) {
    LAS bf16* KT = (LAS bf16*)(C.lds + NU_KV + buf * 18432); LAS bf16* VT = KT + 64 * 72;
    const int r = C.tid >> 3, ch = C.tid & 7;
    const v4u kx = *(const v4u*)(krows + (size_t)r * kld + ch * 8);
    const v4u vx = *(const v4u*)(vt_tile + (size_t)r * vld + ch * 8);
    *(LAS v4u*)(KT + r * 72 + ch * 8) = kx;
    *(LAS v4u*)(VT + r * 72 + ch * 8) = vx;
}
__device__ __forceinline__ void nsa_scores(const Ctx& C, int buf, const bf16x8 (&qf)[2], f32x4 (&s)[4]) {
    const LAS bf16* KT = (const LAS bf16*)(C.lds + NU_KV + buf * 18432);
    const int fr = C.lane & 15, q = C.lane >> 4;
#pragma unroll
    for (int kt = 0; kt < 4; ++kt) { s[kt] = (f32x4){0.f, 0.f, 0.f, 0.f};
#pragma unroll
        for (int ks = 0; ks < 2; ++ks) { const bf16x8 a = *(const LAS bf16x8*)(KT + (16 * kt + fr) * 72 + ks * 32 + 8 * q); s[kt] = __builtin_amdgcn_mfma_f32_16x16x32_bf16(a, qf[ks], s[kt], 0, 0, 0); } }
}
__device__ __forceinline__ void nsa_pv(const Ctx& C, int buf, const f32x4 (&p)[4], f32x4 (&o)[4]) {
    const LAS bf16* VT = (const LAS bf16*)(C.lds + NU_KV + buf * 18432) + 64 * 72;
    const int fr = C.lane & 15, q = C.lane >> 4;
    bf16x8 pf[2];
#pragma unroll
    for (int k2 = 0; k2 < 2; ++k2) { v4u w; w.x = pk2(p[2 * k2][0], p[2 * k2][1]); w.y = pk2(p[2 * k2][2], p[2 * k2][3]); w.z = pk2(p[2 * k2 + 1][0], p[2 * k2 + 1][1]); w.w = pk2(p[2 * k2 + 1][2], p[2 * k2 + 1][3]);
        pf[k2] = __builtin_bit_cast(bf16x8, w); }
#pragma unroll
    for (int dt = 0; dt < 4; ++dt)
#pragma unroll
        for (int k2 = 0; k2 < 2; ++k2) {
            const LAS bf16* vr = VT + (16 * dt + fr) * 72 + 32 * k2 + 4 * q;
            const v2u lo = *(const LAS v2u*)vr, hi = *(const LAS v2u*)(vr + 16);
            const v4u aw = (v4u){lo.x, lo.y, hi.x, hi.y};
            o[dt] = __builtin_amdgcn_mfma_f32_16x16x32_bf16(__builtin_bit_cast(bf16x8, aw), pf[k2], o[dt], 0, 0, 0);
        }
}
__device__ __forceinline__ void nsa_online(const Ctx& C, int buf, f32x4 (&s)[4], AttnState& st) {
    float mx = -INFINITY;
#pragma unroll
    for (int kt = 0; kt < 4; ++kt)
#pragma unroll
        for (int r = 0; r < 4; ++r) mx = fmaxf(mx, s[kt][r]);
    mx = fmaxf(mx, __shfl_xor(mx, 16)); mx = fmaxf(mx, __shfl_xor(mx, 32));
    const float mn = fmaxf(st.m, mx);
    const float msafe = (mn == -INFINITY) ? 0.f : mn;
    const float alpha = fexp(st.m - msafe);
    float ps = 0.f;
#pragma unroll
    for (int kt = 0; kt < 4; ++kt)
#pragma unroll
        for (int r = 0; r < 4; ++r) { const float p = fexp(s[kt][r] - msafe); s[kt][r] = p; ps += p; }
    st.l = st.l * alpha + ps; st.m = mn;
#pragma unroll
    for (int dt = 0; dt < 4; ++dt) st.o[dt] *= alpha;
    nsa_pv(C, buf, s, st.o);
}

__device__ __forceinline__ void nsa_attn_unit(const Ctx& C, int u) {
    const int half = u & 1, uu = u >> 1;
    const int bg = uu & 3, b = bg >> 1, g = bg & 1;
    int qb; { const int rnd = uu >> 8, j = (uu >> 2) & 63; qb = rnd == 0 ? 255 - j : rnd == 1 ? 128 + j : rnd == 2 ? 127 - j : j; }
    const int q0 = 32 * half;
    const int t0 = b * SEQ + qb * 64;
    const int fr = C.lane & 15, q = C.lane >> 4, qq = fr >> 2, hh = fr & 3;
    LAS float* IMP = (LAS float*)(C.lds + NU_IMP);
    LAS unsigned long long* SEL = (LAS unsigned long long*)(C.lds + NU_SEL);
    LAS unsigned long long* UM = (LAS unsigned long long*)(C.lds + NU_UM);
    for (int i = C.tid; i < NQ * 256; i += NTHR) IMP[i] = 0.f;
    bf16* QB = (bf16*)(C.ws + WS_QB);
    bf16x8 qf[NCT][2]; float gate[NCT][3]; int iq[NCT];
#pragma unroll
    for (int ct = 0; ct < NCT; ++ct) { iq[ct] = q0 + 4 * NCT * C.wave + 4 * ct + qq;
        const bf16* qp = QB + (size_t)(t0 + iq[ct]) * 512 + (g * 4 + hh) * 64 + 8 * q;
        qf[ct][0] = *(const bf16x8*)qp; qf[ct][1] = *(const bf16x8*)(qp + 32);
        const float* sm = (const float*)(C.ws + WS_SMALL) + (size_t)(t0 + iq[ct]) * 64 + 16 + (g * 4 + hh) * 3;
#pragma unroll
        for (int k = 0; k < 3; ++k) gate[ct][k] = ((ABL_ZERO & 2) || (ABL_ZERO & (8 << k))) ? 0.f : SCL_B * sigmoidf_(sm[k]); }
    f32x4 out[NCT][4];
#pragma unroll
    for (int ct = 0; ct < NCT; ++ct)
#pragma unroll
        for (int dt = 0; dt < 4; ++dt) out[ct][dt] = (f32x4){0.f, 0.f, 0.f, 0.f};

    const bf16* KC = (const bf16*)(C.ws + WS_KCMP) + (size_t)bg * 1024 * 64;
    const bf16* VCT = (const bf16*)(C.ws + WS_VCT) + (size_t)bg * 64 * 1024;
    const int nct = (4 * qb + 3 + 63) >> 6;
    int cmax[NCT];
#pragma unroll
    for (int ct = 0; ct < NCT; ++ct) cmax[ct] = (64 * qb + iq[ct] - 31) >> 4;
    float cm[NCT], cl[NCT];
#pragma unroll
    for (int ct = 0; ct < NCT; ++ct) { cm[ct] = -INFINITY; cl[ct] = 0.f; }
    __syncthreads();
    for (int pass = 0; pass < 2; ++pass) {
        float cinv[NCT];
        if (pass == 1) {
#pragma unroll
            for (int ct = 0; ct < NCT; ++ct) { float lt = cl[ct]; lt += __shfl_xor(lt, 16); lt += __shfl_xor(lt, 32); cinv[ct] = lt > 0.f ? 1.0f / lt : 0.f; if (cm[ct] == -INFINITY) cm[ct] = 0.f; }
        }
        AttnState ac[NCT];
#pragma unroll
        for (int ct = 0; ct < NCT; ++ct) { ac[ct].m = 0.f; ac[ct].l = 0.f;
#pragma unroll
            for (int dt = 0; dt < 4; ++dt) ac[ct].o[dt] = (f32x4){0.f, 0.f, 0.f, 0.f}; }
        for (int tl = 0; tl < nct; ++tl) {
            const int buf = tl & 1;
            nsa_stage(C, buf, KC + (size_t)tl * 64 * 64, 64, VCT + tl * 64, 1024);
            __syncthreads();
#pragma unroll
            for (int ct = 0; ct < NCT; ++ct) {
                f32x4 s[4]; nsa_scores(C, buf, qf[ct], s);
#pragma unroll
                for (int kt = 0; kt < 4; ++kt)
#pragma unroll
                    for (int r = 0; r < 4; ++r) { const int c = 64 * tl + 16 * kt + 4 * q + r; if (c > cmax[ct]) s[kt][r] = -INFINITY; }
                if (pass == 0) {
                    float mx = -INFINITY;
#pragma unroll
                    for (int kt = 0; kt < 4; ++kt)
#pragma unroll
                        for (int r = 0; r < 4; ++r) mx = fmaxf(mx, s[kt][r]);
                    mx = fmaxf(mx, __shfl_xor(mx, 16)); mx = fmaxf(mx, __shfl_xor(mx, 32));
                    const float mn = fmaxf(cm[ct], mx); const float msafe = (mn == -INFINITY) ? 0.f : mn;
                    float ps = 0.f;
#pragma unroll
                    for (int kt = 0; kt < 4; ++kt)
#pragma unroll
                        for (int r = 0; r < 4; ++r) ps += fexp(s[kt][r] - msafe);
                    cl[ct] = cl[ct] * fexp(cm[ct] - msafe) + ps; cm[ct] = mn;
                } else {
#pragma unroll
                    for (int kt = 0; kt < 4; ++kt) {
#pragma unroll
                        for (int r = 0; r < 4; ++r) s[kt][r] = fexp(s[kt][r] - cm[ct]) * cinv[ct];
                        float gs = (s[kt][0] + s[kt][1]) + (s[kt][2] + s[kt][3]), es = s[kt][3];
                        gs += __shfl_xor(gs, 1); gs += __shfl_xor(gs, 2); es += __shfl_xor(es, 1); es += __shfl_xor(es, 2);
                        if (hh == 0) { const int n = 16 * tl + 4 * kt + q;
                            if (n < 256) { atomicAdd((float*)(IMP + (iq[ct] - q0) * 256 + n), gs); if (n + 1 < 256) atomicAdd((float*)(IMP + (iq[ct] - q0) * 256 + n + 1), es); } }
                    }
                    nsa_pv(C, buf, s, ac[ct].o);
                }
            }
        }
        if (pass == 1) {
#pragma unroll
            for (int ct = 0; ct < NCT; ++ct)
#pragma unroll
                for (int dt = 0; dt < 4; ++dt) out[ct][dt] += ac[ct].o[dt] * gate[ct][0];
        }
        __syncthreads();
    }

    for (int k8 = 0; k8 < 4 * NCT; ++k8) {
        const int i = 4 * NCT * C.wave + k8;
        float v[4]; unsigned long long selw[4] = {0ull, 0ull, 0ull, 0ull};
        int ncand = 0;
#pragma unroll
        for (int k = 0; k < 4; ++k) { const int n = C.lane + 64 * k; const bool valid = n <= qb; const bool forced = valid && (n == 0 || n == qb || n == qb - 1);
            v[k] = (valid && !forced) ? IMP[i * 256 + n] : -INFINITY;
            selw[k] = __ballot(forced); }
        const int nforced = qb >= 2 ? 3 : qb + 1; ncand = qb + 1 - nforced;
        int need = 16 - nforced; if (need > ncand) need = ncand;
        if (need == ncand) {
#pragma unroll
            for (int k = 0; k < 4; ++k) selw[k] |= __ballot(v[k] != -INFINITY);
        } else {
            for (int it = 0; it < need; ++it) {
                float bv = v[0]; int bn = C.lane;
#pragma unroll
                for (int k = 1; k < 4; ++k) if (v[k] > bv) { bv = v[k]; bn = C.lane + 64 * k; }
#pragma unroll
                for (int o = 1; o < 64; o <<= 1) { const float ov = __shfl_xor(bv, o); const int on = __shfl_xor(bn, o); if (ov > bv || (ov == bv && on < bn)) { bv = ov; bn = on; } }
#pragma unroll
                for (int k = 0; k < 4; ++k) { if (bn == C.lane + 64 * k) v[k] = -INFINITY; if ((bn >> 6) == k) selw[k] |= 1ull << (bn & 63); }
            }
        }
        if (C.lane < 4) SEL[i * 4 + C.lane] = C.lane == 0 ? selw[0] : C.lane == 1 ? selw[1] : C.lane == 2 ? selw[2] : selw[3];
    }
    __syncthreads();
    if (C.tid < 4) { unsigned long long um = 0ull; for (int i = 0; i < NQ; ++i) um |= SEL[i * 4 + C.tid]; UM[C.tid] = um; }
    __syncthreads();

    {
        AttnState as[NCT];
#pragma unroll
        for (int ct = 0; ct < NCT; ++ct) { as[ct].m = -INFINITY; as[ct].l = 0.f;
#pragma unroll
            for (int dt = 0; dt < 4; ++dt) as[ct].o[dt] = (f32x4){0.f, 0.f, 0.f, 0.f}; }
        const bf16* KS = (const bf16*)(C.ws + WS_KVS) + (size_t)(b * SEQ) * 256 + g * 64;
        const bf16* VST = (const bf16*)(C.ws + WS_VST) + (size_t)bg * 256 * 4096;
        int buf = 0;
        for (int n = 0; n <= qb; ++n) {
            if (!((UM[n >> 6] >> (n & 63)) & 1ull)) continue;
            nsa_stage(C, buf, KS + (size_t)n * 64 * 256, 256, VST + (size_t)n * 4096, 64);
            __syncthreads();
#pragma unroll
            for (int ct = 0; ct < NCT; ++ct) {
                const bool mysel = (SEL[(iq[ct] - q0) * 4 + (n >> 6)] >> (n & 63)) & 1ull;
                if (__ballot(mysel) == 0ull) continue;
                f32x4 s[4]; nsa_scores(C, buf, qf[ct], s);
#pragma unroll
                for (int kt = 0; kt < 4; ++kt)
#pragma unroll
                    for (int r = 0; r < 4; ++r) { const int key = 16 * kt + 4 * q + r; if (!mysel || (n == qb && key > iq[ct])) s[kt][r] = -INFINITY; }
                nsa_online(C, buf, s, as[ct]);
            }
            buf ^= 1;
        }
#pragma unroll
        for (int ct = 0; ct < NCT; ++ct) { float lt = as[ct].l; lt += __shfl_xor(lt, 16); lt += __shfl_xor(lt, 32); const float inv = lt > 0.f ? gate[ct][1] / lt : 0.f;
#pragma unroll
            for (int dt = 0; dt < 4; ++dt) out[ct][dt] += as[ct].o[dt] * inv; }
        __syncthreads();
    }
    {
        AttnState aw[NCT];
#pragma unroll
        for (int ct = 0; ct < NCT; ++ct) { aw[ct].m = -INFINITY; aw[ct].l = 0.f;
#pragma unroll
            for (int dt = 0; dt < 4; ++dt) aw[ct].o[dt] = (f32x4){0.f, 0.f, 0.f, 0.f}; }
        const bf16* KW = (const bf16*)(C.ws + WS_KVW) + (size_t)(b * SEQ) * 256 + g * 64;
        const bf16* VWT = (const bf16*)(C.ws + WS_VWT) + (size_t)bg * 256 * 4096;
        int buf = 0;
        for (int n = (qb >= 8 ? qb - 8 : 0); n <= qb; ++n) {
            const int delta = qb - n;
            nsa_stage(C, buf, KW + (size_t)n * 64 * 256, 256, VWT + (size_t)n * 4096, 64);
            __syncthreads();
#pragma unroll
            for (int ct = 0; ct < NCT; ++ct) {
                f32x4 s[4]; nsa_scores(C, buf, qf[ct], s);
                if (delta == 0 || delta == 8) {
#pragma unroll
                    for (int kt = 0; kt < 4; ++kt)
#pragma unroll
                        for (int r = 0; r < 4; ++r) { const int key = 16 * kt + 4 * q + r; const bool ok = delta == 0 ? (key <= iq[ct]) : (key > iq[ct]); if (!ok) s[kt][r] = -INFINITY; }
                }
                nsa_online(C, buf, s, aw[ct]);
            }
            buf ^= 1;
        }
#pragma unroll
        for (int ct = 0; ct < NCT; ++ct) { float lt = aw[ct].l; lt += __shfl_xor(lt, 16); lt += __shfl_xor(lt, 32); const float inv = lt > 0.f ? gate[ct][2] / lt : 0.f;
#pragma unroll
            for (int dt = 0; dt < 4; ++dt) out[ct][dt] += aw[ct].o[dt] * inv; }
    }
#pragma unroll
    for (int ct = 0; ct < NCT; ++ct) { bf16* op = QB + (size_t)(t0 + iq[ct]) * 512 + (g * 4 + hh) * 64 + 4 * q;
#pragma unroll
        for (int dt = 0; dt < 4; ++dt) *(v2u*)(op + 16 * dt) = (v2u){pk2(out[ct][dt][0], out[ct][dt][1]), pk2(out[ct][dt][2], out[ct][dt][3])}; }
    __syncthreads();
}

#ifndef NAIVE_GLA
#define NAIVE_GLA 0
#endif
#ifndef NAIVE_MLSTM
#define NAIVE_MLSTM 0
#endif
__device__ __forceinline__ void naive_gla(const Ctx& C, int l, int bh) {
    const int bb = bh >> 2, h = bh & 3, dk = C.lane, g = C.wave;
    LAS float* SS = (LAS float*)(C.lds);
    const bf16* QKA = (const bf16*)(C.ws + WS_QKA); const bf16* VA = (const bf16*)(C.ws + WS_VA); bf16* RA = (bf16*)(C.ws + WS_RA);
    const float* SMALL = (const float*)(C.ws + WS_SMALL);
    float w[16]; const float* wa = C.in(8) + (size_t)l * 16 * 256 + h * 64 + dk;
    for (int r = 0; r < 16; ++r) w[r] = wa[r * 256];
    const float ba = C.in(9)[(size_t)l * 256 + h * 64 + dk];
    const float* gn = C.in(10) + (size_t)l * 128 + 16 * g;
    float S[16];
    for (int e = 0; e < 16; ++e) S[e] = 0.f;
    for (int s = 0; s < SEQ; ++s) {
        const size_t t = (size_t)bb * SEQ + s;
        float x = ba;
        for (int r = 0; r < 16; ++r) x += SMALL[t * 64 + r] * w[r];
        const float al = __expf(logsigmoidf_(x) * (1.0f / 16.0f));
        const float q = bf2f(QKA[t * 512 + h * 64 + dk]) * 0.125f, k = bf2f(QKA[t * 512 + 256 + h * 64 + dk]);
        float o[16]; float ss = 0.f;
        for (int e = 0; e < 16; ++e) { const float v = bf2f(VA[t * 512 + h * 128 + 16 * g + e]); S[e] = al * S[e] + k * v; o[e] = wave_sum(q * S[e]); ss += o[e] * o[e]; }
        if (C.lane == 0) SS[(s & 1) * 8 + g] = ss;
        __syncthreads();
        float tot = 0.f;
        for (int w8 = 0; w8 < 8; ++w8) tot += SS[(s & 1) * 8 + w8];
        const float rinv = 1.0f / sqrtf(tot * (1.0f / 128.0f) + RMS_EPS);
        float mine = 0.f;
        for (int e = 0; e < 16; ++e) if (C.lane == e) mine = o[e];
        if (C.lane < 16) { bf16* p = RA + t * 512 + h * 128 + 16 * g + C.lane; const float r = bf2f(*p); *p = (bf16)f2bf(mine * rinv * gn[C.lane] * siluf_(r)); }
    }
    __syncthreads();
}
__device__ __forceinline__ void naive_mlstm(const Ctx& C, int l, int bh) {
    const int bb = bh >> 2, h = bh & 3, dk = C.lane, g = C.wave;
    const bf16* X = (const bf16*)(C.ws + WS_QKC); const bf16* VC = (const bf16*)(C.ws + WS_VC); bf16* OC = (bf16*)(C.ws + WS_OC);
    const float* SMALL = (const float*)(C.ws + WS_SMALL);
    const int chq = h * 64 + dk, chk = 256 + h * 64 + dk;
    const float* cw = C.in(15) + (size_t)l * 4 * 512; const float* cb = C.in(16) + (size_t)l * 512;
    float wq[4], wk[4];
    for (int i = 0; i < 4; ++i) { wq[i] = cw[i * 512 + chq]; wk[i] = cw[i * 512 + chk]; }
    const float bq = cb[chq], bk = cb[chk];
    float Cm[16]; for (int e = 0; e < 16; ++e) Cm[e] = 0.f;
    float n = 0.f, m = 0.f;
    float xq[4] = {0.f, 0.f, 0.f, 0.f}, xk[4] = {0.f, 0.f, 0.f, 0.f};
    for (int s = 0; s < SEQ; ++s) {
        const size_t t = (size_t)bb * SEQ + s;
        xq[0] = xq[1]; xq[1] = xq[2]; xq[2] = xq[3]; xq[3] = bf2f(X[t * 512 + chq]);
        xk[0] = xk[1]; xk[1] = xk[2]; xk[2] = xk[3]; xk[3] = bf2f(X[t * 512 + chk]);
        const float q = siluf_(bq + wq[0] * xq[0] + wq[1] * xq[1] + wq[2] * xq[2] + wq[3] * xq[3]);
        const float k = siluf_(bk + wk[0] * xk[0] + wk[1] * xk[1] + wk[2] * xk[2] + wk[3] * xk[3]) * 0.125f;
        const float ip = SMALL[t * 64 + 40 + h], lf = logsigmoidf_(SMALL[t * 64 + 44 + h]);
        const float mn = fmaxf(lf + m, ip);
        const float fd = __expf(lf + m - mn), ig = __expf(ip - mn);
        n = fd * n + ig * k;
        const float den = wave_sum(q * n);
        const float dinv = 1.0f / fmaxf(fabsf(den), __expf(-mn));
        float mine = 0.f;
        for (int e = 0; e < 16; ++e) { const float v = bf2f(VC[t * 512 + h * 128 + 16 * g + e]); Cm[e] = fd * Cm[e] + ig * k * v; const float num = wave_sum(q * Cm[e]); if (C.lane == e) mine = num; }
        m = mn;
        if (C.lane < 16) { bf16* p = OC + t * 512 + h * 128 + 16 * g + C.lane; const float og = bf2f(*p); *p = (bf16)f2bf(mine * dinv * sigmoidf_(og)); }
    }
}
#ifndef NAIVE_WIN
#define NAIVE_WIN 0
#endif
__device__ __forceinline__ void naive_win_store(const Ctx& C, size_t t, int col, float z) {
    unsigned char* ws = C.ws;
    int c = col;
    if (c < 256) { ((bf16*)(ws + WS_QKA))[t * 512 + c] = (bf16)f2bf(z); return; } c -= 256;
    if (c < 256) { ((bf16*)(ws + WS_QKA))[t * 512 + 256 + c] = (bf16)f2bf(z); return; } c -= 256;
    if (c < 512) { ((bf16*)(ws + WS_VA))[t * 512 + c] = (bf16)f2bf(z); return; } c -= 512;
    if (c < 512) { ((bf16*)(ws + WS_RA))[t * 512 + c] = (bf16)f2bf(z); return; } c -= 512;
    if (c < 16) { ((float*)(ws + WS_SMALL))[t * 64 + c] = z; return; } c -= 16;
    if (c < 512) { ((bf16*)(ws + WS_QB))[t * 512 + c] = (bf16)f2bf(z); return; } c -= 512;
    if (c < 128) { ((bf16*)(ws + WS_KVC))[t * 256 + c] = (bf16)f2bf(z); return; } c -= 128;
    if (c < 128) { ((bf16*)(ws + WS_KVC))[t * 256 + 128 + c] = (bf16)f2bf(z); return; } c -= 128;
    if (c < 128) { ((bf16*)(ws + WS_KVS))[t * 256 + c] = (bf16)f2bf(z); return; } c -= 128;
    if (c < 128) { ((bf16*)(ws + WS_KVS))[t * 256 + 128 + c] = (bf16)f2bf(z); return; } c -= 128;
    if (c < 128) { ((bf16*)(ws + WS_KVW))[t * 256 + c] = (bf16)f2bf(z); return; } c -= 128;
    if (c < 128) { ((bf16*)(ws + WS_KVW))[t * 256 + 128 + c] = (bf16)f2bf(z); return; } c -= 128;
    if (c < 24) { ((float*)(ws + WS_SMALL))[t * 64 + 16 + c] = z; return; } c -= 24;
    if (c < 512) { ((bf16*)(ws + WS_QKC))[t * 512 + c] = (bf16)f2bf(z); return; } c -= 512;
    if (c < 512) { ((bf16*)(ws + WS_VC))[t * 512 + c] = (bf16)f2bf(z); return; } c -= 512;
    if (c < 512) { ((bf16*)(ws + WS_OC))[t * 512 + c] = (bf16)f2bf(z); return; } c -= 512;
    if (c < 4) { ((float*)(ws + WS_SMALL))[t * 64 + 40 + c] = z; return; } c -= 4;
    if (c < 4) { ((float*)(ws + WS_SMALL))[t * 64 + 44 + c] = z; return; }
}
__device__ __forceinline__ void naive_win(const Ctx& C, int l) {
    LAS float* xs = (LAS float*)C.lds;
    const float* gain = C.in(5) + (size_t)l * DM; const float* W = C.in(6) + (size_t)l * DM * N_IN; const float* bin = C.in(7) + (size_t)l * N_IN;
    for (int tile = C.bid; tile < T / 8; tile += C.G) {
        __syncthreads();
        {
            const size_t t = (size_t)tile * 8 + C.wave; const float* xr = C.X + t * DM;
            float v[16]; float s = 0.f;
            for (int j = 0; j < 16; ++j) { v[j] = xr[C.lane + 64 * j]; s += v[j] * v[j]; }
            const float r = 1.0f / sqrtf(wave_sum(s) * (1.f / DM) + RMS_EPS);
            for (int j = 0; j < 16; ++j) xs[C.wave * 1024 + C.lane + 64 * j] = v[j] * r * gain[C.lane + 64 * j];
        }
        __syncthreads();
        for (int col = C.tid; col < 4400; col += NTHR) {
            float acc[8]; for (int i = 0; i < 8; ++i) acc[i] = 0.f;
            for (int k = 0; k < DM; ++k) { const float w = W[(size_t)k * N_IN + col];
                for (int i = 0; i < 8; ++i) acc[i] += xs[i * 1024 + k] * w; }
            const float bb = bin[col];
            for (int i = 0; i < 8; ++i) naive_win_store(C, (size_t)tile * 8 + i, col, acc[i] + bb);
        }
    }
    __syncthreads();
}
#ifndef NAIVE_MERGE
#define NAIVE_MERGE 0
#endif
__device__ __forceinline__ void naive_merge(const Ctx& C, int l) {
    LAS float* xs = (LAS float*)C.lds;
    LAS float* os = xs + 8 * 1024;
    const float* gain = C.in(5) + (size_t)l * DM; const float* W = C.in(6) + (size_t)l * DM * N_IN; const float* bin = C.in(7) + (size_t)l * N_IN;
    const float* WB = C.in(17) + (size_t)l * 3 * 512 * DM;
    bf16* Y = (bf16*)(C.ws + WS_Y);
    for (int tile = C.bid; tile < T / 8; tile += C.G) {
        __syncthreads();
        {
            const size_t t = (size_t)tile * 8 + C.wave; const float* xr = C.X + t * DM;
            float v[16]; float s = 0.f;
            for (int j = 0; j < 16; ++j) { v[j] = xr[C.lane + 64 * j]; s += v[j] * v[j]; }
            const float r = 1.0f / sqrtf(wave_sum(s) * (1.f / DM) + RMS_EPS);
            for (int j = 0; j < 16; ++j) xs[C.wave * 1024 + C.lane + 64 * j] = v[j] * r * gain[C.lane + 64 * j];
            for (int i = 0; i < 3; ++i) { const bf16* src = (const bf16*)(C.ws + (i == 0 ? WS_RA : i == 1 ? WS_QB : WS_OC)) + t * 512;
                for (int j = 0; j < 8; ++j) os[(i * 8 + C.wave) * 512 + C.lane + 64 * j] = bf2f(src[C.lane + 64 * j]); }
        }
        __syncthreads();
        for (int c = C.tid; c < DM; c += NTHR) {
            float y[8]; for (int i = 0; i < 8; ++i) y[i] = 0.f;
            for (int br = 0; br < 3; ++br) {
                float ga[8], pa[8]; for (int i = 0; i < 8; ++i) { ga[i] = 0.f; pa[i] = 0.f; }
                const int gc = 4400 + br * DM + c;
                for (int k = 0; k < DM; ++k) { const float w = W[(size_t)k * N_IN + gc]; for (int i = 0; i < 8; ++i) ga[i] += xs[i * 1024 + k] * w; }
                for (int j = 0; j < 512; ++j) { const float w = WB[((size_t)br * 512 + j) * DM + c]; for (int i = 0; i < 8; ++i) pa[i] += os[(br * 8 + i) * 512 + j] * w; }
                const float bb = bin[gc];
                for (int i = 0; i < 8; ++i) y[i] += sigmoidf_(ga[i] + bb) * pa[i];
            }
            for (int i = 0; i < 8; ++i) Y[((size_t)tile * 8 + i) * DM + c] = (bf16)f2bf(y[i]);
        }
    }
    __syncthreads();
}
__device__ __forceinline__ void naive_gate(const Ctx& C, int l, int br) {
    LAS float* xs = (LAS float*)C.lds;
    const float* gain = C.in(5) + (size_t)l * DM; const float* W = C.in(6) + (size_t)l * DM * N_IN; const float* bin = C.in(7) + (size_t)l * N_IN;
    bf16* G = (bf16*)(C.ws + WS_G);
    for (int tile = C.bid; tile < T / 8; tile += C.G) {
        __syncthreads();
        {
            const size_t t = (size_t)tile * 8 + C.wave; const float* xr = C.X + t * DM;
            float v[16]; float s = 0.f;
            for (int j = 0; j < 16; ++j) { v[j] = xr[C.lane + 64 * j]; s += v[j] * v[j]; }
            const float r = 1.0f / sqrtf(wave_sum(s) * (1.f / DM) + RMS_EPS);
            for (int j = 0; j < 16; ++j) xs[C.wave * 1024 + C.lane + 64 * j] = v[j] * r * gain[C.lane + 64 * j];
            if (NAIVE_MERGE == 4) { const bf16* xn = (const bf16*)(C.ws + WS_XN) + t * DM; for (int j = 0; j < 16; ++j) xs[C.wave * 1024 + C.lane + 64 * j] = bf2f(xn[C.lane + 64 * j]); }
        }
        __syncthreads();
        for (int c = C.tid; c < DM; c += NTHR) {
            float ga[8]; for (int i = 0; i < 8; ++i) ga[i] = 0.f;
            const int gc = 4400 + br * DM + c;
            const bf16* WGTb = (const bf16*)(C.ws + WS_WGT) + ((size_t)br * DM + c) * DM;
            for (int k = 0; k < DM; ++k) { const float w = (NAIVE_MERGE >= 3) ? bf2f(WGTb[k]) : W[(size_t)k * N_IN + gc]; for (int i = 0; i < 8; ++i) ga[i] += xs[i * 1024 + k] * w; }
            const float bb = bin[gc];
            for (int i = 0; i < 8; ++i) G[((size_t)tile * 8 + i) * DM + c] = (bf16)f2bf(sigmoidf_(ga[i] + bb));
        }
    }
    __syncthreads();
}

__device__ __forceinline__ void phase_mix1(const Ctx& C, int l) {
    const int gw = C.bid * NWAVES + C.wave, NGW = C.G * NWAVES;
    for (int it = gw; it < 2048; it += NGW) nsa_cmp1_item(C, it);
    for (int it = gw; it < 2048; it += NGW) nsa_vtrans_item(C, it);
    for (int t = gw; t < T; t += NGW) nsa_prep_token(C, l, t);
    __syncthreads();
    for (int u = C.bid; u < 4096; u += C.G) { if (u < 2048) { if (!NAIVE_GLA) gla_unit_a(C, l, u); } else { if (!NAIVE_MLSTM) mlstm_unit_a(C, l, u - 2048); } }
}
__device__ __forceinline__ void phase_mix2(const Ctx& C, int l) {
    const int gw = C.bid * NWAVES + C.wave, NGW = C.G * NWAVES;
    for (int it = gw; it < 512; it += NGW) nsa_cmp2_item(C, l, it);
    phase_scan(C);
}
__device__ __forceinline__ void phase_mix3(const Ctx& C, int l) {
    for (int u = C.bid; u < 2048; u += C.G) nsa_attn_unit(C, u);
    for (int u = C.bid; u < 4096; u += C.G) { if (u < 2048) { if (!NAIVE_GLA) gla_unit_c(C, l, u); } else { if (!NAIVE_MLSTM) mlstm_unit_c(C, l, u - 2048); } }
    if (NAIVE_GLA && C.bid < 8) naive_gla(C, l, C.bid);
    if (NAIVE_MLSTM && C.bid >= 8 && C.bid < 16) naive_mlstm(C, l, C.bid - 8);
}

constexpr int MIX_PHASES = 12;
#define MIXER_PHASES \
    if (PH_ON) phase_norm(C, C.in(5) + (size_t)l * DM); \
    PH_END; \
    if (PH_ON) { \
        pg8::Gemm g{(const bf16*)(C.ws + WS_XN), (const bf16*)(C.ws + WS_WIN), T, 4608, DM}; \
        pg8::StaticOrder S; S.init(T, 4608, C.G, C.bid); \
        pg8::EpiWin E{C.ws + WS_R, (const float*)(C.ws + WS_VEC) + VEC_BINP, (float*)(C.ws + WS_SMALL)}; \
        pg8::gemm_phase<pg8::EpiWin, pg8::StaticOrder, false>(C.lds, g, S, E, nullptr); \
        if (NAIVE_WIN) { __syncthreads(); naive_win(C, l); } \
    } \
    PH_END; \
    if (PH_ON) phase_mix1(C, l); \
    PH_END; \
    if (PH_ON) phase_mix2(C, l); \
    PH_END; \
    if (PH_ON) phase_mix3(C, l); \
    PH_END; \
    for (int br = 0; br < 3; ++br) { \
        if (PH_ON) { \
            pg8::Gemm g{(const bf16*)(C.ws + WS_XN), (const bf16*)(C.ws + WS_WGT) + (size_t)br * DM * DM, T, DM, DM}; \
            pg8::StaticOrder S; S.init(T, DM, C.G, C.bid); \
            pg8::EpiGate E{(bf16*)(C.ws + WS_G), DM, C.in(7) + (size_t)l * N_IN + 4400 + br * DM}; \
            pg8::gemm_phase<pg8::EpiGate, pg8::StaticOrder, false>(C.lds, g, S, E, nullptr); \
            if (NAIVE_MERGE >= 2) { __syncthreads(); naive_gate(C, l, br); } \
        } \
        PH_END; \
        if (PH_ON) { \
            const bf16* Asrc = (const bf16*)(C.ws + (br == 0 ? WS_RA : br == 1 ? WS_QB : WS_OC)); \
            pg8::Gemm g{Asrc, (const bf16*)(C.ws + WS_WBR) + (size_t)br * DM * 512, T, DM, 512}; \
            pg8::StaticOrder S; S.init(T, DM, C.G, C.bid); \
            pg8::EpiBranch E{(bf16*)(C.ws + WS_Y), (const bf16*)(C.ws + WS_G), DM, br == 0 ? 1 : 0}; \
            pg8::gemm_phase<pg8::EpiBranch, pg8::StaticOrder, false>(C.lds, g, S, E, nullptr); \
            if (NAIVE_MERGE == 1 && br == 2) { __syncthreads(); naive_merge(C, l); } \
        } \
        PH_END; \
    } \
    if (PH_ON) { \
        pg8::Gemm g{(const bf16*)(C.ws + WS_Y), (const bf16*)(C.ws + WS_WOUT), T, DM, DM}; \
        pg8::StaticOrder S; S.init(T, DM, C.G, C.bid); \
        pg8::EpiResid E{C.X, DM, 1.0f}; \
        pg8::gemm_phase<pg8::EpiResid, pg8::StaticOrder, false>(C.lds, g, S, E, nullptr); \
    } \
    PH_END;

constexpr int N_PHASES = 1 + 8 * 3 + 4 * MIX_PHASES;

__global__ void __launch_bounds__(NTHR, 2) hybrid_fwd(Args args) {
    extern __shared__ __attribute__((aligned(16))) unsigned char lds_raw[];
    Ctx C;
    C.lds = (LAS unsigned char*)lds_raw;
    C.tid = threadIdx.x; C.lane = C.tid & 63; C.wave = __builtin_amdgcn_readfirstlane(C.tid >> 6);
    C.G = gridDim.x; C.bid = blockIdx.x;
    C.inp = (const GAS float* const __attribute__((address_space(4)))*)__builtin_amdgcn_kernarg_segment_ptr();
    C.X = args.out; C.ws = args.ws;
    volatile LAS unsigned* MISC = (volatile LAS unsigned*)(C.lds + MISC_OFF);
    for (int u = C.tid; u < (LDS_BYTES - RING_BYTES) / 4; u += NTHR) ((LAS unsigned*)(C.lds + RING_BYTES))[u] = 0u;
    __syncthreads();
    __builtin_amdgcn_fence(__ATOMIC_ACQUIRE, "agent"); asm volatile("s_waitcnt vmcnt(0)" ::: "memory");
    __syncthreads();
    const int lo = args.ph_lo, hi = args.ph_hi;
    XcdBarrier bar; bar.bar = (unsigned*)(C.ws + WS_CTL) + 4096; bar.x = 0; bar.st = nullptr;
    if (hi - lo > 1) bar = xcd_barrier_post((unsigned*)(C.ws + WS_CTL) + 4096, MISC + 8);
    int pc = 0;
#define PH_ON (C.launder(), pc >= lo && pc < hi)
#define PH_END do { if (pc >= lo && pc + 1 < hi) xcd_barrier(bar); ++pc; } while (0)

    if (PH_ON) phase_init(C);
    PH_END;

    for (int step = 0; step < 2 * NLAYER; ++step) {
        const int l = step >> 1, f = step & 1;
        if (PH_ON) {
            if (f == 0) phase_prep_weights(C, l);
            phase_norm(C, (f ? C.in(19) : C.in(1)) + (size_t)l * DM);
        }
        PH_END;
        if (PH_ON) {
            pg8::Gemm g{(const bf16*)(C.ws + WS_XN), (const bf16*)(C.ws + (f ? WS_WGU2 : WS_WGU1)), T, 2 * DFF, DM};
            pg8::StaticOrder S; S.init(T, 2 * DFF, C.G, C.bid);
            pg8::EpiSwiGLU E{(bf16*)(C.ws + WS_HID), DFF};
            pg8::gemm_phase<pg8::EpiSwiGLU, pg8::StaticOrder, false>(C.lds, g, S, E, nullptr);
        }
        PH_END;
        if (PH_ON) {
            pg8::Gemm g{(const bf16*)(C.ws + WS_HID), (const bf16*)(C.ws + (f ? WS_WDN2 : WS_WDN1)), T, DM, DFF};
            pg8::StaticOrder S; S.init(T, DM, C.G, C.bid);
            pg8::EpiResid E{C.X, DM, 0.5f};
            pg8::gemm_phase<pg8::EpiResid, pg8::StaticOrder, false>(C.lds, g, S, E, nullptr);
        }
        PH_END;
        if (f == 0) {
            MIXER_PHASES
        }
    }
#undef PH_ON
#undef PH_END
    asm volatile("s_waitcnt vmcnt(0)" ::: "memory");
    __syncthreads();
    if (C.tid == 0) { __builtin_amdgcn_fence(__ATOMIC_RELEASE, "agent"); asm volatile("s_waitcnt vmcnt(0)" ::: "memory"); }
}

extern "C" void kernel_launch(void* const* d_in, const int* in_sizes, int n_in, void* d_out, int out_size, void* d_ws, size_t ws_size, hipStream_t stream) {
    static int grid = 0;
    if (grid == 0) {
        if (n_in != 23 || out_size != T * DM || ws_size < WS_END) { fprintf(stderr, "kernel_launch: unexpected shapes (n_in %d out %d ws %zu, need %zu)\n", n_in, out_size, ws_size, (size_t)WS_END); grid = -1; return; }
        int dev = 0, cus = 0, per_cu = 0;
        if (hipGetDevice(&dev) != hipSuccess || hipDeviceGetAttribute(&cus, hipDeviceAttributeMultiprocessorCount, dev) != hipSuccess) { grid = -1; return; }
        if (hipFuncSetAttribute((const void*)hybrid_fwd, hipFuncAttributeMaxDynamicSharedMemorySize, LDS_BYTES) != hipSuccess) { fprintf(stderr, "kernel_launch: hipFuncSetAttribute failed\n"); grid = -1; return; }
        if (hipOccupancyMaxActiveBlocksPerMultiprocessor(&per_cu, (const void*)hybrid_fwd, NTHR, LDS_BYTES) != hipSuccess || per_cu < 1) { fprintf(stderr, "kernel_launch: occupancy query says %d blocks per CU\n", per_cu); }
        (void)hipGetLastError();
        grid = cus;
    }
    if (grid < 0) return;
    (void)hipMemsetAsync((char*)d_ws + WS_CTL, 0, CTL_ZERO_BYTES, stream);
    Args a{};
    for (int i = 0; i < 23; ++i) a.in[i] = (const float*)d_in[i];
    a.out = (float*)d_out; a.ws = (unsigned char*)d_ws;
#if ONE_LAUNCH
    a.ph_lo = 0; a.ph_hi = N_PHASES;
    hipLaunchKernelGGL(hybrid_fwd, dim3(grid), dim3(NTHR), LDS_BYTES, stream, a);
#else
    for (int p = 0; p < N_PHASES; ++p) { a.ph_lo = p; a.ph_hi = p + 1; hipLaunchKernelGGL(hybrid_fwd, dim3(grid), dim3(NTHR), LDS_BYTES, stream, a); }
#endif
}
```

```cpp
#include <hip/hip_runtime.h>
#include <cstdio>
#include <cstdint>

#ifndef ABL_ZERO
#define ABL_ZERO 0
#endif
#ifndef SCL_A
#define SCL_A 1.0f
#define SCL_B 1.0f
#define SCL_C 1.0f
#endif
#define NAIVE_GLA 0
#define NAIVE_MLSTM 0
#define NAIVE_WIN 0
#define NAIVE_MERGE 0
#ifndef ONE_LAUNCH
#define ONE_LAUNCH 1
#endif

#define GAS __attribute__((address_space(1)))
#define LAS __attribute__((address_space(3)))
typedef unsigned short bf16;
typedef unsigned v4u __attribute__((ext_vector_type(4)));
typedef unsigned v2u __attribute__((ext_vector_type(2)));
typedef float f32x4 __attribute__((ext_vector_type(4)));
typedef float f32x2 __attribute__((ext_vector_type(2)));
typedef short bf16x8 __attribute__((ext_vector_type(8)));
typedef short bf16x4 __attribute__((ext_vector_type(4)));

constexpr int NB = 2, SEQ = 16384, T = NB * SEQ, DM = 1024, DFF = 2816, NLAYER = 4;
constexpr int N_IN = 7472;
constexpr int NWAVES = 8, NTHR = 512;
constexpr float RMS_EPS = 1e-6f;
constexpr int NCH = SEQ / 64;

constexpr size_t MiB = 1u << 20;
constexpr size_t WS_CTL = 0, CTL_ZERO_BYTES = 1 * MiB;
constexpr size_t WS_ROPE = 1 * MiB;
constexpr size_t WS_VEC = 5 * MiB;
constexpr size_t WS_WGU1 = 6 * MiB;
constexpr size_t WS_WDN1 = 17 * MiB;
constexpr size_t WS_WGU2 = 23 * MiB;
constexpr size_t WS_WDN2 = 34 * MiB;
constexpr size_t WS_WIN = 40 * MiB;
constexpr size_t WS_WGT = 49 * MiB;
constexpr size_t WS_WBR = 55 * MiB;
constexpr size_t WS_WOUT = 58 * MiB;
constexpr size_t WS_CW1 = 60 * MiB;
constexpr size_t WS_CW2 = 62 * MiB;
constexpr size_t WS_XN = 64 * MiB;
constexpr size_t WS_R = 128 * MiB;
constexpr size_t WS_HID = WS_R;
constexpr size_t WS_QKA = WS_R;
constexpr size_t WS_VA = WS_R + 32 * MiB;
constexpr size_t WS_RA = WS_R + 64 * MiB;
constexpr size_t WS_QB = WS_R + 96 * MiB;
constexpr size_t WS_KVC = WS_R + 128 * MiB;
constexpr size_t WS_KVS = WS_R + 144 * MiB;
constexpr size_t WS_KVW = WS_R + 160 * MiB;
constexpr size_t WS_QKC = WS_R + 176 * MiB;
constexpr size_t WS_VC = WS_R + 208 * MiB;
constexpr size_t WS_OC = WS_R + 240 * MiB;
constexpr size_t WS_SMALL = WS_R + 272 * MiB;
constexpr size_t WS_VST = WS_R + 280 * MiB;
constexpr size_t WS_VWT = WS_R + 288 * MiB;
constexpr size_t WS_KCMP = WS_R + 296 * MiB;
constexpr size_t WS_VCT = WS_KCMP + MiB / 2;
constexpr size_t WS_CMPH = WS_R + 297 * MiB;
constexpr size_t WS_GST = WS_R + 302 * MiB;
constexpr size_t WS_GDEC = WS_R + 334 * MiB;
constexpr size_t WS_MSC = WS_GDEC + MiB / 2;
constexpr size_t WS_MST = WS_R + 335 * MiB;
constexpr size_t WS_MN = WS_R + 367 * MiB;
constexpr size_t WS_G = WS_QKA;
constexpr size_t WS_Y = WS_QKC;
constexpr size_t WS_END = WS_R + 368 * MiB;

constexpr int VEC_BINP = 0;
constexpr int VEC_CB1 = 8192;

#define LDS_WAIT() asm volatile("s_waitcnt lgkmcnt(0)" ::: "memory")
#define VM_WAIT() asm volatile("s_waitcnt vmcnt(0)" ::: "memory")
__device__ __forceinline__ unsigned f2bf(float f) { unsigned u = __builtin_bit_cast(unsigned, f); return (u + 0x7fffu + ((u >> 16) & 1u)) >> 16; }
__device__ __forceinline__ unsigned pk2(float lo, float hi) { return f2bf(lo) | (f2bf(hi) << 16); }
__device__ __forceinline__ float bf2f(unsigned v) { return __builtin_bit_cast(float, (v & 0xffffu) << 16); }
__device__ __forceinline__ float bflo(unsigned w) { return __builtin_bit_cast(float, w << 16); }
__device__ __forceinline__ float bfhi(unsigned w) { return __builtin_bit_cast(float, w & 0xffff0000u); }
__device__ __forceinline__ float fexp(float x) { return __builtin_amdgcn_exp2f(x * 1.44269504089f); }
__device__ __forceinline__ float sigmoidf_(float x) { return 1.0f / (1.0f + __expf(-x)); }
__device__ __forceinline__ float siluf_(float x) { return x / (1.0f + __expf(-x)); }
__device__ __forceinline__ float logsigmoidf_(float x) { return fminf(x, 0.f) - log1pf(__expf(-fabsf(x))); }
__device__ __forceinline__ float wave_sum(float v) {
#pragma unroll
    for (int o = 1; o < 64; o <<= 1) v += __shfl_xor(v, o);
    return v;
}
__device__ __forceinline__ float wave_max(float v) {
#pragma unroll
    for (int o = 1; o < 64; o <<= 1) v = fmaxf(v, __shfl_xor(v, o));
    return v;
}

#define XB_TMO      128
#define XB_XCNT(j)  (256  + 64 * (j))
#define XB_XSUB(j)  (1280 + 64 * (j))
#define XB_XGEN(j)  (2304 + 64 * (j))
#define XB_TOP      3328
#define XB_TOPGEN   3392
#define XCD_BAR_WORDS 3456
#define XB_SPIN_CAP (1u << 24)

__device__ __forceinline__ unsigned xb_ld(unsigned* p)              { return __hip_atomic_load(p, __ATOMIC_RELAXED, __HIP_MEMORY_SCOPE_AGENT); }
__device__ __forceinline__ unsigned xb_add(unsigned* p, unsigned v) { return __hip_atomic_fetch_add(p, v, __ATOMIC_RELAXED, __HIP_MEMORY_SCOPE_AGENT); }
__device__ __forceinline__ unsigned xb_xcc_id() { return (unsigned)__builtin_amdgcn_s_getreg((3 << 11) | 20) & 0xFu; }
#define XB_SPIN(cond, bar) do { unsigned _sp = 0; while (cond) { __builtin_amdgcn_s_sleep(1); \
    if ((++_sp & 255u) == 0u) { if (xb_ld(&(bar)[XB_TMO])) break; if (_sp > XB_SPIN_CAP) { atomicAdd(&(bar)[XB_TMO], 1u); break; } } } } while (0)

struct XcdBarrier {
    unsigned* bar; unsigned x;
    volatile LAS unsigned* st;
};
__device__ __forceinline__ XcdBarrier xcd_barrier_post(unsigned* bar, volatile LAS unsigned* st) {
    XcdBarrier b; b.bar = bar; b.x = xb_xcc_id(); b.st = st;
    if (threadIdx.x == 0) (void)xb_add(&bar[XB_XCNT(b.x)], 1u);
    return b;
}
__device__ __forceinline__ void xcd_barrier_complete(unsigned* bar, unsigned x, unsigned& nloc, unsigned& nx) {
    const unsigned G = gridDim.x * gridDim.y * gridDim.z;
    unsigned sum, cnt, mine, sp = 0u;
    for (;;) {
        sum = 0u; cnt = 0u; mine = 0u;
#pragma unroll
        for (unsigned j = 0; j < 16; ++j) { const unsigned c = xb_ld(&bar[XB_XCNT(j)]); sum += c; cnt += (c > 0u) ? 1u : 0u; mine = (j == x) ? c : mine; }
        if (sum == G) break;
        __builtin_amdgcn_s_sleep(1);
        if ((++sp & 255u) == 0u) { if (xb_ld(&bar[XB_TMO])) break; if (sp > XB_SPIN_CAP) { atomicAdd(&bar[XB_TMO], 1u); break; } }
    }
    nloc = mine > 0u ? mine : 1u; nx = cnt > 0u ? cnt : 1u;
}
__device__ __forceinline__ void xcd_barrier(const XcdBarrier& b) {
    asm volatile("s_waitcnt vmcnt(0)" ::: "memory");
    __syncthreads();
    if (threadIdx.x == 0) {
        unsigned* bar = b.bar;
        __builtin_amdgcn_s_waitcnt(0);
        unsigned nloc = b.st[0], nx = b.st[1];
        if (nloc == 0u) { xcd_barrier_complete(bar, b.x, nloc, nx); b.st[0] = nloc; b.st[1] = nx; }
        const unsigned old = xb_add(&bar[XB_XSUB(b.x)], 1u);
        const unsigned gen = old / nloc;
        if (old + 1u == (gen + 1u) * nloc) {
            __builtin_amdgcn_fence(__ATOMIC_RELEASE, "agent");
            asm volatile("s_waitcnt vmcnt(0)" ::: "memory");
            const unsigned og = xb_add(&bar[XB_TOP], 1u);
            const unsigned tg = og / nx;
            if (og + 1u == (tg + 1u) * nx) xb_add(&bar[XB_TOPGEN], 1u);
            else XB_SPIN(xb_ld(&bar[XB_TOPGEN]) == tg, bar);
            __builtin_amdgcn_fence(__ATOMIC_ACQUIRE, "agent");
            xb_add(&bar[XB_XGEN(b.x)], 1u);
            asm volatile("s_waitcnt vmcnt(0)" ::: "memory");
        } else {
            XB_SPIN(xb_ld(&bar[XB_XGEN(b.x)]) == gen, bar);
            __builtin_amdgcn_fence(__ATOMIC_ACQUIRE, "agent");
            asm volatile("s_waitcnt vmcnt(0)" ::: "memory");
        }
    }
    __syncthreads();
}

namespace pg8 {
#define PG8_LAS __attribute__((address_space(3)))
typedef unsigned short bf16_t;
typedef short bf16x8 __attribute__((ext_vector_type(8)));
typedef float f32x4 __attribute__((ext_vector_type(4)));
typedef unsigned u32x4 __attribute__((ext_vector_type(4)));
constexpr int BM = 256, BK = 64, HALF = 128, HTB = HALF * BK * 2  , STAGE_BYTES = 8 * HTB, NXCD = 8, WGM = 8;

__host__ __device__ __forceinline__ int lds_byte(int r, int c) { const int st = (r >> 4) * 2 + (c >> 5), rr = r & 15, cc = c & 31, ob = rr * 64 + cc * 2; return st * 1024 + (ob ^ (((ob >> 9) & 1) << 5)); }
__host__ __device__ __forceinline__ void stage_rc(int b, int& R, int& C) { const int st = b / 1024, sb = b % 1024, swz = sb ^ (((sb >> 9) & 1) << 5); R = (st >> 1) * 16 + swz / 64; C = (st & 1) * 32 + (swz % 64) / 2; }
__host__ __device__ __forceinline__ int perm32(int rho) { const int n = rho >> 4, i = rho & 15; return 8 * (i >> 2) + 4 * n + (i & 3); }

struct Unit { int pm, pn; };
struct Gemm { const bf16_t* A; const bf16_t* Bt; int M, N, K; };

struct StaticOrder {
    int nM, nN, nwg, G, c;
    __host__ __device__ void init(int M, int N, int G_, int c_) { nM = M / BM; nN = N / BM; nwg = nM * nN; G = G_; c = c_; }
    __host__ __device__ bool next(int i, Unit& u) const {
        const long L = (long)i * G + c; if (L >= nwg) return false;
        int wgid = (int)L; { const int q = nwg / NXCD, r = nwg % NXCD, xcd = wgid % NXCD, off = wgid / NXCD; wgid = (xcd < r ? xcd * (q + 1) : r * (q + 1) + (xcd - r) * q) + off; }
        const int nig = WGM * nN, gid = wgid / nig, fm = gid * WGM, gsz = (nM - fm) < WGM ? (nM - fm) : WGM;
        u.pm = fm + ((wgid % nig) % gsz); u.pn = (wgid % nig) / gsz; return true;
    }
    __device__ __forceinline__ void a_ready(const Unit&) const {}
    __device__ __forceinline__ void done(const Unit&) const {}
};
struct CountedOrder : StaticOrder {
    const unsigned* ready; unsigned need; unsigned* tmo;
    __device__ __forceinline__ void a_ready(const Unit& u) const {
        if (threadIdx.x < 64) {
            const unsigned long long t0 = __builtin_amdgcn_s_memrealtime(); unsigned polls = 0;
            while ((unsigned)__builtin_amdgcn_readfirstlane(__hip_atomic_load(ready + 64 * u.pm, __ATOMIC_RELAXED, __HIP_MEMORY_SCOPE_AGENT)) < need) {
                if ((++polls & 255u) == 0u && __builtin_amdgcn_readfirstlane(__hip_atomic_load(tmo, __ATOMIC_RELAXED, __HIP_MEMORY_SCOPE_AGENT)) != 0u) break;
                if (__builtin_amdgcn_s_memrealtime() - t0 > 2000000ull) {
                    if (threadIdx.x == 0) { unsigned expect = 0u; __hip_atomic_compare_exchange_strong(tmo + 1, &expect, 0x600u | (unsigned)(u.pm & 0xff), __ATOMIC_RELAXED, __ATOMIC_RELAXED, __HIP_MEMORY_SCOPE_AGENT); __hip_atomic_store(tmo, 1u, __ATOMIC_RELAXED, __HIP_MEMORY_SCOPE_AGENT); }
                    break; }
                __builtin_amdgcn_s_sleep(2); }
            __builtin_amdgcn_fence(__ATOMIC_ACQUIRE, "agent");
            asm volatile("s_waitcnt vmcnt(0)" ::: "memory");
        }
#if !defined(BROKEN_HOOK_NO_BARRIER)
        asm volatile("" ::: "memory"); __builtin_amdgcn_s_barrier(); asm volatile("" ::: "memory");
#endif
    }
};

__device__ __forceinline__ unsigned cvt_pk_bf16(float lo, float hi) { unsigned r; asm volatile("v_cvt_pk_bf16_f32 %0, %1, %2" : "=v"(r) : "v"(lo), "v"(hi)); return r; }
typedef float f32x2 __attribute__((ext_vector_type(2)));
__device__ __forceinline__ f32x2 gelu_pk(f32x2 v) {
    const f32x2 av = __builtin_elementwise_abs(v), d = av * 0.2316418882f + 1.0f;
    f32x2 t; t.x = __builtin_amdgcn_rcpf(d.x); t.y = __builtin_amdgcn_rcpf(d.y);
    f32x2 q = t * 0.5307027145f + (-0.7265760135f); q = q * t + 0.7107068705f; q = q * t + (-0.142248368f); q = q * t + 0.127414796f; q = q * t;
    const f32x2 s = (v * v) * (-0.72134752044f);
    f32x2 e; e.x = __builtin_amdgcn_exp2f(s.x); e.y = __builtin_amdgcn_exp2f(s.y);
    const f32x2 m = v * (q * e), r = v - m;
    f32x2 o; o.x = v.x < 0.f ? m.x : r.x; o.y = v.y < 0.f ? m.y : r.y; return o;
}

struct EpiF32 {
    static constexpr bool PERM = false, AFTER_DRAIN = false;
    float* C; int ldc; const float* bias;
    __device__ __forceinline__ void operator()(const f32x4 (&acc)[2][2][4][2], const Unit& u, int wr, int wc, int fr, int fq) const {
        const int row0 = u.pm * BM + wr * 64 + fr, col0 = u.pn * BM + wc * 32 + 4 * fq;
        f32x4 bv[2][2];
#pragma unroll
        for (int bj = 0; bj < 2; ++bj)
#pragma unroll
            for (int n = 0; n < 2; ++n) bv[bj][n] = bias ? *(const f32x4*)(bias + col0 + bj * HALF + n * 16) : (f32x4){0.f, 0.f, 0.f, 0.f};
#pragma unroll
        for (int ai = 0; ai < 2; ++ai)
#pragma unroll
            for (int m = 0; m < 4; ++m) { float* rowp = C + (size_t)(row0 + ai * HALF + m * 16) * ldc + col0;
#pragma unroll
                for (int bj = 0; bj < 2; ++bj)
#pragma unroll
                    for (int n = 0; n < 2; ++n) *(f32x4*)(rowp + bj * HALF + n * 16) = acc[ai][bj][m][n] + bv[bj][n]; }
    }
};
template <int ACT  > struct EpiBf16 {
    static constexpr bool PERM = true, AFTER_DRAIN = false;
    bf16_t* O; int ldc; const float* bias; int split_cols; size_t split_stride;
    __device__ __forceinline__ void operator()(const f32x4 (&acc)[2][2][4][2], const Unit& u, int wr, int wc, int fr, int fq) const {
        const int row0 = u.pm * BM + wr * 64 + fr; int colt = u.pn * BM; bf16_t* base = O;
        if (split_cols) { const int t = colt / split_cols; base += (size_t)t * split_stride; colt -= t * split_cols; }
        const int col0 = colt + wc * 32 + 8 * fq, bcol0 = u.pn * BM + wc * 32 + 8 * fq;
        f32x4 bv[2][2];
#pragma unroll
        for (int bj = 0; bj < 2; ++bj)
#pragma unroll
            for (int n = 0; n < 2; ++n) bv[bj][n] = bias ? *(const f32x4*)(bias + bcol0 + bj * HALF + 4 * n) : (f32x4){0.f, 0.f, 0.f, 0.f};
#pragma unroll
        for (int ai = 0; ai < 2; ++ai)
#pragma unroll
            for (int m = 0; m < 4; ++m) { bf16_t* rowp = base + (size_t)(row0 + ai * HALF + m * 16) * ldc + col0;
#pragma unroll
                for (int bj = 0; bj < 2; ++bj) { f32x4 v0 = acc[ai][bj][m][0] + bv[bj][0], v1 = acc[ai][bj][m][1] + bv[bj][1];
                    if (ACT == 1) { f32x2 a = gelu_pk((f32x2){v0[0], v0[1]}), b = gelu_pk((f32x2){v0[2], v0[3]}), c = gelu_pk((f32x2){v1[0], v1[1]}), d = gelu_pk((f32x2){v1[2], v1[3]});
                        v0 = (f32x4){a.x, a.y, b.x, b.y}; v1 = (f32x4){c.x, c.y, d.x, d.y}; }
                    if (ACT == 2) {
#pragma unroll
                        for (int j = 0; j < 4; ++j) { v0[j] = 0.5f * v0[j] * (1.0f + erff(v0[j] * 0.70710678f)); v1[j] = 0.5f * v1[j] * (1.0f + erff(v1[j] * 0.70710678f)); } }
                    u32x4 w; w.x = cvt_pk_bf16(v0[0], v0[1]); w.y = cvt_pk_bf16(v0[2], v0[3]); w.z = cvt_pk_bf16(v1[0], v1[1]); w.w = cvt_pk_bf16(v1[2], v1[3]);
                    *(u32x4*)(rowp + bj * HALF) = w; } }
    }
};

struct PanelStats {
    unsigned* xbuf;
    unsigned* cnt;
    unsigned* tmo;
    int ntn; float eps;
    unsigned code;
    __device__ __forceinline__ bool run(const f32x4 (&v)[2][2][4][2], const Unit& u, int wr, int wc, int fr, int fq, PG8_LAS unsigned char* lds, int wid, int lane) const {
        typedef float f32x2v __attribute__((ext_vector_type(2)));
        PG8_LAS f32x2v* P = (PG8_LAS f32x2v*)lds;
        PG8_LAS f32x2v* S = (PG8_LAS f32x2v*)(lds + 8192);
        PG8_LAS unsigned* flag = (PG8_LAS unsigned*)(lds + 8192 + 2048);
#pragma unroll
        for (int ai = 0; ai < 2; ++ai)
#pragma unroll
            for (int m = 0; m < 4; ++m) {
                float s = 0.f;
#pragma unroll
                for (int bj = 0; bj < 2; ++bj)
#pragma unroll
                    for (int n = 0; n < 2; ++n) { const f32x4 x = v[ai][bj][m][n]; s += (x[0] + x[1]) + (x[2] + x[3]); }
                s += __shfl_xor(s, 16); s += __shfl_xor(s, 32);
                const float mw = s * (1.0f / 64.0f); float q = 0.f;
#pragma unroll
                for (int bj = 0; bj < 2; ++bj)
#pragma unroll
                    for (int n = 0; n < 2; ++n) { const f32x4 d = v[ai][bj][m][n] - mw; q += (d[0] * d[0] + d[1] * d[1]) + (d[2] * d[2] + d[3] * d[3]); }
                q += __shfl_xor(q, 16); q += __shfl_xor(q, 32);
                if (fq == 0) P[(ai * HALF + wr * 64 + m * 16 + fr) * 4 + wc] = (f32x2v){mw, q};
            }
        asm volatile("s_waitcnt lgkmcnt(0)" ::: "memory"); __builtin_amdgcn_s_barrier(); asm volatile("" ::: "memory");
#if defined(BROKEN_NO_WAIT)
        if (blockIdx.x >= 64) { const long long t0 = clock64(); while (clock64() - t0 < 60000) __builtin_amdgcn_s_sleep(8); }
#endif
        const int row = wid * 32 + (lane & 31);
        if (lane < 32) {
            const f32x2v a = P[row * 4 + 0], b = P[row * 4 + 1], c = P[row * 4 + 2], d = P[row * 4 + 3];
            const float mt = (a.x + b.x + c.x + d.x) * 0.25f;
            const float da = a.x - mt, db = b.x - mt, dc = c.x - mt, dd = d.x - mt;
            const float m2 = (a.y + b.y) + (c.y + d.y) + 64.0f * ((da * da + db * db) + (dc * dc + dd * dd));
            unsigned long long* slot = (unsigned long long*)xbuf + ((size_t)(u.pm * BM + row) * 4 + u.pn);
            __hip_atomic_store(slot, ((unsigned long long)__float_as_uint(m2) << 32) | __float_as_uint(mt), __ATOMIC_RELAXED, __HIP_MEMORY_SCOPE_AGENT);
        }
        asm volatile("s_waitcnt vmcnt(0)" ::: "memory");
        if (lane == 0) __hip_atomic_fetch_add(cnt + 64 * u.pm, 1u, __ATOMIC_RELAXED, __HIP_MEMORY_SCOPE_AGENT);
        if (wid == 0) {
            bool dead = false; const unsigned long long t0 = __builtin_amdgcn_s_memrealtime(); const unsigned want = 8u * (unsigned)ntn;
            for (;;) {
#if defined(BROKEN_NO_WAIT)
                break;
#endif
                if ((unsigned)__builtin_amdgcn_readfirstlane(__hip_atomic_load(cnt + 64 * u.pm, __ATOMIC_RELAXED, __HIP_MEMORY_SCOPE_AGENT)) >= want) break;
                if (__builtin_amdgcn_s_memrealtime() - t0 > 2000000ull) {
                    if (lane == 0) { unsigned expect = 0u; __hip_atomic_compare_exchange_strong(tmo + 1, &expect, code | (unsigned)(u.pm & 0xff), __ATOMIC_RELAXED, __ATOMIC_RELAXED, __HIP_MEMORY_SCOPE_AGENT);
                                     __hip_atomic_store(tmo, 1u, __ATOMIC_RELAXED, __HIP_MEMORY_SCOPE_AGENT); }
                    dead = true; break; }
                __builtin_amdgcn_s_sleep(2);
            }
            __builtin_amdgcn_fence(__ATOMIC_ACQUIRE, "agent");
            if (lane == 0) flag[0] = dead ? 1u : 0u;
        }
        asm volatile("s_waitcnt vmcnt(0) lgkmcnt(0)" ::: "memory"); __builtin_amdgcn_s_barrier(); asm volatile("" ::: "memory");
        const bool bad = flag[0] != 0u;
        if (lane < 32) {
            const unsigned long long* slot = (const unsigned long long*)xbuf + (size_t)(u.pm * BM + row) * 4; float mt[4], m2[4]; float ms = 0.f;
#pragma unroll
            for (int t = 0; t < 4; ++t) { if (t < ntn) { const unsigned long long w = __hip_atomic_load(slot + t, __ATOMIC_RELAXED, __HIP_MEMORY_SCOPE_AGENT); mt[t] = __uint_as_float((unsigned)w); m2[t] = __uint_as_float((unsigned)(w >> 32)); } else { mt[t] = 0.f; m2[t] = 0.f; } ms += mt[t]; }
            const float mean = ms / (float)ntn; float q = 0.f;
#pragma unroll
            for (int t = 0; t < 4; ++t) if (t < ntn) { const float dm = mt[t] - mean; q += m2[t] + 256.0f * dm * dm; }
            S[row] = (f32x2v){mean, 1.0f / sqrtf(q / (256.0f * (float)ntn) + eps)};
        }
        asm volatile("s_waitcnt lgkmcnt(0)" ::: "memory"); __builtin_amdgcn_s_barrier(); asm volatile("" ::: "memory");
        return bad;
    }
};
struct EpiLnRes {
    static constexpr bool PERM = false, AFTER_DRAIN = true;
    const float* base; float* out; int ldc; const float* bias; PanelStats st; unsigned poison;
    __device__ __forceinline__ void refuse(size_t i0, size_t stride, int M, int N) const { const float q = __builtin_nanf(""); for (size_t i = i0; i < (size_t)M * N; i += stride) out[(i / N) * ldc + i % N] = q;
        if (i0 == 0) { unsigned expect = 0u; __hip_atomic_compare_exchange_strong(st.tmo + 1, &expect, 0x7f0u, __ATOMIC_RELAXED, __ATOMIC_RELAXED, __HIP_MEMORY_SCOPE_AGENT); __hip_atomic_store(st.tmo, 1u, __ATOMIC_RELAXED, __HIP_MEMORY_SCOPE_AGENT); } }
    __device__ __forceinline__ void fused(f32x4 (&acc)[2][2][4][2], const Unit& u, int wr, int wc, int fr, int fq, PG8_LAS unsigned char* lds, int wid, int lane) const {
        typedef float f32x2v __attribute__((ext_vector_type(2)));
        const PG8_LAS f32x2v* S = (const PG8_LAS f32x2v*)(lds + 8192);
        const int col0 = u.pn * BM + wc * 32 + 4 * fq;
#pragma unroll
        for (int bj = 0; bj < 2; ++bj)
#pragma unroll
            for (int n = 0; n < 2; ++n) { const f32x4 bv = bias ? *(const f32x4*)(bias + col0 + bj * HALF + n * 16) : (f32x4){0.f, 0.f, 0.f, 0.f};
#pragma unroll
                for (int ai = 0; ai < 2; ++ai)
#pragma unroll
                    for (int m = 0; m < 4; ++m) acc[ai][bj][m][n] += bv; }
        const bool bad = st.run(acc, u, wr, wc, fr, fq, lds, wid, lane) || poison != 0u;
        const float qnan = __builtin_nanf("");
#pragma unroll
        for (int ai = 0; ai < 2; ++ai)
#pragma unroll
            for (int m = 0; m < 4; ++m) { const int r = ai * HALF + wr * 64 + m * 16 + fr; const f32x2v sr = S[r]; const size_t off = (size_t)(u.pm * BM + r) * ldc + col0;
#pragma unroll
                for (int bj = 0; bj < 2; ++bj)
#pragma unroll
                    for (int n = 0; n < 2; ++n) { const f32x4 bs = *(const f32x4*)(base + off + bj * HALF + n * 16); f32x4 o = bs + (acc[ai][bj][m][n] - sr.x) * sr.y;
                        if (bad) o = (f32x4){qnan, qnan, qnan, qnan}; *(f32x4*)(out + off + bj * HALF + n * 16) = o; }
                asm volatile("" ::: "memory"); }
    }
};
struct EpiLnResLn {
    static constexpr bool PERM = false, AFTER_DRAIN = true;
    const float* base; float* out; bf16_t* xn; int ldc; const float* bias; PanelStats st1, st2; unsigned poison;
    __device__ __forceinline__ void refuse(size_t i0, size_t stride, int M, int N) const { const float q = __builtin_nanf(""); for (size_t i = i0; i < (size_t)M * N; i += stride) { const size_t o = (i / N) * ldc + i % N; out[o] = q; xn[o] = (bf16_t)0x7fc0u; }
        if (i0 == 0) { unsigned expect = 0u; __hip_atomic_compare_exchange_strong(st1.tmo + 1, &expect, 0x7f0u, __ATOMIC_RELAXED, __ATOMIC_RELAXED, __HIP_MEMORY_SCOPE_AGENT); __hip_atomic_store(st1.tmo, 1u, __ATOMIC_RELAXED, __HIP_MEMORY_SCOPE_AGENT); } }
    __device__ __forceinline__ void fused(f32x4 (&acc)[2][2][4][2], const Unit& u, int wr, int wc, int fr, int fq, PG8_LAS unsigned char* lds, int wid, int lane) const {
        typedef float f32x2v __attribute__((ext_vector_type(2))); typedef unsigned u32x2v __attribute__((ext_vector_type(2)));
        const PG8_LAS f32x2v* S = (const PG8_LAS f32x2v*)(lds + 8192);
        const int col0 = u.pn * BM + wc * 32 + 4 * fq;
#pragma unroll
        for (int bj = 0; bj < 2; ++bj)
#pragma unroll
            for (int n = 0; n < 2; ++n) { const f32x4 bv = bias ? *(const f32x4*)(bias + col0 + bj * HALF + n * 16) : (f32x4){0.f, 0.f, 0.f, 0.f};
#pragma unroll
                for (int ai = 0; ai < 2; ++ai)
#pragma unroll
                    for (int m = 0; m < 4; ++m) acc[ai][bj][m][n] += bv; }
        bool bad = st1.run(acc, u, wr, wc, fr, fq, lds, wid, lane) || poison != 0u;
        const float qnan = __builtin_nanf("");
#pragma unroll
        for (int ai = 0; ai < 2; ++ai)
#pragma unroll
            for (int m = 0; m < 4; ++m) { const int r = ai * HALF + wr * 64 + m * 16 + fr; const f32x2v sr = S[r]; const size_t off = (size_t)(u.pm * BM + r) * ldc + col0;
#pragma unroll
                for (int bj = 0; bj < 2; ++bj)
#pragma unroll
                    for (int n = 0; n < 2; ++n) { const f32x4 bs = *(const f32x4*)(base + off + bj * HALF + n * 16); acc[ai][bj][m][n] = bs + (acc[ai][bj][m][n] - sr.x) * sr.y; }
                asm volatile("" : "+v"(acc[ai][0][m][0]), "+v"(acc[ai][0][m][1]), "+v"(acc[ai][1][m][0]), "+v"(acc[ai][1][m][1]));
                if (m & 1) asm volatile("" ::: "memory"); }
        const bool bad1 = bad;
        bad = st2.run(acc, u, wr, wc, fr, fq, lds, wid, lane) || bad;
#pragma unroll
        for (int ai = 0; ai < 2; ++ai)
#pragma unroll
            for (int m = 0; m < 4; ++m) { const int r = ai * HALF + wr * 64 + m * 16 + fr; const f32x2v sr = S[r]; const size_t off = (size_t)(u.pm * BM + r) * ldc + col0;
#pragma unroll
                for (int bj = 0; bj < 2; ++bj)
#pragma unroll
                    for (int n = 0; n < 2; ++n) { const f32x4 x1 = acc[ai][bj][m][n]; *(f32x4*)(out + off + bj * HALF + n * 16) = bad1 ? (f32x4){qnan, qnan, qnan, qnan} : x1;
                        const f32x4 o = (x1 - sr.x) * sr.y; u32x2v w; w.x = cvt_pk_bf16(o[0], o[1]); w.y = cvt_pk_bf16(o[2], o[3]);
                        if (bad) { w.x = 0x7fc07fc0u; w.y = 0x7fc07fc0u; } *(u32x2v*)(xn + off + bj * HALF + n * 16) = w; }
                asm volatile("" ::: "memory"); }
    }
};

template <class Epi, class Sched, bool STAMP = false>
__device__ __forceinline__ void gemm_phase(PG8_LAS unsigned char* lds, const Gemm g, const Sched& S, const Epi& E, unsigned long long* stamps) {
    int tid_ = threadIdx.x; asm volatile("" : "+v"(tid_));
    const int tid = tid_, wid = __builtin_amdgcn_readfirstlane(tid >> 6), lane = tid & 63, wr = wid >> 2, wc = wid & 3, fr = lane & 15, fq = lane >> 4;
    const int K = g.K, nt = K / BK;
    int ts_lo = 0, ts_hi = 0, nts = 0; const unsigned long long rt_entry = STAMP ? (unsigned long long)wall_clock64() : 0ull;
#define PG8_STAMP() do { if (STAMP && wid == 0 && nts < 64) { const unsigned long long _c = (unsigned long long)clock64(); \
        ts_lo = (lane == nts) ? (int)(unsigned)_c : ts_lo; ts_hi = (lane == nts) ? (int)(unsigned)(_c >> 32) : ts_hi; ++nts; } } while (0)
    PG8_STAMP();
    unsigned voffA[2], voffB[2];
#pragma unroll
    for (int i = 0; i < 2; ++i) { int R, C; stage_rc(tid * 16 + i * 8192, R, C); const int Rb = Epi::PERM ? ((R & ~31) + perm32(R & 31)) : R;
        voffA[i] = (unsigned)(R * K + C) * 2u; voffB[i] = (unsigned)(Rb * K + C) * 2u; }
    const size_t kstep = (size_t)(BK * 2);
    const size_t hstep = (size_t)HALF * K * 2;
    const size_t tstep = 2 * hstep;
    const unsigned ldsw = (unsigned)wid * 1024u;
    const int aoff = lds_byte(wr * 64 + fr, fq * 8), boff = lds_byte(wc * 32 + fr, fq * 8);
#define PG8_SA(b, h) (((b) * 2 + (h)) * HTB)
#define PG8_SB(b, h) ((4 + (b) * 2 + (h)) * HTB)
#define PG8_STAGE(bufoff, gbase, voff) do { _Pragma("unroll") for (int _i = 0; _i < 2; ++_i) \
        __builtin_amdgcn_global_load_lds((const unsigned*)((const char*)(gbase) + (voff)[_i]), (PG8_LAS unsigned*)(lds + (bufoff) + ldsw + _i * 8192), 16, 0, 0); } while (0)
#define PG8_LDA(dst, b, h) do { _Pragma("unroll") for (int m = 0; m < 4; ++m) _Pragma("unroll") for (int k = 0; k < 2; ++k) dst[m][k] = *(const PG8_LAS bf16x8*)(lds + PG8_SA(b, h) + aoff + m * 2048 + k * 1024); } while (0)
#define PG8_LDB(dst, b, h) do { _Pragma("unroll") for (int n = 0; n < 2; ++n) _Pragma("unroll") for (int k = 0; k < 2; ++k) dst[n][k] = *(const PG8_LAS bf16x8*)(lds + PG8_SB(b, h) + boff + n * 2048 + k * 1024); } while (0)
#define PG8_MMA(ai, bj, At, Bt) do { __builtin_amdgcn_s_setprio(1); _Pragma("unroll") for (int m = 0; m < 4; ++m) _Pragma("unroll") for (int n = 0; n < 2; ++n) _Pragma("unroll") for (int k = 0; k < 2; ++k) \
        acc[ai][bj][m][n] = __builtin_amdgcn_mfma_f32_16x16x32_bf16(Bt[n][k], At[m][k], acc[ai][bj][m][n], 0, 0, 0); __builtin_amdgcn_s_setprio(0); } while (0)
#define PG8_WAIT_V(n) asm volatile("s_waitcnt vmcnt(" #n ")" ::: "memory")
#define PG8_WAIT_L(n) asm volatile("s_waitcnt lgkmcnt(" #n ")" ::: "memory")
#define PG8_BAR __builtin_amdgcn_s_barrier()
#define PG8_SCHED __builtin_amdgcn_sched_barrier(0)
    Unit cur, nxt; int ui = 0;
    if (!S.next(0, cur)) return;
    f32x4 acc[2][2][4][2];
#pragma unroll
    for (int a = 0; a < 2; ++a)
#pragma unroll
        for (int b = 0; b < 2; ++b)
#pragma unroll
            for (int m = 0; m < 4; ++m)
#pragma unroll
                for (int n = 0; n < 2; ++n) acc[a][b][m][n] = (f32x4){0.f, 0.f, 0.f, 0.f};
    bf16x8 At[4][2], B0[2][2], B1[2][2];
    const char* cA = (const char*)g.A + (size_t)cur.pm * tstep; const char* cB = (const char*)g.Bt + (size_t)cur.pn * tstep;
    S.a_ready(cur);
    PG8_STAGE(PG8_SB(0, 0), cB, voffB); PG8_STAGE(PG8_SA(0, 0), cA, voffA); PG8_STAGE(PG8_SB(0, 1), cB + hstep, voffB); PG8_STAGE(PG8_SA(0, 1), cA + hstep, voffA);
    if (wr == 1) PG8_BAR;
    PG8_WAIT_V(4); PG8_BAR;
    PG8_STAGE(PG8_SB(1, 0), cB + kstep, voffB); PG8_STAGE(PG8_SA(1, 0), cA + kstep, voffA); PG8_STAGE(PG8_SB(1, 1), cB + hstep + kstep, voffB);
    PG8_WAIT_V(6); PG8_BAR;
    PG8_STAMP();
    for (;;) {
        const bool has_next = S.next(ui + 1, nxt);
        const char* nA = has_next ? (const char*)g.A + (size_t)nxt.pm * tstep : cA; const char* nB = has_next ? (const char*)g.Bt + (size_t)nxt.pn * tstep : cB;
        for (int t = 0; t < nt; t += 2) {
            const bool last = (t == nt - 2);
            const char* a1 = cA + (size_t)(t + 1) * kstep;
            const char* a2 = last ? nA : cA + (size_t)(t + 2) * kstep; const char* b2 = last ? nB : cB + (size_t)(t + 2) * kstep;
            const char* a3 = a2 + kstep; const char* b3 = b2 + kstep;
            if (last && has_next) S.a_ready(nxt);
            PG8_LDB(B0, 0, 0); PG8_SCHED; PG8_LDA(At, 0, 0); PG8_STAGE(PG8_SA(1, 1), a1 + hstep, voffA);
            PG8_WAIT_L(8); PG8_BAR; PG8_WAIT_L(0); PG8_MMA(0, 0, At, B0); PG8_BAR; PG8_SCHED;
            PG8_LDB(B1, 0, 1); PG8_STAGE(PG8_SB(0, 0), b2, voffB);
            PG8_BAR; PG8_WAIT_L(0); PG8_MMA(0, 1, At, B1); PG8_BAR;
            PG8_LDA(At, 0, 1); PG8_STAGE(PG8_SA(0, 0), a2, voffA);
            PG8_BAR; PG8_WAIT_L(0); PG8_MMA(1, 0, At, B0); PG8_BAR; PG8_SCHED;
            PG8_STAGE(PG8_SB(0, 1), b2 + hstep, voffB);
            PG8_WAIT_V(6); PG8_BAR; PG8_MMA(1, 1, At, B1); PG8_BAR;
            PG8_LDB(B0, 1, 0); PG8_SCHED; PG8_LDA(At, 1, 0); PG8_STAGE(PG8_SA(0, 1), a2 + hstep, voffA);
            PG8_WAIT_L(8); PG8_BAR; PG8_WAIT_L(0); PG8_MMA(0, 0, At, B0); PG8_BAR; PG8_SCHED;
            PG8_LDB(B1, 1, 1); PG8_STAGE(PG8_SB(1, 0), b3, voffB);
            PG8_BAR; PG8_WAIT_L(0); PG8_MMA(0, 1, At, B1); PG8_BAR;
            PG8_LDA(At, 1, 1); PG8_STAGE(PG8_SA(1, 0), a3, voffA);
            PG8_BAR; PG8_WAIT_L(0); PG8_MMA(1, 0, At, B0); PG8_BAR; PG8_SCHED;
            PG8_STAGE(PG8_SB(1, 1), b3 + hstep, voffB);
            PG8_WAIT_V(6); PG8_BAR; PG8_MMA(1, 1, At, B1); PG8_BAR;
        }
        PG8_STAMP();
        if constexpr (!Epi::AFTER_DRAIN) { E(acc, cur, wr, wc, fr, fq); S.done(cur); }
        PG8_STAMP();
        if (!has_next) break;
#pragma unroll
        for (int a = 0; a < 2; ++a)
#pragma unroll
            for (int b = 0; b < 2; ++b)
#pragma unroll
                for (int m = 0; m < 4; ++m)
#pragma unroll
                    for (int n = 0; n < 2; ++n) acc[a][b][m][n] = (f32x4){0.f, 0.f, 0.f, 0.f};
        cur = nxt; cA = nA; cB = nB; ++ui;
    }
    PG8_WAIT_V(0);
    if (wr == 0) PG8_BAR;
    PG8_BAR;
    if constexpr (Epi::AFTER_DRAIN) { E.fused(acc, cur, wr, wc, fr, fq, lds, wid, lane); S.done(cur); }
    PG8_STAMP();
    if (STAMP && wid == 0) { stamps[lane] = lane < nts ? (((unsigned long long)(unsigned)ts_hi << 32) | (unsigned)ts_lo) : 0ull;
        if (lane == 62) stamps[62] = rt_entry; if (lane == 63) stamps[63] = (unsigned long long)wall_clock64(); }
#undef PG8_STAMP
#undef PG8_SA
#undef PG8_SB
#undef PG8_STAGE
#undef PG8_LDA
#undef PG8_LDB
#undef PG8_MMA
#undef PG8_WAIT_V
#undef PG8_WAIT_L
#undef PG8_BAR
#undef PG8_SCHED
}
}

namespace pg8 {
__device__ __forceinline__ float fast_sigmoid(float x) { return __builtin_amdgcn_rcpf(1.0f + __builtin_amdgcn_exp2f(-1.44269504089f * x)); }
struct EpiSwiGLU {
    static constexpr bool PERM = true, AFTER_DRAIN = false;
    bf16_t* H; int ldh;
    __device__ __forceinline__ void operator()(const f32x4 (&acc)[2][2][4][2], const Unit& u, int wr, int wc, int fr, int fq) const {
        const int row0 = u.pm * BM + wr * 64 + fr, hc0 = u.pn * 128 + wc * 32 + 8 * fq;
#pragma unroll
        for (int ai = 0; ai < 2; ++ai)
#pragma unroll
            for (int m = 0; m < 4; ++m) {
                bf16_t* rowp = H + (size_t)(row0 + ai * HALF + m * 16) * ldh + hc0;
                float v[8];
#pragma unroll
                for (int n = 0; n < 2; ++n)
#pragma unroll
                    for (int j = 0; j < 4; ++j) { const float g = acc[ai][0][m][n][j], up = acc[ai][1][m][n][j]; v[n * 4 + j] = g * fast_sigmoid(g) * up; }
                u32x4 w; w.x = cvt_pk_bf16(v[0], v[1]); w.y = cvt_pk_bf16(v[2], v[3]); w.z = cvt_pk_bf16(v[4], v[5]); w.w = cvt_pk_bf16(v[6], v[7]);
                *(u32x4*)rowp = w;
            }
    }
};
struct EpiResid {
    static constexpr bool PERM = false, AFTER_DRAIN = false;
    float* X; int ldc; float alpha;
    __device__ __forceinline__ void operator()(const f32x4 (&acc)[2][2][4][2], const Unit& u, int wr, int wc, int fr, int fq) const {
        const int row0 = u.pm * BM + wr * 64 + fr, col0 = u.pn * BM + wc * 32 + 4 * fq;
#pragma unroll
        for (int ai = 0; ai < 2; ++ai)
#pragma unroll
            for (int m = 0; m < 4; ++m) { float* rowp = X + (size_t)(row0 + ai * HALF + m * 16) * ldc + col0;
#pragma unroll
                for (int bj = 0; bj < 2; ++bj)
#pragma unroll
                    for (int n = 0; n < 2; ++n) { f32x4* p = (f32x4*)(rowp + bj * HALF + n * 16); const f32x4 old = *p; *p = old + acc[ai][bj][m][n] * alpha; } }
    }
};
struct EpiWin {
    static constexpr bool PERM = true, AFTER_DRAIN = false;
    unsigned char* zbase; const float* bias; float* small_out;
    __device__ __forceinline__ void operator()(const f32x4 (&acc)[2][2][4][2], const Unit& u, int wr, int wc, int fr, int fq) const {
        const int row0 = u.pm * BM + wr * 64 + fr; const int pn = u.pn;
        const int bcol0 = pn * BM + wc * 32 + 8 * fq;
        f32x4 bv[2][2];
#pragma unroll
        for (int bj = 0; bj < 2; ++bj)
#pragma unroll
            for (int n = 0; n < 2; ++n) bv[bj][n] = *(const f32x4*)(bias + bcol0 + bj * HALF + 4 * n);
        if (pn == 17) {
            if (wc < 2) {
#pragma unroll
                for (int ai = 0; ai < 2; ++ai)
#pragma unroll
                    for (int m = 0; m < 4; ++m) { float* rowp = small_out + (size_t)(row0 + ai * HALF + m * 16) * 64 + wc * 32 + 8 * fq;
#pragma unroll
                        for (int n = 0; n < 2; ++n) *(f32x4*)(rowp + 4 * n) = acc[ai][0][m][n] + bv[0][n]; }
            }
            return;
        }
        size_t base; int ld, c0;
        if (pn < 8) { base = (size_t)(pn >> 1) * ((size_t)T * 512 * 2); ld = 512; c0 = (pn & 1) * 256; }
        else if (pn < 11) { base = (size_t)4 * T * 512 * 2 + (size_t)(pn - 8) * ((size_t)T * 256 * 2); ld = 256; c0 = 0; }
        else { base = (size_t)4 * T * 512 * 2 + (size_t)3 * T * 256 * 2 + (size_t)((pn - 11) >> 1) * ((size_t)T * 512 * 2); ld = 512; c0 = ((pn - 11) & 1) * 256; }
        bf16_t* O = (bf16_t*)(zbase + base);
        const int col0 = c0 + wc * 32 + 8 * fq;
#pragma unroll
        for (int ai = 0; ai < 2; ++ai)
#pragma unroll
            for (int m = 0; m < 4; ++m) { bf16_t* rowp = O + (size_t)(row0 + ai * HALF + m * 16) * ld + col0;
#pragma unroll
                for (int bj = 0; bj < 2; ++bj) { const f32x4 v0 = acc[ai][bj][m][0] + bv[bj][0], v1 = acc[ai][bj][m][1] + bv[bj][1];
                    u32x4 w; w.x = cvt_pk_bf16(v0[0], v0[1]); w.y = cvt_pk_bf16(v0[2], v0[3]); w.z = cvt_pk_bf16(v1[0], v1[1]); w.w = cvt_pk_bf16(v1[2], v1[3]);
                    *(u32x4*)(rowp + bj * HALF) = w; } }
    }
};
struct EpiGate {
    static constexpr bool PERM = true, AFTER_DRAIN = false;
    bf16_t* G; int ldc; const float* bias;
    __device__ __forceinline__ void operator()(const f32x4 (&acc)[2][2][4][2], const Unit& u, int wr, int wc, int fr, int fq) const {
        const int row0 = u.pm * BM + wr * 64 + fr, col0 = u.pn * BM + wc * 32 + 8 * fq;
        f32x4 bv[2][2];
#pragma unroll
        for (int bj = 0; bj < 2; ++bj)
#pragma unroll
            for (int n = 0; n < 2; ++n) bv[bj][n] = *(const f32x4*)(bias + col0 + bj * HALF + 4 * n);
#pragma unroll
        for (int ai = 0; ai < 2; ++ai)
#pragma unroll
            for (int m = 0; m < 4; ++m) { bf16_t* rowp = G + (size_t)(row0 + ai * HALF + m * 16) * ldc + col0;
#pragma unroll
                for (int bj = 0; bj < 2; ++bj) { f32x4 v0 = acc[ai][bj][m][0] + bv[bj][0], v1 = acc[ai][bj][m][1] + bv[bj][1];
                    u32x4 w; w.x = cvt_pk_bf16(v0[0], v0[1]); w.y = cvt_pk_bf16(v0[2], v0[3]); w.z = cvt_pk_bf16(v1[0], v1[1]); w.w = cvt_pk_bf16(v1[2], v1[3]);
                    *(u32x4*)(rowp + bj * HALF) = w; } }
    }
};
struct EpiBranch {
    static constexpr bool PERM = true, AFTER_DRAIN = false;
    bf16_t* Y; const bf16_t* G; int ldc; int first;
    __device__ __forceinline__ void operator()(const f32x4 (&acc)[2][2][4][2], const Unit& u, int wr, int wc, int fr, int fq) const {
        const int row0 = u.pm * BM + wr * 64 + fr, col0 = u.pn * BM + wc * 32 + 8 * fq;
#pragma unroll
        for (int ai = 0; ai < 2; ++ai)
#pragma unroll
            for (int m = 0; m < 4; ++m) { const size_t off = (size_t)(row0 + ai * HALF + m * 16) * ldc + col0;
#pragma unroll
                for (int bj = 0; bj < 2; ++bj) {
                    const u32x4 g = *(const u32x4*)(G + off + bj * HALF);
                    u32x4 y = (u32x4){0u, 0u, 0u, 0u}; if (!first) y = *(const u32x4*)(Y + off + bj * HALF);
                    const f32x4 a0 = acc[ai][bj][m][0], a1 = acc[ai][bj][m][1];
                    float o[8];
#pragma unroll
                    for (int q = 0; q < 4; ++q) { const unsigned gw = g[q], yw = y[q]; const float al = q < 2 ? a0[2 * q] : a1[2 * q - 4], ah = q < 2 ? a0[2 * q + 1] : a1[2 * q - 3];
                        o[2 * q] = __builtin_bit_cast(float, yw << 16) + fast_sigmoid(__builtin_bit_cast(float, gw << 16)) * al;
                        o[2 * q + 1] = __builtin_bit_cast(float, yw & 0xffff0000u) + fast_sigmoid(__builtin_bit_cast(float, gw & 0xffff0000u)) * ah; }
                    u32x4 w; w.x = cvt_pk_bf16(o[0], o[1]); w.y = cvt_pk_bf16(o[2], o[3]); w.z = cvt_pk_bf16(o[4], o[5]); w.w = cvt_pk_bf16(o[6], o[7]);
                    *(u32x4*)(Y + off + bj * HALF) = w; } }
    }
};
}

constexpr int RING_BYTES = 131072;
constexpr int MISC_OFF = RING_BYTES + 320;
constexpr int LDS_BYTES = 147456;

__constant__ float ROPE_FREQ[32] = {
1.000000000e+00f, 7.498942614e-01f, 5.623413324e-01f, 4.216965139e-01f, 3.162277639e-01f, 2.371373773e-01f, 1.778279394e-01f, 1.333521307e-01f, 1.000000015e-01f, 7.498941571e-02f, 5.623413250e-02f, 4.216965288e-02f, 3.162277490e-02f, 2.371373773e-02f, 1.778279431e-02f, 1.333521493e-02f, 9.999999776e-03f, 7.498941850e-03f, 5.623413250e-03f, 4.216964822e-03f, 3.162277630e-03f, 2.371373586e-03f, 1.778279431e-03f, 1.333521446e-03f, 1.000000047e-03f, 7.498942432e-04f, 5.623413017e-04f, 4.216965172e-04f, 3.162277571e-04f, 2.371373703e-04f, 1.778279402e-04f, 1.333521504e-04f};

struct Args { const float* in[23]; float* out; unsigned char* ws; int ph_lo, ph_hi; };

struct Ctx {
    LAS unsigned char* lds;
    int tid, lane, wave, G, bid;
    __device__ __forceinline__ void launder() { asm volatile("" : "+v"(tid)); lane = tid & 63; asm volatile("" : "+s"(inp));
        GAS unsigned char* g = (GAS unsigned char*)ws; asm volatile("" : "+s"(g)); ws = (unsigned char*)g;
        GAS float* gx = (GAS float*)X; asm volatile("" : "+s"(gx)); X = (float*)gx; }
    const GAS float* const __attribute__((address_space(4)))* inp; float* X; unsigned char* ws;
    __device__ __forceinline__ const float* in(int k) const { return (const float*)inp[k]; }
};

__device__ __forceinline__ void transpose_item(const float* W, int ldw, int src_col0, bf16* WT, int K, int dst_row0, int kb, LAS float* scr, int lane) {
    const int k0 = 64 * kb;
#pragma unroll 8
    for (int i = 0; i < 32; ++i) { const int kk = 2 * i + (lane >> 5); scr[kk * 33 + (lane & 31)] = W[(size_t)(k0 + kk) * ldw + src_col0 + (lane & 31)]; }
    LDS_WAIT(); asm volatile("" ::: "memory");
    const int c = lane & 7;
#pragma unroll
    for (int j = 0; j < 4; ++j) { const int n = (lane >> 3) + 8 * j; const LAS float* s = scr + (8 * c) * 33 + n;
        v4u o; o.x = pk2(s[0 * 33], s[1 * 33]); o.y = pk2(s[2 * 33], s[3 * 33]); o.z = pk2(s[4 * 33], s[5 * 33]); o.w = pk2(s[6 * 33], s[7 * 33]);
        *(v4u*)(WT + (size_t)(dst_row0 + n) * K + k0 + 8 * c) = o; }
    LDS_WAIT(); asm volatile("" ::: "memory");
}
__device__ __forceinline__ int win_small_src(int i) { return i < 16 ? 1536 + i : i < 40 ? 2832 + (i - 16) : i < 44 ? 4392 + (i - 40) : i < 48 ? 4396 + (i - 44) : -1; }
__device__ __forceinline__ int win_src_col(int n) { return n < 1536 ? n : n < 2816 ? n + 16 : n < 4352 ? n + 40 : win_small_src(n - 4352); }

__device__ __forceinline__ void phase_prep_weights(const Ctx& C, int l) {
    LAS float* scr = (LAS float*)(C.lds + C.wave * 16384);
    const int gw = C.bid * NWAVES + C.wave, NGW = C.G * NWAVES;
    unsigned char* ws = C.ws;
    constexpr int I_GU = 16 * 88, I_DN = 44 * 32, I_WIN = 16 * 136, I_GT = 16 * 96, I_BR = 3 * 8 * 32, I_OUT = 16 * 32, I_C1 = 2 * 32 * 8, I_C2 = 2 * 4 * 2;
    constexpr int I_FFN = 2 * I_GU + I_DN;
    constexpr int NITEMS = 2 * I_FFN + I_WIN + I_GT + I_BR + I_OUT + I_C1 + I_C2;
    for (int it = gw; it < NITEMS; it += NGW) {
        int r = it;
        if (r < 2 * I_FFN) {
            const int f = r / I_FFN; r -= f * I_FFN;
            const float* wg = (f ? C.in(20) : C.in(2)) + (size_t)l * DM * DFF; const float* wu = (f ? C.in(21) : C.in(3)) + (size_t)l * DM * DFF; const float* wd = (f ? C.in(22) : C.in(4)) + (size_t)l * DFF * DM;
            bf16* WGU = (bf16*)(ws + (f ? WS_WGU2 : WS_WGU1)); bf16* WDN = (bf16*)(ws + (f ? WS_WDN2 : WS_WDN1));
            if (r < I_GU) { const int kb = r / 88, col = 32 * (r % 88); transpose_item(wg, DFF, col, WGU, DM, 256 * (col >> 7) + (col & 127), kb, scr, C.lane); }
            else if (r < 2 * I_GU) { r -= I_GU; const int kb = r / 88, col = 32 * (r % 88); transpose_item(wu, DFF, col, WGU, DM, 256 * (col >> 7) + 128 + (col & 127), kb, scr, C.lane); }
            else { r -= 2 * I_GU; const int kb = r / 32, col = 32 * (r % 32); transpose_item(wd, DM, col, WDN, DFF, col, kb, scr, C.lane); }
            continue;
        }
        r -= 2 * I_FFN;
        const float* win = C.in(6) + (size_t)l * DM * N_IN;
        if (r < I_WIN) { const int kb = r / 136, n = 32 * (r % 136); transpose_item(win, N_IN, win_src_col(n), (bf16*)(ws + WS_WIN), DM, n, kb, scr, C.lane); continue; } r -= I_WIN;
        if (r < I_GT) { const int kb = r / 96, n = 32 * (r % 96); transpose_item(win, N_IN, 4400 + n, (bf16*)(ws + WS_WGT), DM, n, kb, scr, C.lane); continue; } r -= I_GT;
        if (r < I_BR) { const int i = r / 256, rr = r % 256, kb = rr / 32, n = 32 * (rr % 32);
            transpose_item(C.in(17) + ((size_t)l * 3 + i) * 512 * DM, DM, n, (bf16*)(ws + WS_WBR) + (size_t)i * DM * 512, 512, n, kb, scr, C.lane); continue; } r -= I_BR;
        if (r < I_OUT) { const int kb = r / 32, n = 32 * (r % 32); transpose_item(C.in(18) + (size_t)l * DM * DM, DM, n, (bf16*)(ws + WS_WOUT), DM, n, kb, scr, C.lane); continue; } r -= I_OUT;
        if (r < I_C1) { const int kv = r / 256, rr = r % 256, kb = rr / 8, n = 32 * (rr % 8);
            transpose_item(C.in(13) + ((size_t)l * 2 + kv) * 2048 * 256, 256, n, (bf16*)(ws + WS_CW1) + (size_t)kv * 256 * 2048, 2048, n, kb, scr, C.lane); continue; } r -= I_C1;
        { const int kv = r / 8, rr = r % 8, kb = rr / 2, n = 32 * (rr % 2);
            transpose_item(C.in(14) + ((size_t)l * 2 + kv) * 256 * 64, 64, n, (bf16*)(ws + WS_CW2) + (size_t)kv * 64 * 256, 256, n, kb, scr, C.lane); }
    }
    const int gt = C.bid * NTHR + C.tid, NGT = C.G * NTHR;
    {
        const float* win = C.in(6) + (size_t)l * DM * N_IN; bf16* WIN = (bf16*)(ws + WS_WIN);
        for (int idx = gt; idx < 256 * 128; idx += NGT) { const int i = idx & 255, kc = idx >> 8; const int sc = win_small_src(i);
            v4u o = (v4u){0u, 0u, 0u, 0u};
            if (sc >= 0) { float v[8];
#pragma unroll
                for (int j = 0; j < 8; ++j) v[j] = win[(size_t)(kc * 8 + j) * N_IN + sc];
                o.x = pk2(v[0], v[1]); o.y = pk2(v[2], v[3]); o.z = pk2(v[4], v[5]); o.w = pk2(v[6], v[7]); }
            *(v4u*)(WIN + (size_t)(4352 + i) * DM + kc * 8) = o; }
        float* vec = (float*)(ws + WS_VEC); const float* bin = C.in(7) + (size_t)l * N_IN;
        for (int n = gt; n < 4608; n += NGT) { const int sc = win_src_col(n); vec[VEC_BINP + n] = sc >= 0 ? bin[sc] : 0.f; }
        for (int it = gw; it < 512; it += NGW) { const int kv = it >> 8, n = it & 255;
            const float* pe = C.in(12) + ((size_t)l * 2 + kv) * 2048; const float* w1 = C.in(13) + ((size_t)l * 2 + kv) * 2048 * 256;
            float s = 0.f;
            for (int k = C.lane; k < 2048; k += 64) s += pe[k] * w1[(size_t)k * 256 + n];
            s = wave_sum(s);
            if (C.lane == 0) vec[VEC_CB1 + it] = s; }
    }
}

__device__ __forceinline__ void phase_init(const Ctx& C) {
    const int gt = C.bid * NTHR + C.tid, NGT = C.G * NTHR;
    const f32x4* src = (const f32x4*)C.in(0); f32x4* dst = (f32x4*)C.X;
    for (size_t i = gt; i < (size_t)T * DM / 4; i += NGT) dst[i] = src[i];
    f32x2* rope = (f32x2*)(C.ws + WS_ROPE);
    for (int i = gt; i < SEQ * 32; i += NGT) { const int pos = i >> 5, fi = i & 31;
        const float ang = (float)pos * ROPE_FREQ[fi];
        double rev = (double)ang * 0.15915494309189533577; rev -= floor(rev);
        const float rf = (float)rev;
        rope[i] = (f32x2){__builtin_amdgcn_cosf(rf), __builtin_amdgcn_sinf(rf)}; }
}

__device__ __forceinline__ void phase_norm(const Ctx& C, const float* gain) {
    const int gw = C.bid * NWAVES + C.wave, NGW = C.G * NWAVES;
    bf16* XN = (bf16*)(C.ws + WS_XN);
    f32x4 g[4];
#pragma unroll
    for (int j = 0; j < 4; ++j) g[j] = ((const f32x4*)gain)[C.lane + 64 * j];
    for (int m = gw; m < T; m += NGW) {
        const f32x4* xr = (const f32x4*)(C.X + (size_t)m * DM) + C.lane;
        f32x4 v[4]; float s = 0.f;
#pragma unroll
        for (int j = 0; j < 4; ++j) { v[j] = xr[64 * j]; s += (v[j].x * v[j].x + v[j].y * v[j].y) + (v[j].z * v[j].z + v[j].w * v[j].w); }
        const float r = 1.0f / sqrtf(wave_sum(s) * (1.f / DM) + RMS_EPS);
        unsigned long long* o8 = (unsigned long long*)(XN + (size_t)m * DM) + C.lane;
#pragma unroll
        for (int j = 0; j < 4; ++j) { const f32x4 w = v[j] * r * g[j]; o8[64 * j] = (unsigned long long)pk2(w.x, w.y) | ((unsigned long long)pk2(w.z, w.w) << 32); }
    }
}

template <int KSTEPS, class PA, class PB>
__device__ __forceinline__ f32x4 mma_tile(PA A, int lda, PB Bt, int ldb, f32x4 acc, int lane) {
    const int r = lane & 15, q = lane >> 4;
#pragma unroll
    for (int kk = 0; kk < KSTEPS; ++kk) {
        const bf16x8 a = *(const bf16x8*)(A + r * lda + kk * 32 + 8 * q);
        const bf16x8 b = *(const bf16x8*)(Bt + r * ldb + kk * 32 + 8 * q);
        acc = __builtin_amdgcn_mfma_f32_16x16x32_bf16(a, b, acc, 0, 0, 0);
    }
    return acc;
}
__device__ __forceinline__ float wave_scan_sum(float v, int lane) {
#pragma unroll
    for (int o = 1; o < 64; o <<= 1) { const float t = __shfl_up(v, o); if (lane >= o) v += t; }
    return v;
}
__device__ __forceinline__ float wave_scan_max(float v, int lane) {
#pragma unroll
    for (int o = 1; o < 64; o <<= 1) { const float t = __shfl_up(v, o); if (lane >= o) v = fmaxf(v, t); }
    return v;
}

constexpr int CU_ALR = 0;
constexpr int CU_GT = 4096;
constexpr int CU_VEC = 6144;
constexpr int CU_KT = 8192;
constexpr int CU_VT = 17408;
constexpr int CU_Q = 35840;
constexpr int CU_AT = 45056;
constexpr int CU_O = 54272;
constexpr int CU_END = 88064;

__device__ __forceinline__ void load_vt(const Ctx& C, const bf16* V, int t0, int h) {
    LAS bf16* VT = (LAS bf16*)(C.lds + CU_VT);
    const int dv = C.tid & 127, jq = C.tid >> 7;
    const bf16* src = V + (size_t)(t0 + 16 * jq) * 512 + h * 128 + dv;
    unsigned w[8];
#pragma unroll
    for (int jj = 0; jj < 8; ++jj) { const unsigned lo = src[(size_t)(2 * jj) * 512], hi = src[(size_t)(2 * jj + 1) * 512]; w[jj] = lo | (hi << 16); }
    *(LAS v4u*)(VT + dv * 72 + 16 * jq) = (v4u){w[0], w[1], w[2], w[3]};
    *(LAS v4u*)(VT + dv * 72 + 16 * jq + 8) = (v4u){w[4], w[5], w[6], w[7]};
}

__device__ __forceinline__ float gla_cumsum(const Ctx& C, int l, int t0, int h, float (&b)[8]) {
    LAS float* ALR = (LAS float*)(C.lds + CU_ALR); LAS float* GT = (LAS float*)(C.lds + CU_GT);
    const float* SMALL = (const float*)(C.ws + WS_SMALL);
    if (C.tid < 256) { const int j = C.tid >> 2, c4 = C.tid & 3; *(LAS f32x4*)(ALR + j * 16 + 4 * c4) = *(const f32x4*)(SMALL + (size_t)(t0 + j) * 64 + 4 * c4); }
    const int dk = C.tid & 63, jg = C.tid >> 6;
    float w[16]; const float* wa = C.in(8) + (size_t)l * 16 * 256 + h * 64 + dk;
#pragma unroll
    for (int r = 0; r < 16; ++r) w[r] = wa[r * 256];
    const float ba = C.in(9)[(size_t)l * 256 + h * 64 + dk];
    __syncthreads();
    float run = 0.f;
#pragma unroll
    for (int jj = 0; jj < 8; ++jj) { const int j = 8 * jg + jj; float x = ba;
#pragma unroll
        for (int r = 0; r < 16; ++r) x += ALR[j * 16 + r] * w[r];
        run += logsigmoidf_(x) * (1.0f / 16.0f); b[jj] = run; }
    GT[jg * 64 + dk] = run;
    __syncthreads();
    float pre = 0.f, tot = 0.f;
#pragma unroll
    for (int g2 = 0; g2 < 8; ++g2) { const float v = GT[g2 * 64 + dk]; tot += v; if (g2 < jg) pre += v; }
#pragma unroll
    for (int jj = 0; jj < 8; ++jj) b[jj] += pre;
    return tot;
}

__device__ __forceinline__ void gla_unit_a(const Ctx& C, int l, int ci) {
    const int bh = ci >> 8, c = ci & 255, bb = bh >> 2, h = bh & 3, t0 = bb * SEQ + c * 64;
    const bf16* QKA = (const bf16*)(C.ws + WS_QKA);
    load_vt(C, (const bf16*)(C.ws + WS_VA), t0, h);
    float b[8]; const float btot = gla_cumsum(C, l, t0, h, b);
    const int dk = C.tid & 63, jg = C.tid >> 6;
    LAS bf16* KT = (LAS bf16*)(C.lds + CU_KT);
    float kd[8];
#pragma unroll
    for (int jj = 0; jj < 8; ++jj) { const float k = bf2f(QKA[(size_t)(t0 + 8 * jg + jj) * 512 + 256 + h * 64 + dk]); kd[jj] = k * fexp(btot - b[jj]); }
    *(LAS v4u*)(KT + dk * 72 + 8 * jg) = (v4u){pk2(kd[0], kd[1]), pk2(kd[2], kd[3]), pk2(kd[4], kd[5]), pk2(kd[6], kd[7])};
    if (jg == 0) ((float*)(C.ws + WS_GDEC))[(size_t)ci * 64 + dk] = fexp(btot);
    __syncthreads();
    const LAS bf16* VT = (const LAS bf16*)(C.lds + CU_VT);
    bf16* GST = (bf16*)(C.ws + WS_GST) + (size_t)ci * 8192;
    const int q = C.lane >> 4, fr = C.lane & 15;
#pragma unroll
    for (int nt = 0; nt < 4; ++nt) {
        f32x4 acc = (f32x4){0.f, 0.f, 0.f, 0.f};
        acc = mma_tile<2>(VT + 16 * C.wave * 72, 72, (const LAS bf16*)KT + 16 * nt * 72, 72, acc, C.lane);
#pragma unroll
        for (int r = 0; r < 4; ++r) GST[(16 * C.wave + 4 * q + r) * 64 + 16 * nt + fr] = (bf16)f2bf(acc[r]);
    }
    __syncthreads();
}

__device__ __forceinline__ void gla_unit_c(const Ctx& C, int l, int ci) {
    const int bh = ci >> 8, c = ci & 255, bb = bh >> 2, h = bh & 3, t0 = bb * SEQ + c * 64;
    const bf16* QKA = (const bf16*)(C.ws + WS_QKA);
    load_vt(C, (const bf16*)(C.ws + WS_VA), t0, h);
    float b[8]; (void)gla_cumsum(C, l, t0, h, b);
    const int dk = C.tid & 63, jg = C.tid >> 6;
    LAS bf16* KT = (LAS bf16*)(C.lds + CU_KT); LAS bf16* QT = (LAS bf16*)(C.lds + CU_Q); LAS bf16* AT = (LAS bf16*)(C.lds + CU_AT);
#pragma unroll
    for (int jj = 0; jj < 8; ++jj) { const int j = 8 * jg + jj; const bf16* p = QKA + (size_t)(t0 + j) * 512 + h * 64 + dk;
        const float qv = bf2f(p[0]) * 0.125f, kv = bf2f(p[256]);
        QT[j * 72 + dk] = (bf16)f2bf(qv * fexp(b[jj])); KT[j * 72 + dk] = (bf16)f2bf(kv * fexp(fminf(-b[jj], 80.f))); }
    __syncthreads();
    const int q = C.lane >> 4, fr = C.lane & 15;
    {
        const int it = C.wave >> 1;
#pragma unroll
        for (int u = 0; u < 2; ++u) { const int jt = 2 * (C.wave & 1) + u;
            f32x4 acc = (f32x4){0.f, 0.f, 0.f, 0.f};
            if (jt <= it) acc = mma_tile<2>((const LAS bf16*)KT + 16 * jt * 72, 72, (const LAS bf16*)QT + 16 * it * 72, 72, acc, C.lane);
            const int i = 16 * it + fr;
            float v[4];
#pragma unroll
            for (int r = 0; r < 4; ++r) { const int j = 16 * jt + 4 * q + r; v[r] = (j <= i) ? acc[r] : 0.f; }
            *(LAS v2u*)(AT + i * 72 + 16 * jt + 4 * q) = (v2u){pk2(v[0], v[1]), pk2(v[2], v[3])}; }
    }
    __syncthreads();
    {
        const int it = C.wave & 3; LAS float* O = (LAS float*)(C.lds + CU_O);
        const bf16* ST = (const bf16*)(C.ws + WS_GST) + (size_t)ci * 8192;
        const LAS bf16* VT = (const LAS bf16*)(C.lds + CU_VT);
#pragma unroll
        for (int u = 0; u < 4; ++u) { const int dvt = 4 * (C.wave >> 2) + u;
            f32x4 acc = (f32x4){0.f, 0.f, 0.f, 0.f};
            if (!(ABL_ZERO & 64)) acc = mma_tile<2>((const LAS bf16*)QT + 16 * it * 72, 72, ST + 16 * dvt * 64, 64, acc, C.lane);
            acc = mma_tile<2>((const LAS bf16*)AT + 16 * it * 72, 72, VT + 16 * dvt * 72, 72, acc, C.lane);
#pragma unroll
            for (int r = 0; r < 4; ++r) O[(16 * it + 4 * q + r) * 132 + 16 * dvt + fr] = acc[r]; }
    }
    __syncthreads();
    {
        const int i = C.tid >> 3, s = C.tid & 7; const LAS float* O = (const LAS float*)(C.lds + CU_O) + i * 132 + 16 * s;
        float o[16]; float ss = 0.f;
#pragma unroll
        for (int k = 0; k < 16; ++k) { o[k] = O[k]; ss += o[k] * o[k]; }
        ss += __shfl_xor(ss, 1); ss += __shfl_xor(ss, 2); ss += __shfl_xor(ss, 4);
        const float rinv = 1.0f / sqrtf(ss * (1.0f / 128.0f) + RMS_EPS);
        bf16* RA = (bf16*)(C.ws + WS_RA) + (size_t)(t0 + i) * 512 + h * 128 + 16 * s;
        const float* gn = C.in(10) + (size_t)l * 128 + 16 * s;
        const v4u r0 = *(const v4u*)RA, r1 = *(const v4u*)(RA + 8);
        unsigned rw[8] = {r0.x, r0.y, r0.z, r0.w, r1.x, r1.y, r1.z, r1.w}; unsigned ow[8];
#pragma unroll
        for (int k = 0; k < 8; ++k) { const float a = SCL_A * o[2 * k] * rinv * gn[2 * k] * siluf_(bflo(rw[k])), bq = SCL_A * o[2 * k + 1] * rinv * gn[2 * k + 1] * siluf_(bfhi(rw[k])); ow[k] = (ABL_ZERO & 1) ? 0u : pk2(a, bq); }
        *(v4u*)RA = (v4u){ow[0], ow[1], ow[2], ow[3]}; *(v4u*)(RA + 8) = (v4u){ow[4], ow[5], ow[6], ow[7]};
    }
    __syncthreads();
}

__device__ __forceinline__ void conv_silu8(const Ctx& C, int l, int t0, int c, int ch, int jg, float (&out)[8]) {
    const bf16* X = (const bf16*)(C.ws + WS_QKC);
    const float* cw = C.in(15) + (size_t)l * 4 * 512 + ch; const float cb = C.in(16)[(size_t)l * 512 + ch];
    const float w0 = cw[0], w1 = cw[512], w2 = cw[1024], w3 = cw[1536];
    float x[11];
#pragma unroll
    for (int k = 0; k < 11; ++k) { const int j = 8 * jg + k - 3; const int s = c * 64 + j; x[k] = (s >= 0) ? bf2f(X[(size_t)(t0 + j) * 512 + ch]) : 0.f; }
#pragma unroll
    for (int jj = 0; jj < 8; ++jj) out[jj] = siluf_(cb + w0 * x[jj] + w1 * x[jj + 1] + w2 * x[jj + 2] + w3 * x[jj + 3]);
}

__device__ __forceinline__ void mlstm_unit_a(const Ctx& C, int l, int ci) {
    const int bh = ci >> 8, c = ci & 255, bb = bh >> 2, h = bh & 3, t0 = bb * SEQ + c * 64;
    LAS float* VEC = (LAS float*)(C.lds + CU_VEC); LAS float* GT = (LAS float*)(C.lds + CU_GT);
    load_vt(C, (const bf16*)(C.ws + WS_VC), t0, h);
    const int dk = C.tid & 63, jg = C.tid >> 6;
    float k[8]; conv_silu8(C, l, t0, c, 256 + h * 64 + dk, jg, k);
    if (C.wave == 0) {
        const float* sm = (const float*)(C.ws + WS_SMALL) + (size_t)(t0 + C.lane) * 64;
        const float ip = sm[40 + h], lf = logsigmoidf_(sm[44 + h]);
        const float bj = wave_scan_sum(lf, C.lane); const float a = ip - bj; const float amax = wave_max(a);
        VEC[C.lane] = fexp(a - amax);
        if (C.lane == 63) { float* msc = (float*)(C.ws + WS_MSC) + (size_t)ci * 4; msc[0] = bj; msc[1] = amax; }
    }
    __syncthreads();
    LAS bf16* KT = (LAS bf16*)(C.lds + CU_KT);
    float kw[8]; float ns = 0.f;
#pragma unroll
    for (int jj = 0; jj < 8; ++jj) { kw[jj] = k[jj] * 0.125f * VEC[8 * jg + jj]; ns += kw[jj]; }
    *(LAS v4u*)(KT + dk * 72 + 8 * jg) = (v4u){pk2(kw[0], kw[1]), pk2(kw[2], kw[3]), pk2(kw[4], kw[5]), pk2(kw[6], kw[7])};
    GT[jg * 64 + dk] = ns;
    __syncthreads();
    if (C.tid < 64) { float s = 0.f;
#pragma unroll
        for (int g2 = 0; g2 < 8; ++g2) s += GT[g2 * 64 + C.tid];
        ((float*)(C.ws + WS_MN))[(size_t)ci * 64 + C.tid] = s; }
    const LAS bf16* VT = (const LAS bf16*)(C.lds + CU_VT);
    bf16* MST = (bf16*)(C.ws + WS_MST) + (size_t)ci * 8192;
    const int q = C.lane >> 4, fr = C.lane & 15;
#pragma unroll
    for (int nt = 0; nt < 4; ++nt) {
        f32x4 acc = (f32x4){0.f, 0.f, 0.f, 0.f};
        acc = mma_tile<2>(VT + 16 * C.wave * 72, 72, (const LAS bf16*)KT + 16 * nt * 72, 72, acc, C.lane);
#pragma unroll
        for (int r = 0; r < 4; ++r) MST[(16 * C.wave + 4 * q + r) * 64 + 16 * nt + fr] = (bf16)f2bf(acc[r]);
    }
    __syncthreads();
}

__device__ __forceinline__ void mlstm_unit_c(const Ctx& C, int l, int ci) {
    const int bh = ci >> 8, c = ci & 255, bb = bh >> 2, h = bh & 3, t0 = bb * SEQ + c * 64;
    LAS float* VEC = (LAS float*)(C.lds + CU_VEC);
    LAS float* AJ = VEC + 64, *MI = VEC + 128, *WI = VEC + 192, *EM = VEC + 256, *QN = VEC + 384; LAS float* DENP = (LAS float*)(C.lds + CU_GT);
    load_vt(C, (const bf16*)(C.ws + WS_VC), t0, h);
    const int dk = C.tid & 63, jg = C.tid >> 6;
    LAS bf16* KT = (LAS bf16*)(C.lds + CU_KT); LAS bf16* QT = (LAS bf16*)(C.lds + CU_Q); LAS bf16* AT = (LAS bf16*)(C.lds + CU_AT);
    {
        float qv[8], kv[8]; conv_silu8(C, l, t0, c, h * 64 + dk, jg, qv); conv_silu8(C, l, t0, c, 256 + h * 64 + dk, jg, kv);
#pragma unroll
        for (int jj = 0; jj < 8; ++jj) { const int j = 8 * jg + jj; QT[j * 72 + dk] = (bf16)f2bf(qv[jj]); KT[j * 72 + dk] = (bf16)f2bf(kv[jj] * 0.125f); }
    }
    if (C.wave == 0) {
        const float* sm = (const float*)(C.ws + WS_SMALL) + (size_t)(t0 + C.lane) * 64;
        const float ip = sm[40 + h], lf = logsigmoidf_(sm[44 + h]);
        const float bj = wave_scan_sum(lf, C.lane); const float a = ip - bj; const float arun = wave_scan_max(a, C.lane);
        const float mst = ((const float*)(C.ws + WS_MSC))[(size_t)ci * 4 + 2];
        const float mi = fmaxf(mst, arun);
        AJ[C.lane] = a; MI[C.lane] = mi; WI[C.lane] = fexp(mst - mi); EM[C.lane] = fexp(-(bj + mi));
    }
    __syncthreads();
    const int q = C.lane >> 4, fr = C.lane & 15;
    {
        const int it = C.wave >> 1;
#pragma unroll
        for (int u = 0; u < 2; ++u) { const int jt = 2 * (C.wave & 1) + u;
            f32x4 acc = (f32x4){0.f, 0.f, 0.f, 0.f};
            if (jt <= it) acc = mma_tile<2>((const LAS bf16*)KT + 16 * jt * 72, 72, (const LAS bf16*)QT + 16 * it * 72, 72, acc, C.lane);
            const int i = 16 * it + fr; const float mi = MI[i];
            float v[4]; float ds = 0.f;
#pragma unroll
            for (int r = 0; r < 4; ++r) { const int j = 16 * jt + 4 * q + r; v[r] = (j <= i) ? acc[r] * fexp(AJ[j] - mi) : 0.f; ds += v[r]; }
            ds += __shfl_xor(ds, 16); ds += __shfl_xor(ds, 32);
            if (q == 0) DENP[jt * 64 + i] = ds;
            *(LAS v2u*)(AT + i * 72 + 16 * jt + 4 * q) = (v2u){pk2(v[0], v[1]), pk2(v[2], v[3])}; }
    }
    {
        const int i = C.tid >> 3, s = C.tid & 7; const float* nst = (const float*)(C.ws + WS_MN) + (size_t)ci * 64 + 8 * s;
        float a = 0.f;
#pragma unroll
        for (int k = 0; k < 8; ++k) a += bf2f(QT[i * 72 + 8 * s + k]) * nst[k];
        a += __shfl_xor(a, 1); a += __shfl_xor(a, 2); a += __shfl_xor(a, 4);
        if (s == 0) QN[i] = a;
    }
    __syncthreads();
    {
        const int it = C.wave & 3; LAS float* O = (LAS float*)(C.lds + CU_O);
        const bf16* ST = (const bf16*)(C.ws + WS_MST) + (size_t)ci * 8192;
        const LAS bf16* VT = (const LAS bf16*)(C.lds + CU_VT);
#pragma unroll
        for (int u = 0; u < 4; ++u) { const int dvt = 4 * (C.wave >> 2) + u;
            f32x4 a1 = (f32x4){0.f, 0.f, 0.f, 0.f}, a2 = (f32x4){0.f, 0.f, 0.f, 0.f};
            a1 = mma_tile<2>((const LAS bf16*)QT + 16 * it * 72, 72, ST + 16 * dvt * 64, 64, a1, C.lane);
            a2 = mma_tile<2>((const LAS bf16*)AT + 16 * it * 72, 72, VT + 16 * dvt * 72, 72, a2, C.lane);
#pragma unroll
            for (int r = 0; r < 4; ++r) { const int i = 16 * it + 4 * q + r; O[i * 132 + 16 * dvt + fr] = WI[i] * a1[r] + a2[r]; } }
    }
    __syncthreads();
    {
        const int i = C.tid >> 3, s = C.tid & 7; const LAS float* O = (const LAS float*)(C.lds + CU_O) + i * 132 + 16 * s;
        const float den = WI[i] * QN[i] + ((DENP[i] + DENP[64 + i]) + (DENP[128 + i] + DENP[192 + i])); const float dinv = 1.0f / fmaxf(fabsf(den), EM[i]);
        bf16* OC = (bf16*)(C.ws + WS_OC) + (size_t)(t0 + i) * 512 + h * 128 + 16 * s;
        const v4u r0 = *(const v4u*)OC, r1 = *(const v4u*)(OC + 8);
        unsigned rw[8] = {r0.x, r0.y, r0.z, r0.w, r1.x, r1.y, r1.z, r1.w}; unsigned ow[8];
#pragma unroll
        for (int k = 0; k < 8; ++k) ow[k] = (ABL_ZERO & 4) ? 0u : pk2(SCL_C * O[2 * k] * dinv * sigmoidf_(bflo(rw[k])), SCL_C * O[2 * k + 1] * dinv * sigmoidf_(bfhi(rw[k])));
        *(v4u*)OC = (v4u){ow[0], ow[1], ow[2], ow[3]}; *(v4u*)(OC + 8) = (v4u){ow[4], ow[5], ow[6], ow[7]};
    }
    __syncthreads();
}

__device__ __forceinline__ void phase_scan(const Ctx& C) {
    const int gt = C.bid * NTHR + C.tid, NGT = C.G * NTHR;
    for (int e = gt; e < 65536 + 65536 + 512; e += NGT) {
        if (e < 65536) {
            const int bh = e >> 13, el = e & 8191, dk = el & 63;
            bf16* st = (bf16*)(C.ws + WS_GST) + (size_t)bh * 256 * 8192 + el; const float* dec = (const float*)(C.ws + WS_GDEC) + (size_t)bh * 256 * 64 + dk;
            float s = 0.f;
            for (int c0 = 0; c0 < 256; c0 += 8) { float L[8], d[8];
#pragma unroll
                for (int k = 0; k < 8; ++k) { L[k] = bf2f(st[(size_t)(c0 + k) * 8192]); d[k] = dec[(c0 + k) * 64]; }
#pragma unroll
                for (int k = 0; k < 8; ++k) { st[(size_t)(c0 + k) * 8192] = (bf16)f2bf(s); s = d[k] * s + L[k]; } }
        } else {
            const bool isn = e >= 131072; const int e2 = e - (isn ? 131072 : 65536);
            const int bh = isn ? (e2 >> 6) : (e2 >> 13), el = isn ? (e2 & 63) : (e2 & 8191);
            bf16* st = (bf16*)(C.ws + WS_MST) + (size_t)bh * 256 * 8192 + el; float* nv = (float*)(C.ws + WS_MN) + (size_t)bh * 256 * 64 + el;
            float* msc = (float*)(C.ws + WS_MSC) + (size_t)bh * 256 * 4;
            float s = 0.f, m = 0.f;
            for (int c0 = 0; c0 < 256; c0 += 8) { float L[8], bl[8], am[8];
#pragma unroll
                for (int k = 0; k < 8; ++k) { L[k] = isn ? nv[(c0 + k) * 64] : bf2f(st[(size_t)(c0 + k) * 8192]); bl[k] = msc[(c0 + k) * 4]; am[k] = msc[(c0 + k) * 4 + 1]; }
#pragma unroll
                for (int k = 0; k < 8; ++k) {
                    const float mn = bl[k] + fmaxf(m, am[k]); const float al = fexp(bl[k] + m - mn), be = fexp(bl[k] + am[k] - mn);
                    if (isn) { nv[(c0 + k) * 64] = s; if (el == 0) msc[(c0 + k) * 4 + 2] = m; } else st[(size_t)(c0 + k) * 8192] = (bf16)f2bf(s);
                    s = al * s + be * L[k]; m = mn; } }
        }
    }
}

__device__ __forceinline__ float gelu_tanh(float x) { const float u = 0.7978845608f * (x + 0.044715f * x * x * x); const float e = __expf(2.0f * u); return 0.5f * x * (2.0f - 2.0f / (1.0f + e)); }

__device__ __forceinline__ void nsa_norm_rope_row(bf16* p, const float* gain, const f32x2* rope_row, float scale, int lane) {
    const float x = bf2f(p[lane]);
    const float ss = wave_sum(x * x);
    const float y = x * (1.0f / sqrtf(ss * (1.0f / 64.0f) + RMS_EPS)) * gain[lane];
    const float pr = __shfl_xor(y, 32);
    const f32x2 cs = rope_row[lane & 31];
    const float o = (lane < 32) ? (y * cs.x - pr * cs.y) : (pr * cs.y + y * cs.x);
    p[lane] = (bf16)f2bf(o * scale);
}
__device__ __forceinline__ void nsa_prep_token(const Ctx& C, int l, int t) {
    const float* gn = C.in(11) + (size_t)l * 4 * 64;
    const f32x2* rr = (const f32x2*)(C.ws + WS_ROPE) + (size_t)(t & (SEQ - 1)) * 32;
    bf16* q = (bf16*)(C.ws + WS_QB) + (size_t)t * 512;
#pragma unroll 1
    for (int hh = 0; hh < 8; ++hh) nsa_norm_rope_row(q + hh * 64, gn, rr, 0.125f, C.lane);
    bf16* ks = (bf16*)(C.ws + WS_KVS) + (size_t)t * 256; bf16* kw = (bf16*)(C.ws + WS_KVW) + (size_t)t * 256;
#pragma unroll 1
    for (int g = 0; g < 2; ++g) { nsa_norm_rope_row(ks + g * 64, gn + 128, rr, 1.0f, C.lane); nsa_norm_rope_row(kw + g * 64, gn + 192, rr, 1.0f, C.lane); }
}
__device__ __forceinline__ void nsa_vtrans_item(const Ctx& C, int item) {
    const int which = item >> 10, bg = (item >> 8) & 3, blk = item & 255, b = bg >> 1, g = bg & 1;
    const bf16* src = (const bf16*)(C.ws + (which ? WS_KVW : WS_KVS)) + (size_t)(b * SEQ + blk * 64 + C.lane) * 256 + 128 + g * 64;
    bf16* dst = (bf16*)(C.ws + (which ? WS_VWT : WS_VST)) + (size_t)(bg * 256 + blk) * 4096 + C.lane;
    v4u w[8];
#pragma unroll
    for (int k = 0; k < 8; ++k) w[k] = ((const v4u*)src)[k];
#pragma unroll
    for (int k = 0; k < 8; ++k)
#pragma unroll
        for (int e = 0; e < 4; ++e) { const unsigned x = w[k][e]; dst[(size_t)(8 * k + 2 * e) * 64] = (bf16)(x & 0xffffu); dst[(size_t)(8 * k + 2 * e + 1) * 64] = (bf16)(x >> 16); }
}
__device__ __forceinline__ void nsa_cmp1_item(const Ctx& C, int item) {
    const int kv = item >> 10, rt = (item >> 2) & 255, ng = item & 3;
    const int fr = C.lane & 15, q = C.lane >> 4;
    const int ri = rt * 16 + fr, b = ri >> 11, g = (ri >> 10) & 1, c = ri & 1023, cc = c < 1023 ? c : 1022;
    const bf16* arow = (const bf16*)(C.ws + WS_KVC) + (size_t)(b * SEQ + 16 * cc) * 256 + kv * 128 + g * 64 + 8 * q;
    const bf16* brow = (const bf16*)(C.ws + WS_CW1) + (size_t)kv * 256 * 2048 + (size_t)(ng * 64 + fr) * 2048 + 8 * q;
    f32x4 acc[4];
#pragma unroll
    for (int nt = 0; nt < 4; ++nt) acc[nt] = (f32x4){0.f, 0.f, 0.f, 0.f};
#pragma unroll 4
    for (int kk = 0; kk < 64; ++kk) {
        const bf16x8 a = *(const bf16x8*)(arow + (kk >> 1) * 256 + (kk & 1) * 32);
#pragma unroll
        for (int nt = 0; nt < 4; ++nt) { const bf16x8 bv = *(const bf16x8*)(brow + (size_t)nt * 16 * 2048 + kk * 32); acc[nt] = __builtin_amdgcn_mfma_f32_16x16x32_bf16(a, bv, acc[nt], 0, 0, 0); }
    }
    const float* cb1 = (const float*)(C.ws + WS_VEC) + VEC_CB1 + kv * 256;
    bf16* H1 = (bf16*)(C.ws + WS_CMPH) + (size_t)kv * 4096 * 256;
#pragma unroll
    for (int nt = 0; nt < 4; ++nt) { const int n = ng * 64 + nt * 16 + fr; const float bia = cb1[n];
#pragma unroll
        for (int r = 0; r < 4; ++r) H1[(size_t)(rt * 16 + 4 * q + r) * 256 + n] = (bf16)f2bf(gelu_tanh(acc[nt][r] + bia)); }
}
__device__ __forceinline__ void nsa_cmp2_item(const Ctx& C, int l, int item) {
    const int kv = item >> 8, rt = item & 255;
    const int fr = C.lane & 15, q = C.lane >> 4;
    const bf16* H1 = (const bf16*)(C.ws + WS_CMPH) + (size_t)kv * 4096 * 256 + (size_t)rt * 16 * 256;
    const bf16* W2 = (const bf16*)(C.ws + WS_CW2) + (size_t)kv * 64 * 256;
    f32x4 acc[4];
#pragma unroll
    for (int nt = 0; nt < 4; ++nt) { acc[nt] = (f32x4){0.f, 0.f, 0.f, 0.f}; acc[nt] = mma_tile<8>(H1, 256, W2 + nt * 16 * 256, 256, acc[nt], C.lane); }
    if (kv == 0) {
        const float* gn = C.in(11) + (size_t)l * 4 * 64 + 64;
        bf16* KC = (bf16*)(C.ws + WS_KCMP);
#pragma unroll
        for (int r = 0; r < 4; ++r) {
            float ss = 0.f;
#pragma unroll
            for (int nt = 0; nt < 4; ++nt) ss += acc[nt][r] * acc[nt][r];
            ss += __shfl_xor(ss, 1); ss += __shfl_xor(ss, 2); ss += __shfl_xor(ss, 4); ss += __shfl_xor(ss, 8);
            const float rinv = 1.0f / sqrtf(ss * (1.0f / 64.0f) + RMS_EPS);
            float y[4];
#pragma unroll
            for (int nt = 0; nt < 4; ++nt) y[nt] = acc[nt][r] * rinv * gn[nt * 16 + fr];
            const int ri = rt * 16 + 4 * q + r, c = ri & 1023; int pos = 16 * c + 31; pos = pos < SEQ ? pos : SEQ - 1;
            const f32x2* rr = (const f32x2*)(C.ws + WS_ROPE) + (size_t)pos * 32;
            const f32x2 c0 = rr[fr], c1 = rr[16 + fr];
            bf16* o = KC + (size_t)ri * 64;
            o[fr] = (bf16)f2bf(y[0] * c0.x - y[2] * c0.y); o[16 + fr] = (bf16)f2bf(y[1] * c1.x - y[3] * c1.y);
            o[32 + fr] = (bf16)f2bf(y[0] * c0.y + y[2] * c0.x); o[48 + fr] = (bf16)f2bf(y[1] * c1.y + y[3] * c1.x);
        }
    } else {
        bf16* VCT = (bf16*)(C.ws + WS_VCT);
        const int ri0 = rt * 16, bg = ri0 >> 10, c0 = (ri0 & 1023) + 4 * q;
#pragma unroll
        for (int nt = 0; nt < 4; ++nt) { const int d = nt * 16 + fr;
            *(v2u*)(VCT + (size_t)(bg * 64 + d) * 1024 + c0) = (v2u){pk2(acc[nt][0], acc[nt][1]), pk2(acc[nt][2], acc[nt][3])}; }
    }
}

constexpr int NU_IMP = 0;
constexpr int NU_SEL = 65536;
constexpr int NU_UM = 67584;
constexpr int NU_KV = 67840;
constexpr int NU_END = NU_KV + 2 * 18432;

struct AttnState { float m, l; f32x4 o[4]; };
constexpr int NCT = 1, NQ = 32 * NCT;

__device__ __forceinline__ void nsa_stage(const Ctx& C, int buf, const bf16* krows, int kld, const bf16* vt_tile, int vld) {
    LAS bf16* KT = (LAS bf16*)(C.lds + NU_KV + buf * 18432); LAS bf16* VT = KT + 64 * 72;
    const int r = C.tid >> 3, ch = C.tid & 7;
    const v4u kx = *(const v4u*)(krows + (size_t)r * kld + ch * 8);
    const v4u vx = *(const v4u*)(vt_tile + (size_t)r * vld + ch * 8);
    *(LAS v4u*)(KT + r * 72 + ch * 8) = kx;
    *(LAS v4u*)(VT + r * 72 + ch * 8) = vx;
}
__device__ __forceinline__ void nsa_scores(const Ctx& C, int buf, const bf16x8 (&qf)[2], f32x4 (&s)[4]) {
    const LAS bf16* KT = (const LAS bf16*)(C.lds + NU_KV + buf * 18432);
    const int fr = C.lane & 15, q = C.lane >> 4;
#pragma unroll
    for (int kt = 0; kt < 4; ++kt) { s[kt] = (f32x4){0.f, 0.f, 0.f, 0.f};
#pragma unroll
        for (int ks = 0; ks < 2; ++ks) { const bf16x8 a = *(const LAS bf16x8*)(KT + (16 * kt + fr) * 72 + ks * 32 + 8 * q); s[kt] = __builtin_amdgcn_mfma_f32_16x16x32_bf16(a, qf[ks], s[kt], 0, 0, 0); } }
}
__device__ __forceinline__ void nsa_pv(const Ctx& C, int buf, const f32x4 (&p)[4], f32x4 (&o)[4]) {
    const LAS bf16* VT = (const LAS bf16*)(C.lds + NU_KV + buf * 18432) + 64 * 72;
    const int fr = C.lane & 15, q = C.lane >> 4;
    bf16x8 pf[2];
#pragma unroll
    for (int k2 = 0; k2 < 2; ++k2) { v4u w; w.x = pk2(p[2 * k2][0], p[2 * k2][1]); w.y = pk2(p[2 * k2][2], p[2 * k2][3]); w.z = pk2(p[2 * k2 + 1][0], p[2 * k2 + 1][1]); w.w = pk2(p[2 * k2 + 1][2], p[2 * k2 + 1][3]);
        pf[k2] = __builtin_bit_cast(bf16x8, w); }
#pragma unroll
    for (int dt = 0; dt < 4; ++dt)
#pragma unroll
        for (int k2 = 0; k2 < 2; ++k2) {
            const LAS bf16* vr = VT + (16 * dt + fr) * 72 + 32 * k2 + 4 * q;
            const v2u lo = *(const LAS v2u*)vr, hi = *(const LAS v2u*)(vr + 16);
            const v4u aw = (v4u){lo.x, lo.y, hi.x, hi.y};
            o[dt] = __builtin_amdgcn_mfma_f32_16x16x32_bf16(__builtin_bit_cast(bf16x8, aw), pf[k2], o[dt], 0, 0, 0);
        }
}
__device__ __forceinline__ void nsa_online(const Ctx& C, int buf, f32x4 (&s)[4], AttnState& st) {
    float mx = -INFINITY;
#pragma unroll
    for (int kt = 0; kt < 4; ++kt)
#pragma unroll
        for (int r = 0; r < 4; ++r) mx = fmaxf(mx, s[kt][r]);
    mx = fmaxf(mx, __shfl_xor(mx, 16)); mx = fmaxf(mx, __shfl_xor(mx, 32));
    const float mn = fmaxf(st.m, mx);
    const float msafe = (mn == -INFINITY) ? 0.f : mn;
    const float alpha = fexp(st.m - msafe);
    float ps = 0.f;
#pragma unroll
    for (int kt = 0; kt < 4; ++kt)
#pragma unroll
        for (int r = 0; r < 4; ++r) { const float p = fexp(s[kt][r] - msafe); s[kt][r] = p; ps += p; }
    st.l = st.l * alpha + ps; st.m = mn;
#pragma unroll
    for (int dt = 0; dt < 4; ++dt) st.o[dt] *= alpha;
    nsa_pv(C, buf, s, st.o);
}

__device__ __forceinline__ void nsa_attn_unit(const Ctx& C, int u) {
    const int half = u & 1, uu = u >> 1;
    const int bg = uu & 3, b = bg >> 1, g = bg & 1;
    int qb; { const int rnd = uu >> 8, j = (uu >> 2) & 63; qb = rnd == 0 ? 255 - j : rnd == 1 ? 128 + j : rnd == 2 ? 127 - j : j; }
    const int q0 = 32 * half;
    const int t0 = b * SEQ + qb * 64;
    const int fr = C.lane & 15, q = C.lane >> 4, qq = fr >> 2, hh = fr & 3;
    LAS float* IMP = (LAS float*)(C.lds + NU_IMP);
    LAS unsigned long long* SEL = (LAS unsigned long long*)(C.lds + NU_SEL);
    LAS unsigned long long* UM = (LAS unsigned long long*)(C.lds + NU_UM);
    for (int i = C.tid; i < NQ * 256; i += NTHR) IMP[i] = 0.f;
    bf16* QB = (bf16*)(C.ws + WS_QB);
    bf16x8 qf[NCT][2]; float gate[NCT][3]; int iq[NCT];
#pragma unroll
    for (int ct = 0; ct < NCT; ++ct) { iq[ct] = q0 + 4 * NCT * C.wave + 4 * ct + qq;
        const bf16* qp = QB + (size_t)(t0 + iq[ct]) * 512 + (g * 4 + hh) * 64 + 8 * q;
        qf[ct][0] = *(const bf16x8*)qp; qf[ct][1] = *(const bf16x8*)(qp + 32);
        const float* sm = (const float*)(C.ws + WS_SMALL) + (size_t)(t0 + iq[ct]) * 64 + 16 + (g * 4 + hh) * 3;
#pragma unroll
        for (int k = 0; k < 3; ++k) gate[ct][k] = ((ABL_ZERO & 2) || (ABL_ZERO & (8 << k))) ? 0.f : SCL_B * sigmoidf_(sm[k]); }
    f32x4 out[NCT][4];
#pragma unroll
    for (int ct = 0; ct < NCT; ++ct)
#pragma unroll
        for (int dt = 0; dt < 4; ++dt) out[ct][dt] = (f32x4){0.f, 0.f, 0.f, 0.f};

    const bf16* KC = (const bf16*)(C.ws + WS_KCMP) + (size_t)bg * 1024 * 64;
    const bf16* VCT = (const bf16*)(C.ws + WS_VCT) + (size_t)bg * 64 * 1024;
    const int nct = (4 * qb + 3 + 63) >> 6;
    int cmax[NCT];
#pragma unroll
    for (int ct = 0; ct < NCT; ++ct) cmax[ct] = (64 * qb + iq[ct] - 31) >> 4;
    float cm[NCT], cl[NCT];
#pragma unroll
    for (int ct = 0; ct < NCT; ++ct) { cm[ct] = -INFINITY; cl[ct] = 0.f; }
    __syncthreads();
    for (int pass = 0; pass < 2; ++pass) {
        float cinv[NCT];
        if (pass == 1) {
#pragma unroll
            for (int ct = 0; ct < NCT; ++ct) { float lt = cl[ct]; lt += __shfl_xor(lt, 16); lt += __shfl_xor(lt, 32); cinv[ct] = lt > 0.f ? 1.0f / lt : 0.f; if (cm[ct] == -INFINITY) cm[ct] = 0.f; }
        }
        AttnState ac[NCT];
#pragma unroll
        for (int ct = 0; ct < NCT; ++ct) { ac[ct].m = 0.f; ac[ct].l = 0.f;
#pragma unroll
            for (int dt = 0; dt < 4; ++dt) ac[ct].o[dt] = (f32x4){0.f, 0.f, 0.f, 0.f}; }
        for (int tl = 0; tl < nct; ++tl) {
            const int buf = tl & 1;
            nsa_stage(C, buf, KC + (size_t)tl * 64 * 64, 64, VCT + tl * 64, 1024);
            __syncthreads();
#pragma unroll
            for (int ct = 0; ct < NCT; ++ct) {
                f32x4 s[4]; nsa_scores(C, buf, qf[ct], s);
#pragma unroll
                for (int kt = 0; kt < 4; ++kt)
#pragma unroll
                    for (int r = 0; r < 4; ++r) { const int c = 64 * tl + 16 * kt + 4 * q + r; if (c > cmax[ct]) s[kt][r] = -INFINITY; }
                if (pass == 0) {
                    float mx = -INFINITY;
#pragma unroll
                    for (int kt = 0; kt < 4; ++kt)
#pragma unroll
                        for (int r = 0; r < 4; ++r) mx = fmaxf(mx, s[kt][r]);
                    mx = fmaxf(mx, __shfl_xor(mx, 16)); mx = fmaxf(mx, __shfl_xor(mx, 32));
                    const float mn = fmaxf(cm[ct], mx); const float msafe = (mn == -INFINITY) ? 0.f : mn;
                    float ps = 0.f;
#pragma unroll
                    for (int kt = 0; kt < 4; ++kt)
#pragma unroll
                        for (int r = 0; r < 4; ++r) ps += fexp(s[kt][r] - msafe);
                    cl[ct] = cl[ct] * fexp(cm[ct] - msafe) + ps; cm[ct] = mn;
                } else {
#pragma unroll
                    for (int kt = 0; kt < 4; ++kt) {
#pragma unroll
                        for (int r = 0; r < 4; ++r) s[kt][r] = fexp(s[kt][r] - cm[ct]) * cinv[ct];
                        float gs = (s[kt][0] + s[kt][1]) + (s[kt][2] + s[kt][3]), es = s[kt][3];
                        gs += __shfl_xor(gs, 1); gs += __shfl_xor(gs, 2); es += __shfl_xor(es, 1); es += __shfl_xor(es, 2);
                        if (hh == 0) { const int n = 16 * tl + 4 * kt + q;
                            if (n < 256) { atomicAdd((float*)(IMP + (iq[ct] - q0) * 256 + n), gs); if (n + 1 < 256) atomicAdd((float*)(IMP + (iq[ct] - q0) * 256 + n + 1), es); } }
                    }
                    nsa_pv(C, buf, s, ac[ct].o);
                }
            }
        }
        if (pass == 1) {
#pragma unroll
            for (int ct = 0; ct < NCT; ++ct)
#pragma unroll
                for (int dt = 0; dt < 4; ++dt) out[ct][dt] += ac[ct].o[dt] * gate[ct][0];
        }
        __syncthreads();
    }

    for (int k8 = 0; k8 < 4 * NCT; ++k8) {
        const int i = 4 * NCT * C.wave + k8;
        float v[4]; unsigned long long selw[4] = {0ull, 0ull, 0ull, 0ull};
        int ncand = 0;
#pragma unroll
        for (int k = 0; k < 4; ++k) { const int n = C.lane + 64 * k; const bool valid = n <= qb; const bool forced = valid && (n == 0 || n == qb || n == qb - 1);
            v[k] = (valid && !forced) ? IMP[i * 256 + n] : -INFINITY;
            selw[k] = __ballot(forced); }
        const int nforced = qb >= 2 ? 3 : qb + 1; ncand = qb + 1 - nforced;
        int need = 16 - nforced; if (need > ncand) need = ncand;
        if (need == ncand) {
#pragma unroll
            for (int k = 0; k < 4; ++k) selw[k] |= __ballot(v[k] != -INFINITY);
        } else {
            for (int it = 0; it < need; ++it) {
                float bv = v[0]; int bn = C.lane;
#pragma unroll
                for (int k = 1; k < 4; ++k) if (v[k] > bv) { bv = v[k]; bn = C.lane + 64 * k; }
#pragma unroll
                for (int o = 1; o < 64; o <<= 1) { const float ov = __shfl_xor(bv, o); const int on = __shfl_xor(bn, o); if (ov > bv || (ov == bv && on < bn)) { bv = ov; bn = on; } }
#pragma unroll
                for (int k = 0; k < 4; ++k) { if (bn == C.lane + 64 * k) v[k] = -INFINITY; if ((bn >> 6) == k) selw[k] |= 1ull << (bn & 63); }
            }
        }
        if (C.lane < 4) SEL[i * 4 + C.lane] = C.lane == 0 ? selw[0] : C.lane == 1 ? selw[1] : C.lane == 2 ? selw[2] : selw[3];
    }
    __syncthreads();
    if (C.tid < 4) { unsigned long long um = 0ull; for (int i = 0; i < NQ; ++i) um |= SEL[i * 4 + C.tid]; UM[C.tid] = um; }
    __syncthreads();

    {
        AttnState as[NCT];
#pragma unroll
        for (int ct = 0; ct < NCT; ++ct) { as[ct].m = -INFINITY; as[ct].l = 0.f;
#pragma unroll
            for (int dt = 0; dt < 4; ++dt) as[ct].o[dt] = (f32x4){0.f, 0.f, 0.f, 0.f}; }
        const bf16* KS = (const bf16*)(C.ws + WS_KVS) + (size_t)(b * SEQ) * 256 + g * 64;
        const bf16* VST = (const bf16*)(C.ws + WS_VST) + (size_t)bg * 256 * 4096;
        int buf = 0;
        for (int n = 0; n <= qb; ++n) {
            if (!((UM[n >> 6] >> (n & 63)) & 1ull)) continue;
            nsa_stage(C, buf, KS + (size_t)n * 64 * 256, 256, VST + (size_t)n * 4096, 64);
            __syncthreads();
#pragma unroll
            for (int ct = 0; ct < NCT; ++ct) {
                const bool mysel = (SEL[(iq[ct] - q0) * 4 + (n >> 6)] >> (n & 63)) & 1ull;
                if (__ballot(mysel) == 0ull) continue;
                f32x4 s[4]; nsa_scores(C, buf, qf[ct], s);
#pragma unroll
                for (int kt = 0; kt < 4; ++kt)
#pragma unroll
                    for (int r = 0; r < 4; ++r) { const int key = 16 * kt + 4 * q + r; if (!mysel || (n == qb && key > iq[ct])) s[kt][r] = -INFINITY; }
                nsa_online(C, buf, s, as[ct]);
            }
            buf ^= 1;
        }
#pragma unroll
        for (int ct = 0; ct < NCT; ++ct) { float lt = as[ct].l; lt += __shfl_xor(lt, 16); lt += __shfl_xor(lt, 32); const float inv = lt > 0.f ? gate[ct][1] / lt : 0.f;
#pragma unroll
            for (int dt = 0; dt < 4; ++dt) out[ct][dt] += as[ct].o[dt] * inv; }
        __syncthreads();
    }
    {
        AttnState aw[NCT];
#pragma unroll
        for (int ct = 0; ct < NCT; ++ct) { aw[ct].m = -INFINITY; aw[ct].l = 0.f;
#pragma unroll
            for (int dt = 0; dt < 4; ++dt) aw[ct].o[dt] = (f32x4){0.f, 0.f, 0.f, 0.f}; }
        const bf16* KW = (const bf16*)(C.ws + WS_KVW) + (size_t)(b * SEQ) * 256 + g * 64;
        const bf16* VWT = (const bf16*)(C.ws + WS_VWT) + (size_t)bg * 256 * 4096;
        int buf = 0;
        for (int n = (qb >= 8 ? qb - 8 : 0); n <= qb; ++n) {
            const int delta = qb - n;
            nsa_stage(C, buf, KW + (size_t)n * 64 * 256, 256, VWT + (size_t)n * 4096, 64);
            __syncthreads();
#pragma unroll
            for (int ct = 0; ct < NCT; ++ct) {
                f32x4 s[4]; nsa_scores(C, buf, qf[ct], s);
                if (delta == 0 || delta == 8) {
#pragma unroll
                    for (int kt = 0; kt < 4; ++kt)
#pragma unroll
                        for (int r = 0; r < 4; ++r) { const int key = 16 * kt + 4 * q + r; const bool ok = delta == 0 ? (key <= iq[ct]) : (key > iq[ct]); if (!ok) s[kt][r] = -INFINITY; }
                }
                nsa_online(C, buf, s, aw[ct]);
            }
            buf ^= 1;
        }
#pragma unroll
        for (int ct = 0; ct < NCT; ++ct) { float lt = aw[ct].l; lt += __shfl_xor(lt, 16); lt += __shfl_xor(lt, 32); const float inv = lt > 0.f ? gate[ct][2] / lt : 0.f;
#pragma unroll
            for (int dt = 0; dt < 4; ++dt) out[ct][dt] += aw[ct].o[dt] * inv; }
    }
#pragma unroll
    for (int ct = 0; ct < NCT; ++ct) { bf16* op = QB + (size_t)(t0 + iq[ct]) * 512 + (g * 4 + hh) * 64 + 4 * q;
#pragma unroll
        for (int dt = 0; dt < 4; ++dt) *(v2u*)(op + 16 * dt) = (v2u){pk2(out[ct][dt][0], out[ct][dt][1]), pk2(out[ct][dt][2], out[ct][dt][3])}; }
    __syncthreads();
}

#ifndef NAIVE_GLA
#define NAIVE_GLA 0
#endif
#ifndef NAIVE_MLSTM
#define NAIVE_MLSTM 0
#endif
__device__ __forceinline__ void naive_gla(const Ctx& C, int l, int bh) {
    const int bb = bh >> 2, h = bh & 3, dk = C.lane, g = C.wave;
    LAS float* SS = (LAS float*)(C.lds);
    const bf16* QKA = (const bf16*)(C.ws + WS_QKA); const bf16* VA = (const bf16*)(C.ws + WS_VA); bf16* RA = (bf16*)(C.ws + WS_RA);
    const float* SMALL = (const float*)(C.ws + WS_SMALL);
    float w[16]; const float* wa = C.in(8) + (size_t)l * 16 * 256 + h * 64 + dk;
    for (int r = 0; r < 16; ++r) w[r] = wa[r * 256];
    const float ba = C.in(9)[(size_t)l * 256 + h * 64 + dk];
    const float* gn = C.in(10) + (size_t)l * 128 + 16 * g;
    float S[16];
    for (int e = 0; e < 16; ++e) S[e] = 0.f;
    for (int s = 0; s < SEQ; ++s) {
        const size_t t = (size_t)bb * SEQ + s;
        float x = ba;
        for (int r = 0; r < 16; ++r) x += SMALL[t * 64 + r] * w[r];
        const float al = __expf(logsigmoidf_(x) * (1.0f / 16.0f));
        const float q = bf2f(QKA[t * 512 + h * 64 + dk]) * 0.125f, k = bf2f(QKA[t * 512 + 256 + h * 64 + dk]);
        float o[16]; float ss = 0.f;
        for (int e = 0; e < 16; ++e) { const float v = bf2f(VA[t * 512 + h * 128 + 16 * g + e]); S[e] = al * S[e] + k * v; o[e] = wave_sum(q * S[e]); ss += o[e] * o[e]; }
        if (C.lane == 0) SS[(s & 1) * 8 + g] = ss;
        __syncthreads();
        float tot = 0.f;
        for (int w8 = 0; w8 < 8; ++w8) tot += SS[(s & 1) * 8 + w8];
        const float rinv = 1.0f / sqrtf(tot * (1.0f / 128.0f) + RMS_EPS);
        float mine = 0.f;
        for (int e = 0; e < 16; ++e) if (C.lane == e) mine = o[e];
        if (C.lane < 16) { bf16* p = RA + t * 512 + h * 128 + 16 * g + C.lane; const float r = bf2f(*p); *p = (bf16)f2bf(mine * rinv * gn[C.lane] * siluf_(r)); }
    }
    __syncthreads();
}
__device__ __forceinline__ void naive_mlstm(const Ctx& C, int l, int bh) {
    const int bb = bh >> 2, h = bh & 3, dk = C.lane, g = C.wave;
    const bf16* X = (const bf16*)(C.ws + WS_QKC); const bf16* VC = (const bf16*)(C.ws + WS_VC); bf16* OC = (bf16*)(C.ws + WS_OC);
    const float* SMALL = (const float*)(C.ws + WS_SMALL);
    const int chq = h * 64 + dk, chk = 256 + h * 64 + dk;
    const float* cw = C.in(15) + (size_t)l * 4 * 512; const float* cb = C.in(16) + (size_t)l * 512;
    float wq[4], wk[4];
    for (int i = 0; i < 4; ++i) { wq[i] = cw[i * 512 + chq]; wk[i] = cw[i * 512 + chk]; }
    const float bq = cb[chq], bk = cb[chk];
    float Cm[16]; for (int e = 0; e < 16; ++e) Cm[e] = 0.f;
    float n = 0.f, m = 0.f;
    float xq[4] = {0.f, 0.f, 0.f, 0.f}, xk[4] = {0.f, 0.f, 0.f, 0.f};
    for (int s = 0; s < SEQ; ++s) {
        const size_t t = (size_t)bb * SEQ + s;
        xq[0] = xq[1]; xq[1] = xq[2]; xq[2] = xq[3]; xq[3] = bf2f(X[t * 512 + chq]);
        xk[0] = xk[1]; xk[1] = xk[2]; xk[2] = xk[3]; xk[3] = bf2f(X[t * 512 + chk]);
        const float q = siluf_(bq + wq[0] * xq[0] + wq[1] * xq[1] + wq[2] * xq[2] + wq[3] * xq[3]);
        const float k = siluf_(bk + wk[0] * xk[0] + wk[1] * xk[1] + wk[2] * xk[2] + wk[3] * xk[3]) * 0.125f;
        const float ip = SMALL[t * 64 + 40 + h], lf = logsigmoidf_(SMALL[t * 64 + 44 + h]);
        const float mn = fmaxf(lf + m, ip);
        const float fd = __expf(lf + m - mn), ig = __expf(ip - mn);
        n = fd * n + ig * k;
        const float den = wave_sum(q * n);
        const float dinv = 1.0f / fmaxf(fabsf(den), __expf(-mn));
        float mine = 0.f;
        for (int e = 0; e < 16; ++e) { const float v = bf2f(VC[t * 512 + h * 128 + 16 * g + e]); Cm[e] = fd * Cm[e] + ig * k * v; const float num = wave_sum(q * Cm[e]); if (C.lane == e) mine = num; }
        m = mn;
        if (C.lane < 16) { bf16* p = OC + t * 512 + h * 128 + 16 * g + C.lane; const float og = bf2f(*p); *p = (bf16)f2bf(mine * dinv * sigmoidf_(og)); }
    }
}
#ifndef NAIVE_WIN
#define NAIVE_WIN 0
#endif
__device__ __forceinline__ void naive_win_store(const Ctx& C, size_t t, int col, float z) {
    unsigned char* ws = C.ws;
    int c = col;
    if (c < 256) { ((bf16*)(ws + WS_QKA))[t * 512 + c] = (bf16)f2bf(z); return; } c -= 256;
    if (c < 256) { ((bf16*)(ws + WS_QKA))[t * 512 + 256 + c] = (bf16)f2bf(z); return; } c -= 256;
    if (c < 512) { ((bf16*)(ws + WS_VA))[t * 512 + c] = (bf16)f2bf(z); return; } c -= 512;
    if (c < 512) { ((bf16*)(ws + WS_RA))[t * 512 + c] = (bf16)f2bf(z); return; } c -= 512;
    if (c < 16) { ((float*)(ws + WS_SMALL))[t * 64 + c] = z; return; } c -= 16;
    if (c < 512) { ((bf16*)(ws + WS_QB))[t * 512 + c] = (bf16)f2bf(z); return; } c -= 512;
    if (c < 128) { ((bf16*)(ws + WS_KVC))[t * 256 + c] = (bf16)f2bf(z); return; } c -= 128;
    if (c < 128) { ((bf16*)(ws + WS_KVC))[t * 256 + 128 + c] = (bf16)f2bf(z); return; } c -= 128;
    if (c < 128) { ((bf16*)(ws + WS_KVS))[t * 256 + c] = (bf16)f2bf(z); return; } c -= 128;
    if (c < 128) { ((bf16*)(ws + WS_KVS))[t * 256 + 128 + c] = (bf16)f2bf(z); return; } c -= 128;
    if (c < 128) { ((bf16*)(ws + WS_KVW))[t * 256 + c] = (bf16)f2bf(z); return; } c -= 128;
    if (c < 128) { ((bf16*)(ws + WS_KVW))[t * 256 + 128 + c] = (bf16)f2bf(z); return; } c -= 128;
    if (c < 24) { ((float*)(ws + WS_SMALL))[t * 64 + 16 + c] = z; return; } c -= 24;
    if (c < 512) { ((bf16*)(ws + WS_QKC))[t * 512 + c] = (bf16)f2bf(z); return; } c -= 512;
    if (c < 512) { ((bf16*)(ws + WS_VC))[t * 512 + c] = (bf16)f2bf(z); return; } c -= 512;
    if (c < 512) { ((bf16*)(ws + WS_OC))[t * 512 + c] = (bf16)f2bf(z); return; } c -= 512;
    if (c < 4) { ((float*)(ws + WS_SMALL))[t * 64 + 40 + c] = z; return; } c -= 4;
    if (c < 4) { ((float*)(ws + WS_SMALL))[t * 64 + 44 + c] = z; return; }
}
__device__ __forceinline__ void naive_win(const Ctx& C, int l) {
    LAS float* xs = (LAS float*)C.lds;
    const float* gain = C.in(5) + (size_t)l * DM; const float* W = C.in(6) + (size_t)l * DM * N_IN; const float* bin = C.in(7) + (size_t)l * N_IN;
    for (int tile = C.bid; tile < T / 8; tile += C.G) {
        __syncthreads();
        {
            const size_t t = (size_t)tile * 8 + C.wave; const float* xr = C.X + t * DM;
            float v[16]; float s = 0.f;
            for (int j = 0; j < 16; ++j) { v[j] = xr[C.lane + 64 * j]; s += v[j] * v[j]; }
            const float r = 1.0f / sqrtf(wave_sum(s) * (1.f / DM) + RMS_EPS);
            for (int j = 0; j < 16; ++j) xs[C.wave * 1024 + C.lane + 64 * j] = v[j] * r * gain[C.lane + 64 * j];
        }
        __syncthreads();
        for (int col = C.tid; col < 4400; col += NTHR) {
            float acc[8]; for (int i = 0; i < 8; ++i) acc[i] = 0.f;
            for (int k = 0; k < DM; ++k) { const float w = W[(size_t)k * N_IN + col];
                for (int i = 0; i < 8; ++i) acc[i] += xs[i * 1024 + k] * w; }
            const float bb = bin[col];
            for (int i = 0; i < 8; ++i) naive_win_store(C, (size_t)tile * 8 + i, col, acc[i] + bb);
        }
    }
    __syncthreads();
}
#ifndef NAIVE_MERGE
#define NAIVE_MERGE 0
#endif
__device__ __forceinline__ void naive_merge(const Ctx& C, int l) {
    LAS float* xs = (LAS float*)C.lds;
    LAS float* os = xs + 8 * 1024;
    const float* gain = C.in(5) + (size_t)l * DM; const float* W = C.in(6) + (size_t)l * DM * N_IN; const float* bin = C.in(7) + (size_t)l * N_IN;
    const float* WB = C.in(17) + (size_t)l * 3 * 512 * DM;
    bf16* Y = (bf16*)(C.ws + WS_Y);
    for (int tile = C.bid; tile < T / 8; tile += C.G) {
        __syncthreads();
        {
            const size_t t = (size_t)tile * 8 + C.wave; const float* xr = C.X + t * DM;
            float v[16]; float s = 0.f;
            for (int j = 0; j < 16; ++j) { v[j] = xr[C.lane + 64 * j]; s += v[j] * v[j]; }
            const float r = 1.0f / sqrtf(wave_sum(s) * (1.f / DM) + RMS_EPS);
            for (int j = 0; j < 16; ++j) xs[C.wave * 1024 + C.lane + 64 * j] = v[j] * r * gain[C.lane + 64 * j];
            for (int i = 0; i < 3; ++i) { const bf16* src = (const bf16*)(C.ws + (i == 0 ? WS_RA : i == 1 ? WS_QB : WS_OC)) + t * 512;
                for (int j = 0; j < 8; ++j) os[(i * 8 + C.wave) * 512 + C.lane + 64 * j] = bf2f(src[C.lane + 64 * j]); }
        }
        __syncthreads();
        for (int c = C.tid; c < DM; c += NTHR) {
            float y[8]; for (int i = 0; i < 8; ++i) y[i] = 0.f;
            for (int br = 0; br < 3; ++br) {
                float ga[8], pa[8]; for (int i = 0; i < 8; ++i) { ga[i] = 0.f; pa[i] = 0.f; }
                const int gc = 4400 + br * DM + c;
                for (int k = 0; k < DM; ++k) { const float w = W[(size_t)k * N_IN + gc]; for (int i = 0; i < 8; ++i) ga[i] += xs[i * 1024 + k] * w; }
                for (int j = 0; j < 512; ++j) { const float w = WB[((size_t)br * 512 + j) * DM + c]; for (int i = 0; i < 8; ++i) pa[i] += os[(br * 8 + i) * 512 + j] * w; }
                const float bb = bin[gc];
                for (int i = 0; i < 8; ++i) y[i] += sigmoidf_(ga[i] + bb) * pa[i];
            }
            for (int i = 0; i < 8; ++i) Y[((size_t)tile * 8 + i) * DM + c] = (bf16)f2bf(y[i]);
        }
    }
    __syncthreads();
}
__device__ __forceinline__ void naive_gate(const Ctx& C, int l, int br) {
    LAS float* xs = (LAS float*)C.lds;
    const float* gain = C.in(5) + (size_t)l * DM; const float* W = C.in(6) + (size_t)l * DM * N_IN; const float* bin = C.in(7) + (size_t)l * N_IN;
    bf16* G = (bf16*)(C.ws + WS_G);
    for (int tile = C.bid; tile < T / 8; tile += C.G) {
        __syncthreads();
        {
            const size_t t = (size_t)tile * 8 + C.wave; const float* xr = C.X + t * DM;
            float v[16]; float s = 0.f;
            for (int j = 0; j < 16; ++j) { v[j] = xr[C.lane + 64 * j]; s += v[j] * v[j]; }
            const float r = 1.0f / sqrtf(wave_sum(s) * (1.f / DM) + RMS_EPS);
            for (int j = 0; j < 16; ++j) xs[C.wave * 1024 + C.lane + 64 * j] = v[j] * r * gain[C.lane + 64 * j];
            if (NAIVE_MERGE == 4) { const bf16* xn = (const bf16*)(C.ws + WS_XN) + t * DM; for (int j = 0; j < 16; ++j) xs[C.wave * 1024 + C.lane + 64 * j] = bf2f(xn[C.lane + 64 * j]); }
        }
        __syncthreads();
        for (int c = C.tid; c < DM; c += NTHR) {
            float ga[8]; for (int i = 0; i < 8; ++i) ga[i] = 0.f;
            const int gc = 4400 + br * DM + c;
            const bf16* WGTb = (const bf16*)(C.ws + WS_WGT) + ((size_t)br * DM + c) * DM;
            for (int k = 0; k < DM; ++k) { const float w = (NAIVE_MERGE >= 3) ? bf2f(WGTb[k]) : W[(size_t)k * N_IN + gc]; for (int i = 0; i < 8; ++i) ga[i] += xs[i * 1024 + k] * w; }
            const float bb = bin[gc];
            for (int i = 0; i < 8; ++i) G[((size_t)tile * 8 + i) * DM + c] = (bf16)f2bf(sigmoidf_(ga[i] + bb));
        }
    }
    __syncthreads();
}

__device__ __forceinline__ void phase_mix1(const Ctx& C, int l) {
    const int gw = C.bid * NWAVES + C.wave, NGW = C.G * NWAVES;
    for (int it = gw; it < 2048; it += NGW) nsa_cmp1_item(C, it);
    for (int it = gw; it < 2048; it += NGW) nsa_vtrans_item(C, it);
    for (int t = gw; t < T; t += NGW) nsa_prep_token(C, l, t);
    __syncthreads();
    for (int u = C.bid; u < 4096; u += C.G) { if (u < 2048) { if (!NAIVE_GLA) gla_unit_a(C, l, u); } else { if (!NAIVE_MLSTM) mlstm_unit_a(C, l, u - 2048); } }
}
__device__ __forceinline__ void phase_mix2(const Ctx& C, int l) {
    const int gw = C.bid * NWAVES + C.wave, NGW = C.G * NWAVES;
    for (int it = gw; it < 512; it += NGW) nsa_cmp2_item(C, l, it);
    phase_scan(C);
}
__device__ __forceinline__ void phase_mix3(const Ctx& C, int l) {
    for (int u = C.bid; u < 2048; u += C.G) nsa_attn_unit(C, u);
    for (int u = C.bid; u < 4096; u += C.G) { if (u < 2048) { if (!NAIVE_GLA) gla_unit_c(C, l, u); } else { if (!NAIVE_MLSTM) mlstm_unit_c(C, l, u - 2048); } }
    if (NAIVE_GLA && C.bid < 8) naive_gla(C, l, C.bid);
    if (NAIVE_MLSTM && C.bid >= 8 && C.bid < 16) naive_mlstm(C, l, C.bid - 8);
}

constexpr int MIX_PHASES = 12;
#define MIXER_PHASES \
    if (PH_ON) phase_norm(C, C.in(5) + (size_t)l * DM); \
    PH_END; \
    if (PH_ON) { \
        pg8::Gemm g{(const bf16*)(C.ws + WS_XN), (const bf16*)(C.ws + WS_WIN), T, 4608, DM}; \
        pg8::StaticOrder S; S.init(T, 4608, C.G, C.bid); \
        pg8::EpiWin E{C.ws + WS_R, (const float*)(C.ws + WS_VEC) + VEC_BINP, (float*)(C.ws + WS_SMALL)}; \
        pg8::gemm_phase<pg8::EpiWin, pg8::StaticOrder, false>(C.lds, g, S, E, nullptr); \
        if (NAIVE_WIN) { __syncthreads(); naive_win(C, l); } \
    } \
    PH_END; \
    if (PH_ON) phase_mix1(C, l); \
    PH_END; \
    if (PH_ON) phase_mix2(C, l); \
    PH_END; \
    if (PH_ON) phase_mix3(C, l); \
    PH_END; \
    for (int br = 0; br < 3; ++br) { \
        if (PH_ON) { \
            pg8::Gemm g{(const bf16*)(C.ws + WS_XN), (const bf16*)(C.ws + WS_WGT) + (size_t)br * DM * DM, T, DM, DM}; \
            pg8::StaticOrder S; S.init(T, DM, C.G, C.bid); \
            pg8::EpiGate E{(bf16*)(C.ws + WS_G), DM, C.in(7) + (size_t)l * N_IN + 4400 + br * DM}; \
            pg8::gemm_phase<pg8::EpiGate, pg8::StaticOrder, false>(C.lds, g, S, E, nullptr); \
            if (NAIVE_MERGE >= 2) { __syncthreads(); naive_gate(C, l, br); } \
        } \
        PH_END; \
        if (PH_ON) { \
            const bf16* Asrc = (const bf16*)(C.ws + (br == 0 ? WS_RA : br == 1 ? WS_QB : WS_OC)); \
            pg8::Gemm g{Asrc, (const bf16*)(C.ws + WS_WBR) + (size_t)br * DM * 512, T, DM, 512}; \
            pg8::StaticOrder S; S.init(T, DM, C.G, C.bid); \
            pg8::EpiBranch E{(bf16*)(C.ws + WS_Y), (const bf16*)(C.ws + WS_G), DM, br == 0 ? 1 : 0}; \
            pg8::gemm_phase<pg8::EpiBranch, pg8::StaticOrder, false>(C.lds, g, S, E, nullptr); \
            if (NAIVE_MERGE == 1 && br == 2) { __syncthreads(); naive_merge(C, l); } \
        } \
        PH_END; \
    } \
    if (PH_ON) { \
        pg8::Gemm g{(const bf16*)(C.ws + WS_Y), (const bf16*)(C.ws + WS_WOUT), T, DM, DM}; \
        pg8::StaticOrder S; S.init(T, DM, C.G, C.bid); \
        pg8::EpiResid E{C.X, DM, 1.0f}; \
        pg8::gemm_phase<pg8::EpiResid, pg8::StaticOrder, false>(C.lds, g, S, E, nullptr); \
    } \
    PH_END;

constexpr int N_PHASES = 1 + 8 * 3 + 4 * MIX_PHASES;

__global__ void __launch_bounds__(NTHR, 2) hybrid_fwd(Args args) {
    extern __shared__ __attribute__((aligned(16))) unsigned char lds_raw[];
    Ctx C;
    C.lds = (LAS unsigned char*)lds_raw;
    C.tid = threadIdx.x; C.lane = C.tid & 63; C.wave = __builtin_amdgcn_readfirstlane(C.tid >> 6);
    C.G = gridDim.x; C.bid = blockIdx.x;
    C.inp = (const GAS float* const __attribute__((address_space(4)))*)__builtin_amdgcn_kernarg_segment_ptr();
    C.X = args.out; C.ws = args.ws;
    volatile LAS unsigned* MISC = (volatile LAS unsigned*)(C.lds + MISC_OFF);
    for (int u = C.tid; u < (LDS_BYTES - RING_BYTES) / 4; u += NTHR) ((LAS unsigned*)(C.lds + RING_BYTES))[u] = 0u;
    __syncthreads();
    __builtin_amdgcn_fence(__ATOMIC_ACQUIRE, "agent"); asm volatile("s_waitcnt vmcnt(0)" ::: "memory");
    __syncthreads();
    const int lo = args.ph_lo, hi = args.ph_hi;
    XcdBarrier bar; bar.bar = (unsigned*)(C.ws + WS_CTL) + 4096; bar.x = 0; bar.st = nullptr;
    if (hi - lo > 1) bar = xcd_barrier_post((unsigned*)(C.ws + WS_CTL) + 4096, MISC + 8);
    int pc = 0;
#define PH_ON (C.launder(), pc >= lo && pc < hi)
#define PH_END do { if (pc >= lo && pc + 1 < hi) xcd_barrier(bar); ++pc; } while (0)

    if (PH_ON) phase_init(C);
    PH_END;

    for (int step = 0; step < 2 * NLAYER; ++step) {
        const int l = step >> 1, f = step & 1;
        if (PH_ON) {
            if (f == 0) phase_prep_weights(C, l);
            phase_norm(C, (f ? C.in(19) : C.in(1)) + (size_t)l * DM);
        }
        PH_END;
        if (PH_ON) {
            pg8::Gemm g{(const bf16*)(C.ws + WS_XN), (const bf16*)(C.ws + (f ? WS_WGU2 : WS_WGU1)), T, 2 * DFF, DM};
            pg8::StaticOrder S; S.init(T, 2 * DFF, C.G, C.bid);
            pg8::EpiSwiGLU E{(bf16*)(C.ws + WS_HID), DFF};
            pg8::gemm_phase<pg8::EpiSwiGLU, pg8::StaticOrder, false>(C.lds, g, S, E, nullptr);
        }
        PH_END;
        if (PH_ON) {
            pg8::Gemm g{(const bf16*)(C.ws + WS_HID), (const bf16*)(C.ws + (f ? WS_WDN2 : WS_WDN1)), T, DM, DFF};
            pg8::StaticOrder S; S.init(T, DM, C.G, C.bid);
            pg8::EpiResid E{C.X, DM, 0.5f};
            pg8::gemm_phase<pg8::EpiResid, pg8::StaticOrder, false>(C.lds, g, S, E, nullptr);
        }
        PH_END;
        if (f == 0) {
            MIXER_PHASES
        }
    }
#undef PH_ON
#undef PH_END
    asm volatile("s_waitcnt vmcnt(0)" ::: "memory");
    __syncthreads();
    if (C.tid == 0) { __builtin_amdgcn_fence(__ATOMIC_RELEASE, "agent"); asm volatile("s_waitcnt vmcnt(0)" ::: "memory"); }
}

extern "C" void kernel_launch(void* const* d_in, const int* in_sizes, int n_in, void* d_out, int out_size, void* d_ws, size_t ws_size, hipStream_t stream) {
    static int grid = 0;
    if (grid == 0) {
        if (n_in != 23 || out_size != T * DM || ws_size < WS_END) { fprintf(stderr, "kernel_launch: unexpected shapes (n_in %d out %d ws %zu, need %zu)\n", n_in, out_size, ws_size, (size_t)WS_END); grid = -1; return; }
        int dev = 0, cus = 0, per_cu = 0;
        if (hipGetDevice(&dev) != hipSuccess || hipDeviceGetAttribute(&cus, hipDeviceAttributeMultiprocessorCount, dev) != hipSuccess) { grid = -1; return; }
        if (hipFuncSetAttribute((const void*)hybrid_fwd, hipFuncAttributeMaxDynamicSharedMemorySize, LDS_BYTES) != hipSuccess) { fprintf(stderr, "kernel_launch: hipFuncSetAttribute failed\n"); grid = -1; return; }
        if (hipOccupancyMaxActiveBlocksPerMultiprocessor(&per_cu, (const void*)hybrid_fwd, NTHR, LDS_BYTES) != hipSuccess || per_cu < 1) { fprintf(stderr, "kernel_launch: occupancy query says %d blocks per CU\n", per_cu); }
        (void)hipGetLastError();
        grid = cus;
    }
    if (grid < 0) return;
    (void)hipMemsetAsync((char*)d_ws + WS_CTL, 0, CTL_ZERO_BYTES, stream);
    Args a{};
    for (int i = 0; i < 23; ++i) a.in[i] = (const float*)d_in[i];
    a.out = (float*)d_out; a.ws = (unsigned char*)d_ws;
#if ONE_LAUNCH
    a.ph_lo = 0; a.ph_hi = N_PHASES;
    hipLaunchKernelGGL(hybrid_fwd, dim3(grid), dim3(NTHR), LDS_BYTES, stream, a);
#else
    for (int p = 0; p < N_PHASES; ++p) { a.ph_lo = p; a.ph_hi = p + 1; hipLaunchKernelGGL(hybrid_fwd, dim3(grid), dim3(NTHR), LDS_BYTES, stream, a); }
#endif
}
```

```cpp
#include <hip/hip_runtime.h>
#include <cstdio>
#include <cstdint>

#ifndef ABL_ZERO
#define ABL_ZERO 0
#endif
#ifndef SCL_A
#define SCL_A 1.0f
#define SCL_B 1.0f
#define SCL_C 1.0f
#endif
#define NAIVE_GLA 0
#define NAIVE_MLSTM 0
#define NAIVE_WIN 0
#define NAIVE_MERGE 0
#ifndef TIMEDUP
#define TIMEDUP 0
#endif
#ifndef ONE_LAUNCH
#define ONE_LAUNCH 1
#endif

#define GAS __attribute__((address_space(1)))
#define LAS __attribute__((address_space(3)))
typedef unsigned short bf16;
typedef unsigned v4u __attribute__((ext_vector_type(4)));
typedef unsigned v2u __attribute__((ext_vector_type(2)));
typedef float f32x4 __attribute__((ext_vector_type(4)));
typedef float f32x2 __attribute__((ext_vector_type(2)));
typedef short bf16x8 __attribute__((ext_vector_type(8)));
typedef short bf16x4 __attribute__((ext_vector_type(4)));

constexpr int NB = 2, SEQ = 16384, T = NB * SEQ, DM = 1024, DFF = 2816, NLAYER = 4;
constexpr int N_IN = 7472;
constexpr int NWAVES = 8, NTHR = 512;
constexpr float RMS_EPS = 1e-6f;
constexpr int NCH = SEQ / 64;

constexpr size_t MiB = 1u << 20;
constexpr size_t WS_CTL = 0, CTL_ZERO_BYTES = 1 * MiB;
constexpr size_t WS_ROPE = 1 * MiB;
constexpr size_t WS_VEC = 5 * MiB;
constexpr size_t WS_WGU1 = 6 * MiB;
constexpr size_t WS_WDN1 = 17 * MiB;
constexpr size_t WS_WGU2 = 23 * MiB;
constexpr size_t WS_WDN2 = 34 * MiB;
constexpr size_t WS_WIN = 40 * MiB;
constexpr size_t WS_WGT = 49 * MiB;
constexpr size_t WS_WBR = 55 * MiB;
constexpr size_t WS_WOUT = 58 * MiB;
constexpr size_t WS_CW1 = 60 * MiB;
constexpr size_t WS_CW2 = 62 * MiB;
constexpr size_t WS_XN = 64 * MiB;
constexpr size_t WS_R = 128 * MiB;
constexpr size_t WS_HID = WS_R;
constexpr size_t WS_QKA = WS_R;
constexpr size_t WS_VA = WS_R + 32 * MiB;
constexpr size_t WS_RA = WS_R + 64 * MiB;
constexpr size_t WS_QB = WS_R + 96 * MiB;
constexpr size_t WS_KVC = WS_R + 128 * MiB;
constexpr size_t WS_KVS = WS_R + 144 * MiB;
constexpr size_t WS_KVW = WS_R + 160 * MiB;
constexpr size_t WS_QKC = WS_R + 176 * MiB;
constexpr size_t WS_VC = WS_R + 208 * MiB;
constexpr size_t WS_OC = WS_R + 240 * MiB;
constexpr size_t WS_SMALL = WS_R + 272 * MiB;
constexpr size_t WS_VST = WS_R + 280 * MiB;
constexpr size_t WS_VWT = WS_R + 288 * MiB;
constexpr size_t WS_KCMP = WS_R + 296 * MiB;
constexpr size_t WS_VCT = WS_KCMP + MiB / 2;
constexpr size_t WS_CMPH = WS_R + 297 * MiB;
constexpr size_t WS_GST = WS_R + 302 * MiB;
constexpr size_t WS_GDEC = WS_R + 334 * MiB;
constexpr size_t WS_MSC = WS_GDEC + MiB / 2;
constexpr size_t WS_MST = WS_R + 335 * MiB;
constexpr size_t WS_MN = WS_R + 367 * MiB;
constexpr size_t WS_G0 = WS_QKA, WS_G1 = WS_QKC, WS_G2 = WS_GST;
constexpr size_t WS_G = WS_G0;
constexpr size_t WS_Y = WS_XN;
constexpr size_t WS_END = WS_R + 368 * MiB;

constexpr int VEC_BINP = 0;
constexpr int VEC_CB1 = 8192;

#define LDS_WAIT() asm volatile("s_waitcnt lgkmcnt(0)" ::: "memory")
#define VM_WAIT() asm volatile("s_waitcnt vmcnt(0)" ::: "memory")
__device__ __forceinline__ unsigned f2bf(float f) { unsigned u = __builtin_bit_cast(unsigned, f); return (u + 0x7fffu + ((u >> 16) & 1u)) >> 16; }
__device__ __forceinline__ unsigned pk2(float lo, float hi) { unsigned r; asm("v_cvt_pk_bf16_f32 %0, %1, %2" : "=v"(r) : "v"(lo), "v"(hi)); return r; }
__device__ __forceinline__ float bf2f(unsigned v) { return __builtin_bit_cast(float, (v & 0xffffu) << 16); }
__device__ __forceinline__ float bflo(unsigned w) { return __builtin_bit_cast(float, w << 16); }
__device__ __forceinline__ float bfhi(unsigned w) { return __builtin_bit_cast(float, w & 0xffff0000u); }
__device__ __forceinline__ float fexp(float x) { return __builtin_amdgcn_exp2f(x * 1.44269504089f); }
__device__ __forceinline__ float sigmoidf_(float x) { return 1.0f / (1.0f + __expf(-x)); }
__device__ __forceinline__ float siluf_(float x) { return x / (1.0f + __expf(-x)); }
__device__ __forceinline__ float logsigmoidf_(float x) { return fminf(x, 0.f) - log1pf(__expf(-fabsf(x))); }
__device__ __forceinline__ float wave_sum(float v) {
#pragma unroll
    for (int o = 1; o < 64; o <<= 1) v += __shfl_xor(v, o);
    return v;
}
__device__ __forceinline__ float wave_max(float v) {
#pragma unroll
    for (int o = 1; o < 64; o <<= 1) v = fmaxf(v, __shfl_xor(v, o));
    return v;
}

#define XB_TMO      128
#define XB_XCNT(j)  (256  + 64 * (j))
#define XB_XSUB(j)  (1280 + 64 * (j))
#define XB_XGEN(j)  (2304 + 64 * (j))
#define XB_TOP      3328
#define XB_TOPGEN   3392
#define XCD_BAR_WORDS 3456
#define XB_SPIN_CAP (1u << 24)

__device__ __forceinline__ unsigned xb_ld(unsigned* p)              { return __hip_atomic_load(p, __ATOMIC_RELAXED, __HIP_MEMORY_SCOPE_AGENT); }
__device__ __forceinline__ unsigned xb_add(unsigned* p, unsigned v) { return __hip_atomic_fetch_add(p, v, __ATOMIC_RELAXED, __HIP_MEMORY_SCOPE_AGENT); }
__device__ __forceinline__ unsigned xb_xcc_id() { return (unsigned)__builtin_amdgcn_s_getreg((3 << 11) | 20) & 0xFu; }
#define XB_SPIN(cond, bar) do { unsigned _sp = 0; while (cond) { __builtin_amdgcn_s_sleep(1); \
    if ((++_sp & 255u) == 0u) { if (xb_ld(&(bar)[XB_TMO])) break; if (_sp > XB_SPIN_CAP) { atomicAdd(&(bar)[XB_TMO], 1u); break; } } } } while (0)

struct XcdBarrier {
    unsigned* bar; unsigned x;
    volatile LAS unsigned* st;
};
__device__ __forceinline__ XcdBarrier xcd_barrier_post(unsigned* bar, volatile LAS unsigned* st) {
    XcdBarrier b; b.bar = bar; b.x = xb_xcc_id(); b.st = st;
    if (threadIdx.x == 0) (void)xb_add(&bar[XB_XCNT(b.x)], 1u);
    return b;
}
__device__ __forceinline__ void xcd_barrier_complete(unsigned* bar, unsigned x, unsigned& nloc, unsigned& nx) {
    const unsigned G = gridDim.x * gridDim.y * gridDim.z;
    unsigned sum, cnt, mine, sp = 0u;
    for (;;) {
        sum = 0u; cnt = 0u; mine = 0u;
#pragma unroll
        for (unsigned j = 0; j < 16; ++j) { const unsigned c = xb_ld(&bar[XB_XCNT(j)]); sum += c; cnt += (c > 0u) ? 1u : 0u; mine = (j == x) ? c : mine; }
        if (sum == G) break;
        __builtin_amdgcn_s_sleep(1);
        if ((++sp & 255u) == 0u) { if (xb_ld(&bar[XB_TMO])) break; if (sp > XB_SPIN_CAP) { atomicAdd(&bar[XB_TMO], 1u); break; } }
    }
    nloc = mine > 0u ? mine : 1u; nx = cnt > 0u ? cnt : 1u;
}
__device__ __forceinline__ void xcd_barrier(const XcdBarrier& b) {
    asm volatile("s_waitcnt vmcnt(0)" ::: "memory");
    __syncthreads();
    if (threadIdx.x == 0) {
        unsigned* bar = b.bar;
        __builtin_amdgcn_s_waitcnt(0);
        unsigned nloc = b.st[0], nx = b.st[1];
        if (nloc == 0u) { xcd_barrier_complete(bar, b.x, nloc, nx); b.st[0] = nloc; b.st[1] = nx; }
        const unsigned old = xb_add(&bar[XB_XSUB(b.x)], 1u);
        const unsigned gen = old / nloc;
        if (old + 1u == (gen + 1u) * nloc) {
            __builtin_amdgcn_fence(__ATOMIC_RELEASE, "agent");
            asm volatile("s_waitcnt vmcnt(0)" ::: "memory");
            const unsigned og = xb_add(&bar[XB_TOP], 1u);
            const unsigned tg = og / nx;
            if (og + 1u == (tg + 1u) * nx) xb_add(&bar[XB_TOPGEN], 1u);
            else XB_SPIN(xb_ld(&bar[XB_TOPGEN]) == tg, bar);
            __builtin_amdgcn_fence(__ATOMIC_ACQUIRE, "agent");
            xb_add(&bar[XB_XGEN(b.x)], 1u);
            asm volatile("s_waitcnt vmcnt(0)" ::: "memory");
        } else {
            XB_SPIN(xb_ld(&bar[XB_XGEN(b.x)]) == gen, bar);
            __builtin_amdgcn_fence(__ATOMIC_ACQUIRE, "agent");
            asm volatile("s_waitcnt vmcnt(0)" ::: "memory");
        }
    }
    __syncthreads();
}

namespace pg8 {
#define PG8_LAS __attribute__((address_space(3)))
typedef unsigned short bf16_t;
typedef short bf16x8 __attribute__((ext_vector_type(8)));
typedef float f32x4 __attribute__((ext_vector_type(4)));
typedef unsigned u32x4 __attribute__((ext_vector_type(4)));
constexpr int BM = 256, BK = 64, HALF = 128, HTB = HALF * BK * 2  , STAGE_BYTES = 8 * HTB, NXCD = 8, WGM = 8;

__host__ __device__ __forceinline__ int lds_byte(int r, int c) { const int st = (r >> 4) * 2 + (c >> 5), rr = r & 15, cc = c & 31, ob = rr * 64 + cc * 2; return st * 1024 + (ob ^ (((ob >> 9) & 1) << 5)); }
__host__ __device__ __forceinline__ void stage_rc(int b, int& R, int& C) { const int st = b / 1024, sb = b % 1024, swz = sb ^ (((sb >> 9) & 1) << 5); R = (st >> 1) * 16 + swz / 64; C = (st & 1) * 32 + (swz % 64) / 2; }
__host__ __device__ __forceinline__ int perm32(int rho) { const int n = rho >> 4, i = rho & 15; return 8 * (i >> 2) + 4 * n + (i & 3); }

struct Unit { int pm, pn; };
struct Gemm { const bf16_t* A; const bf16_t* Bt; int M, N, K; };

struct StaticOrder {
    int nM, nN, nwg, G, c;
    __host__ __device__ void init(int M, int N, int G_, int c_) { nM = M / BM; nN = N / BM; nwg = nM * nN; G = G_; c = c_; }
    __host__ __device__ bool next(int i, Unit& u) const {
        const long L = (long)i * G + c; if (L >= nwg) return false;
        int wgid = (int)L; { const int q = nwg / NXCD, r = nwg % NXCD, xcd = wgid % NXCD, off = wgid / NXCD; wgid = (xcd < r ? xcd * (q + 1) : r * (q + 1) + (xcd - r) * q) + off; }
        const int nig = WGM * nN, gid = wgid / nig, fm = gid * WGM, gsz = (nM - fm) < WGM ? (nM - fm) : WGM;
        u.pm = fm + ((wgid % nig) % gsz); u.pn = (wgid % nig) / gsz; return true;
    }
    __device__ __forceinline__ void a_ready(const Unit&) const {}
    __device__ __forceinline__ void done(const Unit&) const {}
};
struct CountedOrder : StaticOrder {
    const unsigned* ready; unsigned need; unsigned* tmo;
    __device__ __forceinline__ void a_ready(const Unit& u) const {
        if (threadIdx.x < 64) {
            const unsigned long long t0 = __builtin_amdgcn_s_memrealtime(); unsigned polls = 0;
            while ((unsigned)__builtin_amdgcn_readfirstlane(__hip_atomic_load(ready + 64 * u.pm, __ATOMIC_RELAXED, __HIP_MEMORY_SCOPE_AGENT)) < need) {
                if ((++polls & 255u) == 0u && __builtin_amdgcn_readfirstlane(__hip_atomic_load(tmo, __ATOMIC_RELAXED, __HIP_MEMORY_SCOPE_AGENT)) != 0u) break;
                if (__builtin_amdgcn_s_memrealtime() - t0 > 2000000ull) {
                    if (threadIdx.x == 0) { unsigned expect = 0u; __hip_atomic_compare_exchange_strong(tmo + 1, &expect, 0x600u | (unsigned)(u.pm & 0xff), __ATOMIC_RELAXED, __ATOMIC_RELAXED, __HIP_MEMORY_SCOPE_AGENT); __hip_atomic_store(tmo, 1u, __ATOMIC_RELAXED, __HIP_MEMORY_SCOPE_AGENT); }
                    break; }
                __builtin_amdgcn_s_sleep(2); }
            __builtin_amdgcn_fence(__ATOMIC_ACQUIRE, "agent");
            asm volatile("s_waitcnt vmcnt(0)" ::: "memory");
        }
#if !defined(BROKEN_HOOK_NO_BARRIER)
        asm volatile("" ::: "memory"); __builtin_amdgcn_s_barrier(); asm volatile("" ::: "memory");
#endif
    }
};

__device__ __forceinline__ unsigned cvt_pk_bf16(float lo, float hi) { unsigned r; asm volatile("v_cvt_pk_bf16_f32 %0, %1, %2" : "=v"(r) : "v"(lo), "v"(hi)); return r; }
typedef float f32x2 __attribute__((ext_vector_type(2)));
__device__ __forceinline__ f32x2 gelu_pk(f32x2 v) {
    const f32x2 av = __builtin_elementwise_abs(v), d = av * 0.2316418882f + 1.0f;
    f32x2 t; t.x = __builtin_amdgcn_rcpf(d.x); t.y = __builtin_amdgcn_rcpf(d.y);
    f32x2 q = t * 0.5307027145f + (-0.7265760135f); q = q * t + 0.7107068705f; q = q * t + (-0.142248368f); q = q * t + 0.127414796f; q = q * t;
    const f32x2 s = (v * v) * (-0.72134752044f);
    f32x2 e; e.x = __builtin_amdgcn_exp2f(s.x); e.y = __builtin_amdgcn_exp2f(s.y);
    const f32x2 m = v * (q * e), r = v - m;
    f32x2 o; o.x = v.x < 0.f ? m.x : r.x; o.y = v.y < 0.f ? m.y : r.y; return o;
}

struct EpiF32 {
    static constexpr bool PERM = false, AFTER_DRAIN = false;
    float* C; int ldc; const float* bias;
    __device__ __forceinline__ void operator()(const f32x4 (&acc)[2][2][4][2], const Unit& u, int wr, int wc, int fr, int fq) const {
        const int row0 = u.pm * BM + wr * 64 + fr, col0 = u.pn * BM + wc * 32 + 4 * fq;
        f32x4 bv[2][2];
#pragma unroll
        for (int bj = 0; bj < 2; ++bj)
#pragma unroll
            for (int n = 0; n < 2; ++n) bv[bj][n] = bias ? *(const f32x4*)(bias + col0 + bj * HALF + n * 16) : (f32x4){0.f, 0.f, 0.f, 0.f};
#pragma unroll
        for (int ai = 0; ai < 2; ++ai)
#pragma unroll
            for (int m = 0; m < 4; ++m) { float* rowp = C + (size_t)(row0 + ai * HALF + m * 16) * ldc + col0;
#pragma unroll
                for (int bj = 0; bj < 2; ++bj)
#pragma unroll
                    for (int n = 0; n < 2; ++n) *(f32x4*)(rowp + bj * HALF + n * 16) = acc[ai][bj][m][n] + bv[bj][n]; }
    }
};
template <int ACT  > struct EpiBf16 {
    static constexpr bool PERM = true, AFTER_DRAIN = false;
    bf16_t* O; int ldc; const float* bias; int split_cols; size_t split_stride;
    __device__ __forceinline__ void operator()(const f32x4 (&acc)[2][2][4][2], const Unit& u, int wr, int wc, int fr, int fq) const {
        const int row0 = u.pm * BM + wr * 64 + fr; int colt = u.pn * BM; bf16_t* base = O;
        if (split_cols) { const int t = colt / split_cols; base += (size_t)t * split_stride; colt -= t * split_cols; }
        const int col0 = colt + wc * 32 + 8 * fq, bcol0 = u.pn * BM + wc * 32 + 8 * fq;
        f32x4 bv[2][2];
#pragma unroll
        for (int bj = 0; bj < 2; ++bj)
#pragma unroll
            for (int n = 0; n < 2; ++n) bv[bj][n] = bias ? *(const f32x4*)(bias + bcol0 + bj * HALF + 4 * n) : (f32x4){0.f, 0.f, 0.f, 0.f};
#pragma unroll
        for (int ai = 0; ai < 2; ++ai)
#pragma unroll
            for (int m = 0; m < 4; ++m) { bf16_t* rowp = base + (size_t)(row0 + ai * HALF + m * 16) * ldc + col0;
#pragma unroll
                for (int bj = 0; bj < 2; ++bj) { f32x4 v0 = acc[ai][bj][m][0] + bv[bj][0], v1 = acc[ai][bj][m][1] + bv[bj][1];
                    if (ACT == 1) { f32x2 a = gelu_pk((f32x2){v0[0], v0[1]}), b = gelu_pk((f32x2){v0[2], v0[3]}), c = gelu_pk((f32x2){v1[0], v1[1]}), d = gelu_pk((f32x2){v1[2], v1[3]});
                        v0 = (f32x4){a.x, a.y, b.x, b.y}; v1 = (f32x4){c.x, c.y, d.x, d.y}; }
                    if (ACT == 2) {
#pragma unroll
                        for (int j = 0; j < 4; ++j) { v0[j] = 0.5f * v0[j] * (1.0f + erff(v0[j] * 0.70710678f)); v1[j] = 0.5f * v1[j] * (1.0f + erff(v1[j] * 0.70710678f)); } }
                    u32x4 w; w.x = cvt_pk_bf16(v0[0], v0[1]); w.y = cvt_pk_bf16(v0[2], v0[3]); w.z = cvt_pk_bf16(v1[0], v1[1]); w.w = cvt_pk_bf16(v1[2], v1[3]);
                    *(u32x4*)(rowp + bj * HALF) = w; } }
    }
};

struct PanelStats {
    unsigned* xbuf;
    unsigned* cnt;
    unsigned* tmo;
    int ntn; float eps;
    unsigned code;
    __device__ __forceinline__ bool run(const f32x4 (&v)[2][2][4][2], const Unit& u, int wr, int wc, int fr, int fq, PG8_LAS unsigned char* lds, int wid, int lane) const {
        typedef float f32x2v __attribute__((ext_vector_type(2)));
        PG8_LAS f32x2v* P = (PG8_LAS f32x2v*)lds;
        PG8_LAS f32x2v* S = (PG8_LAS f32x2v*)(lds + 8192);
        PG8_LAS unsigned* flag = (PG8_LAS unsigned*)(lds + 8192 + 2048);
#pragma unroll
        for (int ai = 0; ai < 2; ++ai)
#pragma unroll
            for (int m = 0; m < 4; ++m) {
                float s = 0.f;
#pragma unroll
                for (int bj = 0; bj < 2; ++bj)
#pragma unroll
                    for (int n = 0; n < 2; ++n) { const f32x4 x = v[ai][bj][m][n]; s += (x[0] + x[1]) + (x[2] + x[3]); }
                s += __shfl_xor(s, 16); s += __shfl_xor(s, 32);
                const float mw = s * (1.0f / 64.0f); float q = 0.f;
#pragma unroll
                for (int bj = 0; bj < 2; ++bj)
#pragma unroll
                    for (int n = 0; n < 2; ++n) { const f32x4 d = v[ai][bj][m][n] - mw; q += (d[0] * d[0] + d[1] * d[1]) + (d[2] * d[2] + d[3] * d[3]); }
                q += __shfl_xor(q, 16); q += __shfl_xor(q, 32);
                if (fq == 0) P[(ai * HALF + wr * 64 + m * 16 + fr) * 4 + wc] = (f32x2v){mw, q};
            }
        asm volatile("s_waitcnt lgkmcnt(0)" ::: "memory"); __builtin_amdgcn_s_barrier(); asm volatile("" ::: "memory");
#if defined(BROKEN_NO_WAIT)
        if (blockIdx.x >= 64) { const long long t0 = clock64(); while (clock64() - t0 < 60000) __builtin_amdgcn_s_sleep(8); }
#endif
        const int row = wid * 32 + (lane & 31);
        if (lane < 32) {
            const f32x2v a = P[row * 4 + 0], b = P[row * 4 + 1], c = P[row * 4 + 2], d = P[row * 4 + 3];
            const float mt = (a.x + b.x + c.x + d.x) * 0.25f;
            const float da = a.x - mt, db = b.x - mt, dc = c.x - mt, dd = d.x - mt;
            const float m2 = (a.y + b.y) + (c.y + d.y) + 64.0f * ((da * da + db * db) + (dc * dc + dd * dd));
            unsigned long long* slot = (unsigned long long*)xbuf + ((size_t)(u.pm * BM + row) * 4 + u.pn);
            __hip_atomic_store(slot, ((unsigned long long)__float_as_uint(m2) << 32) | __float_as_uint(mt), __ATOMIC_RELAXED, __HIP_MEMORY_SCOPE_AGENT);
        }
        asm volatile("s_waitcnt vmcnt(0)" ::: "memory");
        if (lane == 0) __hip_atomic_fetch_add(cnt + 64 * u.pm, 1u, __ATOMIC_RELAXED, __HIP_MEMORY_SCOPE_AGENT);
        if (wid == 0) {
            bool dead = false; const unsigned long long t0 = __builtin_amdgcn_s_memrealtime(); const unsigned want = 8u * (unsigned)ntn;
            for (;;) {
#if defined(BROKEN_NO_WAIT)
                break;
#endif
                if ((unsigned)__builtin_amdgcn_readfirstlane(__hip_atomic_load(cnt + 64 * u.pm, __ATOMIC_RELAXED, __HIP_MEMORY_SCOPE_AGENT)) >= want) break;
                if (__builtin_amdgcn_s_memrealtime() - t0 > 2000000ull) {
                    if (lane == 0) { unsigned expect = 0u; __hip_atomic_compare_exchange_strong(tmo + 1, &expect, code | (unsigned)(u.pm & 0xff), __ATOMIC_RELAXED, __ATOMIC_RELAXED, __HIP_MEMORY_SCOPE_AGENT);
                                     __hip_atomic_store(tmo, 1u, __ATOMIC_RELAXED, __HIP_MEMORY_SCOPE_AGENT); }
                    dead = true; break; }
                __builtin_amdgcn_s_sleep(2);
            }
            __builtin_amdgcn_fence(__ATOMIC_ACQUIRE, "agent");
            if (lane == 0) flag[0] = dead ? 1u : 0u;
        }
        asm volatile("s_waitcnt vmcnt(0) lgkmcnt(0)" ::: "memory"); __builtin_amdgcn_s_barrier(); asm volatile("" ::: "memory");
        const bool bad = flag[0] != 0u;
        if (lane < 32) {
            const unsigned long long* slot = (const unsigned long long*)xbuf + (size_t)(u.pm * BM + row) * 4; float mt[4], m2[4]; float ms = 0.f;
#pragma unroll
            for (int t = 0; t < 4; ++t) { if (t < ntn) { const unsigned long long w = __hip_atomic_load(slot + t, __ATOMIC_RELAXED, __HIP_MEMORY_SCOPE_AGENT); mt[t] = __uint_as_float((unsigned)w); m2[t] = __uint_as_float((unsigned)(w >> 32)); } else { mt[t] = 0.f; m2[t] = 0.f; } ms += mt[t]; }
            const float mean = ms / (float)ntn; float q = 0.f;
#pragma unroll
            for (int t = 0; t < 4; ++t) if (t < ntn) { const float dm = mt[t] - mean; q += m2[t] + 256.0f * dm * dm; }
            S[row] = (f32x2v){mean, 1.0f / sqrtf(q / (256.0f * (float)ntn) + eps)};
        }
        asm volatile("s_waitcnt lgkmcnt(0)" ::: "memory"); __builtin_amdgcn_s_barrier(); asm volatile("" ::: "memory");
        return bad;
    }
};
struct EpiLnRes {
    static constexpr bool PERM = false, AFTER_DRAIN = true;
    const float* base; float* out; int ldc; const float* bias; PanelStats st; unsigned poison;
    __device__ __forceinline__ void refuse(size_t i0, size_t stride, int M, int N) const { const float q = __builtin_nanf(""); for (size_t i = i0; i < (size_t)M * N; i += stride) out[(i / N) * ldc + i % N] = q;
        if (i0 == 0) { unsigned expect = 0u; __hip_atomic_compare_exchange_strong(st.tmo + 1, &expect, 0x7f0u, __ATOMIC_RELAXED, __ATOMIC_RELAXED, __HIP_MEMORY_SCOPE_AGENT); __hip_atomic_store(st.tmo, 1u, __ATOMIC_RELAXED, __HIP_MEMORY_SCOPE_AGENT); } }
    __device__ __forceinline__ void fused(f32x4 (&acc)[2][2][4][2], const Unit& u, int wr, int wc, int fr, int fq, PG8_LAS unsigned char* lds, int wid, int lane) const {
        typedef float f32x2v __attribute__((ext_vector_type(2)));
        const PG8_LAS f32x2v* S = (const PG8_LAS f32x2v*)(lds + 8192);
        const int col0 = u.pn * BM + wc * 32 + 4 * fq;
#pragma unroll
        for (int bj = 0; bj < 2; ++bj)
#pragma unroll
            for (int n = 0; n < 2; ++n) { const f32x4 bv = bias ? *(const f32x4*)(bias + col0 + bj * HALF + n * 16) : (f32x4){0.f, 0.f, 0.f, 0.f};
#pragma unroll
                for (int ai = 0; ai < 2; ++ai)
#pragma unroll
                    for (int m = 0; m < 4; ++m) acc[ai][bj][m][n] += bv; }
        const bool bad = st.run(acc, u, wr, wc, fr, fq, lds, wid, lane) || poison != 0u;
        const float qnan = __builtin_nanf("");
#pragma unroll
        for (int ai = 0; ai < 2; ++ai)
#pragma unroll
            for (int m = 0; m < 4; ++m) { const int r = ai * HALF + wr * 64 + m * 16 + fr; const f32x2v sr = S[r]; const size_t off = (size_t)(u.pm * BM + r) * ldc + col0;
#pragma unroll
                for (int bj = 0; bj < 2; ++bj)
#pragma unroll
                    for (int n = 0; n < 2; ++n) { const f32x4 bs = *(const f32x4*)(base + off + bj * HALF + n * 16); f32x4 o = bs + (acc[ai][bj][m][n] - sr.x) * sr.y;
                        if (bad) o = (f32x4){qnan, qnan, qnan, qnan}; *(f32x4*)(out + off + bj * HALF + n * 16) = o; }
                asm volatile("" ::: "memory"); }
    }
};
struct EpiLnResLn {
    static constexpr bool PERM = false, AFTER_DRAIN = true;
    const float* base; float* out; bf16_t* xn; int ldc; const float* bias; PanelStats st1, st2; unsigned poison;
    __device__ __forceinline__ void refuse(size_t i0, size_t stride, int M, int N) const { const float q = __builtin_nanf(""); for (size_t i = i0; i < (size_t)M * N; i += stride) { const size_t o = (i / N) * ldc + i % N; out[o] = q; xn[o] = (bf16_t)0x7fc0u; }
        if (i0 == 0) { unsigned expect = 0u; __hip_atomic_compare_exchange_strong(st1.tmo + 1, &expect, 0x7f0u, __ATOMIC_RELAXED, __ATOMIC_RELAXED, __HIP_MEMORY_SCOPE_AGENT); __hip_atomic_store(st1.tmo, 1u, __ATOMIC_RELAXED, __HIP_MEMORY_SCOPE_AGENT); } }
    __device__ __forceinline__ void fused(f32x4 (&acc)[2][2][4][2], const Unit& u, int wr, int wc, int fr, int fq, PG8_LAS unsigned char* lds, int wid, int lane) const {
        typedef float f32x2v __attribute__((ext_vector_type(2))); typedef unsigned u32x2v __attribute__((ext_vector_type(2)));
        const PG8_LAS f32x2v* S = (const PG8_LAS f32x2v*)(lds + 8192);
        const int col0 = u.pn * BM + wc * 32 + 4 * fq;
#pragma unroll
        for (int bj = 0; bj < 2; ++bj)
#pragma unroll
            for (int n = 0; n < 2; ++n) { const f32x4 bv = bias ? *(const f32x4*)(bias + col0 + bj * HALF + n * 16) : (f32x4){0.f, 0.f, 0.f, 0.f};
#pragma unroll
                for (int ai = 0; ai < 2; ++ai)
#pragma unroll
                    for (int m = 0; m < 4; ++m) acc[ai][bj][m][n] += bv; }
        bool bad = st1.run(acc, u, wr, wc, fr, fq, lds, wid, lane) || poison != 0u;
        const float qnan = __builtin_nanf("");
#pragma unroll
        for (int ai = 0; ai < 2; ++ai)
#pragma unroll
            for (int m = 0; m < 4; ++m) { const int r = ai * HALF + wr * 64 + m * 16 + fr; const f32x2v sr = S[r]; const size_t off = (size_t)(u.pm * BM + r) * ldc + col0;
#pragma unroll
                for (int bj = 0; bj < 2; ++bj)
#pragma unroll
                    for (int n = 0; n < 2; ++n) { const f32x4 bs = *(const f32x4*)(base + off + bj * HALF + n * 16); acc[ai][bj][m][n] = bs + (acc[ai][bj][m][n] - sr.x) * sr.y; }
                asm volatile("" : "+v"(acc[ai][0][m][0]), "+v"(acc[ai][0][m][1]), "+v"(acc[ai][1][m][0]), "+v"(acc[ai][1][m][1]));
                if (m & 1) asm volatile("" ::: "memory"); }
        const bool bad1 = bad;
        bad = st2.run(acc, u, wr, wc, fr, fq, lds, wid, lane) || bad;
#pragma unroll
        for (int ai = 0; ai < 2; ++ai)
#pragma unroll
            for (int m = 0; m < 4; ++m) { const int r = ai * HALF + wr * 64 + m * 16 + fr; const f32x2v sr = S[r]; const size_t off = (size_t)(u.pm * BM + r) * ldc + col0;
#pragma unroll
                for (int bj = 0; bj < 2; ++bj)
#pragma unroll
                    for (int n = 0; n < 2; ++n) { const f32x4 x1 = acc[ai][bj][m][n]; *(f32x4*)(out + off + bj * HALF + n * 16) = bad1 ? (f32x4){qnan, qnan, qnan, qnan} : x1;
                        const f32x4 o = (x1 - sr.x) * sr.y; u32x2v w; w.x = cvt_pk_bf16(o[0], o[1]); w.y = cvt_pk_bf16(o[2], o[3]);
                        if (bad) { w.x = 0x7fc07fc0u; w.y = 0x7fc07fc0u; } *(u32x2v*)(xn + off + bj * HALF + n * 16) = w; }
                asm volatile("" ::: "memory"); }
    }
};

template <class Epi, class Sched, bool STAMP = false>
__device__ __forceinline__ void gemm_phase(PG8_LAS unsigned char* lds, const Gemm g, const Sched& S, const Epi& E, unsigned long long* stamps) {
    int tid_ = threadIdx.x; asm volatile("" : "+v"(tid_));
    const int tid = tid_, wid = __builtin_amdgcn_readfirstlane(tid >> 6), lane = tid & 63, wr = wid >> 2, wc = wid & 3, fr = lane & 15, fq = lane >> 4;
    const int K = g.K, nt = K / BK;
    int ts_lo = 0, ts_hi = 0, nts = 0; const unsigned long long rt_entry = STAMP ? (unsigned long long)wall_clock64() : 0ull;
#define PG8_STAMP() do { if (STAMP && wid == 0 && nts < 64) { const unsigned long long _c = (unsigned long long)clock64(); \
        ts_lo = (lane == nts) ? (int)(unsigned)_c : ts_lo; ts_hi = (lane == nts) ? (int)(unsigned)(_c >> 32) : ts_hi; ++nts; } } while (0)
    PG8_STAMP();
    unsigned voffA[2], voffB[2];
#pragma unroll
    for (int i = 0; i < 2; ++i) { int R, C; stage_rc(tid * 16 + i * 8192, R, C); const int Rb = Epi::PERM ? ((R & ~31) + perm32(R & 31)) : R;
        voffA[i] = (unsigned)(R * K + C) * 2u; voffB[i] = (unsigned)(Rb * K + C) * 2u; }
    const size_t kstep = (size_t)(BK * 2);
    const size_t hstep = (size_t)HALF * K * 2;
    const size_t tstep = 2 * hstep;
    const unsigned ldsw = (unsigned)wid * 1024u;
    const int aoff = lds_byte(wr * 64 + fr, fq * 8), boff = lds_byte(wc * 32 + fr, fq * 8);
#define PG8_SA(b, h) (((b) * 2 + (h)) * HTB)
#define PG8_SB(b, h) ((4 + (b) * 2 + (h)) * HTB)
#define PG8_STAGE(bufoff, gbase, voff) do { _Pragma("unroll") for (int _i = 0; _i < 2; ++_i) \
        __builtin_amdgcn_global_load_lds((const unsigned*)((const char*)(gbase) + (voff)[_i]), (PG8_LAS unsigned*)(lds + (bufoff) + ldsw + _i * 8192), 16, 0, 0); } while (0)
#define PG8_LDA(dst, b, h) do { _Pragma("unroll") for (int m = 0; m < 4; ++m) _Pragma("unroll") for (int k = 0; k < 2; ++k) dst[m][k] = *(const PG8_LAS bf16x8*)(lds + PG8_SA(b, h) + aoff + m * 2048 + k * 1024); } while (0)
#define PG8_LDB(dst, b, h) do { _Pragma("unroll") for (int n = 0; n < 2; ++n) _Pragma("unroll") for (int k = 0; k < 2; ++k) dst[n][k] = *(const PG8_LAS bf16x8*)(lds + PG8_SB(b, h) + boff + n * 2048 + k * 1024); } while (0)
#define PG8_MMA(ai, bj, At, Bt) do { __builtin_amdgcn_s_setprio(1); _Pragma("unroll") for (int m = 0; m < 4; ++m) _Pragma("unroll") for (int n = 0; n < 2; ++n) _Pragma("unroll") for (int k = 0; k < 2; ++k) \
        acc[ai][bj][m][n] = __builtin_amdgcn_mfma_f32_16x16x32_bf16(Bt[n][k], At[m][k], acc[ai][bj][m][n], 0, 0, 0); __builtin_amdgcn_s_setprio(0); } while (0)
#define PG8_WAIT_V(n) asm volatile("s_waitcnt vmcnt(" #n ")" ::: "memory")
#define PG8_WAIT_L(n) asm volatile("s_waitcnt lgkmcnt(" #n ")" ::: "memory")
#define PG8_BAR __builtin_amdgcn_s_barrier()
#define PG8_SCHED __builtin_amdgcn_sched_barrier(0)
    Unit cur, nxt; int ui = 0;
    if (!S.next(0, cur)) return;
    f32x4 acc[2][2][4][2];
#pragma unroll
    for (int a = 0; a < 2; ++a)
#pragma unroll
        for (int b = 0; b < 2; ++b)
#pragma unroll
            for (int m = 0; m < 4; ++m)
#pragma unroll
                for (int n = 0; n < 2; ++n) acc[a][b][m][n] = (f32x4){0.f, 0.f, 0.f, 0.f};
    bf16x8 At[4][2], B0[2][2], B1[2][2];
    const char* cA = (const char*)g.A + (size_t)cur.pm * tstep; const char* cB = (const char*)g.Bt + (size_t)cur.pn * tstep;
    S.a_ready(cur);
    PG8_STAGE(PG8_SB(0, 0), cB, voffB); PG8_STAGE(PG8_SA(0, 0), cA, voffA); PG8_STAGE(PG8_SB(0, 1), cB + hstep, voffB); PG8_STAGE(PG8_SA(0, 1), cA + hstep, voffA);
    if (wr == 1) PG8_BAR;
    PG8_WAIT_V(4); PG8_BAR;
    PG8_STAGE(PG8_SB(1, 0), cB + kstep, voffB); PG8_STAGE(PG8_SA(1, 0), cA + kstep, voffA); PG8_STAGE(PG8_SB(1, 1), cB + hstep + kstep, voffB);
    PG8_WAIT_V(6); PG8_BAR;
    PG8_STAMP();
    for (;;) {
        const bool has_next = S.next(ui + 1, nxt);
        const char* nA = has_next ? (const char*)g.A + (size_t)nxt.pm * tstep : cA; const char* nB = has_next ? (const char*)g.Bt + (size_t)nxt.pn * tstep : cB;
        for (int t = 0; t < nt; t += 2) {
            const bool last = (t == nt - 2);
            const char* a1 = cA + (size_t)(t + 1) * kstep;
            const char* a2 = last ? nA : cA + (size_t)(t + 2) * kstep; const char* b2 = last ? nB : cB + (size_t)(t + 2) * kstep;
            const char* a3 = a2 + kstep; const char* b3 = b2 + kstep;
            if (last && has_next) S.a_ready(nxt);
            PG8_LDB(B0, 0, 0); PG8_SCHED; PG8_LDA(At, 0, 0); PG8_STAGE(PG8_SA(1, 1), a1 + hstep, voffA);
            PG8_WAIT_L(8); PG8_BAR; PG8_WAIT_L(0); PG8_MMA(0, 0, At, B0); PG8_BAR; PG8_SCHED;
            PG8_LDB(B1, 0, 1); PG8_STAGE(PG8_SB(0, 0), b2, voffB);
            PG8_BAR; PG8_WAIT_L(0); PG8_MMA(0, 1, At, B1); PG8_BAR;
            PG8_LDA(At, 0, 1); PG8_STAGE(PG8_SA(0, 0), a2, voffA);
            PG8_BAR; PG8_WAIT_L(0); PG8_MMA(1, 0, At, B0); PG8_BAR; PG8_SCHED;
            PG8_STAGE(PG8_SB(0, 1), b2 + hstep, voffB);
            PG8_WAIT_V(6); PG8_BAR; PG8_MMA(1, 1, At, B1); PG8_BAR;
            PG8_LDB(B0, 1, 0); PG8_SCHED; PG8_LDA(At, 1, 0); PG8_STAGE(PG8_SA(0, 1), a2 + hstep, voffA);
            PG8_WAIT_L(8); PG8_BAR; PG8_WAIT_L(0); PG8_MMA(0, 0, At, B0); PG8_BAR; PG8_SCHED;
            PG8_LDB(B1, 1, 1); PG8_STAGE(PG8_SB(1, 0), b3, voffB);
            PG8_BAR; PG8_WAIT_L(0); PG8_MMA(0, 1, At, B1); PG8_BAR;
            PG8_LDA(At, 1, 1); PG8_STAGE(PG8_SA(1, 0), a3, voffA);
            PG8_BAR; PG8_WAIT_L(0); PG8_MMA(1, 0, At, B0); PG8_BAR; PG8_SCHED;
            PG8_STAGE(PG8_SB(1, 1), b3 + hstep, voffB);
            PG8_WAIT_V(6); PG8_BAR; PG8_MMA(1, 1, At, B1); PG8_BAR;
        }
        PG8_STAMP();
        if constexpr (!Epi::AFTER_DRAIN) { E(acc, cur, wr, wc, fr, fq); S.done(cur); }
        PG8_STAMP();
        if (!has_next) break;
#pragma unroll
        for (int a = 0; a < 2; ++a)
#pragma unroll
            for (int b = 0; b < 2; ++b)
#pragma unroll
                for (int m = 0; m < 4; ++m)
#pragma unroll
                    for (int n = 0; n < 2; ++n) acc[a][b][m][n] = (f32x4){0.f, 0.f, 0.f, 0.f};
        cur = nxt; cA = nA; cB = nB; ++ui;
    }
    PG8_WAIT_V(0);
    if (wr == 0) PG8_BAR;
    PG8_BAR;
    if constexpr (Epi::AFTER_DRAIN) { E.fused(acc, cur, wr, wc, fr, fq, lds, wid, lane); S.done(cur); }
    PG8_STAMP();
    if (STAMP && wid == 0) { stamps[lane] = lane < nts ? (((unsigned long long)(unsigned)ts_hi << 32) | (unsigned)ts_lo) : 0ull;
        if (lane == 62) stamps[62] = rt_entry; if (lane == 63) stamps[63] = (unsigned long long)wall_clock64(); }
#undef PG8_STAMP
#undef PG8_SA
#undef PG8_SB
#undef PG8_STAGE
#undef PG8_LDA
#undef PG8_LDB
#undef PG8_MMA
#undef PG8_WAIT_V
#undef PG8_WAIT_L
#undef PG8_BAR
#undef PG8_SCHED
}
}

namespace pg8 {
__device__ __forceinline__ float fast_sigmoid(float x) { return __builtin_amdgcn_rcpf(1.0f + __builtin_amdgcn_exp2f(-1.44269504089f * x)); }
struct EpiSwiGLU {
    static constexpr bool PERM = true, AFTER_DRAIN = false;
    bf16_t* H; int ldh;
    __device__ __forceinline__ void operator()(const f32x4 (&acc)[2][2][4][2], const Unit& u, int wr, int wc, int fr, int fq) const {
        const int row0 = u.pm * BM + wr * 64 + fr, hc0 = u.pn * 128 + wc * 32 + 8 * fq;
#pragma unroll
        for (int ai = 0; ai < 2; ++ai)
#pragma unroll
            for (int m = 0; m < 4; ++m) {
                bf16_t* rowp = H + (size_t)(row0 + ai * HALF + m * 16) * ldh + hc0;
                float v[8];
#pragma unroll
                for (int n = 0; n < 2; ++n)
#pragma unroll
                    for (int j = 0; j < 4; ++j) { const float g = acc[ai][0][m][n][j], up = acc[ai][1][m][n][j]; v[n * 4 + j] = g * fast_sigmoid(g) * up; }
                u32x4 w; w.x = cvt_pk_bf16(v[0], v[1]); w.y = cvt_pk_bf16(v[2], v[3]); w.z = cvt_pk_bf16(v[4], v[5]); w.w = cvt_pk_bf16(v[6], v[7]);
                *(u32x4*)rowp = w;
            }
    }
};
struct EpiResid {
    static constexpr bool PERM = false, AFTER_DRAIN = false;
    float* X; int ldc; float alpha;
    __device__ __forceinline__ void operator()(const f32x4 (&acc)[2][2][4][2], const Unit& u, int wr, int wc, int fr, int fq) const {
        const int row0 = u.pm * BM + wr * 64 + fr, col0 = u.pn * BM + wc * 32 + 4 * fq;
#pragma unroll
        for (int ai = 0; ai < 2; ++ai)
#pragma unroll
            for (int m = 0; m < 4; ++m) { float* rowp = X + (size_t)(row0 + ai * HALF + m * 16) * ldc + col0;
#pragma unroll
                for (int bj = 0; bj < 2; ++bj)
#pragma unroll
                    for (int n = 0; n < 2; ++n) { f32x4* p = (f32x4*)(rowp + bj * HALF + n * 16); const f32x4 old = *p; *p = old + acc[ai][bj][m][n] * alpha; } }
    }
};
struct EpiWin {
    static constexpr bool PERM = true, AFTER_DRAIN = false;
    unsigned char* zbase; const float* bias; float* small_out;
    __device__ __forceinline__ void operator()(const f32x4 (&acc)[2][2][4][2], const Unit& u, int wr, int wc, int fr, int fq) const {
        const int row0 = u.pm * BM + wr * 64 + fr; const int pn = u.pn;
        const int bcol0 = pn * BM + wc * 32 + 8 * fq;
        f32x4 bv[2][2];
#pragma unroll
        for (int bj = 0; bj < 2; ++bj)
#pragma unroll
            for (int n = 0; n < 2; ++n) bv[bj][n] = *(const f32x4*)(bias + bcol0 + bj * HALF + 4 * n);
        if (pn == 17) {
            if (wc < 2) {
#pragma unroll
                for (int ai = 0; ai < 2; ++ai)
#pragma unroll
                    for (int m = 0; m < 4; ++m) { float* rowp = small_out + (size_t)(row0 + ai * HALF + m * 16) * 64 + wc * 32 + 8 * fq;
#pragma unroll
                        for (int n = 0; n < 2; ++n) *(f32x4*)(rowp + 4 * n) = acc[ai][0][m][n] + bv[0][n]; }
            }
            return;
        }
        size_t base; int ld, c0;
        if (pn < 8) { base = (size_t)(pn >> 1) * ((size_t)T * 512 * 2); ld = 512; c0 = (pn & 1) * 256; }
        else if (pn < 11) { base = (size_t)4 * T * 512 * 2 + (size_t)(pn - 8) * ((size_t)T * 256 * 2); ld = 256; c0 = 0; }
        else { base = (size_t)4 * T * 512 * 2 + (size_t)3 * T * 256 * 2 + (size_t)((pn - 11) >> 1) * ((size_t)T * 512 * 2); ld = 512; c0 = ((pn - 11) & 1) * 256; }
        bf16_t* O = (bf16_t*)(zbase + base);
        const int col0 = c0 + wc * 32 + 8 * fq;
#pragma unroll
        for (int ai = 0; ai < 2; ++ai)
#pragma unroll
            for (int m = 0; m < 4; ++m) { bf16_t* rowp = O + (size_t)(row0 + ai * HALF + m * 16) * ld + col0;
#pragma unroll
                for (int bj = 0; bj < 2; ++bj) { const f32x4 v0 = acc[ai][bj][m][0] + bv[bj][0], v1 = acc[ai][bj][m][1] + bv[bj][1];
                    u32x4 w; w.x = cvt_pk_bf16(v0[0], v0[1]); w.y = cvt_pk_bf16(v0[2], v0[3]); w.z = cvt_pk_bf16(v1[0], v1[1]); w.w = cvt_pk_bf16(v1[2], v1[3]);
                    *(u32x4*)(rowp + bj * HALF) = w; } }
    }
};
struct EpiGate {
    static constexpr bool PERM = true, AFTER_DRAIN = false;
    unsigned char* ws; int ldc; const float* bias;
    __device__ __forceinline__ void operator()(const f32x4 (&acc)[2][2][4][2], const Unit& u, int wr, int wc, int fr, int fq) const {
        const int br = u.pn >> 2;
        bf16_t* G = (bf16_t*)(ws + WS_G0 + (size_t)(br >= 1) * (WS_G1 - WS_G0) + (size_t)(br >= 2) * (WS_G2 - WS_G1));
        const int row0 = u.pm * BM + wr * 64 + fr, col0 = (u.pn & 3) * BM + wc * 32 + 8 * fq, bcol0 = u.pn * BM + wc * 32 + 8 * fq;
        f32x4 bv[2][2];
#pragma unroll
        for (int bj = 0; bj < 2; ++bj)
#pragma unroll
            for (int n = 0; n < 2; ++n) bv[bj][n] = *(const f32x4*)(bias + bcol0 + bj * HALF + 4 * n);
#pragma unroll
        for (int ai = 0; ai < 2; ++ai)
#pragma unroll
            for (int m = 0; m < 4; ++m) { bf16_t* rowp = G + (size_t)(row0 + ai * HALF + m * 16) * ldc + col0;
#pragma unroll
                for (int bj = 0; bj < 2; ++bj) { f32x4 v0 = acc[ai][bj][m][0] + bv[bj][0], v1 = acc[ai][bj][m][1] + bv[bj][1];
                    u32x4 w; w.x = cvt_pk_bf16(v0[0], v0[1]); w.y = cvt_pk_bf16(v0[2], v0[3]); w.z = cvt_pk_bf16(v1[0], v1[1]); w.w = cvt_pk_bf16(v1[2], v1[3]);
                    *(u32x4*)(rowp + bj * HALF) = w; } }
    }
};
struct EpiBranch {
    static constexpr bool PERM = true, AFTER_DRAIN = false;
    bf16_t* Y; const bf16_t* G; int ldc; int first;
    __device__ __forceinline__ void operator()(const f32x4 (&acc)[2][2][4][2], const Unit& u, int wr, int wc, int fr, int fq) const {
        const int row0 = u.pm * BM + wr * 64 + fr, col0 = u.pn * BM + wc * 32 + 8 * fq;
#pragma unroll
        for (int ai = 0; ai < 2; ++ai)
#pragma unroll
            for (int m = 0; m < 4; ++m) { const size_t off = (size_t)(row0 + ai * HALF + m * 16) * ldc + col0;
#pragma unroll
                for (int bj = 0; bj < 2; ++bj) {
                    const u32x4 g = *(const u32x4*)(G + off + bj * HALF);
                    u32x4 y = (u32x4){0u, 0u, 0u, 0u}; if (!first) y = *(const u32x4*)(Y + off + bj * HALF);
                    const f32x4 a0 = acc[ai][bj][m][0], a1 = acc[ai][bj][m][1];
                    float o[8];
#pragma unroll
                    for (int q = 0; q < 4; ++q) { const unsigned gw = g[q], yw = y[q]; const float al = q < 2 ? a0[2 * q] : a1[2 * q - 4], ah = q < 2 ? a0[2 * q + 1] : a1[2 * q - 3];
                        o[2 * q] = __builtin_bit_cast(float, yw << 16) + fast_sigmoid(__builtin_bit_cast(float, gw << 16)) * al;
                        o[2 * q + 1] = __builtin_bit_cast(float, yw & 0xffff0000u) + fast_sigmoid(__builtin_bit_cast(float, gw & 0xffff0000u)) * ah; }
                    u32x4 w; w.x = cvt_pk_bf16(o[0], o[1]); w.y = cvt_pk_bf16(o[2], o[3]); w.z = cvt_pk_bf16(o[4], o[5]); w.w = cvt_pk_bf16(o[6], o[7]);
                    *(u32x4*)(Y + off + bj * HALF) = w; } }
    }
};
}

constexpr int RING_BYTES = 131072;
constexpr int MISC_OFF = RING_BYTES + 320;
constexpr int LDS_BYTES = 147456;

__constant__ float ROPE_FREQ[32] = {
1.000000000e+00f, 7.498942614e-01f, 5.623413324e-01f, 4.216965139e-01f, 3.162277639e-01f, 2.371373773e-01f, 1.778279394e-01f, 1.333521307e-01f, 1.000000015e-01f, 7.498941571e-02f, 5.623413250e-02f, 4.216965288e-02f, 3.162277490e-02f, 2.371373773e-02f, 1.778279431e-02f, 1.333521493e-02f, 9.999999776e-03f, 7.498941850e-03f, 5.623413250e-03f, 4.216964822e-03f, 3.162277630e-03f, 2.371373586e-03f, 1.778279431e-03f, 1.333521446e-03f, 1.000000047e-03f, 7.498942432e-04f, 5.623413017e-04f, 4.216965172e-04f, 3.162277571e-04f, 2.371373703e-04f, 1.778279402e-04f, 1.333521504e-04f};

struct Args { const float* in[23]; float* out; unsigned char* ws; int ph_lo, ph_hi; };

struct Ctx {
    LAS unsigned char* lds;
    int tid, lane, wave, G, bid;
    __device__ __forceinline__ void launder() { asm volatile("" : "+v"(tid)); lane = tid & 63; asm volatile("" : "+s"(inp));
        GAS unsigned char* g = (GAS unsigned char*)ws; asm volatile("" : "+s"(g)); ws = (unsigned char*)g;
        GAS float* gx = (GAS float*)X; asm volatile("" : "+s"(gx)); X = (float*)gx; }
    const GAS float* const __attribute__((address_space(4)))* inp; float* X; unsigned char* ws;
    __device__ __forceinline__ const float* in(int k) const { return (const float*)inp[k]; }
};

__device__ __forceinline__ void transpose_item(const float* W, int ldw, int src_col0, bf16* WT, int K, int dst_row0, int kb, LAS float* scr, int lane) {
    const int k0 = 64 * kb;
#pragma unroll 8
    for (int i = 0; i < 32; ++i) { const int kk = 2 * i + (lane >> 5); scr[kk * 33 + (lane & 31)] = W[(size_t)(k0 + kk) * ldw + src_col0 + (lane & 31)]; }
    LDS_WAIT(); asm volatile("" ::: "memory");
    const int c = lane & 7;
#pragma unroll
    for (int j = 0; j < 4; ++j) { const int n = (lane >> 3) + 8 * j; const LAS float* s = scr + (8 * c) * 33 + n;
        v4u o; o.x = pk2(s[0 * 33], s[1 * 33]); o.y = pk2(s[2 * 33], s[3 * 33]); o.z = pk2(s[4 * 33], s[5 * 33]); o.w = pk2(s[6 * 33], s[7 * 33]);
        *(v4u*)(WT + (size_t)(dst_row0 + n) * K + k0 + 8 * c) = o; }
    LDS_WAIT(); asm volatile("" ::: "memory");
}
__device__ __forceinline__ int win_small_src(int i) { return i < 16 ? 1536 + i : i < 40 ? 2832 + (i - 16) : i < 44 ? 4392 + (i - 40) : i < 48 ? 4396 + (i - 44) : -1; }
__device__ __forceinline__ int win_src_col(int n) { return n < 1536 ? n : n < 2816 ? n + 16 : n < 4352 ? n + 40 : win_small_src(n - 4352); }

__device__ __forceinline__ void phase_prep_weights(const Ctx& C, int l) {
    LAS float* scr = (LAS float*)(C.lds + C.wave * 16384);
    const int gw = C.bid * NWAVES + C.wave, NGW = C.G * NWAVES;
    unsigned char* ws = C.ws;
    constexpr int I_GU = 16 * 88, I_DN = 44 * 32, I_WIN = 16 * 136, I_GT = 16 * 96, I_BR = 3 * 8 * 32, I_OUT = 16 * 32, I_C1 = 2 * 32 * 8, I_C2 = 2 * 4 * 2;
    constexpr int I_FFN = 2 * I_GU + I_DN;
    constexpr int NITEMS = 2 * I_FFN + I_WIN + I_GT + I_BR + I_OUT + I_C1 + I_C2;
    for (int it = gw; it < NITEMS; it += NGW) {
        int r = it;
        if (r < 2 * I_FFN) {
            const int f = r / I_FFN; r -= f * I_FFN;
            const float* wg = (f ? C.in(20) : C.in(2)) + (size_t)l * DM * DFF; const float* wu = (f ? C.in(21) : C.in(3)) + (size_t)l * DM * DFF; const float* wd = (f ? C.in(22) : C.in(4)) + (size_t)l * DFF * DM;
            bf16* WGU = (bf16*)(ws + (f ? WS_WGU2 : WS_WGU1)); bf16* WDN = (bf16*)(ws + (f ? WS_WDN2 : WS_WDN1));
            if (r < I_GU) { const int kb = r / 88, col = 32 * (r % 88); transpose_item(wg, DFF, col, WGU, DM, 256 * (col >> 7) + (col & 127), kb, scr, C.lane); }
            else if (r < 2 * I_GU) { r -= I_GU; const int kb = r / 88, col = 32 * (r % 88); transpose_item(wu, DFF, col, WGU, DM, 256 * (col >> 7) + 128 + (col & 127), kb, scr, C.lane); }
            else { r -= 2 * I_GU; const int kb = r / 32, col = 32 * (r % 32); transpose_item(wd, DM, col, WDN, DFF, col, kb, scr, C.lane); }
            continue;
        }
        r -= 2 * I_FFN;
        const float* win = C.in(6) + (size_t)l * DM * N_IN;
        if (r < I_WIN) { const int kb = r / 136, n = 32 * (r % 136); transpose_item(win, N_IN, win_src_col(n), (bf16*)(ws + WS_WIN), DM, n, kb, scr, C.lane); continue; } r -= I_WIN;
        if (r < I_GT) { const int kb = r / 96, n = 32 * (r % 96); transpose_item(win, N_IN, 4400 + n, (bf16*)(ws + WS_WGT), DM, n, kb, scr, C.lane); continue; } r -= I_GT;
        if (r < I_BR) { const int i = r / 256, rr = r % 256, kb = rr / 32, n = 32 * (rr % 32);
            transpose_item(C.in(17) + ((size_t)l * 3 + i) * 512 * DM, DM, n, (bf16*)(ws + WS_WBR) + (size_t)i * DM * 512, 512, n, kb, scr, C.lane); continue; } r -= I_BR;
        if (r < I_OUT) { const int kb = r / 32, n = 32 * (r % 32); transpose_item(C.in(18) + (size_t)l * DM * DM, DM, n, (bf16*)(ws + WS_WOUT), DM, n, kb, scr, C.lane); continue; } r -= I_OUT;
        if (r < I_C1) { const int kv = r / 256, rr = r % 256, kb = rr / 8, n = 32 * (rr % 8);
            transpose_item(C.in(13) + ((size_t)l * 2 + kv) * 2048 * 256, 256, n, (bf16*)(ws + WS_CW1) + (size_t)kv * 256 * 2048, 2048, n, kb, scr, C.lane); continue; } r -= I_C1;
        { const int kv = r / 8, rr = r % 8, kb = rr / 2, n = 32 * (rr % 2);
            transpose_item(C.in(14) + ((size_t)l * 2 + kv) * 256 * 64, 64, n, (bf16*)(ws + WS_CW2) + (size_t)kv * 64 * 256, 256, n, kb, scr, C.lane); }
    }
    const int gt = C.bid * NTHR + C.tid, NGT = C.G * NTHR;
    {
        const float* win = C.in(6) + (size_t)l * DM * N_IN; bf16* WIN = (bf16*)(ws + WS_WIN);
        for (int idx = gt; idx < 256 * 128; idx += NGT) { const int i = idx & 255, kc = idx >> 8; const int sc = win_small_src(i);
            v4u o = (v4u){0u, 0u, 0u, 0u};
            if (sc >= 0) { float v[8];
#pragma unroll
                for (int j = 0; j < 8; ++j) v[j] = win[(size_t)(kc * 8 + j) * N_IN + sc];
                o.x = pk2(v[0], v[1]); o.y = pk2(v[2], v[3]); o.z = pk2(v[4], v[5]); o.w = pk2(v[6], v[7]); }
            *(v4u*)(WIN + (size_t)(4352 + i) * DM + kc * 8) = o; }
        float* vec = (float*)(ws + WS_VEC); const float* bin = C.in(7) + (size_t)l * N_IN;
        for (int n = gt; n < 4608; n += NGT) { const int sc = win_src_col(n); vec[VEC_BINP + n] = sc >= 0 ? bin[sc] : 0.f; }
        for (int it = gw; it < 512; it += NGW) { const int kv = it >> 8, n = it & 255;
            const float* pe = C.in(12) + ((size_t)l * 2 + kv) * 2048; const float* w1 = C.in(13) + ((size_t)l * 2 + kv) * 2048 * 256;
            float s = 0.f;
            for (int k = C.lane; k < 2048; k += 64) s += pe[k] * w1[(size_t)k * 256 + n];
            s = wave_sum(s);
            if (C.lane == 0) vec[VEC_CB1 + it] = s; }
    }
}

__device__ __forceinline__ void phase_init(const Ctx& C) {
    const int gt = C.bid * NTHR + C.tid, NGT = C.G * NTHR;
    const f32x4* src = (const f32x4*)C.in(0); f32x4* dst = (f32x4*)C.X;
    for (size_t i = gt; i < (size_t)T * DM / 4; i += NGT) dst[i] = src[i];
    f32x2* rope = (f32x2*)(C.ws + WS_ROPE);
    for (int i = gt; i < SEQ * 32; i += NGT) { const int pos = i >> 5, fi = i & 31;
        const float ang = (float)pos * ROPE_FREQ[fi];
        double rev = (double)ang * 0.15915494309189533577; rev -= floor(rev);
        const float rf = (float)rev;
        rope[i] = (f32x2){__builtin_amdgcn_cosf(rf), __builtin_amdgcn_sinf(rf)}; }
}

__device__ __forceinline__ void phase_norm(const Ctx& C, const float* gain) {
    const int gw = C.bid * NWAVES + C.wave, NGW = C.G * NWAVES;
    bf16* XN = (bf16*)(C.ws + WS_XN);
    f32x4 g[4];
#pragma unroll
    for (int j = 0; j < 4; ++j) g[j] = ((const f32x4*)gain)[C.lane + 64 * j];
    for (int m = gw; m < T; m += NGW) {
        const f32x4* xr = (const f32x4*)(C.X + (size_t)m * DM) + C.lane;
        f32x4 v[4]; float s = 0.f;
#pragma unroll
        for (int j = 0; j < 4; ++j) { v[j] = xr[64 * j]; s += (v[j].x * v[j].x + v[j].y * v[j].y) + (v[j].z * v[j].z + v[j].w * v[j].w); }
        const float r = 1.0f / sqrtf(wave_sum(s) * (1.f / DM) + RMS_EPS);
        unsigned long long* o8 = (unsigned long long*)(XN + (size_t)m * DM) + C.lane;
#pragma unroll
        for (int j = 0; j < 4; ++j) { const f32x4 w = v[j] * r * g[j]; o8[64 * j] = (unsigned long long)pk2(w.x, w.y) | ((unsigned long long)pk2(w.z, w.w) << 32); }
    }
}

template <int KSTEPS, class PA, class PB>
__device__ __forceinline__ f32x4 mma_tile(PA A, int lda, PB Bt, int ldb, f32x4 acc, int lane) {
    const int r = lane & 15, q = lane >> 4;
#pragma unroll
    for (int kk = 0; kk < KSTEPS; ++kk) {
        const bf16x8 a = *(const bf16x8*)(A + r * lda + kk * 32 + 8 * q);
        const bf16x8 b = *(const bf16x8*)(Bt + r * ldb + kk * 32 + 8 * q);
        acc = __builtin_amdgcn_mfma_f32_16x16x32_bf16(a, b, acc, 0, 0, 0);
    }
    return acc;
}
__device__ __forceinline__ float wave_scan_sum(float v, int lane) {
#pragma unroll
    for (int o = 1; o < 64; o <<= 1) { const float t = __shfl_up(v, o); if (lane >= o) v += t; }
    return v;
}
__device__ __forceinline__ float wave_scan_max(float v, int lane) {
#pragma unroll
    for (int o = 1; o < 64; o <<= 1) { const float t = __shfl_up(v, o); if (lane >= o) v = fmaxf(v, t); }
    return v;
}

constexpr int CU_ALR = 0;
constexpr int CU_GT = 4096;
constexpr int CU_VEC = 6144;
constexpr int CU_KT = 8192;
constexpr int CU_VT = 17408;
constexpr int CU_Q = 35840;
constexpr int CU_AT = 45056;
constexpr int CU_O = 54272;
constexpr int CU_END = 88064;

__device__ __forceinline__ void load_vt(const Ctx& C, const bf16* V, int t0, int h) {
    LAS bf16* VT = (LAS bf16*)(C.lds + CU_VT);
    const int dv = C.tid & 127, jq = C.tid >> 7;
    const bf16* src = V + (size_t)(t0 + 16 * jq) * 512 + h * 128 + dv;
    unsigned w[8];
#pragma unroll
    for (int jj = 0; jj < 8; ++jj) { const unsigned lo = src[(size_t)(2 * jj) * 512], hi = src[(size_t)(2 * jj + 1) * 512]; w[jj] = lo | (hi << 16); }
    *(LAS v4u*)(VT + dv * 72 + 16 * jq) = (v4u){w[0], w[1], w[2], w[3]};
    *(LAS v4u*)(VT + dv * 72 + 16 * jq + 8) = (v4u){w[4], w[5], w[6], w[7]};
}

__device__ __forceinline__ float gla_cumsum(const Ctx& C, int l, int t0, int h, float (&b)[8]) {
    LAS float* ALR = (LAS float*)(C.lds + CU_ALR); LAS float* GT = (LAS float*)(C.lds + CU_GT);
    const float* SMALL = (const float*)(C.ws + WS_SMALL);
    if (C.tid < 256) { const int j = C.tid >> 2, c4 = C.tid & 3; *(LAS f32x4*)(ALR + j * 16 + 4 * c4) = *(const f32x4*)(SMALL + (size_t)(t0 + j) * 64 + 4 * c4); }
    const int dk = C.tid & 63, jg = C.tid >> 6;
    float w[16]; const float* wa = C.in(8) + (size_t)l * 16 * 256 + h * 64 + dk;
#pragma unroll
    for (int r = 0; r < 16; ++r) w[r] = wa[r * 256];
    const float ba = C.in(9)[(size_t)l * 256 + h * 64 + dk];
    __syncthreads();
    float run = 0.f;
#pragma unroll
    for (int jj = 0; jj < 8; ++jj) { const int j = 8 * jg + jj; float x = ba;
#pragma unroll
        for (int r = 0; r < 16; ++r) x += ALR[j * 16 + r] * w[r];
        run += logsigmoidf_(x) * (1.0f / 16.0f); b[jj] = run; }
    GT[jg * 64 + dk] = run;
    __syncthreads();
    float pre = 0.f, tot = 0.f;
#pragma unroll
    for (int g2 = 0; g2 < 8; ++g2) { const float v = GT[g2 * 64 + dk]; tot += v; if (g2 < jg) pre += v; }
#pragma unroll
    for (int jj = 0; jj < 8; ++jj) b[jj] += pre;
    return tot;
}

__device__ __forceinline__ void gla_unit_a(const Ctx& C, int l, int ci) {
    const int bh = ci >> 8, c = ci & 255, bb = bh >> 2, h = bh & 3, t0 = bb * SEQ + c * 64;
    const bf16* QKA = (const bf16*)(C.ws + WS_QKA);
    load_vt(C, (const bf16*)(C.ws + WS_VA), t0, h);
    const int dk = C.tid & 63, jg = C.tid >> 6;
    unsigned kraw[8];
#pragma unroll
    for (int jj = 0; jj < 8; ++jj) kraw[jj] = QKA[(size_t)(t0 + 8 * jg + jj) * 512 + 256 + h * 64 + dk];
    float b[8]; const float btot = gla_cumsum(C, l, t0, h, b);
    LAS bf16* KT = (LAS bf16*)(C.lds + CU_KT);
    float kd[8];
#pragma unroll
    for (int jj = 0; jj < 8; ++jj) { const float k = bf2f(kraw[jj]); kd[jj] = k * fexp(btot - b[jj]); }
    *(LAS v4u*)(KT + dk * 72 + 8 * jg) = (v4u){pk2(kd[0], kd[1]), pk2(kd[2], kd[3]), pk2(kd[4], kd[5]), pk2(kd[6], kd[7])};
    if (jg == 0) ((float*)(C.ws + WS_GDEC))[(size_t)ci * 64 + dk] = fexp(btot);
    __syncthreads();
    const LAS bf16* VT = (const LAS bf16*)(C.lds + CU_VT);
    bf16* GST = (bf16*)(C.ws + WS_GST) + (size_t)ci * 8192;
    const int q = C.lane >> 4, fr = C.lane & 15;
#pragma unroll
    for (int nt = 0; nt < 4; ++nt) {
        f32x4 acc = (f32x4){0.f, 0.f, 0.f, 0.f};
        acc = mma_tile<2>(VT + 16 * C.wave * 72, 72, (const LAS bf16*)KT + 16 * nt * 72, 72, acc, C.lane);
#pragma unroll
        for (int r = 0; r < 4; ++r) GST[(16 * C.wave + 4 * q + r) * 64 + 16 * nt + fr] = (bf16)f2bf(acc[r]);
    }
    __syncthreads();
}

__device__ __forceinline__ void gla_unit_c(const Ctx& C, int l, int ci, bool DRY) {
    const int bh = ci >> 8, c = ci & 255, bb = bh >> 2, h = bh & 3, t0 = bb * SEQ + c * 64;
    const bf16* QKA = (const bf16*)(C.ws + WS_QKA);
    load_vt(C, (const bf16*)(C.ws + WS_VA), t0, h);
    const int dk = C.tid & 63, jg = C.tid >> 6;
    unsigned qraw[8], kraw[8];
#pragma unroll
    for (int jj = 0; jj < 8; ++jj) { const bf16* p = QKA + (size_t)(t0 + 8 * jg + jj) * 512 + h * 64 + dk; qraw[jj] = p[0]; kraw[jj] = p[256]; }
    bf16x8 stf[4][2];
    { const bf16* ST = (const bf16*)(C.ws + WS_GST) + (size_t)ci * 8192 + (size_t)(16 * 4 * (C.wave >> 2) + (C.lane & 15)) * 64 + 8 * (C.lane >> 4);
#pragma unroll
      for (int u = 0; u < 4; ++u) { stf[u][0] = *(const bf16x8*)(ST + u * 16 * 64); stf[u][1] = *(const bf16x8*)(ST + u * 16 * 64 + 32); } }
    v4u ar0, ar1;
    { const bf16* RAp = (const bf16*)(C.ws + WS_RA) + (size_t)(t0 + (C.tid >> 3)) * 512 + h * 128 + 16 * (C.tid & 7); ar0 = *(const v4u*)RAp; ar1 = *(const v4u*)(RAp + 8); }
    float b[8]; (void)gla_cumsum(C, l, t0, h, b);
    LAS bf16* KT = (LAS bf16*)(C.lds + CU_KT); LAS bf16* QT = (LAS bf16*)(C.lds + CU_Q); LAS bf16* AT = (LAS bf16*)(C.lds + CU_AT);
#pragma unroll
    for (int jj = 0; jj < 8; ++jj) { const int j = 8 * jg + jj;
        const float qv = bf2f(qraw[jj]) * 0.125f, kv = bf2f(kraw[jj]);
        QT[j * 72 + dk] = (bf16)f2bf(qv * fexp(b[jj])); KT[j * 72 + dk] = (bf16)f2bf(kv * fexp(fminf(-b[jj], 80.f))); }
    __syncthreads();
    const int q = C.lane >> 4, fr = C.lane & 15;
    {
        const int it = C.wave >> 1;
#pragma unroll
        for (int u = 0; u < 2; ++u) { const int jt = 2 * (C.wave & 1) + u;
            f32x4 acc = (f32x4){0.f, 0.f, 0.f, 0.f};
            if (jt <= it) acc = mma_tile<2>((const LAS bf16*)KT + 16 * jt * 72, 72, (const LAS bf16*)QT + 16 * it * 72, 72, acc, C.lane);
            const int i = 16 * it + fr;
            float v[4];
#pragma unroll
            for (int r = 0; r < 4; ++r) { const int j = 16 * jt + 4 * q + r; v[r] = (j <= i) ? acc[r] : 0.f; }
            *(LAS v2u*)(AT + i * 72 + 16 * jt + 4 * q) = (v2u){pk2(v[0], v[1]), pk2(v[2], v[3])}; }
    }
    __syncthreads();
    {
        const int it = C.wave & 3; LAS float* O = (LAS float*)(C.lds + CU_O);
        const LAS bf16* VT = (const LAS bf16*)(C.lds + CU_VT);
#pragma unroll
        for (int u = 0; u < 4; ++u) { const int dvt = 4 * (C.wave >> 2) + u;
            f32x4 acc = (f32x4){0.f, 0.f, 0.f, 0.f};
#pragma unroll
            for (int kk = 0; kk < 2; ++kk) { const bf16x8 a = *(const LAS bf16x8*)((const LAS bf16*)QT + (16 * it + fr) * 72 + kk * 32 + 8 * q); acc = __builtin_amdgcn_mfma_f32_16x16x32_bf16(a, stf[u][kk], acc, 0, 0, 0); }
            acc = mma_tile<2>((const LAS bf16*)AT + 16 * it * 72, 72, VT + 16 * dvt * 72, 72, acc, C.lane);
#pragma unroll
            for (int r = 0; r < 4; ++r) O[(16 * it + 4 * q + r) * 132 + 16 * dvt + fr] = acc[r]; }
    }
    __syncthreads();
    {
        const int i = C.tid >> 3, s = C.tid & 7; const LAS float* O = (const LAS float*)(C.lds + CU_O) + i * 132 + 16 * s;
        float o[16]; float ss = 0.f;
#pragma unroll
        for (int k = 0; k < 16; ++k) { o[k] = O[k]; ss += o[k] * o[k]; }
        ss += __shfl_xor(ss, 1); ss += __shfl_xor(ss, 2); ss += __shfl_xor(ss, 4);
        const float rinv = 1.0f / sqrtf(ss * (1.0f / 128.0f) + RMS_EPS);
        bf16* RA = (bf16*)(C.ws + WS_RA) + (size_t)(t0 + i) * 512 + h * 128 + 16 * s;
        const float* gn = C.in(10) + (size_t)l * 128 + 16 * s;
        const v4u r0 = ar0, r1 = ar1;
        unsigned rw[8] = {r0.x, r0.y, r0.z, r0.w, r1.x, r1.y, r1.z, r1.w}; unsigned ow[8];
#pragma unroll
        for (int k = 0; k < 8; ++k) { const float a = SCL_A * o[2 * k] * rinv * gn[2 * k] * siluf_(bflo(rw[k])), bq = SCL_A * o[2 * k + 1] * rinv * gn[2 * k + 1] * siluf_(bfhi(rw[k])); ow[k] = (ABL_ZERO & 1) ? 0u : pk2(a, bq); }
        if (DRY) { asm volatile("" :: "v"(ow[0]), "v"(ow[1]), "v"(ow[2]), "v"(ow[3]), "v"(ow[4]), "v"(ow[5]), "v"(ow[6]), "v"(ow[7])); } else {
        *(v4u*)RA = (v4u){ow[0], ow[1], ow[2], ow[3]}; *(v4u*)(RA + 8) = (v4u){ow[4], ow[5], ow[6], ow[7]}; }
    }
    __syncthreads();
}

__device__ __forceinline__ void conv_silu8(const Ctx& C, int l, int t0, int c, int ch, int jg, float (&out)[8]) {
    const bf16* X = (const bf16*)(C.ws + WS_QKC);
    const float* cw = C.in(15) + (size_t)l * 4 * 512 + ch; const float cb = C.in(16)[(size_t)l * 512 + ch];
    const float w0 = cw[0], w1 = cw[512], w2 = cw[1024], w3 = cw[1536];
    float x[11];
#pragma unroll
    for (int k = 0; k < 11; ++k) { const int j = 8 * jg + k - 3; const int s = c * 64 + j; x[k] = (s >= 0) ? bf2f(X[(size_t)(t0 + j) * 512 + ch]) : 0.f; }
#pragma unroll
    for (int jj = 0; jj < 8; ++jj) out[jj] = siluf_(cb + w0 * x[jj] + w1 * x[jj + 1] + w2 * x[jj + 2] + w3 * x[jj + 3]);
}

__device__ __forceinline__ void mlstm_unit_a(const Ctx& C, int l, int ci) {
    const int bh = ci >> 8, c = ci & 255, bb = bh >> 2, h = bh & 3, t0 = bb * SEQ + c * 64;
    LAS float* VEC = (LAS float*)(C.lds + CU_VEC); LAS float* GT = (LAS float*)(C.lds + CU_GT);
    load_vt(C, (const bf16*)(C.ws + WS_VC), t0, h);
    const int dk = C.tid & 63, jg = C.tid >> 6;
    float k[8]; conv_silu8(C, l, t0, c, 256 + h * 64 + dk, jg, k);
    if (C.wave == 0) {
        const float* sm = (const float*)(C.ws + WS_SMALL) + (size_t)(t0 + C.lane) * 64;
        const float ip = sm[40 + h], lf = logsigmoidf_(sm[44 + h]);
        const float bj = wave_scan_sum(lf, C.lane); const float a = ip - bj; const float amax = wave_max(a);
        VEC[C.lane] = fexp(a - amax);
        if (C.lane == 63) { float* msc = (float*)(C.ws + WS_MSC) + (size_t)ci * 4; msc[0] = bj; msc[1] = amax; }
    }
    __syncthreads();
    LAS bf16* KT = (LAS bf16*)(C.lds + CU_KT);
    float kw[8]; float ns = 0.f;
#pragma unroll
    for (int jj = 0; jj < 8; ++jj) { kw[jj] = k[jj] * 0.125f * VEC[8 * jg + jj]; ns += kw[jj]; }
    *(LAS v4u*)(KT + dk * 72 + 8 * jg) = (v4u){pk2(kw[0], kw[1]), pk2(kw[2], kw[3]), pk2(kw[4], kw[5]), pk2(kw[6], kw[7])};
    GT[jg * 64 + dk] = ns;
    __syncthreads();
    if (C.tid < 64) { float s = 0.f;
#pragma unroll
        for (int g2 = 0; g2 < 8; ++g2) s += GT[g2 * 64 + C.tid];
        ((float*)(C.ws + WS_MN))[(size_t)ci * 64 + C.tid] = s; }
    const LAS bf16* VT = (const LAS bf16*)(C.lds + CU_VT);
    bf16* MST = (bf16*)(C.ws + WS_MST) + (size_t)ci * 8192;
    const int q = C.lane >> 4, fr = C.lane & 15;
#pragma unroll
    for (int nt = 0; nt < 4; ++nt) {
        f32x4 acc = (f32x4){0.f, 0.f, 0.f, 0.f};
        acc = mma_tile<2>(VT + 16 * C.wave * 72, 72, (const LAS bf16*)KT + 16 * nt * 72, 72, acc, C.lane);
#pragma unroll
        for (int r = 0; r < 4; ++r) MST[(16 * C.wave + 4 * q + r) * 64 + 16 * nt + fr] = (bf16)f2bf(acc[r]);
    }
    __syncthreads();
}

__device__ __forceinline__ void mlstm_unit_c(const Ctx& C, int l, int ci, bool DRY) {
    const int bh = ci >> 8, c = ci & 255, bb = bh >> 2, h = bh & 3, t0 = bb * SEQ + c * 64;
    LAS float* VEC = (LAS float*)(C.lds + CU_VEC);
    LAS float* AJ = VEC + 64, *MI = VEC + 128, *WI = VEC + 192, *EM = VEC + 256, *QN = VEC + 384; LAS float* DENP = (LAS float*)(C.lds + CU_GT);
    load_vt(C, (const bf16*)(C.ws + WS_VC), t0, h);
    const int dk = C.tid & 63, jg = C.tid >> 6;
    LAS bf16* KT = (LAS bf16*)(C.lds + CU_KT); LAS bf16* QT = (LAS bf16*)(C.lds + CU_Q); LAS bf16* AT = (LAS bf16*)(C.lds + CU_AT);
    bf16x8 stf[4][2];
    { const bf16* ST = (const bf16*)(C.ws + WS_MST) + (size_t)ci * 8192 + (size_t)(16 * 4 * (C.wave >> 2) + (C.lane & 15)) * 64 + 8 * (C.lane >> 4);
#pragma unroll
      for (int u = 0; u < 4; ++u) { stf[u][0] = *(const bf16x8*)(ST + u * 16 * 64); stf[u][1] = *(const bf16x8*)(ST + u * 16 * 64 + 32); } }
    v4u co0, co1; f32x4 nst0, nst1;
    { const bf16* OCp = (const bf16*)(C.ws + WS_OC) + (size_t)(t0 + (C.tid >> 3)) * 512 + h * 128 + 16 * (C.tid & 7); co0 = *(const v4u*)OCp; co1 = *(const v4u*)(OCp + 8);
      const float* np = (const float*)(C.ws + WS_MN) + (size_t)ci * 64 + 8 * (C.tid & 7); nst0 = *(const f32x4*)np; nst1 = *(const f32x4*)(np + 4); }
    {
        float qv[8], kv[8]; conv_silu8(C, l, t0, c, h * 64 + dk, jg, qv); conv_silu8(C, l, t0, c, 256 + h * 64 + dk, jg, kv);
#pragma unroll
        for (int jj = 0; jj < 8; ++jj) { const int j = 8 * jg + jj; QT[j * 72 + dk] = (bf16)f2bf(qv[jj]); KT[j * 72 + dk] = (bf16)f2bf(kv[jj] * 0.125f); }
    }
    if (C.wave == 0) {
        const float* sm = (const float*)(C.ws + WS_SMALL) + (size_t)(t0 + C.lane) * 64;
        const float ip = sm[40 + h], lf = logsigmoidf_(sm[44 + h]);
        const float bj = wave_scan_sum(lf, C.lane); const float a = ip - bj; const float arun = wave_scan_max(a, C.lane);
        const float mst = ((const float*)(C.ws + WS_MSC))[(size_t)ci * 4 + 2];
        const float mi = fmaxf(mst, arun);
        AJ[C.lane] = a; MI[C.lane] = mi; WI[C.lane] = fexp(mst - mi); EM[C.lane] = fexp(-(bj + mi));
    }
    __syncthreads();
    const int q = C.lane >> 4, fr = C.lane & 15;
    {
        const int it = C.wave >> 1;
#pragma unroll
        for (int u = 0; u < 2; ++u) { const int jt = 2 * (C.wave & 1) + u;
            f32x4 acc = (f32x4){0.f, 0.f, 0.f, 0.f};
            if (jt <= it) acc = mma_tile<2>((const LAS bf16*)KT + 16 * jt * 72, 72, (const LAS bf16*)QT + 16 * it * 72, 72, acc, C.lane);
            const int i = 16 * it + fr; const float mi = MI[i];
            float v[4]; float ds = 0.f;
#pragma unroll
            for (int r = 0; r < 4; ++r) { const int j = 16 * jt + 4 * q + r; v[r] = (j <= i) ? acc[r] * fexp(AJ[j] - mi) : 0.f; ds += v[r]; }
            ds += __shfl_xor(ds, 16); ds += __shfl_xor(ds, 32);
            if (q == 0) DENP[jt * 64 + i] = ds;
            *(LAS v2u*)(AT + i * 72 + 16 * jt + 4 * q) = (v2u){pk2(v[0], v[1]), pk2(v[2], v[3])}; }
    }
    {
        const int i = C.tid >> 3, s = C.tid & 7; const float nst[8] = {nst0[0], nst0[1], nst0[2], nst0[3], nst1[0], nst1[1], nst1[2], nst1[3]};
        float a = 0.f;
#pragma unroll
        for (int k = 0; k < 8; ++k) a += bf2f(QT[i * 72 + 8 * s + k]) * nst[k];
        a += __shfl_xor(a, 1); a += __shfl_xor(a, 2); a += __shfl_xor(a, 4);
        if (s == 0) QN[i] = a;
    }
    __syncthreads();
    {
        const int it = C.wave & 3; LAS float* O = (LAS float*)(C.lds + CU_O);
        const LAS bf16* VT = (const LAS bf16*)(C.lds + CU_VT);
#pragma unroll
        for (int u = 0; u < 4; ++u) { const int dvt = 4 * (C.wave >> 2) + u;
            f32x4 a1 = (f32x4){0.f, 0.f, 0.f, 0.f}, a2 = (f32x4){0.f, 0.f, 0.f, 0.f};
#pragma unroll
            for (int kk = 0; kk < 2; ++kk) { const bf16x8 a = *(const LAS bf16x8*)((const LAS bf16*)QT + (16 * it + fr) * 72 + kk * 32 + 8 * q); a1 = __builtin_amdgcn_mfma_f32_16x16x32_bf16(a, stf[u][kk], a1, 0, 0, 0); }
            a2 = mma_tile<2>((const LAS bf16*)AT + 16 * it * 72, 72, VT + 16 * dvt * 72, 72, a2, C.lane);
#pragma unroll
            for (int r = 0; r < 4; ++r) { const int i = 16 * it + 4 * q + r; O[i * 132 + 16 * dvt + fr] = WI[i] * a1[r] + a2[r]; } }
    }
    __syncthreads();
    {
        const int i = C.tid >> 3, s = C.tid & 7; const LAS float* O = (const LAS float*)(C.lds + CU_O) + i * 132 + 16 * s;
        const float den = WI[i] * QN[i] + ((DENP[i] + DENP[64 + i]) + (DENP[128 + i] + DENP[192 + i])); const float dinv = 1.0f / fmaxf(fabsf(den), EM[i]);
        bf16* OC = (bf16*)(C.ws + WS_OC) + (size_t)(t0 + i) * 512 + h * 128 + 16 * s;
        const v4u r0 = co0, r1 = co1;
        unsigned rw[8] = {r0.x, r0.y, r0.z, r0.w, r1.x, r1.y, r1.z, r1.w}; unsigned ow[8];
#pragma unroll
        for (int k = 0; k < 8; ++k) ow[k] = (ABL_ZERO & 4) ? 0u : pk2(SCL_C * O[2 * k] * dinv * sigmoidf_(bflo(rw[k])), SCL_C * O[2 * k + 1] * dinv * sigmoidf_(bfhi(rw[k])));
        if (DRY) { asm volatile("" :: "v"(ow[0]), "v"(ow[1]), "v"(ow[2]), "v"(ow[3]), "v"(ow[4]), "v"(ow[5]), "v"(ow[6]), "v"(ow[7])); } else {
        *(v4u*)OC = (v4u){ow[0], ow[1], ow[2], ow[3]}; *(v4u*)(OC + 8) = (v4u){ow[4], ow[5], ow[6], ow[7]}; }
    }
    __syncthreads();
}

__device__ __forceinline__ void phase_scan(const Ctx& C) {
    const int gt = C.bid * NTHR + C.tid, NGT = C.G * NTHR;
    for (int e = gt; e < 65536 + 65536 + 512; e += NGT) {
        if (e < 65536) {
            const int bh = e >> 13, el = e & 8191, dk = el & 63;
            bf16* st = (bf16*)(C.ws + WS_GST) + (size_t)bh * 256 * 8192 + el; const float* dec = (const float*)(C.ws + WS_GDEC) + (size_t)bh * 256 * 64 + dk;
            float s = 0.f;
            for (int c0 = 0; c0 < 256; c0 += 8) { float L[8], d[8];
#pragma unroll
                for (int k = 0; k < 8; ++k) { L[k] = bf2f(st[(size_t)(c0 + k) * 8192]); d[k] = dec[(c0 + k) * 64]; }
#pragma unroll
                for (int k = 0; k < 8; ++k) { st[(size_t)(c0 + k) * 8192] = (bf16)f2bf(s); s = d[k] * s + L[k]; } }
        } else {
            const bool isn = e >= 131072; const int e2 = e - (isn ? 131072 : 65536);
            const int bh = isn ? (e2 >> 6) : (e2 >> 13), el = isn ? (e2 & 63) : (e2 & 8191);
            bf16* st = (bf16*)(C.ws + WS_MST) + (size_t)bh * 256 * 8192 + el; float* nv = (float*)(C.ws + WS_MN) + (size_t)bh * 256 * 64 + el;
            float* msc = (float*)(C.ws + WS_MSC) + (size_t)bh * 256 * 4;
            float s = 0.f, m = 0.f;
            for (int c0 = 0; c0 < 256; c0 += 8) { float L[8], bl[8], am[8];
#pragma unroll
                for (int k = 0; k < 8; ++k) { L[k] = isn ? nv[(c0 + k) * 64] : bf2f(st[(size_t)(c0 + k) * 8192]); bl[k] = msc[(c0 + k) * 4]; am[k] = msc[(c0 + k) * 4 + 1]; }
#pragma unroll
                for (int k = 0; k < 8; ++k) {
                    const float mn = bl[k] + fmaxf(m, am[k]); const float al = fexp(bl[k] + m - mn), be = fexp(bl[k] + am[k] - mn);
                    if (isn) { nv[(c0 + k) * 64] = s; if (el == 0) msc[(c0 + k) * 4 + 2] = m; } else st[(size_t)(c0 + k) * 8192] = (bf16)f2bf(s);
                    s = al * s + be * L[k]; m = mn; } }
        }
    }
}

__device__ __forceinline__ float gelu_tanh(float x) { const float u = 0.7978845608f * (x + 0.044715f * x * x * x); const float e = __expf(2.0f * u); return 0.5f * x * (2.0f - 2.0f / (1.0f + e)); }

__device__ __forceinline__ void nsa_norm_rope_row(bf16* p, const float* gain, const f32x2* rope_row, float scale, int lane) {
    const float x = bf2f(p[lane]);
    const float ss = wave_sum(x * x);
    const float y = x * (1.0f / sqrtf(ss * (1.0f / 64.0f) + RMS_EPS)) * gain[lane];
    const float pr = __shfl_xor(y, 32);
    const f32x2 cs = rope_row[lane & 31];
    const float o = (lane < 32) ? (y * cs.x - pr * cs.y) : (pr * cs.y + y * cs.x);
    p[lane] = (bf16)f2bf(o * scale);
}
__device__ __forceinline__ void nsa_prep_token(const Ctx& C, int l, int t) {
    const float* gn = C.in(11) + (size_t)l * 4 * 64;
    const f32x2* rr = (const f32x2*)(C.ws + WS_ROPE) + (size_t)(t & (SEQ - 1)) * 32;
    bf16* q = (bf16*)(C.ws + WS_QB) + (size_t)t * 512;
#pragma unroll 1
    for (int hh = 0; hh < 8; ++hh) nsa_norm_rope_row(q + hh * 64, gn, rr, 0.125f, C.lane);
    bf16* ks = (bf16*)(C.ws + WS_KVS) + (size_t)t * 256; bf16* kw = (bf16*)(C.ws + WS_KVW) + (size_t)t * 256;
#pragma unroll 1
    for (int g = 0; g < 2; ++g) { nsa_norm_rope_row(ks + g * 64, gn + 128, rr, 1.0f, C.lane); nsa_norm_rope_row(kw + g * 64, gn + 192, rr, 1.0f, C.lane); }
}
__device__ __forceinline__ void nsa_vtrans_item(const Ctx& C, int item) {
    const int which = item >> 10, bg = (item >> 8) & 3, blk = item & 255, b = bg >> 1, g = bg & 1;
    const bf16* src = (const bf16*)(C.ws + (which ? WS_KVW : WS_KVS)) + (size_t)(b * SEQ + blk * 64 + C.lane) * 256 + 128 + g * 64;
    bf16* dst = (bf16*)(C.ws + (which ? WS_VWT : WS_VST)) + (size_t)(bg * 256 + blk) * 4096 + C.lane;
    v4u w[8];
#pragma unroll
    for (int k = 0; k < 8; ++k) w[k] = ((const v4u*)src)[k];
#pragma unroll
    for (int k = 0; k < 8; ++k)
#pragma unroll
        for (int e = 0; e < 4; ++e) { const unsigned x = w[k][e]; dst[(size_t)(8 * k + 2 * e) * 64] = (bf16)(x & 0xffffu); dst[(size_t)(8 * k + 2 * e + 1) * 64] = (bf16)(x >> 16); }
}
__device__ __forceinline__ void nsa_cmp1_item(const Ctx& C, int item) {
    const int kv = item >> 10, rt = (item >> 2) & 255, ng = item & 3;
    const int fr = C.lane & 15, q = C.lane >> 4;
    const int ri = rt * 16 + fr, b = ri >> 11, g = (ri >> 10) & 1, c = ri & 1023, cc = c < 1023 ? c : 1022;
    const bf16* arow = (const bf16*)(C.ws + WS_KVC) + (size_t)(b * SEQ + 16 * cc) * 256 + kv * 128 + g * 64 + 8 * q;
    const bf16* brow = (const bf16*)(C.ws + WS_CW1) + (size_t)kv * 256 * 2048 + (size_t)(ng * 64 + fr) * 2048 + 8 * q;
    f32x4 acc[4];
#pragma unroll
    for (int nt = 0; nt < 4; ++nt) acc[nt] = (f32x4){0.f, 0.f, 0.f, 0.f};
#pragma unroll 4
    for (int kk = 0; kk < 64; ++kk) {
        const bf16x8 a = *(const bf16x8*)(arow + (kk >> 1) * 256 + (kk & 1) * 32);
#pragma unroll
        for (int nt = 0; nt < 4; ++nt) { const bf16x8 bv = *(const bf16x8*)(brow + (size_t)nt * 16 * 2048 + kk * 32); acc[nt] = __builtin_amdgcn_mfma_f32_16x16x32_bf16(a, bv, acc[nt], 0, 0, 0); }
    }
    const float* cb1 = (const float*)(C.ws + WS_VEC) + VEC_CB1 + kv * 256;
    bf16* H1 = (bf16*)(C.ws + WS_CMPH) + (size_t)kv * 4096 * 256;
#pragma unroll
    for (int nt = 0; nt < 4; ++nt) { const int n = ng * 64 + nt * 16 + fr; const float bia = cb1[n];
#pragma unroll
        for (int r = 0; r < 4; ++r) H1[(size_t)(rt * 16 + 4 * q + r) * 256 + n] = (bf16)f2bf(gelu_tanh(acc[nt][r] + bia)); }
}
__device__ __forceinline__ void nsa_cmp2_item(const Ctx& C, int l, int item) {
    const int kv = item >> 8, rt = item & 255;
    const int fr = C.lane & 15, q = C.lane >> 4;
    const bf16* H1 = (const bf16*)(C.ws + WS_CMPH) + (size_t)kv * 4096 * 256 + (size_t)rt * 16 * 256;
    const bf16* W2 = (const bf16*)(C.ws + WS_CW2) + (size_t)kv * 64 * 256;
    f32x4 acc[4];
#pragma unroll
    for (int nt = 0; nt < 4; ++nt) { acc[nt] = (f32x4){0.f, 0.f, 0.f, 0.f}; acc[nt] = mma_tile<8>(H1, 256, W2 + nt * 16 * 256, 256, acc[nt], C.lane); }
    if (kv == 0) {
        const float* gn = C.in(11) + (size_t)l * 4 * 64 + 64;
        bf16* KC = (bf16*)(C.ws + WS_KCMP);
#pragma unroll
        for (int r = 0; r < 4; ++r) {
            float ss = 0.f;
#pragma unroll
            for (int nt = 0; nt < 4; ++nt) ss += acc[nt][r] * acc[nt][r];
            ss += __shfl_xor(ss, 1); ss += __shfl_xor(ss, 2); ss += __shfl_xor(ss, 4); ss += __shfl_xor(ss, 8);
            const float rinv = 1.0f / sqrtf(ss * (1.0f / 64.0f) + RMS_EPS);
            float y[4];
#pragma unroll
            for (int nt = 0; nt < 4; ++nt) y[nt] = acc[nt][r] * rinv * gn[nt * 16 + fr];
            const int ri = rt * 16 + 4 * q + r, c = ri & 1023; int pos = 16 * c + 31; pos = pos < SEQ ? pos : SEQ - 1;
            const f32x2* rr = (const f32x2*)(C.ws + WS_ROPE) + (size_t)pos * 32;
            const f32x2 c0 = rr[fr], c1 = rr[16 + fr];
            bf16* o = KC + (size_t)ri * 64;
            o[fr] = (bf16)f2bf(y[0] * c0.x - y[2] * c0.y); o[16 + fr] = (bf16)f2bf(y[1] * c1.x - y[3] * c1.y);
            o[32 + fr] = (bf16)f2bf(y[0] * c0.y + y[2] * c0.x); o[48 + fr] = (bf16)f2bf(y[1] * c1.y + y[3] * c1.x);
        }
    } else {
        bf16* VCT = (bf16*)(C.ws + WS_VCT);
        const int ri0 = rt * 16, bg = ri0 >> 10, c0 = (ri0 & 1023) + 4 * q;
#pragma unroll
        for (int nt = 0; nt < 4; ++nt) { const int d = nt * 16 + fr;
            *(v2u*)(VCT + (size_t)(bg * 64 + d) * 1024 + c0) = (v2u){pk2(acc[nt][0], acc[nt][1]), pk2(acc[nt][2], acc[nt][3])}; }
    }
}

constexpr int NQ = 32;
constexpr int NU_IMP = 0;
constexpr int NU_SEL = 32768;
constexpr int NU_UM = 33792;
constexpr int NU_UL = 33824;
constexpr int NU_KV = 35072;
constexpr int NU_TILE = 18432;
constexpr int NU_END = NU_KV + 4 * NU_TILE;
constexpr float LOG2E = 1.44269504089f;

struct TileSrc { const bf16* k; int kld; const bf16* v; int vld; };

__device__ __forceinline__ void nsa_fetch(const Ctx& C, const TileSrc& ts, bool on, v4u& kr, v4u& vr) {
    const int r = C.tid >> 3, ch = C.tid & 7;
    if (on) { kr = *(const v4u*)(ts.k + (size_t)r * ts.kld + ch * 8); vr = *(const v4u*)(ts.v + (size_t)r * ts.vld + ch * 8); }
}
__device__ __forceinline__ void nsa_commit(const Ctx& C, int j, bool on, const v4u& kr, const v4u& vr) {
    LAS bf16* KT = (LAS bf16*)(C.lds + NU_KV + j * NU_TILE); LAS bf16* VT = KT + 64 * 72;
    const int r = C.tid >> 3, ch = C.tid & 7;
    if (on) { *(LAS v4u*)(KT + r * 72 + ch * 8) = kr; *(LAS v4u*)(VT + r * 72 + ch * 8) = vr; }
}
__device__ __forceinline__ void nsa_scores(const Ctx& C, int j, const bf16x8 (&qf)[2], f32x4 (&s)[4]) {
    const LAS bf16* KT = (const LAS bf16*)(C.lds + NU_KV + j * NU_TILE);
    const int fr = C.lane & 15, q = C.lane >> 4;
#pragma unroll
    for (int kt = 0; kt < 4; ++kt) { s[kt] = (f32x4){0.f, 0.f, 0.f, 0.f};
#pragma unroll
        for (int ks = 0; ks < 2; ++ks) { const bf16x8 a = *(const LAS bf16x8*)(KT + (16 * kt + fr) * 72 + ks * 32 + 8 * q); s[kt] = __builtin_amdgcn_mfma_f32_16x16x32_bf16(a, qf[ks], s[kt], 0, 0, 0); } }
}
__device__ __forceinline__ void nsa_pv(const Ctx& C, int j, const f32x4 (&p)[4], f32x4 (&o)[4]) {
    const LAS bf16* VT = (const LAS bf16*)(C.lds + NU_KV + j * NU_TILE) + 64 * 72;
    const int fr = C.lane & 15, q = C.lane >> 4;
    bf16x8 pf[2];
#pragma unroll
    for (int k2 = 0; k2 < 2; ++k2) { v4u w; w.x = pk2(p[2 * k2][0], p[2 * k2][1]); w.y = pk2(p[2 * k2][2], p[2 * k2][3]); w.z = pk2(p[2 * k2 + 1][0], p[2 * k2 + 1][1]); w.w = pk2(p[2 * k2 + 1][2], p[2 * k2 + 1][3]);
        pf[k2] = __builtin_bit_cast(bf16x8, w); }
#pragma unroll
    for (int dt = 0; dt < 4; ++dt)
#pragma unroll
        for (int k2 = 0; k2 < 2; ++k2) {
            const LAS bf16* vr = VT + (16 * dt + fr) * 72 + 32 * k2 + 4 * q;
            const v2u lo = *(const LAS v2u*)vr, hi = *(const LAS v2u*)(vr + 16);
            const v4u aw = (v4u){lo.x, lo.y, hi.x, hi.y};
            o[dt] = __builtin_amdgcn_mfma_f32_16x16x32_bf16(__builtin_bit_cast(bf16x8, aw), pf[k2], o[dt], 0, 0, 0);
        }
}
__device__ __forceinline__ float nsa_exp(f32x4 (&s)[4], float ml2) {
    float ps = 0.f;
#pragma unroll
    for (int kt = 0; kt < 4; ++kt)
#pragma unroll
        for (int r = 0; r < 4; ++r) { const float p = __builtin_amdgcn_exp2f(s[kt][r] * LOG2E - ml2); s[kt][r] = p; ps += p; }
    return ps;
}

__device__ __forceinline__ void nsa_attn_unit(const Ctx& C, int l, int u, bool DRY) {
    const int half = u & 1, uu = u >> 1;
    const int bg = uu & 3, b = bg >> 1, g = bg & 1;
    int qb; { const int rnd = uu >> 8, j = (uu >> 2) & 63; qb = rnd == 0 ? 255 - j : rnd == 1 ? 128 + j : rnd == 2 ? 127 - j : j; }
    const int q0 = 32 * half;
    const int t0 = b * SEQ + qb * 64;
    const int fr = C.lane & 15, q = C.lane >> 4, qq = fr >> 2, hh = fr & 3;
    LAS float* IMP = (LAS float*)(C.lds + NU_IMP);
    LAS unsigned long long* SEL = (LAS unsigned long long*)(C.lds + NU_SEL);
    LAS unsigned long long* UM = (LAS unsigned long long*)(C.lds + NU_UM);
    LAS int* UL = (LAS int*)(C.lds + NU_UL);
    for (int i = C.tid; i < NQ * 256; i += NTHR) IMP[i] = 0.f;
    float mc2, ms2, mw2;
    { const float* gn = C.in(11) + (size_t)l * 256;
      const float gq = wave_max(fabsf(gn[C.lane])), g1 = wave_max(fabsf(gn[64 + C.lane])), g2 = wave_max(fabsf(gn[128 + C.lane])), g3 = wave_max(fabsf(gn[192 + C.lane]));
      mc2 = 8.0f * gq * g1 * LOG2E; ms2 = 8.0f * gq * g2 * LOG2E; mw2 = 8.0f * gq * g3 * LOG2E; }
    bf16* QB = (bf16*)(C.ws + WS_QB);
    const int iq = q0 + 4 * C.wave + qq;
    bf16x8 qf[2]; float gate[3];
    { const bf16* qp = QB + (size_t)(t0 + iq) * 512 + (g * 4 + hh) * 64 + 8 * q;
      qf[0] = *(const bf16x8*)qp; qf[1] = *(const bf16x8*)(qp + 32);
      const float* sm = (const float*)(C.ws + WS_SMALL) + (size_t)(t0 + iq) * 64 + 16 + (g * 4 + hh) * 3;
#pragma unroll
      for (int k = 0; k < 3; ++k) gate[k] = ((ABL_ZERO & 2) || (ABL_ZERO & (8 << k))) ? 0.f : SCL_B * sigmoidf_(sm[k]); }
    f32x4 out[4];
#pragma unroll
    for (int dt = 0; dt < 4; ++dt) out[dt] = (f32x4){0.f, 0.f, 0.f, 0.f};
    v4u kr[4], vr[4];

    const bf16* KC = (const bf16*)(C.ws + WS_KCMP) + (size_t)bg * 1024 * 64;
    const bf16* VCT = (const bf16*)(C.ws + WS_VCT) + (size_t)bg * 64 * 1024;
    const int nct = (4 * qb + 3 + 63) >> 6, ncs = (nct + 3) >> 2;
    const int cmax = (64 * qb + iq - 31) >> 4, cmin = (64 * qb + q0 + 4 * C.wave - 31) >> 4;
    float cl = 0.f, cinv = 0.f;
    for (int rep = (TIMEDUP & 2048) ? 0 : 1; rep < 2; ++rep) { cl = 0.f;
    for (int pass = 0; pass < 2; ++pass) {
        f32x4 ao[4];
#pragma unroll
        for (int dt = 0; dt < 4; ++dt) ao[dt] = (f32x4){0.f, 0.f, 0.f, 0.f};
        if (pass == 1) { float lt = cl; lt += __shfl_xor(lt, 16); lt += __shfl_xor(lt, 32); cinv = lt > 0.f ? 1.0f / lt : 0.f; }
#pragma unroll
        for (int j = 0; j < 4; ++j) { const TileSrc ts{KC + (size_t)j * 64 * 64, 64, VCT + j * 64, 1024}; nsa_fetch(C, ts, j < nct, kr[j], vr[j]); }
        for (int st = 0; st < ncs; ++st) {
            __syncthreads();
#pragma unroll
            for (int j = 0; j < 4; ++j) nsa_commit(C, j, 4 * st + j < nct, kr[j], vr[j]);
            __syncthreads();
            if (st + 1 < ncs) {
#pragma unroll
                for (int j = 0; j < 4; ++j) { const int tl = 4 * (st + 1) + j; const TileSrc ts{KC + (size_t)tl * 64 * 64, 64, VCT + tl * 64, 1024}; nsa_fetch(C, ts, tl < nct, kr[j], vr[j]); }
            }
#pragma unroll
            for (int j = 0; j < 4; ++j) {
                const int tl = 4 * st + j;
                if (tl < nct) {
                    f32x4 s[4]; nsa_scores(C, j, qf, s);
                    if (64 * tl + 63 > cmin) {
#pragma unroll
                    for (int kt = 0; kt < 4; ++kt)
#pragma unroll
                        for (int r = 0; r < 4; ++r) { const int c = 64 * tl + 16 * kt + 4 * q + r; if (c > cmax) s[kt][r] = -INFINITY; }
                    }
                    const float ps = nsa_exp(s, mc2);
                    if (pass == 0) cl += ps;
                    else {
#pragma unroll
                        for (int kt = 0; kt < 4; ++kt) {
#pragma unroll
                            for (int r = 0; r < 4; ++r) s[kt][r] *= cinv;
                            float gs = (s[kt][0] + s[kt][1]) + (s[kt][2] + s[kt][3]), es = s[kt][3];
                            gs += __shfl_xor(gs, 1); gs += __shfl_xor(gs, 2); es += __shfl_xor(es, 1); es += __shfl_xor(es, 2);
                            if (hh == 0) { const int n = 16 * tl + 4 * kt + q;
                                if (n < 256) { atomicAdd((float*)(IMP + (iq - q0) * 256 + n), gs); if (n + 1 < 256) atomicAdd((float*)(IMP + (iq - q0) * 256 + n + 1), es); } }
                        }
                        nsa_pv(C, j, s, ao);
                    }
                }
            }
        }
        if (pass == 1) {
#pragma unroll
            for (int dt = 0; dt < 4; ++dt) out[dt] += ao[dt] * (rep == 1 ? gate[0] : 0.f);
        }
        __syncthreads();
    } }

    for (int rep = (TIMEDUP & 256) ? 0 : 1; rep < 2; ++rep)
    for (int k4 = 0; k4 < 4; ++k4) {
        const int i = 4 * C.wave + k4;
        unsigned key[4]; unsigned long long selw[4];
#pragma unroll
        for (int k = 0; k < 4; ++k) { const int n = C.lane + 64 * k; const bool valid = n <= qb; const bool forced = valid && (n == 0 || n == qb || n == qb - 1);
            key[k] = (valid && !forced) ? (__builtin_bit_cast(unsigned, fmaxf(IMP[i * 256 + n], 0.f)) + 1u) : 0u;
            selw[k] = __ballot(forced); }
        const int nforced = qb >= 2 ? 3 : qb + 1; const int ncand = qb + 1 - nforced;
        int need = 16 - nforced; if (need > ncand) need = ncand;
        if (need == ncand) {
#pragma unroll
            for (int k = 0; k < 4; ++k) selw[k] |= __ballot(key[k] != 0u);
        } else {
            unsigned thr = 0u;
            for (int bit = 31; bit >= 0; --bit) { const unsigned cand = thr | (1u << bit); int cnt = 0;
#pragma unroll
                for (int k = 0; k < 4; ++k) cnt += __builtin_popcountll(__ballot(key[k] >= cand));
                if (cnt >= need) thr = cand; }
            int left = need;
#pragma unroll
            for (int k = 0; k < 4; ++k) { const unsigned long long gt = __ballot(key[k] > thr); selw[k] |= gt; left -= __builtin_popcountll(gt); }
#pragma unroll
            for (int k = 0; k < 4; ++k) { unsigned long long eq = __ballot(key[k] == thr);
                while (left > 0 && eq) { const unsigned long long low = eq & (0ull - eq); selw[k] |= low; eq ^= low; --left; } }
        }
        if (C.lane < 4) SEL[i * 4 + C.lane] = C.lane == 0 ? selw[0] : C.lane == 1 ? selw[1] : C.lane == 2 ? selw[2] : selw[3];
    }
    __syncthreads();
    if (C.tid < 4) { unsigned long long um = 0ull; for (int i = 0; i < NQ; ++i) um |= SEL[i * 4 + C.tid]; UM[C.tid] = um; }
    __syncthreads();
    int ucnt;
    {
        const unsigned long long u0 = UM[0], u1 = UM[1], u2 = UM[2], u3 = UM[3];
        const int c0 = __builtin_popcountll(u0), c1 = __builtin_popcountll(u1), c2 = __builtin_popcountll(u2), c3 = __builtin_popcountll(u3);
        ucnt = c0 + c1 + c2 + c3;
        if (C.tid < 256) { const int w = C.tid >> 6, bit = C.tid & 63; const unsigned long long uw = w == 0 ? u0 : w == 1 ? u1 : w == 2 ? u2 : u3;
            if ((uw >> bit) & 1ull) { const int pos = (w > 0 ? c0 : 0) + (w > 1 ? c1 : 0) + (w > 2 ? c2 : 0) + __builtin_popcountll(uw & ((1ull << bit) - 1ull)); UL[pos] = C.tid; } }
    }
    __syncthreads();

    for (int rep = (TIMEDUP & 1024) ? 0 : 1; rep < 2; ++rep) {
        f32x4 ao[4]; float al = 0.f;
#pragma unroll
        for (int dt = 0; dt < 4; ++dt) ao[dt] = (f32x4){0.f, 0.f, 0.f, 0.f};
        const bf16* KS = (const bf16*)(C.ws + WS_KVS) + (size_t)(b * SEQ) * 256 + g * 64;
        const bf16* VST = (const bf16*)(C.ws + WS_VST) + (size_t)bg * 256 * 4096;
        const int nss = (ucnt + 3) >> 2;
        const unsigned long long my0 = SEL[(iq - q0) * 4 + 0], my1 = SEL[(iq - q0) * 4 + 1], my2 = SEL[(iq - q0) * 4 + 2], my3 = SEL[(iq - q0) * 4 + 3];
        v4u kr2[4], vr2[4];
#define SLC_FETCH(STG, KR, VR) do { _Pragma("unroll") for (int j = 0; j < 4; ++j) { const int ix = 4 * (STG) + j; const int n = ix < ucnt ? UL[ix] : 0; \
            const TileSrc ts{KS + (size_t)n * 64 * 256, 256, VST + (size_t)n * 4096, 64}; nsa_fetch(C, ts, ix < ucnt, KR[j], VR[j]); } } while (0)
#define SLC_STAGE(STG, KR, VR) do { \
            __syncthreads(); \
            _Pragma("unroll") for (int j = 0; j < 4; ++j) nsa_commit(C, j, 4 * (STG) + j < ucnt, KR[j], VR[j]); \
            __syncthreads(); \
            if ((STG) + 2 < nss) SLC_FETCH((STG) + 2, KR, VR); \
            _Pragma("unroll") for (int j = 0; j < 4; ++j) { \
                const int ix = 4 * (STG) + j; \
                if (ix < ucnt) { \
                    const int n = UL[ix]; \
                    const unsigned long long mw = (n >> 6) == 0 ? my0 : (n >> 6) == 1 ? my1 : (n >> 6) == 2 ? my2 : my3; \
                    const bool mysel = (mw >> (n & 63)) & 1ull; \
                    if (__ballot(mysel) != 0ull) { \
                        f32x4 s[4]; nsa_scores(C, j, qf, s); \
                        if (n == qb) { _Pragma("unroll") for (int kt = 0; kt < 4; ++kt) _Pragma("unroll") for (int r = 0; r < 4; ++r) { const int key = 16 * kt + 4 * q + r; if (key > iq) s[kt][r] = -INFINITY; } } \
                        al += nsa_exp(s, mysel ? ms2 : INFINITY); \
                        nsa_pv(C, j, s, ao); \
                    } } } } while (0)
        SLC_FETCH(0, kr, vr);
        if (nss > 1) SLC_FETCH(1, kr2, vr2);
        for (int st = 0; st < nss; st += 2) {
            SLC_STAGE(st, kr, vr);
            if (st + 1 < nss) SLC_STAGE(st + 1, kr2, vr2);
        }
#undef SLC_FETCH
#undef SLC_STAGE
        float lt = al; lt += __shfl_xor(lt, 16); lt += __shfl_xor(lt, 32); const float inv = (lt > 0.f && rep == 1) ? gate[1] / lt : 0.f;
#pragma unroll
        for (int dt = 0; dt < 4; ++dt) out[dt] += ao[dt] * inv;
    }
    for (int rep = (TIMEDUP & 512) ? 0 : 1; rep < 2; ++rep) {
        f32x4 ao[4]; float al = 0.f;
#pragma unroll
        for (int dt = 0; dt < 4; ++dt) ao[dt] = (f32x4){0.f, 0.f, 0.f, 0.f};
        const bf16* KW = (const bf16*)(C.ws + WS_KVW) + (size_t)(b * SEQ) * 256 + g * 64;
        const bf16* VWT = (const bf16*)(C.ws + WS_VWT) + (size_t)bg * 256 * 4096;
        const int nfirst = qb >= 8 ? qb - 8 : 0, nw = qb - nfirst + 1, nws = (nw + 3) >> 2;
#pragma unroll
        for (int j = 0; j < 4; ++j) { const int n = nfirst + j; const TileSrc ts{KW + (size_t)n * 64 * 256, 256, VWT + (size_t)n * 4096, 64}; nsa_fetch(C, ts, j < nw, kr[j], vr[j]); }
        for (int st = 0; st < nws; ++st) {
            __syncthreads();
#pragma unroll
            for (int j = 0; j < 4; ++j) nsa_commit(C, j, 4 * st + j < nw, kr[j], vr[j]);
            __syncthreads();
            if (st + 1 < nws) {
#pragma unroll
                for (int j = 0; j < 4; ++j) { const int ix = 4 * (st + 1) + j; const int n = nfirst + (ix < nw ? ix : 0); const TileSrc ts{KW + (size_t)n * 64 * 256, 256, VWT + (size_t)n * 4096, 64}; nsa_fetch(C, ts, ix < nw, kr[j], vr[j]); }
            }
#pragma unroll
            for (int j = 0; j < 4; ++j) {
                const int ix = 4 * st + j;
                if (ix < nw) {
                    const int delta = qb - (nfirst + ix);
                    f32x4 s[4]; nsa_scores(C, j, qf, s);
                    if (delta == 0 || delta == 8) {
#pragma unroll
                        for (int kt = 0; kt < 4; ++kt)
#pragma unroll
                            for (int r = 0; r < 4; ++r) { const int key = 16 * kt + 4 * q + r; const bool ok = delta == 0 ? (key <= iq) : (key > iq); if (!ok) s[kt][r] = -INFINITY; }
                    }
                    al += nsa_exp(s, mw2);
                    nsa_pv(C, j, s, ao);
                }
            }
        }
        float lt = al; lt += __shfl_xor(lt, 16); lt += __shfl_xor(lt, 32); const float inv = (lt > 0.f && rep == 1) ? gate[2] / lt : 0.f;
#pragma unroll
        for (int dt = 0; dt < 4; ++dt) out[dt] += ao[dt] * inv;
    }
    if (DRY) {
#pragma unroll
      for (int dt = 0; dt < 4; ++dt) asm volatile("" :: "v"(out[dt]));
    } else { bf16* op = QB + (size_t)(t0 + iq) * 512 + (g * 4 + hh) * 64 + 4 * q;
#pragma unroll
      for (int dt = 0; dt < 4; ++dt) *(v2u*)(op + 16 * dt) = (v2u){pk2(out[dt][0], out[dt][1]), pk2(out[dt][2], out[dt][3])}; }
    __syncthreads();
}

#ifndef NAIVE_GLA
#define NAIVE_GLA 0
#endif
#ifndef NAIVE_MLSTM
#define NAIVE_MLSTM 0
#endif
__device__ __forceinline__ void naive_gla(const Ctx& C, int l, int bh) {
    const int bb = bh >> 2, h = bh & 3, dk = C.lane, g = C.wave;
    LAS float* SS = (LAS float*)(C.lds);
    const bf16* QKA = (const bf16*)(C.ws + WS_QKA); const bf16* VA = (const bf16*)(C.ws + WS_VA); bf16* RA = (bf16*)(C.ws + WS_RA);
    const float* SMALL = (const float*)(C.ws + WS_SMALL);
    float w[16]; const float* wa = C.in(8) + (size_t)l * 16 * 256 + h * 64 + dk;
    for (int r = 0; r < 16; ++r) w[r] = wa[r * 256];
    const float ba = C.in(9)[(size_t)l * 256 + h * 64 + dk];
    const float* gn = C.in(10) + (size_t)l * 128 + 16 * g;
    float S[16];
    for (int e = 0; e < 16; ++e) S[e] = 0.f;
    for (int s = 0; s < SEQ; ++s) {
        const size_t t = (size_t)bb * SEQ + s;
        float x = ba;
        for (int r = 0; r < 16; ++r) x += SMALL[t * 64 + r] * w[r];
        const float al = __expf(logsigmoidf_(x) * (1.0f / 16.0f));
        const float q = bf2f(QKA[t * 512 + h * 64 + dk]) * 0.125f, k = bf2f(QKA[t * 512 + 256 + h * 64 + dk]);
        float o[16]; float ss = 0.f;
        for (int e = 0; e < 16; ++e) { const float v = bf2f(VA[t * 512 + h * 128 + 16 * g + e]); S[e] = al * S[e] + k * v; o[e] = wave_sum(q * S[e]); ss += o[e] * o[e]; }
        if (C.lane == 0) SS[(s & 1) * 8 + g] = ss;
        __syncthreads();
        float tot = 0.f;
        for (int w8 = 0; w8 < 8; ++w8) tot += SS[(s & 1) * 8 + w8];
        const float rinv = 1.0f / sqrtf(tot * (1.0f / 128.0f) + RMS_EPS);
        float mine = 0.f;
        for (int e = 0; e < 16; ++e) if (C.lane == e) mine = o[e];
        if (C.lane < 16) { bf16* p = RA + t * 512 + h * 128 + 16 * g + C.lane; const float r = bf2f(*p); *p = (bf16)f2bf(mine * rinv * gn[C.lane] * siluf_(r)); }
    }
    __syncthreads();
}
__device__ __forceinline__ void naive_mlstm(const Ctx& C, int l, int bh) {
    const int bb = bh >> 2, h = bh & 3, dk = C.lane, g = C.wave;
    const bf16* X = (const bf16*)(C.ws + WS_QKC); const bf16* VC = (const bf16*)(C.ws + WS_VC); bf16* OC = (bf16*)(C.ws + WS_OC);
    const float* SMALL = (const float*)(C.ws + WS_SMALL);
    const int chq = h * 64 + dk, chk = 256 + h * 64 + dk;
    const float* cw = C.in(15) + (size_t)l * 4 * 512; const float* cb = C.in(16) + (size_t)l * 512;
    float wq[4], wk[4];
    for (int i = 0; i < 4; ++i) { wq[i] = cw[i * 512 + chq]; wk[i] = cw[i * 512 + chk]; }
    const float bq = cb[chq], bk = cb[chk];
    float Cm[16]; for (int e = 0; e < 16; ++e) Cm[e] = 0.f;
    float n = 0.f, m = 0.f;
    float xq[4] = {0.f, 0.f, 0.f, 0.f}, xk[4] = {0.f, 0.f, 0.f, 0.f};
    for (int s = 0; s < SEQ; ++s) {
        const size_t t = (size_t)bb * SEQ + s;
        xq[0] = xq[1]; xq[1] = xq[2]; xq[2] = xq[3]; xq[3] = bf2f(X[t * 512 + chq]);
        xk[0] = xk[1]; xk[1] = xk[2]; xk[2] = xk[3]; xk[3] = bf2f(X[t * 512 + chk]);
        const float q = siluf_(bq + wq[0] * xq[0] + wq[1] * xq[1] + wq[2] * xq[2] + wq[3] * xq[3]);
        const float k = siluf_(bk + wk[0] * xk[0] + wk[1] * xk[1] + wk[2] * xk[2] + wk[3] * xk[3]) * 0.125f;
        const float ip = SMALL[t * 64 + 40 + h], lf = logsigmoidf_(SMALL[t * 64 + 44 + h]);
        const float mn = fmaxf(lf + m, ip);
        const float fd = __expf(lf + m - mn), ig = __expf(ip - mn);
        n = fd * n + ig * k;
        const float den = wave_sum(q * n);
        const float dinv = 1.0f / fmaxf(fabsf(den), __expf(-mn));
        float mine = 0.f;
        for (int e = 0; e < 16; ++e) { const float v = bf2f(VC[t * 512 + h * 128 + 16 * g + e]); Cm[e] = fd * Cm[e] + ig * k * v; const float num = wave_sum(q * Cm[e]); if (C.lane == e) mine = num; }
        m = mn;
        if (C.lane < 16) { bf16* p = OC + t * 512 + h * 128 + 16 * g + C.lane; const float og = bf2f(*p); *p = (bf16)f2bf(mine * dinv * sigmoidf_(og)); }
    }
}
#ifndef NAIVE_WIN
#define NAIVE_WIN 0
#endif
__device__ __forceinline__ void naive_win_store(const Ctx& C, size_t t, int col, float z) {
    unsigned char* ws = C.ws;
    int c = col;
    if (c < 256) { ((bf16*)(ws + WS_QKA))[t * 512 + c] = (bf16)f2bf(z); return; } c -= 256;
    if (c < 256) { ((bf16*)(ws + WS_QKA))[t * 512 + 256 + c] = (bf16)f2bf(z); return; } c -= 256;
    if (c < 512) { ((bf16*)(ws + WS_VA))[t * 512 + c] = (bf16)f2bf(z); return; } c -= 512;
    if (c < 512) { ((bf16*)(ws + WS_RA))[t * 512 + c] = (bf16)f2bf(z); return; } c -= 512;
    if (c < 16) { ((float*)(ws + WS_SMALL))[t * 64 + c] = z; return; } c -= 16;
    if (c < 512) { ((bf16*)(ws + WS_QB))[t * 512 + c] = (bf16)f2bf(z); return; } c -= 512;
    if (c < 128) { ((bf16*)(ws + WS_KVC))[t * 256 + c] = (bf16)f2bf(z); return; } c -= 128;
    if (c < 128) { ((bf16*)(ws + WS_KVC))[t * 256 + 128 + c] = (bf16)f2bf(z); return; } c -= 128;
    if (c < 128) { ((bf16*)(ws + WS_KVS))[t * 256 + c] = (bf16)f2bf(z); return; } c -= 128;
    if (c < 128) { ((bf16*)(ws + WS_KVS))[t * 256 + 128 + c] = (bf16)f2bf(z); return; } c -= 128;
    if (c < 128) { ((bf16*)(ws + WS_KVW))[t * 256 + c] = (bf16)f2bf(z); return; } c -= 128;
    if (c < 128) { ((bf16*)(ws + WS_KVW))[t * 256 + 128 + c] = (bf16)f2bf(z); return; } c -= 128;
    if (c < 24) { ((float*)(ws + WS_SMALL))[t * 64 + 16 + c] = z; return; } c -= 24;
    if (c < 512) { ((bf16*)(ws + WS_QKC))[t * 512 + c] = (bf16)f2bf(z); return; } c -= 512;
    if (c < 512) { ((bf16*)(ws + WS_VC))[t * 512 + c] = (bf16)f2bf(z); return; } c -= 512;
    if (c < 512) { ((bf16*)(ws + WS_OC))[t * 512 + c] = (bf16)f2bf(z); return; } c -= 512;
    if (c < 4) { ((float*)(ws + WS_SMALL))[t * 64 + 40 + c] = z; return; } c -= 4;
    if (c < 4) { ((float*)(ws + WS_SMALL))[t * 64 + 44 + c] = z; return; }
}
__device__ __forceinline__ void naive_win(const Ctx& C, int l) {
    LAS float* xs = (LAS float*)C.lds;
    const float* gain = C.in(5) + (size_t)l * DM; const float* W = C.in(6) + (size_t)l * DM * N_IN; const float* bin = C.in(7) + (size_t)l * N_IN;
    for (int tile = C.bid; tile < T / 8; tile += C.G) {
        __syncthreads();
        {
            const size_t t = (size_t)tile * 8 + C.wave; const float* xr = C.X + t * DM;
            float v[16]; float s = 0.f;
            for (int j = 0; j < 16; ++j) { v[j] = xr[C.lane + 64 * j]; s += v[j] * v[j]; }
            const float r = 1.0f / sqrtf(wave_sum(s) * (1.f / DM) + RMS_EPS);
            for (int j = 0; j < 16; ++j) xs[C.wave * 1024 + C.lane + 64 * j] = v[j] * r * gain[C.lane + 64 * j];
        }
        __syncthreads();
        for (int col = C.tid; col < 4400; col += NTHR) {
            float acc[8]; for (int i = 0; i < 8; ++i) acc[i] = 0.f;
            for (int k = 0; k < DM; ++k) { const float w = W[(size_t)k * N_IN + col];
                for (int i = 0; i < 8; ++i) acc[i] += xs[i * 1024 + k] * w; }
            const float bb = bin[col];
            for (int i = 0; i < 8; ++i) naive_win_store(C, (size_t)tile * 8 + i, col, acc[i] + bb);
        }
    }
    __syncthreads();
}
#ifndef NAIVE_MERGE
#define NAIVE_MERGE 0
#endif
__device__ __forceinline__ void naive_merge(const Ctx& C, int l) {
    LAS float* xs = (LAS float*)C.lds;
    LAS float* os = xs + 8 * 1024;
    const float* gain = C.in(5) + (size_t)l * DM; const float* W = C.in(6) + (size_t)l * DM * N_IN; const float* bin = C.in(7) + (size_t)l * N_IN;
    const float* WB = C.in(17) + (size_t)l * 3 * 512 * DM;
    bf16* Y = (bf16*)(C.ws + WS_Y);
    for (int tile = C.bid; tile < T / 8; tile += C.G) {
        __syncthreads();
        {
            const size_t t = (size_t)tile * 8 + C.wave; const float* xr = C.X + t * DM;
            float v[16]; float s = 0.f;
            for (int j = 0; j < 16; ++j) { v[j] = xr[C.lane + 64 * j]; s += v[j] * v[j]; }
            const float r = 1.0f / sqrtf(wave_sum(s) * (1.f / DM) + RMS_EPS);
            for (int j = 0; j < 16; ++j) xs[C.wave * 1024 + C.lane + 64 * j] = v[j] * r * gain[C.lane + 64 * j];
            for (int i = 0; i < 3; ++i) { const bf16* src = (const bf16*)(C.ws + (i == 0 ? WS_RA : i == 1 ? WS_QB : WS_OC)) + t * 512;
                for (int j = 0; j < 8; ++j) os[(i * 8 + C.wave) * 512 + C.lane + 64 * j] = bf2f(src[C.lane + 64 * j]); }
        }
        __syncthreads();
        for (int c = C.tid; c < DM; c += NTHR) {
            float y[8]; for (int i = 0; i < 8; ++i) y[i] = 0.f;
            for (int br = 0; br < 3; ++br) {
                float ga[8], pa[8]; for (int i = 0; i < 8; ++i) { ga[i] = 0.f; pa[i] = 0.f; }
                const int gc = 4400 + br * DM + c;
                for (int k = 0; k < DM; ++k) { const float w = W[(size_t)k * N_IN + gc]; for (int i = 0; i < 8; ++i) ga[i] += xs[i * 1024 + k] * w; }
                for (int j = 0; j < 512; ++j) { const float w = WB[((size_t)br * 512 + j) * DM + c]; for (int i = 0; i < 8; ++i) pa[i] += os[(br * 8 + i) * 512 + j] * w; }
                const float bb = bin[gc];
                for (int i = 0; i < 8; ++i) y[i] += sigmoidf_(ga[i] + bb) * pa[i];
            }
            for (int i = 0; i < 8; ++i) Y[((size_t)tile * 8 + i) * DM + c] = (bf16)f2bf(y[i]);
        }
    }
    __syncthreads();
}
__device__ __forceinline__ void naive_gate(const Ctx& C, int l, int br) {
    LAS float* xs = (LAS float*)C.lds;
    const float* gain = C.in(5) + (size_t)l * DM; const float* W = C.in(6) + (size_t)l * DM * N_IN; const float* bin = C.in(7) + (size_t)l * N_IN;
    bf16* G = (bf16*)(C.ws + WS_G);
    for (int tile = C.bid; tile < T / 8; tile += C.G) {
        __syncthreads();
        {
            const size_t t = (size_t)tile * 8 + C.wave; const float* xr = C.X + t * DM;
            float v[16]; float s = 0.f;
            for (int j = 0; j < 16; ++j) { v[j] = xr[C.lane + 64 * j]; s += v[j] * v[j]; }
            const float r = 1.0f / sqrtf(wave_sum(s) * (1.f / DM) + RMS_EPS);
            for (int j = 0; j < 16; ++j) xs[C.wave * 1024 + C.lane + 64 * j] = v[j] * r * gain[C.lane + 64 * j];
            if (NAIVE_MERGE == 4) { const bf16* xn = (const bf16*)(C.ws + WS_XN) + t * DM; for (int j = 0; j < 16; ++j) xs[C.wave * 1024 + C.lane + 64 * j] = bf2f(xn[C.lane + 64 * j]); }
        }
        __syncthreads();
        for (int c = C.tid; c < DM; c += NTHR) {
            float ga[8]; for (int i = 0; i < 8; ++i) ga[i] = 0.f;
            const int gc = 4400 + br * DM + c;
            const bf16* WGTb = (const bf16*)(C.ws + WS_WGT) + ((size_t)br * DM + c) * DM;
            for (int k = 0; k < DM; ++k) { const float w = (NAIVE_MERGE >= 3) ? bf2f(WGTb[k]) : W[(size_t)k * N_IN + gc]; for (int i = 0; i < 8; ++i) ga[i] += xs[i * 1024 + k] * w; }
            const float bb = bin[gc];
            for (int i = 0; i < 8; ++i) G[((size_t)tile * 8 + i) * DM + c] = (bf16)f2bf(sigmoidf_(ga[i] + bb));
        }
    }
    __syncthreads();
}

__device__ __forceinline__ void phase_mix1(const Ctx& C, int l) {
    const int gw = C.bid * NWAVES + C.wave, NGW = C.G * NWAVES;
    for (int rep = (TIMEDUP & 32) ? 0 : 1; rep < 2; ++rep) {
    for (int it = gw; it < 2048; it += NGW) nsa_cmp1_item(C, it);
    for (int it = gw; it < 2048; it += NGW) nsa_vtrans_item(C, it); }
    for (int t = gw; t < T; t += NGW) nsa_prep_token(C, l, t);
    __syncthreads();
    for (int rep = (TIMEDUP & 16) ? 0 : 1; rep < 2; ++rep) for (int u = C.bid; u < 4096; u += C.G) { if (u < 2048) { if (!NAIVE_GLA) gla_unit_a(C, l, u); } else { if (!NAIVE_MLSTM) mlstm_unit_a(C, l, u - 2048); } }
}
__device__ __forceinline__ void phase_mix2(const Ctx& C, int l) {
    const int gw = C.bid * NWAVES + C.wave, NGW = C.G * NWAVES;
    for (int it = gw; it < 512; it += NGW) nsa_cmp2_item(C, l, it);
    phase_scan(C);
}
__device__ __forceinline__ void phase_mix3(const Ctx& C, int l) {
    for (int rep = (TIMEDUP & 1) ? 0 : 1; rep < 2; ++rep) for (int u = C.bid; u < 2048; u += C.G) nsa_attn_unit(C, l, u, rep == 0);
    for (int rep = (TIMEDUP & 2) ? 0 : 1; rep < 2; ++rep) for (int u = C.bid; u < 4096; u += C.G) { if (u < 2048) { if (!NAIVE_GLA) gla_unit_c(C, l, u, rep == 0); } else { if (!NAIVE_MLSTM) mlstm_unit_c(C, l, u - 2048, rep == 0); } }
    if (NAIVE_GLA && C.bid < 8) naive_gla(C, l, C.bid);
    if (NAIVE_MLSTM && C.bid >= 8 && C.bid < 16) naive_mlstm(C, l, C.bid - 8);
}

constexpr int MIX_PHASES = 10;
#define MIXER_PHASES \
    if (PH_ON) phase_norm(C, C.in(5) + (size_t)l * DM); \
    PH_END; \
    if (PH_ON) { \
        pg8::Gemm g{(const bf16*)(C.ws + WS_XN), (const bf16*)(C.ws + WS_WIN), T, 4608, DM}; \
        pg8::StaticOrder S; S.init(T, 4608, C.G, C.bid); \
        pg8::EpiWin E{C.ws + WS_R, (const float*)(C.ws + WS_VEC) + VEC_BINP, (float*)(C.ws + WS_SMALL)}; \
        for (int rep = (TIMEDUP & 64) ? 0 : 1; rep < 2; ++rep) pg8::gemm_phase<pg8::EpiWin, pg8::StaticOrder, false>(C.lds, g, S, E, nullptr); \
        if (NAIVE_WIN) { __syncthreads(); naive_win(C, l); } \
    } \
    PH_END; \
    if (PH_ON) phase_mix1(C, l); \
    PH_END; \
    if (PH_ON) phase_mix2(C, l); \
    PH_END; \
    if (PH_ON) phase_mix3(C, l); \
    PH_END; \
    if (PH_ON) { \
        pg8::Gemm g{(const bf16*)(C.ws + WS_XN), (const bf16*)(C.ws + WS_WGT), T, 3 * DM, DM}; \
        pg8::StaticOrder S; S.init(T, 3 * DM, C.G, C.bid); \
        pg8::EpiGate E{C.ws, DM, C.in(7) + (size_t)l * N_IN + 4400}; \
        pg8::gemm_phase<pg8::EpiGate, pg8::StaticOrder, false>(C.lds, g, S, E, nullptr); \
    } \
    PH_END; \
    for (int br = 0; br < 3; ++br) { \
        if (PH_ON) { \
            const bf16* Asrc = (const bf16*)(C.ws + (br == 0 ? WS_RA : br == 1 ? WS_QB : WS_OC)); \
            pg8::Gemm g{Asrc, (const bf16*)(C.ws + WS_WBR) + (size_t)br * DM * 512, T, DM, 512}; \
            pg8::StaticOrder S; S.init(T, DM, C.G, C.bid); \
            pg8::EpiBranch E{(bf16*)(C.ws + WS_Y), (const bf16*)(C.ws + WS_G0 + (size_t)(br >= 1) * (WS_G1 - WS_G0) + (size_t)(br >= 2) * (WS_G2 - WS_G1)), DM, br == 0 ? 1 : 0}; \
            pg8::gemm_phase<pg8::EpiBranch, pg8::StaticOrder, false>(C.lds, g, S, E, nullptr); \
        } \
        PH_END; \
    } \
    if (PH_ON) { \
        pg8::Gemm g{(const bf16*)(C.ws + WS_Y), (const bf16*)(C.ws + WS_WOUT), T, DM, DM}; \
        pg8::StaticOrder S; S.init(T, DM, C.G, C.bid); \
        pg8::EpiResid E{C.X, DM, 1.0f}; \
        pg8::gemm_phase<pg8::EpiResid, pg8::StaticOrder, false>(C.lds, g, S, E, nullptr); \
    } \
    PH_END;

constexpr int N_PHASES = 1 + 8 * 3 + 4 * MIX_PHASES;

__global__ void __launch_bounds__(NTHR, 2) hybrid_fwd(Args args) {
    extern __shared__ __attribute__((aligned(16))) unsigned char lds_raw[];
    Ctx C;
    C.lds = (LAS unsigned char*)lds_raw;
    C.tid = threadIdx.x; C.lane = C.tid & 63; C.wave = __builtin_amdgcn_readfirstlane(C.tid >> 6);
    C.G = gridDim.x; C.bid = blockIdx.x;
    C.inp = (const GAS float* const __attribute__((address_space(4)))*)__builtin_amdgcn_kernarg_segment_ptr();
    C.X = args.out; C.ws = args.ws;
    volatile LAS unsigned* MISC = (volatile LAS unsigned*)(C.lds + MISC_OFF);
    for (int u = C.tid; u < (LDS_BYTES - RING_BYTES) / 4; u += NTHR) ((LAS unsigned*)(C.lds + RING_BYTES))[u] = 0u;
    __syncthreads();
    __builtin_amdgcn_fence(__ATOMIC_ACQUIRE, "agent"); asm volatile("s_waitcnt vmcnt(0)" ::: "memory");
    __syncthreads();
    const int lo = args.ph_lo, hi = args.ph_hi;
    XcdBarrier bar; bar.bar = (unsigned*)(C.ws + WS_CTL) + 4096; bar.x = 0; bar.st = nullptr;
    if (hi - lo > 1) bar = xcd_barrier_post((unsigned*)(C.ws + WS_CTL) + 4096, MISC + 8);
    int pc = 0;
#define PH_ON (C.launder(), pc >= lo && pc < hi)
#define PH_END do { if (pc >= lo && pc + 1 < hi) { xcd_barrier(bar); if (TIMEDUP & 4096) xcd_barrier(bar); } ++pc; } while (0)

    if (PH_ON) phase_init(C);
    PH_END;

    for (int step = 0; step < 2 * NLAYER; ++step) {
        const int l = step >> 1, f = step & 1;
        if (PH_ON) {
            if (f == 0) for (int rep = (TIMEDUP & 128) ? 0 : 1; rep < 2; ++rep) phase_prep_weights(C, l);
            for (int rep = (TIMEDUP & 8) ? 0 : 1; rep < 2; ++rep) phase_norm(C, (f ? C.in(19) : C.in(1)) + (size_t)l * DM);
        }
        PH_END;
        if (PH_ON) {
            pg8::Gemm g{(const bf16*)(C.ws + WS_XN), (const bf16*)(C.ws + (f ? WS_WGU2 : WS_WGU1)), T, 2 * DFF, DM};
            pg8::StaticOrder S; S.init(T, 2 * DFF, C.G, C.bid);
            pg8::EpiSwiGLU E{(bf16*)(C.ws + WS_HID), DFF};
            for (int rep = (TIMEDUP & 4) ? 0 : 1; rep < 2; ++rep) pg8::gemm_phase<pg8::EpiSwiGLU, pg8::StaticOrder, false>(C.lds, g, S, E, nullptr);
        }
        PH_END;
        if (PH_ON) {
            pg8::Gemm g{(const bf16*)(C.ws + WS_HID), (const bf16*)(C.ws + (f ? WS_WDN2 : WS_WDN1)), T, DM, DFF};
            pg8::StaticOrder S; S.init(T, DM, C.G, C.bid);
            pg8::EpiResid E{C.X, DM, 0.5f};
            pg8::gemm_phase<pg8::EpiResid, pg8::StaticOrder, false>(C.lds, g, S, E, nullptr);
        }
        PH_END;
        if (f == 0) {
            MIXER_PHASES
        }
    }
#undef PH_ON
#undef PH_END
    asm volatile("s_waitcnt vmcnt(0)" ::: "memory");
    __syncthreads();
    if (C.tid == 0) { __builtin_amdgcn_fence(__ATOMIC_RELEASE, "agent"); asm volatile("s_waitcnt vmcnt(0)" ::: "memory"); }
}

extern "C" void kernel_launch(void* const* d_in, const int* in_sizes, int n_in, void* d_out, int out_size, void* d_ws, size_t ws_size, hipStream_t stream) {
    static int grid = 0;
    if (grid == 0) {
        if (n_in != 23 || out_size != T * DM || ws_size < WS_END) { fprintf(stderr, "kernel_launch: unexpected shapes (n_in %d out %d ws %zu, need %zu)\n", n_in, out_size, ws_size, (size_t)WS_END); grid = -1; return; }
        int dev = 0, cus = 0, per_cu = 0;
        if (hipGetDevice(&dev) != hipSuccess || hipDeviceGetAttribute(&cus, hipDeviceAttributeMultiprocessorCount, dev) != hipSuccess) { grid = -1; return; }
        if (hipFuncSetAttribute((const void*)hybrid_fwd, hipFuncAttributeMaxDynamicSharedMemorySize, LDS_BYTES) != hipSuccess) { fprintf(stderr, "kernel_launch: hipFuncSetAttribute failed\n"); grid = -1; return; }
        if (hipOccupancyMaxActiveBlocksPerMultiprocessor(&per_cu, (const void*)hybrid_fwd, NTHR, LDS_BYTES) != hipSuccess || per_cu < 1) { fprintf(stderr, "kernel_launch: occupancy query says %d blocks per CU\n", per_cu); }
        (void)hipGetLastError();
        grid = cus;
    }
    if (grid < 0) return;
    (void)hipMemsetAsync((char*)d_ws + WS_CTL, 0, CTL_ZERO_BYTES, stream);
    Args a{};
    for (int i = 0; i < 23; ++i) a.in[i] = (const float*)d_in[i];
    a.out = (float*)d_out; a.ws = (unsigned char*)d_ws;
#if ONE_LAUNCH
    a.ph_lo = 0; a.ph_hi = N_PHASES;
    hipLaunchKernelGGL(hybrid_fwd, dim3(grid), dim3(NTHR), LDS_BYTES, stream, a);
#else
    for (int p = 0; p < N_PHASES; ++p) { a.ph_lo = p; a.ph_hi = p + 1; hipLaunchKernelGGL(hybrid_fwd, dim3(grid), dim3(NTHR), LDS_BYTES, stream, a); }
#endif
}
```

```cpp
#include <hip/hip_runtime.h>
#include <cstdio>
#include <cstdint>

#ifndef ABL_ZERO
#define ABL_ZERO 0
#endif
#ifndef SCL_A
#define SCL_A 1.0f
#define SCL_B 1.0f
#define SCL_C 1.0f
#endif
#define NAIVE_GLA 0
#define NAIVE_MLSTM 0
#define NAIVE_WIN 0
#define NAIVE_MERGE 0
#ifndef TIMEDUP
#define TIMEDUP 0
#endif
#ifndef ONE_LAUNCH
#define ONE_LAUNCH 1
#endif

#define GAS __attribute__((address_space(1)))
#define LAS __attribute__((address_space(3)))
typedef unsigned short bf16;
typedef unsigned v4u __attribute__((ext_vector_type(4)));
typedef unsigned v2u __attribute__((ext_vector_type(2)));
typedef float f32x4 __attribute__((ext_vector_type(4)));
typedef float f32x2 __attribute__((ext_vector_type(2)));
typedef short bf16x8 __attribute__((ext_vector_type(8)));
typedef short bf16x4 __attribute__((ext_vector_type(4)));

constexpr int NB = 2, SEQ = 16384, T = NB * SEQ, DM = 1024, DFF = 2816, NLAYER = 4;
constexpr int N_IN = 7472;
constexpr int NWAVES = 8, NTHR = 512;
constexpr float RMS_EPS = 1e-6f;
constexpr int NCH = SEQ / 64;

constexpr size_t MiB = 1u << 20;
constexpr size_t WS_CTL = 0, CTL_ZERO_BYTES = 1 * MiB;
constexpr size_t WS_ROPE = 1 * MiB;
constexpr size_t WS_VEC = 5 * MiB;
constexpr size_t WS_WGU1 = 6 * MiB;
constexpr size_t WS_WDN1 = 17 * MiB;
constexpr size_t WS_WGU2 = 23 * MiB;
constexpr size_t WS_WDN2 = 34 * MiB;
constexpr size_t WS_WIN = 40 * MiB;
constexpr size_t WS_WGT = 49 * MiB;
constexpr size_t WS_WBR = 55 * MiB;
constexpr size_t WS_WOUT = 58 * MiB;
constexpr size_t WS_CW1 = 60 * MiB;
constexpr size_t WS_CW2 = 62 * MiB;
constexpr size_t WS_XN = 64 * MiB;
constexpr size_t WS_R = 128 * MiB;
constexpr size_t WS_HID = WS_R;
constexpr size_t WS_QKA = WS_R;
constexpr size_t WS_VA = WS_R + 32 * MiB;
constexpr size_t WS_RA = WS_R + 64 * MiB;
constexpr size_t WS_QB = WS_R + 96 * MiB;
constexpr size_t WS_KVC = WS_R + 128 * MiB;
constexpr size_t WS_KVS = WS_R + 144 * MiB;
constexpr size_t WS_KVW = WS_R + 160 * MiB;
constexpr size_t WS_QKC = WS_R + 176 * MiB;
constexpr size_t WS_VC = WS_R + 208 * MiB;
constexpr size_t WS_OC = WS_R + 240 * MiB;
constexpr size_t WS_SMALL = WS_R + 272 * MiB;
constexpr size_t WS_VST = WS_R + 280 * MiB;
constexpr size_t WS_VWT = WS_R + 288 * MiB;
constexpr size_t WS_KCMP = WS_R + 296 * MiB;
constexpr size_t WS_VCT = WS_KCMP + MiB / 2;
constexpr size_t WS_CMPH = WS_R + 297 * MiB;
constexpr size_t WS_GST = WS_R + 302 * MiB;
constexpr size_t WS_GDEC = WS_R + 334 * MiB;
constexpr size_t WS_MSC = WS_GDEC + MiB / 2;
constexpr size_t WS_MST = WS_R + 335 * MiB;
constexpr size_t WS_MN = WS_R + 367 * MiB;
constexpr size_t WS_G0 = WS_QKA, WS_G1 = WS_QKC, WS_G2 = WS_GST;
constexpr size_t WS_G = WS_G0;
constexpr size_t WS_Y = WS_XN;
constexpr size_t WS_END = WS_R + 368 * MiB;

constexpr int VEC_BINP = 0;
constexpr int VEC_CB1 = 8192;

#define LDS_WAIT() asm volatile("s_waitcnt lgkmcnt(0)" ::: "memory")
#define VM_WAIT() asm volatile("s_waitcnt vmcnt(0)" ::: "memory")
__device__ __forceinline__ unsigned f2bf(float f) { unsigned u = __builtin_bit_cast(unsigned, f); return (u + 0x7fffu + ((u >> 16) & 1u)) >> 16; }
typedef __bf16 bf2_t __attribute__((ext_vector_type(2)));
__device__ __forceinline__ unsigned pk2(float lo, float hi) { const f32x2 v = {lo, hi}; return __builtin_bit_cast(unsigned, __builtin_convertvector(v, bf2_t)); }
__device__ __forceinline__ float bf2f(unsigned v) { return __builtin_bit_cast(float, (v & 0xffffu) << 16); }
__device__ __forceinline__ float bflo(unsigned w) { return __builtin_bit_cast(float, w << 16); }
__device__ __forceinline__ float bfhi(unsigned w) { return __builtin_bit_cast(float, w & 0xffff0000u); }
__device__ __forceinline__ float fexp(float x) { return __builtin_amdgcn_exp2f(x * 1.44269504089f); }
__device__ __forceinline__ float sigmoidf_(float x) { return 1.0f / (1.0f + __expf(-x)); }
__device__ __forceinline__ float siluf_(float x) { return x / (1.0f + __expf(-x)); }
__device__ __forceinline__ float logsigmoidf_(float x) { return fminf(x, 0.f) - __logf(1.0f + __expf(-fabsf(x))); }
__device__ __forceinline__ float wave_sum(float v) {
#pragma unroll
    for (int o = 1; o < 64; o <<= 1) v += __shfl_xor(v, o);
    return v;
}
__device__ __forceinline__ float wave_max(float v) {
#pragma unroll
    for (int o = 1; o < 64; o <<= 1) v = fmaxf(v, __shfl_xor(v, o));
    return v;
}

#define XB_TMO      128
#define XB_XCNT(j)  (256  + 64 * (j))
#define XB_XSUB(j)  (1280 + 64 * (j))
#define XB_XGEN(j)  (2304 + 64 * (j))
#define XB_TOP      3328
#define XB_TOPGEN   3392
#define XCD_BAR_WORDS 3456
#define XB_SPIN_CAP (1u << 24)

__device__ __forceinline__ unsigned xb_ld(unsigned* p)              { return __hip_atomic_load(p, __ATOMIC_RELAXED, __HIP_MEMORY_SCOPE_AGENT); }
__device__ __forceinline__ unsigned xb_add(unsigned* p, unsigned v) { return __hip_atomic_fetch_add(p, v, __ATOMIC_RELAXED, __HIP_MEMORY_SCOPE_AGENT); }
__device__ __forceinline__ unsigned xb_xcc_id() { return (unsigned)__builtin_amdgcn_s_getreg((3 << 11) | 20) & 0xFu; }
#define XB_SPIN(cond, bar) do { unsigned _sp = 0; while (cond) { __builtin_amdgcn_s_sleep(1); \
    if ((++_sp & 255u) == 0u) { if (xb_ld(&(bar)[XB_TMO])) break; if (_sp > XB_SPIN_CAP) { atomicAdd(&(bar)[XB_TMO], 1u); break; } } } } while (0)

struct XcdBarrier {
    unsigned* bar; unsigned x;
    volatile LAS unsigned* st;
};
__device__ __forceinline__ XcdBarrier xcd_barrier_post(unsigned* bar, volatile LAS unsigned* st) {
    XcdBarrier b; b.bar = bar; b.x = xb_xcc_id(); b.st = st;
    if (threadIdx.x == 0) (void)xb_add(&bar[XB_XCNT(b.x)], 1u);
    return b;
}
__device__ __forceinline__ void xcd_barrier_complete(unsigned* bar, unsigned x, unsigned& nloc, unsigned& nx) {
    const unsigned G = gridDim.x * gridDim.y * gridDim.z;
    unsigned sum, cnt, mine, sp = 0u;
    for (;;) {
        sum = 0u; cnt = 0u; mine = 0u;
#pragma unroll
        for (unsigned j = 0; j < 16; ++j) { const unsigned c = xb_ld(&bar[XB_XCNT(j)]); sum += c; cnt += (c > 0u) ? 1u : 0u; mine = (j == x) ? c : mine; }
        if (sum == G) break;
        __builtin_amdgcn_s_sleep(1);
        if ((++sp & 255u) == 0u) { if (xb_ld(&bar[XB_TMO])) break; if (sp > XB_SPIN_CAP) { atomicAdd(&bar[XB_TMO], 1u); break; } }
    }
    nloc = mine > 0u ? mine : 1u; nx = cnt > 0u ? cnt : 1u;
}
__device__ __forceinline__ void xcd_barrier(const XcdBarrier& b) {
    asm volatile("s_waitcnt vmcnt(0)" ::: "memory");
    __syncthreads();
    if (threadIdx.x == 0) {
        unsigned* bar = b.bar;
        __builtin_amdgcn_s_waitcnt(0);
        unsigned nloc = b.st[0], nx = b.st[1];
        if (nloc == 0u) { xcd_barrier_complete(bar, b.x, nloc, nx); b.st[0] = nloc; b.st[1] = nx; }
        const unsigned old = xb_add(&bar[XB_XSUB(b.x)], 1u);
        const unsigned gen = old / nloc;
        if (old + 1u == (gen + 1u) * nloc) {
            __builtin_amdgcn_fence(__ATOMIC_RELEASE, "agent");
            asm volatile("s_waitcnt vmcnt(0)" ::: "memory");
            const unsigned og = xb_add(&bar[XB_TOP], 1u);
            const unsigned tg = og / nx;
            if (og + 1u == (tg + 1u) * nx) xb_add(&bar[XB_TOPGEN], 1u);
            else XB_SPIN(xb_ld(&bar[XB_TOPGEN]) == tg, bar);
            __builtin_amdgcn_fence(__ATOMIC_ACQUIRE, "agent");
            xb_add(&bar[XB_XGEN(b.x)], 1u);
            asm volatile("s_waitcnt vmcnt(0)" ::: "memory");
        } else {
            XB_SPIN(xb_ld(&bar[XB_XGEN(b.x)]) == gen, bar);
            __builtin_amdgcn_fence(__ATOMIC_ACQUIRE, "agent");
            asm volatile("s_waitcnt vmcnt(0)" ::: "memory");
        }
    }
    __syncthreads();
}

namespace pg8 {
#define PG8_LAS __attribute__((address_space(3)))
typedef unsigned short bf16_t;
typedef short bf16x8 __attribute__((ext_vector_type(8)));
typedef float f32x4 __attribute__((ext_vector_type(4)));
typedef unsigned u32x4 __attribute__((ext_vector_type(4)));
constexpr int BM = 256, BK = 64, HALF = 128, HTB = HALF * BK * 2  , STAGE_BYTES = 8 * HTB, NXCD = 8, WGM = 8;

__host__ __device__ __forceinline__ int lds_byte(int r, int c) { const int st = (r >> 4) * 2 + (c >> 5), rr = r & 15, cc = c & 31, ob = rr * 64 + cc * 2; return st * 1024 + (ob ^ (((ob >> 9) & 1) << 5)); }
__host__ __device__ __forceinline__ void stage_rc(int b, int& R, int& C) { const int st = b / 1024, sb = b % 1024, swz = sb ^ (((sb >> 9) & 1) << 5); R = (st >> 1) * 16 + swz / 64; C = (st & 1) * 32 + (swz % 64) / 2; }
__host__ __device__ __forceinline__ int perm32(int rho) { const int n = rho >> 4, i = rho & 15; return 8 * (i >> 2) + 4 * n + (i & 3); }

struct Unit { int pm, pn; };
struct Gemm { const bf16_t* A; const bf16_t* Bt; int M, N, K; };

struct StaticOrder {
    int nM, nN, nwg, G, c;
    __host__ __device__ void init(int M, int N, int G_, int c_) { nM = M / BM; nN = N / BM; nwg = nM * nN; G = G_; c = c_; }
    __host__ __device__ bool next(int i, Unit& u) const {
        const long L = (long)i * G + c; if (L >= nwg) return false;
        int wgid = (int)L; { const int q = nwg / NXCD, r = nwg % NXCD, xcd = wgid % NXCD, off = wgid / NXCD; wgid = (xcd < r ? xcd * (q + 1) : r * (q + 1) + (xcd - r) * q) + off; }
        const int nig = WGM * nN, gid = wgid / nig, fm = gid * WGM, gsz = (nM - fm) < WGM ? (nM - fm) : WGM;
        u.pm = fm + ((wgid % nig) % gsz); u.pn = (wgid % nig) / gsz; return true;
    }
    __device__ __forceinline__ void a_ready(const Unit&) const {}
    __device__ __forceinline__ void done(const Unit&) const {}
};
struct CountedOrder : StaticOrder {
    const unsigned* ready; unsigned need; unsigned* tmo;
    __device__ __forceinline__ void a_ready(const Unit& u) const {
        if (threadIdx.x < 64) {
            const unsigned long long t0 = __builtin_amdgcn_s_memrealtime(); unsigned polls = 0;
            while ((unsigned)__builtin_amdgcn_readfirstlane(__hip_atomic_load(ready + 64 * u.pm, __ATOMIC_RELAXED, __HIP_MEMORY_SCOPE_AGENT)) < need) {
                if ((++polls & 255u) == 0u && __builtin_amdgcn_readfirstlane(__hip_atomic_load(tmo, __ATOMIC_RELAXED, __HIP_MEMORY_SCOPE_AGENT)) != 0u) break;
                if (__builtin_amdgcn_s_memrealtime() - t0 > 2000000ull) {
                    if (threadIdx.x == 0) { unsigned expect = 0u; __hip_atomic_compare_exchange_strong(tmo + 1, &expect, 0x600u | (unsigned)(u.pm & 0xff), __ATOMIC_RELAXED, __ATOMIC_RELAXED, __HIP_MEMORY_SCOPE_AGENT); __hip_atomic_store(tmo, 1u, __ATOMIC_RELAXED, __HIP_MEMORY_SCOPE_AGENT); }
                    break; }
                __builtin_amdgcn_s_sleep(2); }
            __builtin_amdgcn_fence(__ATOMIC_ACQUIRE, "agent");
            asm volatile("s_waitcnt vmcnt(0)" ::: "memory");
        }
#if !defined(BROKEN_HOOK_NO_BARRIER)
        asm volatile("" ::: "memory"); __builtin_amdgcn_s_barrier(); asm volatile("" ::: "memory");
#endif
    }
};

__device__ __forceinline__ unsigned cvt_pk_bf16(float lo, float hi) { unsigned r; asm volatile("v_cvt_pk_bf16_f32 %0, %1, %2" : "=v"(r) : "v"(lo), "v"(hi)); return r; }
typedef float f32x2 __attribute__((ext_vector_type(2)));
__device__ __forceinline__ f32x2 gelu_pk(f32x2 v) {
    const f32x2 av = __builtin_elementwise_abs(v), d = av * 0.2316418882f + 1.0f;
    f32x2 t; t.x = __builtin_amdgcn_rcpf(d.x); t.y = __builtin_amdgcn_rcpf(d.y);
    f32x2 q = t * 0.5307027145f + (-0.7265760135f); q = q * t + 0.7107068705f; q = q * t + (-0.142248368f); q = q * t + 0.127414796f; q = q * t;
    const f32x2 s = (v * v) * (-0.72134752044f);
    f32x2 e; e.x = __builtin_amdgcn_exp2f(s.x); e.y = __builtin_amdgcn_exp2f(s.y);
    const f32x2 m = v * (q * e), r = v - m;
    f32x2 o; o.x = v.x < 0.f ? m.x : r.x; o.y = v.y < 0.f ? m.y : r.y; return o;
}

struct EpiF32 {
    static constexpr bool PERM = false, AFTER_DRAIN = false;
    float* C; int ldc; const float* bias;
    __device__ __forceinline__ void operator()(const f32x4 (&acc)[2][2][4][2], const Unit& u, int wr, int wc, int fr, int fq) const {
        const int row0 = u.pm * BM + wr * 64 + fr, col0 = u.pn * BM + wc * 32 + 4 * fq;
        f32x4 bv[2][2];
#pragma unroll
        for (int bj = 0; bj < 2; ++bj)
#pragma unroll
            for (int n = 0; n < 2; ++n) bv[bj][n] = bias ? *(const f32x4*)(bias + col0 + bj * HALF + n * 16) : (f32x4){0.f, 0.f, 0.f, 0.f};
#pragma unroll
        for (int ai = 0; ai < 2; ++ai)
#pragma unroll
            for (int m = 0; m < 4; ++m) { float* rowp = C + (size_t)(row0 + ai * HALF + m * 16) * ldc + col0;
#pragma unroll
                for (int bj = 0; bj < 2; ++bj)
#pragma unroll
                    for (int n = 0; n < 2; ++n) *(f32x4*)(rowp + bj * HALF + n * 16) = acc[ai][bj][m][n] + bv[bj][n]; }
    }
};
template <int ACT  > struct EpiBf16 {
    static constexpr bool PERM = true, AFTER_DRAIN = false;
    bf16_t* O; int ldc; const float* bias; int split_cols; size_t split_stride;
    __device__ __forceinline__ void operator()(const f32x4 (&acc)[2][2][4][2], const Unit& u, int wr, int wc, int fr, int fq) const {
        const int row0 = u.pm * BM + wr * 64 + fr; int colt = u.pn * BM; bf16_t* base = O;
        if (split_cols) { const int t = colt / split_cols; base += (size_t)t * split_stride; colt -= t * split_cols; }
        const int col0 = colt + wc * 32 + 8 * fq, bcol0 = u.pn * BM + wc * 32 + 8 * fq;
        f32x4 bv[2][2];
#pragma unroll
        for (int bj = 0; bj < 2; ++bj)
#pragma unroll
            for (int n = 0; n < 2; ++n) bv[bj][n] = bias ? *(const f32x4*)(bias + bcol0 + bj * HALF + 4 * n) : (f32x4){0.f, 0.f, 0.f, 0.f};
#pragma unroll
        for (int ai = 0; ai < 2; ++ai)
#pragma unroll
            for (int m = 0; m < 4; ++m) { bf16_t* rowp = base + (size_t)(row0 + ai * HALF + m * 16) * ldc + col0;
#pragma unroll
                for (int bj = 0; bj < 2; ++bj) { f32x4 v0 = acc[ai][bj][m][0] + bv[bj][0], v1 = acc[ai][bj][m][1] + bv[bj][1];
                    if (ACT == 1) { f32x2 a = gelu_pk((f32x2){v0[0], v0[1]}), b = gelu_pk((f32x2){v0[2], v0[3]}), c = gelu_pk((f32x2){v1[0], v1[1]}), d = gelu_pk((f32x2){v1[2], v1[3]});
                        v0 = (f32x4){a.x, a.y, b.x, b.y}; v1 = (f32x4){c.x, c.y, d.x, d.y}; }
                    if (ACT == 2) {
#pragma unroll
                        for (int j = 0; j < 4; ++j) { v0[j] = 0.5f * v0[j] * (1.0f + erff(v0[j] * 0.70710678f)); v1[j] = 0.5f * v1[j] * (1.0f + erff(v1[j] * 0.70710678f)); } }
                    u32x4 w; w.x = cvt_pk_bf16(v0[0], v0[1]); w.y = cvt_pk_bf16(v0[2], v0[3]); w.z = cvt_pk_bf16(v1[0], v1[1]); w.w = cvt_pk_bf16(v1[2], v1[3]);
                    *(u32x4*)(rowp + bj * HALF) = w; } }
    }
};

struct PanelStats {
    unsigned* xbuf;
    unsigned* cnt;
    unsigned* tmo;
    int ntn; float eps;
    unsigned code;
    __device__ __forceinline__ bool run(const f32x4 (&v)[2][2][4][2], const Unit& u, int wr, int wc, int fr, int fq, PG8_LAS unsigned char* lds, int wid, int lane) const {
        typedef float f32x2v __attribute__((ext_vector_type(2)));
        PG8_LAS f32x2v* P = (PG8_LAS f32x2v*)lds;
        PG8_LAS f32x2v* S = (PG8_LAS f32x2v*)(lds + 8192);
        PG8_LAS unsigned* flag = (PG8_LAS unsigned*)(lds + 8192 + 2048);
#pragma unroll
        for (int ai = 0; ai < 2; ++ai)
#pragma unroll
            for (int m = 0; m < 4; ++m) {
                float s = 0.f;
#pragma unroll
                for (int bj = 0; bj < 2; ++bj)
#pragma unroll
                    for (int n = 0; n < 2; ++n) { const f32x4 x = v[ai][bj][m][n]; s += (x[0] + x[1]) + (x[2] + x[3]); }
                s += __shfl_xor(s, 16); s += __shfl_xor(s, 32);
                const float mw = s * (1.0f / 64.0f); float q = 0.f;
#pragma unroll
                for (int bj = 0; bj < 2; ++bj)
#pragma unroll
                    for (int n = 0; n < 2; ++n) { const f32x4 d = v[ai][bj][m][n] - mw; q += (d[0] * d[0] + d[1] * d[1]) + (d[2] * d[2] + d[3] * d[3]); }
                q += __shfl_xor(q, 16); q += __shfl_xor(q, 32);
                if (fq == 0) P[(ai * HALF + wr * 64 + m * 16 + fr) * 4 + wc] = (f32x2v){mw, q};
            }
        asm volatile("s_waitcnt lgkmcnt(0)" ::: "memory"); __builtin_amdgcn_s_barrier(); asm volatile("" ::: "memory");
#if defined(BROKEN_NO_WAIT)
        if (blockIdx.x >= 64) { const long long t0 = clock64(); while (clock64() - t0 < 60000) __builtin_amdgcn_s_sleep(8); }
#endif
        const int row = wid * 32 + (lane & 31);
        if (lane < 32) {
            const f32x2v a = P[row * 4 + 0], b = P[row * 4 + 1], c = P[row * 4 + 2], d = P[row * 4 + 3];
            const float mt = (a.x + b.x + c.x + d.x) * 0.25f;
            const float da = a.x - mt, db = b.x - mt, dc = c.x - mt, dd = d.x - mt;
            const float m2 = (a.y + b.y) + (c.y + d.y) + 64.0f * ((da * da + db * db) + (dc * dc + dd * dd));
            unsigned long long* slot = (unsigned long long*)xbuf + ((size_t)(u.pm * BM + row) * 4 + u.pn);
            __hip_atomic_store(slot, ((unsigned long long)__float_as_uint(m2) << 32) | __float_as_uint(mt), __ATOMIC_RELAXED, __HIP_MEMORY_SCOPE_AGENT);
        }
        asm volatile("s_waitcnt vmcnt(0)" ::: "memory");
        if (lane == 0) __hip_atomic_fetch_add(cnt + 64 * u.pm, 1u, __ATOMIC_RELAXED, __HIP_MEMORY_SCOPE_AGENT);
        if (wid == 0) {
            bool dead = false; const unsigned long long t0 = __builtin_amdgcn_s_memrealtime(); const unsigned want = 8u * (unsigned)ntn;
            for (;;) {
#if defined(BROKEN_NO_WAIT)
                break;
#endif
                if ((unsigned)__builtin_amdgcn_readfirstlane(__hip_atomic_load(cnt + 64 * u.pm, __ATOMIC_RELAXED, __HIP_MEMORY_SCOPE_AGENT)) >= want) break;
                if (__builtin_amdgcn_s_memrealtime() - t0 > 2000000ull) {
                    if (lane == 0) { unsigned expect = 0u; __hip_atomic_compare_exchange_strong(tmo + 1, &expect, code | (unsigned)(u.pm & 0xff), __ATOMIC_RELAXED, __ATOMIC_RELAXED, __HIP_MEMORY_SCOPE_AGENT);
                                     __hip_atomic_store(tmo, 1u, __ATOMIC_RELAXED, __HIP_MEMORY_SCOPE_AGENT); }
                    dead = true; break; }
                __builtin_amdgcn_s_sleep(2);
            }
            __builtin_amdgcn_fence(__ATOMIC_ACQUIRE, "agent");
            if (lane == 0) flag[0] = dead ? 1u : 0u;
        }
        asm volatile("s_waitcnt vmcnt(0) lgkmcnt(0)" ::: "memory"); __builtin_amdgcn_s_barrier(); asm volatile("" ::: "memory");
        const bool bad = flag[0] != 0u;
        if (lane < 32) {
            const unsigned long long* slot = (const unsigned long long*)xbuf + (size_t)(u.pm * BM + row) * 4; float mt[4], m2[4]; float ms = 0.f;
#pragma unroll
            for (int t = 0; t < 4; ++t) { if (t < ntn) { const unsigned long long w = __hip_atomic_load(slot + t, __ATOMIC_RELAXED, __HIP_MEMORY_SCOPE_AGENT); mt[t] = __uint_as_float((unsigned)w); m2[t] = __uint_as_float((unsigned)(w >> 32)); } else { mt[t] = 0.f; m2[t] = 0.f; } ms += mt[t]; }
            const float mean = ms / (float)ntn; float q = 0.f;
#pragma unroll
            for (int t = 0; t < 4; ++t) if (t < ntn) { const float dm = mt[t] - mean; q += m2[t] + 256.0f * dm * dm; }
            S[row] = (f32x2v){mean, 1.0f / sqrtf(q / (256.0f * (float)ntn) + eps)};
        }
        asm volatile("s_waitcnt lgkmcnt(0)" ::: "memory"); __builtin_amdgcn_s_barrier(); asm volatile("" ::: "memory");
        return bad;
    }
};
struct EpiLnRes {
    static constexpr bool PERM = false, AFTER_DRAIN = true;
    const float* base; float* out; int ldc; const float* bias; PanelStats st; unsigned poison;
    __device__ __forceinline__ void refuse(size_t i0, size_t stride, int M, int N) const { const float q = __builtin_nanf(""); for (size_t i = i0; i < (size_t)M * N; i += stride) out[(i / N) * ldc + i % N] = q;
        if (i0 == 0) { unsigned expect = 0u; __hip_atomic_compare_exchange_strong(st.tmo + 1, &expect, 0x7f0u, __ATOMIC_RELAXED, __ATOMIC_RELAXED, __HIP_MEMORY_SCOPE_AGENT); __hip_atomic_store(st.tmo, 1u, __ATOMIC_RELAXED, __HIP_MEMORY_SCOPE_AGENT); } }
    __device__ __forceinline__ void fused(f32x4 (&acc)[2][2][4][2], const Unit& u, int wr, int wc, int fr, int fq, PG8_LAS unsigned char* lds, int wid, int lane) const {
        typedef float f32x2v __attribute__((ext_vector_type(2)));
        const PG8_LAS f32x2v* S = (const PG8_LAS f32x2v*)(lds + 8192);
        const int col0 = u.pn * BM + wc * 32 + 4 * fq;
#pragma unroll
        for (int bj = 0; bj < 2; ++bj)
#pragma unroll
            for (int n = 0; n < 2; ++n) { const f32x4 bv = bias ? *(const f32x4*)(bias + col0 + bj * HALF + n * 16) : (f32x4){0.f, 0.f, 0.f, 0.f};
#pragma unroll
                for (int ai = 0; ai < 2; ++ai)
#pragma unroll
                    for (int m = 0; m < 4; ++m) acc[ai][bj][m][n] += bv; }
        const bool bad = st.run(acc, u, wr, wc, fr, fq, lds, wid, lane) || poison != 0u;
        const float qnan = __builtin_nanf("");
#pragma unroll
        for (int ai = 0; ai < 2; ++ai)
#pragma unroll
            for (int m = 0; m < 4; ++m) { const int r = ai * HALF + wr * 64 + m * 16 + fr; const f32x2v sr = S[r]; const size_t off = (size_t)(u.pm * BM + r) * ldc + col0;
#pragma unroll
                for (int bj = 0; bj < 2; ++bj)
#pragma unroll
                    for (int n = 0; n < 2; ++n) { const f32x4 bs = *(const f32x4*)(base + off + bj * HALF + n * 16); f32x4 o = bs + (acc[ai][bj][m][n] - sr.x) * sr.y;
                        if (bad) o = (f32x4){qnan, qnan, qnan, qnan}; *(f32x4*)(out + off + bj * HALF + n * 16) = o; }
                asm volatile("" ::: "memory"); }
    }
};
struct EpiLnResLn {
    static constexpr bool PERM = false, AFTER_DRAIN = true;
    const float* base; float* out; bf16_t* xn; int ldc; const float* bias; PanelStats st1, st2; unsigned poison;
    __device__ __forceinline__ void refuse(size_t i0, size_t stride, int M, int N) const { const float q = __builtin_nanf(""); for (size_t i = i0; i < (size_t)M * N; i += stride) { const size_t o = (i / N) * ldc + i % N; out[o] = q; xn[o] = (bf16_t)0x7fc0u; }
        if (i0 == 0) { unsigned expect = 0u; __hip_atomic_compare_exchange_strong(st1.tmo + 1, &expect, 0x7f0u, __ATOMIC_RELAXED, __ATOMIC_RELAXED, __HIP_MEMORY_SCOPE_AGENT); __hip_atomic_store(st1.tmo, 1u, __ATOMIC_RELAXED, __HIP_MEMORY_SCOPE_AGENT); } }
    __device__ __forceinline__ void fused(f32x4 (&acc)[2][2][4][2], const Unit& u, int wr, int wc, int fr, int fq, PG8_LAS unsigned char* lds, int wid, int lane) const {
        typedef float f32x2v __attribute__((ext_vector_type(2))); typedef unsigned u32x2v __attribute__((ext_vector_type(2)));
        const PG8_LAS f32x2v* S = (const PG8_LAS f32x2v*)(lds + 8192);
        const int col0 = u.pn * BM + wc * 32 + 4 * fq;
#pragma unroll
        for (int bj = 0; bj < 2; ++bj)
#pragma unroll
            for (int n = 0; n < 2; ++n) { const f32x4 bv = bias ? *(const f32x4*)(bias + col0 + bj * HALF + n * 16) : (f32x4){0.f, 0.f, 0.f, 0.f};
#pragma unroll
                for (int ai = 0; ai < 2; ++ai)
#pragma unroll
                    for (int m = 0; m < 4; ++m) acc[ai][bj][m][n] += bv; }
        bool bad = st1.run(acc, u, wr, wc, fr, fq, lds, wid, lane) || poison != 0u;
        const float qnan = __builtin_nanf("");
#pragma unroll
        for (int ai = 0; ai < 2; ++ai)
#pragma unroll
            for (int m = 0; m < 4; ++m) { const int r = ai * HALF + wr * 64 + m * 16 + fr; const f32x2v sr = S[r]; const size_t off = (size_t)(u.pm * BM + r) * ldc + col0;
#pragma unroll
                for (int bj = 0; bj < 2; ++bj)
#pragma unroll
                    for (int n = 0; n < 2; ++n) { const f32x4 bs = *(const f32x4*)(base + off + bj * HALF + n * 16); acc[ai][bj][m][n] = bs + (acc[ai][bj][m][n] - sr.x) * sr.y; }
                asm volatile("" : "+v"(acc[ai][0][m][0]), "+v"(acc[ai][0][m][1]), "+v"(acc[ai][1][m][0]), "+v"(acc[ai][1][m][1]));
                if (m & 1) asm volatile("" ::: "memory"); }
        const bool bad1 = bad;
        bad = st2.run(acc, u, wr, wc, fr, fq, lds, wid, lane) || bad;
#pragma unroll
        for (int ai = 0; ai < 2; ++ai)
#pragma unroll
            for (int m = 0; m < 4; ++m) { const int r = ai * HALF + wr * 64 + m * 16 + fr; const f32x2v sr = S[r]; const size_t off = (size_t)(u.pm * BM + r) * ldc + col0;
#pragma unroll
                for (int bj = 0; bj < 2; ++bj)
#pragma unroll
                    for (int n = 0; n < 2; ++n) { const f32x4 x1 = acc[ai][bj][m][n]; *(f32x4*)(out + off + bj * HALF + n * 16) = bad1 ? (f32x4){qnan, qnan, qnan, qnan} : x1;
                        const f32x4 o = (x1 - sr.x) * sr.y; u32x2v w; w.x = cvt_pk_bf16(o[0], o[1]); w.y = cvt_pk_bf16(o[2], o[3]);
                        if (bad) { w.x = 0x7fc07fc0u; w.y = 0x7fc07fc0u; } *(u32x2v*)(xn + off + bj * HALF + n * 16) = w; }
                asm volatile("" ::: "memory"); }
    }
};

template <class Epi, class Sched, bool STAMP = false>
__device__ __forceinline__ void gemm_phase(PG8_LAS unsigned char* lds, const Gemm g, const Sched& S, const Epi& E, unsigned long long* stamps) {
    int tid_ = threadIdx.x; asm volatile("" : "+v"(tid_));
    const int tid = tid_, wid = __builtin_amdgcn_readfirstlane(tid >> 6), lane = tid & 63, wr = wid >> 2, wc = wid & 3, fr = lane & 15, fq = lane >> 4;
    const int K = g.K, nt = K / BK;
    int ts_lo = 0, ts_hi = 0, nts = 0; const unsigned long long rt_entry = STAMP ? (unsigned long long)wall_clock64() : 0ull;
#define PG8_STAMP() do { if (STAMP && wid == 0 && nts < 64) { const unsigned long long _c = (unsigned long long)clock64(); \
        ts_lo = (lane == nts) ? (int)(unsigned)_c : ts_lo; ts_hi = (lane == nts) ? (int)(unsigned)(_c >> 32) : ts_hi; ++nts; } } while (0)
    PG8_STAMP();
    unsigned voffA[2], voffB[2];
#pragma unroll
    for (int i = 0; i < 2; ++i) { int R, C; stage_rc(tid * 16 + i * 8192, R, C); const int Rb = Epi::PERM ? ((R & ~31) + perm32(R & 31)) : R;
        voffA[i] = (unsigned)(R * K + C) * 2u; voffB[i] = (unsigned)(Rb * K + C) * 2u; }
    const size_t kstep = (size_t)(BK * 2);
    const size_t hstep = (size_t)HALF * K * 2;
    const size_t tstep = 2 * hstep;
    const unsigned ldsw = (unsigned)wid * 1024u;
    const int aoff = lds_byte(wr * 64 + fr, fq * 8), boff = lds_byte(wc * 32 + fr, fq * 8);
#define PG8_SA(b, h) (((b) * 2 + (h)) * HTB)
#define PG8_SB(b, h) ((4 + (b) * 2 + (h)) * HTB)
#define PG8_STAGE(bufoff, gbase, voff) do { _Pragma("unroll") for (int _i = 0; _i < 2; ++_i) \
        __builtin_amdgcn_global_load_lds((const unsigned*)((const char*)(gbase) + (voff)[_i]), (PG8_LAS unsigned*)(lds + (bufoff) + ldsw + _i * 8192), 16, 0, 0); } while (0)
#define PG8_LDA(dst, b, h) do { _Pragma("unroll") for (int m = 0; m < 4; ++m) _Pragma("unroll") for (int k = 0; k < 2; ++k) dst[m][k] = *(const PG8_LAS bf16x8*)(lds + PG8_SA(b, h) + aoff + m * 2048 + k * 1024); } while (0)
#define PG8_LDB(dst, b, h) do { _Pragma("unroll") for (int n = 0; n < 2; ++n) _Pragma("unroll") for (int k = 0; k < 2; ++k) dst[n][k] = *(const PG8_LAS bf16x8*)(lds + PG8_SB(b, h) + boff + n * 2048 + k * 1024); } while (0)
#define PG8_MMA(ai, bj, At, Bt) do { __builtin_amdgcn_s_setprio(1); _Pragma("unroll") for (int m = 0; m < 4; ++m) _Pragma("unroll") for (int n = 0; n < 2; ++n) _Pragma("unroll") for (int k = 0; k < 2; ++k) \
        acc[ai][bj][m][n] = __builtin_amdgcn_mfma_f32_16x16x32_bf16(Bt[n][k], At[m][k], acc[ai][bj][m][n], 0, 0, 0); __builtin_amdgcn_s_setprio(0); } while (0)
#define PG8_WAIT_V(n) asm volatile("s_waitcnt vmcnt(" #n ")" ::: "memory")
#define PG8_WAIT_L(n) asm volatile("s_waitcnt lgkmcnt(" #n ")" ::: "memory")
#define PG8_BAR __builtin_amdgcn_s_barrier()
#define PG8_SCHED __builtin_amdgcn_sched_barrier(0)
    Unit cur, nxt; int ui = 0;
    if (!S.next(0, cur)) return;
    f32x4 acc[2][2][4][2];
#pragma unroll
    for (int a = 0; a < 2; ++a)
#pragma unroll
        for (int b = 0; b < 2; ++b)
#pragma unroll
            for (int m = 0; m < 4; ++m)
#pragma unroll
                for (int n = 0; n < 2; ++n) acc[a][b][m][n] = (f32x4){0.f, 0.f, 0.f, 0.f};
    bf16x8 At[4][2], B0[2][2], B1[2][2];
    const char* cA = (const char*)g.A + (size_t)cur.pm * tstep; const char* cB = (const char*)g.Bt + (size_t)cur.pn * tstep;
    S.a_ready(cur);
    PG8_STAGE(PG8_SB(0, 0), cB, voffB); PG8_STAGE(PG8_SA(0, 0), cA, voffA); PG8_STAGE(PG8_SB(0, 1), cB + hstep, voffB); PG8_STAGE(PG8_SA(0, 1), cA + hstep, voffA);
    if (wr == 1) PG8_BAR;
    PG8_WAIT_V(4); PG8_BAR;
    PG8_STAGE(PG8_SB(1, 0), cB + kstep, voffB); PG8_STAGE(PG8_SA(1, 0), cA + kstep, voffA); PG8_STAGE(PG8_SB(1, 1), cB + hstep + kstep, voffB);
    PG8_WAIT_V(6); PG8_BAR;
    PG8_STAMP();
    for (;;) {
        const bool has_next = S.next(ui + 1, nxt);
        const char* nA = has_next ? (const char*)g.A + (size_t)nxt.pm * tstep : cA; const char* nB = has_next ? (const char*)g.Bt + (size_t)nxt.pn * tstep : cB;
        for (int t = 0; t < nt; t += 2) {
            const bool last = (t == nt - 2);
            const char* a1 = cA + (size_t)(t + 1) * kstep;
            const char* a2 = last ? nA : cA + (size_t)(t + 2) * kstep; const char* b2 = last ? nB : cB + (size_t)(t + 2) * kstep;
            const char* a3 = a2 + kstep; const char* b3 = b2 + kstep;
            if (last && has_next) S.a_ready(nxt);
            PG8_LDB(B0, 0, 0); PG8_SCHED; PG8_LDA(At, 0, 0); PG8_STAGE(PG8_SA(1, 1), a1 + hstep, voffA);
            PG8_WAIT_L(8); PG8_BAR; PG8_WAIT_L(0); PG8_MMA(0, 0, At, B0); PG8_BAR; PG8_SCHED;
            PG8_LDB(B1, 0, 1); PG8_STAGE(PG8_SB(0, 0), b2, voffB);
            PG8_BAR; PG8_WAIT_L(0); PG8_MMA(0, 1, At, B1); PG8_BAR;
            PG8_LDA(At, 0, 1); PG8_STAGE(PG8_SA(0, 0), a2, voffA);
            PG8_BAR; PG8_WAIT_L(0); PG8_MMA(1, 0, At, B0); PG8_BAR; PG8_SCHED;
            PG8_STAGE(PG8_SB(0, 1), b2 + hstep, voffB);
            PG8_WAIT_V(6); PG8_BAR; PG8_MMA(1, 1, At, B1); PG8_BAR;
            PG8_LDB(B0, 1, 0); PG8_SCHED; PG8_LDA(At, 1, 0); PG8_STAGE(PG8_SA(0, 1), a2 + hstep, voffA);
            PG8_WAIT_L(8); PG8_BAR; PG8_WAIT_L(0); PG8_MMA(0, 0, At, B0); PG8_BAR; PG8_SCHED;
            PG8_LDB(B1, 1, 1); PG8_STAGE(PG8_SB(1, 0), b3, voffB);
            PG8_BAR; PG8_WAIT_L(0); PG8_MMA(0, 1, At, B1); PG8_BAR;
            PG8_LDA(At, 1, 1); PG8_STAGE(PG8_SA(1, 0), a3, voffA);
            PG8_BAR; PG8_WAIT_L(0); PG8_MMA(1, 0, At, B0); PG8_BAR; PG8_SCHED;
            PG8_STAGE(PG8_SB(1, 1), b3 + hstep, voffB);
            PG8_WAIT_V(6); PG8_BAR; PG8_MMA(1, 1, At, B1); PG8_BAR;
        }
        PG8_STAMP();
        if constexpr (!Epi::AFTER_DRAIN) { E(acc, cur, wr, wc, fr, fq); S.done(cur); }
        PG8_STAMP();
        if (!has_next) break;
#pragma unroll
        for (int a = 0; a < 2; ++a)
#pragma unroll
            for (int b = 0; b < 2; ++b)
#pragma unroll
                for (int m = 0; m < 4; ++m)
#pragma unroll
                    for (int n = 0; n < 2; ++n) acc[a][b][m][n] = (f32x4){0.f, 0.f, 0.f, 0.f};
        cur = nxt; cA = nA; cB = nB; ++ui;
    }
    PG8_WAIT_V(0);
    if (wr == 0) PG8_BAR;
    PG8_BAR;
    if constexpr (Epi::AFTER_DRAIN) { E.fused(acc, cur, wr, wc, fr, fq, lds, wid, lane); S.done(cur); }
    PG8_STAMP();
    if (STAMP && wid == 0) { stamps[lane] = lane < nts ? (((unsigned long long)(unsigned)ts_hi << 32) | (unsigned)ts_lo) : 0ull;
        if (lane == 62) stamps[62] = rt_entry; if (lane == 63) stamps[63] = (unsigned long long)wall_clock64(); }
#undef PG8_STAMP
#undef PG8_SA
#undef PG8_SB
#undef PG8_STAGE
#undef PG8_LDA
#undef PG8_LDB
#undef PG8_MMA
#undef PG8_WAIT_V
#undef PG8_WAIT_L
#undef PG8_BAR
#undef PG8_SCHED
}
}

namespace pg8 {
__device__ __forceinline__ float fast_sigmoid(float x) { return __builtin_amdgcn_rcpf(1.0f + __builtin_amdgcn_exp2f(-1.44269504089f * x)); }
struct EpiSwiGLU {
    static constexpr bool PERM = true, AFTER_DRAIN = false;
    bf16_t* H; int ldh;
    __device__ __forceinline__ void operator()(const f32x4 (&acc)[2][2][4][2], const Unit& u, int wr, int wc, int fr, int fq) const {
        const int row0 = u.pm * BM + wr * 64 + fr, hc0 = u.pn * 128 + wc * 32 + 8 * fq;
#pragma unroll
        for (int ai = 0; ai < 2; ++ai)
#pragma unroll
            for (int m = 0; m < 4; ++m) {
                bf16_t* rowp = H + (size_t)(row0 + ai * HALF + m * 16) * ldh + hc0;
                float v[8];
#pragma unroll
                for (int n = 0; n < 2; ++n)
#pragma unroll
                    for (int j = 0; j < 4; ++j) { const float g = acc[ai][0][m][n][j], up = acc[ai][1][m][n][j]; v[n * 4 + j] = g * fast_sigmoid(g) * up; }
                u32x4 w; w.x = cvt_pk_bf16(v[0], v[1]); w.y = cvt_pk_bf16(v[2], v[3]); w.z = cvt_pk_bf16(v[4], v[5]); w.w = cvt_pk_bf16(v[6], v[7]);
                *(u32x4*)rowp = w;
            }
    }
};
struct EpiResid {
    static constexpr bool PERM = false, AFTER_DRAIN = false;
    float* X; int ldc; float alpha; const float* Xsrc;
    __device__ __forceinline__ void operator()(const f32x4 (&acc)[2][2][4][2], const Unit& u, int wr, int wc, int fr, int fq) const {
        const int row0 = u.pm * BM + wr * 64 + fr, col0 = u.pn * BM + wc * 32 + 4 * fq;
#pragma unroll
        for (int ai = 0; ai < 2; ++ai)
#pragma unroll
            for (int m = 0; m < 4; ++m) { const size_t ro = (size_t)(row0 + ai * HALF + m * 16) * ldc + col0;
#pragma unroll
                for (int bj = 0; bj < 2; ++bj)
#pragma unroll
                    for (int n = 0; n < 2; ++n) { const f32x4 old = *(const f32x4*)(Xsrc + ro + bj * HALF + n * 16); *(f32x4*)(X + ro + bj * HALF + n * 16) = old + acc[ai][bj][m][n] * alpha; } }
    }
};
struct EpiWin {
    static constexpr bool PERM = true, AFTER_DRAIN = false;
    unsigned char* zbase; const float* bias; float* small_out;
    __device__ __forceinline__ void operator()(const f32x4 (&acc)[2][2][4][2], const Unit& u, int wr, int wc, int fr, int fq) const {
        const int row0 = u.pm * BM + wr * 64 + fr; const int pn = u.pn;
        const int bcol0 = pn * BM + wc * 32 + 8 * fq;
        f32x4 bv[2][2];
#pragma unroll
        for (int bj = 0; bj < 2; ++bj)
#pragma unroll
            for (int n = 0; n < 2; ++n) bv[bj][n] = *(const f32x4*)(bias + bcol0 + bj * HALF + 4 * n);
        if (pn == 17) {
            if (wc < 2) {
#pragma unroll
                for (int ai = 0; ai < 2; ++ai)
#pragma unroll
                    for (int m = 0; m < 4; ++m) { float* rowp = small_out + (size_t)(row0 + ai * HALF + m * 16) * 64 + wc * 32 + 8 * fq;
#pragma unroll
                        for (int n = 0; n < 2; ++n) *(f32x4*)(rowp + 4 * n) = acc[ai][0][m][n] + bv[0][n]; }
            }
            return;
        }
        size_t base; int ld, c0;
        if (pn < 8) { base = (size_t)(pn >> 1) * ((size_t)T * 512 * 2); ld = 512; c0 = (pn & 1) * 256; }
        else if (pn < 11) { base = (size_t)4 * T * 512 * 2 + (size_t)(pn - 8) * ((size_t)T * 256 * 2); ld = 256; c0 = 0; }
        else { base = (size_t)4 * T * 512 * 2 + (size_t)3 * T * 256 * 2 + (size_t)((pn - 11) >> 1) * ((size_t)T * 512 * 2); ld = 512; c0 = ((pn - 11) & 1) * 256; }
        bf16_t* O = (bf16_t*)(zbase + base);
        const int col0 = c0 + wc * 32 + 8 * fq;
#pragma unroll
        for (int ai = 0; ai < 2; ++ai)
#pragma unroll
            for (int m = 0; m < 4; ++m) { bf16_t* rowp = O + (size_t)(row0 + ai * HALF + m * 16) * ld + col0;
#pragma unroll
                for (int bj = 0; bj < 2; ++bj) { const f32x4 v0 = acc[ai][bj][m][0] + bv[bj][0], v1 = acc[ai][bj][m][1] + bv[bj][1];
                    u32x4 w; w.x = cvt_pk_bf16(v0[0], v0[1]); w.y = cvt_pk_bf16(v0[2], v0[3]); w.z = cvt_pk_bf16(v1[0], v1[1]); w.w = cvt_pk_bf16(v1[2], v1[3]);
                    *(u32x4*)(rowp + bj * HALF) = w; } }
    }
};
struct EpiGate {
    static constexpr bool PERM = true, AFTER_DRAIN = false;
    unsigned char* ws; int ldc; const float* bias;
    __device__ __forceinline__ void operator()(const f32x4 (&acc)[2][2][4][2], const Unit& u, int wr, int wc, int fr, int fq) const {
        const int br = u.pn >> 2;
        bf16_t* G = (bf16_t*)(ws + WS_G0 + (size_t)(br >= 1) * (WS_G1 - WS_G0) + (size_t)(br >= 2) * (WS_G2 - WS_G1));
        const int row0 = u.pm * BM + wr * 64 + fr, col0 = (u.pn & 3) * BM + wc * 32 + 8 * fq, bcol0 = u.pn * BM + wc * 32 + 8 * fq;
        f32x4 bv[2][2];
#pragma unroll
        for (int bj = 0; bj < 2; ++bj)
#pragma unroll
            for (int n = 0; n < 2; ++n) bv[bj][n] = *(const f32x4*)(bias + bcol0 + bj * HALF + 4 * n);
#pragma unroll
        for (int ai = 0; ai < 2; ++ai)
#pragma unroll
            for (int m = 0; m < 4; ++m) { bf16_t* rowp = G + (size_t)(row0 + ai * HALF + m * 16) * ldc + col0;
#pragma unroll
                for (int bj = 0; bj < 2; ++bj) { f32x4 v0 = acc[ai][bj][m][0] + bv[bj][0], v1 = acc[ai][bj][m][1] + bv[bj][1];
                    u32x4 w; w.x = cvt_pk_bf16(v0[0], v0[1]); w.y = cvt_pk_bf16(v0[2], v0[3]); w.z = cvt_pk_bf16(v1[0], v1[1]); w.w = cvt_pk_bf16(v1[2], v1[3]);
                    *(u32x4*)(rowp + bj * HALF) = w; } }
    }
};
struct EpiBranch {
    static constexpr bool PERM = true, AFTER_DRAIN = false;
    bf16_t* Y; const bf16_t* G; int ldc; int first;
    __device__ __forceinline__ void operator()(const f32x4 (&acc)[2][2][4][2], const Unit& u, int wr, int wc, int fr, int fq) const {
        const int row0 = u.pm * BM + wr * 64 + fr, col0 = u.pn * BM + wc * 32 + 8 * fq;
#pragma unroll
        for (int ai = 0; ai < 2; ++ai)
#pragma unroll
            for (int m = 0; m < 4; ++m) { const size_t off = (size_t)(row0 + ai * HALF + m * 16) * ldc + col0;
#pragma unroll
                for (int bj = 0; bj < 2; ++bj) {
                    const u32x4 g = *(const u32x4*)(G + off + bj * HALF);
                    u32x4 y = (u32x4){0u, 0u, 0u, 0u}; if (!first) y = *(const u32x4*)(Y + off + bj * HALF);
                    const f32x4 a0 = acc[ai][bj][m][0], a1 = acc[ai][bj][m][1];
                    float o[8];
#pragma unroll
                    for (int q = 0; q < 4; ++q) { const unsigned gw = g[q], yw = y[q]; const float al = q < 2 ? a0[2 * q] : a1[2 * q - 4], ah = q < 2 ? a0[2 * q + 1] : a1[2 * q - 3];
                        o[2 * q] = __builtin_bit_cast(float, yw << 16) + fast_sigmoid(__builtin_bit_cast(float, gw << 16)) * al;
                        o[2 * q + 1] = __builtin_bit_cast(float, yw & 0xffff0000u) + fast_sigmoid(__builtin_bit_cast(float, gw & 0xffff0000u)) * ah; }
                    u32x4 w; w.x = cvt_pk_bf16(o[0], o[1]); w.y = cvt_pk_bf16(o[2], o[3]); w.z = cvt_pk_bf16(o[4], o[5]); w.w = cvt_pk_bf16(o[6], o[7]);
                    *(u32x4*)(Y + off + bj * HALF) = w; } }
    }
};
}

constexpr int RING_BYTES = 131072;
constexpr int MISC_OFF = RING_BYTES + 320;
constexpr int LDS_BYTES = 147456;

__constant__ float ROPE_FREQ[32] = {
1.000000000e+00f, 7.498942614e-01f, 5.623413324e-01f, 4.216965139e-01f, 3.162277639e-01f, 2.371373773e-01f, 1.778279394e-01f, 1.333521307e-01f, 1.000000015e-01f, 7.498941571e-02f, 5.623413250e-02f, 4.216965288e-02f, 3.162277490e-02f, 2.371373773e-02f, 1.778279431e-02f, 1.333521493e-02f, 9.999999776e-03f, 7.498941850e-03f, 5.623413250e-03f, 4.216964822e-03f, 3.162277630e-03f, 2.371373586e-03f, 1.778279431e-03f, 1.333521446e-03f, 1.000000047e-03f, 7.498942432e-04f, 5.623413017e-04f, 4.216965172e-04f, 3.162277571e-04f, 2.371373703e-04f, 1.778279402e-04f, 1.333521504e-04f};

struct Args { const float* in[23]; float* out; unsigned char* ws; int ph_lo, ph_hi; };

struct Ctx {
    LAS unsigned char* lds;
    int tid, lane, wave, G, bid;
    __device__ __forceinline__ void launder() { asm volatile("" : "+v"(tid)); lane = tid & 63; asm volatile("" : "+s"(inp));
        GAS unsigned char* g = (GAS unsigned char*)ws; asm volatile("" : "+s"(g)); ws = (unsigned char*)g;
        GAS float* gx = (GAS float*)X; asm volatile("" : "+s"(gx)); X = (float*)gx; }
    const GAS float* const __attribute__((address_space(4)))* inp; float* X; unsigned char* ws;
    __device__ __forceinline__ const float* in(int k) const { return (const float*)inp[k]; }
};

__device__ __forceinline__ void transpose_item(const float* W, int ldw, int src_col0, bf16* WT, int K, int dst_row0, int kb, LAS float* scr, int lane) {
    const int k0 = 64 * kb;
#pragma unroll 8
    for (int i = 0; i < 32; ++i) { const int kk = 2 * i + (lane >> 5); scr[kk * 33 + (lane & 31)] = W[(size_t)(k0 + kk) * ldw + src_col0 + (lane & 31)]; }
    LDS_WAIT(); asm volatile("" ::: "memory");
    const int c = lane & 7;
#pragma unroll
    for (int j = 0; j < 4; ++j) { const int n = (lane >> 3) + 8 * j; const LAS float* s = scr + (8 * c) * 33 + n;
        v4u o; o.x = pk2(s[0 * 33], s[1 * 33]); o.y = pk2(s[2 * 33], s[3 * 33]); o.z = pk2(s[4 * 33], s[5 * 33]); o.w = pk2(s[6 * 33], s[7 * 33]);
        *(v4u*)(WT + (size_t)(dst_row0 + n) * K + k0 + 8 * c) = o; }
    LDS_WAIT(); asm volatile("" ::: "memory");
}
__device__ __forceinline__ int win_small_src(int i) { return i < 16 ? 1536 + i : i < 40 ? 2832 + (i - 16) : i < 44 ? 4392 + (i - 40) : i < 48 ? 4396 + (i - 44) : -1; }
__device__ __forceinline__ int win_src_col(int n) { return n < 1536 ? n : n < 2816 ? n + 16 : n < 4352 ? n + 40 : win_small_src(n - 4352); }

__device__ __forceinline__ void phase_prep_weights(const Ctx& C, int l) {
    LAS float* scr = (LAS float*)(C.lds + C.wave * 16384);
    const int gw = C.bid * NWAVES + C.wave, NGW = C.G * NWAVES;
    unsigned char* ws = C.ws;
    constexpr int I_GU = 16 * 88, I_DN = 44 * 32, I_WIN = 16 * 136, I_GT = 16 * 96, I_BR = 3 * 8 * 32, I_OUT = 16 * 32, I_C1 = 2 * 32 * 8, I_C2 = 2 * 4 * 2;
    constexpr int I_FFN = 2 * I_GU + I_DN;
    constexpr int NITEMS = 2 * I_FFN + I_WIN + I_GT + I_BR + I_OUT + I_C1 + I_C2;
    for (int it = gw; it < NITEMS; it += NGW) {
        int r = it;
        if (r < 2 * I_FFN) {
            const int f = r / I_FFN; r -= f * I_FFN;
            const float* wg = (f ? C.in(20) : C.in(2)) + (size_t)l * DM * DFF; const float* wu = (f ? C.in(21) : C.in(3)) + (size_t)l * DM * DFF; const float* wd = (f ? C.in(22) : C.in(4)) + (size_t)l * DFF * DM;
            bf16* WGU = (bf16*)(ws + (f ? WS_WGU2 : WS_WGU1)); bf16* WDN = (bf16*)(ws + (f ? WS_WDN2 : WS_WDN1));
            if (r < I_GU) { const int kb = r / 88, col = 32 * (r % 88); transpose_item(wg, DFF, col, WGU, DM, 256 * (col >> 7) + (col & 127), kb, scr, C.lane); }
            else if (r < 2 * I_GU) { r -= I_GU; const int kb = r / 88, col = 32 * (r % 88); transpose_item(wu, DFF, col, WGU, DM, 256 * (col >> 7) + 128 + (col & 127), kb, scr, C.lane); }
            else { r -= 2 * I_GU; const int kb = r / 32, col = 32 * (r % 32); transpose_item(wd, DM, col, WDN, DFF, col, kb, scr, C.lane); }
            continue;
        }
        r -= 2 * I_FFN;
        const float* win = C.in(6) + (size_t)l * DM * N_IN;
        if (r < I_WIN) { const int kb = r / 136, n = 32 * (r % 136); transpose_item(win, N_IN, win_src_col(n), (bf16*)(ws + WS_WIN), DM, n, kb, scr, C.lane); continue; } r -= I_WIN;
        if (r < I_GT) { const int kb = r / 96, n = 32 * (r % 96); transpose_item(win, N_IN, 4400 + n, (bf16*)(ws + WS_WGT), DM, n, kb, scr, C.lane); continue; } r -= I_GT;
        if (r < I_BR) { const int i = r / 256, rr = r % 256, kb = rr / 32, n = 32 * (rr % 32);
            transpose_item(C.in(17) + ((size_t)l * 3 + i) * 512 * DM, DM, n, (bf16*)(ws + WS_WBR) + (size_t)i * DM * 512, 512, n, kb, scr, C.lane); continue; } r -= I_BR;
        if (r < I_OUT) { const int kb = r / 32, n = 32 * (r % 32); transpose_item(C.in(18) + (size_t)l * DM * DM, DM, n, (bf16*)(ws + WS_WOUT), DM, n, kb, scr, C.lane); continue; } r -= I_OUT;
        if (r < I_C1) { const int kv = r / 256, rr = r % 256, kb = rr / 8, n = 32 * (rr % 8);
            transpose_item(C.in(13) + ((size_t)l * 2 + kv) * 2048 * 256, 256, n, (bf16*)(ws + WS_CW1) + (size_t)kv * 256 * 2048, 2048, n, kb, scr, C.lane); continue; } r -= I_C1;
        { const int kv = r / 8, rr = r % 8, kb = rr / 2, n = 32 * (rr % 2);
            transpose_item(C.in(14) + ((size_t)l * 2 + kv) * 256 * 64, 64, n, (bf16*)(ws + WS_CW2) + (size_t)kv * 64 * 256, 256, n, kb, scr, C.lane); }
    }
    const int gt = C.bid * NTHR + C.tid, NGT = C.G * NTHR;
    {
        const float* win = C.in(6) + (size_t)l * DM * N_IN; bf16* WIN = (bf16*)(ws + WS_WIN);
        for (int idx = gt; idx < 256 * 128; idx += NGT) { const int i = idx & 255, kc = idx >> 8; const int sc = win_small_src(i);
            v4u o = (v4u){0u, 0u, 0u, 0u};
            if (sc >= 0) { float v[8];
#pragma unroll
                for (int j = 0; j < 8; ++j) v[j] = win[(size_t)(kc * 8 + j) * N_IN + sc];
                o.x = pk2(v[0], v[1]); o.y = pk2(v[2], v[3]); o.z = pk2(v[4], v[5]); o.w = pk2(v[6], v[7]); }
            *(v4u*)(WIN + (size_t)(4352 + i) * DM + kc * 8) = o; }
        float* vec = (float*)(ws + WS_VEC); const float* bin = C.in(7) + (size_t)l * N_IN;
        for (int n = gt; n < 4608; n += NGT) { const int sc = win_src_col(n); vec[VEC_BINP + n] = sc >= 0 ? bin[sc] : 0.f; }
        for (int it = gw; it < 512; it += NGW) { const int kv = it >> 8, n = it & 255;
            const float* pe = C.in(12) + ((size_t)l * 2 + kv) * 2048; const float* w1 = C.in(13) + ((size_t)l * 2 + kv) * 2048 * 256;
            float s = 0.f;
            for (int k = C.lane; k < 2048; k += 64) s += pe[k] * w1[(size_t)k * 256 + n];
            s = wave_sum(s);
            if (C.lane == 0) vec[VEC_CB1 + it] = s; }
    }
}

__device__ __forceinline__ void phase_init(const Ctx& C) {
    const int gt = C.bid * NTHR + C.tid, NGT = C.G * NTHR;
    f32x2* rope = (f32x2*)(C.ws + WS_ROPE);
    for (int i = gt; i < SEQ * 32; i += NGT) { const int pos = i >> 5, fi = i & 31;
        const float ang = (float)pos * ROPE_FREQ[fi];
        double rev = (double)ang * 0.15915494309189533577; rev -= floor(rev);
        const float rf = (float)rev;
        rope[i] = (f32x2){__builtin_amdgcn_cosf(rf), __builtin_amdgcn_sinf(rf)}; }
}

__device__ __forceinline__ void phase_norm(const Ctx& C, const float* gain, const float* Xsrc) {
    const int gw = C.bid * NWAVES + C.wave, NGW = C.G * NWAVES;
    bf16* XN = (bf16*)(C.ws + WS_XN);
    f32x4 g[4];
#pragma unroll
    for (int j = 0; j < 4; ++j) g[j] = ((const f32x4*)gain)[C.lane + 64 * j];
    for (int m = gw; m < T; m += NGW) {
        const f32x4* xr = (const f32x4*)(Xsrc + (size_t)m * DM) + C.lane;
        f32x4 v[4]; float s = 0.f;
#pragma unroll
        for (int j = 0; j < 4; ++j) { v[j] = xr[64 * j]; s += (v[j].x * v[j].x + v[j].y * v[j].y) + (v[j].z * v[j].z + v[j].w * v[j].w); }
        const float r = 1.0f / sqrtf(wave_sum(s) * (1.f / DM) + RMS_EPS);
        unsigned long long* o8 = (unsigned long long*)(XN + (size_t)m * DM) + C.lane;
#pragma unroll
        for (int j = 0; j < 4; ++j) { const f32x4 w = v[j] * r * g[j]; o8[64 * j] = (unsigned long long)pk2(w.x, w.y) | ((unsigned long long)pk2(w.z, w.w) << 32); }
    }
}

template <int KSTEPS, class PA, class PB>
__device__ __forceinline__ f32x4 mma_tile(PA A, int lda, PB Bt, int ldb, f32x4 acc, int lane) {
    const int r = lane & 15, q = lane >> 4;
#pragma unroll
    for (int kk = 0; kk < KSTEPS; ++kk) {
        const bf16x8 a = *(const bf16x8*)(A + r * lda + kk * 32 + 8 * q);
        const bf16x8 b = *(const bf16x8*)(Bt + r * ldb + kk * 32 + 8 * q);
        acc = __builtin_amdgcn_mfma_f32_16x16x32_bf16(a, b, acc, 0, 0, 0);
    }
    return acc;
}
__device__ __forceinline__ float wave_scan_sum(float v, int lane) {
#pragma unroll
    for (int o = 1; o < 64; o <<= 1) { const float t = __shfl_up(v, o); if (lane >= o) v += t; }
    return v;
}
__device__ __forceinline__ float wave_scan_max(float v, int lane) {
#pragma unroll
    for (int o = 1; o < 64; o <<= 1) { const float t = __shfl_up(v, o); if (lane >= o) v = fmaxf(v, t); }
    return v;
}

constexpr int CU_ALR = 0;
constexpr int CU_GT = 4096;
constexpr int CU_VEC = 6144;
constexpr int CU_KT = 8192;
constexpr int CU_VT = 17408;
constexpr int CU_Q = 35840;
constexpr int CU_AT = 45056;
constexpr int CU_O = 54272;
constexpr int CU_END = 88064;

__device__ __forceinline__ void load_vt(const Ctx& C, const bf16* V, int t0, int h) {
    LAS bf16* VT = (LAS bf16*)(C.lds + CU_VT);
    const int dv = C.tid & 127, jq = C.tid >> 7;
    const bf16* src = V + (size_t)(t0 + 16 * jq) * 512 + h * 128 + dv;
    unsigned w[8];
#pragma unroll
    for (int jj = 0; jj < 8; ++jj) { const unsigned lo = src[(size_t)(2 * jj) * 512], hi = src[(size_t)(2 * jj + 1) * 512]; w[jj] = lo | (hi << 16); }
    *(LAS v4u*)(VT + dv * 72 + 16 * jq) = (v4u){w[0], w[1], w[2], w[3]};
    *(LAS v4u*)(VT + dv * 72 + 16 * jq + 8) = (v4u){w[4], w[5], w[6], w[7]};
}

__device__ __forceinline__ float gla_cumsum(const Ctx& C, int l, int t0, int h, float (&b)[8]) {
    LAS float* ALR = (LAS float*)(C.lds + CU_ALR); LAS float* GT = (LAS float*)(C.lds + CU_GT);
    const float* SMALL = (const float*)(C.ws + WS_SMALL);
    if (C.tid < 256) { const int j = C.tid >> 2, c4 = C.tid & 3; *(LAS f32x4*)(ALR + j * 16 + 4 * c4) = *(const f32x4*)(SMALL + (size_t)(t0 + j) * 64 + 4 * c4); }
    const int dk = C.tid & 63, jg = C.tid >> 6;
    float w[16]; const float* wa = C.in(8) + (size_t)l * 16 * 256 + h * 64 + dk;
#pragma unroll
    for (int r = 0; r < 16; ++r) w[r] = wa[r * 256];
    const float ba = C.in(9)[(size_t)l * 256 + h * 64 + dk];
    __syncthreads();
    float run = 0.f;
#pragma unroll
    for (int jj = 0; jj < 8; ++jj) { const int j = 8 * jg + jj; float x = ba;
#pragma unroll
        for (int r = 0; r < 16; ++r) x += ALR[j * 16 + r] * w[r];
        run += logsigmoidf_(x) * (1.0f / 16.0f); b[jj] = run; }
    GT[jg * 64 + dk] = run;
    __syncthreads();
    float pre = 0.f, tot = 0.f;
#pragma unroll
    for (int g2 = 0; g2 < 8; ++g2) { const float v = GT[g2 * 64 + dk]; tot += v; if (g2 < jg) pre += v; }
#pragma unroll
    for (int jj = 0; jj < 8; ++jj) b[jj] += pre;
    return tot;
}

__device__ __forceinline__ void gla_unit_a(const Ctx& C, int l, int ci) {
    const int bh = ci >> 8, c = ci & 255, bb = bh >> 2, h = bh & 3, t0 = bb * SEQ + c * 64;
    const bf16* QKA = (const bf16*)(C.ws + WS_QKA);
    load_vt(C, (const bf16*)(C.ws + WS_VA), t0, h);
    const int dk = C.tid & 63, jg = C.tid >> 6;
    unsigned kraw[8];
#pragma unroll
    for (int jj = 0; jj < 8; ++jj) kraw[jj] = QKA[(size_t)(t0 + 8 * jg + jj) * 512 + 256 + h * 64 + dk];
    float b[8]; const float btot = gla_cumsum(C, l, t0, h, b);
    LAS bf16* KT = (LAS bf16*)(C.lds + CU_KT);
    float kd[8];
#pragma unroll
    for (int jj = 0; jj < 8; ++jj) { const float k = bf2f(kraw[jj]); kd[jj] = k * fexp(btot - b[jj]); }
    *(LAS v4u*)(KT + dk * 72 + 8 * jg) = (v4u){pk2(kd[0], kd[1]), pk2(kd[2], kd[3]), pk2(kd[4], kd[5]), pk2(kd[6], kd[7])};
    if (jg == 0) ((float*)(C.ws + WS_GDEC))[(size_t)ci * 64 + dk] = fexp(btot);
    __syncthreads();
    const LAS bf16* VT = (const LAS bf16*)(C.lds + CU_VT);
    bf16* GST = (bf16*)(C.ws + WS_GST) + (size_t)ci * 8192;
    const int q = C.lane >> 4, fr = C.lane & 15;
#pragma unroll
    for (int nt = 0; nt < 4; ++nt) {
        f32x4 acc = (f32x4){0.f, 0.f, 0.f, 0.f};
        acc = mma_tile<2>(VT + 16 * C.wave * 72, 72, (const LAS bf16*)KT + 16 * nt * 72, 72, acc, C.lane);
#pragma unroll
        for (int r = 0; r < 4; ++r) GST[(16 * C.wave + 4 * q + r) * 64 + 16 * nt + fr] = (bf16)f2bf(acc[r]);
    }
    __syncthreads();
}

__device__ __forceinline__ void gla_unit_c(const Ctx& C, int l, int ci, bool DRY) {
    const int bh = ci >> 8, c = ci & 255, bb = bh >> 2, h = bh & 3, t0 = bb * SEQ + c * 64;
    const bf16* QKA = (const bf16*)(C.ws + WS_QKA);
    load_vt(C, (const bf16*)(C.ws + WS_VA), t0, h);
    const int dk = C.tid & 63, jg = C.tid >> 6;
    unsigned qraw[8], kraw[8];
#pragma unroll
    for (int jj = 0; jj < 8; ++jj) { const bf16* p = QKA + (size_t)(t0 + 8 * jg + jj) * 512 + h * 64 + dk; qraw[jj] = p[0]; kraw[jj] = p[256]; }
    bf16x8 stf[4][2];
    { const bf16* ST = (const bf16*)(C.ws + WS_GST) + (size_t)ci * 8192 + (size_t)(16 * 4 * (C.wave >> 2) + (C.lane & 15)) * 64 + 8 * (C.lane >> 4);
#pragma unroll
      for (int u = 0; u < 4; ++u) { stf[u][0] = *(const bf16x8*)(ST + u * 16 * 64); stf[u][1] = *(const bf16x8*)(ST + u * 16 * 64 + 32); } }
    v4u ar0, ar1;
    { const bf16* RAp = (const bf16*)(C.ws + WS_RA) + (size_t)(t0 + (C.tid >> 3)) * 512 + h * 128 + 16 * (C.tid & 7); ar0 = *(const v4u*)RAp; ar1 = *(const v4u*)(RAp + 8); }
    float b[8]; (void)gla_cumsum(C, l, t0, h, b);
    LAS bf16* KT = (LAS bf16*)(C.lds + CU_KT); LAS bf16* QT = (LAS bf16*)(C.lds + CU_Q); LAS bf16* AT = (LAS bf16*)(C.lds + CU_AT);
#pragma unroll
    for (int jj = 0; jj < 8; ++jj) { const int j = 8 * jg + jj;
        const float qv = bf2f(qraw[jj]) * 0.125f, kv = bf2f(kraw[jj]);
        QT[j * 72 + dk] = (bf16)f2bf(qv * fexp(b[jj])); KT[j * 72 + dk] = (bf16)f2bf(kv * fexp(fminf(-b[jj], 80.f))); }
    __syncthreads();
    const int q = C.lane >> 4, fr = C.lane & 15;
    {
        const int it = C.wave >> 1;
#pragma unroll
        for (int u = 0; u < 2; ++u) { const int jt = 2 * (C.wave & 1) + u;
            f32x4 acc = (f32x4){0.f, 0.f, 0.f, 0.f};
            if (jt <= it) acc = mma_tile<2>((const LAS bf16*)KT + 16 * jt * 72, 72, (const LAS bf16*)QT + 16 * it * 72, 72, acc, C.lane);
            const int i = 16 * it + fr;
            float v[4];
#pragma unroll
            for (int r = 0; r < 4; ++r) { const int j = 16 * jt + 4 * q + r; v[r] = (j <= i) ? acc[r] : 0.f; }
            *(LAS v2u*)(AT + i * 72 + 16 * jt + 4 * q) = (v2u){pk2(v[0], v[1]), pk2(v[2], v[3])}; }
    }
    __syncthreads();
    {
        const int it = C.wave & 3; LAS float* O = (LAS float*)(C.lds + CU_O);
        const LAS bf16* VT = (const LAS bf16*)(C.lds + CU_VT);
#pragma unroll
        for (int u = 0; u < 4; ++u) { const int dvt = 4 * (C.wave >> 2) + u;
            f32x4 acc = (f32x4){0.f, 0.f, 0.f, 0.f};
#pragma unroll
            for (int kk = 0; kk < 2; ++kk) { const bf16x8 a = *(const LAS bf16x8*)((const LAS bf16*)QT + (16 * it + fr) * 72 + kk * 32 + 8 * q); acc = __builtin_amdgcn_mfma_f32_16x16x32_bf16(a, stf[u][kk], acc, 0, 0, 0); }
            acc = mma_tile<2>((const LAS bf16*)AT + 16 * it * 72, 72, VT + 16 * dvt * 72, 72, acc, C.lane);
#pragma unroll
            for (int r = 0; r < 4; ++r) O[(16 * it + 4 * q + r) * 132 + 16 * dvt + fr] = acc[r]; }
    }
    __syncthreads();
    {
        const int i = C.tid >> 3, s = C.tid & 7; const LAS float* O = (const LAS float*)(C.lds + CU_O) + i * 132 + 16 * s;
        float o[16]; float ss = 0.f;
#pragma unroll
        for (int k = 0; k < 16; ++k) { o[k] = O[k]; ss += o[k] * o[k]; }
        ss += __shfl_xor(ss, 1); ss += __shfl_xor(ss, 2); ss += __shfl_xor(ss, 4);
        const float rinv = 1.0f / sqrtf(ss * (1.0f / 128.0f) + RMS_EPS);
        bf16* RA = (bf16*)(C.ws + WS_RA) + (size_t)(t0 + i) * 512 + h * 128 + 16 * s;
        const float* gn = C.in(10) + (size_t)l * 128 + 16 * s;
        const v4u r0 = ar0, r1 = ar1;
        unsigned rw[8] = {r0.x, r0.y, r0.z, r0.w, r1.x, r1.y, r1.z, r1.w}; unsigned ow[8];
#pragma unroll
        for (int k = 0; k < 8; ++k) { const float a = SCL_A * o[2 * k] * rinv * gn[2 * k] * siluf_(bflo(rw[k])), bq = SCL_A * o[2 * k + 1] * rinv * gn[2 * k + 1] * siluf_(bfhi(rw[k])); ow[k] = (ABL_ZERO & 1) ? 0u : pk2(a, bq); }
        if (DRY) { asm volatile("" :: "v"(ow[0]), "v"(ow[1]), "v"(ow[2]), "v"(ow[3]), "v"(ow[4]), "v"(ow[5]), "v"(ow[6]), "v"(ow[7])); } else {
        *(v4u*)RA = (v4u){ow[0], ow[1], ow[2], ow[3]}; *(v4u*)(RA + 8) = (v4u){ow[4], ow[5], ow[6], ow[7]}; }
    }
    __syncthreads();
}

__device__ __forceinline__ void conv_silu8(const Ctx& C, int l, int t0, int c, int ch, int jg, float (&out)[8]) {
    const bf16* X = (const bf16*)(C.ws + WS_QKC);
    const float* cw = C.in(15) + (size_t)l * 4 * 512 + ch; const float cb = C.in(16)[(size_t)l * 512 + ch];
    const float w0 = cw[0], w1 = cw[512], w2 = cw[1024], w3 = cw[1536];
    float x[11];
#pragma unroll
    for (int k = 0; k < 11; ++k) { const int j = 8 * jg + k - 3; const int s = c * 64 + j; x[k] = (s >= 0) ? bf2f(X[(size_t)(t0 + j) * 512 + ch]) : 0.f; }
#pragma unroll
    for (int jj = 0; jj < 8; ++jj) out[jj] = siluf_(cb + w0 * x[jj] + w1 * x[jj + 1] + w2 * x[jj + 2] + w3 * x[jj + 3]);
}

__device__ __forceinline__ void mlstm_unit_a(const Ctx& C, int l, int ci) {
    const int bh = ci >> 8, c = ci & 255, bb = bh >> 2, h = bh & 3, t0 = bb * SEQ + c * 64;
    LAS float* VEC = (LAS float*)(C.lds + CU_VEC); LAS float* GT = (LAS float*)(C.lds + CU_GT);
    load_vt(C, (const bf16*)(C.ws + WS_VC), t0, h);
    const int dk = C.tid & 63, jg = C.tid >> 6;
    float k[8]; conv_silu8(C, l, t0, c, 256 + h * 64 + dk, jg, k);
    if (C.wave == 0) {
        const float* sm = (const float*)(C.ws + WS_SMALL) + (size_t)(t0 + C.lane) * 64;
        const float ip = sm[40 + h], lf = logsigmoidf_(sm[44 + h]);
        const float bj = wave_scan_sum(lf, C.lane); const float a = ip - bj; const float amax = wave_max(a);
        VEC[C.lane] = fexp(a - amax);
        if (C.lane == 63) { float* msc = (float*)(C.ws + WS_MSC) + (size_t)ci * 4; msc[0] = bj; msc[1] = amax; }
    }
    __syncthreads();
    LAS bf16* KT = (LAS bf16*)(C.lds + CU_KT);
    float kw[8]; float ns = 0.f;
#pragma unroll
    for (int jj = 0; jj < 8; ++jj) { kw[jj] = k[jj] * 0.125f * VEC[8 * jg + jj]; ns += kw[jj]; }
    *(LAS v4u*)(KT + dk * 72 + 8 * jg) = (v4u){pk2(kw[0], kw[1]), pk2(kw[2], kw[3]), pk2(kw[4], kw[5]), pk2(kw[6], kw[7])};
    GT[jg * 64 + dk] = ns;
    __syncthreads();
    if (C.tid < 64) { float s = 0.f;
#pragma unroll
        for (int g2 = 0; g2 < 8; ++g2) s += GT[g2 * 64 + C.tid];
        ((float*)(C.ws + WS_MN))[(size_t)ci * 64 + C.tid] = s; }
    const LAS bf16* VT = (const LAS bf16*)(C.lds + CU_VT);
    bf16* MST = (bf16*)(C.ws + WS_MST) + (size_t)ci * 8192;
    const int q = C.lane >> 4, fr = C.lane & 15;
#pragma unroll
    for (int nt = 0; nt < 4; ++nt) {
        f32x4 acc = (f32x4){0.f, 0.f, 0.f, 0.f};
        acc = mma_tile<2>(VT + 16 * C.wave * 72, 72, (const LAS bf16*)KT + 16 * nt * 72, 72, acc, C.lane);
#pragma unroll
        for (int r = 0; r < 4; ++r) MST[(16 * C.wave + 4 * q + r) * 64 + 16 * nt + fr] = (bf16)f2bf(acc[r]);
    }
    __syncthreads();
}

__device__ __forceinline__ void mlstm_unit_c(const Ctx& C, int l, int ci, bool DRY) {
    const int bh = ci >> 8, c = ci & 255, bb = bh >> 2, h = bh & 3, t0 = bb * SEQ + c * 64;
    LAS float* VEC = (LAS float*)(C.lds + CU_VEC);
    LAS float* AJ = VEC + 64, *MI = VEC + 128, *WI = VEC + 192, *EM = VEC + 256, *QN = VEC + 384; LAS float* DENP = (LAS float*)(C.lds + CU_GT);
    load_vt(C, (const bf16*)(C.ws + WS_VC), t0, h);
    const int dk = C.tid & 63, jg = C.tid >> 6;
    LAS bf16* KT = (LAS bf16*)(C.lds + CU_KT); LAS bf16* QT = (LAS bf16*)(C.lds + CU_Q); LAS bf16* AT = (LAS bf16*)(C.lds + CU_AT);
    bf16x8 stf[4][2];
    { const bf16* ST = (const bf16*)(C.ws + WS_MST) + (size_t)ci * 8192 + (size_t)(16 * 4 * (C.wave >> 2) + (C.lane & 15)) * 64 + 8 * (C.lane >> 4);
#pragma unroll
      for (int u = 0; u < 4; ++u) { stf[u][0] = *(const bf16x8*)(ST + u * 16 * 64); stf[u][1] = *(const bf16x8*)(ST + u * 16 * 64 + 32); } }
    v4u co0, co1; f32x4 nst0, nst1;
    { const bf16* OCp = (const bf16*)(C.ws + WS_OC) + (size_t)(t0 + (C.tid >> 3)) * 512 + h * 128 + 16 * (C.tid & 7); co0 = *(const v4u*)OCp; co1 = *(const v4u*)(OCp + 8);
      const float* np = (const float*)(C.ws + WS_MN) + (size_t)ci * 64 + 8 * (C.tid & 7); nst0 = *(const f32x4*)np; nst1 = *(const f32x4*)(np + 4); }
    {
        float qv[8], kv[8]; conv_silu8(C, l, t0, c, h * 64 + dk, jg, qv); conv_silu8(C, l, t0, c, 256 + h * 64 + dk, jg, kv);
#pragma unroll
        for (int jj = 0; jj < 8; ++jj) { const int j = 8 * jg + jj; QT[j * 72 + dk] = (bf16)f2bf(qv[jj]); KT[j * 72 + dk] = (bf16)f2bf(kv[jj] * 0.125f); }
    }
    if (C.wave == 0) {
        const float* sm = (const float*)(C.ws + WS_SMALL) + (size_t)(t0 + C.lane) * 64;
        const float ip = sm[40 + h], lf = logsigmoidf_(sm[44 + h]);
        const float bj = wave_scan_sum(lf, C.lane); const float a = ip - bj; const float arun = wave_scan_max(a, C.lane);
        const float mst = ((const float*)(C.ws + WS_MSC))[(size_t)ci * 4 + 2];
        const float mi = fmaxf(mst, arun);
        AJ[C.lane] = a; MI[C.lane] = mi; WI[C.lane] = fexp(mst - mi); EM[C.lane] = fexp(-(bj + mi));
    }
    __syncthreads();
    const int q = C.lane >> 4, fr = C.lane & 15;
    {
        const int it = C.wave >> 1;
#pragma unroll
        for (int u = 0; u < 2; ++u) { const int jt = 2 * (C.wave & 1) + u;
            f32x4 acc = (f32x4){0.f, 0.f, 0.f, 0.f};
            if (jt <= it) acc = mma_tile<2>((const LAS bf16*)KT + 16 * jt * 72, 72, (const LAS bf16*)QT + 16 * it * 72, 72, acc, C.lane);
            const int i = 16 * it + fr; const float mi = MI[i];
            float v[4]; float ds = 0.f;
#pragma unroll
            for (int r = 0; r < 4; ++r) { const int j = 16 * jt + 4 * q + r; v[r] = (j <= i) ? acc[r] * fexp(AJ[j] - mi) : 0.f; ds += v[r]; }
            ds += __shfl_xor(ds, 16); ds += __shfl_xor(ds, 32);
            if (q == 0) DENP[jt * 64 + i] = ds;
            *(LAS v2u*)(AT + i * 72 + 16 * jt + 4 * q) = (v2u){pk2(v[0], v[1]), pk2(v[2], v[3])}; }
    }
    {
        const int i = C.tid >> 3, s = C.tid & 7; const float nst[8] = {nst0[0], nst0[1], nst0[2], nst0[3], nst1[0], nst1[1], nst1[2], nst1[3]};
        float a = 0.f;
#pragma unroll
        for (int k = 0; k < 8; ++k) a += bf2f(QT[i * 72 + 8 * s + k]) * nst[k];
        a += __shfl_xor(a, 1); a += __shfl_xor(a, 2); a += __shfl_xor(a, 4);
        if (s == 0) QN[i] = a;
    }
    __syncthreads();
    {
        const int it = C.wave & 3; LAS float* O = (LAS float*)(C.lds + CU_O);
        const LAS bf16* VT = (const LAS bf16*)(C.lds + CU_VT);
#pragma unroll
        for (int u = 0; u < 4; ++u) { const int dvt = 4 * (C.wave >> 2) + u;
            f32x4 a1 = (f32x4){0.f, 0.f, 0.f, 0.f}, a2 = (f32x4){0.f, 0.f, 0.f, 0.f};
#pragma unroll
            for (int kk = 0; kk < 2; ++kk) { const bf16x8 a = *(const LAS bf16x8*)((const LAS bf16*)QT + (16 * it + fr) * 72 + kk * 32 + 8 * q); a1 = __builtin_amdgcn_mfma_f32_16x16x32_bf16(a, stf[u][kk], a1, 0, 0, 0); }
            a2 = mma_tile<2>((const LAS bf16*)AT + 16 * it * 72, 72, VT + 16 * dvt * 72, 72, a2, C.lane);
#pragma unroll
            for (int r = 0; r < 4; ++r) { const int i = 16 * it + 4 * q + r; O[i * 132 + 16 * dvt + fr] = WI[i] * a1[r] + a2[r]; } }
    }
    __syncthreads();
    {
        const int i = C.tid >> 3, s = C.tid & 7; const LAS float* O = (const LAS float*)(C.lds + CU_O) + i * 132 + 16 * s;
        const float den = WI[i] * QN[i] + ((DENP[i] + DENP[64 + i]) + (DENP[128 + i] + DENP[192 + i])); const float dinv = 1.0f / fmaxf(fabsf(den), EM[i]);
        bf16* OC = (bf16*)(C.ws + WS_OC) + (size_t)(t0 + i) * 512 + h * 128 + 16 * s;
        const v4u r0 = co0, r1 = co1;
        unsigned rw[8] = {r0.x, r0.y, r0.z, r0.w, r1.x, r1.y, r1.z, r1.w}; unsigned ow[8];
#pragma unroll
        for (int k = 0; k < 8; ++k) ow[k] = (ABL_ZERO & 4) ? 0u : pk2(SCL_C * O[2 * k] * dinv * sigmoidf_(bflo(rw[k])), SCL_C * O[2 * k + 1] * dinv * sigmoidf_(bfhi(rw[k])));
        if (DRY) { asm volatile("" :: "v"(ow[0]), "v"(ow[1]), "v"(ow[2]), "v"(ow[3]), "v"(ow[4]), "v"(ow[5]), "v"(ow[6]), "v"(ow[7])); } else {
        *(v4u*)OC = (v4u){ow[0], ow[1], ow[2], ow[3]}; *(v4u*)(OC + 8) = (v4u){ow[4], ow[5], ow[6], ow[7]}; }
    }
    __syncthreads();
}

__device__ __forceinline__ void phase_scan(const Ctx& C) {
    const int gt = C.bid * NTHR + C.tid, NGT = C.G * NTHR;
    for (int e = gt; e < 65536 + 65536; e += NGT) {
        if (e < 65536) {
            const int bh = e >> 13, el = e & 8191, dk = el & 63;
            bf16* st = (bf16*)(C.ws + WS_GST) + (size_t)bh * 256 * 8192 + el; const float* dec = (const float*)(C.ws + WS_GDEC) + (size_t)bh * 256 * 64 + dk;
            float s = 0.f;
            for (int c0 = 0; c0 < 256; c0 += 8) { float L[8], d[8];
#pragma unroll
                for (int k = 0; k < 8; ++k) { L[k] = bf2f(st[(size_t)(c0 + k) * 8192]); d[k] = dec[(c0 + k) * 64]; }
#pragma unroll
                for (int k = 0; k < 8; ++k) { st[(size_t)(c0 + k) * 8192] = (bf16)f2bf(s); s = d[k] * s + L[k]; } }
        } else {
            const int e2 = e - 65536, bh = e2 >> 13, el = e2 & 8191; const bool hasn = el < 64;
            bf16* st = (bf16*)(C.ws + WS_MST) + (size_t)bh * 256 * 8192 + el; float* nv = (float*)(C.ws + WS_MN) + (size_t)bh * 256 * 64 + (hasn ? el : 0);
            float* msc = (float*)(C.ws + WS_MSC) + (size_t)bh * 256 * 4;
            float s = 0.f, sn = 0.f, m = 0.f;
            for (int c0 = 0; c0 < 256; c0 += 8) { float L[8], Ln[8], bl[8], am[8];
#pragma unroll
                for (int k = 0; k < 8; ++k) { L[k] = bf2f(st[(size_t)(c0 + k) * 8192]); Ln[k] = hasn ? nv[(c0 + k) * 64] : 0.f; bl[k] = msc[(c0 + k) * 4]; am[k] = msc[(c0 + k) * 4 + 1]; }
#pragma unroll
                for (int k = 0; k < 8; ++k) {
                    const float mn = bl[k] + fmaxf(m, am[k]); const float al = fexp(bl[k] + m - mn), be = fexp(bl[k] + am[k] - mn);
                    st[(size_t)(c0 + k) * 8192] = (bf16)f2bf(s);
                    if (hasn) { nv[(c0 + k) * 64] = sn; if (el == 0) msc[(c0 + k) * 4 + 2] = m; }
                    s = al * s + be * L[k]; sn = al * sn + be * Ln[k]; m = mn; } }
        }
    }
}

__device__ __forceinline__ float gelu_tanh(float x) { const float u = 0.7978845608f * (x + 0.044715f * x * x * x); const float e = __expf(2.0f * u); return 0.5f * x * (2.0f - 2.0f / (1.0f + e)); }

__device__ __forceinline__ void nsa_prep_token(const Ctx& C, int l, int t) {
    const float* gn = C.in(11) + (size_t)l * 4 * 64;
    const f32x2 cs = ((const f32x2*)(C.ws + WS_ROPE))[(size_t)(t & (SEQ - 1)) * 32 + (C.lane & 31)];
    bf16* q = (bf16*)(C.ws + WS_QB) + (size_t)t * 512 + C.lane;
    bf16* ks = (bf16*)(C.ws + WS_KVS) + (size_t)t * 256 + C.lane; bf16* kw = (bf16*)(C.ws + WS_KVW) + (size_t)t * 256 + C.lane;
    const float g0 = gn[C.lane], g2 = gn[128 + C.lane], g3 = gn[192 + C.lane];
    float x[12], ss[12];
#pragma unroll
    for (int r = 0; r < 8; ++r) x[r] = bf2f(q[r * 64]);
    x[8] = bf2f(ks[0]); x[9] = bf2f(ks[64]); x[10] = bf2f(kw[0]); x[11] = bf2f(kw[64]);
#pragma unroll
    for (int r = 0; r < 12; ++r) ss[r] = x[r] * x[r];
#pragma unroll
    for (int o = 1; o < 64; o <<= 1)
#pragma unroll
        for (int r = 0; r < 12; ++r) ss[r] += __shfl_xor(ss[r], o);
    float y[12], pr[12];
#pragma unroll
    for (int r = 0; r < 12; ++r) { const float g = r < 8 ? g0 : r < 10 ? g2 : g3; y[r] = x[r] * (1.0f / sqrtf(ss[r] * (1.0f / 64.0f) + RMS_EPS)) * g; }
#pragma unroll
    for (int r = 0; r < 12; ++r) pr[r] = __shfl_xor(y[r], 32);
#pragma unroll
    for (int r = 0; r < 12; ++r) { const float o = (C.lane < 32) ? (y[r] * cs.x - pr[r] * cs.y) : (pr[r] * cs.y + y[r] * cs.x); const unsigned ob = f2bf(r < 8 ? o * 0.125f : o);
        if (r < 8) q[r * 64] = (bf16)ob; else if (r == 8) ks[0] = (bf16)ob; else if (r == 9) ks[64] = (bf16)ob; else if (r == 10) kw[0] = (bf16)ob; else kw[64] = (bf16)ob; }
}
__device__ __forceinline__ void nsa_vtrans_item(const Ctx& C, int item) {
    const int which = item >> 10, bg = (item >> 8) & 3, blk = item & 255, b = bg >> 1, g = bg & 1;
    const bf16* src = (const bf16*)(C.ws + (which ? WS_KVW : WS_KVS)) + (size_t)(b * SEQ + blk * 64 + C.lane) * 256 + 128 + g * 64;
    bf16* dst = (bf16*)(C.ws + (which ? WS_VWT : WS_VST)) + (size_t)(bg * 256 + blk) * 4096 + C.lane;
    v4u w[8];
#pragma unroll
    for (int k = 0; k < 8; ++k) w[k] = ((const v4u*)src)[k];
#pragma unroll
    for (int k = 0; k < 8; ++k)
#pragma unroll
        for (int e = 0; e < 4; ++e) { const unsigned x = w[k][e]; dst[(size_t)(8 * k + 2 * e) * 64] = (bf16)(x & 0xffffu); dst[(size_t)(8 * k + 2 * e + 1) * 64] = (bf16)(x >> 16); }
}
__device__ __forceinline__ void nsa_cmp1_item(const Ctx& C, int item) {
    const int kv = item >> 10, rt = (item >> 2) & 255, ng = item & 3;
    const int fr = C.lane & 15, q = C.lane >> 4;
    const int ri = rt * 16 + fr, b = ri >> 11, g = (ri >> 10) & 1, c = ri & 1023, cc = c < 1023 ? c : 1022;
    const bf16* arow = (const bf16*)(C.ws + WS_KVC) + (size_t)(b * SEQ + 16 * cc) * 256 + kv * 128 + g * 64 + 8 * q;
    const bf16* brow = (const bf16*)(C.ws + WS_CW1) + (size_t)kv * 256 * 2048 + (size_t)(ng * 64 + fr) * 2048 + 8 * q;
    f32x4 acc[4];
#pragma unroll
    for (int nt = 0; nt < 4; ++nt) acc[nt] = (f32x4){0.f, 0.f, 0.f, 0.f};
#pragma unroll 4
    for (int kk = 0; kk < 64; ++kk) {
        const bf16x8 a = *(const bf16x8*)(arow + (kk >> 1) * 256 + (kk & 1) * 32);
#pragma unroll
        for (int nt = 0; nt < 4; ++nt) { const bf16x8 bv = *(const bf16x8*)(brow + (size_t)nt * 16 * 2048 + kk * 32); acc[nt] = __builtin_amdgcn_mfma_f32_16x16x32_bf16(a, bv, acc[nt], 0, 0, 0); }
    }
    const float* cb1 = (const float*)(C.ws + WS_VEC) + VEC_CB1 + kv * 256;
    bf16* H1 = (bf16*)(C.ws + WS_CMPH) + (size_t)kv * 4096 * 256;
#pragma unroll
    for (int nt = 0; nt < 4; ++nt) { const int n = ng * 64 + nt * 16 + fr; const float bia = cb1[n];
#pragma unroll
        for (int r = 0; r < 4; ++r) H1[(size_t)(rt * 16 + 4 * q + r) * 256 + n] = (bf16)f2bf(gelu_tanh(acc[nt][r] + bia)); }
}
__device__ __forceinline__ void nsa_cmp2_item(const Ctx& C, int l, int item) {
    const int kv = item >> 8, rt = item & 255;
    const int fr = C.lane & 15, q = C.lane >> 4;
    const bf16* H1 = (const bf16*)(C.ws + WS_CMPH) + (size_t)kv * 4096 * 256 + (size_t)rt * 16 * 256;
    const bf16* W2 = (const bf16*)(C.ws + WS_CW2) + (size_t)kv * 64 * 256;
    f32x4 acc[4];
#pragma unroll
    for (int nt = 0; nt < 4; ++nt) { acc[nt] = (f32x4){0.f, 0.f, 0.f, 0.f}; acc[nt] = mma_tile<8>(H1, 256, W2 + nt * 16 * 256, 256, acc[nt], C.lane); }
    if (kv == 0) {
        const float* gn = C.in(11) + (size_t)l * 4 * 64 + 64;
        bf16* KC = (bf16*)(C.ws + WS_KCMP);
#pragma unroll
        for (int r = 0; r < 4; ++r) {
            float ss = 0.f;
#pragma unroll
            for (int nt = 0; nt < 4; ++nt) ss += acc[nt][r] * acc[nt][r];
            ss += __shfl_xor(ss, 1); ss += __shfl_xor(ss, 2); ss += __shfl_xor(ss, 4); ss += __shfl_xor(ss, 8);
            const float rinv = 1.0f / sqrtf(ss * (1.0f / 64.0f) + RMS_EPS);
            float y[4];
#pragma unroll
            for (int nt = 0; nt < 4; ++nt) y[nt] = acc[nt][r] * rinv * gn[nt * 16 + fr];
            const int ri = rt * 16 + 4 * q + r, c = ri & 1023; int pos = 16 * c + 31; pos = pos < SEQ ? pos : SEQ - 1;
            const f32x2* rr = (const f32x2*)(C.ws + WS_ROPE) + (size_t)pos * 32;
            const f32x2 c0 = rr[fr], c1 = rr[16 + fr];
            bf16* o = KC + (size_t)ri * 64;
            o[fr] = (bf16)f2bf(y[0] * c0.x - y[2] * c0.y); o[16 + fr] = (bf16)f2bf(y[1] * c1.x - y[3] * c1.y);
            o[32 + fr] = (bf16)f2bf(y[0] * c0.y + y[2] * c0.x); o[48 + fr] = (bf16)f2bf(y[1] * c1.y + y[3] * c1.x);
        }
    } else {
        bf16* VCT = (bf16*)(C.ws + WS_VCT);
        const int ri0 = rt * 16, bg = ri0 >> 10, c0 = (ri0 & 1023) + 4 * q;
#pragma unroll
        for (int nt = 0; nt < 4; ++nt) { const int d = nt * 16 + fr;
            *(v2u*)(VCT + (size_t)(bg * 64 + d) * 1024 + c0) = (v2u){pk2(acc[nt][0], acc[nt][1]), pk2(acc[nt][2], acc[nt][3])}; }
    }
}

constexpr int NQ = 32;
constexpr int NU_IMP = 0;
constexpr int NU_SEL = 32768;
constexpr int NU_UM = 33792;
constexpr int NU_UL = 33824;
constexpr int NU_KV = 35072;
constexpr int NU_TILE = 18432;
constexpr int NU_END = NU_KV + 4 * NU_TILE;
constexpr float LOG2E = 1.44269504089f;

struct TileSrc { const bf16* k; int kld; const bf16* v; int vld; };

__device__ __forceinline__ void nsa_fetch(const Ctx& C, const TileSrc& ts, bool on, v4u& kr, v4u& vr) {
    const int r = C.tid >> 3, ch = C.tid & 7;
    if (on) { kr = *(const v4u*)(ts.k + (size_t)r * ts.kld + ch * 8); vr = *(const v4u*)(ts.v + (size_t)r * ts.vld + ch * 8); }
}
__device__ __forceinline__ void nsa_commit(const Ctx& C, int j, bool on, const v4u& kr, const v4u& vr) {
    LAS bf16* KT = (LAS bf16*)(C.lds + NU_KV + j * NU_TILE); LAS bf16* VT = KT + 64 * 72;
    const int r = C.tid >> 3, ch = C.tid & 7;
    if (on) { *(LAS v4u*)(KT + r * 72 + ch * 8) = kr; *(LAS v4u*)(VT + r * 72 + ch * 8) = vr; }
}
__device__ __forceinline__ void nsa_scores(const Ctx& C, int j, const bf16x8 (&qf)[2], f32x4 (&s)[4]) {
    const LAS bf16* KT = (const LAS bf16*)(C.lds + NU_KV + j * NU_TILE);
    const int fr = C.lane & 15, q = C.lane >> 4;
#pragma unroll
    for (int kt = 0; kt < 4; ++kt) { s[kt] = (f32x4){0.f, 0.f, 0.f, 0.f};
#pragma unroll
        for (int ks = 0; ks < 2; ++ks) { const bf16x8 a = *(const LAS bf16x8*)(KT + (16 * kt + fr) * 72 + ks * 32 + 8 * q); s[kt] = __builtin_amdgcn_mfma_f32_16x16x32_bf16(a, qf[ks], s[kt], 0, 0, 0); } }
}
__device__ __forceinline__ void nsa_pv(const Ctx& C, int j, const f32x4 (&p)[4], f32x4 (&o)[4]) {
    const LAS bf16* VT = (const LAS bf16*)(C.lds + NU_KV + j * NU_TILE) + 64 * 72;
    const int fr = C.lane & 15, q = C.lane >> 4;
    bf16x8 pf[2];
#pragma unroll
    for (int k2 = 0; k2 < 2; ++k2) { v4u w; w.x = pk2(p[2 * k2][0], p[2 * k2][1]); w.y = pk2(p[2 * k2][2], p[2 * k2][3]); w.z = pk2(p[2 * k2 + 1][0], p[2 * k2 + 1][1]); w.w = pk2(p[2 * k2 + 1][2], p[2 * k2 + 1][3]);
        pf[k2] = __builtin_bit_cast(bf16x8, w); }
#pragma unroll
    for (int dt = 0; dt < 4; ++dt)
#pragma unroll
        for (int k2 = 0; k2 < 2; ++k2) {
            const LAS bf16* vr = VT + (16 * dt + fr) * 72 + 32 * k2 + 4 * q;
            const v2u lo = *(const LAS v2u*)vr, hi = *(const LAS v2u*)(vr + 16);
            const v4u aw = (v4u){lo.x, lo.y, hi.x, hi.y};
            o[dt] = __builtin_amdgcn_mfma_f32_16x16x32_bf16(__builtin_bit_cast(bf16x8, aw), pf[k2], o[dt], 0, 0, 0);
        }
}
__device__ __forceinline__ float nsa_exp(f32x4 (&s)[4], float ml2) {
    float ps = 0.f;
#pragma unroll
    for (int kt = 0; kt < 4; ++kt)
#pragma unroll
        for (int r = 0; r < 4; ++r) { const float p = __builtin_amdgcn_exp2f(s[kt][r] * LOG2E - ml2); s[kt][r] = p; ps += p; }
    return ps;
}

__device__ __forceinline__ void nsa_attn_unit(const Ctx& C, int l, int u, bool DRY) {
    const int half = u & 1, bg = (u >> 1) & 3, b = bg >> 1, g = bg & 1;
    const int qb = 255 - (u >> 3);
    const int q0 = 32 * half;
    const int t0 = b * SEQ + qb * 64;
    const int fr = C.lane & 15, q = C.lane >> 4, qq = fr >> 2, hh = fr & 3;
    LAS float* IMP = (LAS float*)(C.lds + NU_IMP);
    LAS unsigned long long* SEL = (LAS unsigned long long*)(C.lds + NU_SEL);
    LAS unsigned long long* UM = (LAS unsigned long long*)(C.lds + NU_UM);
    LAS int* UL = (LAS int*)(C.lds + NU_UL);
    for (int i = C.tid; i < NQ * 256; i += NTHR) IMP[i] = 0.f;
    float mc2, ms2, mw2;
    { const float* gn = C.in(11) + (size_t)l * 256;
      const float gq = wave_max(fabsf(gn[C.lane])), g1 = wave_max(fabsf(gn[64 + C.lane])), g2 = wave_max(fabsf(gn[128 + C.lane])), g3 = wave_max(fabsf(gn[192 + C.lane]));
      mc2 = 8.0f * gq * g1 * LOG2E; ms2 = 8.0f * gq * g2 * LOG2E; mw2 = 8.0f * gq * g3 * LOG2E; }
    bf16* QB = (bf16*)(C.ws + WS_QB);
    const int iq = q0 + 4 * C.wave + qq;
    bf16x8 qf[2]; float gate[3];
    { const bf16* qp = QB + (size_t)(t0 + iq) * 512 + (g * 4 + hh) * 64 + 8 * q;
      qf[0] = *(const bf16x8*)qp; qf[1] = *(const bf16x8*)(qp + 32);
      const float* sm = (const float*)(C.ws + WS_SMALL) + (size_t)(t0 + iq) * 64 + 16 + (g * 4 + hh) * 3;
#pragma unroll
      for (int k = 0; k < 3; ++k) gate[k] = ((ABL_ZERO & 2) || (ABL_ZERO & (8 << k))) ? 0.f : SCL_B * sigmoidf_(sm[k]); }
    f32x4 out[4];
#pragma unroll
    for (int dt = 0; dt < 4; ++dt) out[dt] = (f32x4){0.f, 0.f, 0.f, 0.f};
    v4u kr[4], vr[4];

    const bf16* KC = (const bf16*)(C.ws + WS_KCMP) + (size_t)bg * 1024 * 64;
    const bf16* VCT = (const bf16*)(C.ws + WS_VCT) + (size_t)bg * 64 * 1024;
    const int nct = (4 * qb + 3 + 63) >> 6, ncs = (nct + 3) >> 2;
    const int cmax = (64 * qb + iq - 31) >> 4, cmin = (64 * qb + q0 + 4 * C.wave - 31) >> 4;
    float cl = 0.f, cinv = 0.f;
    for (int rep = (TIMEDUP & 2048) ? 0 : 1; rep < 2; ++rep) { cl = 0.f;
    for (int pass = 0; pass < 2; ++pass) {
        f32x4 ao[4];
#pragma unroll
        for (int dt = 0; dt < 4; ++dt) ao[dt] = (f32x4){0.f, 0.f, 0.f, 0.f};
        if (pass == 1) { float lt = cl; lt += __shfl_xor(lt, 16); lt += __shfl_xor(lt, 32); cinv = lt > 0.f ? 1.0f / lt : 0.f; }
#pragma unroll
        for (int j = 0; j < 4; ++j) { const TileSrc ts{KC + (size_t)j * 64 * 64, 64, VCT + j * 64, 1024}; nsa_fetch(C, ts, j < nct, kr[j], vr[j]); }
        for (int st = 0; st < ncs; ++st) {
            __syncthreads();
#pragma unroll
            for (int j = 0; j < 4; ++j) nsa_commit(C, j, 4 * st + j < nct, kr[j], vr[j]);
            __syncthreads();
            if (st + 1 < ncs) {
#pragma unroll
                for (int j = 0; j < 4; ++j) { const int tl = 4 * (st + 1) + j; const TileSrc ts{KC + (size_t)tl * 64 * 64, 64, VCT + tl * 64, 1024}; nsa_fetch(C, ts, tl < nct, kr[j], vr[j]); }
            }
#pragma unroll
            for (int j = 0; j < 4; ++j) {
                const int tl = 4 * st + j;
                if (tl < nct) {
                    f32x4 s[4]; nsa_scores(C, j, qf, s);
                    if (64 * tl + 63 > cmin) {
#pragma unroll
                    for (int kt = 0; kt < 4; ++kt)
#pragma unroll
                        for (int r = 0; r < 4; ++r) { const int c = 64 * tl + 16 * kt + 4 * q + r; if (c > cmax) s[kt][r] = -INFINITY; }
                    }
                    const float ps = nsa_exp(s, mc2);
                    if (pass == 0) cl += ps;
                    else {
#pragma unroll
                        for (int kt = 0; kt < 4; ++kt) {
#pragma unroll
                            for (int r = 0; r < 4; ++r) s[kt][r] *= cinv;
                            float gs = (s[kt][0] + s[kt][1]) + (s[kt][2] + s[kt][3]), es = s[kt][3];
                            gs += __shfl_xor(gs, 1); gs += __shfl_xor(gs, 2); es += __shfl_xor(es, 1); es += __shfl_xor(es, 2);
                            if (hh == 0) { const int n = 16 * tl + 4 * kt + q;
                                if (n < 256) { atomicAdd((float*)(IMP + (iq - q0) * 256 + n), gs); if (n + 1 < 256) atomicAdd((float*)(IMP + (iq - q0) * 256 + n + 1), es); } }
                        }
                        nsa_pv(C, j, s, ao);
                    }
                }
            }
        }
        if (pass == 1) {
#pragma unroll
            for (int dt = 0; dt < 4; ++dt) out[dt] += ao[dt] * (rep == 1 ? gate[0] : 0.f);
        }
        __syncthreads();
    } }

    for (int rep = (TIMEDUP & 256) ? 0 : 1; rep < 2; ++rep)
    for (int k4 = 0; k4 < 4; ++k4) {
        const int i = 4 * C.wave + k4;
        unsigned key[4]; unsigned long long selw[4];
#pragma unroll
        for (int k = 0; k < 4; ++k) { const int n = C.lane + 64 * k; const bool valid = n <= qb; const bool forced = valid && (n == 0 || n == qb || n == qb - 1);
            key[k] = (valid && !forced) ? (__builtin_bit_cast(unsigned, fmaxf(IMP[i * 256 + n], 0.f)) + 1u) : 0u;
            selw[k] = __ballot(forced); }
        const int nforced = qb >= 2 ? 3 : qb + 1; const int ncand = qb + 1 - nforced;
        int need = 16 - nforced; if (need > ncand) need = ncand;
        if (need == ncand) {
#pragma unroll
            for (int k = 0; k < 4; ++k) selw[k] |= __ballot(key[k] != 0u);
        } else {
            unsigned thr = 0u;
            for (int bit = 31; bit >= 0; --bit) { const unsigned cand = thr | (1u << bit); int cnt = 0;
#pragma unroll
                for (int k = 0; k < 4; ++k) cnt += __builtin_popcountll(__ballot(key[k] >= cand));
                if (cnt >= need) thr = cand; }
            int left = need;
#pragma unroll
            for (int k = 0; k < 4; ++k) { const unsigned long long gt = __ballot(key[k] > thr); selw[k] |= gt; left -= __builtin_popcountll(gt); }
#pragma unroll
            for (int k = 0; k < 4; ++k) { unsigned long long eq = __ballot(key[k] == thr);
                while (left > 0 && eq) { const unsigned long long low = eq & (0ull - eq); selw[k] |= low; eq ^= low; --left; } }
        }
        if (C.lane < 4) SEL[i * 4 + C.lane] = C.lane == 0 ? selw[0] : C.lane == 1 ? selw[1] : C.lane == 2 ? selw[2] : selw[3];
    }
    __syncthreads();
    if (C.tid < 4) { unsigned long long um = 0ull; for (int i = 0; i < NQ; ++i) um |= SEL[i * 4 + C.tid]; UM[C.tid] = um; }
    __syncthreads();
    int ucnt;
    {
        const unsigned long long u0 = UM[0], u1 = UM[1], u2 = UM[2], u3 = UM[3];
        const int c0 = __builtin_popcountll(u0), c1 = __builtin_popcountll(u1), c2 = __builtin_popcountll(u2), c3 = __builtin_popcountll(u3);
        ucnt = c0 + c1 + c2 + c3;
        if (C.tid < 256) { const int w = C.tid >> 6, bit = C.tid & 63; const unsigned long long uw = w == 0 ? u0 : w == 1 ? u1 : w == 2 ? u2 : u3;
            if ((uw >> bit) & 1ull) { const int pos = (w > 0 ? c0 : 0) + (w > 1 ? c1 : 0) + (w > 2 ? c2 : 0) + __builtin_popcountll(uw & ((1ull << bit) - 1ull)); UL[pos] = C.tid; } }
    }
    __syncthreads();

    for (int rep = (TIMEDUP & 1024) ? 0 : 1; rep < 2; ++rep) {
        f32x4 ao[4]; float al = 0.f;
#pragma unroll
        for (int dt = 0; dt < 4; ++dt) ao[dt] = (f32x4){0.f, 0.f, 0.f, 0.f};
        const bf16* KS = (const bf16*)(C.ws + WS_KVS) + (size_t)(b * SEQ) * 256 + g * 64;
        const bf16* VST = (const bf16*)(C.ws + WS_VST) + (size_t)bg * 256 * 4096;
        const int nss = (ucnt + 3) >> 2;
        const unsigned long long my0 = SEL[(iq - q0) * 4 + 0], my1 = SEL[(iq - q0) * 4 + 1], my2 = SEL[(iq - q0) * 4 + 2], my3 = SEL[(iq - q0) * 4 + 3];
        v4u kr2[4], vr2[4];
#define SLC_FETCH(STG, KR, VR) do { _Pragma("unroll") for (int j = 0; j < 4; ++j) { const int ix = 4 * (STG) + j; const int n = ix < ucnt ? UL[ix] : 0; \
            const TileSrc ts{KS + (size_t)n * 64 * 256, 256, VST + (size_t)n * 4096, 64}; nsa_fetch(C, ts, ix < ucnt, KR[j], VR[j]); } } while (0)
#define SLC_STAGE(STG, KR, VR) do { \
            __syncthreads(); \
            _Pragma("unroll") for (int j = 0; j < 4; ++j) nsa_commit(C, j, 4 * (STG) + j < ucnt, KR[j], VR[j]); \
            __syncthreads(); \
            if ((STG) + 2 < nss) SLC_FETCH((STG) + 2, KR, VR); \
            _Pragma("unroll") for (int j = 0; j < 4; ++j) { \
                const int ix = 4 * (STG) + j; \
                if (ix < ucnt) { \
                    const int n = UL[ix]; \
                    const unsigned long long mw = (n >> 6) == 0 ? my0 : (n >> 6) == 1 ? my1 : (n >> 6) == 2 ? my2 : my3; \
                    const bool mysel = (mw >> (n & 63)) & 1ull; \
                    if (__ballot(mysel) != 0ull) { \
                        f32x4 s[4]; nsa_scores(C, j, qf, s); \
                        if (n == qb) { _Pragma("unroll") for (int kt = 0; kt < 4; ++kt) _Pragma("unroll") for (int r = 0; r < 4; ++r) { const int key = 16 * kt + 4 * q + r; if (key > iq) s[kt][r] = -INFINITY; } } \
                        al += nsa_exp(s, mysel ? ms2 : INFINITY); \
                        nsa_pv(C, j, s, ao); \
                    } } } } while (0)
        SLC_FETCH(0, kr, vr);
        if (nss > 1) SLC_FETCH(1, kr2, vr2);
        for (int st = 0; st < nss; st += 2) {
            SLC_STAGE(st, kr, vr);
            if (st + 1 < nss) SLC_STAGE(st + 1, kr2, vr2);
        }
#undef SLC_FETCH
#undef SLC_STAGE
        float lt = al; lt += __shfl_xor(lt, 16); lt += __shfl_xor(lt, 32); const float inv = (lt > 0.f && rep == 1) ? gate[1] / lt : 0.f;
#pragma unroll
        for (int dt = 0; dt < 4; ++dt) out[dt] += ao[dt] * inv;
    }
    for (int rep = (TIMEDUP & 512) ? 0 : 1; rep < 2; ++rep) {
        f32x4 ao[4]; float al = 0.f;
#pragma unroll
        for (int dt = 0; dt < 4; ++dt) ao[dt] = (f32x4){0.f, 0.f, 0.f, 0.f};
        const bf16* KW = (const bf16*)(C.ws + WS_KVW) + (size_t)(b * SEQ) * 256 + g * 64;
        const bf16* VWT = (const bf16*)(C.ws + WS_VWT) + (size_t)bg * 256 * 4096;
        const int nfirst = qb >= 8 ? qb - 8 : 0, nw = qb - nfirst + 1, nws = (nw + 3) >> 2;
#pragma unroll
        for (int j = 0; j < 4; ++j) { const int n = nfirst + j; const TileSrc ts{KW + (size_t)n * 64 * 256, 256, VWT + (size_t)n * 4096, 64}; nsa_fetch(C, ts, j < nw, kr[j], vr[j]); }
        for (int st = 0; st < nws; ++st) {
            __syncthreads();
#pragma unroll
            for (int j = 0; j < 4; ++j) nsa_commit(C, j, 4 * st + j < nw, kr[j], vr[j]);
            __syncthreads();
            if (st + 1 < nws) {
#pragma unroll
                for (int j = 0; j < 4; ++j) { const int ix = 4 * (st + 1) + j; const int n = nfirst + (ix < nw ? ix : 0); const TileSrc ts{KW + (size_t)n * 64 * 256, 256, VWT + (size_t)n * 4096, 64}; nsa_fetch(C, ts, ix < nw, kr[j], vr[j]); }
            }
#pragma unroll
            for (int j = 0; j < 4; ++j) {
                const int ix = 4 * st + j;
                if (ix < nw) {
                    const int delta = qb - (nfirst + ix);
                    f32x4 s[4]; nsa_scores(C, j, qf, s);
                    if (delta == 0 || delta == 8) {
#pragma unroll
                        for (int kt = 0; kt < 4; ++kt)
#pragma unroll
                            for (int r = 0; r < 4; ++r) { const int key = 16 * kt + 4 * q + r; const bool ok = delta == 0 ? (key <= iq) : (key > iq); if (!ok) s[kt][r] = -INFINITY; }
                    }
                    al += nsa_exp(s, mw2);
                    nsa_pv(C, j, s, ao);
                }
            }
        }
        float lt = al; lt += __shfl_xor(lt, 16); lt += __shfl_xor(lt, 32); const float inv = (lt > 0.f && rep == 1) ? gate[2] / lt : 0.f;
#pragma unroll
        for (int dt = 0; dt < 4; ++dt) out[dt] += ao[dt] * inv;
    }
    if (DRY) {
#pragma unroll
      for (int dt = 0; dt < 4; ++dt) asm volatile("" :: "v"(out[dt]));
    } else { bf16* op = QB + (size_t)(t0 + iq) * 512 + (g * 4 + hh) * 64 + 4 * q;
#pragma unroll
      for (int dt = 0; dt < 4; ++dt) *(v2u*)(op + 16 * dt) = (v2u){pk2(out[dt][0], out[dt][1]), pk2(out[dt][2], out[dt][3])}; }
    __syncthreads();
}


#ifndef NAIVE_GLA
#define NAIVE_GLA 0
#endif
#ifndef NAIVE_MLSTM
#define NAIVE_MLSTM 0
#endif
__device__ __forceinline__ void naive_gla(const Ctx& C, int l, int bh) {
    const int bb = bh >> 2, h = bh & 3, dk = C.lane, g = C.wave;
    LAS float* SS = (LAS float*)(C.lds);
    const bf16* QKA = (const bf16*)(C.ws + WS_QKA); const bf16* VA = (const bf16*)(C.ws + WS_VA); bf16* RA = (bf16*)(C.ws + WS_RA);
    const float* SMALL = (const float*)(C.ws + WS_SMALL);
    float w[16]; const float* wa = C.in(8) + (size_t)l * 16 * 256 + h * 64 + dk;
    for (int r = 0; r < 16; ++r) w[r] = wa[r * 256];
    const float ba = C.in(9)[(size_t)l * 256 + h * 64 + dk];
    const float* gn = C.in(10) + (size_t)l * 128 + 16 * g;
    float S[16];
    for (int e = 0; e < 16; ++e) S[e] = 0.f;
    for (int s = 0; s < SEQ; ++s) {
        const size_t t = (size_t)bb * SEQ + s;
        float x = ba;
        for (int r = 0; r < 16; ++r) x += SMALL[t * 64 + r] * w[r];
        const float al = __expf(logsigmoidf_(x) * (1.0f / 16.0f));
        const float q = bf2f(QKA[t * 512 + h * 64 + dk]) * 0.125f, k = bf2f(QKA[t * 512 + 256 + h * 64 + dk]);
        float o[16]; float ss = 0.f;
        for (int e = 0; e < 16; ++e) { const float v = bf2f(VA[t * 512 + h * 128 + 16 * g + e]); S[e] = al * S[e] + k * v; o[e] = wave_sum(q * S[e]); ss += o[e] * o[e]; }
        if (C.lane == 0) SS[(s & 1) * 8 + g] = ss;
        __syncthreads();
        float tot = 0.f;
        for (int w8 = 0; w8 < 8; ++w8) tot += SS[(s & 1) * 8 + w8];
        const float rinv = 1.0f / sqrtf(tot * (1.0f / 128.0f) + RMS_EPS);
        float mine = 0.f;
        for (int e = 0; e < 16; ++e) if (C.lane == e) mine = o[e];
        if (C.lane < 16) { bf16* p = RA + t * 512 + h * 128 + 16 * g + C.lane; const float r = bf2f(*p); *p = (bf16)f2bf(mine * rinv * gn[C.lane] * siluf_(r)); }
    }
    __syncthreads();
}
__device__ __forceinline__ void naive_mlstm(const Ctx& C, int l, int bh) {
    const int bb = bh >> 2, h = bh & 3, dk = C.lane, g = C.wave;
    const bf16* X = (const bf16*)(C.ws + WS_QKC); const bf16* VC = (const bf16*)(C.ws + WS_VC); bf16* OC = (bf16*)(C.ws + WS_OC);
    const float* SMALL = (const float*)(C.ws + WS_SMALL);
    const int chq = h * 64 + dk, chk = 256 + h * 64 + dk;
    const float* cw = C.in(15) + (size_t)l * 4 * 512; const float* cb = C.in(16) + (size_t)l * 512;
    float wq[4], wk[4];
    for (int i = 0; i < 4; ++i) { wq[i] = cw[i * 512 + chq]; wk[i] = cw[i * 512 + chk]; }
    const float bq = cb[chq], bk = cb[chk];
    float Cm[16]; for (int e = 0; e < 16; ++e) Cm[e] = 0.f;
    float n = 0.f, m = 0.f;
    float xq[4] = {0.f, 0.f, 0.f, 0.f}, xk[4] = {0.f, 0.f, 0.f, 0.f};
    for (int s = 0; s < SEQ; ++s) {
        const size_t t = (size_t)bb * SEQ + s;
        xq[0] = xq[1]; xq[1] = xq[2]; xq[2] = xq[3]; xq[3] = bf2f(X[t * 512 + chq]);
        xk[0] = xk[1]; xk[1] = xk[2]; xk[2] = xk[3]; xk[3] = bf2f(X[t * 512 + chk]);
        const float q = siluf_(bq + wq[0] * xq[0] + wq[1] * xq[1] + wq[2] * xq[2] + wq[3] * xq[3]);
        const float k = siluf_(bk + wk[0] * xk[0] + wk[1] * xk[1] + wk[2] * xk[2] + wk[3] * xk[3]) * 0.125f;
        const float ip = SMALL[t * 64 + 40 + h], lf = logsigmoidf_(SMALL[t * 64 + 44 + h]);
        const float mn = fmaxf(lf + m, ip);
        const float fd = __expf(lf + m - mn), ig = __expf(ip - mn);
        n = fd * n + ig * k;
        const float den = wave_sum(q * n);
        const float dinv = 1.0f / fmaxf(fabsf(den), __expf(-mn));
        float mine = 0.f;
        for (int e = 0; e < 16; ++e) { const float v = bf2f(VC[t * 512 + h * 128 + 16 * g + e]); Cm[e] = fd * Cm[e] + ig * k * v; const float num = wave_sum(q * Cm[e]); if (C.lane == e) mine = num; }
        m = mn;
        if (C.lane < 16) { bf16* p = OC + t * 512 + h * 128 + 16 * g + C.lane; const float og = bf2f(*p); *p = (bf16)f2bf(mine * dinv * sigmoidf_(og)); }
    }
}
#ifndef NAIVE_WIN
#define NAIVE_WIN 0
#endif
__device__ __forceinline__ void naive_win_store(const Ctx& C, size_t t, int col, float z) {
    unsigned char* ws = C.ws;
    int c = col;
    if (c < 256) { ((bf16*)(ws + WS_QKA))[t * 512 + c] = (bf16)f2bf(z); return; } c -= 256;
    if (c < 256) { ((bf16*)(ws + WS_QKA))[t * 512 + 256 + c] = (bf16)f2bf(z); return; } c -= 256;
    if (c < 512) { ((bf16*)(ws + WS_VA))[t * 512 + c] = (bf16)f2bf(z); return; } c -= 512;
    if (c < 512) { ((bf16*)(ws + WS_RA))[t * 512 + c] = (bf16)f2bf(z); return; } c -= 512;
    if (c < 16) { ((float*)(ws + WS_SMALL))[t * 64 + c] = z; return; } c -= 16;
    if (c < 512) { ((bf16*)(ws + WS_QB))[t * 512 + c] = (bf16)f2bf(z); return; } c -= 512;
    if (c < 128) { ((bf16*)(ws + WS_KVC))[t * 256 + c] = (bf16)f2bf(z); return; } c -= 128;
    if (c < 128) { ((bf16*)(ws + WS_KVC))[t * 256 + 128 + c] = (bf16)f2bf(z); return; } c -= 128;
    if (c < 128) { ((bf16*)(ws + WS_KVS))[t * 256 + c] = (bf16)f2bf(z); return; } c -= 128;
    if (c < 128) { ((bf16*)(ws + WS_KVS))[t * 256 + 128 + c] = (bf16)f2bf(z); return; } c -= 128;
    if (c < 128) { ((bf16*)(ws + WS_KVW))[t * 256 + c] = (bf16)f2bf(z); return; } c -= 128;
    if (c < 128) { ((bf16*)(ws + WS_KVW))[t * 256 + 128 + c] = (bf16)f2bf(z); return; } c -= 128;
    if (c < 24) { ((float*)(ws + WS_SMALL))[t * 64 + 16 + c] = z; return; } c -= 24;
    if (c < 512) { ((bf16*)(ws + WS_QKC))[t * 512 + c] = (bf16)f2bf(z); return; } c -= 512;
    if (c < 512) { ((bf16*)(ws + WS_VC))[t * 512 + c] = (bf16)f2bf(z); return; } c -= 512;
    if (c < 512) { ((bf16*)(ws + WS_OC))[t * 512 + c] = (bf16)f2bf(z); return; } c -= 512;
    if (c < 4) { ((float*)(ws + WS_SMALL))[t * 64 + 40 + c] = z; return; } c -= 4;
    if (c < 4) { ((float*)(ws + WS_SMALL))[t * 64 + 44 + c] = z; return; }
}
__device__ __forceinline__ void naive_win(const Ctx& C, int l) {
    LAS float* xs = (LAS float*)C.lds;
    const float* gain = C.in(5) + (size_t)l * DM; const float* W = C.in(6) + (size_t)l * DM * N_IN; const float* bin = C.in(7) + (size_t)l * N_IN;
    for (int tile = C.bid; tile < T / 8; tile += C.G) {
        __syncthreads();
        {
            const size_t t = (size_t)tile * 8 + C.wave; const float* xr = C.X + t * DM;
            float v[16]; float s = 0.f;
            for (int j = 0; j < 16; ++j) { v[j] = xr[C.lane + 64 * j]; s += v[j] * v[j]; }
            const float r = 1.0f / sqrtf(wave_sum(s) * (1.f / DM) + RMS_EPS);
            for (int j = 0; j < 16; ++j) xs[C.wave * 1024 + C.lane + 64 * j] = v[j] * r * gain[C.lane + 64 * j];
        }
        __syncthreads();
        for (int col = C.tid; col < 4400; col += NTHR) {
            float acc[8]; for (int i = 0; i < 8; ++i) acc[i] = 0.f;
            for (int k = 0; k < DM; ++k) { const float w = W[(size_t)k * N_IN + col];
                for (int i = 0; i < 8; ++i) acc[i] += xs[i * 1024 + k] * w; }
            const float bb = bin[col];
            for (int i = 0; i < 8; ++i) naive_win_store(C, (size_t)tile * 8 + i, col, acc[i] + bb);
        }
    }
    __syncthreads();
}
#ifndef NAIVE_MERGE
#define NAIVE_MERGE 0
#endif
__device__ __forceinline__ void naive_merge(const Ctx& C, int l) {
    LAS float* xs = (LAS float*)C.lds;
    LAS float* os = xs + 8 * 1024;
    const float* gain = C.in(5) + (size_t)l * DM; const float* W = C.in(6) + (size_t)l * DM * N_IN; const float* bin = C.in(7) + (size_t)l * N_IN;
    const float* WB = C.in(17) + (size_t)l * 3 * 512 * DM;
    bf16* Y = (bf16*)(C.ws + WS_Y);
    for (int tile = C.bid; tile < T / 8; tile += C.G) {
        __syncthreads();
        {
            const size_t t = (size_t)tile * 8 + C.wave; const float* xr = C.X + t * DM;
            float v[16]; float s = 0.f;
            for (int j = 0; j < 16; ++j) { v[j] = xr[C.lane + 64 * j]; s += v[j] * v[j]; }
            const float r = 1.0f / sqrtf(wave_sum(s) * (1.f / DM) + RMS_EPS);
            for (int j = 0; j < 16; ++j) xs[C.wave * 1024 + C.lane + 64 * j] = v[j] * r * gain[C.lane + 64 * j];
            for (int i = 0; i < 3; ++i) { const bf16* src = (const bf16*)(C.ws + (i == 0 ? WS_RA : i == 1 ? WS_QB : WS_OC)) + t * 512;
                for (int j = 0; j < 8; ++j) os[(i * 8 + C.wave) * 512 + C.lane + 64 * j] = bf2f(src[C.lane + 64 * j]); }
        }
        __syncthreads();
        for (int c = C.tid; c < DM; c += NTHR) {
            float y[8]; for (int i = 0; i < 8; ++i) y[i] = 0.f;
            for (int br = 0; br < 3; ++br) {
                float ga[8], pa[8]; for (int i = 0; i < 8; ++i) { ga[i] = 0.f; pa[i] = 0.f; }
                const int gc = 4400 + br * DM + c;
                for (int k = 0; k < DM; ++k) { const float w = W[(size_t)k * N_IN + gc]; for (int i = 0; i < 8; ++i) ga[i] += xs[i * 1024 + k] * w; }
                for (int j = 0; j < 512; ++j) { const float w = WB[((size_t)br * 512 + j) * DM + c]; for (int i = 0; i < 8; ++i) pa[i] += os[(br * 8 + i) * 512 + j] * w; }
                const float bb = bin[gc];
                for (int i = 0; i < 8; ++i) y[i] += sigmoidf_(ga[i] + bb) * pa[i];
            }
            for (int i = 0; i < 8; ++i) Y[((size_t)tile * 8 + i) * DM + c] = (bf16)f2bf(y[i]);
        }
    }
    __syncthreads();
}
__device__ __forceinline__ void naive_gate(const Ctx& C, int l, int br) {
    LAS float* xs = (LAS float*)C.lds;
    const float* gain = C.in(5) + (size_t)l * DM; const float* W = C.in(6) + (size_t)l * DM * N_IN; const float* bin = C.in(7) + (size_t)l * N_IN;
    bf16* G = (bf16*)(C.ws + WS_G);
    for (int tile = C.bid; tile < T / 8; tile += C.G) {
        __syncthreads();
        {
            const size_t t = (size_t)tile * 8 + C.wave; const float* xr = C.X + t * DM;
            float v[16]; float s = 0.f;
            for (int j = 0; j < 16; ++j) { v[j] = xr[C.lane + 64 * j]; s += v[j] * v[j]; }
            const float r = 1.0f / sqrtf(wave_sum(s) * (1.f / DM) + RMS_EPS);
            for (int j = 0; j < 16; ++j) xs[C.wave * 1024 + C.lane + 64 * j] = v[j] * r * gain[C.lane + 64 * j];
            if (NAIVE_MERGE == 4) { const bf16* xn = (const bf16*)(C.ws + WS_XN) + t * DM; for (int j = 0; j < 16; ++j) xs[C.wave * 1024 + C.lane + 64 * j] = bf2f(xn[C.lane + 64 * j]); }
        }
        __syncthreads();
        for (int c = C.tid; c < DM; c += NTHR) {
            float ga[8]; for (int i = 0; i < 8; ++i) ga[i] = 0.f;
            const int gc = 4400 + br * DM + c;
            const bf16* WGTb = (const bf16*)(C.ws + WS_WGT) + ((size_t)br * DM + c) * DM;
            for (int k = 0; k < DM; ++k) { const float w = (NAIVE_MERGE >= 3) ? bf2f(WGTb[k]) : W[(size_t)k * N_IN + gc]; for (int i = 0; i < 8; ++i) ga[i] += xs[i * 1024 + k] * w; }
            const float bb = bin[gc];
            for (int i = 0; i < 8; ++i) G[((size_t)tile * 8 + i) * DM + c] = (bf16)f2bf(sigmoidf_(ga[i] + bb));
        }
    }
    __syncthreads();
}

__device__ __forceinline__ void phase_mix1(const Ctx& C, int l) {
    const int gw = C.bid * NWAVES + C.wave, NGW = C.G * NWAVES;
    for (int rep = (TIMEDUP & 32) ? 0 : 1; rep < 2; ++rep) {
    for (int it = gw; it < 2048; it += NGW) nsa_cmp1_item(C, it);
    for (int it = gw; it < 2048; it += NGW) nsa_vtrans_item(C, it); }
    for (int t = gw; t < T; t += NGW) nsa_prep_token(C, l, t);
    __syncthreads();
    for (int rep = (TIMEDUP & 16) ? 0 : 1; rep < 2; ++rep) for (int u = C.bid; u < 4096; u += C.G) { if (u < 2048) { if (!NAIVE_GLA) gla_unit_a(C, l, u); } else { if (!NAIVE_MLSTM) mlstm_unit_a(C, l, u - 2048); } }
}
__device__ __forceinline__ void phase_mix2(const Ctx& C, int l) {
    const int gw = C.bid * NWAVES + C.wave, NGW = C.G * NWAVES;
    for (int it = gw; it < 512; it += NGW) nsa_cmp2_item(C, l, it);
    phase_scan(C);
}
__device__ __forceinline__ void phase_mix3(const Ctx& C, int l) {
    for (int rep = (TIMEDUP & 1) ? 0 : 1; rep < 2; ++rep) for (int i = C.bid; i < 2048; i += C.G) {
        const int r = i / C.G, w = i % C.G; const int pos = (r & 1) ? (2047 - ((r >> 1) * C.G + w)) : ((r >> 1) * C.G + w);
        nsa_attn_unit(C, l, pos, rep == 0); }
    const_cast<Ctx&>(C).launder(); const Ctx& D = C;
    for (int rep = (TIMEDUP & 2) ? 0 : 1; rep < 2; ++rep) for (int u = D.bid; u < 4096; u += D.G) { if (u < 2048) { if (!NAIVE_GLA) gla_unit_c(D, l, u, rep == 0); } else { if (!NAIVE_MLSTM) mlstm_unit_c(D, l, u - 2048, rep == 0); } }
    if (NAIVE_GLA && C.bid < 8) naive_gla(C, l, C.bid);
    if (NAIVE_MLSTM && C.bid >= 8 && C.bid < 16) naive_mlstm(C, l, C.bid - 8);
}

constexpr int MIX_PHASES = 10;
#define MIXER_PHASES \
    if (PH_ON) phase_norm(C, C.in(5) + (size_t)l * DM, C.X); \
    PH_END; \
    if (PH_ON) { \
        pg8::Gemm g{(const bf16*)(C.ws + WS_XN), (const bf16*)(C.ws + WS_WIN), T, 4608, DM}; \
        pg8::StaticOrder S; S.init(T, 4608, C.G, C.bid); \
        pg8::EpiWin E{C.ws + WS_R, (const float*)(C.ws + WS_VEC) + VEC_BINP, (float*)(C.ws + WS_SMALL)}; \
        for (int rep = (TIMEDUP & 64) ? 0 : 1; rep < 2; ++rep) pg8::gemm_phase<pg8::EpiWin, pg8::StaticOrder, false>(C.lds, g, S, E, nullptr); \
        if (NAIVE_WIN) { __syncthreads(); naive_win(C, l); } \
    } \
    PH_END; \
    if (PH_ON) phase_mix1(C, l); \
    PH_END; \
    if (PH_ON) phase_mix2(C, l); \
    PH_END; \
    if (PH_ON) phase_mix3(C, l); \
    PH_END; \
    if (PH_ON) { \
        pg8::Gemm g{(const bf16*)(C.ws + WS_XN), (const bf16*)(C.ws + WS_WGT), T, 3 * DM, DM}; \
        pg8::StaticOrder S; S.init(T, 3 * DM, C.G, C.bid); \
        pg8::EpiGate E{C.ws, DM, C.in(7) + (size_t)l * N_IN + 4400}; \
        pg8::gemm_phase<pg8::EpiGate, pg8::StaticOrder, false>(C.lds, g, S, E, nullptr); \
    } \
    PH_END; \
    for (int br = 0; br < 3; ++br) { \
        if (PH_ON) { \
            const bf16* Asrc = (const bf16*)(C.ws + (br == 0 ? WS_RA : br == 1 ? WS_QB : WS_OC)); \
            pg8::Gemm g{Asrc, (const bf16*)(C.ws + WS_WBR) + (size_t)br * DM * 512, T, DM, 512}; \
            pg8::StaticOrder S; S.init(T, DM, C.G, C.bid); \
            pg8::EpiBranch E{(bf16*)(C.ws + WS_Y), (const bf16*)(C.ws + WS_G0 + (size_t)(br >= 1) * (WS_G1 - WS_G0) + (size_t)(br >= 2) * (WS_G2 - WS_G1)), DM, br == 0 ? 1 : 0}; \
            pg8::gemm_phase<pg8::EpiBranch, pg8::StaticOrder, false>(C.lds, g, S, E, nullptr); \
        } \
        PH_END; \
    } \
    if (PH_ON) { \
        pg8::Gemm g{(const bf16*)(C.ws + WS_Y), (const bf16*)(C.ws + WS_WOUT), T, DM, DM}; \
        pg8::StaticOrder S; S.init(T, DM, C.G, C.bid); \
        pg8::EpiResid E{C.X, DM, 1.0f, C.X}; \
        pg8::gemm_phase<pg8::EpiResid, pg8::StaticOrder, false>(C.lds, g, S, E, nullptr); \
    } \
    PH_END;

constexpr int N_PHASES = 8 * 3 + 4 * MIX_PHASES;

__global__ void __launch_bounds__(NTHR, 2) hybrid_fwd(Args args) {
    extern __shared__ __attribute__((aligned(16))) unsigned char lds_raw[];
    Ctx C;
    C.lds = (LAS unsigned char*)lds_raw;
    C.tid = threadIdx.x; C.lane = C.tid & 63; C.wave = __builtin_amdgcn_readfirstlane(C.tid >> 6);
    C.G = gridDim.x; C.bid = blockIdx.x;
    C.inp = (const GAS float* const __attribute__((address_space(4)))*)__builtin_amdgcn_kernarg_segment_ptr();
    C.X = args.out; C.ws = args.ws;
    volatile LAS unsigned* MISC = (volatile LAS unsigned*)(C.lds + MISC_OFF);
    for (int u = C.tid; u < (LDS_BYTES - RING_BYTES) / 4; u += NTHR) ((LAS unsigned*)(C.lds + RING_BYTES))[u] = 0u;
    __syncthreads();
    __builtin_amdgcn_fence(__ATOMIC_ACQUIRE, "agent"); asm volatile("s_waitcnt vmcnt(0)" ::: "memory");
    __syncthreads();
    const int lo = args.ph_lo, hi = args.ph_hi;
    XcdBarrier bar; bar.bar = (unsigned*)(C.ws + WS_CTL) + 4096; bar.x = 0; bar.st = nullptr;
    if (hi - lo > 1) bar = xcd_barrier_post((unsigned*)(C.ws + WS_CTL) + 4096, MISC + 8);
    int pc = 0;
#define PH_ON (C.launder(), pc >= lo && pc < hi)
#define PH_END do { if (pc >= lo && pc + 1 < hi) { xcd_barrier(bar); if (TIMEDUP & 4096) xcd_barrier(bar); } ++pc; } while (0)

    for (int step = 0; step < 2 * NLAYER; ++step) {
        const int l = step >> 1, f = step & 1;
        if (PH_ON) {
            if (step == 0) phase_init(C);
            if (f == 0) for (int rep = (TIMEDUP & 128) ? 0 : 1; rep < 2; ++rep) phase_prep_weights(C, l);
            for (int rep = (TIMEDUP & 8) ? 0 : 1; rep < 2; ++rep) phase_norm(C, (f ? C.in(19) : C.in(1)) + (size_t)l * DM, step == 0 ? C.in(0) : (const float*)C.X);
        }
        PH_END;
        if (PH_ON) {
            pg8::Gemm g{(const bf16*)(C.ws + WS_XN), (const bf16*)(C.ws + (f ? WS_WGU2 : WS_WGU1)), T, 2 * DFF, DM};
            pg8::StaticOrder S; S.init(T, 2 * DFF, C.G, C.bid);
            pg8::EpiSwiGLU E{(bf16*)(C.ws + WS_HID), DFF};
            for (int rep = (TIMEDUP & 4) ? 0 : 1; rep < 2; ++rep) pg8::gemm_phase<pg8::EpiSwiGLU, pg8::StaticOrder, false>(C.lds, g, S, E, nullptr);
        }
        PH_END;
        if (PH_ON) {
            pg8::Gemm g{(const bf16*)(C.ws + WS_HID), (const bf16*)(C.ws + (f ? WS_WDN2 : WS_WDN1)), T, DM, DFF};
            pg8::StaticOrder S; S.init(T, DM, C.G, C.bid);
            pg8::EpiResid E{C.X, DM, 0.5f, step == 0 ? C.in(0) : (const float*)C.X};
            pg8::gemm_phase<pg8::EpiResid, pg8::StaticOrder, false>(C.lds, g, S, E, nullptr);
        }
        PH_END;
        if (f == 0) {
            MIXER_PHASES
        }
    }
#undef PH_ON
#undef PH_END
    asm volatile("s_waitcnt vmcnt(0)" ::: "memory");
    __syncthreads();
    if (C.tid == 0) { __builtin_amdgcn_fence(__ATOMIC_RELEASE, "agent"); asm volatile("s_waitcnt vmcnt(0)" ::: "memory"); }
}

extern "C" void kernel_launch(void* const* d_in, const int* in_sizes, int n_in, void* d_out, int out_size, void* d_ws, size_t ws_size, hipStream_t stream) {
    static int grid = 0;
    if (grid == 0) {
        if (n_in != 23 || out_size != T * DM || ws_size < WS_END) { fprintf(stderr, "kernel_launch: unexpected shapes (n_in %d out %d ws %zu, need %zu)\n", n_in, out_size, ws_size, (size_t)WS_END); grid = -1; return; }
        int dev = 0, cus = 0, per_cu = 0;
        if (hipGetDevice(&dev) != hipSuccess || hipDeviceGetAttribute(&cus, hipDeviceAttributeMultiprocessorCount, dev) != hipSuccess) { grid = -1; return; }
        if (hipFuncSetAttribute((const void*)hybrid_fwd, hipFuncAttributeMaxDynamicSharedMemorySize, LDS_BYTES) != hipSuccess) { fprintf(stderr, "kernel_launch: hipFuncSetAttribute failed\n"); grid = -1; return; }
        if (hipOccupancyMaxActiveBlocksPerMultiprocessor(&per_cu, (const void*)hybrid_fwd, NTHR, LDS_BYTES) != hipSuccess || per_cu < 1) { fprintf(stderr, "kernel_launch: occupancy query says %d blocks per CU\n", per_cu); }
        (void)hipGetLastError();
        grid = cus;
    }
    if (grid < 0) return;
    (void)hipMemsetAsync((char*)d_ws + WS_CTL, 0, CTL_ZERO_BYTES, stream);
    Args a{};
    for (int i = 0; i < 23; ++i) a.in[i] = (const float*)d_in[i];
    a.out = (float*)d_out; a.ws = (unsigned char*)d_ws;
#if ONE_LAUNCH
    a.ph_lo = 0; a.ph_hi = N_PHASES;
    hipLaunchKernelGGL(hybrid_fwd, dim3(grid), dim3(NTHR), LDS_BYTES, stream, a);
#else
    for (int p = 0; p < N_PHASES; ++p) { a.ph_lo = p; a.ph_hi = p + 1; hipLaunchKernelGGL(hybrid_fwd, dim3(grid), dim3(NTHR), LDS_BYTES, stream, a); }
#endif
}
```

```cpp
#include <hip/hip_runtime.h>
#include <cstdio>
#include <cstdint>

#ifndef ABL_ZERO
#define ABL_ZERO 0
#endif
#ifndef SCL_A
#define SCL_A 1.0f
#define SCL_B 1.0f
#define SCL_C 1.0f
#endif
#ifndef TIMEDUP
#define TIMEDUP 0
#endif
#ifndef ONE_LAUNCH
#define ONE_LAUNCH 1
#endif

#define GAS __attribute__((address_space(1)))
#define LAS __attribute__((address_space(3)))
typedef unsigned short bf16;
typedef unsigned v4u __attribute__((ext_vector_type(4)));
typedef unsigned v2u __attribute__((ext_vector_type(2)));
typedef float f32x4 __attribute__((ext_vector_type(4)));
typedef float f32x2 __attribute__((ext_vector_type(2)));
typedef short bf16x8 __attribute__((ext_vector_type(8)));
typedef short bf16x4 __attribute__((ext_vector_type(4)));

constexpr int NB = 2, SEQ = 16384, T = NB * SEQ, DM = 1024, DFF = 2816, NLAYER = 4;
constexpr int N_IN = 7472;
constexpr int NWAVES = 8, NTHR = 512;
constexpr float RMS_EPS = 1e-6f;
constexpr int NCH = SEQ / 64;

constexpr size_t MiB = 1u << 20;
constexpr size_t WS_CTL = 0, CTL_ZERO_BYTES = 1 * MiB;
constexpr size_t WS_ROPE = 1 * MiB;
constexpr size_t WS_VEC = 5 * MiB;
constexpr size_t WS_WGU1 = 6 * MiB;
constexpr size_t WS_WDN1 = 17 * MiB;
constexpr size_t WS_WGU2 = 23 * MiB;
constexpr size_t WS_WDN2 = 34 * MiB;
constexpr size_t WS_WIN = 40 * MiB;
constexpr size_t WS_WGT = 49 * MiB;
constexpr size_t WS_WBR = 55 * MiB;
constexpr size_t WS_WOUT = 58 * MiB;
constexpr size_t WS_CW1 = 60 * MiB;
constexpr size_t WS_CW2 = 62 * MiB;
constexpr size_t WS_XN = 64 * MiB;
constexpr size_t WS_R = 128 * MiB;
constexpr size_t WS_HID = WS_R;
constexpr size_t WS_QKA = WS_R;
constexpr size_t WS_VA = WS_R + 32 * MiB;
constexpr size_t WS_RA = WS_R + 64 * MiB;
constexpr size_t WS_QB = WS_R + 96 * MiB;
constexpr size_t WS_KVC = WS_R + 128 * MiB;
constexpr size_t WS_KVS = WS_R + 144 * MiB;
constexpr size_t WS_KVW = WS_R + 160 * MiB;
constexpr size_t WS_QKC = WS_R + 176 * MiB;
constexpr size_t WS_VC = WS_R + 208 * MiB;
constexpr size_t WS_OC = WS_R + 240 * MiB;
constexpr size_t WS_SMALL = WS_R + 272 * MiB;
constexpr size_t WS_VST = WS_R + 280 * MiB;
constexpr size_t WS_VWT = WS_R + 288 * MiB;
constexpr size_t WS_KCMP = WS_R + 296 * MiB;
constexpr size_t WS_VCT = WS_KCMP + MiB / 2;
constexpr size_t WS_CMPH = WS_R + 297 * MiB;
constexpr size_t WS_GST = WS_R + 302 * MiB;
constexpr size_t WS_GDEC = WS_R + 334 * MiB;
constexpr size_t WS_MSC = WS_GDEC + MiB / 2;
constexpr size_t WS_MST = WS_R + 335 * MiB;
constexpr size_t WS_MN = WS_R + 367 * MiB;
constexpr size_t WS_G0 = WS_QKA, WS_G1 = WS_QKC, WS_G2 = WS_GST;
constexpr size_t WS_G = WS_G0;
constexpr size_t WS_Y = WS_XN;
constexpr size_t WS_END = WS_R + 368 * MiB;

constexpr int VEC_BINP = 0;
constexpr int VEC_CB1 = 8192;

#define LDS_WAIT() asm volatile("s_waitcnt lgkmcnt(0)" ::: "memory")
#define VM_WAIT() asm volatile("s_waitcnt vmcnt(0)" ::: "memory")
__device__ __forceinline__ unsigned f2bf(float f) { unsigned u = __builtin_bit_cast(unsigned, f); return (u + 0x7fffu + ((u >> 16) & 1u)) >> 16; }
typedef __bf16 bf2_t __attribute__((ext_vector_type(2)));
__device__ __forceinline__ unsigned pk2(float lo, float hi) { const f32x2 v = {lo, hi}; return __builtin_bit_cast(unsigned, __builtin_convertvector(v, bf2_t)); }
__device__ __forceinline__ float bf2f(unsigned v) { return __builtin_bit_cast(float, (v & 0xffffu) << 16); }
__device__ __forceinline__ float bflo(unsigned w) { return __builtin_bit_cast(float, w << 16); }
__device__ __forceinline__ float bfhi(unsigned w) { return __builtin_bit_cast(float, w & 0xffff0000u); }
__device__ __forceinline__ float fexp(float x) { return __builtin_amdgcn_exp2f(x * 1.44269504089f); }
__device__ __forceinline__ float sigmoidf_(float x) { return 1.0f / (1.0f + __expf(-x)); }
__device__ __forceinline__ float siluf_(float x) { return x / (1.0f + __expf(-x)); }
__device__ __forceinline__ float logsigmoidf_(float x) { return fminf(x, 0.f) - __logf(1.0f + __expf(-fabsf(x))); }
__device__ __forceinline__ float wave_sum(float v) {
#pragma unroll
    for (int o = 1; o < 64; o <<= 1) v += __shfl_xor(v, o);
    return v;
}
__device__ __forceinline__ float wave_max(float v) {
#pragma unroll
    for (int o = 1; o < 64; o <<= 1) v = fmaxf(v, __shfl_xor(v, o));
    return v;
}

#define XB_TMO      128
#define XB_XCNT(j)  (256  + 64 * (j))
#define XB_XSUB(j)  (1280 + 64 * (j))
#define XB_XGEN(j)  (2304 + 64 * (j))
#define XB_TOP      3328
#define XB_TOPGEN   3392
#define XCD_BAR_WORDS 3456
#define XB_SPIN_CAP (1u << 24)

__device__ __forceinline__ unsigned xb_ld(unsigned* p)              { return __hip_atomic_load(p, __ATOMIC_RELAXED, __HIP_MEMORY_SCOPE_AGENT); }
__device__ __forceinline__ unsigned xb_add(unsigned* p, unsigned v) { return __hip_atomic_fetch_add(p, v, __ATOMIC_RELAXED, __HIP_MEMORY_SCOPE_AGENT); }
__device__ __forceinline__ unsigned xb_xcc_id() { return (unsigned)__builtin_amdgcn_s_getreg((3 << 11) | 20) & 0xFu; }
#define XB_SPIN(cond, bar) do { unsigned _sp = 0; while (cond) { __builtin_amdgcn_s_sleep(1); \
    if ((++_sp & 255u) == 0u) { if (xb_ld(&(bar)[XB_TMO])) break; if (_sp > XB_SPIN_CAP) { atomicAdd(&(bar)[XB_TMO], 1u); break; } } } } while (0)

struct XcdBarrier {
    unsigned* bar; unsigned x;
    volatile LAS unsigned* st;
};
__device__ __forceinline__ XcdBarrier xcd_barrier_post(unsigned* bar, volatile LAS unsigned* st) {
    XcdBarrier b; b.bar = bar; b.x = xb_xcc_id(); b.st = st;
    if (threadIdx.x == 0) (void)xb_add(&bar[XB_XCNT(b.x)], 1u);
    return b;
}
__device__ __forceinline__ void xcd_barrier_complete(unsigned* bar, unsigned x, unsigned& nloc, unsigned& nx) {
    const unsigned G = gridDim.x * gridDim.y * gridDim.z;
    unsigned sum, cnt, mine, sp = 0u;
    for (;;) {
        sum = 0u; cnt = 0u; mine = 0u;
#pragma unroll
        for (unsigned j = 0; j < 16; ++j) { const unsigned c = xb_ld(&bar[XB_XCNT(j)]); sum += c; cnt += (c > 0u) ? 1u : 0u; mine = (j == x) ? c : mine; }
        if (sum == G) break;
        __builtin_amdgcn_s_sleep(1);
        if ((++sp & 255u) == 0u) { if (xb_ld(&bar[XB_TMO])) break; if (sp > XB_SPIN_CAP) { atomicAdd(&bar[XB_TMO], 1u); break; } }
    }
    nloc = mine > 0u ? mine : 1u; nx = cnt > 0u ? cnt : 1u;
}
__device__ __forceinline__ void xcd_barrier(const XcdBarrier& b) {
    asm volatile("s_waitcnt vmcnt(0)" ::: "memory");
    __syncthreads();
    if (threadIdx.x == 0) {
        unsigned* bar = b.bar;
        __builtin_amdgcn_s_waitcnt(0);
        unsigned nloc = b.st[0], nx = b.st[1];
        if (nloc == 0u) { xcd_barrier_complete(bar, b.x, nloc, nx); b.st[0] = nloc; b.st[1] = nx; }
        const unsigned old = xb_add(&bar[XB_XSUB(b.x)], 1u);
        const unsigned gen = old / nloc;
        if (old + 1u == (gen + 1u) * nloc) {
            __builtin_amdgcn_fence(__ATOMIC_RELEASE, "agent");
            asm volatile("s_waitcnt vmcnt(0)" ::: "memory");
            const unsigned og = xb_add(&bar[XB_TOP], 1u);
            const unsigned tg = og / nx;
            if (og + 1u == (tg + 1u) * nx) xb_add(&bar[XB_TOPGEN], 1u);
            else XB_SPIN(xb_ld(&bar[XB_TOPGEN]) == tg, bar);
            __builtin_amdgcn_fence(__ATOMIC_ACQUIRE, "agent");
            xb_add(&bar[XB_XGEN(b.x)], 1u);
            asm volatile("s_waitcnt vmcnt(0)" ::: "memory");
        } else {
            XB_SPIN(xb_ld(&bar[XB_XGEN(b.x)]) == gen, bar);
            __builtin_amdgcn_fence(__ATOMIC_ACQUIRE, "agent");
            asm volatile("s_waitcnt vmcnt(0)" ::: "memory");
        }
    }
    __syncthreads();
}

namespace pg8 {
#define PG8_LAS __attribute__((address_space(3)))
typedef unsigned short bf16_t;
typedef short bf16x8 __attribute__((ext_vector_type(8)));
typedef float f32x4 __attribute__((ext_vector_type(4)));
typedef unsigned u32x4 __attribute__((ext_vector_type(4)));
constexpr int BM = 256, BK = 64, HALF = 128, HTB = HALF * BK * 2  , STAGE_BYTES = 8 * HTB, NXCD = 8, WGM = 8;

__host__ __device__ __forceinline__ int lds_byte(int r, int c) { const int st = (r >> 4) * 2 + (c >> 5), rr = r & 15, cc = c & 31, ob = rr * 64 + cc * 2; return st * 1024 + (ob ^ (((ob >> 9) & 1) << 5)); }
__host__ __device__ __forceinline__ void stage_rc(int b, int& R, int& C) { const int st = b / 1024, sb = b % 1024, swz = sb ^ (((sb >> 9) & 1) << 5); R = (st >> 1) * 16 + swz / 64; C = (st & 1) * 32 + (swz % 64) / 2; }
__host__ __device__ __forceinline__ int perm32(int rho) { const int n = rho >> 4, i = rho & 15; return 8 * (i >> 2) + 4 * n + (i & 3); }

struct Unit { int pm, pn; };
struct Gemm { const bf16_t* A; const bf16_t* Bt; int M, N, K; };

struct StaticOrder {
    int nM, nN, nwg, G, c;
    __host__ __device__ void init(int M, int N, int G_, int c_) { nM = M / BM; nN = N / BM; nwg = nM * nN; G = G_; c = c_; }
    __host__ __device__ bool next(int i, Unit& u) const {
        const long L = (long)i * G + c; if (L >= nwg) return false;
        int wgid = (int)L; { const int q = nwg / NXCD, r = nwg % NXCD, xcd = wgid % NXCD, off = wgid / NXCD; wgid = (xcd < r ? xcd * (q + 1) : r * (q + 1) + (xcd - r) * q) + off; }
        const int nig = WGM * nN, gid = wgid / nig, fm = gid * WGM, gsz = (nM - fm) < WGM ? (nM - fm) : WGM;
        u.pm = fm + ((wgid % nig) % gsz); u.pn = (wgid % nig) / gsz; return true;
    }
    __device__ __forceinline__ void a_ready(const Unit&) const {}
    __device__ __forceinline__ void done(const Unit&) const {}
};
struct CountedOrder : StaticOrder {
    const unsigned* ready; unsigned need; unsigned* tmo;
    __device__ __forceinline__ void a_ready(const Unit& u) const {
        if (threadIdx.x < 64) {
            const unsigned long long t0 = __builtin_amdgcn_s_memrealtime(); unsigned polls = 0;
            while ((unsigned)__builtin_amdgcn_readfirstlane(__hip_atomic_load(ready + 64 * u.pm, __ATOMIC_RELAXED, __HIP_MEMORY_SCOPE_AGENT)) < need) {
                if ((++polls & 255u) == 0u && __builtin_amdgcn_readfirstlane(__hip_atomic_load(tmo, __ATOMIC_RELAXED, __HIP_MEMORY_SCOPE_AGENT)) != 0u) break;
                if (__builtin_amdgcn_s_memrealtime() - t0 > 2000000ull) {
                    if (threadIdx.x == 0) { unsigned expect = 0u; __hip_atomic_compare_exchange_strong(tmo + 1, &expect, 0x600u | (unsigned)(u.pm & 0xff), __ATOMIC_RELAXED, __ATOMIC_RELAXED, __HIP_MEMORY_SCOPE_AGENT); __hip_atomic_store(tmo, 1u, __ATOMIC_RELAXED, __HIP_MEMORY_SCOPE_AGENT); }
                    break; }
                __builtin_amdgcn_s_sleep(2); }
            __builtin_amdgcn_fence(__ATOMIC_ACQUIRE, "agent");
            asm volatile("s_waitcnt vmcnt(0)" ::: "memory");
        }
#if !defined(BROKEN_HOOK_NO_BARRIER)
        asm volatile("" ::: "memory"); __builtin_amdgcn_s_barrier(); asm volatile("" ::: "memory");
#endif
    }
};

__device__ __forceinline__ unsigned cvt_pk_bf16(float lo, float hi) { unsigned r; asm volatile("v_cvt_pk_bf16_f32 %0, %1, %2" : "=v"(r) : "v"(lo), "v"(hi)); return r; }
typedef float f32x2 __attribute__((ext_vector_type(2)));
__device__ __forceinline__ f32x2 gelu_pk(f32x2 v) {
    const f32x2 av = __builtin_elementwise_abs(v), d = av * 0.2316418882f + 1.0f;
    f32x2 t; t.x = __builtin_amdgcn_rcpf(d.x); t.y = __builtin_amdgcn_rcpf(d.y);
    f32x2 q = t * 0.5307027145f + (-0.7265760135f); q = q * t + 0.7107068705f; q = q * t + (-0.142248368f); q = q * t + 0.127414796f; q = q * t;
    const f32x2 s = (v * v) * (-0.72134752044f);
    f32x2 e; e.x = __builtin_amdgcn_exp2f(s.x); e.y = __builtin_amdgcn_exp2f(s.y);
    const f32x2 m = v * (q * e), r = v - m;
    f32x2 o; o.x = v.x < 0.f ? m.x : r.x; o.y = v.y < 0.f ? m.y : r.y; return o;
}

struct EpiF32 {
    static constexpr bool PERM = false, AFTER_DRAIN = false;
    float* C; int ldc; const float* bias;
    __device__ __forceinline__ void operator()(const f32x4 (&acc)[2][2][4][2], const Unit& u, int wr, int wc, int fr, int fq) const {
        const int row0 = u.pm * BM + wr * 64 + fr, col0 = u.pn * BM + wc * 32 + 4 * fq;
        f32x4 bv[2][2];
#pragma unroll
        for (int bj = 0; bj < 2; ++bj)
#pragma unroll
            for (int n = 0; n < 2; ++n) bv[bj][n] = bias ? *(const f32x4*)(bias + col0 + bj * HALF + n * 16) : (f32x4){0.f, 0.f, 0.f, 0.f};
#pragma unroll
        for (int ai = 0; ai < 2; ++ai)
#pragma unroll
            for (int m = 0; m < 4; ++m) { float* rowp = C + (size_t)(row0 + ai * HALF + m * 16) * ldc + col0;
#pragma unroll
                for (int bj = 0; bj < 2; ++bj)
#pragma unroll
                    for (int n = 0; n < 2; ++n) *(f32x4*)(rowp + bj * HALF + n * 16) = acc[ai][bj][m][n] + bv[bj][n]; }
    }
};
template <int ACT  > struct EpiBf16 {
    static constexpr bool PERM = true, AFTER_DRAIN = false;
    bf16_t* O; int ldc; const float* bias; int split_cols; size_t split_stride;
    __device__ __forceinline__ void operator()(const f32x4 (&acc)[2][2][4][2], const Unit& u, int wr, int wc, int fr, int fq) const {
        const int row0 = u.pm * BM + wr * 64 + fr; int colt = u.pn * BM; bf16_t* base = O;
        if (split_cols) { const int t = colt / split_cols; base += (size_t)t * split_stride; colt -= t * split_cols; }
        const int col0 = colt + wc * 32 + 8 * fq, bcol0 = u.pn * BM + wc * 32 + 8 * fq;
        f32x4 bv[2][2];
#pragma unroll
        for (int bj = 0; bj < 2; ++bj)
#pragma unroll
            for (int n = 0; n < 2; ++n) bv[bj][n] = bias ? *(const f32x4*)(bias + bcol0 + bj * HALF + 4 * n) : (f32x4){0.f, 0.f, 0.f, 0.f};
#pragma unroll
        for (int ai = 0; ai < 2; ++ai)
#pragma unroll
            for (int m = 0; m < 4; ++m) { bf16_t* rowp = base + (size_t)(row0 + ai * HALF + m * 16) * ldc + col0;
#pragma unroll
                for (int bj = 0; bj < 2; ++bj) { f32x4 v0 = acc[ai][bj][m][0] + bv[bj][0], v1 = acc[ai][bj][m][1] + bv[bj][1];
                    if (ACT == 1) { f32x2 a = gelu_pk((f32x2){v0[0], v0[1]}), b = gelu_pk((f32x2){v0[2], v0[3]}), c = gelu_pk((f32x2){v1[0], v1[1]}), d = gelu_pk((f32x2){v1[2], v1[3]});
                        v0 = (f32x4){a.x, a.y, b.x, b.y}; v1 = (f32x4){c.x, c.y, d.x, d.y}; }
                    if (ACT == 2) {
#pragma unroll
                        for (int j = 0; j < 4; ++j) { v0[j] = 0.5f * v0[j] * (1.0f + erff(v0[j] * 0.70710678f)); v1[j] = 0.5f * v1[j] * (1.0f + erff(v1[j] * 0.70710678f)); } }
                    u32x4 w; w.x = cvt_pk_bf16(v0[0], v0[1]); w.y = cvt_pk_bf16(v0[2], v0[3]); w.z = cvt_pk_bf16(v1[0], v1[1]); w.w = cvt_pk_bf16(v1[2], v1[3]);
                    *(u32x4*)(rowp + bj * HALF) = w; } }
    }
};

struct PanelStats {
    unsigned* xbuf;
    unsigned* cnt;
    unsigned* tmo;
    int ntn; float eps;
    unsigned code;
    __device__ __forceinline__ bool run(const f32x4 (&v)[2][2][4][2], const Unit& u, int wr, int wc, int fr, int fq, PG8_LAS unsigned char* lds, int wid, int lane) const {
        typedef float f32x2v __attribute__((ext_vector_type(2)));
        PG8_LAS f32x2v* P = (PG8_LAS f32x2v*)lds;
        PG8_LAS f32x2v* S = (PG8_LAS f32x2v*)(lds + 8192);
        PG8_LAS unsigned* flag = (PG8_LAS unsigned*)(lds + 8192 + 2048);
#pragma unroll
        for (int ai = 0; ai < 2; ++ai)
#pragma unroll
            for (int m = 0; m < 4; ++m) {
                float s = 0.f;
#pragma unroll
                for (int bj = 0; bj < 2; ++bj)
#pragma unroll
                    for (int n = 0; n < 2; ++n) { const f32x4 x = v[ai][bj][m][n]; s += (x[0] + x[1]) + (x[2] + x[3]); }
                s += __shfl_xor(s, 16); s += __shfl_xor(s, 32);
                const float mw = s * (1.0f / 64.0f); float q = 0.f;
#pragma unroll
                for (int bj = 0; bj < 2; ++bj)
#pragma unroll
                    for (int n = 0; n < 2; ++n) { const f32x4 d = v[ai][bj][m][n] - mw; q += (d[0] * d[0] + d[1] * d[1]) + (d[2] * d[2] + d[3] * d[3]); }
                q += __shfl_xor(q, 16); q += __shfl_xor(q, 32);
                if (fq == 0) P[(ai * HALF + wr * 64 + m * 16 + fr) * 4 + wc] = (f32x2v){mw, q};
            }
        asm volatile("s_waitcnt lgkmcnt(0)" ::: "memory"); __builtin_amdgcn_s_barrier(); asm volatile("" ::: "memory");
#if defined(BROKEN_NO_WAIT)
        if (blockIdx.x >= 64) { const long long t0 = clock64(); while (clock64() - t0 < 60000) __builtin_amdgcn_s_sleep(8); }
#endif
        const int row = wid * 32 + (lane & 31);
        if (lane < 32) {
            const f32x2v a = P[row * 4 + 0], b = P[row * 4 + 1], c = P[row * 4 + 2], d = P[row * 4 + 3];
            const float mt = (a.x + b.x + c.x + d.x) * 0.25f;
            const float da = a.x - mt, db = b.x - mt, dc = c.x - mt, dd = d.x - mt;
            const float m2 = (a.y + b.y) + (c.y + d.y) + 64.0f * ((da * da + db * db) + (dc * dc + dd * dd));
            unsigned long long* slot = (unsigned long long*)xbuf + ((size_t)(u.pm * BM + row) * 4 + u.pn);
            __hip_atomic_store(slot, ((unsigned long long)__float_as_uint(m2) << 32) | __float_as_uint(mt), __ATOMIC_RELAXED, __HIP_MEMORY_SCOPE_AGENT);
        }
        asm volatile("s_waitcnt vmcnt(0)" ::: "memory");
        if (lane == 0) __hip_atomic_fetch_add(cnt + 64 * u.pm, 1u, __ATOMIC_RELAXED, __HIP_MEMORY_SCOPE_AGENT);
        if (wid == 0) {
            bool dead = false; const unsigned long long t0 = __builtin_amdgcn_s_memrealtime(); const unsigned want = 8u * (unsigned)ntn;
            for (;;) {
#if defined(BROKEN_NO_WAIT)
                break;
#endif
                if ((unsigned)__builtin_amdgcn_readfirstlane(__hip_atomic_load(cnt + 64 * u.pm, __ATOMIC_RELAXED, __HIP_MEMORY_SCOPE_AGENT)) >= want) break;
                if (__builtin_amdgcn_s_memrealtime() - t0 > 2000000ull) {
                    if (lane == 0) { unsigned expect = 0u; __hip_atomic_compare_exchange_strong(tmo + 1, &expect, code | (unsigned)(u.pm & 0xff), __ATOMIC_RELAXED, __ATOMIC_RELAXED, __HIP_MEMORY_SCOPE_AGENT);
                                     __hip_atomic_store(tmo, 1u, __ATOMIC_RELAXED, __HIP_MEMORY_SCOPE_AGENT); }
                    dead = true; break; }
                __builtin_amdgcn_s_sleep(2);
            }
            __builtin_amdgcn_fence(__ATOMIC_ACQUIRE, "agent");
            if (lane == 0) flag[0] = dead ? 1u : 0u;
        }
        asm volatile("s_waitcnt vmcnt(0) lgkmcnt(0)" ::: "memory"); __builtin_amdgcn_s_barrier(); asm volatile("" ::: "memory");
        const bool bad = flag[0] != 0u;
        if (lane < 32) {
            const unsigned long long* slot = (const unsigned long long*)xbuf + (size_t)(u.pm * BM + row) * 4; float mt[4], m2[4]; float ms = 0.f;
#pragma unroll
            for (int t = 0; t < 4; ++t) { if (t < ntn) { const unsigned long long w = __hip_atomic_load(slot + t, __ATOMIC_RELAXED, __HIP_MEMORY_SCOPE_AGENT); mt[t] = __uint_as_float((unsigned)w); m2[t] = __uint_as_float((unsigned)(w >> 32)); } else { mt[t] = 0.f; m2[t] = 0.f; } ms += mt[t]; }
            const float mean = ms / (float)ntn; float q = 0.f;
#pragma unroll
            for (int t = 0; t < 4; ++t) if (t < ntn) { const float dm = mt[t] - mean; q += m2[t] + 256.0f * dm * dm; }
            S[row] = (f32x2v){mean, 1.0f / sqrtf(q / (256.0f * (float)ntn) + eps)};
        }
        asm volatile("s_waitcnt lgkmcnt(0)" ::: "memory"); __builtin_amdgcn_s_barrier(); asm volatile("" ::: "memory");
        return bad;
    }
};
struct EpiLnRes {
    static constexpr bool PERM = false, AFTER_DRAIN = true;
    const float* base; float* out; int ldc; const float* bias; PanelStats st; unsigned poison;
    __device__ __forceinline__ void refuse(size_t i0, size_t stride, int M, int N) const { const float q = __builtin_nanf(""); for (size_t i = i0; i < (size_t)M * N; i += stride) out[(i / N) * ldc + i % N] = q;
        if (i0 == 0) { unsigned expect = 0u; __hip_atomic_compare_exchange_strong(st.tmo + 1, &expect, 0x7f0u, __ATOMIC_RELAXED, __ATOMIC_RELAXED, __HIP_MEMORY_SCOPE_AGENT); __hip_atomic_store(st.tmo, 1u, __ATOMIC_RELAXED, __HIP_MEMORY_SCOPE_AGENT); } }
    __device__ __forceinline__ void fused(f32x4 (&acc)[2][2][4][2], const Unit& u, int wr, int wc, int fr, int fq, PG8_LAS unsigned char* lds, int wid, int lane) const {
        typedef float f32x2v __attribute__((ext_vector_type(2)));
        const PG8_LAS f32x2v* S = (const PG8_LAS f32x2v*)(lds + 8192);
        const int col0 = u.pn * BM + wc * 32 + 4 * fq;
#pragma unroll
        for (int bj = 0; bj < 2; ++bj)
#pragma unroll
            for (int n = 0; n < 2; ++n) { const f32x4 bv = bias ? *(const f32x4*)(bias + col0 + bj * HALF + n * 16) : (f32x4){0.f, 0.f, 0.f, 0.f};
#pragma unroll
                for (int ai = 0; ai < 2; ++ai)
#pragma unroll
                    for (int m = 0; m < 4; ++m) acc[ai][bj][m][n] += bv; }
        const bool bad = st.run(acc, u, wr, wc, fr, fq, lds, wid, lane) || poison != 0u;
        const float qnan = __builtin_nanf("");
#pragma unroll
        for (int ai = 0; ai < 2; ++ai)
#pragma unroll
            for (int m = 0; m < 4; ++m) { const int r = ai * HALF + wr * 64 + m * 16 + fr; const f32x2v sr = S[r]; const size_t off = (size_t)(u.pm * BM + r) * ldc + col0;
#pragma unroll
                for (int bj = 0; bj < 2; ++bj)
#pragma unroll
                    for (int n = 0; n < 2; ++n) { const f32x4 bs = *(const f32x4*)(base + off + bj * HALF + n * 16); f32x4 o = bs + (acc[ai][bj][m][n] - sr.x) * sr.y;
                        if (bad) o = (f32x4){qnan, qnan, qnan, qnan}; *(f32x4*)(out + off + bj * HALF + n * 16) = o; }
                asm volatile("" ::: "memory"); }
    }
};
struct EpiLnResLn {
    static constexpr bool PERM = false, AFTER_DRAIN = true;
    const float* base; float* out; bf16_t* xn; int ldc; const float* bias; PanelStats st1, st2; unsigned poison;
    __device__ __forceinline__ void refuse(size_t i0, size_t stride, int M, int N) const { const float q = __builtin_nanf(""); for (size_t i = i0; i < (size_t)M * N; i += stride) { const size_t o = (i / N) * ldc + i % N; out[o] = q; xn[o] = (bf16_t)0x7fc0u; }
        if (i0 == 0) { unsigned expect = 0u; __hip_atomic_compare_exchange_strong(st1.tmo + 1, &expect, 0x7f0u, __ATOMIC_RELAXED, __ATOMIC_RELAXED, __HIP_MEMORY_SCOPE_AGENT); __hip_atomic_store(st1.tmo, 1u, __ATOMIC_RELAXED, __HIP_MEMORY_SCOPE_AGENT); } }
    __device__ __forceinline__ void fused(f32x4 (&acc)[2][2][4][2], const Unit& u, int wr, int wc, int fr, int fq, PG8_LAS unsigned char* lds, int wid, int lane) const {
        typedef float f32x2v __attribute__((ext_vector_type(2))); typedef unsigned u32x2v __attribute__((ext_vector_type(2)));
        const PG8_LAS f32x2v* S = (const PG8_LAS f32x2v*)(lds + 8192);
        const int col0 = u.pn * BM + wc * 32 + 4 * fq;
#pragma unroll
        for (int bj = 0; bj < 2; ++bj)
#pragma unroll
            for (int n = 0; n < 2; ++n) { const f32x4 bv = bias ? *(const f32x4*)(bias + col0 + bj * HALF + n * 16) : (f32x4){0.f, 0.f, 0.f, 0.f};
#pragma unroll
                for (int ai = 0; ai < 2; ++ai)
#pragma unroll
                    for (int m = 0; m < 4; ++m) acc[ai][bj][m][n] += bv; }
        bool bad = st1.run(acc, u, wr, wc, fr, fq, lds, wid, lane) || poison != 0u;
        const float qnan = __builtin_nanf("");
#pragma unroll
        for (int ai = 0; ai < 2; ++ai)
#pragma unroll
            for (int m = 0; m < 4; ++m) { const int r = ai * HALF + wr * 64 + m * 16 + fr; const f32x2v sr = S[r]; const size_t off = (size_t)(u.pm * BM + r) * ldc + col0;
#pragma unroll
                for (int bj = 0; bj < 2; ++bj)
#pragma unroll
                    for (int n = 0; n < 2; ++n) { const f32x4 bs = *(const f32x4*)(base + off + bj * HALF + n * 16); acc[ai][bj][m][n] = bs + (acc[ai][bj][m][n] - sr.x) * sr.y; }
                asm volatile("" : "+v"(acc[ai][0][m][0]), "+v"(acc[ai][0][m][1]), "+v"(acc[ai][1][m][0]), "+v"(acc[ai][1][m][1]));
                if (m & 1) asm volatile("" ::: "memory"); }
        const bool bad1 = bad;
        bad = st2.run(acc, u, wr, wc, fr, fq, lds, wid, lane) || bad;
#pragma unroll
        for (int ai = 0; ai < 2; ++ai)
#pragma unroll
            for (int m = 0; m < 4; ++m) { const int r = ai * HALF + wr * 64 + m * 16 + fr; const f32x2v sr = S[r]; const size_t off = (size_t)(u.pm * BM + r) * ldc + col0;
#pragma unroll
                for (int bj = 0; bj < 2; ++bj)
#pragma unroll
                    for (int n = 0; n < 2; ++n) { const f32x4 x1 = acc[ai][bj][m][n]; *(f32x4*)(out + off + bj * HALF + n * 16) = bad1 ? (f32x4){qnan, qnan, qnan, qnan} : x1;
                        const f32x4 o = (x1 - sr.x) * sr.y; u32x2v w; w.x = cvt_pk_bf16(o[0], o[1]); w.y = cvt_pk_bf16(o[2], o[3]);
                        if (bad) { w.x = 0x7fc07fc0u; w.y = 0x7fc07fc0u; } *(u32x2v*)(xn + off + bj * HALF + n * 16) = w; }
                asm volatile("" ::: "memory"); }
    }
};

template <class Epi, class Sched, bool STAMP = false>
__device__ __forceinline__ void gemm_phase(PG8_LAS unsigned char* lds, const Gemm g, const Sched& S, const Epi& E, unsigned long long* stamps) {
    int tid_ = threadIdx.x; asm volatile("" : "+v"(tid_));
    const int tid = tid_, wid = __builtin_amdgcn_readfirstlane(tid >> 6), lane = tid & 63, wr = wid >> 2, wc = wid & 3, fr = lane & 15, fq = lane >> 4;
    const int K = g.K, nt = K / BK;
    int ts_lo = 0, ts_hi = 0, nts = 0; const unsigned long long rt_entry = STAMP ? (unsigned long long)wall_clock64() : 0ull;
#define PG8_STAMP() do { if (STAMP && wid == 0 && nts < 64) { const unsigned long long _c = (unsigned long long)clock64(); \
        ts_lo = (lane == nts) ? (int)(unsigned)_c : ts_lo; ts_hi = (lane == nts) ? (int)(unsigned)(_c >> 32) : ts_hi; ++nts; } } while (0)
    PG8_STAMP();
    unsigned voffA[2], voffB[2];
#pragma unroll
    for (int i = 0; i < 2; ++i) { int R, C; stage_rc(tid * 16 + i * 8192, R, C); const int Rb = Epi::PERM ? ((R & ~31) + perm32(R & 31)) : R;
        voffA[i] = (unsigned)(R * K + C) * 2u; voffB[i] = (unsigned)(Rb * K + C) * 2u; }
    const size_t kstep = (size_t)(BK * 2);
    const size_t hstep = (size_t)HALF * K * 2;
    const size_t tstep = 2 * hstep;
    const unsigned ldsw = (unsigned)wid * 1024u;
    const int aoff = lds_byte(wr * 64 + fr, fq * 8), boff = lds_byte(wc * 32 + fr, fq * 8);
#define PG8_SA(b, h) (((b) * 2 + (h)) * HTB)
#define PG8_SB(b, h) ((4 + (b) * 2 + (h)) * HTB)
#define PG8_STAGE(bufoff, gbase, voff) do { _Pragma("unroll") for (int _i = 0; _i < 2; ++_i) \
        __builtin_amdgcn_global_load_lds((const unsigned*)((const char*)(gbase) + (voff)[_i]), (PG8_LAS unsigned*)(lds + (bufoff) + ldsw + _i * 8192), 16, 0, 0); } while (0)
#define PG8_LDA(dst, b, h) do { _Pragma("unroll") for (int m = 0; m < 4; ++m) _Pragma("unroll") for (int k = 0; k < 2; ++k) dst[m][k] = *(const PG8_LAS bf16x8*)(lds + PG8_SA(b, h) + aoff + m * 2048 + k * 1024); } while (0)
#define PG8_LDB(dst, b, h) do { _Pragma("unroll") for (int n = 0; n < 2; ++n) _Pragma("unroll") for (int k = 0; k < 2; ++k) dst[n][k] = *(const PG8_LAS bf16x8*)(lds + PG8_SB(b, h) + boff + n * 2048 + k * 1024); } while (0)
#define PG8_MMA(ai, bj, At, Bt) do { __builtin_amdgcn_s_setprio(1); _Pragma("unroll") for (int m = 0; m < 4; ++m) _Pragma("unroll") for (int n = 0; n < 2; ++n) _Pragma("unroll") for (int k = 0; k < 2; ++k) \
        acc[ai][bj][m][n] = __builtin_amdgcn_mfma_f32_16x16x32_bf16(Bt[n][k], At[m][k], acc[ai][bj][m][n], 0, 0, 0); __builtin_amdgcn_s_setprio(0); } while (0)
#define PG8_WAIT_V(n) asm volatile("s_waitcnt vmcnt(" #n ")" ::: "memory")
#define PG8_WAIT_L(n) asm volatile("s_waitcnt lgkmcnt(" #n ")" ::: "memory")
#define PG8_BAR __builtin_amdgcn_s_barrier()
#define PG8_SCHED __builtin_amdgcn_sched_barrier(0)
    Unit cur, nxt; int ui = 0;
    if (!S.next(0, cur)) return;
    f32x4 acc[2][2][4][2];
#pragma unroll
    for (int a = 0; a < 2; ++a)
#pragma unroll
        for (int b = 0; b < 2; ++b)
#pragma unroll
            for (int m = 0; m < 4; ++m)
#pragma unroll
                for (int n = 0; n < 2; ++n) acc[a][b][m][n] = (f32x4){0.f, 0.f, 0.f, 0.f};
    bf16x8 At[4][2], B0[2][2], B1[2][2];
    const char* cA = (const char*)g.A + (size_t)cur.pm * tstep; const char* cB = (const char*)g.Bt + (size_t)cur.pn * tstep;
    S.a_ready(cur);
    PG8_STAGE(PG8_SB(0, 0), cB, voffB); PG8_STAGE(PG8_SA(0, 0), cA, voffA); PG8_STAGE(PG8_SB(0, 1), cB + hstep, voffB); PG8_STAGE(PG8_SA(0, 1), cA + hstep, voffA);
    if (wr == 1) PG8_BAR;
    PG8_WAIT_V(4); PG8_BAR;
    PG8_STAGE(PG8_SB(1, 0), cB + kstep, voffB); PG8_STAGE(PG8_SA(1, 0), cA + kstep, voffA); PG8_STAGE(PG8_SB(1, 1), cB + hstep + kstep, voffB);
    PG8_WAIT_V(6); PG8_BAR;
    PG8_STAMP();
    for (;;) {
        const bool has_next = S.next(ui + 1, nxt);
        const char* nA = has_next ? (const char*)g.A + (size_t)nxt.pm * tstep : cA; const char* nB = has_next ? (const char*)g.Bt + (size_t)nxt.pn * tstep : cB;
        for (int t = 0; t < nt; t += 2) {
            const bool last = (t == nt - 2);
            const char* a1 = cA + (size_t)(t + 1) * kstep;
            const char* a2 = last ? nA : cA + (size_t)(t + 2) * kstep; const char* b2 = last ? nB : cB + (size_t)(t + 2) * kstep;
            const char* a3 = a2 + kstep; const char* b3 = b2 + kstep;
            if (last && has_next) S.a_ready(nxt);
            PG8_LDB(B0, 0, 0); PG8_SCHED; PG8_LDA(At, 0, 0); PG8_STAGE(PG8_SA(1, 1), a1 + hstep, voffA);
            PG8_WAIT_L(8); PG8_BAR; PG8_WAIT_L(0); PG8_MMA(0, 0, At, B0); PG8_BAR; PG8_SCHED;
            PG8_LDB(B1, 0, 1); PG8_STAGE(PG8_SB(0, 0), b2, voffB);
            PG8_BAR; PG8_WAIT_L(0); PG8_MMA(0, 1, At, B1); PG8_BAR;
            PG8_LDA(At, 0, 1); PG8_STAGE(PG8_SA(0, 0), a2, voffA);
            PG8_BAR; PG8_WAIT_L(0); PG8_MMA(1, 0, At, B0); PG8_BAR; PG8_SCHED;
            PG8_STAGE(PG8_SB(0, 1), b2 + hstep, voffB);
            PG8_WAIT_V(6); PG8_BAR; PG8_MMA(1, 1, At, B1); PG8_BAR;
            PG8_LDB(B0, 1, 0); PG8_SCHED; PG8_LDA(At, 1, 0); PG8_STAGE(PG8_SA(0, 1), a2 + hstep, voffA);
            PG8_WAIT_L(8); PG8_BAR; PG8_WAIT_L(0); PG8_MMA(0, 0, At, B0); PG8_BAR; PG8_SCHED;
            PG8_LDB(B1, 1, 1); PG8_STAGE(PG8_SB(1, 0), b3, voffB);
            PG8_BAR; PG8_WAIT_L(0); PG8_MMA(0, 1, At, B1); PG8_BAR;
            PG8_LDA(At, 1, 1); PG8_STAGE(PG8_SA(1, 0), a3, voffA);
            PG8_BAR; PG8_WAIT_L(0); PG8_MMA(1, 0, At, B0); PG8_BAR; PG8_SCHED;
            PG8_STAGE(PG8_SB(1, 1), b3 + hstep, voffB);
            PG8_WAIT_V(6); PG8_BAR; PG8_MMA(1, 1, At, B1); PG8_BAR;
        }
        PG8_STAMP();
        if constexpr (!Epi::AFTER_DRAIN) { E(acc, cur, wr, wc, fr, fq); S.done(cur); }
        PG8_STAMP();
        if (!has_next) break;
#pragma unroll
        for (int a = 0; a < 2; ++a)
#pragma unroll
            for (int b = 0; b < 2; ++b)
#pragma unroll
                for (int m = 0; m < 4; ++m)
#pragma unroll
                    for (int n = 0; n < 2; ++n) acc[a][b][m][n] = (f32x4){0.f, 0.f, 0.f, 0.f};
        cur = nxt; cA = nA; cB = nB; ++ui;
    }
    PG8_WAIT_V(0);
    if (wr == 0) PG8_BAR;
    PG8_BAR;
    if constexpr (Epi::AFTER_DRAIN) { E.fused(acc, cur, wr, wc, fr, fq, lds, wid, lane); S.done(cur); }
    PG8_STAMP();
    if (STAMP && wid == 0) { stamps[lane] = lane < nts ? (((unsigned long long)(unsigned)ts_hi << 32) | (unsigned)ts_lo) : 0ull;
        if (lane == 62) stamps[62] = rt_entry; if (lane == 63) stamps[63] = (unsigned long long)wall_clock64(); }
#undef PG8_STAMP
#undef PG8_SA
#undef PG8_SB
#undef PG8_STAGE
#undef PG8_LDA
#undef PG8_LDB
#undef PG8_MMA
#undef PG8_WAIT_V
#undef PG8_WAIT_L
#undef PG8_BAR
#undef PG8_SCHED
}
}

namespace pg8 {
__device__ __forceinline__ float fast_sigmoid(float x) { return __builtin_amdgcn_rcpf(1.0f + __builtin_amdgcn_exp2f(-1.44269504089f * x)); }
struct EpiSwiGLU {
    static constexpr bool PERM = true, AFTER_DRAIN = false;
    bf16_t* H; int ldh;
    __device__ __forceinline__ void operator()(const f32x4 (&acc)[2][2][4][2], const Unit& u, int wr, int wc, int fr, int fq) const {
        const int row0 = u.pm * BM + wr * 64 + fr, hc0 = u.pn * 128 + wc * 32 + 8 * fq;
#pragma unroll
        for (int ai = 0; ai < 2; ++ai)
#pragma unroll
            for (int m = 0; m < 4; ++m) {
                bf16_t* rowp = H + (size_t)(row0 + ai * HALF + m * 16) * ldh + hc0;
                float v[8];
#pragma unroll
                for (int n = 0; n < 2; ++n)
#pragma unroll
                    for (int j = 0; j < 4; ++j) { const float g = acc[ai][0][m][n][j], up = acc[ai][1][m][n][j]; v[n * 4 + j] = g * fast_sigmoid(g) * up; }
                u32x4 w; w.x = cvt_pk_bf16(v[0], v[1]); w.y = cvt_pk_bf16(v[2], v[3]); w.z = cvt_pk_bf16(v[4], v[5]); w.w = cvt_pk_bf16(v[6], v[7]);
                *(u32x4*)rowp = w;
            }
    }
};
struct EpiResid {
    static constexpr bool PERM = false, AFTER_DRAIN = false;
    float* X; int ldc; float alpha; const float* Xsrc;
    __device__ __forceinline__ void operator()(const f32x4 (&acc)[2][2][4][2], const Unit& u, int wr, int wc, int fr, int fq) const {
        const int row0 = u.pm * BM + wr * 64 + fr, col0 = u.pn * BM + wc * 32 + 4 * fq;
#pragma unroll
        for (int ai = 0; ai < 2; ++ai)
#pragma unroll
            for (int m = 0; m < 4; ++m) { const size_t ro = (size_t)(row0 + ai * HALF + m * 16) * ldc + col0;
#pragma unroll
                for (int bj = 0; bj < 2; ++bj)
#pragma unroll
                    for (int n = 0; n < 2; ++n) { const f32x4 old = *(const f32x4*)(Xsrc + ro + bj * HALF + n * 16); *(f32x4*)(X + ro + bj * HALF + n * 16) = old + acc[ai][bj][m][n] * alpha; } }
    }
};
struct EpiWin {
    static constexpr bool PERM = true, AFTER_DRAIN = false;
    unsigned char* zbase; const float* bias; float* small_out;
    __device__ __forceinline__ void operator()(const f32x4 (&acc)[2][2][4][2], const Unit& u, int wr, int wc, int fr, int fq) const {
        const int row0 = u.pm * BM + wr * 64 + fr; const int pn = u.pn;
        const int bcol0 = pn * BM + wc * 32 + 8 * fq;
        f32x4 bv[2][2];
#pragma unroll
        for (int bj = 0; bj < 2; ++bj)
#pragma unroll
            for (int n = 0; n < 2; ++n) bv[bj][n] = *(const f32x4*)(bias + bcol0 + bj * HALF + 4 * n);
        if (pn == 17) {
            if (wc < 2) {
#pragma unroll
                for (int ai = 0; ai < 2; ++ai)
#pragma unroll
                    for (int m = 0; m < 4; ++m) { float* rowp = small_out + (size_t)(row0 + ai * HALF + m * 16) * 64 + wc * 32 + 8 * fq;
#pragma unroll
                        for (int n = 0; n < 2; ++n) *(f32x4*)(rowp + 4 * n) = acc[ai][0][m][n] + bv[0][n]; }
            }
            return;
        }
        size_t base; int ld, c0;
        if (pn < 8) { base = (size_t)(pn >> 1) * ((size_t)T * 512 * 2); ld = 512; c0 = (pn & 1) * 256; }
        else if (pn < 11) { base = (size_t)4 * T * 512 * 2 + (size_t)(pn - 8) * ((size_t)T * 256 * 2); ld = 256; c0 = 0; }
        else { base = (size_t)4 * T * 512 * 2 + (size_t)3 * T * 256 * 2 + (size_t)((pn - 11) >> 1) * ((size_t)T * 512 * 2); ld = 512; c0 = ((pn - 11) & 1) * 256; }
        bf16_t* O = (bf16_t*)(zbase + base);
        const int col0 = c0 + wc * 32 + 8 * fq;
#pragma unroll
        for (int ai = 0; ai < 2; ++ai)
#pragma unroll
            for (int m = 0; m < 4; ++m) { bf16_t* rowp = O + (size_t)(row0 + ai * HALF + m * 16) * ld + col0;
#pragma unroll
                for (int bj = 0; bj < 2; ++bj) { const f32x4 v0 = acc[ai][bj][m][0] + bv[bj][0], v1 = acc[ai][bj][m][1] + bv[bj][1];
                    u32x4 w; w.x = cvt_pk_bf16(v0[0], v0[1]); w.y = cvt_pk_bf16(v0[2], v0[3]); w.z = cvt_pk_bf16(v1[0], v1[1]); w.w = cvt_pk_bf16(v1[2], v1[3]);
                    *(u32x4*)(rowp + bj * HALF) = w; } }
    }
};
struct EpiGate {
    static constexpr bool PERM = true, AFTER_DRAIN = false;
    unsigned char* ws; int ldc; const float* bias;
    __device__ __forceinline__ void operator()(const f32x4 (&acc)[2][2][4][2], const Unit& u, int wr, int wc, int fr, int fq) const {
        const int br = u.pn >> 2;
        bf16_t* G = (bf16_t*)(ws + WS_G0 + (size_t)(br >= 1) * (WS_G1 - WS_G0) + (size_t)(br >= 2) * (WS_G2 - WS_G1));
        const int row0 = u.pm * BM + wr * 64 + fr, col0 = (u.pn & 3) * BM + wc * 32 + 8 * fq, bcol0 = u.pn * BM + wc * 32 + 8 * fq;
        f32x4 bv[2][2];
#pragma unroll
        for (int bj = 0; bj < 2; ++bj)
#pragma unroll
            for (int n = 0; n < 2; ++n) bv[bj][n] = *(const f32x4*)(bias + bcol0 + bj * HALF + 4 * n);
#pragma unroll
        for (int ai = 0; ai < 2; ++ai)
#pragma unroll
            for (int m = 0; m < 4; ++m) { bf16_t* rowp = G + (size_t)(row0 + ai * HALF + m * 16) * ldc + col0;
#pragma unroll
                for (int bj = 0; bj < 2; ++bj) { f32x4 v0 = acc[ai][bj][m][0] + bv[bj][0], v1 = acc[ai][bj][m][1] + bv[bj][1];
                    u32x4 w; w.x = cvt_pk_bf16(v0[0], v0[1]); w.y = cvt_pk_bf16(v0[2], v0[3]); w.z = cvt_pk_bf16(v1[0], v1[1]); w.w = cvt_pk_bf16(v1[2], v1[3]);
                    *(u32x4*)(rowp + bj * HALF) = w; } }
    }
};
struct EpiBranch {
    static constexpr bool PERM = true, AFTER_DRAIN = false;
    bf16_t* Y; const bf16_t* G; int ldc; int first;
    __device__ __forceinline__ void operator()(const f32x4 (&acc)[2][2][4][2], const Unit& u, int wr, int wc, int fr, int fq) const {
        const int row0 = u.pm * BM + wr * 64 + fr, col0 = u.pn * BM + wc * 32 + 8 * fq;
#pragma unroll
        for (int ai = 0; ai < 2; ++ai)
#pragma unroll
            for (int m = 0; m < 4; ++m) { const size_t off = (size_t)(row0 + ai * HALF + m * 16) * ldc + col0;
#pragma unroll
                for (int bj = 0; bj < 2; ++bj) {
                    const u32x4 g = *(const u32x4*)(G + off + bj * HALF);
                    u32x4 y = (u32x4){0u, 0u, 0u, 0u}; if (!first) y = *(const u32x4*)(Y + off + bj * HALF);
                    const f32x4 a0 = acc[ai][bj][m][0], a1 = acc[ai][bj][m][1];
                    float o[8];
#pragma unroll
                    for (int q = 0; q < 4; ++q) { const unsigned gw = g[q], yw = y[q]; const float al = q < 2 ? a0[2 * q] : a1[2 * q - 4], ah = q < 2 ? a0[2 * q + 1] : a1[2 * q - 3];
                        o[2 * q] = __builtin_bit_cast(float, yw << 16) + fast_sigmoid(__builtin_bit_cast(float, gw << 16)) * al;
                        o[2 * q + 1] = __builtin_bit_cast(float, yw & 0xffff0000u) + fast_sigmoid(__builtin_bit_cast(float, gw & 0xffff0000u)) * ah; }
                    u32x4 w; w.x = cvt_pk_bf16(o[0], o[1]); w.y = cvt_pk_bf16(o[2], o[3]); w.z = cvt_pk_bf16(o[4], o[5]); w.w = cvt_pk_bf16(o[6], o[7]);
                    *(u32x4*)(Y + off + bj * HALF) = w; } }
    }
};
}

constexpr int RING_BYTES = 131072;
constexpr int MISC_OFF = RING_BYTES + 320;
constexpr int LDS_BYTES = 147456;

__constant__ float ROPE_FREQ[32] = {
1.000000000e+00f, 7.498942614e-01f, 5.623413324e-01f, 4.216965139e-01f, 3.162277639e-01f, 2.371373773e-01f, 1.778279394e-01f, 1.333521307e-01f, 1.000000015e-01f, 7.498941571e-02f, 5.623413250e-02f, 4.216965288e-02f, 3.162277490e-02f, 2.371373773e-02f, 1.778279431e-02f, 1.333521493e-02f, 9.999999776e-03f, 7.498941850e-03f, 5.623413250e-03f, 4.216964822e-03f, 3.162277630e-03f, 2.371373586e-03f, 1.778279431e-03f, 1.333521446e-03f, 1.000000047e-03f, 7.498942432e-04f, 5.623413017e-04f, 4.216965172e-04f, 3.162277571e-04f, 2.371373703e-04f, 1.778279402e-04f, 1.333521504e-04f};

struct Args { const float* in[23]; float* out; unsigned char* ws; int ph_lo, ph_hi; };

struct Ctx {
    LAS unsigned char* lds;
    int tid, lane, wave, G, bid;
    __device__ __forceinline__ void launder() { asm volatile("" : "+v"(tid)); lane = tid & 63; asm volatile("" : "+s"(inp));
        GAS unsigned char* g = (GAS unsigned char*)ws; asm volatile("" : "+s"(g)); ws = (unsigned char*)g;
        GAS float* gx = (GAS float*)X; asm volatile("" : "+s"(gx)); X = (float*)gx; }
    const GAS float* const __attribute__((address_space(4)))* inp; float* X; unsigned char* ws;
    __device__ __forceinline__ const float* in(int k) const { return (const float*)inp[k]; }
};

__device__ __forceinline__ void transpose_item(const float* W, int ldw, int src_col0, bf16* WT, int K, int dst_row0, int kb, LAS float* scr, int lane) {
    const int k0 = 64 * kb;
#pragma unroll 8
    for (int i = 0; i < 32; ++i) { const int kk = 2 * i + (lane >> 5); scr[kk * 33 + (lane & 31)] = W[(size_t)(k0 + kk) * ldw + src_col0 + (lane & 31)]; }
    LDS_WAIT(); asm volatile("" ::: "memory");
    const int c = lane & 7;
#pragma unroll
    for (int j = 0; j < 4; ++j) { const int n = (lane >> 3) + 8 * j; const LAS float* s = scr + (8 * c) * 33 + n;
        v4u o; o.x = pk2(s[0 * 33], s[1 * 33]); o.y = pk2(s[2 * 33], s[3 * 33]); o.z = pk2(s[4 * 33], s[5 * 33]); o.w = pk2(s[6 * 33], s[7 * 33]);
        *(v4u*)(WT + (size_t)(dst_row0 + n) * K + k0 + 8 * c) = o; }
    LDS_WAIT(); asm volatile("" ::: "memory");
}
__device__ __forceinline__ int win_small_src(int i) { return i < 16 ? 1536 + i : i < 40 ? 2832 + (i - 16) : i < 44 ? 4392 + (i - 40) : i < 48 ? 4396 + (i - 44) : -1; }
__device__ __forceinline__ int win_src_col(int n) { return n < 1536 ? n : n < 2816 ? n + 16 : n < 4352 ? n + 40 : win_small_src(n - 4352); }

__device__ __forceinline__ void phase_prep_weights(const Ctx& C, int l) {
    LAS float* scr = (LAS float*)(C.lds + C.wave * 16384);
    const int gw = C.bid * NWAVES + C.wave, NGW = C.G * NWAVES;
    unsigned char* ws = C.ws;
    constexpr int I_GU = 16 * 88, I_DN = 44 * 32, I_WIN = 16 * 136, I_GT = 16 * 96, I_BR = 3 * 8 * 32, I_OUT = 16 * 32, I_C1 = 2 * 32 * 8, I_C2 = 2 * 4 * 2;
    constexpr int I_FFN = 2 * I_GU + I_DN;
    constexpr int NITEMS = 2 * I_FFN + I_WIN + I_GT + I_BR + I_OUT + I_C1 + I_C2;
    for (int it = gw; it < NITEMS; it += NGW) {
        int r = it;
        if (r < 2 * I_FFN) {
            const int f = r / I_FFN; r -= f * I_FFN;
            const float* wg = (f ? C.in(20) : C.in(2)) + (size_t)l * DM * DFF; const float* wu = (f ? C.in(21) : C.in(3)) + (size_t)l * DM * DFF; const float* wd = (f ? C.in(22) : C.in(4)) + (size_t)l * DFF * DM;
            bf16* WGU = (bf16*)(ws + (f ? WS_WGU2 : WS_WGU1)); bf16* WDN = (bf16*)(ws + (f ? WS_WDN2 : WS_WDN1));
            if (r < I_GU) { const int kb = r / 88, col = 32 * (r % 88); transpose_item(wg, DFF, col, WGU, DM, 256 * (col >> 7) + (col & 127), kb, scr, C.lane); }
            else if (r < 2 * I_GU) { r -= I_GU; const int kb = r / 88, col = 32 * (r % 88); transpose_item(wu, DFF, col, WGU, DM, 256 * (col >> 7) + 128 + (col & 127), kb, scr, C.lane); }
            else { r -= 2 * I_GU; const int kb = r / 32, col = 32 * (r % 32); transpose_item(wd, DM, col, WDN, DFF, col, kb, scr, C.lane); }
            continue;
        }
        r -= 2 * I_FFN;
        const float* win = C.in(6) + (size_t)l * DM * N_IN;
        if (r < I_WIN) { const int kb = r / 136, n = 32 * (r % 136); transpose_item(win, N_IN, win_src_col(n), (bf16*)(ws + WS_WIN), DM, n, kb, scr, C.lane); continue; } r -= I_WIN;
        if (r < I_GT) { const int kb = r / 96, n = 32 * (r % 96); transpose_item(win, N_IN, 4400 + n, (bf16*)(ws + WS_WGT), DM, n, kb, scr, C.lane); continue; } r -= I_GT;
        if (r < I_BR) { const int i = r / 256, rr = r % 256, kb = rr / 32, n = 32 * (rr % 32);
            transpose_item(C.in(17) + ((size_t)l * 3 + i) * 512 * DM, DM, n, (bf16*)(ws + WS_WBR) + (size_t)i * DM * 512, 512, n, kb, scr, C.lane); continue; } r -= I_BR;
        if (r < I_OUT) { const int kb = r / 32, n = 32 * (r % 32); transpose_item(C.in(18) + (size_t)l * DM * DM, DM, n, (bf16*)(ws + WS_WOUT), DM, n, kb, scr, C.lane); continue; } r -= I_OUT;
        if (r < I_C1) { const int kv = r / 256, rr = r % 256, kb = rr / 8, n = 32 * (rr % 8);
            transpose_item(C.in(13) + ((size_t)l * 2 + kv) * 2048 * 256, 256, n, (bf16*)(ws + WS_CW1) + (size_t)kv * 256 * 2048, 2048, n, kb, scr, C.lane); continue; } r -= I_C1;
        { const int kv = r / 8, rr = r % 8, kb = rr / 2, n = 32 * (rr % 2);
            transpose_item(C.in(14) + ((size_t)l * 2 + kv) * 256 * 64, 64, n, (bf16*)(ws + WS_CW2) + (size_t)kv * 64 * 256, 256, n, kb, scr, C.lane); }
    }
    const int gt = C.bid * NTHR + C.tid, NGT = C.G * NTHR;
    {
        const float* win = C.in(6) + (size_t)l * DM * N_IN; bf16* WIN = (bf16*)(ws + WS_WIN);
        for (int idx = gt; idx < 256 * 128; idx += NGT) { const int i = idx & 255, kc = idx >> 8; const int sc = win_small_src(i);
            v4u o = (v4u){0u, 0u, 0u, 0u};
            if (sc >= 0) { float v[8];
#pragma unroll
                for (int j = 0; j < 8; ++j) v[j] = win[(size_t)(kc * 8 + j) * N_IN + sc];
                o.x = pk2(v[0], v[1]); o.y = pk2(v[2], v[3]); o.z = pk2(v[4], v[5]); o.w = pk2(v[6], v[7]); }
            *(v4u*)(WIN + (size_t)(4352 + i) * DM + kc * 8) = o; }
        float* vec = (float*)(ws + WS_VEC); const float* bin = C.in(7) + (size_t)l * N_IN;
        for (int n = gt; n < 4608; n += NGT) { const int sc = win_src_col(n); vec[VEC_BINP + n] = sc >= 0 ? bin[sc] : 0.f; }
        for (int it = gw; it < 512; it += NGW) { const int kv = it >> 8, n = it & 255;
            const float* pe = C.in(12) + ((size_t)l * 2 + kv) * 2048; const float* w1 = C.in(13) + ((size_t)l * 2 + kv) * 2048 * 256;
            float s = 0.f;
            for (int k = C.lane; k < 2048; k += 64) s += pe[k] * w1[(size_t)k * 256 + n];
            s = wave_sum(s);
            if (C.lane == 0) vec[VEC_CB1 + it] = s; }
    }
}

__device__ __forceinline__ void phase_init(const Ctx& C) {
    const int gt = C.bid * NTHR + C.tid, NGT = C.G * NTHR;
    f32x2* rope = (f32x2*)(C.ws + WS_ROPE);
    for (int i = gt; i < SEQ * 32; i += NGT) { const int pos = i >> 5, fi = i & 31;
        const float ang = (float)pos * ROPE_FREQ[fi];
        double rev = (double)ang * 0.15915494309189533577; rev -= floor(rev);
        const float rf = (float)rev;
        rope[i] = (f32x2){__builtin_amdgcn_cosf(rf), __builtin_amdgcn_sinf(rf)}; }
}

__device__ __forceinline__ void phase_norm(const Ctx& C, const float* gain, const float* Xsrc) {
    const int gw = C.bid * NWAVES + C.wave, NGW = C.G * NWAVES;
    bf16* XN = (bf16*)(C.ws + WS_XN);
    f32x4 g[4];
#pragma unroll
    for (int j = 0; j < 4; ++j) g[j] = ((const f32x4*)gain)[C.lane + 64 * j];
    for (int m = gw; m < T; m += NGW) {
        const f32x4* xr = (const f32x4*)(Xsrc + (size_t)m * DM) + C.lane;
        f32x4 v[4]; float s = 0.f;
#pragma unroll
        for (int j = 0; j < 4; ++j) { v[j] = xr[64 * j]; s += (v[j].x * v[j].x + v[j].y * v[j].y) + (v[j].z * v[j].z + v[j].w * v[j].w); }
        const float r = 1.0f / sqrtf(wave_sum(s) * (1.f / DM) + RMS_EPS);
        unsigned long long* o8 = (unsigned long long*)(XN + (size_t)m * DM) + C.lane;
#pragma unroll
        for (int j = 0; j < 4; ++j) { const f32x4 w = v[j] * r * g[j]; o8[64 * j] = (unsigned long long)pk2(w.x, w.y) | ((unsigned long long)pk2(w.z, w.w) << 32); }
    }
}

template <int KSTEPS, class PA, class PB>
__device__ __forceinline__ f32x4 mma_tile(PA A, int lda, PB Bt, int ldb, f32x4 acc, int lane) {
    const int r = lane & 15, q = lane >> 4;
#pragma unroll
    for (int kk = 0; kk < KSTEPS; ++kk) {
        const bf16x8 a = *(const bf16x8*)(A + r * lda + kk * 32 + 8 * q);
        const bf16x8 b = *(const bf16x8*)(Bt + r * ldb + kk * 32 + 8 * q);
        acc = __builtin_amdgcn_mfma_f32_16x16x32_bf16(a, b, acc, 0, 0, 0);
    }
    return acc;
}
__device__ __forceinline__ float wave_scan_sum(float v, int lane) {
#pragma unroll
    for (int o = 1; o < 64; o <<= 1) { const float t = __shfl_up(v, o); if (lane >= o) v += t; }
    return v;
}
__device__ __forceinline__ float wave_scan_max(float v, int lane) {
#pragma unroll
    for (int o = 1; o < 64; o <<= 1) { const float t = __shfl_up(v, o); if (lane >= o) v = fmaxf(v, t); }
    return v;
}

constexpr int CU_ALR = 0;
constexpr int CU_GT = 4096;
constexpr int CU_VEC = 6144;
constexpr int CU_KT = 8192;
constexpr int CU_VT = 17408;
constexpr int CU_Q = 35840;
constexpr int CU_AT = 45056;
constexpr int CU_O = 54272;
constexpr int CU_END = 88064;

__device__ __forceinline__ void load_vt(const Ctx& C, const bf16* V, int t0, int h) {
    LAS bf16* VT = (LAS bf16*)(C.lds + CU_VT);
    const int dv = C.tid & 127, jq = C.tid >> 7;
    const bf16* src = V + (size_t)(t0 + 16 * jq) * 512 + h * 128 + dv;
    unsigned w[8];
#pragma unroll
    for (int jj = 0; jj < 8; ++jj) { const unsigned lo = src[(size_t)(2 * jj) * 512], hi = src[(size_t)(2 * jj + 1) * 512]; w[jj] = lo | (hi << 16); }
    *(LAS v4u*)(VT + dv * 72 + 16 * jq) = (v4u){w[0], w[1], w[2], w[3]};
    *(LAS v4u*)(VT + dv * 72 + 16 * jq + 8) = (v4u){w[4], w[5], w[6], w[7]};
}

__device__ __forceinline__ float gla_cumsum(const Ctx& C, int l, int t0, int h, float (&b)[8]) {
    LAS float* ALR = (LAS float*)(C.lds + CU_ALR); LAS float* GT = (LAS float*)(C.lds + CU_GT);
    const float* SMALL = (const float*)(C.ws + WS_SMALL);
    if (C.tid < 256) { const int j = C.tid >> 2, c4 = C.tid & 3; *(LAS f32x4*)(ALR + j * 16 + 4 * c4) = *(const f32x4*)(SMALL + (size_t)(t0 + j) * 64 + 4 * c4); }
    const int dk = C.tid & 63, jg = C.tid >> 6;
    float w[16]; const float* wa = C.in(8) + (size_t)l * 16 * 256 + h * 64 + dk;
#pragma unroll
    for (int r = 0; r < 16; ++r) w[r] = wa[r * 256];
    const float ba = C.in(9)[(size_t)l * 256 + h * 64 + dk];
    __syncthreads();
    float run = 0.f;
#pragma unroll
    for (int jj = 0; jj < 8; ++jj) { const int j = 8 * jg + jj; float x = ba;
#pragma unroll
        for (int r = 0; r < 16; ++r) x += ALR[j * 16 + r] * w[r];
        run += logsigmoidf_(x) * (1.0f / 16.0f); b[jj] = run; }
    GT[jg * 64 + dk] = run;
    __syncthreads();
    float pre = 0.f, tot = 0.f;
#pragma unroll
    for (int g2 = 0; g2 < 8; ++g2) { const float v = GT[g2 * 64 + dk]; tot += v; if (g2 < jg) pre += v; }
#pragma unroll
    for (int jj = 0; jj < 8; ++jj) b[jj] += pre;
    return tot;
}

__device__ __forceinline__ void gla_unit_a(const Ctx& C, int l, int ci) {
    const int bh = ci >> 8, c = ci & 255, bb = bh >> 2, h = bh & 3, t0 = bb * SEQ + c * 64;
    const bf16* QKA = (const bf16*)(C.ws + WS_QKA);
    load_vt(C, (const bf16*)(C.ws + WS_VA), t0, h);
    const int dk = C.tid & 63, jg = C.tid >> 6;
    unsigned kraw[8];
#pragma unroll
    for (int jj = 0; jj < 8; ++jj) kraw[jj] = QKA[(size_t)(t0 + 8 * jg + jj) * 512 + 256 + h * 64 + dk];
    float b[8]; const float btot = gla_cumsum(C, l, t0, h, b);
    LAS bf16* KT = (LAS bf16*)(C.lds + CU_KT);
    float kd[8];
#pragma unroll
    for (int jj = 0; jj < 8; ++jj) { const float k = bf2f(kraw[jj]); kd[jj] = k * fexp(btot - b[jj]); }
    *(LAS v4u*)(KT + dk * 72 + 8 * jg) = (v4u){pk2(kd[0], kd[1]), pk2(kd[2], kd[3]), pk2(kd[4], kd[5]), pk2(kd[6], kd[7])};
    if (jg == 0) ((float*)(C.ws + WS_GDEC))[(size_t)ci * 64 + dk] = fexp(btot);
    __syncthreads();
    const LAS bf16* VT = (const LAS bf16*)(C.lds + CU_VT);
    bf16* GST = (bf16*)(C.ws + WS_GST) + (size_t)ci * 8192;
    const int q = C.lane >> 4, fr = C.lane & 15;
#pragma unroll
    for (int nt = 0; nt < 4; ++nt) {
        f32x4 acc = (f32x4){0.f, 0.f, 0.f, 0.f};
        acc = mma_tile<2>(VT + 16 * C.wave * 72, 72, (const LAS bf16*)KT + 16 * nt * 72, 72, acc, C.lane);
#pragma unroll
        for (int r = 0; r < 4; ++r) GST[(16 * C.wave + 4 * q + r) * 64 + 16 * nt + fr] = (bf16)f2bf(acc[r]);
    }
    __syncthreads();
}

__device__ __forceinline__ void gla_unit_c(const Ctx& C, int l, int ci, bool DRY) {
    const int bh = ci >> 8, c = ci & 255, bb = bh >> 2, h = bh & 3, t0 = bb * SEQ + c * 64;
    const bf16* QKA = (const bf16*)(C.ws + WS_QKA);
    load_vt(C, (const bf16*)(C.ws + WS_VA), t0, h);
    const int dk = C.tid & 63, jg = C.tid >> 6;
    unsigned qraw[8], kraw[8];
#pragma unroll
    for (int jj = 0; jj < 8; ++jj) { const bf16* p = QKA + (size_t)(t0 + 8 * jg + jj) * 512 + h * 64 + dk; qraw[jj] = p[0]; kraw[jj] = p[256]; }
    bf16x8 stf[4][2];
    { const bf16* ST = (const bf16*)(C.ws + WS_GST) + (size_t)ci * 8192 + (size_t)(16 * 4 * (C.wave >> 2) + (C.lane & 15)) * 64 + 8 * (C.lane >> 4);
#pragma unroll
      for (int u = 0; u < 4; ++u) { stf[u][0] = *(const bf16x8*)(ST + u * 16 * 64); stf[u][1] = *(const bf16x8*)(ST + u * 16 * 64 + 32); } }
    v4u ar0, ar1;
    { const bf16* RAp = (const bf16*)(C.ws + WS_RA) + (size_t)(t0 + (C.tid >> 3)) * 512 + h * 128 + 16 * (C.tid & 7); ar0 = *(const v4u*)RAp; ar1 = *(const v4u*)(RAp + 8); }
    float b[8]; (void)gla_cumsum(C, l, t0, h, b);
    LAS bf16* KT = (LAS bf16*)(C.lds + CU_KT); LAS bf16* QT = (LAS bf16*)(C.lds + CU_Q); LAS bf16* AT = (LAS bf16*)(C.lds + CU_AT);
#pragma unroll
    for (int jj = 0; jj < 8; ++jj) { const int j = 8 * jg + jj;
        const float qv = bf2f(qraw[jj]) * 0.125f, kv = bf2f(kraw[jj]);
        QT[j * 72 + dk] = (bf16)f2bf(qv * fexp(b[jj])); KT[j * 72 + dk] = (bf16)f2bf(kv * fexp(fminf(-b[jj], 80.f))); }
    __syncthreads();
    const int q = C.lane >> 4, fr = C.lane & 15;
    {
        const int it = C.wave >> 1;
#pragma unroll
        for (int u = 0; u < 2; ++u) { const int jt = 2 * (C.wave & 1) + u;
            f32x4 acc = (f32x4){0.f, 0.f, 0.f, 0.f};
            if (jt <= it) acc = mma_tile<2>((const LAS bf16*)KT + 16 * jt * 72, 72, (const LAS bf16*)QT + 16 * it * 72, 72, acc, C.lane);
            const int i = 16 * it + fr;
            float v[4];
#pragma unroll
            for (int r = 0; r < 4; ++r) { const int j = 16 * jt + 4 * q + r; v[r] = (j <= i) ? acc[r] : 0.f; }
            *(LAS v2u*)(AT + i * 72 + 16 * jt + 4 * q) = (v2u){pk2(v[0], v[1]), pk2(v[2], v[3])}; }
    }
    __syncthreads();
    {
        const int it = C.wave & 3; LAS float* O = (LAS float*)(C.lds + CU_O);
        const LAS bf16* VT = (const LAS bf16*)(C.lds + CU_VT);
#pragma unroll
        for (int u = 0; u < 4; ++u) { const int dvt = 4 * (C.wave >> 2) + u;
            f32x4 acc = (f32x4){0.f, 0.f, 0.f, 0.f};
#pragma unroll
            for (int kk = 0; kk < 2; ++kk) { const bf16x8 a = *(const LAS bf16x8*)((const LAS bf16*)QT + (16 * it + fr) * 72 + kk * 32 + 8 * q); acc = __builtin_amdgcn_mfma_f32_16x16x32_bf16(a, stf[u][kk], acc, 0, 0, 0); }
            acc = mma_tile<2>((const LAS bf16*)AT + 16 * it * 72, 72, VT + 16 * dvt * 72, 72, acc, C.lane);
#pragma unroll
            for (int r = 0; r < 4; ++r) O[(16 * it + 4 * q + r) * 132 + 16 * dvt + fr] = acc[r]; }
    }
    __syncthreads();
    {
        const int i = C.tid >> 3, s = C.tid & 7; const LAS float* O = (const LAS float*)(C.lds + CU_O) + i * 132 + 16 * s;
        float o[16]; float ss = 0.f;
#pragma unroll
        for (int k = 0; k < 16; ++k) { o[k] = O[k]; ss += o[k] * o[k]; }
        ss += __shfl_xor(ss, 1); ss += __shfl_xor(ss, 2); ss += __shfl_xor(ss, 4);
        const float rinv = 1.0f / sqrtf(ss * (1.0f / 128.0f) + RMS_EPS);
        bf16* RA = (bf16*)(C.ws + WS_RA) + (size_t)(t0 + i) * 512 + h * 128 + 16 * s;
        const float* gn = C.in(10) + (size_t)l * 128 + 16 * s;
        const v4u r0 = ar0, r1 = ar1;
        unsigned rw[8] = {r0.x, r0.y, r0.z, r0.w, r1.x, r1.y, r1.z, r1.w}; unsigned ow[8];
#pragma unroll
        for (int k = 0; k < 8; ++k) { const float a = SCL_A * o[2 * k] * rinv * gn[2 * k] * siluf_(bflo(rw[k])), bq = SCL_A * o[2 * k + 1] * rinv * gn[2 * k + 1] * siluf_(bfhi(rw[k])); ow[k] = (ABL_ZERO & 1) ? 0u : pk2(a, bq); }
        if (DRY) { asm volatile("" :: "v"(ow[0]), "v"(ow[1]), "v"(ow[2]), "v"(ow[3]), "v"(ow[4]), "v"(ow[5]), "v"(ow[6]), "v"(ow[7])); } else {
        *(v4u*)RA = (v4u){ow[0], ow[1], ow[2], ow[3]}; *(v4u*)(RA + 8) = (v4u){ow[4], ow[5], ow[6], ow[7]}; }
    }
    __syncthreads();
}

__device__ __forceinline__ void conv_silu8(const Ctx& C, int l, int t0, int c, int ch, int jg, float (&out)[8]) {
    const bf16* X = (const bf16*)(C.ws + WS_QKC);
    const float* cw = C.in(15) + (size_t)l * 4 * 512 + ch; const float cb = C.in(16)[(size_t)l * 512 + ch];
    const float w0 = cw[0], w1 = cw[512], w2 = cw[1024], w3 = cw[1536];
    float x[11];
#pragma unroll
    for (int k = 0; k < 11; ++k) { const int j = 8 * jg + k - 3; const int s = c * 64 + j; x[k] = (s >= 0) ? bf2f(X[(size_t)(t0 + j) * 512 + ch]) : 0.f; }
#pragma unroll
    for (int jj = 0; jj < 8; ++jj) out[jj] = siluf_(cb + w0 * x[jj] + w1 * x[jj + 1] + w2 * x[jj + 2] + w3 * x[jj + 3]);
}

__device__ __forceinline__ void mlstm_unit_a(const Ctx& C, int l, int ci) {
    const int bh = ci >> 8, c = ci & 255, bb = bh >> 2, h = bh & 3, t0 = bb * SEQ + c * 64;
    LAS float* VEC = (LAS float*)(C.lds + CU_VEC); LAS float* GT = (LAS float*)(C.lds + CU_GT);
    load_vt(C, (const bf16*)(C.ws + WS_VC), t0, h);
    const int dk = C.tid & 63, jg = C.tid >> 6;
    float k[8]; conv_silu8(C, l, t0, c, 256 + h * 64 + dk, jg, k);
    if (C.wave == 0) {
        const float* sm = (const float*)(C.ws + WS_SMALL) + (size_t)(t0 + C.lane) * 64;
        const float ip = sm[40 + h], lf = logsigmoidf_(sm[44 + h]);
        const float bj = wave_scan_sum(lf, C.lane); const float a = ip - bj; const float amax = wave_max(a);
        VEC[C.lane] = fexp(a - amax);
        if (C.lane == 63) { float* msc = (float*)(C.ws + WS_MSC) + (size_t)ci * 4; msc[0] = bj; msc[1] = amax; }
    }
    __syncthreads();
    LAS bf16* KT = (LAS bf16*)(C.lds + CU_KT);
    float kw[8]; float ns = 0.f;
#pragma unroll
    for (int jj = 0; jj < 8; ++jj) { kw[jj] = k[jj] * 0.125f * VEC[8 * jg + jj]; ns += kw[jj]; }
    *(LAS v4u*)(KT + dk * 72 + 8 * jg) = (v4u){pk2(kw[0], kw[1]), pk2(kw[2], kw[3]), pk2(kw[4], kw[5]), pk2(kw[6], kw[7])};
    GT[jg * 64 + dk] = ns;
    __syncthreads();
    if (C.tid < 64) { float s = 0.f;
#pragma unroll
        for (int g2 = 0; g2 < 8; ++g2) s += GT[g2 * 64 + C.tid];
        ((float*)(C.ws + WS_MN))[(size_t)ci * 64 + C.tid] = s; }
    const LAS bf16* VT = (const LAS bf16*)(C.lds + CU_VT);
    bf16* MST = (bf16*)(C.ws + WS_MST) + (size_t)ci * 8192;
    const int q = C.lane >> 4, fr = C.lane & 15;
#pragma unroll
    for (int nt = 0; nt < 4; ++nt) {
        f32x4 acc = (f32x4){0.f, 0.f, 0.f, 0.f};
        acc = mma_tile<2>(VT + 16 * C.wave * 72, 72, (const LAS bf16*)KT + 16 * nt * 72, 72, acc, C.lane);
#pragma unroll
        for (int r = 0; r < 4; ++r) MST[(16 * C.wave + 4 * q + r) * 64 + 16 * nt + fr] = (bf16)f2bf(acc[r]);
    }
    __syncthreads();
}

__device__ __forceinline__ void mlstm_unit_c(const Ctx& C, int l, int ci, bool DRY) {
    const int bh = ci >> 8, c = ci & 255, bb = bh >> 2, h = bh & 3, t0 = bb * SEQ + c * 64;
    LAS float* VEC = (LAS float*)(C.lds + CU_VEC);
    LAS float* AJ = VEC + 64, *MI = VEC + 128, *WI = VEC + 192, *EM = VEC + 256, *QN = VEC + 384; LAS float* DENP = (LAS float*)(C.lds + CU_GT);
    load_vt(C, (const bf16*)(C.ws + WS_VC), t0, h);
    const int dk = C.tid & 63, jg = C.tid >> 6;
    LAS bf16* KT = (LAS bf16*)(C.lds + CU_KT); LAS bf16* QT = (LAS bf16*)(C.lds + CU_Q); LAS bf16* AT = (LAS bf16*)(C.lds + CU_AT);
    bf16x8 stf[4][2];
    { const bf16* ST = (const bf16*)(C.ws + WS_MST) + (size_t)ci * 8192 + (size_t)(16 * 4 * (C.wave >> 2) + (C.lane & 15)) * 64 + 8 * (C.lane >> 4);
#pragma unroll
      for (int u = 0; u < 4; ++u) { stf[u][0] = *(const bf16x8*)(ST + u * 16 * 64); stf[u][1] = *(const bf16x8*)(ST + u * 16 * 64 + 32); } }
    v4u co0, co1; f32x4 nst0, nst1;
    { const bf16* OCp = (const bf16*)(C.ws + WS_OC) + (size_t)(t0 + (C.tid >> 3)) * 512 + h * 128 + 16 * (C.tid & 7); co0 = *(const v4u*)OCp; co1 = *(const v4u*)(OCp + 8);
      const float* np = (const float*)(C.ws + WS_MN) + (size_t)ci * 64 + 8 * (C.tid & 7); nst0 = *(const f32x4*)np; nst1 = *(const f32x4*)(np + 4); }
    {
        float qv[8], kv[8]; conv_silu8(C, l, t0, c, h * 64 + dk, jg, qv); conv_silu8(C, l, t0, c, 256 + h * 64 + dk, jg, kv);
#pragma unroll
        for (int jj = 0; jj < 8; ++jj) { const int j = 8 * jg + jj; QT[j * 72 + dk] = (bf16)f2bf(qv[jj]); KT[j * 72 + dk] = (bf16)f2bf(kv[jj] * 0.125f); }
    }
    if (C.wave == 0) {
        const float* sm = (const float*)(C.ws + WS_SMALL) + (size_t)(t0 + C.lane) * 64;
        const float ip = sm[40 + h], lf = logsigmoidf_(sm[44 + h]);
        const float bj = wave_scan_sum(lf, C.lane); const float a = ip - bj; const float arun = wave_scan_max(a, C.lane);
        const float mst = ((const float*)(C.ws + WS_MSC))[(size_t)ci * 4 + 2];
        const float mi = fmaxf(mst, arun);
        AJ[C.lane] = a; MI[C.lane] = mi; WI[C.lane] = fexp(mst - mi); EM[C.lane] = fexp(-(bj + mi));
    }
    __syncthreads();
    const int q = C.lane >> 4, fr = C.lane & 15;
    {
        const int it = C.wave >> 1;
#pragma unroll
        for (int u = 0; u < 2; ++u) { const int jt = 2 * (C.wave & 1) + u;
            f32x4 acc = (f32x4){0.f, 0.f, 0.f, 0.f};
            if (jt <= it) acc = mma_tile<2>((const LAS bf16*)KT + 16 * jt * 72, 72, (const LAS bf16*)QT + 16 * it * 72, 72, acc, C.lane);
            const int i = 16 * it + fr; const float mi = MI[i];
            float v[4]; float ds = 0.f;
#pragma unroll
            for (int r = 0; r < 4; ++r) { const int j = 16 * jt + 4 * q + r; v[r] = (j <= i) ? acc[r] * fexp(AJ[j] - mi) : 0.f; ds += v[r]; }
            ds += __shfl_xor(ds, 16); ds += __shfl_xor(ds, 32);
            if (q == 0) DENP[jt * 64 + i] = ds;
            *(LAS v2u*)(AT + i * 72 + 16 * jt + 4 * q) = (v2u){pk2(v[0], v[1]), pk2(v[2], v[3])}; }
    }
    {
        const int i = C.tid >> 3, s = C.tid & 7; const float nst[8] = {nst0[0], nst0[1], nst0[2], nst0[3], nst1[0], nst1[1], nst1[2], nst1[3]};
        float a = 0.f;
#pragma unroll
        for (int k = 0; k < 8; ++k) a += bf2f(QT[i * 72 + 8 * s + k]) * nst[k];
        a += __shfl_xor(a, 1); a += __shfl_xor(a, 2); a += __shfl_xor(a, 4);
        if (s == 0) QN[i] = a;
    }
    __syncthreads();
    {
        const int it = C.wave & 3; LAS float* O = (LAS float*)(C.lds + CU_O);
        const LAS bf16* VT = (const LAS bf16*)(C.lds + CU_VT);
#pragma unroll
        for (int u = 0; u < 4; ++u) { const int dvt = 4 * (C.wave >> 2) + u;
            f32x4 a1 = (f32x4){0.f, 0.f, 0.f, 0.f}, a2 = (f32x4){0.f, 0.f, 0.f, 0.f};
#pragma unroll
            for (int kk = 0; kk < 2; ++kk) { const bf16x8 a = *(const LAS bf16x8*)((const LAS bf16*)QT + (16 * it + fr) * 72 + kk * 32 + 8 * q); a1 = __builtin_amdgcn_mfma_f32_16x16x32_bf16(a, stf[u][kk], a1, 0, 0, 0); }
            a2 = mma_tile<2>((const LAS bf16*)AT + 16 * it * 72, 72, VT + 16 * dvt * 72, 72, a2, C.lane);
#pragma unroll
            for (int r = 0; r < 4; ++r) { const int i = 16 * it + 4 * q + r; O[i * 132 + 16 * dvt + fr] = WI[i] * a1[r] + a2[r]; } }
    }
    __syncthreads();
    {
        const int i = C.tid >> 3, s = C.tid & 7; const LAS float* O = (const LAS float*)(C.lds + CU_O) + i * 132 + 16 * s;
        const float den = WI[i] * QN[i] + ((DENP[i] + DENP[64 + i]) + (DENP[128 + i] + DENP[192 + i])); const float dinv = 1.0f / fmaxf(fabsf(den), EM[i]);
        bf16* OC = (bf16*)(C.ws + WS_OC) + (size_t)(t0 + i) * 512 + h * 128 + 16 * s;
        const v4u r0 = co0, r1 = co1;
        unsigned rw[8] = {r0.x, r0.y, r0.z, r0.w, r1.x, r1.y, r1.z, r1.w}; unsigned ow[8];
#pragma unroll
        for (int k = 0; k < 8; ++k) ow[k] = (ABL_ZERO & 4) ? 0u : pk2(SCL_C * O[2 * k] * dinv * sigmoidf_(bflo(rw[k])), SCL_C * O[2 * k + 1] * dinv * sigmoidf_(bfhi(rw[k])));
        if (DRY) { asm volatile("" :: "v"(ow[0]), "v"(ow[1]), "v"(ow[2]), "v"(ow[3]), "v"(ow[4]), "v"(ow[5]), "v"(ow[6]), "v"(ow[7])); } else {
        *(v4u*)OC = (v4u){ow[0], ow[1], ow[2], ow[3]}; *(v4u*)(OC + 8) = (v4u){ow[4], ow[5], ow[6], ow[7]}; }
    }
    __syncthreads();
}

__device__ __forceinline__ void phase_scan(const Ctx& C) {
    const int gt = C.bid * NTHR + C.tid, NGT = C.G * NTHR;
    for (int e = gt; e < 65536 + 65536; e += NGT) {
        if (e < 65536) {
            const int bh = e >> 13, el = e & 8191, dk = el & 63;
            bf16* st = (bf16*)(C.ws + WS_GST) + (size_t)bh * 256 * 8192 + el; const float* dec = (const float*)(C.ws + WS_GDEC) + (size_t)bh * 256 * 64 + dk;
            float s = 0.f;
            for (int c0 = 0; c0 < 256; c0 += 8) { float L[8], d[8];
#pragma unroll
                for (int k = 0; k < 8; ++k) { L[k] = bf2f(st[(size_t)(c0 + k) * 8192]); d[k] = dec[(c0 + k) * 64]; }
#pragma unroll
                for (int k = 0; k < 8; ++k) { st[(size_t)(c0 + k) * 8192] = (bf16)f2bf(s); s = d[k] * s + L[k]; } }
        } else {
            const int e2 = e - 65536, bh = e2 >> 13, el = e2 & 8191; const bool hasn = el < 64;
            bf16* st = (bf16*)(C.ws + WS_MST) + (size_t)bh * 256 * 8192 + el; float* nv = (float*)(C.ws + WS_MN) + (size_t)bh * 256 * 64 + (hasn ? el : 0);
            float* msc = (float*)(C.ws + WS_MSC) + (size_t)bh * 256 * 4;
            float s = 0.f, sn = 0.f, m = 0.f;
            for (int c0 = 0; c0 < 256; c0 += 8) { float L[8], Ln[8], bl[8], am[8];
#pragma unroll
                for (int k = 0; k < 8; ++k) { L[k] = bf2f(st[(size_t)(c0 + k) * 8192]); Ln[k] = hasn ? nv[(c0 + k) * 64] : 0.f; bl[k] = msc[(c0 + k) * 4]; am[k] = msc[(c0 + k) * 4 + 1]; }
#pragma unroll
                for (int k = 0; k < 8; ++k) {
                    const float mn = bl[k] + fmaxf(m, am[k]); const float al = fexp(bl[k] + m - mn), be = fexp(bl[k] + am[k] - mn);
                    st[(size_t)(c0 + k) * 8192] = (bf16)f2bf(s);
                    if (hasn) { nv[(c0 + k) * 64] = sn; if (el == 0) msc[(c0 + k) * 4 + 2] = m; }
                    s = al * s + be * L[k]; sn = al * sn + be * Ln[k]; m = mn; } }
        }
    }
}

__device__ __forceinline__ float gelu_tanh(float x) { const float u = 0.7978845608f * (x + 0.044715f * x * x * x); const float e = __expf(2.0f * u); return 0.5f * x * (2.0f - 2.0f / (1.0f + e)); }

__device__ __forceinline__ void nsa_prep_token(const Ctx& C, int l, int t) {
    const float* gn = C.in(11) + (size_t)l * 4 * 64;
    const f32x2 cs = ((const f32x2*)(C.ws + WS_ROPE))[(size_t)(t & (SEQ - 1)) * 32 + (C.lane & 31)];
    bf16* q = (bf16*)(C.ws + WS_QB) + (size_t)t * 512 + C.lane;
    bf16* ks = (bf16*)(C.ws + WS_KVS) + (size_t)t * 256 + C.lane; bf16* kw = (bf16*)(C.ws + WS_KVW) + (size_t)t * 256 + C.lane;
    const float g0 = gn[C.lane], g2 = gn[128 + C.lane], g3 = gn[192 + C.lane];
    float x[12], ss[12];
#pragma unroll
    for (int r = 0; r < 8; ++r) x[r] = bf2f(q[r * 64]);
    x[8] = bf2f(ks[0]); x[9] = bf2f(ks[64]); x[10] = bf2f(kw[0]); x[11] = bf2f(kw[64]);
#pragma unroll
    for (int r = 0; r < 12; ++r) ss[r] = x[r] * x[r];
#pragma unroll
    for (int o = 1; o < 64; o <<= 1)
#pragma unroll
        for (int r = 0; r < 12; ++r) ss[r] += __shfl_xor(ss[r], o);
    float y[12], pr[12];
#pragma unroll
    for (int r = 0; r < 12; ++r) { const float g = r < 8 ? g0 : r < 10 ? g2 : g3; y[r] = x[r] * (1.0f / sqrtf(ss[r] * (1.0f / 64.0f) + RMS_EPS)) * g; }
#pragma unroll
    for (int r = 0; r < 12; ++r) pr[r] = __shfl_xor(y[r], 32);
#pragma unroll
    for (int r = 0; r < 12; ++r) { const float o = (C.lane < 32) ? (y[r] * cs.x - pr[r] * cs.y) : (pr[r] * cs.y + y[r] * cs.x); const unsigned ob = f2bf(r < 8 ? o * 0.125f : o);
        if (r < 8) q[r * 64] = (bf16)ob; else if (r == 8) ks[0] = (bf16)ob; else if (r == 9) ks[64] = (bf16)ob; else if (r == 10) kw[0] = (bf16)ob; else kw[64] = (bf16)ob; }
}
__device__ __forceinline__ void nsa_vtrans_item(const Ctx& C, int item) {
    const int which = item >> 10, bg = (item >> 8) & 3, blk = item & 255, b = bg >> 1, g = bg & 1;
    const bf16* src = (const bf16*)(C.ws + (which ? WS_KVW : WS_KVS)) + (size_t)(b * SEQ + blk * 64 + C.lane) * 256 + 128 + g * 64;
    bf16* dst = (bf16*)(C.ws + (which ? WS_VWT : WS_VST)) + (size_t)(bg * 256 + blk) * 4096 + C.lane;
    v4u w[8];
#pragma unroll
    for (int k = 0; k < 8; ++k) w[k] = ((const v4u*)src)[k];
#pragma unroll
    for (int k = 0; k < 8; ++k)
#pragma unroll
        for (int e = 0; e < 4; ++e) { const unsigned x = w[k][e]; dst[(size_t)(8 * k + 2 * e) * 64] = (bf16)(x & 0xffffu); dst[(size_t)(8 * k + 2 * e + 1) * 64] = (bf16)(x >> 16); }
}
__device__ __forceinline__ void nsa_cmp1_item(const Ctx& C, int item) {
    const int kv = item >> 10, rt = (item >> 2) & 255, ng = item & 3;
    const int fr = C.lane & 15, q = C.lane >> 4;
    const int ri = rt * 16 + fr, b = ri >> 11, g = (ri >> 10) & 1, c = ri & 1023, cc = c < 1023 ? c : 1022;
    const bf16* arow = (const bf16*)(C.ws + WS_KVC) + (size_t)(b * SEQ + 16 * cc) * 256 + kv * 128 + g * 64 + 8 * q;
    const bf16* brow = (const bf16*)(C.ws + WS_CW1) + (size_t)kv * 256 * 2048 + (size_t)(ng * 64 + fr) * 2048 + 8 * q;
    f32x4 acc[4];
#pragma unroll
    for (int nt = 0; nt < 4; ++nt) acc[nt] = (f32x4){0.f, 0.f, 0.f, 0.f};
#pragma unroll 4
    for (int kk = 0; kk < 64; ++kk) {
        const bf16x8 a = *(const bf16x8*)(arow + (kk >> 1) * 256 + (kk & 1) * 32);
#pragma unroll
        for (int nt = 0; nt < 4; ++nt) { const bf16x8 bv = *(const bf16x8*)(brow + (size_t)nt * 16 * 2048 + kk * 32); acc[nt] = __builtin_amdgcn_mfma_f32_16x16x32_bf16(a, bv, acc[nt], 0, 0, 0); }
    }
    const float* cb1 = (const float*)(C.ws + WS_VEC) + VEC_CB1 + kv * 256;
    bf16* H1 = (bf16*)(C.ws + WS_CMPH) + (size_t)kv * 4096 * 256;
#pragma unroll
    for (int nt = 0; nt < 4; ++nt) { const int n = ng * 64 + nt * 16 + fr; const float bia = cb1[n];
#pragma unroll
        for (int r = 0; r < 4; ++r) H1[(size_t)(rt * 16 + 4 * q + r) * 256 + n] = (bf16)f2bf(gelu_tanh(acc[nt][r] + bia)); }
}
__device__ __forceinline__ void nsa_cmp2_item(const Ctx& C, int l, int item) {
    const int kv = item >> 8, rt = item & 255;
    const int fr = C.lane & 15, q = C.lane >> 4;
    const bf16* H1 = (const bf16*)(C.ws + WS_CMPH) + (size_t)kv * 4096 * 256 + (size_t)rt * 16 * 256;
    const bf16* W2 = (const bf16*)(C.ws + WS_CW2) + (size_t)kv * 64 * 256;
    f32x4 acc[4];
#pragma unroll
    for (int nt = 0; nt < 4; ++nt) { acc[nt] = (f32x4){0.f, 0.f, 0.f, 0.f}; acc[nt] = mma_tile<8>(H1, 256, W2 + nt * 16 * 256, 256, acc[nt], C.lane); }
    if (kv == 0) {
        const float* gn = C.in(11) + (size_t)l * 4 * 64 + 64;
        bf16* KC = (bf16*)(C.ws + WS_KCMP);
#pragma unroll
        for (int r = 0; r < 4; ++r) {
            float ss = 0.f;
#pragma unroll
            for (int nt = 0; nt < 4; ++nt) ss += acc[nt][r] * acc[nt][r];
            ss += __shfl_xor(ss, 1); ss += __shfl_xor(ss, 2); ss += __shfl_xor(ss, 4); ss += __shfl_xor(ss, 8);
            const float rinv = 1.0f / sqrtf(ss * (1.0f / 64.0f) + RMS_EPS);
            float y[4];
#pragma unroll
            for (int nt = 0; nt < 4; ++nt) y[nt] = acc[nt][r] * rinv * gn[nt * 16 + fr];
            const int ri = rt * 16 + 4 * q + r, c = ri & 1023; int pos = 16 * c + 31; pos = pos < SEQ ? pos : SEQ - 1;
            const f32x2* rr = (const f32x2*)(C.ws + WS_ROPE) + (size_t)pos * 32;
            const f32x2 c0 = rr[fr], c1 = rr[16 + fr];
            bf16* o = KC + (size_t)ri * 64;
            o[fr] = (bf16)f2bf(y[0] * c0.x - y[2] * c0.y); o[16 + fr] = (bf16)f2bf(y[1] * c1.x - y[3] * c1.y);
            o[32 + fr] = (bf16)f2bf(y[0] * c0.y + y[2] * c0.x); o[48 + fr] = (bf16)f2bf(y[1] * c1.y + y[3] * c1.x);
        }
    } else {
        bf16* VCT = (bf16*)(C.ws + WS_VCT);
        const int ri0 = rt * 16, bg = ri0 >> 10, c0 = (ri0 & 1023) + 4 * q;
#pragma unroll
        for (int nt = 0; nt < 4; ++nt) { const int d = nt * 16 + fr;
            *(v2u*)(VCT + (size_t)(bg * 64 + d) * 1024 + c0) = (v2u){pk2(acc[nt][0], acc[nt][1]), pk2(acc[nt][2], acc[nt][3])}; }
    }
}

constexpr int NQ = 32;
constexpr int NU_IMP = 0;
constexpr int NU_SEL = 32768;
constexpr int NU_UM = 33792;
constexpr int NU_UL = 33824;
constexpr int NU_KV = 35072;
constexpr int NU_TILE = 18432;
constexpr int NU_END = NU_KV + 4 * NU_TILE;
constexpr float LOG2E = 1.44269504089f;

struct TileSrc { const bf16* k; int kld; const bf16* v; int vld; };

__device__ __forceinline__ void nsa_fetch(const Ctx& C, const TileSrc& ts, bool on, v4u& kr, v4u& vr) {
    const int r = C.tid >> 3, ch = C.tid & 7;
    if (on) { kr = *(const v4u*)(ts.k + (size_t)r * ts.kld + ch * 8); vr = *(const v4u*)(ts.v + (size_t)r * ts.vld + ch * 8); }
}
__device__ __forceinline__ void nsa_commit(const Ctx& C, int j, bool on, const v4u& kr, const v4u& vr) {
    LAS bf16* KT = (LAS bf16*)(C.lds + NU_KV + j * NU_TILE); LAS bf16* VT = KT + 64 * 72;
    const int r = C.tid >> 3, ch = C.tid & 7;
    if (on) { *(LAS v4u*)(KT + r * 72 + ch * 8) = kr; *(LAS v4u*)(VT + r * 72 + ch * 8) = vr; }
}
__device__ __forceinline__ void nsa_scores(const Ctx& C, int j, const bf16x8 (&qf)[2], f32x4 (&s)[4]) {
    const LAS bf16* KT = (const LAS bf16*)(C.lds + NU_KV + j * NU_TILE);
    const int fr = C.lane & 15, q = C.lane >> 4;
#pragma unroll
    for (int kt = 0; kt < 4; ++kt) { s[kt] = (f32x4){0.f, 0.f, 0.f, 0.f};
#pragma unroll
        for (int ks = 0; ks < 2; ++ks) { const bf16x8 a = *(const LAS bf16x8*)(KT + (16 * kt + fr) * 72 + ks * 32 + 8 * q); s[kt] = __builtin_amdgcn_mfma_f32_16x16x32_bf16(a, qf[ks], s[kt], 0, 0, 0); } }
}
__device__ __forceinline__ void nsa_pv(const Ctx& C, int j, const f32x4 (&p)[4], f32x4 (&o)[4]) {
    const LAS bf16* VT = (const LAS bf16*)(C.lds + NU_KV + j * NU_TILE) + 64 * 72;
    const int fr = C.lane & 15, q = C.lane >> 4;
    bf16x8 pf[2];
#pragma unroll
    for (int k2 = 0; k2 < 2; ++k2) { v4u w; w.x = pk2(p[2 * k2][0], p[2 * k2][1]); w.y = pk2(p[2 * k2][2], p[2 * k2][3]); w.z = pk2(p[2 * k2 + 1][0], p[2 * k2 + 1][1]); w.w = pk2(p[2 * k2 + 1][2], p[2 * k2 + 1][3]);
        pf[k2] = __builtin_bit_cast(bf16x8, w); }
#pragma unroll
    for (int dt = 0; dt < 4; ++dt)
#pragma unroll
        for (int k2 = 0; k2 < 2; ++k2) {
            const LAS bf16* vr = VT + (16 * dt + fr) * 72 + 32 * k2 + 4 * q;
            const v2u lo = *(const LAS v2u*)vr, hi = *(const LAS v2u*)(vr + 16);
            const v4u aw = (v4u){lo.x, lo.y, hi.x, hi.y};
            o[dt] = __builtin_amdgcn_mfma_f32_16x16x32_bf16(__builtin_bit_cast(bf16x8, aw), pf[k2], o[dt], 0, 0, 0);
        }
}
__device__ __forceinline__ float nsa_exp(f32x4 (&s)[4], float ml2) {
    float ps = 0.f;
#pragma unroll
    for (int kt = 0; kt < 4; ++kt)
#pragma unroll
        for (int r = 0; r < 4; ++r) { const float p = __builtin_amdgcn_exp2f(s[kt][r] * LOG2E - ml2); s[kt][r] = p; ps += p; }
    return ps;
}

__device__ __forceinline__ void nsa_attn_unit(const Ctx& C, int l, int u, bool DRY) {
    const int half = u & 1, bg = (u >> 1) & 3, b = bg >> 1, g = bg & 1;
    const int qb = 255 - (u >> 3);
    const int q0 = 32 * half;
    const int t0 = b * SEQ + qb * 64;
    const int fr = C.lane & 15, q = C.lane >> 4, qq = fr >> 2, hh = fr & 3;
    LAS float* IMP = (LAS float*)(C.lds + NU_IMP);
    LAS unsigned long long* SEL = (LAS unsigned long long*)(C.lds + NU_SEL);
    LAS unsigned long long* UM = (LAS unsigned long long*)(C.lds + NU_UM);
    LAS int* UL = (LAS int*)(C.lds + NU_UL);
    for (int i = C.tid; i < NQ * 256; i += NTHR) IMP[i] = 0.f;
    float mc2, ms2, mw2;
    { const float* gn = C.in(11) + (size_t)l * 256;
      const float gq = wave_max(fabsf(gn[C.lane])), g1 = wave_max(fabsf(gn[64 + C.lane])), g2 = wave_max(fabsf(gn[128 + C.lane])), g3 = wave_max(fabsf(gn[192 + C.lane]));
      mc2 = 8.0f * gq * g1 * LOG2E; ms2 = 8.0f * gq * g2 * LOG2E; mw2 = 8.0f * gq * g3 * LOG2E; }
    bf16* QB = (bf16*)(C.ws + WS_QB);
    const int iq = q0 + 4 * C.wave + qq;
    bf16x8 qf[2]; float gate[3];
    { const bf16* qp = QB + (size_t)(t0 + iq) * 512 + (g * 4 + hh) * 64 + 8 * q;
      qf[0] = *(const bf16x8*)qp; qf[1] = *(const bf16x8*)(qp + 32);
      const float* sm = (const float*)(C.ws + WS_SMALL) + (size_t)(t0 + iq) * 64 + 16 + (g * 4 + hh) * 3;
#pragma unroll
      for (int k = 0; k < 3; ++k) gate[k] = ((ABL_ZERO & 2) || (ABL_ZERO & (8 << k))) ? 0.f : SCL_B * sigmoidf_(sm[k]); }
    f32x4 out[4];
#pragma unroll
    for (int dt = 0; dt < 4; ++dt) out[dt] = (f32x4){0.f, 0.f, 0.f, 0.f};
    v4u kr[4], vr[4];

    const bf16* KC = (const bf16*)(C.ws + WS_KCMP) + (size_t)bg * 1024 * 64;
    const bf16* VCT = (const bf16*)(C.ws + WS_VCT) + (size_t)bg * 64 * 1024;
    const int nct = (4 * qb + 3 + 63) >> 6, ncs = (nct + 3) >> 2;
    const int cmax = (64 * qb + iq - 31) >> 4, cmin = (64 * qb + q0 + 4 * C.wave - 31) >> 4;
    float cl = 0.f, cinv = 0.f;
    for (int rep = (TIMEDUP & 2048) ? 0 : 1; rep < 2; ++rep) { cl = 0.f;
    for (int pass = 0; pass < 2; ++pass) {
        f32x4 ao[4];
#pragma unroll
        for (int dt = 0; dt < 4; ++dt) ao[dt] = (f32x4){0.f, 0.f, 0.f, 0.f};
        if (pass == 1) { float lt = cl; lt += __shfl_xor(lt, 16); lt += __shfl_xor(lt, 32); cinv = lt > 0.f ? 1.0f / lt : 0.f; }
#pragma unroll
        for (int j = 0; j < 4; ++j) { const TileSrc ts{KC + (size_t)j * 64 * 64, 64, VCT + j * 64, 1024}; nsa_fetch(C, ts, j < nct, kr[j], vr[j]); }
        for (int st = 0; st < ncs; ++st) {
            __syncthreads();
#pragma unroll
            for (int j = 0; j < 4; ++j) nsa_commit(C, j, 4 * st + j < nct, kr[j], vr[j]);
            __syncthreads();
            if (st + 1 < ncs) {
#pragma unroll
                for (int j = 0; j < 4; ++j) { const int tl = 4 * (st + 1) + j; const TileSrc ts{KC + (size_t)tl * 64 * 64, 64, VCT + tl * 64, 1024}; nsa_fetch(C, ts, tl < nct, kr[j], vr[j]); }
            }
#pragma unroll
            for (int j = 0; j < 4; ++j) {
                const int tl = 4 * st + j;
                if (tl < nct) {
                    f32x4 s[4]; nsa_scores(C, j, qf, s);
                    if (64 * tl + 63 > cmin) {
#pragma unroll
                    for (int kt = 0; kt < 4; ++kt)
#pragma unroll
                        for (int r = 0; r < 4; ++r) { const int c = 64 * tl + 16 * kt + 4 * q + r; if (c > cmax) s[kt][r] = -INFINITY; }
                    }
                    const float ps = nsa_exp(s, mc2);
                    if (pass == 0) cl += ps;
                    else {
#pragma unroll
                        for (int kt = 0; kt < 4; ++kt) {
#pragma unroll
                            for (int r = 0; r < 4; ++r) s[kt][r] *= cinv;
                            float gs = (s[kt][0] + s[kt][1]) + (s[kt][2] + s[kt][3]), es = s[kt][3];
                            gs += __shfl_xor(gs, 1); gs += __shfl_xor(gs, 2); es += __shfl_xor(es, 1); es += __shfl_xor(es, 2);
                            if (hh == 0) { const int n = 16 * tl + 4 * kt + q;
                                if (n < 256) { atomicAdd((float*)(IMP + (iq - q0) * 256 + n), gs); if (n + 1 < 256) atomicAdd((float*)(IMP + (iq - q0) * 256 + n + 1), es); } }
                        }
                        nsa_pv(C, j, s, ao);
                    }
                }
            }
        }
        if (pass == 1) {
#pragma unroll
            for (int dt = 0; dt < 4; ++dt) out[dt] += ao[dt] * (rep == 1 ? gate[0] : 0.f);
        }
        __syncthreads();
    } }

    for (int rep = (TIMEDUP & 256) ? 0 : 1; rep < 2; ++rep)
    for (int k4 = 0; k4 < 4; ++k4) {
        const int i = 4 * C.wave + k4;
        unsigned key[4]; unsigned long long selw[4];
#pragma unroll
        for (int k = 0; k < 4; ++k) { const int n = C.lane + 64 * k; const bool valid = n <= qb; const bool forced = valid && (n == 0 || n == qb || n == qb - 1);
            key[k] = (valid && !forced) ? (__builtin_bit_cast(unsigned, fmaxf(IMP[i * 256 + n], 0.f)) + 1u) : 0u;
            selw[k] = __ballot(forced); }
        const int nforced = qb >= 2 ? 3 : qb + 1; const int ncand = qb + 1 - nforced;
        int need = 16 - nforced; if (need > ncand) need = ncand;
        if (need == ncand) {
#pragma unroll
            for (int k = 0; k < 4; ++k) selw[k] |= __ballot(key[k] != 0u);
        } else {
            unsigned thr = 0u;
            for (int bit = 31; bit >= 0; --bit) { const unsigned cand = thr | (1u << bit); int cnt = 0;
#pragma unroll
                for (int k = 0; k < 4; ++k) cnt += __builtin_popcountll(__ballot(key[k] >= cand));
                if (cnt >= need) thr = cand; }
            int left = need;
#pragma unroll
            for (int k = 0; k < 4; ++k) { const unsigned long long gt = __ballot(key[k] > thr); selw[k] |= gt; left -= __builtin_popcountll(gt); }
#pragma unroll
            for (int k = 0; k < 4; ++k) { unsigned long long eq = __ballot(key[k] == thr);
                while (left > 0 && eq) { const unsigned long long low = eq & (0ull - eq); selw[k] |= low; eq ^= low; --left; } }
        }
        if (C.lane < 4) SEL[i * 4 + C.lane] = C.lane == 0 ? selw[0] : C.lane == 1 ? selw[1] : C.lane == 2 ? selw[2] : selw[3];
    }
    __syncthreads();
    if (C.tid < 4) { unsigned long long um = 0ull; for (int i = 0; i < NQ; ++i) um |= SEL[i * 4 + C.tid]; UM[C.tid] = um; }
    __syncthreads();
    int ucnt;
    {
        const unsigned long long u0 = UM[0], u1 = UM[1], u2 = UM[2], u3 = UM[3];
        const int c0 = __builtin_popcountll(u0), c1 = __builtin_popcountll(u1), c2 = __builtin_popcountll(u2), c3 = __builtin_popcountll(u3);
        ucnt = c0 + c1 + c2 + c3;
        if (C.tid < 256) { const int w = C.tid >> 6, bit = C.tid & 63; const unsigned long long uw = w == 0 ? u0 : w == 1 ? u1 : w == 2 ? u2 : u3;
            if ((uw >> bit) & 1ull) { const int pos = (w > 0 ? c0 : 0) + (w > 1 ? c1 : 0) + (w > 2 ? c2 : 0) + __builtin_popcountll(uw & ((1ull << bit) - 1ull)); UL[pos] = C.tid; } }
    }
    __syncthreads();

    for (int rep = (TIMEDUP & 1024) ? 0 : 1; rep < 2; ++rep) {
        f32x4 ao[4]; float al = 0.f;
#pragma unroll
        for (int dt = 0; dt < 4; ++dt) ao[dt] = (f32x4){0.f, 0.f, 0.f, 0.f};
        const bf16* KS = (const bf16*)(C.ws + WS_KVS) + (size_t)(b * SEQ) * 256 + g * 64;
        const bf16* VST = (const bf16*)(C.ws + WS_VST) + (size_t)bg * 256 * 4096;
        const int nss = (ucnt + 3) >> 2;
        const unsigned long long my0 = SEL[(iq - q0) * 4 + 0], my1 = SEL[(iq - q0) * 4 + 1], my2 = SEL[(iq - q0) * 4 + 2], my3 = SEL[(iq - q0) * 4 + 3];
        v4u kr2[4], vr2[4];
#define SLC_FETCH(STG, KR, VR) do { _Pragma("unroll") for (int j = 0; j < 4; ++j) { const int ix = 4 * (STG) + j; const int n = ix < ucnt ? UL[ix] : 0; \
            const TileSrc ts{KS + (size_t)n * 64 * 256, 256, VST + (size_t)n * 4096, 64}; nsa_fetch(C, ts, ix < ucnt, KR[j], VR[j]); } } while (0)
#define SLC_STAGE(STG, KR, VR) do { \
            __syncthreads(); \
            _Pragma("unroll") for (int j = 0; j < 4; ++j) nsa_commit(C, j, 4 * (STG) + j < ucnt, KR[j], VR[j]); \
            __syncthreads(); \
            if ((STG) + 2 < nss) SLC_FETCH((STG) + 2, KR, VR); \
            _Pragma("unroll") for (int j = 0; j < 4; ++j) { \
                const int ix = 4 * (STG) + j; \
                if (ix < ucnt) { \
                    const int n = UL[ix]; \
                    const unsigned long long mw = (n >> 6) == 0 ? my0 : (n >> 6) == 1 ? my1 : (n >> 6) == 2 ? my2 : my3; \
                    const bool mysel = (mw >> (n & 63)) & 1ull; \
                    if (__ballot(mysel) != 0ull) { \
                        f32x4 s[4]; nsa_scores(C, j, qf, s); \
                        if (n == qb) { _Pragma("unroll") for (int kt = 0; kt < 4; ++kt) _Pragma("unroll") for (int r = 0; r < 4; ++r) { const int key = 16 * kt + 4 * q + r; if (key > iq) s[kt][r] = -INFINITY; } } \
                        al += nsa_exp(s, mysel ? ms2 : INFINITY); \
                        nsa_pv(C, j, s, ao); \
                    } } } } while (0)
        SLC_FETCH(0, kr, vr);
        if (nss > 1) SLC_FETCH(1, kr2, vr2);
        for (int st = 0; st < nss; st += 2) {
            SLC_STAGE(st, kr, vr);
            if (st + 1 < nss) SLC_STAGE(st + 1, kr2, vr2);
        }
#undef SLC_FETCH
#undef SLC_STAGE
        float lt = al; lt += __shfl_xor(lt, 16); lt += __shfl_xor(lt, 32); const float inv = (lt > 0.f && rep == 1) ? gate[1] / lt : 0.f;
#pragma unroll
        for (int dt = 0; dt < 4; ++dt) out[dt] += ao[dt] * inv;
    }
    for (int rep = (TIMEDUP & 512) ? 0 : 1; rep < 2; ++rep) {
        f32x4 ao[4]; float al = 0.f;
#pragma unroll
        for (int dt = 0; dt < 4; ++dt) ao[dt] = (f32x4){0.f, 0.f, 0.f, 0.f};
        const bf16* KW = (const bf16*)(C.ws + WS_KVW) + (size_t)(b * SEQ) * 256 + g * 64;
        const bf16* VWT = (const bf16*)(C.ws + WS_VWT) + (size_t)bg * 256 * 4096;
        const int nfirst = qb >= 8 ? qb - 8 : 0, nw = qb - nfirst + 1, nws = (nw + 3) >> 2;
#pragma unroll
        for (int j = 0; j < 4; ++j) { const int n = nfirst + j; const TileSrc ts{KW + (size_t)n * 64 * 256, 256, VWT + (size_t)n * 4096, 64}; nsa_fetch(C, ts, j < nw, kr[j], vr[j]); }
        for (int st = 0; st < nws; ++st) {
            __syncthreads();
#pragma unroll
            for (int j = 0; j < 4; ++j) nsa_commit(C, j, 4 * st + j < nw, kr[j], vr[j]);
            __syncthreads();
            if (st + 1 < nws) {
#pragma unroll
                for (int j = 0; j < 4; ++j) { const int ix = 4 * (st + 1) + j; const int n = nfirst + (ix < nw ? ix : 0); const TileSrc ts{KW + (size_t)n * 64 * 256, 256, VWT + (size_t)n * 4096, 64}; nsa_fetch(C, ts, ix < nw, kr[j], vr[j]); }
            }
#pragma unroll
            for (int j = 0; j < 4; ++j) {
                const int ix = 4 * st + j;
                if (ix < nw) {
                    const int delta = qb - (nfirst + ix);
                    f32x4 s[4]; nsa_scores(C, j, qf, s);
                    if (delta == 0 || delta == 8) {
#pragma unroll
                        for (int kt = 0; kt < 4; ++kt)
#pragma unroll
                            for (int r = 0; r < 4; ++r) { const int key = 16 * kt + 4 * q + r; const bool ok = delta == 0 ? (key <= iq) : (key > iq); if (!ok) s[kt][r] = -INFINITY; }
                    }
                    al += nsa_exp(s, mw2);
                    nsa_pv(C, j, s, ao);
                }
            }
        }
        float lt = al; lt += __shfl_xor(lt, 16); lt += __shfl_xor(lt, 32); const float inv = (lt > 0.f && rep == 1) ? gate[2] / lt : 0.f;
#pragma unroll
        for (int dt = 0; dt < 4; ++dt) out[dt] += ao[dt] * inv;
    }
    if (DRY) {
#pragma unroll
      for (int dt = 0; dt < 4; ++dt) asm volatile("" :: "v"(out[dt]));
    } else { bf16* op = QB + (size_t)(t0 + iq) * 512 + (g * 4 + hh) * 64 + 4 * q;
#pragma unroll
      for (int dt = 0; dt < 4; ++dt) *(v2u*)(op + 16 * dt) = (v2u){pk2(out[dt][0], out[dt][1]), pk2(out[dt][2], out[dt][3])}; }
    __syncthreads();
}


__device__ __forceinline__ void phase_mix1(const Ctx& C, int l) {
    const int gw = C.bid * NWAVES + C.wave, NGW = C.G * NWAVES;
    for (int rep = (TIMEDUP & 32) ? 0 : 1; rep < 2; ++rep) {
    for (int it = gw; it < 2048; it += NGW) nsa_cmp1_item(C, it);
    for (int it = gw; it < 2048; it += NGW) nsa_vtrans_item(C, it); }
    for (int t = gw; t < T; t += NGW) nsa_prep_token(C, l, t);
    __syncthreads();
    for (int rep = (TIMEDUP & 16) ? 0 : 1; rep < 2; ++rep) for (int u = C.bid; u < 4096; u += C.G) { if (u < 2048) gla_unit_a(C, l, u); else mlstm_unit_a(C, l, u - 2048); }
}
__device__ __forceinline__ void phase_mix2(const Ctx& C, int l) {
    const int gw = C.bid * NWAVES + C.wave, NGW = C.G * NWAVES;
    for (int it = gw; it < 512; it += NGW) nsa_cmp2_item(C, l, it);
    phase_scan(C);
}
__device__ __forceinline__ void phase_mix3(const Ctx& C, int l) {
    for (int rep = (TIMEDUP & 1) ? 0 : 1; rep < 2; ++rep) for (int i = C.bid; i < 2048; i += C.G) {
        const int r = i / C.G, w = i % C.G; const int pos = (r & 1) ? (2047 - ((r >> 1) * C.G + w)) : ((r >> 1) * C.G + w);
        nsa_attn_unit(C, l, pos, rep == 0); }
    const_cast<Ctx&>(C).launder(); const Ctx& D = C;
    for (int rep = (TIMEDUP & 2) ? 0 : 1; rep < 2; ++rep) for (int u = D.bid; u < 4096; u += D.G) { if (u < 2048) gla_unit_c(D, l, u, rep == 0); else mlstm_unit_c(D, l, u - 2048, rep == 0); }
}

constexpr int MIX_PHASES = 10;
#define MIXER_PHASES \
    if (PH_ON) phase_norm(C, C.in(5) + (size_t)l * DM, C.X); \
    PH_END; \
    if (PH_ON) { \
        pg8::Gemm g{(const bf16*)(C.ws + WS_XN), (const bf16*)(C.ws + WS_WIN), T, 4608, DM}; \
        pg8::StaticOrder S; S.init(T, 4608, C.G, C.bid); \
        pg8::EpiWin E{C.ws + WS_R, (const float*)(C.ws + WS_VEC) + VEC_BINP, (float*)(C.ws + WS_SMALL)}; \
        for (int rep = (TIMEDUP & 64) ? 0 : 1; rep < 2; ++rep) pg8::gemm_phase<pg8::EpiWin, pg8::StaticOrder, false>(C.lds, g, S, E, nullptr); \
    } \
    PH_END; \
    if (PH_ON) phase_mix1(C, l); \
    PH_END; \
    if (PH_ON) phase_mix2(C, l); \
    PH_END; \
    if (PH_ON) phase_mix3(C, l); \
    PH_END; \
    if (PH_ON) { \
        pg8::Gemm g{(const bf16*)(C.ws + WS_XN), (const bf16*)(C.ws + WS_WGT), T, 3 * DM, DM}; \
        pg8::StaticOrder S; S.init(T, 3 * DM, C.G, C.bid); \
        pg8::EpiGate E{C.ws, DM, C.in(7) + (size_t)l * N_IN + 4400}; \
        pg8::gemm_phase<pg8::EpiGate, pg8::StaticOrder, false>(C.lds, g, S, E, nullptr); \
    } \
    PH_END; \
    for (int br = 0; br < 3; ++br) { \
        if (PH_ON) { \
            const bf16* Asrc = (const bf16*)(C.ws + (br == 0 ? WS_RA : br == 1 ? WS_QB : WS_OC)); \
            pg8::Gemm g{Asrc, (const bf16*)(C.ws + WS_WBR) + (size_t)br * DM * 512, T, DM, 512}; \
            pg8::StaticOrder S; S.init(T, DM, C.G, C.bid); \
            pg8::EpiBranch E{(bf16*)(C.ws + WS_Y), (const bf16*)(C.ws + WS_G0 + (size_t)(br >= 1) * (WS_G1 - WS_G0) + (size_t)(br >= 2) * (WS_G2 - WS_G1)), DM, br == 0 ? 1 : 0}; \
            pg8::gemm_phase<pg8::EpiBranch, pg8::StaticOrder, false>(C.lds, g, S, E, nullptr); \
        } \
        PH_END; \
    } \
    if (PH_ON) { \
        pg8::Gemm g{(const bf16*)(C.ws + WS_Y), (const bf16*)(C.ws + WS_WOUT), T, DM, DM}; \
        pg8::StaticOrder S; S.init(T, DM, C.G, C.bid); \
        pg8::EpiResid E{C.X, DM, 1.0f, C.X}; \
        pg8::gemm_phase<pg8::EpiResid, pg8::StaticOrder, false>(C.lds, g, S, E, nullptr); \
    } \
    PH_END;

constexpr int N_PHASES = 8 * 3 + 4 * MIX_PHASES;

__global__ void __launch_bounds__(NTHR, 2) hybrid_fwd(Args args) {
    extern __shared__ __attribute__((aligned(16))) unsigned char lds_raw[];
    Ctx C;
    C.lds = (LAS unsigned char*)lds_raw;
    C.tid = threadIdx.x; C.lane = C.tid & 63; C.wave = __builtin_amdgcn_readfirstlane(C.tid >> 6);
    C.G = gridDim.x; C.bid = blockIdx.x;
    C.inp = (const GAS float* const __attribute__((address_space(4)))*)__builtin_amdgcn_kernarg_segment_ptr();
    C.X = args.out; C.ws = args.ws;
    volatile LAS unsigned* MISC = (volatile LAS unsigned*)(C.lds + MISC_OFF);
    for (int u = C.tid; u < (LDS_BYTES - RING_BYTES) / 4; u += NTHR) ((LAS unsigned*)(C.lds + RING_BYTES))[u] = 0u;
    __syncthreads();
    __builtin_amdgcn_fence(__ATOMIC_ACQUIRE, "agent"); asm volatile("s_waitcnt vmcnt(0)" ::: "memory");
    __syncthreads();
    const int lo = args.ph_lo, hi = args.ph_hi;
    XcdBarrier bar; bar.bar = (unsigned*)(C.ws + WS_CTL) + 4096; bar.x = 0; bar.st = nullptr;
    if (hi - lo > 1) bar = xcd_barrier_post((unsigned*)(C.ws + WS_CTL) + 4096, MISC + 8);
    int pc = 0;
#define PH_ON (C.launder(), pc >= lo && pc < hi)
#define PH_END_NB do { ++pc; } while (0)
#define PH_END do { if (pc >= lo && pc + 1 < hi) { xcd_barrier(bar); if (TIMEDUP & 4096) xcd_barrier(bar); } ++pc; } while (0)

    for (int step = 0; step < 2 * NLAYER; ++step) {
        const int l = step >> 1, f = step & 1;
        if (PH_ON) {
            if (step == 0) phase_init(C);
            if (f == 0) for (int rep = (TIMEDUP & 128) ? 0 : 1; rep < 2; ++rep) phase_prep_weights(C, l);
            for (int rep = (TIMEDUP & 8) ? 0 : 1; rep < 2; ++rep) phase_norm(C, (f ? C.in(19) : C.in(1)) + (size_t)l * DM, step == 0 ? C.in(0) : (const float*)C.X);
        }
        PH_END;
        if (PH_ON) {
            pg8::Gemm g{(const bf16*)(C.ws + WS_XN), (const bf16*)(C.ws + (f ? WS_WGU2 : WS_WGU1)), T, 2 * DFF, DM};
            pg8::StaticOrder S; S.init(T, 2 * DFF, C.G, C.bid);
            pg8::EpiSwiGLU E{(bf16*)(C.ws + WS_HID), DFF};
            for (int rep = (TIMEDUP & 4) ? 0 : 1; rep < 2; ++rep) pg8::gemm_phase<pg8::EpiSwiGLU, pg8::StaticOrder, false>(C.lds, g, S, E, nullptr);
        }
        PH_END;
        if (PH_ON) {
            pg8::Gemm g{(const bf16*)(C.ws + WS_HID), (const bf16*)(C.ws + (f ? WS_WDN2 : WS_WDN1)), T, DM, DFF};
            pg8::StaticOrder S; S.init(T, DM, C.G, C.bid);
            pg8::EpiResid E{C.X, DM, 0.5f, step == 0 ? C.in(0) : (const float*)C.X};
            pg8::gemm_phase<pg8::EpiResid, pg8::StaticOrder, false>(C.lds, g, S, E, nullptr);
        }
        PH_END;
        if (f == 0) {
            MIXER_PHASES
        }
    }
#undef PH_ON
#undef PH_END
#undef PH_END_NB
    asm volatile("s_waitcnt vmcnt(0)" ::: "memory");
    __syncthreads();
    if (C.tid == 0) { __builtin_amdgcn_fence(__ATOMIC_RELEASE, "agent"); asm volatile("s_waitcnt vmcnt(0)" ::: "memory"); }
}

extern "C" void kernel_launch(void* const* d_in, const int* in_sizes, int n_in, void* d_out, int out_size, void* d_ws, size_t ws_size, hipStream_t stream) {
    static int grid = 0;
    if (grid == 0) {
        if (n_in != 23 || out_size != T * DM || ws_size < WS_END) { fprintf(stderr, "kernel_launch: unexpected shapes (n_in %d out %d ws %zu, need %zu)\n", n_in, out_size, ws_size, (size_t)WS_END); grid = -1; return; }
        int dev = 0, cus = 0, per_cu = 0;
        if (hipGetDevice(&dev) != hipSuccess || hipDeviceGetAttribute(&cus, hipDeviceAttributeMultiprocessorCount, dev) != hipSuccess) { grid = -1; return; }
        if (hipFuncSetAttribute((const void*)hybrid_fwd, hipFuncAttributeMaxDynamicSharedMemorySize, LDS_BYTES) != hipSuccess) { fprintf(stderr, "kernel_launch: hipFuncSetAttribute failed\n"); grid = -1; return; }
        if (hipOccupancyMaxActiveBlocksPerMultiprocessor(&per_cu, (const void*)hybrid_fwd, NTHR, LDS_BYTES) != hipSuccess || per_cu < 1) { fprintf(stderr, "kernel_launch: occupancy query says %d blocks per CU\n", per_cu); }
        (void)hipGetLastError();
        grid = cus;
    }
    if (grid < 0) return;
    (void)hipMemsetAsync((char*)d_ws + WS_CTL, 0, CTL_ZERO_BYTES, stream);
    Args a{};
    for (int i = 0; i < 23; ++i) a.in[i] = (const float*)d_in[i];
    a.out = (float*)d_out; a.ws = (unsigned char*)d_ws;
#if ONE_LAUNCH
    a.ph_lo = 0; a.ph_hi = N_PHASES;
    hipLaunchKernelGGL(hybrid_fwd, dim3(grid), dim3(NTHR), LDS_BYTES, stream, a);
#else
    for (int p = 0; p < N_PHASES; ++p) { a.ph_lo = p; a.ph_hi = p + 1; hipLaunchKernelGGL(hybrid_fwd, dim3(grid), dim3(NTHR), LDS_BYTES, stream, a); }
#endif
}
```

```cpp
#include <hip/hip_runtime.h>
#include <cstdio>
#include <cstdint>

#ifndef ABL_ZERO
#define ABL_ZERO 0
#endif
#ifndef SCL_A
#define SCL_A 1.0f
#define SCL_B 1.0f
#define SCL_C 1.0f
#endif
#ifndef TIMEDUP
#define TIMEDUP 0
#endif
#ifndef ONE_LAUNCH
#define ONE_LAUNCH 1
#endif

#define GAS __attribute__((address_space(1)))
#define LAS __attribute__((address_space(3)))
typedef unsigned short bf16;
typedef unsigned v4u __attribute__((ext_vector_type(4)));
typedef unsigned v2u __attribute__((ext_vector_type(2)));
typedef float f32x4 __attribute__((ext_vector_type(4)));
typedef float f32x2 __attribute__((ext_vector_type(2)));
typedef short bf16x8 __attribute__((ext_vector_type(8)));
typedef short bf16x4 __attribute__((ext_vector_type(4)));

constexpr int NB = 2, SEQ = 16384, T = NB * SEQ, DM = 1024, DFF = 2816, NLAYER = 4;
constexpr int N_IN = 7472;
constexpr int NWAVES = 8, NTHR = 512;
constexpr float RMS_EPS = 1e-6f;
constexpr int NCH = SEQ / 64;

constexpr size_t MiB = 1u << 20;
constexpr size_t WS_CTL = 0, CTL_ZERO_BYTES = 1 * MiB;
constexpr size_t WS_ROPE = 1 * MiB;
constexpr size_t WS_VEC = 5 * MiB;
constexpr size_t WS_WGU1 = 6 * MiB;
constexpr size_t WS_WDN1 = 17 * MiB;
constexpr size_t WS_WGU2 = 23 * MiB;
constexpr size_t WS_WDN2 = 34 * MiB;
constexpr size_t WS_WIN = 40 * MiB;
constexpr size_t WS_WGT = 49 * MiB;
constexpr size_t WS_WBR = 55 * MiB;
constexpr size_t WS_WOUT = 58 * MiB;
constexpr size_t WS_CW1 = 60 * MiB;
constexpr size_t WS_CW2 = 62 * MiB;
constexpr size_t WS_XN = 64 * MiB;
constexpr size_t WS_R = 128 * MiB;
constexpr size_t WS_HID = WS_R;
constexpr size_t WS_QKA = WS_R;
constexpr size_t WS_VA = WS_R + 32 * MiB;
constexpr size_t WS_RA = WS_R + 64 * MiB;
constexpr size_t WS_QB = WS_R + 96 * MiB;
constexpr size_t WS_KVC = WS_R + 128 * MiB;
constexpr size_t WS_KVS = WS_R + 144 * MiB;
constexpr size_t WS_KVW = WS_R + 160 * MiB;
constexpr size_t WS_QKC = WS_R + 176 * MiB;
constexpr size_t WS_VC = WS_R + 208 * MiB;
constexpr size_t WS_OC = WS_R + 240 * MiB;
constexpr size_t WS_SMALL = WS_R + 272 * MiB;
constexpr size_t WS_VST = WS_R + 280 * MiB;
constexpr size_t WS_VWT = WS_R + 288 * MiB;
constexpr size_t WS_KCMP = WS_R + 296 * MiB;
constexpr size_t WS_VCT = WS_KCMP + MiB / 2;
constexpr size_t WS_CMPH = WS_R + 297 * MiB;
constexpr size_t WS_GST = WS_R + 302 * MiB;
constexpr size_t WS_GDEC = WS_R + 334 * MiB;
constexpr size_t WS_MSC = WS_GDEC + MiB / 2;
constexpr size_t WS_MST = WS_R + 335 * MiB;
constexpr size_t WS_MN = WS_R + 367 * MiB;
constexpr size_t WS_G0 = WS_QKA, WS_G1 = WS_QKC, WS_G2 = WS_GST;
constexpr size_t WS_G = WS_G0;
constexpr size_t WS_Y = WS_XN;
constexpr size_t WS_END = WS_R + 368 * MiB;

constexpr int VEC_BINP = 0;
constexpr int VEC_CB1 = 8192;

#define LDS_WAIT() asm volatile("s_waitcnt lgkmcnt(0)" ::: "memory")
#define VM_WAIT() asm volatile("s_waitcnt vmcnt(0)" ::: "memory")
__device__ __forceinline__ unsigned f2bf(float f) { unsigned u = __builtin_bit_cast(unsigned, f); return (u + 0x7fffu + ((u >> 16) & 1u)) >> 16; }
typedef __bf16 bf2_t __attribute__((ext_vector_type(2)));
__device__ __forceinline__ unsigned pk2(float lo, float hi) { const f32x2 v = {lo, hi}; return __builtin_bit_cast(unsigned, __builtin_convertvector(v, bf2_t)); }
__device__ __forceinline__ float bf2f(unsigned v) { return __builtin_bit_cast(float, (v & 0xffffu) << 16); }
__device__ __forceinline__ float bflo(unsigned w) { return __builtin_bit_cast(float, w << 16); }
__device__ __forceinline__ float bfhi(unsigned w) { return __builtin_bit_cast(float, w & 0xffff0000u); }
__device__ __forceinline__ float fexp(float x) { return __builtin_amdgcn_exp2f(x * 1.44269504089f); }
__device__ __forceinline__ float sigmoidf_(float x) { return 1.0f / (1.0f + __expf(-x)); }
__device__ __forceinline__ float siluf_(float x) { return x / (1.0f + __expf(-x)); }
__device__ __forceinline__ float logsigmoidf_(float x) { return fminf(x, 0.f) - __logf(1.0f + __expf(-fabsf(x))); }
__device__ __forceinline__ float wave_sum(float v) {
#pragma unroll
    for (int o = 1; o < 64; o <<= 1) v += __shfl_xor(v, o);
    return v;
}
__device__ __forceinline__ float wave_max(float v) {
#pragma unroll
    for (int o = 1; o < 64; o <<= 1) v = fmaxf(v, __shfl_xor(v, o));
    return v;
}

#define XB_TMO      128
#define XB_XCNT(j)  (256  + 64 * (j))
#define XB_XSUB(j)  (1280 + 64 * (j))
#define XB_XGEN(j)  (2304 + 64 * (j))
#define XB_TOP      3328
#define XB_TOPGEN   3392
#define XCD_BAR_WORDS 3456
#define XB_SPIN_CAP (1u << 24)

__device__ __forceinline__ unsigned xb_ld(unsigned* p)              { return __hip_atomic_load(p, __ATOMIC_RELAXED, __HIP_MEMORY_SCOPE_AGENT); }
__device__ __forceinline__ unsigned xb_add(unsigned* p, unsigned v) { return __hip_atomic_fetch_add(p, v, __ATOMIC_RELAXED, __HIP_MEMORY_SCOPE_AGENT); }
__device__ __forceinline__ unsigned xb_xcc_id() { return (unsigned)__builtin_amdgcn_s_getreg((3 << 11) | 20) & 0xFu; }
#define XB_SPIN(cond, bar) do { unsigned _sp = 0; while (cond) { __builtin_amdgcn_s_sleep(1); \
    if ((++_sp & 255u) == 0u) { if (xb_ld(&(bar)[XB_TMO])) break; if (_sp > XB_SPIN_CAP) { atomicAdd(&(bar)[XB_TMO], 1u); break; } } } } while (0)

struct XcdBarrier {
    unsigned* bar; unsigned x;
    volatile LAS unsigned* st;
};
__device__ __forceinline__ XcdBarrier xcd_barrier_post(unsigned* bar, volatile LAS unsigned* st) {
    XcdBarrier b; b.bar = bar; b.x = xb_xcc_id(); b.st = st;
    if (threadIdx.x == 0) (void)xb_add(&bar[XB_XCNT(b.x)], 1u);
    return b;
}
__device__ __forceinline__ void xcd_barrier_complete(unsigned* bar, unsigned x, unsigned& nloc, unsigned& nx) {
    const unsigned G = gridDim.x * gridDim.y * gridDim.z;
    unsigned sum, cnt, mine, sp = 0u;
    for (;;) {
        sum = 0u; cnt = 0u; mine = 0u;
#pragma unroll
        for (unsigned j = 0; j < 16; ++j) { const unsigned c = xb_ld(&bar[XB_XCNT(j)]); sum += c; cnt += (c > 0u) ? 1u : 0u; mine = (j == x) ? c : mine; }
        if (sum == G) break;
        __builtin_amdgcn_s_sleep(1);
        if ((++sp & 255u) == 0u) { if (xb_ld(&bar[XB_TMO])) break; if (sp > XB_SPIN_CAP) { atomicAdd(&bar[XB_TMO], 1u); break; } }
    }
    nloc = mine > 0u ? mine : 1u; nx = cnt > 0u ? cnt : 1u;
}
__device__ __forceinline__ void xcd_barrier(const XcdBarrier& b) {
    asm volatile("s_waitcnt vmcnt(0)" ::: "memory");
    __syncthreads();
    if (threadIdx.x == 0) {
        unsigned* bar = b.bar;
        __builtin_amdgcn_s_waitcnt(0);
        unsigned nloc = b.st[0], nx = b.st[1];
        if (nloc == 0u) { xcd_barrier_complete(bar, b.x, nloc, nx); b.st[0] = nloc; b.st[1] = nx; }
        const unsigned old = xb_add(&bar[XB_XSUB(b.x)], 1u);
        const unsigned gen = old / nloc;
        if (old + 1u == (gen + 1u) * nloc) {
            __builtin_amdgcn_fence(__ATOMIC_RELEASE, "agent");
            asm volatile("s_waitcnt vmcnt(0)" ::: "memory");
            const unsigned og = xb_add(&bar[XB_TOP], 1u);
            const unsigned tg = og / nx;
            if (og + 1u == (tg + 1u) * nx) xb_add(&bar[XB_TOPGEN], 1u);
            else XB_SPIN(xb_ld(&bar[XB_TOPGEN]) == tg, bar);
            __builtin_amdgcn_fence(__ATOMIC_ACQUIRE, "agent");
            xb_add(&bar[XB_XGEN(b.x)], 1u);
            asm volatile("s_waitcnt vmcnt(0)" ::: "memory");
        } else {
            XB_SPIN(xb_ld(&bar[XB_XGEN(b.x)]) == gen, bar);
            __builtin_amdgcn_fence(__ATOMIC_ACQUIRE, "agent");
            asm volatile("s_waitcnt vmcnt(0)" ::: "memory");
        }
    }
    __syncthreads();
}

namespace pg8 {
#define PG8_LAS __attribute__((address_space(3)))
typedef unsigned short bf16_t;
typedef short bf16x8 __attribute__((ext_vector_type(8)));
typedef float f32x4 __attribute__((ext_vector_type(4)));
typedef unsigned u32x4 __attribute__((ext_vector_type(4)));
constexpr int BM = 256, BK = 64, HALF = 128, HTB = HALF * BK * 2  , STAGE_BYTES = 8 * HTB, NXCD = 8, WGM = 8;

__host__ __device__ __forceinline__ int lds_byte(int r, int c) { const int st = (r >> 4) * 2 + (c >> 5), rr = r & 15, cc = c & 31, ob = rr * 64 + cc * 2; return st * 1024 + (ob ^ (((ob >> 9) & 1) << 5)); }
__host__ __device__ __forceinline__ void stage_rc(int b, int& R, int& C) { const int st = b / 1024, sb = b % 1024, swz = sb ^ (((sb >> 9) & 1) << 5); R = (st >> 1) * 16 + swz / 64; C = (st & 1) * 32 + (swz % 64) / 2; }
__host__ __device__ __forceinline__ int perm32(int rho) { const int n = rho >> 4, i = rho & 15; return 8 * (i >> 2) + 4 * n + (i & 3); }

struct Unit { int pm, pn; };
struct Gemm { const bf16_t* A; const bf16_t* Bt; int M, N, K; };

struct StaticOrder {
    int nM, nN, nwg, G, c;
    __host__ __device__ void init(int M, int N, int G_, int c_) { nM = M / BM; nN = N / BM; nwg = nM * nN; G = G_; c = c_; }
    __host__ __device__ bool next(int i, Unit& u) const {
        const long L = (long)i * G + c; if (L >= nwg) return false;
        int wgid = (int)L; { const int q = nwg / NXCD, r = nwg % NXCD, xcd = wgid % NXCD, off = wgid / NXCD; wgid = (xcd < r ? xcd * (q + 1) : r * (q + 1) + (xcd - r) * q) + off; }
        const int nig = WGM * nN, gid = wgid / nig, fm = gid * WGM, gsz = (nM - fm) < WGM ? (nM - fm) : WGM;
        u.pm = fm + ((wgid % nig) % gsz); u.pn = (wgid % nig) / gsz; return true;
    }
    __device__ __forceinline__ void a_ready(const Unit&) const {}
    __device__ __forceinline__ void done(const Unit&) const {}
};
struct CountedOrder : StaticOrder {
    const unsigned* ready; unsigned need; unsigned* tmo;
    __device__ __forceinline__ void a_ready(const Unit& u) const {
        if (threadIdx.x < 64) {
            const unsigned long long t0 = __builtin_amdgcn_s_memrealtime(); unsigned polls = 0;
            while ((unsigned)__builtin_amdgcn_readfirstlane(__hip_atomic_load(ready + 64 * u.pm, __ATOMIC_RELAXED, __HIP_MEMORY_SCOPE_AGENT)) < need) {
                if ((++polls & 255u) == 0u && __builtin_amdgcn_readfirstlane(__hip_atomic_load(tmo, __ATOMIC_RELAXED, __HIP_MEMORY_SCOPE_AGENT)) != 0u) break;
                if (__builtin_amdgcn_s_memrealtime() - t0 > 2000000ull) {
                    if (threadIdx.x == 0) { unsigned expect = 0u; __hip_atomic_compare_exchange_strong(tmo + 1, &expect, 0x600u | (unsigned)(u.pm & 0xff), __ATOMIC_RELAXED, __ATOMIC_RELAXED, __HIP_MEMORY_SCOPE_AGENT); __hip_atomic_store(tmo, 1u, __ATOMIC_RELAXED, __HIP_MEMORY_SCOPE_AGENT); }
                    break; }
                __builtin_amdgcn_s_sleep(2); }
            __builtin_amdgcn_fence(__ATOMIC_ACQUIRE, "agent");
            asm volatile("s_waitcnt vmcnt(0)" ::: "memory");
        }
#if !defined(BROKEN_HOOK_NO_BARRIER)
        asm volatile("" ::: "memory"); __builtin_amdgcn_s_barrier(); asm volatile("" ::: "memory");
#endif
    }
};

__device__ __forceinline__ unsigned cvt_pk_bf16(float lo, float hi) { unsigned r; asm volatile("v_cvt_pk_bf16_f32 %0, %1, %2" : "=v"(r) : "v"(lo), "v"(hi)); return r; }
typedef float f32x2 __attribute__((ext_vector_type(2)));
__device__ __forceinline__ f32x2 gelu_pk(f32x2 v) {
    const f32x2 av = __builtin_elementwise_abs(v), d = av * 0.2316418882f + 1.0f;
    f32x2 t; t.x = __builtin_amdgcn_rcpf(d.x); t.y = __builtin_amdgcn_rcpf(d.y);
    f32x2 q = t * 0.5307027145f + (-0.7265760135f); q = q * t + 0.7107068705f; q = q * t + (-0.142248368f); q = q * t + 0.127414796f; q = q * t;
    const f32x2 s = (v * v) * (-0.72134752044f);
    f32x2 e; e.x = __builtin_amdgcn_exp2f(s.x); e.y = __builtin_amdgcn_exp2f(s.y);
    const f32x2 m = v * (q * e), r = v - m;
    f32x2 o; o.x = v.x < 0.f ? m.x : r.x; o.y = v.y < 0.f ? m.y : r.y; return o;
}

struct EpiF32 {
    static constexpr bool PERM = false, AFTER_DRAIN = false;
    float* C; int ldc; const float* bias;
    __device__ __forceinline__ void operator()(const f32x4 (&acc)[2][2][4][2], const Unit& u, int wr, int wc, int fr, int fq) const {
        const int row0 = u.pm * BM + wr * 64 + fr, col0 = u.pn * BM + wc * 32 + 4 * fq;
        f32x4 bv[2][2];
#pragma unroll
        for (int bj = 0; bj < 2; ++bj)
#pragma unroll
            for (int n = 0; n < 2; ++n) bv[bj][n] = bias ? *(const f32x4*)(bias + col0 + bj * HALF + n * 16) : (f32x4){0.f, 0.f, 0.f, 0.f};
#pragma unroll
        for (int ai = 0; ai < 2; ++ai)
#pragma unroll
            for (int m = 0; m < 4; ++m) { float* rowp = C + (size_t)(row0 + ai * HALF + m * 16) * ldc + col0;
#pragma unroll
                for (int bj = 0; bj < 2; ++bj)
#pragma unroll
                    for (int n = 0; n < 2; ++n) *(f32x4*)(rowp + bj * HALF + n * 16) = acc[ai][bj][m][n] + bv[bj][n]; }
    }
};
template <int ACT  > struct EpiBf16 {
    static constexpr bool PERM = true, AFTER_DRAIN = false;
    bf16_t* O; int ldc; const float* bias; int split_cols; size_t split_stride;
    __device__ __forceinline__ void operator()(const f32x4 (&acc)[2][2][4][2], const Unit& u, int wr, int wc, int fr, int fq) const {
        const int row0 = u.pm * BM + wr * 64 + fr; int colt = u.pn * BM; bf16_t* base = O;
        if (split_cols) { const int t = colt / split_cols; base += (size_t)t * split_stride; colt -= t * split_cols; }
        const int col0 = colt + wc * 32 + 8 * fq, bcol0 = u.pn * BM + wc * 32 + 8 * fq;
        f32x4 bv[2][2];
#pragma unroll
        for (int bj = 0; bj < 2; ++bj)
#pragma unroll
            for (int n = 0; n < 2; ++n) bv[bj][n] = bias ? *(const f32x4*)(bias + bcol0 + bj * HALF + 4 * n) : (f32x4){0.f, 0.f, 0.f, 0.f};
#pragma unroll
        for (int ai = 0; ai < 2; ++ai)
#pragma unroll
            for (int m = 0; m < 4; ++m) { bf16_t* rowp = base + (size_t)(row0 + ai * HALF + m * 16) * ldc + col0;
#pragma unroll
                for (int bj = 0; bj < 2; ++bj) { f32x4 v0 = acc[ai][bj][m][0] + bv[bj][0], v1 = acc[ai][bj][m][1] + bv[bj][1];
                    if (ACT == 1) { f32x2 a = gelu_pk((f32x2){v0[0], v0[1]}), b = gelu_pk((f32x2){v0[2], v0[3]}), c = gelu_pk((f32x2){v1[0], v1[1]}), d = gelu_pk((f32x2){v1[2], v1[3]});
                        v0 = (f32x4){a.x, a.y, b.x, b.y}; v1 = (f32x4){c.x, c.y, d.x, d.y}; }
                    if (ACT == 2) {
#pragma unroll
                        for (int j = 0; j < 4; ++j) { v0[j] = 0.5f * v0[j] * (1.0f + erff(v0[j] * 0.70710678f)); v1[j] = 0.5f * v1[j] * (1.0f + erff(v1[j] * 0.70710678f)); } }
                    u32x4 w; w.x = cvt_pk_bf16(v0[0], v0[1]); w.y = cvt_pk_bf16(v0[2], v0[3]); w.z = cvt_pk_bf16(v1[0], v1[1]); w.w = cvt_pk_bf16(v1[2], v1[3]);
                    *(u32x4*)(rowp + bj * HALF) = w; } }
    }
};

struct PanelStats {
    unsigned* xbuf;
    unsigned* cnt;
    unsigned* tmo;
    int ntn; float eps;
    unsigned code;
    __device__ __forceinline__ bool run(const f32x4 (&v)[2][2][4][2], const Unit& u, int wr, int wc, int fr, int fq, PG8_LAS unsigned char* lds, int wid, int lane) const {
        typedef float f32x2v __attribute__((ext_vector_type(2)));
        PG8_LAS f32x2v* P = (PG8_LAS f32x2v*)lds;
        PG8_LAS f32x2v* S = (PG8_LAS f32x2v*)(lds + 8192);
        PG8_LAS unsigned* flag = (PG8_LAS unsigned*)(lds + 8192 + 2048);
#pragma unroll
        for (int ai = 0; ai < 2; ++ai)
#pragma unroll
            for (int m = 0; m < 4; ++m) {
                float s = 0.f;
#pragma unroll
                for (int bj = 0; bj < 2; ++bj)
#pragma unroll
                    for (int n = 0; n < 2; ++n) { const f32x4 x = v[ai][bj][m][n]; s += (x[0] + x[1]) + (x[2] + x[3]); }
                s += __shfl_xor(s, 16); s += __shfl_xor(s, 32);
                const float mw = s * (1.0f / 64.0f); float q = 0.f;
#pragma unroll
                for (int bj = 0; bj < 2; ++bj)
#pragma unroll
                    for (int n = 0; n < 2; ++n) { const f32x4 d = v[ai][bj][m][n] - mw; q += (d[0] * d[0] + d[1] * d[1]) + (d[2] * d[2] + d[3] * d[3]); }
                q += __shfl_xor(q, 16); q += __shfl_xor(q, 32);
                if (fq == 0) P[(ai * HALF + wr * 64 + m * 16 + fr) * 4 + wc] = (f32x2v){mw, q};
            }
        asm volatile("s_waitcnt lgkmcnt(0)" ::: "memory"); __builtin_amdgcn_s_barrier(); asm volatile("" ::: "memory");
#if defined(BROKEN_NO_WAIT)
        if (blockIdx.x >= 64) { const long long t0 = clock64(); while (clock64() - t0 < 60000) __builtin_amdgcn_s_sleep(8); }
#endif
        const int row = wid * 32 + (lane & 31);
        if (lane < 32) {
            const f32x2v a = P[row * 4 + 0], b = P[row * 4 + 1], c = P[row * 4 + 2], d = P[row * 4 + 3];
            const float mt = (a.x + b.x + c.x + d.x) * 0.25f;
            const float da = a.x - mt, db = b.x - mt, dc = c.x - mt, dd = d.x - mt;
            const float m2 = (a.y + b.y) + (c.y + d.y) + 64.0f * ((da * da + db * db) + (dc * dc + dd * dd));
            unsigned long long* slot = (unsigned long long*)xbuf + ((size_t)(u.pm * BM + row) * 4 + u.pn);
            __hip_atomic_store(slot, ((unsigned long long)__float_as_uint(m2) << 32) | __float_as_uint(mt), __ATOMIC_RELAXED, __HIP_MEMORY_SCOPE_AGENT);
        }
        asm volatile("s_waitcnt vmcnt(0)" ::: "memory");
        if (lane == 0) __hip_atomic_fetch_add(cnt + 64 * u.pm, 1u, __ATOMIC_RELAXED, __HIP_MEMORY_SCOPE_AGENT);
        if (wid == 0) {
            bool dead = false; const unsigned long long t0 = __builtin_amdgcn_s_memrealtime(); const unsigned want = 8u * (unsigned)ntn;
            for (;;) {
#if defined(BROKEN_NO_WAIT)
                break;
#endif
                if ((unsigned)__builtin_amdgcn_readfirstlane(__hip_atomic_load(cnt + 64 * u.pm, __ATOMIC_RELAXED, __HIP_MEMORY_SCOPE_AGENT)) >= want) break;
                if (__builtin_amdgcn_s_memrealtime() - t0 > 2000000ull) {
                    if (lane == 0) { unsigned expect = 0u; __hip_atomic_compare_exchange_strong(tmo + 1, &expect, code | (unsigned)(u.pm & 0xff), __ATOMIC_RELAXED, __ATOMIC_RELAXED, __HIP_MEMORY_SCOPE_AGENT);
                                     __hip_atomic_store(tmo, 1u, __ATOMIC_RELAXED, __HIP_MEMORY_SCOPE_AGENT); }
                    dead = true; break; }
                __builtin_amdgcn_s_sleep(2);
            }
            __builtin_amdgcn_fence(__ATOMIC_ACQUIRE, "agent");
            if (lane == 0) flag[0] = dead ? 1u : 0u;
        }
        asm volatile("s_waitcnt vmcnt(0) lgkmcnt(0)" ::: "memory"); __builtin_amdgcn_s_barrier(); asm volatile("" ::: "memory");
        const bool bad = flag[0] != 0u;
        if (lane < 32) {
            const unsigned long long* slot = (const unsigned long long*)xbuf + (size_t)(u.pm * BM + row) * 4; float mt[4], m2[4]; float ms = 0.f;
#pragma unroll
            for (int t = 0; t < 4; ++t) { if (t < ntn) { const unsigned long long w = __hip_atomic_load(slot + t, __ATOMIC_RELAXED, __HIP_MEMORY_SCOPE_AGENT); mt[t] = __uint_as_float((unsigned)w); m2[t] = __uint_as_float((unsigned)(w >> 32)); } else { mt[t] = 0.f; m2[t] = 0.f; } ms += mt[t]; }
            const float mean = ms / (float)ntn; float q = 0.f;
#pragma unroll
            for (int t = 0; t < 4; ++t) if (t < ntn) { const float dm = mt[t] - mean; q += m2[t] + 256.0f * dm * dm; }
            S[row] = (f32x2v){mean, 1.0f / sqrtf(q / (256.0f * (float)ntn) + eps)};
        }
        asm volatile("s_waitcnt lgkmcnt(0)" ::: "memory"); __builtin_amdgcn_s_barrier(); asm volatile("" ::: "memory");
        return bad;
    }
};
struct EpiLnRes {
    static constexpr bool PERM = false, AFTER_DRAIN = true;
    const float* base; float* out; int ldc; const float* bias; PanelStats st; unsigned poison;
    __device__ __forceinline__ void refuse(size_t i0, size_t stride, int M, int N) const { const float q = __builtin_nanf(""); for (size_t i = i0; i < (size_t)M * N; i += stride) out[(i / N) * ldc + i % N] = q;
        if (i0 == 0) { unsigned expect = 0u; __hip_atomic_compare_exchange_strong(st.tmo + 1, &expect, 0x7f0u, __ATOMIC_RELAXED, __ATOMIC_RELAXED, __HIP_MEMORY_SCOPE_AGENT); __hip_atomic_store(st.tmo, 1u, __ATOMIC_RELAXED, __HIP_MEMORY_SCOPE_AGENT); } }
    __device__ __forceinline__ void fused(f32x4 (&acc)[2][2][4][2], const Unit& u, int wr, int wc, int fr, int fq, PG8_LAS unsigned char* lds, int wid, int lane) const {
        typedef float f32x2v __attribute__((ext_vector_type(2)));
        const PG8_LAS f32x2v* S = (const PG8_LAS f32x2v*)(lds + 8192);
        const int col0 = u.pn * BM + wc * 32 + 4 * fq;
#pragma unroll
        for (int bj = 0; bj < 2; ++bj)
#pragma unroll
            for (int n = 0; n < 2; ++n) { const f32x4 bv = bias ? *(const f32x4*)(bias + col0 + bj * HALF + n * 16) : (f32x4){0.f, 0.f, 0.f, 0.f};
#pragma unroll
                for (int ai = 0; ai < 2; ++ai)
#pragma unroll
                    for (int m = 0; m < 4; ++m) acc[ai][bj][m][n] += bv; }
        const bool bad = st.run(acc, u, wr, wc, fr, fq, lds, wid, lane) || poison != 0u;
        const float qnan = __builtin_nanf("");
#pragma unroll
        for (int ai = 0; ai < 2; ++ai)
#pragma unroll
            for (int m = 0; m < 4; ++m) { const int r = ai * HALF + wr * 64 + m * 16 + fr; const f32x2v sr = S[r]; const size_t off = (size_t)(u.pm * BM + r) * ldc + col0;
#pragma unroll
                for (int bj = 0; bj < 2; ++bj)
#pragma unroll
                    for (int n = 0; n < 2; ++n) { const f32x4 bs = *(const f32x4*)(base + off + bj * HALF + n * 16); f32x4 o = bs + (acc[ai][bj][m][n] - sr.x) * sr.y;
                        if (bad) o = (f32x4){qnan, qnan, qnan, qnan}; *(f32x4*)(out + off + bj * HALF + n * 16) = o; }
                asm volatile("" ::: "memory"); }
    }
};
struct EpiLnResLn {
    static constexpr bool PERM = false, AFTER_DRAIN = true;
    const float* base; float* out; bf16_t* xn; int ldc; const float* bias; PanelStats st1, st2; unsigned poison;
    __device__ __forceinline__ void refuse(size_t i0, size_t stride, int M, int N) const { const float q = __builtin_nanf(""); for (size_t i = i0; i < (size_t)M * N; i += stride) { const size_t o = (i / N) * ldc + i % N; out[o] = q; xn[o] = (bf16_t)0x7fc0u; }
        if (i0 == 0) { unsigned expect = 0u; __hip_atomic_compare_exchange_strong(st1.tmo + 1, &expect, 0x7f0u, __ATOMIC_RELAXED, __ATOMIC_RELAXED, __HIP_MEMORY_SCOPE_AGENT); __hip_atomic_store(st1.tmo, 1u, __ATOMIC_RELAXED, __HIP_MEMORY_SCOPE_AGENT); } }
    __device__ __forceinline__ void fused(f32x4 (&acc)[2][2][4][2], const Unit& u, int wr, int wc, int fr, int fq, PG8_LAS unsigned char* lds, int wid, int lane) const {
        typedef float f32x2v __attribute__((ext_vector_type(2))); typedef unsigned u32x2v __attribute__((ext_vector_type(2)));
        const PG8_LAS f32x2v* S = (const PG8_LAS f32x2v*)(lds + 8192);
        const int col0 = u.pn * BM + wc * 32 + 4 * fq;
#pragma unroll
        for (int bj = 0; bj < 2; ++bj)
#pragma unroll
            for (int n = 0; n < 2; ++n) { const f32x4 bv = bias ? *(const f32x4*)(bias + col0 + bj * HALF + n * 16) : (f32x4){0.f, 0.f, 0.f, 0.f};
#pragma unroll
                for (int ai = 0; ai < 2; ++ai)
#pragma unroll
                    for (int m = 0; m < 4; ++m) acc[ai][bj][m][n] += bv; }
        bool bad = st1.run(acc, u, wr, wc, fr, fq, lds, wid, lane) || poison != 0u;
        const float qnan = __builtin_nanf("");
#pragma unroll
        for (int ai = 0; ai < 2; ++ai)
#pragma unroll
            for (int m = 0; m < 4; ++m) { const int r = ai * HALF + wr * 64 + m * 16 + fr; const f32x2v sr = S[r]; const size_t off = (size_t)(u.pm * BM + r) * ldc + col0;
#pragma unroll
                for (int bj = 0; bj < 2; ++bj)
#pragma unroll
                    for (int n = 0; n < 2; ++n) { const f32x4 bs = *(const f32x4*)(base + off + bj * HALF + n * 16); acc[ai][bj][m][n] = bs + (acc[ai][bj][m][n] - sr.x) * sr.y; }
                asm volatile("" : "+v"(acc[ai][0][m][0]), "+v"(acc[ai][0][m][1]), "+v"(acc[ai][1][m][0]), "+v"(acc[ai][1][m][1]));
                if (m & 1) asm volatile("" ::: "memory"); }
        const bool bad1 = bad;
        bad = st2.run(acc, u, wr, wc, fr, fq, lds, wid, lane) || bad;
#pragma unroll
        for (int ai = 0; ai < 2; ++ai)
#pragma unroll
            for (int m = 0; m < 4; ++m) { const int r = ai * HALF + wr * 64 + m * 16 + fr; const f32x2v sr = S[r]; const size_t off = (size_t)(u.pm * BM + r) * ldc + col0;
#pragma unroll
                for (int bj = 0; bj < 2; ++bj)
#pragma unroll
                    for (int n = 0; n < 2; ++n) { const f32x4 x1 = acc[ai][bj][m][n]; *(f32x4*)(out + off + bj * HALF + n * 16) = bad1 ? (f32x4){qnan, qnan, qnan, qnan} : x1;
                        const f32x4 o = (x1 - sr.x) * sr.y; u32x2v w; w.x = cvt_pk_bf16(o[0], o[1]); w.y = cvt_pk_bf16(o[2], o[3]);
                        if (bad) { w.x = 0x7fc07fc0u; w.y = 0x7fc07fc0u; } *(u32x2v*)(xn + off + bj * HALF + n * 16) = w; }
                asm volatile("" ::: "memory"); }
    }
};

template <class Epi, class Sched, bool STAMP = false>
__device__ __forceinline__ void gemm_phase(PG8_LAS unsigned char* lds, const Gemm g, const Sched& S, const Epi& E, unsigned long long* stamps) {
    int tid_ = threadIdx.x; asm volatile("" : "+v"(tid_));
    const int tid = tid_, wid = __builtin_amdgcn_readfirstlane(tid >> 6), lane = tid & 63, wr = wid >> 2, wc = wid & 3, fr = lane & 15, fq = lane >> 4;
    const int K = g.K, nt = K / BK;
    int ts_lo = 0, ts_hi = 0, nts = 0; const unsigned long long rt_entry = STAMP ? (unsigned long long)wall_clock64() : 0ull;
#define PG8_STAMP() do { if (STAMP && wid == 0 && nts < 64) { const unsigned long long _c = (unsigned long long)clock64(); \
        ts_lo = (lane == nts) ? (int)(unsigned)_c : ts_lo; ts_hi = (lane == nts) ? (int)(unsigned)(_c >> 32) : ts_hi; ++nts; } } while (0)
    PG8_STAMP();
    unsigned voffA[2], voffB[2];
#pragma unroll
    for (int i = 0; i < 2; ++i) { int R, C; stage_rc(tid * 16 + i * 8192, R, C); const int Rb = Epi::PERM ? ((R & ~31) + perm32(R & 31)) : R;
        voffA[i] = (unsigned)(R * K + C) * 2u; voffB[i] = (unsigned)(Rb * K + C) * 2u; }
    const size_t kstep = (size_t)(BK * 2);
    const size_t hstep = (size_t)HALF * K * 2;
    const size_t tstep = 2 * hstep;
    const unsigned ldsw = (unsigned)wid * 1024u;
    const int aoff = lds_byte(wr * 64 + fr, fq * 8), boff = lds_byte(wc * 32 + fr, fq * 8);
#define PG8_SA(b, h) (((b) * 2 + (h)) * HTB)
#define PG8_SB(b, h) ((4 + (b) * 2 + (h)) * HTB)
#define PG8_STAGE(bufoff, gbase, voff) do { _Pragma("unroll") for (int _i = 0; _i < 2; ++_i) \
        __builtin_amdgcn_global_load_lds((const unsigned*)((const char*)(gbase) + (voff)[_i]), (PG8_LAS unsigned*)(lds + (bufoff) + ldsw + _i * 8192), 16, 0, 0); } while (0)
#define PG8_LDA(dst, b, h) do { _Pragma("unroll") for (int m = 0; m < 4; ++m) _Pragma("unroll") for (int k = 0; k < 2; ++k) dst[m][k] = *(const PG8_LAS bf16x8*)(lds + PG8_SA(b, h) + aoff + m * 2048 + k * 1024); } while (0)
#define PG8_LDB(dst, b, h) do { _Pragma("unroll") for (int n = 0; n < 2; ++n) _Pragma("unroll") for (int k = 0; k < 2; ++k) dst[n][k] = *(const PG8_LAS bf16x8*)(lds + PG8_SB(b, h) + boff + n * 2048 + k * 1024); } while (0)
#define PG8_MMA(ai, bj, At, Bt) do { __builtin_amdgcn_s_setprio(1); _Pragma("unroll") for (int m = 0; m < 4; ++m) _Pragma("unroll") for (int n = 0; n < 2; ++n) _Pragma("unroll") for (int k = 0; k < 2; ++k) \
        acc[ai][bj][m][n] = __builtin_amdgcn_mfma_f32_16x16x32_bf16(Bt[n][k], At[m][k], acc[ai][bj][m][n], 0, 0, 0); __builtin_amdgcn_s_setprio(0); } while (0)
#define PG8_WAIT_V(n) asm volatile("s_waitcnt vmcnt(" #n ")" ::: "memory")
#define PG8_WAIT_L(n) asm volatile("s_waitcnt lgkmcnt(" #n ")" ::: "memory")
#define PG8_BAR __builtin_amdgcn_s_barrier()
#define PG8_SCHED __builtin_amdgcn_sched_barrier(0)
    Unit cur, nxt; int ui = 0;
    if (!S.next(0, cur)) return;
    f32x4 acc[2][2][4][2];
#pragma unroll
    for (int a = 0; a < 2; ++a)
#pragma unroll
        for (int b = 0; b < 2; ++b)
#pragma unroll
            for (int m = 0; m < 4; ++m)
#pragma unroll
                for (int n = 0; n < 2; ++n) acc[a][b][m][n] = (f32x4){0.f, 0.f, 0.f, 0.f};
    bf16x8 At[4][2], B0[2][2], B1[2][2];
    const char* cA = (const char*)g.A + (size_t)cur.pm * tstep; const char* cB = (const char*)g.Bt + (size_t)cur.pn * tstep;
    S.a_ready(cur);
    PG8_STAGE(PG8_SB(0, 0), cB, voffB); PG8_STAGE(PG8_SA(0, 0), cA, voffA); PG8_STAGE(PG8_SB(0, 1), cB + hstep, voffB); PG8_STAGE(PG8_SA(0, 1), cA + hstep, voffA);
    if (wr == 1) PG8_BAR;
    PG8_WAIT_V(4); PG8_BAR;
    PG8_STAGE(PG8_SB(1, 0), cB + kstep, voffB); PG8_STAGE(PG8_SA(1, 0), cA + kstep, voffA); PG8_STAGE(PG8_SB(1, 1), cB + hstep + kstep, voffB);
    PG8_WAIT_V(6); PG8_BAR;
    PG8_STAMP();
    for (;;) {
        const bool has_next = S.next(ui + 1, nxt);
        const char* nA = has_next ? (const char*)g.A + (size_t)nxt.pm * tstep : cA; const char* nB = has_next ? (const char*)g.Bt + (size_t)nxt.pn * tstep : cB;
        for (int t = 0; t < nt; t += 2) {
            const bool last = (t == nt - 2);
            const char* a1 = cA + (size_t)(t + 1) * kstep;
            const char* a2 = last ? nA : cA + (size_t)(t + 2) * kstep; const char* b2 = last ? nB : cB + (size_t)(t + 2) * kstep;
            const char* a3 = a2 + kstep; const char* b3 = b2 + kstep;
            if (last && has_next) S.a_ready(nxt);
            PG8_LDB(B0, 0, 0); PG8_SCHED; PG8_LDA(At, 0, 0); PG8_STAGE(PG8_SA(1, 1), a1 + hstep, voffA);
            PG8_WAIT_L(8); PG8_BAR; PG8_WAIT_L(0); PG8_MMA(0, 0, At, B0); PG8_BAR; PG8_SCHED;
            PG8_LDB(B1, 0, 1); PG8_STAGE(PG8_SB(0, 0), b2, voffB);
            PG8_BAR; PG8_WAIT_L(0); PG8_MMA(0, 1, At, B1); PG8_BAR;
            PG8_LDA(At, 0, 1); PG8_STAGE(PG8_SA(0, 0), a2, voffA);
            PG8_BAR; PG8_WAIT_L(0); PG8_MMA(1, 0, At, B0); PG8_BAR; PG8_SCHED;
            PG8_STAGE(PG8_SB(0, 1), b2 + hstep, voffB);
            PG8_WAIT_V(6); PG8_BAR; PG8_MMA(1, 1, At, B1); PG8_BAR;
            PG8_LDB(B0, 1, 0); PG8_SCHED; PG8_LDA(At, 1, 0); PG8_STAGE(PG8_SA(0, 1), a2 + hstep, voffA);
            PG8_WAIT_L(8); PG8_BAR; PG8_WAIT_L(0); PG8_MMA(0, 0, At, B0); PG8_BAR; PG8_SCHED;
            PG8_LDB(B1, 1, 1); PG8_STAGE(PG8_SB(1, 0), b3, voffB);
            PG8_BAR; PG8_WAIT_L(0); PG8_MMA(0, 1, At, B1); PG8_BAR;
            PG8_LDA(At, 1, 1); PG8_STAGE(PG8_SA(1, 0), a3, voffA);
            PG8_BAR; PG8_WAIT_L(0); PG8_MMA(1, 0, At, B0); PG8_BAR; PG8_SCHED;
            PG8_STAGE(PG8_SB(1, 1), b3 + hstep, voffB);
            PG8_WAIT_V(6); PG8_BAR; PG8_MMA(1, 1, At, B1); PG8_BAR;
        }
        PG8_STAMP();
        if constexpr (!Epi::AFTER_DRAIN) { E(acc, cur, wr, wc, fr, fq); S.done(cur); }
        PG8_STAMP();
        if (!has_next) break;
#pragma unroll
        for (int a = 0; a < 2; ++a)
#pragma unroll
            for (int b = 0; b < 2; ++b)
#pragma unroll
                for (int m = 0; m < 4; ++m)
#pragma unroll
                    for (int n = 0; n < 2; ++n) acc[a][b][m][n] = (f32x4){0.f, 0.f, 0.f, 0.f};
        cur = nxt; cA = nA; cB = nB; ++ui;
    }
    PG8_WAIT_V(0);
    if (wr == 0) PG8_BAR;
    PG8_BAR;
    if constexpr (Epi::AFTER_DRAIN) { E.fused(acc, cur, wr, wc, fr, fq, lds, wid, lane); S.done(cur); }
    PG8_STAMP();
    if (STAMP && wid == 0) { stamps[lane] = lane < nts ? (((unsigned long long)(unsigned)ts_hi << 32) | (unsigned)ts_lo) : 0ull;
        if (lane == 62) stamps[62] = rt_entry; if (lane == 63) stamps[63] = (unsigned long long)wall_clock64(); }
#undef PG8_STAMP
#undef PG8_SA
#undef PG8_SB
#undef PG8_STAGE
#undef PG8_LDA
#undef PG8_LDB
#undef PG8_MMA
#undef PG8_WAIT_V
#undef PG8_WAIT_L
#undef PG8_BAR
#undef PG8_SCHED
}
}

namespace pg8 {
__device__ __forceinline__ float fast_sigmoid(float x) { return __builtin_amdgcn_rcpf(1.0f + __builtin_amdgcn_exp2f(-1.44269504089f * x)); }
struct EpiSwiGLU {
    static constexpr bool PERM = true, AFTER_DRAIN = false;
    bf16_t* H; int ldh;
    __device__ __forceinline__ void operator()(const f32x4 (&acc)[2][2][4][2], const Unit& u, int wr, int wc, int fr, int fq) const {
        const int row0 = u.pm * BM + wr * 64 + fr, hc0 = u.pn * 128 + wc * 32 + 8 * fq;
#pragma unroll
        for (int ai = 0; ai < 2; ++ai)
#pragma unroll
            for (int m = 0; m < 4; ++m) {
                bf16_t* rowp = H + (size_t)(row0 + ai * HALF + m * 16) * ldh + hc0;
                float v[8];
#pragma unroll
                for (int n = 0; n < 2; ++n)
#pragma unroll
                    for (int j = 0; j < 4; ++j) { const float g = acc[ai][0][m][n][j], up = acc[ai][1][m][n][j]; v[n * 4 + j] = g * fast_sigmoid(g) * up; }
                u32x4 w; w.x = cvt_pk_bf16(v[0], v[1]); w.y = cvt_pk_bf16(v[2], v[3]); w.z = cvt_pk_bf16(v[4], v[5]); w.w = cvt_pk_bf16(v[6], v[7]);
                *(u32x4*)rowp = w;
            }
    }
};
struct EpiResid {
    static constexpr bool PERM = false, AFTER_DRAIN = false;
    float* X; int ldc; float alpha; const float* Xsrc;
    __device__ __forceinline__ void operator()(const f32x4 (&acc)[2][2][4][2], const Unit& u, int wr, int wc, int fr, int fq) const {
        const int row0 = u.pm * BM + wr * 64 + fr, col0 = u.pn * BM + wc * 32 + 4 * fq;
#pragma unroll
        for (int ai = 0; ai < 2; ++ai)
#pragma unroll
            for (int m = 0; m < 4; ++m) { const size_t ro = (size_t)(row0 + ai * HALF + m * 16) * ldc + col0;
#pragma unroll
                for (int bj = 0; bj < 2; ++bj)
#pragma unroll
                    for (int n = 0; n < 2; ++n) { const f32x4 old = *(const f32x4*)(Xsrc + ro + bj * HALF + n * 16); *(f32x4*)(X + ro + bj * HALF + n * 16) = old + acc[ai][bj][m][n] * alpha; } }
    }
};
struct EpiWin {
    static constexpr bool PERM = true, AFTER_DRAIN = false;
    unsigned char* zbase; const float* bias; float* small_out;
    __device__ __forceinline__ void operator()(const f32x4 (&acc)[2][2][4][2], const Unit& u, int wr, int wc, int fr, int fq) const {
        const int row0 = u.pm * BM + wr * 64 + fr; const int pn = u.pn;
        const int bcol0 = pn * BM + wc * 32 + 8 * fq;
        f32x4 bv[2][2];
#pragma unroll
        for (int bj = 0; bj < 2; ++bj)
#pragma unroll
            for (int n = 0; n < 2; ++n) bv[bj][n] = *(const f32x4*)(bias + bcol0 + bj * HALF + 4 * n);
        if (pn == 17) {
            if (wc < 2) {
#pragma unroll
                for (int ai = 0; ai < 2; ++ai)
#pragma unroll
                    for (int m = 0; m < 4; ++m) { float* rowp = small_out + (size_t)(row0 + ai * HALF + m * 16) * 64 + wc * 32 + 8 * fq;
#pragma unroll
                        for (int n = 0; n < 2; ++n) *(f32x4*)(rowp + 4 * n) = acc[ai][0][m][n] + bv[0][n]; }
            }
            return;
        }
        size_t base; int ld, c0;
        if (pn < 8) { base = (size_t)(pn >> 1) * ((size_t)T * 512 * 2); ld = 512; c0 = (pn & 1) * 256; }
        else if (pn < 11) { base = (size_t)4 * T * 512 * 2 + (size_t)(pn - 8) * ((size_t)T * 256 * 2); ld = 256; c0 = 0; }
        else { base = (size_t)4 * T * 512 * 2 + (size_t)3 * T * 256 * 2 + (size_t)((pn - 11) >> 1) * ((size_t)T * 512 * 2); ld = 512; c0 = ((pn - 11) & 1) * 256; }
        bf16_t* O = (bf16_t*)(zbase + base);
        const int col0 = c0 + wc * 32 + 8 * fq;
#pragma unroll
        for (int ai = 0; ai < 2; ++ai)
#pragma unroll
            for (int m = 0; m < 4; ++m) { bf16_t* rowp = O + (size_t)(row0 + ai * HALF + m * 16) * ld + col0;
#pragma unroll
                for (int bj = 0; bj < 2; ++bj) { const f32x4 v0 = acc[ai][bj][m][0] + bv[bj][0], v1 = acc[ai][bj][m][1] + bv[bj][1];
                    u32x4 w; w.x = cvt_pk_bf16(v0[0], v0[1]); w.y = cvt_pk_bf16(v0[2], v0[3]); w.z = cvt_pk_bf16(v1[0], v1[1]); w.w = cvt_pk_bf16(v1[2], v1[3]);
                    *(u32x4*)(rowp + bj * HALF) = w; } }
    }
};
struct EpiGate {
    static constexpr bool PERM = true, AFTER_DRAIN = false;
    unsigned char* ws; int ldc; const float* bias;
    __device__ __forceinline__ void operator()(const f32x4 (&acc)[2][2][4][2], const Unit& u, int wr, int wc, int fr, int fq) const {
        const int br = u.pn >> 2;
        bf16_t* G = (bf16_t*)(ws + WS_G0 + (size_t)(br >= 1) * (WS_G1 - WS_G0) + (size_t)(br >= 2) * (WS_G2 - WS_G1));
        const int row0 = u.pm * BM + wr * 64 + fr, col0 = (u.pn & 3) * BM + wc * 32 + 8 * fq, bcol0 = u.pn * BM + wc * 32 + 8 * fq;
        f32x4 bv[2][2];
#pragma unroll
        for (int bj = 0; bj < 2; ++bj)
#pragma unroll
            for (int n = 0; n < 2; ++n) bv[bj][n] = *(const f32x4*)(bias + bcol0 + bj * HALF + 4 * n);
#pragma unroll
        for (int ai = 0; ai < 2; ++ai)
#pragma unroll
            for (int m = 0; m < 4; ++m) { bf16_t* rowp = G + (size_t)(row0 + ai * HALF + m * 16) * ldc + col0;
#pragma unroll
                for (int bj = 0; bj < 2; ++bj) { f32x4 v0 = acc[ai][bj][m][0] + bv[bj][0], v1 = acc[ai][bj][m][1] + bv[bj][1];
                    u32x4 w; w.x = cvt_pk_bf16(v0[0], v0[1]); w.y = cvt_pk_bf16(v0[2], v0[3]); w.z = cvt_pk_bf16(v1[0], v1[1]); w.w = cvt_pk_bf16(v1[2], v1[3]);
                    *(u32x4*)(rowp + bj * HALF) = w; } }
    }
};
struct EpiBranch {
    static constexpr bool PERM = true, AFTER_DRAIN = false;
    bf16_t* Y; const bf16_t* G; int ldc; int first;
    __device__ __forceinline__ void operator()(const f32x4 (&acc)[2][2][4][2], const Unit& u, int wr, int wc, int fr, int fq) const {
        const int row0 = u.pm * BM + wr * 64 + fr, col0 = u.pn * BM + wc * 32 + 8 * fq;
#pragma unroll
        for (int ai = 0; ai < 2; ++ai)
#pragma unroll
            for (int m = 0; m < 4; ++m) { const size_t off = (size_t)(row0 + ai * HALF + m * 16) * ldc + col0;
#pragma unroll
                for (int bj = 0; bj < 2; ++bj) {
                    const u32x4 g = *(const u32x4*)(G + off + bj * HALF);
                    u32x4 y = (u32x4){0u, 0u, 0u, 0u}; if (!first) y = *(const u32x4*)(Y + off + bj * HALF);
                    const f32x4 a0 = acc[ai][bj][m][0], a1 = acc[ai][bj][m][1];
                    float o[8];
#pragma unroll
                    for (int q = 0; q < 4; ++q) { const unsigned gw = g[q], yw = y[q]; const float al = q < 2 ? a0[2 * q] : a1[2 * q - 4], ah = q < 2 ? a0[2 * q + 1] : a1[2 * q - 3];
                        o[2 * q] = __builtin_bit_cast(float, yw << 16) + fast_sigmoid(__builtin_bit_cast(float, gw << 16)) * al;
                        o[2 * q + 1] = __builtin_bit_cast(float, yw & 0xffff0000u) + fast_sigmoid(__builtin_bit_cast(float, gw & 0xffff0000u)) * ah; }
                    u32x4 w; w.x = cvt_pk_bf16(o[0], o[1]); w.y = cvt_pk_bf16(o[2], o[3]); w.z = cvt_pk_bf16(o[4], o[5]); w.w = cvt_pk_bf16(o[6], o[7]);
                    if (first == 2) asm volatile("" :: "v"(w)); else *(u32x4*)(Y + off + bj * HALF) = w; } }
    }
};
}

constexpr int RING_BYTES = 131072;
constexpr int MISC_OFF = RING_BYTES + 320;
constexpr int LDS_BYTES = 147456;

__constant__ float ROPE_FREQ[32] = {
1.000000000e+00f, 7.498942614e-01f, 5.623413324e-01f, 4.216965139e-01f, 3.162277639e-01f, 2.371373773e-01f, 1.778279394e-01f, 1.333521307e-01f, 1.000000015e-01f, 7.498941571e-02f, 5.623413250e-02f, 4.216965288e-02f, 3.162277490e-02f, 2.371373773e-02f, 1.778279431e-02f, 1.333521493e-02f, 9.999999776e-03f, 7.498941850e-03f, 5.623413250e-03f, 4.216964822e-03f, 3.162277630e-03f, 2.371373586e-03f, 1.778279431e-03f, 1.333521446e-03f, 1.000000047e-03f, 7.498942432e-04f, 5.623413017e-04f, 4.216965172e-04f, 3.162277571e-04f, 2.371373703e-04f, 1.778279402e-04f, 1.333521504e-04f};

struct Args { const float* in[23]; float* out; unsigned char* ws; int ph_lo, ph_hi; };

struct Ctx {
    LAS unsigned char* lds;
    int tid, lane, wave, G, bid;
    __device__ __forceinline__ void launder() { asm volatile("" : "+v"(tid)); lane = tid & 63; asm volatile("" : "+s"(inp));
        GAS unsigned char* g = (GAS unsigned char*)ws; asm volatile("" : "+s"(g)); ws = (unsigned char*)g;
        GAS float* gx = (GAS float*)X; asm volatile("" : "+s"(gx)); X = (float*)gx; }
    const GAS float* const __attribute__((address_space(4)))* inp; float* X; unsigned char* ws;
    __device__ __forceinline__ const float* in(int k) const { return (const float*)inp[k]; }
};

__device__ __forceinline__ void transpose_item(const float* W, int ldw, int src_col0, bf16* WT, int K, int dst_row0, int kb, LAS float* scr, int lane) {
    const int k0 = 64 * kb;
#pragma unroll 8
    for (int i = 0; i < 32; ++i) { const int kk = 2 * i + (lane >> 5); scr[kk * 33 + (lane & 31)] = W[(size_t)(k0 + kk) * ldw + src_col0 + (lane & 31)]; }
    LDS_WAIT(); asm volatile("" ::: "memory");
    const int c = lane & 7;
#pragma unroll
    for (int j = 0; j < 4; ++j) { const int n = (lane >> 3) + 8 * j; const LAS float* s = scr + (8 * c) * 33 + n;
        v4u o; o.x = pk2(s[0 * 33], s[1 * 33]); o.y = pk2(s[2 * 33], s[3 * 33]); o.z = pk2(s[4 * 33], s[5 * 33]); o.w = pk2(s[6 * 33], s[7 * 33]);
        *(v4u*)(WT + (size_t)(dst_row0 + n) * K + k0 + 8 * c) = o; }
    LDS_WAIT(); asm volatile("" ::: "memory");
}
__device__ __forceinline__ int win_small_src(int i) { return i < 16 ? 1536 + i : i < 40 ? 2832 + (i - 16) : i < 44 ? 4392 + (i - 40) : i < 48 ? 4396 + (i - 44) : -1; }
__device__ __forceinline__ int win_src_col(int n) { return n < 1536 ? n : n < 2816 ? n + 16 : n < 4352 ? n + 40 : win_small_src(n - 4352); }

__device__ __forceinline__ void phase_prep_weights(const Ctx& C, int l) {
    LAS float* scr = (LAS float*)(C.lds + C.wave * 16384);
    const int gw = C.bid * NWAVES + C.wave, NGW = C.G * NWAVES;
    unsigned char* ws = C.ws;
    constexpr int I_GU = 16 * 88, I_DN = 44 * 32, I_WIN = 16 * 136, I_GT = 16 * 96, I_BR = 3 * 8 * 32, I_OUT = 16 * 32, I_C1 = 2 * 32 * 8, I_C2 = 2 * 4 * 2;
    constexpr int I_FFN = 2 * I_GU + I_DN;
    constexpr int NITEMS = 2 * I_FFN + I_WIN + I_GT + I_BR + I_OUT + I_C1 + I_C2;
    for (int it = gw; it < NITEMS; it += NGW) {
        int r = it;
        if (r < 2 * I_FFN) {
            const int f = r / I_FFN; r -= f * I_FFN;
            const float* wg = (f ? C.in(20) : C.in(2)) + (size_t)l * DM * DFF; const float* wu = (f ? C.in(21) : C.in(3)) + (size_t)l * DM * DFF; const float* wd = (f ? C.in(22) : C.in(4)) + (size_t)l * DFF * DM;
            bf16* WGU = (bf16*)(ws + (f ? WS_WGU2 : WS_WGU1)); bf16* WDN = (bf16*)(ws + (f ? WS_WDN2 : WS_WDN1));
            if (r < I_GU) { const int kb = r / 88, col = 32 * (r % 88); transpose_item(wg, DFF, col, WGU, DM, 256 * (col >> 7) + (col & 127), kb, scr, C.lane); }
            else if (r < 2 * I_GU) { r -= I_GU; const int kb = r / 88, col = 32 * (r % 88); transpose_item(wu, DFF, col, WGU, DM, 256 * (col >> 7) + 128 + (col & 127), kb, scr, C.lane); }
            else { r -= 2 * I_GU; const int kb = r / 32, col = 32 * (r % 32); transpose_item(wd, DM, col, WDN, DFF, col, kb, scr, C.lane); }
            continue;
        }
        r -= 2 * I_FFN;
        const float* win = C.in(6) + (size_t)l * DM * N_IN;
        if (r < I_WIN) { const int kb = r / 136, n = 32 * (r % 136); transpose_item(win, N_IN, win_src_col(n), (bf16*)(ws + WS_WIN), DM, n, kb, scr, C.lane); continue; } r -= I_WIN;
        if (r < I_GT) { const int kb = r / 96, n = 32 * (r % 96); transpose_item(win, N_IN, 4400 + n, (bf16*)(ws + WS_WGT), DM, n, kb, scr, C.lane); continue; } r -= I_GT;
        if (r < I_BR) { const int i = r / 256, rr = r % 256, kb = rr / 32, n = 32 * (rr % 32);
            transpose_item(C.in(17) + ((size_t)l * 3 + i) * 512 * DM, DM, n, (bf16*)(ws + WS_WBR) + (size_t)i * DM * 512, 512, n, kb, scr, C.lane); continue; } r -= I_BR;
        if (r < I_OUT) { const int kb = r / 32, n = 32 * (r % 32); transpose_item(C.in(18) + (size_t)l * DM * DM, DM, n, (bf16*)(ws + WS_WOUT), DM, n, kb, scr, C.lane); continue; } r -= I_OUT;
        if (r < I_C1) { const int kv = r / 256, rr = r % 256, kb = rr / 8, n = 32 * (rr % 8);
            transpose_item(C.in(13) + ((size_t)l * 2 + kv) * 2048 * 256, 256, n, (bf16*)(ws + WS_CW1) + (size_t)kv * 256 * 2048, 2048, n, kb, scr, C.lane); continue; } r -= I_C1;
        { const int kv = r / 8, rr = r % 8, kb = rr / 2, n = 32 * (rr % 2);
            transpose_item(C.in(14) + ((size_t)l * 2 + kv) * 256 * 64, 64, n, (bf16*)(ws + WS_CW2) + (size_t)kv * 64 * 256, 256, n, kb, scr, C.lane); }
    }
    const int gt = C.bid * NTHR + C.tid, NGT = C.G * NTHR;
    {
        const float* win = C.in(6) + (size_t)l * DM * N_IN; bf16* WIN = (bf16*)(ws + WS_WIN);
        for (int idx = gt; idx < 256 * 128; idx += NGT) { const int i = idx & 255, kc = idx >> 8; const int sc = win_small_src(i);
            v4u o = (v4u){0u, 0u, 0u, 0u};
            if (sc >= 0) { float v[8];
#pragma unroll
                for (int j = 0; j < 8; ++j) v[j] = win[(size_t)(kc * 8 + j) * N_IN + sc];
                o.x = pk2(v[0], v[1]); o.y = pk2(v[2], v[3]); o.z = pk2(v[4], v[5]); o.w = pk2(v[6], v[7]); }
            *(v4u*)(WIN + (size_t)(4352 + i) * DM + kc * 8) = o; }
        float* vec = (float*)(ws + WS_VEC); const float* bin = C.in(7) + (size_t)l * N_IN;
        for (int n = gt; n < 4608; n += NGT) { const int sc = win_src_col(n); vec[VEC_BINP + n] = sc >= 0 ? bin[sc] : 0.f; }
        for (int it = gw; it < 512; it += NGW) { const int kv = it >> 8, n = it & 255;
            const float* pe = C.in(12) + ((size_t)l * 2 + kv) * 2048; const float* w1 = C.in(13) + ((size_t)l * 2 + kv) * 2048 * 256;
            float s = 0.f;
            for (int k = C.lane; k < 2048; k += 64) s += pe[k] * w1[(size_t)k * 256 + n];
            s = wave_sum(s);
            if (C.lane == 0) vec[VEC_CB1 + it] = s; }
    }
}

__device__ __forceinline__ void phase_init(const Ctx& C) {
    const int gt = C.bid * NTHR + C.tid, NGT = C.G * NTHR;
    f32x2* rope = (f32x2*)(C.ws + WS_ROPE);
    for (int i = gt; i < SEQ * 32; i += NGT) { const int pos = i >> 5, fi = i & 31;
        const float ang = (float)pos * ROPE_FREQ[fi];
        double rev = (double)ang * 0.15915494309189533577; rev -= floor(rev);
        const float rf = (float)rev;
        rope[i] = (f32x2){__builtin_amdgcn_cosf(rf), __builtin_amdgcn_sinf(rf)}; }
}

__device__ __forceinline__ void phase_norm(const Ctx& C, const float* gain, const float* Xsrc) {
    const int gw = C.bid * NWAVES + C.wave, NGW = C.G * NWAVES;
    bf16* XN = (bf16*)(C.ws + WS_XN);
    f32x4 g[4];
#pragma unroll
    for (int j = 0; j < 4; ++j) g[j] = ((const f32x4*)gain)[C.lane + 64 * j];
    for (int m = gw; m < T; m += NGW) {
        const f32x4* xr = (const f32x4*)(Xsrc + (size_t)m * DM) + C.lane;
        f32x4 v[4]; float s = 0.f;
#pragma unroll
        for (int j = 0; j < 4; ++j) { v[j] = xr[64 * j]; s += (v[j].x * v[j].x + v[j].y * v[j].y) + (v[j].z * v[j].z + v[j].w * v[j].w); }
        const float r = 1.0f / sqrtf(wave_sum(s) * (1.f / DM) + RMS_EPS);
        unsigned long long* o8 = (unsigned long long*)(XN + (size_t)m * DM) + C.lane;
#pragma unroll
        for (int j = 0; j < 4; ++j) { const f32x4 w = v[j] * r * g[j]; o8[64 * j] = (unsigned long long)pk2(w.x, w.y) | ((unsigned long long)pk2(w.z, w.w) << 32); }
    }
}

template <int KSTEPS, class PA, class PB>
__device__ __forceinline__ f32x4 mma_tile(PA A, int lda, PB Bt, int ldb, f32x4 acc, int lane) {
    const int r = lane & 15, q = lane >> 4;
#pragma unroll
    for (int kk = 0; kk < KSTEPS; ++kk) {
        const bf16x8 a = *(const bf16x8*)(A + r * lda + kk * 32 + 8 * q);
        const bf16x8 b = *(const bf16x8*)(Bt + r * ldb + kk * 32 + 8 * q);
        acc = __builtin_amdgcn_mfma_f32_16x16x32_bf16(a, b, acc, 0, 0, 0);
    }
    return acc;
}
__device__ __forceinline__ float wave_scan_sum(float v, int lane) {
#pragma unroll
    for (int o = 1; o < 64; o <<= 1) { const float t = __shfl_up(v, o); if (lane >= o) v += t; }
    return v;
}
__device__ __forceinline__ float wave_scan_max(float v, int lane) {
#pragma unroll
    for (int o = 1; o < 64; o <<= 1) { const float t = __shfl_up(v, o); if (lane >= o) v = fmaxf(v, t); }
    return v;
}

__device__ __forceinline__ void lds_frag2(const LAS bf16* tile, int row0, int lane, bf16x8 (&f)[2]) {
    const LAS bf16* p = tile + (row0 + (lane & 15)) * 72 + 8 * (lane >> 4);
    f[0] = *(const LAS bf16x8*)p; f[1] = *(const LAS bf16x8*)(p + 32);
}
constexpr int CU_ALR = 0;
constexpr int CU_GT = 4096;
constexpr int CU_VEC = 6144;
constexpr int CU_KT = 8192;
constexpr int CU_VT = 17408;
constexpr int CU_Q = 35840;
constexpr int CU_AT = 45056;
constexpr int CU_O = 54272;
constexpr int CU_END = 88064;
constexpr int CU_WA = 110592;

__device__ __forceinline__ void load_vt(const Ctx& C, const bf16* V, int t0, int h) {
    LAS bf16* VT = (LAS bf16*)(C.lds + CU_VT);
    const int dv = C.tid & 127, jq = C.tid >> 7;
    const bf16* src = V + (size_t)(t0 + 16 * jq) * 512 + h * 128 + dv;
    unsigned w[8];
#pragma unroll
    for (int jj = 0; jj < 8; ++jj) { const unsigned lo = src[(size_t)(2 * jj) * 512], hi = src[(size_t)(2 * jj + 1) * 512]; w[jj] = lo | (hi << 16); }
    *(LAS v4u*)(VT + dv * 72 + 16 * jq) = (v4u){w[0], w[1], w[2], w[3]};
    *(LAS v4u*)(VT + dv * 72 + 16 * jq + 8) = (v4u){w[4], w[5], w[6], w[7]};
}

__device__ __forceinline__ void gla_stage_alpha(const Ctx& C, int l) {
    LAS float* WA = (LAS float*)(C.lds + CU_WA);
    const float* wa = C.in(8) + (size_t)l * 16 * 256; const float* ba = C.in(9) + (size_t)l * 256;
    for (int i = C.tid; i < 16 * 256 + 256; i += NTHR) WA[i] = i < 4096 ? wa[i] : ba[i - 4096];
}
__device__ __forceinline__ float gla_cumsum(const Ctx& C, int l, int t0, int h, float (&b)[8]) {
    LAS float* ALR = (LAS float*)(C.lds + CU_ALR); LAS float* GT = (LAS float*)(C.lds + CU_GT);
    const float* SMALL = (const float*)(C.ws + WS_SMALL);
    if (C.tid < 256) { const int j = C.tid >> 2, c4 = C.tid & 3; *(LAS f32x4*)(ALR + j * 16 + 4 * c4) = *(const f32x4*)(SMALL + (size_t)(t0 + j) * 64 + 4 * c4); }
    const int dk = C.tid & 63, jg = C.tid >> 6;
    const LAS float* WA = (const LAS float*)(C.lds + CU_WA) + h * 64 + dk; (void)l;
    __syncthreads();
    float w[16];
#pragma unroll
    for (int r = 0; r < 16; ++r) w[r] = WA[r * 256];
    const float ba = WA[16 * 256];
    float run = 0.f;
#pragma unroll
    for (int jj = 0; jj < 8; ++jj) { const int j = 8 * jg + jj; float x = ba;
#pragma unroll
        for (int r = 0; r < 16; ++r) x += ALR[j * 16 + r] * w[r];
        run += logsigmoidf_(x) * (1.0f / 16.0f); b[jj] = run; }
    GT[jg * 64 + dk] = run;
    __syncthreads();
    float pre = 0.f, tot = 0.f;
#pragma unroll
    for (int g2 = 0; g2 < 8; ++g2) { const float v = GT[g2 * 64 + dk]; tot += v; if (g2 < jg) pre += v; }
#pragma unroll
    for (int jj = 0; jj < 8; ++jj) b[jj] += pre;
    return tot;
}

__device__ __forceinline__ void gla_unit_a(const Ctx& C, int l, int ci) {
    const int bh = ci >> 8, c = ci & 255, bb = bh >> 2, h = bh & 3, t0 = bb * SEQ + c * 64;
    const bf16* QKA = (const bf16*)(C.ws + WS_QKA);
    load_vt(C, (const bf16*)(C.ws + WS_VA), t0, h);
    const int dk = C.tid & 63, jg = C.tid >> 6;
    unsigned kraw[8];
#pragma unroll
    for (int jj = 0; jj < 8; ++jj) kraw[jj] = QKA[(size_t)(t0 + 8 * jg + jj) * 512 + 256 + h * 64 + dk];
    float b[8]; const float btot = gla_cumsum(C, l, t0, h, b);
    LAS bf16* KT = (LAS bf16*)(C.lds + CU_KT);
    float kd[8];
#pragma unroll
    for (int jj = 0; jj < 8; ++jj) { const float k = bf2f(kraw[jj]); kd[jj] = k * fexp(btot - b[jj]); }
    *(LAS v4u*)(KT + dk * 72 + 8 * jg) = (v4u){pk2(kd[0], kd[1]), pk2(kd[2], kd[3]), pk2(kd[4], kd[5]), pk2(kd[6], kd[7])};
    if (jg == 0) ((float*)(C.ws + WS_GDEC))[(size_t)ci * 64 + dk] = fexp(btot);
    __syncthreads();
    const LAS bf16* VT = (const LAS bf16*)(C.lds + CU_VT);
    bf16* GST = (bf16*)(C.ws + WS_GST) + (size_t)ci * 8192;
    const int q = C.lane >> 4, fr = C.lane & 15;
    {
        bf16x8 av[2], bk[4][2]; lds_frag2(VT, 16 * C.wave, C.lane, av);
#pragma unroll
        for (int nt = 0; nt < 4; ++nt) lds_frag2((const LAS bf16*)KT, 16 * nt, C.lane, bk[nt]);
        f32x4 acc[4];
#pragma unroll
        for (int nt = 0; nt < 4; ++nt) acc[nt] = __builtin_amdgcn_mfma_f32_16x16x32_bf16(av[0], bk[nt][0], (f32x4){0.f, 0.f, 0.f, 0.f}, 0, 0, 0);
#pragma unroll
        for (int nt = 0; nt < 4; ++nt) acc[nt] = __builtin_amdgcn_mfma_f32_16x16x32_bf16(av[1], bk[nt][1], acc[nt], 0, 0, 0);
#pragma unroll
        for (int nt = 0; nt < 4; ++nt)
#pragma unroll
            for (int r = 0; r < 4; ++r) GST[(16 * C.wave + 4 * q + r) * 64 + 16 * nt + fr] = (bf16)f2bf(acc[nt][r]);
    }
    __syncthreads();
}

__device__ __forceinline__ void gla_unit_c(const Ctx& C, int l, int ci, bool DRY) {
    const int bh = ci >> 8, c = ci & 255, bb = bh >> 2, h = bh & 3, t0 = bb * SEQ + c * 64;
    const bf16* QKA = (const bf16*)(C.ws + WS_QKA);
    load_vt(C, (const bf16*)(C.ws + WS_VA), t0, h);
    const int dk = C.tid & 63, jg = C.tid >> 6;
    unsigned qraw[8], kraw[8];
#pragma unroll
    for (int jj = 0; jj < 8; ++jj) { const bf16* p = QKA + (size_t)(t0 + 8 * jg + jj) * 512 + h * 64 + dk; qraw[jj] = p[0]; kraw[jj] = p[256]; }
    bf16x8 stf[4][2];
    { const bf16* ST = (const bf16*)(C.ws + WS_GST) + (size_t)ci * 8192 + (size_t)(16 * 4 * (C.wave >> 2) + (C.lane & 15)) * 64 + 8 * (C.lane >> 4);
#pragma unroll
      for (int u = 0; u < 4; ++u) { stf[u][0] = *(const bf16x8*)(ST + u * 16 * 64); stf[u][1] = *(const bf16x8*)(ST + u * 16 * 64 + 32); } }
    v4u ar0, ar1;
    { const bf16* RAp = (const bf16*)(C.ws + WS_RA) + (size_t)(t0 + (C.tid >> 3)) * 512 + h * 128 + 16 * (C.tid & 7); ar0 = *(const v4u*)RAp; ar1 = *(const v4u*)(RAp + 8); }
    float b[8]; (void)gla_cumsum(C, l, t0, h, b);
    LAS bf16* KT = (LAS bf16*)(C.lds + CU_KT); LAS bf16* QT = (LAS bf16*)(C.lds + CU_Q); LAS bf16* AT = (LAS bf16*)(C.lds + CU_AT);
#pragma unroll
    for (int jj = 0; jj < 8; ++jj) { const int j = 8 * jg + jj;
        const float qv = bf2f(qraw[jj]) * 0.125f, kv = bf2f(kraw[jj]);
        QT[j * 72 + dk] = (bf16)f2bf(qv * fexp(b[jj])); KT[j * 72 + dk] = (bf16)f2bf(kv * fexp(fminf(-b[jj], 80.f))); }
    __syncthreads();
    const int q = C.lane >> 4, fr = C.lane & 15;
    {
        const int it = C.wave >> 1;
        bf16x8 bq[2], ak[2][2]; lds_frag2((const LAS bf16*)QT, 16 * it, C.lane, bq);
#pragma unroll
        for (int u = 0; u < 2; ++u) lds_frag2((const LAS bf16*)KT, 16 * (2 * (C.wave & 1) + u), C.lane, ak[u]);
        f32x4 acc2[2];
#pragma unroll
        for (int u = 0; u < 2; ++u) acc2[u] = __builtin_amdgcn_mfma_f32_16x16x32_bf16(ak[u][0], bq[0], (f32x4){0.f, 0.f, 0.f, 0.f}, 0, 0, 0);
#pragma unroll
        for (int u = 0; u < 2; ++u) acc2[u] = __builtin_amdgcn_mfma_f32_16x16x32_bf16(ak[u][1], bq[1], acc2[u], 0, 0, 0);
#pragma unroll
        for (int u = 0; u < 2; ++u) { const int jt = 2 * (C.wave & 1) + u;
            const int i = 16 * it + fr;
            float v[4];
#pragma unroll
            for (int r = 0; r < 4; ++r) { const int j = 16 * jt + 4 * q + r; v[r] = (j <= i) ? acc2[u][r] : 0.f; }
            *(LAS v2u*)(AT + i * 72 + 16 * jt + 4 * q) = (v2u){pk2(v[0], v[1]), pk2(v[2], v[3])}; }
    }
    __syncthreads();
    {
        const int it = C.wave & 3; LAS float* O = (LAS float*)(C.lds + CU_O);
        const LAS bf16* VT = (const LAS bf16*)(C.lds + CU_VT);
        bf16x8 qa[2], aa[2], bv[4][2]; lds_frag2((const LAS bf16*)QT, 16 * it, C.lane, qa); lds_frag2((const LAS bf16*)AT, 16 * it, C.lane, aa);
#pragma unroll
        for (int u = 0; u < 4; ++u) lds_frag2(VT, 16 * (4 * (C.wave >> 2) + u), C.lane, bv[u]);
        f32x4 acc4[4];
#pragma unroll
        for (int u = 0; u < 4; ++u) acc4[u] = __builtin_amdgcn_mfma_f32_16x16x32_bf16(qa[0], stf[u][0], (f32x4){0.f, 0.f, 0.f, 0.f}, 0, 0, 0);
#pragma unroll
        for (int u = 0; u < 4; ++u) acc4[u] = __builtin_amdgcn_mfma_f32_16x16x32_bf16(qa[1], stf[u][1], acc4[u], 0, 0, 0);
#pragma unroll
        for (int u = 0; u < 4; ++u) acc4[u] = __builtin_amdgcn_mfma_f32_16x16x32_bf16(aa[0], bv[u][0], acc4[u], 0, 0, 0);
#pragma unroll
        for (int u = 0; u < 4; ++u) acc4[u] = __builtin_amdgcn_mfma_f32_16x16x32_bf16(aa[1], bv[u][1], acc4[u], 0, 0, 0);
#pragma unroll
        for (int u = 0; u < 4; ++u) { const int dvt = 4 * (C.wave >> 2) + u;
#pragma unroll
            for (int r = 0; r < 4; ++r) O[(16 * it + 4 * q + r) * 132 + 16 * dvt + fr] = acc4[u][r]; }
    }
    __syncthreads();
    {
        const int i = C.tid >> 3, s = C.tid & 7; const LAS float* O = (const LAS float*)(C.lds + CU_O) + i * 132 + 16 * s;
        float o[16]; float ss = 0.f;
#pragma unroll
        for (int k = 0; k < 16; ++k) { o[k] = O[k]; ss += o[k] * o[k]; }
        ss += __shfl_xor(ss, 1); ss += __shfl_xor(ss, 2); ss += __shfl_xor(ss, 4);
        const float rinv = 1.0f / sqrtf(ss * (1.0f / 128.0f) + RMS_EPS);
        bf16* RA = (bf16*)(C.ws + WS_RA) + (size_t)(t0 + i) * 512 + h * 128 + 16 * s;
        const float* gn = C.in(10) + (size_t)l * 128 + 16 * s;
        const v4u r0 = ar0, r1 = ar1;
        unsigned rw[8] = {r0.x, r0.y, r0.z, r0.w, r1.x, r1.y, r1.z, r1.w}; unsigned ow[8];
#pragma unroll
        for (int k = 0; k < 8; ++k) { const float a = SCL_A * o[2 * k] * rinv * gn[2 * k] * siluf_(bflo(rw[k])), bq = SCL_A * o[2 * k + 1] * rinv * gn[2 * k + 1] * siluf_(bfhi(rw[k])); ow[k] = (ABL_ZERO & 1) ? 0u : pk2(a, bq); }
        if (DRY) { asm volatile("" :: "v"(ow[0]), "v"(ow[1]), "v"(ow[2]), "v"(ow[3]), "v"(ow[4]), "v"(ow[5]), "v"(ow[6]), "v"(ow[7])); } else {
        *(v4u*)RA = (v4u){ow[0], ow[1], ow[2], ow[3]}; *(v4u*)(RA + 8) = (v4u){ow[4], ow[5], ow[6], ow[7]}; }
    }
    __syncthreads();
}

__device__ __forceinline__ void conv_silu8(const Ctx& C, int l, int t0, int c, int ch, int jg, float (&out)[8]) {
    const bf16* X = (const bf16*)(C.ws + WS_QKC);
    const float* cw = C.in(15) + (size_t)l * 4 * 512 + ch; const float cb = C.in(16)[(size_t)l * 512 + ch];
    const float w0 = cw[0], w1 = cw[512], w2 = cw[1024], w3 = cw[1536];
    float x[11];
#pragma unroll
    for (int k = 0; k < 11; ++k) { const int j = 8 * jg + k - 3; const int s = c * 64 + j; x[k] = (s >= 0) ? bf2f(X[(size_t)(t0 + j) * 512 + ch]) : 0.f; }
#pragma unroll
    for (int jj = 0; jj < 8; ++jj) out[jj] = siluf_(cb + w0 * x[jj] + w1 * x[jj + 1] + w2 * x[jj + 2] + w3 * x[jj + 3]);
}

__device__ __forceinline__ void mlstm_unit_a(const Ctx& C, int l, int ci) {
    const int bh = ci >> 8, c = ci & 255, bb = bh >> 2, h = bh & 3, t0 = bb * SEQ + c * 64;
    LAS float* VEC = (LAS float*)(C.lds + CU_VEC); LAS float* GT = (LAS float*)(C.lds + CU_GT);
    load_vt(C, (const bf16*)(C.ws + WS_VC), t0, h);
    const int dk = C.tid & 63, jg = C.tid >> 6;
    float k[8]; conv_silu8(C, l, t0, c, 256 + h * 64 + dk, jg, k);
    if (C.wave == 0) {
        const float* sm = (const float*)(C.ws + WS_SMALL) + (size_t)(t0 + C.lane) * 64;
        const float ip = sm[40 + h], lf = logsigmoidf_(sm[44 + h]);
        const float bj = wave_scan_sum(lf, C.lane); const float a = ip - bj; const float amax = wave_max(a);
        VEC[C.lane] = fexp(a - amax);
        if (C.lane == 63) { float* msc = (float*)(C.ws + WS_MSC) + (size_t)ci * 4; msc[0] = bj; msc[1] = amax; }
    }
    __syncthreads();
    LAS bf16* KT = (LAS bf16*)(C.lds + CU_KT);
    float kw[8]; float ns = 0.f;
#pragma unroll
    for (int jj = 0; jj < 8; ++jj) { kw[jj] = k[jj] * 0.125f * VEC[8 * jg + jj]; ns += kw[jj]; }
    *(LAS v4u*)(KT + dk * 72 + 8 * jg) = (v4u){pk2(kw[0], kw[1]), pk2(kw[2], kw[3]), pk2(kw[4], kw[5]), pk2(kw[6], kw[7])};
    GT[jg * 64 + dk] = ns;
    __syncthreads();
    if (C.tid < 64) { float s = 0.f;
#pragma unroll
        for (int g2 = 0; g2 < 8; ++g2) s += GT[g2 * 64 + C.tid];
        ((float*)(C.ws + WS_MN))[(size_t)ci * 64 + C.tid] = s; }
    const LAS bf16* VT = (const LAS bf16*)(C.lds + CU_VT);
    bf16* MST = (bf16*)(C.ws + WS_MST) + (size_t)ci * 8192;
    const int q = C.lane >> 4, fr = C.lane & 15;
    {
        bf16x8 av[2], bk[4][2]; lds_frag2(VT, 16 * C.wave, C.lane, av);
#pragma unroll
        for (int nt = 0; nt < 4; ++nt) lds_frag2((const LAS bf16*)KT, 16 * nt, C.lane, bk[nt]);
        f32x4 acc[4];
#pragma unroll
        for (int nt = 0; nt < 4; ++nt) acc[nt] = __builtin_amdgcn_mfma_f32_16x16x32_bf16(av[0], bk[nt][0], (f32x4){0.f, 0.f, 0.f, 0.f}, 0, 0, 0);
#pragma unroll
        for (int nt = 0; nt < 4; ++nt) acc[nt] = __builtin_amdgcn_mfma_f32_16x16x32_bf16(av[1], bk[nt][1], acc[nt], 0, 0, 0);
#pragma unroll
        for (int nt = 0; nt < 4; ++nt)
#pragma unroll
            for (int r = 0; r < 4; ++r) MST[(16 * C.wave + 4 * q + r) * 64 + 16 * nt + fr] = (bf16)f2bf(acc[nt][r]);
    }
    __syncthreads();
}

__device__ __forceinline__ void mlstm_unit_c(const Ctx& C, int l, int ci, bool DRY) {
    const int bh = ci >> 8, c = ci & 255, bb = bh >> 2, h = bh & 3, t0 = bb * SEQ + c * 64;
    LAS float* VEC = (LAS float*)(C.lds + CU_VEC);
    LAS float* AJ = VEC + 64, *MI = VEC + 128, *WI = VEC + 192, *EM = VEC + 256, *QN = VEC + 384; LAS float* DENP = (LAS float*)(C.lds + CU_GT);
    load_vt(C, (const bf16*)(C.ws + WS_VC), t0, h);
    const int dk = C.tid & 63, jg = C.tid >> 6;
    LAS bf16* KT = (LAS bf16*)(C.lds + CU_KT); LAS bf16* QT = (LAS bf16*)(C.lds + CU_Q); LAS bf16* AT = (LAS bf16*)(C.lds + CU_AT);
    bf16x8 stf[4][2];
    { const bf16* ST = (const bf16*)(C.ws + WS_MST) + (size_t)ci * 8192 + (size_t)(16 * 4 * (C.wave >> 2) + (C.lane & 15)) * 64 + 8 * (C.lane >> 4);
#pragma unroll
      for (int u = 0; u < 4; ++u) { stf[u][0] = *(const bf16x8*)(ST + u * 16 * 64); stf[u][1] = *(const bf16x8*)(ST + u * 16 * 64 + 32); } }
    v4u co0, co1; f32x4 nst0, nst1;
    { const bf16* OCp = (const bf16*)(C.ws + WS_OC) + (size_t)(t0 + (C.tid >> 3)) * 512 + h * 128 + 16 * (C.tid & 7); co0 = *(const v4u*)OCp; co1 = *(const v4u*)(OCp + 8);
      const float* np = (const float*)(C.ws + WS_MN) + (size_t)ci * 64 + 8 * (C.tid & 7); nst0 = *(const f32x4*)np; nst1 = *(const f32x4*)(np + 4); }
    {
        float qv[8], kv[8]; conv_silu8(C, l, t0, c, h * 64 + dk, jg, qv); conv_silu8(C, l, t0, c, 256 + h * 64 + dk, jg, kv);
#pragma unroll
        for (int jj = 0; jj < 8; ++jj) { const int j = 8 * jg + jj; QT[j * 72 + dk] = (bf16)f2bf(qv[jj]); KT[j * 72 + dk] = (bf16)f2bf(kv[jj] * 0.125f); }
    }
    if (C.wave == 0) {
        const float* sm = (const float*)(C.ws + WS_SMALL) + (size_t)(t0 + C.lane) * 64;
        const float ip = sm[40 + h], lf = logsigmoidf_(sm[44 + h]);
        const float bj = wave_scan_sum(lf, C.lane); const float a = ip - bj; const float arun = wave_scan_max(a, C.lane);
        const float mst = ((const float*)(C.ws + WS_MSC))[(size_t)ci * 4 + 2];
        const float mi = fmaxf(mst, arun);
        AJ[C.lane] = a; MI[C.lane] = mi; WI[C.lane] = fexp(mst - mi); EM[C.lane] = fexp(-(bj + mi));
    }
    __syncthreads();
    const int q = C.lane >> 4, fr = C.lane & 15;
    {
        const int it = C.wave >> 1;
        bf16x8 bq[2], ak[2][2]; lds_frag2((const LAS bf16*)QT, 16 * it, C.lane, bq);
#pragma unroll
        for (int u = 0; u < 2; ++u) lds_frag2((const LAS bf16*)KT, 16 * (2 * (C.wave & 1) + u), C.lane, ak[u]);
        f32x4 acc2[2];
#pragma unroll
        for (int u = 0; u < 2; ++u) acc2[u] = __builtin_amdgcn_mfma_f32_16x16x32_bf16(ak[u][0], bq[0], (f32x4){0.f, 0.f, 0.f, 0.f}, 0, 0, 0);
#pragma unroll
        for (int u = 0; u < 2; ++u) acc2[u] = __builtin_amdgcn_mfma_f32_16x16x32_bf16(ak[u][1], bq[1], acc2[u], 0, 0, 0);
#pragma unroll
        for (int u = 0; u < 2; ++u) { const int jt = 2 * (C.wave & 1) + u; const f32x4 acc = acc2[u];
            const int i = 16 * it + fr; const float mi = MI[i];
            float v[4]; float ds = 0.f;
#pragma unroll
            for (int r = 0; r < 4; ++r) { const int j = 16 * jt + 4 * q + r; v[r] = (j <= i) ? acc[r] * fexp(AJ[j] - mi) : 0.f; ds += v[r]; }
            ds += __shfl_xor(ds, 16); ds += __shfl_xor(ds, 32);
            if (q == 0) DENP[jt * 64 + i] = ds;
            *(LAS v2u*)(AT + i * 72 + 16 * jt + 4 * q) = (v2u){pk2(v[0], v[1]), pk2(v[2], v[3])}; }
    }
    {
        const int i = C.tid >> 3, s = C.tid & 7; const float nst[8] = {nst0[0], nst0[1], nst0[2], nst0[3], nst1[0], nst1[1], nst1[2], nst1[3]};
        float a = 0.f;
#pragma unroll
        for (int k = 0; k < 8; ++k) a += bf2f(QT[i * 72 + 8 * s + k]) * nst[k];
        a += __shfl_xor(a, 1); a += __shfl_xor(a, 2); a += __shfl_xor(a, 4);
        if (s == 0) QN[i] = a;
    }
    __syncthreads();
    {
        const int it = C.wave & 3; LAS float* O = (LAS float*)(C.lds + CU_O);
        const LAS bf16* VT = (const LAS bf16*)(C.lds + CU_VT);
        bf16x8 qa[2], aa[2], bv[4][2]; lds_frag2((const LAS bf16*)QT, 16 * it, C.lane, qa); lds_frag2((const LAS bf16*)AT, 16 * it, C.lane, aa);
#pragma unroll
        for (int u = 0; u < 4; ++u) lds_frag2(VT, 16 * (4 * (C.wave >> 2) + u), C.lane, bv[u]);
        f32x4 a1[4], a2[4];
#pragma unroll
        for (int u = 0; u < 4; ++u) { a1[u] = __builtin_amdgcn_mfma_f32_16x16x32_bf16(qa[0], stf[u][0], (f32x4){0.f, 0.f, 0.f, 0.f}, 0, 0, 0); a2[u] = __builtin_amdgcn_mfma_f32_16x16x32_bf16(aa[0], bv[u][0], (f32x4){0.f, 0.f, 0.f, 0.f}, 0, 0, 0); }
#pragma unroll
        for (int u = 0; u < 4; ++u) { a1[u] = __builtin_amdgcn_mfma_f32_16x16x32_bf16(qa[1], stf[u][1], a1[u], 0, 0, 0); a2[u] = __builtin_amdgcn_mfma_f32_16x16x32_bf16(aa[1], bv[u][1], a2[u], 0, 0, 0); }
        float wi4[4];
#pragma unroll
        for (int r = 0; r < 4; ++r) wi4[r] = WI[16 * it + 4 * q + r];
#pragma unroll
        for (int u = 0; u < 4; ++u) { const int dvt = 4 * (C.wave >> 2) + u;
#pragma unroll
            for (int r = 0; r < 4; ++r) { const int i = 16 * it + 4 * q + r; O[i * 132 + 16 * dvt + fr] = wi4[r] * a1[u][r] + a2[u][r]; } }
    }
    __syncthreads();
    {
        const int i = C.tid >> 3, s = C.tid & 7; const LAS float* O = (const LAS float*)(C.lds + CU_O) + i * 132 + 16 * s;
        const float den = WI[i] * QN[i] + ((DENP[i] + DENP[64 + i]) + (DENP[128 + i] + DENP[192 + i])); const float dinv = 1.0f / fmaxf(fabsf(den), EM[i]);
        bf16* OC = (bf16*)(C.ws + WS_OC) + (size_t)(t0 + i) * 512 + h * 128 + 16 * s;
        const v4u r0 = co0, r1 = co1;
        unsigned rw[8] = {r0.x, r0.y, r0.z, r0.w, r1.x, r1.y, r1.z, r1.w}; unsigned ow[8];
#pragma unroll
        for (int k = 0; k < 8; ++k) ow[k] = (ABL_ZERO & 4) ? 0u : pk2(SCL_C * O[2 * k] * dinv * sigmoidf_(bflo(rw[k])), SCL_C * O[2 * k + 1] * dinv * sigmoidf_(bfhi(rw[k])));
        if (DRY) { asm volatile("" :: "v"(ow[0]), "v"(ow[1]), "v"(ow[2]), "v"(ow[3]), "v"(ow[4]), "v"(ow[5]), "v"(ow[6]), "v"(ow[7])); } else {
        *(v4u*)OC = (v4u){ow[0], ow[1], ow[2], ow[3]}; *(v4u*)(OC + 8) = (v4u){ow[4], ow[5], ow[6], ow[7]}; }
    }
    __syncthreads();
}

__device__ __forceinline__ void phase_scan(const Ctx& C, bool DRY) {
    const int gt = C.bid * NTHR + C.tid, NGT = C.G * NTHR;
    for (int e = gt; e < 65536 + 65536; e += NGT) {
        if (e < 65536) {
            const int bh = e >> 13, el = e & 8191, dk = el & 63;
            bf16* st = (bf16*)(C.ws + WS_GST) + (size_t)bh * 256 * 8192 + el; const float* dec = (const float*)(C.ws + WS_GDEC) + (size_t)bh * 256 * 64 + dk;
            float s = 0.f;
            for (int c0 = 0; c0 < 256; c0 += 8) { float L[8], d[8];
#pragma unroll
                for (int k = 0; k < 8; ++k) { L[k] = bf2f(st[(size_t)(c0 + k) * 8192]); d[k] = dec[(c0 + k) * 64]; }
#pragma unroll
                for (int k = 0; k < 8; ++k) { if (!DRY) st[(size_t)(c0 + k) * 8192] = (bf16)f2bf(s); s = d[k] * s + L[k]; } }
            if (DRY) asm volatile("" :: "v"(s));
        } else {
            const int e2 = e - 65536, bh = e2 >> 13, el = e2 & 8191; const bool hasn = el < 64;
            bf16* st = (bf16*)(C.ws + WS_MST) + (size_t)bh * 256 * 8192 + el; float* nv = (float*)(C.ws + WS_MN) + (size_t)bh * 256 * 64 + (hasn ? el : 0);
            float* msc = (float*)(C.ws + WS_MSC) + (size_t)bh * 256 * 4;
            float s = 0.f, sn = 0.f, m = 0.f;
            for (int c0 = 0; c0 < 256; c0 += 8) { float L[8], Ln[8], bl[8], am[8];
#pragma unroll
                for (int k = 0; k < 8; ++k) { L[k] = bf2f(st[(size_t)(c0 + k) * 8192]); Ln[k] = hasn ? nv[(c0 + k) * 64] : 0.f; bl[k] = msc[(c0 + k) * 4]; am[k] = msc[(c0 + k) * 4 + 1]; }
#pragma unroll
                for (int k = 0; k < 8; ++k) {
                    const float mn = bl[k] + fmaxf(m, am[k]); const float al = fexp(bl[k] + m - mn), be = fexp(bl[k] + am[k] - mn);
                    if (!DRY) { st[(size_t)(c0 + k) * 8192] = (bf16)f2bf(s);
                    if (hasn) { nv[(c0 + k) * 64] = sn; if (el == 0) msc[(c0 + k) * 4 + 2] = m; } }
                    s = al * s + be * L[k]; sn = al * sn + be * Ln[k]; m = mn; } }
            if (DRY) asm volatile("" :: "v"(s), "v"(sn));
        }
    }
}

__device__ __forceinline__ float gelu_tanh(float x) { const float u = 0.7978845608f * (x + 0.044715f * x * x * x); const float e = __expf(2.0f * u); return 0.5f * x * (2.0f - 2.0f / (1.0f + e)); }

__device__ __forceinline__ void nsa_prep_rows(const float* gain, const f32x2* rope_row, float scale, bf16* p, int c8, bool DRY) {
    const v4u raw = *(const v4u*)p;
    float x[8]; x[0] = bflo(raw.x); x[1] = bfhi(raw.x); x[2] = bflo(raw.y); x[3] = bfhi(raw.y); x[4] = bflo(raw.z); x[5] = bfhi(raw.z); x[6] = bflo(raw.w); x[7] = bfhi(raw.w);
    float ss = 0.f;
#pragma unroll
    for (int k = 0; k < 8; ++k) ss += x[k] * x[k];
    ss += __shfl_xor(ss, 1); ss += __shfl_xor(ss, 2); ss += __shfl_xor(ss, 4);
    const float rinv = 1.0f / sqrtf(ss * (1.0f / 64.0f) + RMS_EPS);
    const f32x4 g0 = *(const f32x4*)(gain + 8 * c8), g1 = *(const f32x4*)(gain + 8 * c8 + 4);
    float y[8], pr[8];
#pragma unroll
    for (int k = 0; k < 8; ++k) y[k] = x[k] * rinv * (k < 4 ? g0[k] : g1[k - 4]);
#pragma unroll
    for (int k = 0; k < 8; ++k) pr[k] = __shfl_xor(y[k], 4);
    const f32x2* cs = rope_row + 8 * (c8 & 3);
    float o[8];
#pragma unroll
    for (int k = 0; k < 8; ++k) { const f32x2 c = cs[k]; o[k] = ((c8 < 4) ? (y[k] * c.x - pr[k] * c.y) : (pr[k] * c.y + y[k] * c.x)) * scale; }
    const v4u w = (v4u){pk2(o[0], o[1]), pk2(o[2], o[3]), pk2(o[4], o[5]), pk2(o[6], o[7])};
    if (DRY) asm volatile("" :: "v"(w)); else *(v4u*)p = w;
}
__device__ __forceinline__ void nsa_prep_token(const Ctx& C, int l, int tp, bool DRY) {
    const float* gn = C.in(11) + (size_t)l * 4 * 64;
    const int c8 = C.lane & 7, row = C.lane >> 3;
    const f32x2* rope = (const f32x2*)(C.ws + WS_ROPE);
#pragma unroll
    for (int h2 = 0; h2 < 2; ++h2) { const int t = 2 * tp + h2;
        nsa_prep_rows(gn, rope + (size_t)(t & (SEQ - 1)) * 32, 0.125f, (bf16*)(C.ws + WS_QB) + (size_t)t * 512 + row * 64 + 8 * c8, c8, DRY); }
    {
        const int t = 2 * tp + (row >> 2), kind = (row >> 1) & 1, g = row & 1;
        bf16* p = (bf16*)(C.ws + (kind ? WS_KVW : WS_KVS)) + (size_t)t * 256 + g * 64 + 8 * c8;
        nsa_prep_rows(gn + (kind ? 192 : 128), rope + (size_t)(t & (SEQ - 1)) * 32, 1.0f, p, c8, DRY); }
}
__device__ __forceinline__ void nsa_vtrans_item(const Ctx& C, int item) {
    const int which = item >> 10, bg = (item >> 8) & 3, blk = item & 255, b = bg >> 1, g = bg & 1;
    const bf16* src = (const bf16*)(C.ws + (which ? WS_KVW : WS_KVS)) + (size_t)(b * SEQ + blk * 64 + C.lane) * 256 + 128 + g * 64;
    bf16* dst = (bf16*)(C.ws + (which ? WS_VWT : WS_VST)) + (size_t)(bg * 256 + blk) * 4096 + C.lane;
    v4u w[8];
#pragma unroll
    for (int k = 0; k < 8; ++k) w[k] = ((const v4u*)src)[k];
#pragma unroll
    for (int k = 0; k < 8; ++k)
#pragma unroll
        for (int e = 0; e < 4; ++e) { const unsigned x = w[k][e]; dst[(size_t)(8 * k + 2 * e) * 64] = (bf16)(x & 0xffffu); dst[(size_t)(8 * k + 2 * e + 1) * 64] = (bf16)(x >> 16); }
}
__device__ __forceinline__ void nsa_cmp1_item(const Ctx& C, int item) {
    const int kv = item >> 10, rt = (item >> 2) & 255, ng = item & 3;
    const int fr = C.lane & 15, q = C.lane >> 4;
    const int ri = rt * 16 + fr, b = ri >> 11, g = (ri >> 10) & 1, c = ri & 1023, cc = c < 1023 ? c : 1022;
    const bf16* arow = (const bf16*)(C.ws + WS_KVC) + (size_t)(b * SEQ + 16 * cc) * 256 + kv * 128 + g * 64 + 8 * q;
    const bf16* brow = (const bf16*)(C.ws + WS_CW1) + (size_t)kv * 256 * 2048 + (size_t)(ng * 64 + fr) * 2048 + 8 * q;
    f32x4 acc[4];
#pragma unroll
    for (int nt = 0; nt < 4; ++nt) acc[nt] = (f32x4){0.f, 0.f, 0.f, 0.f};
#pragma unroll 4
    for (int kk = 0; kk < 64; ++kk) {
        const bf16x8 a = *(const bf16x8*)(arow + (kk >> 1) * 256 + (kk & 1) * 32);
#pragma unroll
        for (int nt = 0; nt < 4; ++nt) { const bf16x8 bv = *(const bf16x8*)(brow + (size_t)nt * 16 * 2048 + kk * 32); acc[nt] = __builtin_amdgcn_mfma_f32_16x16x32_bf16(a, bv, acc[nt], 0, 0, 0); }
    }
    const float* cb1 = (const float*)(C.ws + WS_VEC) + VEC_CB1 + kv * 256;
    bf16* H1 = (bf16*)(C.ws + WS_CMPH) + (size_t)kv * 4096 * 256;
#pragma unroll
    for (int nt = 0; nt < 4; ++nt) { const int n = ng * 64 + nt * 16 + fr; const float bia = cb1[n];
#pragma unroll
        for (int r = 0; r < 4; ++r) H1[(size_t)(rt * 16 + 4 * q + r) * 256 + n] = (bf16)f2bf(gelu_tanh(acc[nt][r] + bia)); }
}
__device__ __forceinline__ void nsa_cmp2_item(const Ctx& C, int l, int item) {
    const int kv = item >> 8, rt = item & 255;
    const int fr = C.lane & 15, q = C.lane >> 4;
    const bf16* H1 = (const bf16*)(C.ws + WS_CMPH) + (size_t)kv * 4096 * 256 + (size_t)rt * 16 * 256;
    const bf16* W2 = (const bf16*)(C.ws + WS_CW2) + (size_t)kv * 64 * 256;
    f32x4 acc[4];
#pragma unroll
    for (int nt = 0; nt < 4; ++nt) { acc[nt] = (f32x4){0.f, 0.f, 0.f, 0.f}; acc[nt] = mma_tile<8>(H1, 256, W2 + nt * 16 * 256, 256, acc[nt], C.lane); }
    if (kv == 0) {
        const float* gn = C.in(11) + (size_t)l * 4 * 64 + 64;
        bf16* KC = (bf16*)(C.ws + WS_KCMP);
#pragma unroll
        for (int r = 0; r < 4; ++r) {
            float ss = 0.f;
#pragma unroll
            for (int nt = 0; nt < 4; ++nt) ss += acc[nt][r] * acc[nt][r];
            ss += __shfl_xor(ss, 1); ss += __shfl_xor(ss, 2); ss += __shfl_xor(ss, 4); ss += __shfl_xor(ss, 8);
            const float rinv = 1.0f / sqrtf(ss * (1.0f / 64.0f) + RMS_EPS);
            float y[4];
#pragma unroll
            for (int nt = 0; nt < 4; ++nt) y[nt] = acc[nt][r] * rinv * gn[nt * 16 + fr];
            const int ri = rt * 16 + 4 * q + r, c = ri & 1023; int pos = 16 * c + 31; pos = pos < SEQ ? pos : SEQ - 1;
            const f32x2* rr = (const f32x2*)(C.ws + WS_ROPE) + (size_t)pos * 32;
            const f32x2 c0 = rr[fr], c1 = rr[16 + fr];
            bf16* o = KC + (size_t)ri * 64;
            o[fr] = (bf16)f2bf(y[0] * c0.x - y[2] * c0.y); o[16 + fr] = (bf16)f2bf(y[1] * c1.x - y[3] * c1.y);
            o[32 + fr] = (bf16)f2bf(y[0] * c0.y + y[2] * c0.x); o[48 + fr] = (bf16)f2bf(y[1] * c1.y + y[3] * c1.x);
        }
    } else {
        bf16* VCT = (bf16*)(C.ws + WS_VCT);
        const int ri0 = rt * 16, bg = ri0 >> 10, c0 = (ri0 & 1023) + 4 * q;
#pragma unroll
        for (int nt = 0; nt < 4; ++nt) { const int d = nt * 16 + fr;
            *(v2u*)(VCT + (size_t)(bg * 64 + d) * 1024 + c0) = (v2u){pk2(acc[nt][0], acc[nt][1]), pk2(acc[nt][2], acc[nt][3])}; }
    }
}

constexpr int NQ = 32;
constexpr int NU_IMP = 0;
constexpr int NU_SEL = 32768;
constexpr int NU_UM = 33792;
constexpr int NU_UL = 33824;
constexpr int NU_KV = 35072;
constexpr int NU_TILE = 18432;
constexpr int NU_END = NU_KV + 4 * NU_TILE;
constexpr float LOG2E = 1.44269504089f;

struct TileSrc { const bf16* k; int kld; const bf16* v; int vld; };

__device__ __forceinline__ void nsa_fetch(const Ctx& C, const TileSrc& ts, bool on, v4u& kr, v4u& vr) {
    const int r = C.tid >> 3, ch = C.tid & 7; (void)on;
    kr = *(const v4u*)(ts.k + (size_t)r * ts.kld + ch * 8); vr = *(const v4u*)(ts.v + (size_t)r * ts.vld + ch * 8);
}
__device__ __forceinline__ void nsa_commit(const Ctx& C, int j, bool on, const v4u& kr, const v4u& vr) {
    LAS bf16* KT = (LAS bf16*)(C.lds + NU_KV + j * NU_TILE); LAS bf16* VT = KT + 64 * 72;
    const int r = C.tid >> 3, ch = C.tid & 7; (void)on;
    *(LAS v4u*)(KT + r * 72 + ch * 8) = kr; *(LAS v4u*)(VT + r * 72 + ch * 8) = vr;
}
__device__ __forceinline__ void nsa_scores(const Ctx& C, int j, const bf16x8 (&qf)[2], f32x4 (&s)[4]) {
    const LAS bf16* KT = (const LAS bf16*)(C.lds + NU_KV + j * NU_TILE);
    const int fr = C.lane & 15, q = C.lane >> 4;
    bf16x8 a[4][2];
#pragma unroll
    for (int kt = 0; kt < 4; ++kt)
#pragma unroll
        for (int ks = 0; ks < 2; ++ks) a[kt][ks] = *(const LAS bf16x8*)(KT + (16 * kt + fr) * 72 + ks * 32 + 8 * q);
#pragma unroll
    for (int kt = 0; kt < 4; ++kt) s[kt] = __builtin_amdgcn_mfma_f32_16x16x32_bf16(a[kt][0], qf[0], (f32x4){0.f, 0.f, 0.f, 0.f}, 0, 0, 0);
#pragma unroll
    for (int kt = 0; kt < 4; ++kt) s[kt] = __builtin_amdgcn_mfma_f32_16x16x32_bf16(a[kt][1], qf[1], s[kt], 0, 0, 0);
}
__device__ __forceinline__ void nsa_vfrag(const Ctx& C, int j, v4u (&vf)[4][2]) {
    const LAS bf16* VT = (const LAS bf16*)(C.lds + NU_KV + j * NU_TILE) + 64 * 72;
    const int fr = C.lane & 15, q = C.lane >> 4;
#pragma unroll
    for (int dt = 0; dt < 4; ++dt)
#pragma unroll
        for (int k2 = 0; k2 < 2; ++k2) { const LAS bf16* vr = VT + (16 * dt + fr) * 72 + 32 * k2 + 4 * q;
            const v2u lo = *(const LAS v2u*)vr, hi = *(const LAS v2u*)(vr + 16); vf[dt][k2] = (v4u){lo.x, lo.y, hi.x, hi.y}; }
}
__device__ __forceinline__ void nsa_pv(const Ctx& C, int j, const f32x4 (&p)[4], f32x4 (&o)[4], const v4u (&vf)[4][2]) {
    bf16x8 pf[2];
#pragma unroll
    for (int k2 = 0; k2 < 2; ++k2) { v4u w; w.x = pk2(p[2 * k2][0], p[2 * k2][1]); w.y = pk2(p[2 * k2][2], p[2 * k2][3]); w.z = pk2(p[2 * k2 + 1][0], p[2 * k2 + 1][1]); w.w = pk2(p[2 * k2 + 1][2], p[2 * k2 + 1][3]);
        pf[k2] = __builtin_bit_cast(bf16x8, w); }
#pragma unroll
    for (int k2 = 0; k2 < 2; ++k2)
#pragma unroll
        for (int dt = 0; dt < 4; ++dt) o[dt] = __builtin_amdgcn_mfma_f32_16x16x32_bf16(__builtin_bit_cast(bf16x8, vf[dt][k2]), pf[k2], o[dt], 0, 0, 0);
}
__device__ __forceinline__ float nsa_exp(f32x4 (&s)[4], float ml2) {
    float ps = 0.f;
#pragma unroll
    for (int kt = 0; kt < 4; ++kt)
#pragma unroll
        for (int r = 0; r < 4; ++r) { const float p = __builtin_amdgcn_exp2f(s[kt][r] * LOG2E - ml2); s[kt][r] = p; ps += p; }
    return ps;
}

__device__ __forceinline__ void nsa_attn_unit(const Ctx& C, int l, int u, bool DRY) {
    const int half = u & 1, bg = (u >> 1) & 3, b = bg >> 1, g = bg & 1;
    const int qb = 255 - (u >> 3);
    const int q0 = 32 * half;
    const int t0 = b * SEQ + qb * 64;
    const int fr = C.lane & 15, q = C.lane >> 4, qq = fr >> 2, hh = fr & 3;
    LAS float* IMP = (LAS float*)(C.lds + NU_IMP);
    LAS unsigned long long* SEL = (LAS unsigned long long*)(C.lds + NU_SEL);
    LAS unsigned long long* UM = (LAS unsigned long long*)(C.lds + NU_UM);
    LAS int* UL = (LAS int*)(C.lds + NU_UL);
    for (int i = C.tid; i < NQ * 256; i += NTHR) IMP[i] = 0.f;
    float mc2, ms2, mw2;
    { const float* gn = C.in(11) + (size_t)l * 256;
      const float gq = wave_max(fabsf(gn[C.lane])), g1 = wave_max(fabsf(gn[64 + C.lane])), g2 = wave_max(fabsf(gn[128 + C.lane])), g3 = wave_max(fabsf(gn[192 + C.lane]));
      mc2 = 8.0f * gq * g1 * LOG2E; ms2 = 8.0f * gq * g2 * LOG2E; mw2 = 8.0f * gq * g3 * LOG2E; }
    bf16* QB = (bf16*)(C.ws + WS_QB);
    const int iq = q0 + 4 * C.wave + qq;
    bf16x8 qf[2]; float gate[3];
    { const bf16* qp = QB + (size_t)(t0 + iq) * 512 + (g * 4 + hh) * 64 + 8 * q;
      qf[0] = *(const bf16x8*)qp; qf[1] = *(const bf16x8*)(qp + 32);
      const float* sm = (const float*)(C.ws + WS_SMALL) + (size_t)(t0 + iq) * 64 + 16 + (g * 4 + hh) * 3;
#pragma unroll
      for (int k = 0; k < 3; ++k) gate[k] = ((ABL_ZERO & 2) || (ABL_ZERO & (8 << k))) ? 0.f : SCL_B * sigmoidf_(sm[k]); }
    f32x4 out[4];
#pragma unroll
    for (int dt = 0; dt < 4; ++dt) out[dt] = (f32x4){0.f, 0.f, 0.f, 0.f};
    v4u kr[4], vr[4];

    const bf16* KC = (const bf16*)(C.ws + WS_KCMP) + (size_t)bg * 1024 * 64;
    const bf16* VCT = (const bf16*)(C.ws + WS_VCT) + (size_t)bg * 64 * 1024;
    const int nct = (4 * qb + 3 + 63) >> 6, ncs = (nct + 3) >> 2;
    const int cmax = (64 * qb + iq - 31) >> 4, cmin = (64 * qb + q0 + 4 * C.wave - 31) >> 4;
    float cl = 0.f, cinv = 0.f;
    for (int rep = (TIMEDUP & 2048) ? 0 : 1; rep < 2; ++rep) { cl = 0.f;
    for (int pass = 0; pass < 2; ++pass) {
        f32x4 ao[4];
#pragma unroll
        for (int dt = 0; dt < 4; ++dt) ao[dt] = (f32x4){0.f, 0.f, 0.f, 0.f};
        if (pass == 1) { float lt = cl; lt += __shfl_xor(lt, 16); lt += __shfl_xor(lt, 32); cinv = lt > 0.f ? 1.0f / lt : 0.f; }
#pragma unroll
        for (int j = 0; j < 4; ++j) { const int tl = j < nct ? j : nct - 1; const TileSrc ts{KC + (size_t)tl * 64 * 64, 64, VCT + tl * 64, 1024}; nsa_fetch(C, ts, true, kr[j], vr[j]); }
        for (int st = 0; st < ncs; ++st) {
            __syncthreads();
#pragma unroll
            for (int j = 0; j < 4; ++j) nsa_commit(C, j, 4 * st + j < nct, kr[j], vr[j]);
            __syncthreads();
            if (st + 1 < ncs) {
#pragma unroll
                for (int j = 0; j < 4; ++j) { const int t4 = 4 * (st + 1) + j, tl = t4 < nct ? t4 : nct - 1; const TileSrc ts{KC + (size_t)tl * 64 * 64, 64, VCT + tl * 64, 1024}; nsa_fetch(C, ts, true, kr[j], vr[j]); }
            }
#pragma unroll
            for (int j = 0; j < 4; ++j) {
                const int tl = 4 * st + j;
                if (tl < nct) {
                    f32x4 s[4]; v4u vf[4][2]; nsa_scores(C, j, qf, s); if (pass == 1) nsa_vfrag(C, j, vf);
                    if (64 * tl + 63 > cmin) {
#pragma unroll
                    for (int kt = 0; kt < 4; ++kt)
#pragma unroll
                        for (int r = 0; r < 4; ++r) { const int c = 64 * tl + 16 * kt + 4 * q + r; if (c > cmax) s[kt][r] = -INFINITY; }
                    }
                    const float ps = nsa_exp(s, mc2);
                    if (pass == 0) cl += ps;
                    else {
#pragma unroll
                        for (int kt = 0; kt < 4; ++kt) {
#pragma unroll
                            for (int r = 0; r < 4; ++r) s[kt][r] *= cinv;
                            float gs = (s[kt][0] + s[kt][1]) + (s[kt][2] + s[kt][3]), es = s[kt][3];
                            gs += __shfl_xor(gs, 1); gs += __shfl_xor(gs, 2); es += __shfl_xor(es, 1); es += __shfl_xor(es, 2);
                            if (hh == 0) { const int n = 16 * tl + 4 * kt + q;
                                if (n < 256) { atomicAdd((float*)(IMP + (iq - q0) * 256 + n), gs); if (n + 1 < 256) atomicAdd((float*)(IMP + (iq - q0) * 256 + n + 1), es); } }
                        }
                        nsa_pv(C, j, s, ao, vf);
                    }
                }
            }
        }
        if (pass == 1) {
#pragma unroll
            for (int dt = 0; dt < 4; ++dt) out[dt] += ao[dt] * (rep == 1 ? gate[0] : 0.f);
        }
        __syncthreads();
    } }

    for (int rep = (TIMEDUP & 256) ? 0 : 1; rep < 2; ++rep) {
        unsigned key[4][4]; unsigned long long selw[4][4];
        const int nforced = qb >= 2 ? 3 : qb + 1; const int ncand = qb + 1 - nforced;
        int need = 16 - nforced; if (need > ncand) need = ncand;
#pragma unroll
        for (int k4 = 0; k4 < 4; ++k4)
#pragma unroll
            for (int k = 0; k < 4; ++k) { const int n = C.lane + 64 * k; const bool valid = n <= qb; const bool forced = valid && (n == 0 || n == qb || n == qb - 1);
                key[k4][k] = (valid && !forced) ? (__builtin_bit_cast(unsigned, fmaxf(IMP[(4 * C.wave + k4) * 256 + n], 0.f)) + 1u) : 0u;
                selw[k4][k] = __ballot(forced); }
        if (need == ncand) {
#pragma unroll
            for (int k4 = 0; k4 < 4; ++k4)
#pragma unroll
                for (int k = 0; k < 4; ++k) selw[k4][k] |= __ballot(key[k4][k] != 0u);
        } else {
            unsigned thr[4] = {0u, 0u, 0u, 0u};
            for (int bit = 31; bit >= 12; --bit) {
#pragma unroll
                for (int k4 = 0; k4 < 4; ++k4) { const unsigned cand = thr[k4] | (1u << bit); int cnt = 0;
#pragma unroll
                    for (int k = 0; k < 4; ++k) cnt += __builtin_popcountll(__ballot(key[k4][k] >= cand));
                    if (cnt >= need) thr[k4] = cand; } }
#pragma unroll
            for (int k4 = 0; k4 < 4; ++k4) { int left = need; const unsigned hi = thr[k4] + 0xfffu;
#pragma unroll
                for (int k = 0; k < 4; ++k) { const unsigned long long gt = __ballot(key[k4][k] > hi); selw[k4][k] |= gt; left -= __builtin_popcountll(gt); }
#pragma unroll
                for (int k = 0; k < 4; ++k) { unsigned long long eq = __ballot(key[k4][k] != 0u && key[k4][k] >= thr[k4] && key[k4][k] <= hi);
                    while (left > 0 && eq) { const unsigned long long low = eq & (0ull - eq); selw[k4][k] |= low; eq ^= low; --left; } } }
        }
#pragma unroll
        for (int k4 = 0; k4 < 4; ++k4)
            if (C.lane < 4) SEL[(4 * C.wave + k4) * 4 + C.lane] = C.lane == 0 ? selw[k4][0] : C.lane == 1 ? selw[k4][1] : C.lane == 2 ? selw[k4][2] : selw[k4][3];
    }
    __syncthreads();
    if (C.tid < 4) { unsigned long long um = 0ull; for (int i = 0; i < NQ; ++i) um |= SEL[i * 4 + C.tid]; UM[C.tid] = um; }
    __syncthreads();
    int ucnt;
    {
        const unsigned long long u0 = UM[0], u1 = UM[1], u2 = UM[2], u3 = UM[3];
        const int c0 = __builtin_popcountll(u0), c1 = __builtin_popcountll(u1), c2 = __builtin_popcountll(u2), c3 = __builtin_popcountll(u3);
        ucnt = c0 + c1 + c2 + c3;
        if (C.tid < 256) { const int w = C.tid >> 6, bit = C.tid & 63; const unsigned long long uw = w == 0 ? u0 : w == 1 ? u1 : w == 2 ? u2 : u3;
            if ((uw >> bit) & 1ull) { const int pos = (w > 0 ? c0 : 0) + (w > 1 ? c1 : 0) + (w > 2 ? c2 : 0) + __builtin_popcountll(uw & ((1ull << bit) - 1ull)); UL[pos] = C.tid; } }
    }
    __syncthreads();

    for (int rep = (TIMEDUP & 1024) ? 0 : 1; rep < 2; ++rep) {
        f32x4 ao[4]; float al = 0.f;
#pragma unroll
        for (int dt = 0; dt < 4; ++dt) ao[dt] = (f32x4){0.f, 0.f, 0.f, 0.f};
        const bf16* KS = (const bf16*)(C.ws + WS_KVS) + (size_t)(b * SEQ) * 256 + g * 64;
        const bf16* VST = (const bf16*)(C.ws + WS_VST) + (size_t)bg * 256 * 4096;
        const int nss = (ucnt + 3) >> 2;
        const unsigned long long my0 = SEL[(iq - q0) * 4 + 0], my1 = SEL[(iq - q0) * 4 + 1], my2 = SEL[(iq - q0) * 4 + 2], my3 = SEL[(iq - q0) * 4 + 3];
#define SLC_FETCH(STG, KR, VR) do { _Pragma("unroll") for (int j = 0; j < 4; ++j) { const int ix = 4 * (STG) + j; const int n = ix < ucnt ? UL[ix] : 0; \
            const TileSrc ts{KS + (size_t)n * 64 * 256, 256, VST + (size_t)n * 4096, 64}; nsa_fetch(C, ts, ix < ucnt, KR[j], VR[j]); } } while (0)
#define SLC_STAGE(STG, KR, VR) do { \
            __syncthreads(); \
            _Pragma("unroll") for (int j = 0; j < 4; ++j) nsa_commit(C, j, 4 * (STG) + j < ucnt, KR[j], VR[j]); \
            __syncthreads(); \
            if ((STG) + 1 < nss) SLC_FETCH((STG) + 1, KR, VR); \
            _Pragma("unroll") for (int j = 0; j < 4; ++j) { \
                const int ix = 4 * (STG) + j; \
                if (ix < ucnt) { \
                    const int n = UL[ix]; \
                    const unsigned long long mw = (n >> 6) == 0 ? my0 : (n >> 6) == 1 ? my1 : (n >> 6) == 2 ? my2 : my3; \
                    const bool mysel = (mw >> (n & 63)) & 1ull; \
                    if (__ballot(mysel) != 0ull) { \
                        f32x4 s[4]; v4u vf[4][2]; nsa_scores(C, j, qf, s); nsa_vfrag(C, j, vf); \
                        if (n == qb) { _Pragma("unroll") for (int kt = 0; kt < 4; ++kt) _Pragma("unroll") for (int r = 0; r < 4; ++r) { const int key = 16 * kt + 4 * q + r; if (key > iq) s[kt][r] = -INFINITY; } } \
                        al += nsa_exp(s, mysel ? ms2 : INFINITY); \
                        nsa_pv(C, j, s, ao, vf); \
                    } } } } while (0)
        SLC_FETCH(0, kr, vr);
        for (int st = 0; st < nss; ++st) SLC_STAGE(st, kr, vr);
#undef SLC_FETCH
#undef SLC_STAGE
        float lt = al; lt += __shfl_xor(lt, 16); lt += __shfl_xor(lt, 32); const float inv = (lt > 0.f && rep == 1) ? gate[1] / lt : 0.f;
#pragma unroll
        for (int dt = 0; dt < 4; ++dt) out[dt] += ao[dt] * inv;
    }
    for (int rep = (TIMEDUP & 512) ? 0 : 1; rep < 2; ++rep) {
        f32x4 ao[4]; float al = 0.f;
#pragma unroll
        for (int dt = 0; dt < 4; ++dt) ao[dt] = (f32x4){0.f, 0.f, 0.f, 0.f};
        const bf16* KW = (const bf16*)(C.ws + WS_KVW) + (size_t)(b * SEQ) * 256 + g * 64;
        const bf16* VWT = (const bf16*)(C.ws + WS_VWT) + (size_t)bg * 256 * 4096;
        const int nfirst = qb >= 8 ? qb - 8 : 0, nw = qb - nfirst + 1, nws = (nw + 3) >> 2;
#pragma unroll
        for (int j = 0; j < 4; ++j) { const int n = nfirst + (j < nw ? j : 0); const TileSrc ts{KW + (size_t)n * 64 * 256, 256, VWT + (size_t)n * 4096, 64}; nsa_fetch(C, ts, true, kr[j], vr[j]); }
        for (int st = 0; st < nws; ++st) {
            __syncthreads();
#pragma unroll
            for (int j = 0; j < 4; ++j) nsa_commit(C, j, 4 * st + j < nw, kr[j], vr[j]);
            __syncthreads();
            if (st + 1 < nws) {
#pragma unroll
                for (int j = 0; j < 4; ++j) { const int ix = 4 * (st + 1) + j; const int n = nfirst + (ix < nw ? ix : 0); const TileSrc ts{KW + (size_t)n * 64 * 256, 256, VWT + (size_t)n * 4096, 64}; nsa_fetch(C, ts, ix < nw, kr[j], vr[j]); }
            }
#pragma unroll
            for (int j = 0; j < 4; ++j) {
                const int ix = 4 * st + j;
                if (ix < nw) {
                    const int delta = qb - (nfirst + ix);
                    f32x4 s[4]; v4u vf[4][2]; nsa_scores(C, j, qf, s); nsa_vfrag(C, j, vf);
                    if (delta == 0 || delta == 8) {
#pragma unroll
                        for (int kt = 0; kt < 4; ++kt)
#pragma unroll
                            for (int r = 0; r < 4; ++r) { const int key = 16 * kt + 4 * q + r; const bool ok = delta == 0 ? (key <= iq) : (key > iq); if (!ok) s[kt][r] = -INFINITY; }
                    }
                    al += nsa_exp(s, mw2);
                    nsa_pv(C, j, s, ao, vf);
                }
            }
        }
        float lt = al; lt += __shfl_xor(lt, 16); lt += __shfl_xor(lt, 32); const float inv = (lt > 0.f && rep == 1) ? gate[2] / lt : 0.f;
#pragma unroll
        for (int dt = 0; dt < 4; ++dt) out[dt] += ao[dt] * inv;
    }
    if (DRY) {
#pragma unroll
      for (int dt = 0; dt < 4; ++dt) asm volatile("" :: "v"(out[dt]));
    } else { bf16* op = QB + (size_t)(t0 + iq) * 512 + (g * 4 + hh) * 64 + 4 * q;
#pragma unroll
      for (int dt = 0; dt < 4; ++dt) *(v2u*)(op + 16 * dt) = (v2u){pk2(out[dt][0], out[dt][1]), pk2(out[dt][2], out[dt][3])}; }
    __syncthreads();
}


__device__ __forceinline__ void phase_mix1(const Ctx& C, int l) {
    const int gw = C.bid * NWAVES + C.wave, NGW = C.G * NWAVES;
    for (int rep = (TIMEDUP & 32) ? 0 : 1; rep < 2; ++rep) {
    for (int it = gw; it < 2048; it += NGW) nsa_cmp1_item(C, it);
    for (int it = gw; it < 2048; it += NGW) nsa_vtrans_item(C, it); }
    for (int rep = (TIMEDUP & 262144) ? 0 : 1; rep < 2; ++rep) for (int tp = gw; tp < T / 2; tp += NGW) nsa_prep_token(C, l, tp, rep == 0);
    gla_stage_alpha(C, l);
    __syncthreads();
    for (int rep = (TIMEDUP & 16) ? 0 : 1; rep < 2; ++rep) for (int u = C.bid; u < 4096; u += C.G) { if (u < 2048) gla_unit_a(C, l, u); else mlstm_unit_a(C, l, u - 2048); }
}
__device__ __forceinline__ void phase_mix2(const Ctx& C, int l) {
    const int gw = C.bid * NWAVES + C.wave, NGW = C.G * NWAVES;
    for (int rep = (TIMEDUP & 1048576) ? 0 : 1; rep < 2; ++rep) for (int it = gw; it < 512; it += NGW) nsa_cmp2_item(C, l, it);
    for (int rep = (TIMEDUP & 524288) ? 0 : 1; rep < 2; ++rep) phase_scan(C, rep == 0);
}
__device__ __forceinline__ void phase_mix3(const Ctx& C, int l) {
    for (int rep = (TIMEDUP & 1) ? 0 : 1; rep < 2; ++rep) for (int i = C.bid; i < 2048; i += C.G) {
        const_cast<Ctx&>(C).launder();
        const int r = i / C.G, w = i % C.G; const int pos = (r & 1) ? (2047 - ((r >> 1) * C.G + w)) : ((r >> 1) * C.G + w);
        nsa_attn_unit(C, l, pos, rep == 0); }
    const_cast<Ctx&>(C).launder(); const Ctx& D = C;
    gla_stage_alpha(D, l);
    for (int rep = (TIMEDUP & 2) ? 0 : 1; rep < 2; ++rep) for (int u = D.bid; u < 4096; u += D.G) { if (u < 2048) gla_unit_c(D, l, u, rep == 0); else mlstm_unit_c(D, l, u - 2048, rep == 0); }
}

constexpr int MIX_PHASES = 10;
#define MIXER_PHASES \
    if (PH_ON) for (int rep = (TIMEDUP & 131072) ? 0 : 1; rep < 2; ++rep) phase_norm(C, C.in(5) + (size_t)l * DM, C.X); \
    PH_END; \
    if (PH_ON) { \
        pg8::Gemm g{(const bf16*)(C.ws + WS_XN), (const bf16*)(C.ws + WS_WIN), T, 4608, DM}; \
        pg8::StaticOrder S; S.init(T, 4608, C.G, C.bid); \
        pg8::EpiWin E{C.ws + WS_R, (const float*)(C.ws + WS_VEC) + VEC_BINP, (float*)(C.ws + WS_SMALL)}; \
        for (int rep = (TIMEDUP & 64) ? 0 : 1; rep < 2; ++rep) pg8::gemm_phase<pg8::EpiWin, pg8::StaticOrder, false>(C.lds, g, S, E, nullptr); \
    } \
    PH_END; \
    if (PH_ON) phase_mix1(C, l); \
    PH_END; \
    if (PH_ON) phase_mix2(C, l); \
    PH_END; \
    if (PH_ON) phase_mix3(C, l); \
    PH_END; \
    if (PH_ON) { \
        pg8::Gemm g{(const bf16*)(C.ws + WS_XN), (const bf16*)(C.ws + WS_WGT), T, 3 * DM, DM}; \
        pg8::StaticOrder S; S.init(T, 3 * DM, C.G, C.bid); \
        pg8::EpiGate E{C.ws, DM, C.in(7) + (size_t)l * N_IN + 4400}; \
        for (int rep = (TIMEDUP & 16384) ? 0 : 1; rep < 2; ++rep) pg8::gemm_phase<pg8::EpiGate, pg8::StaticOrder, false>(C.lds, g, S, E, nullptr); \
    } \
    PH_END; \
    for (int br = 0; br < 3; ++br) { \
        if (PH_ON) { \
            const bf16* Asrc = (const bf16*)(C.ws + (br == 0 ? WS_RA : br == 1 ? WS_QB : WS_OC)); \
            pg8::Gemm g{Asrc, (const bf16*)(C.ws + WS_WBR) + (size_t)br * DM * 512, T, DM, 512}; \
            pg8::StaticOrder S; S.init(T, DM, C.G, C.bid); \
            for (int rep = (TIMEDUP & 32768) ? 0 : 1; rep < 2; ++rep) { \
            pg8::EpiBranch E{(bf16*)(C.ws + WS_Y), (const bf16*)(C.ws + WS_G0 + (size_t)(br >= 1) * (WS_G1 - WS_G0) + (size_t)(br >= 2) * (WS_G2 - WS_G1)), DM, rep == 0 ? 2 : (br == 0 ? 1 : 0)}; \
            pg8::gemm_phase<pg8::EpiBranch, pg8::StaticOrder, false>(C.lds, g, S, E, nullptr); } \
        } \
        PH_END; \
    } \
    if (PH_ON) { \
        pg8::Gemm g{(const bf16*)(C.ws + WS_Y), (const bf16*)(C.ws + WS_WOUT), T, DM, DM}; \
        pg8::StaticOrder S; S.init(T, DM, C.G, C.bid); \
        for (int rep = (TIMEDUP & 65536) ? 0 : 1; rep < 2; ++rep) { \
        pg8::EpiResid E{C.X, DM, rep == 1 ? 1.0f : 0.f, C.X}; \
        pg8::gemm_phase<pg8::EpiResid, pg8::StaticOrder, false>(C.lds, g, S, E, nullptr); } \
    } \
    PH_END;

constexpr int N_PHASES = 8 * 3 + 4 * MIX_PHASES;

__global__ void __launch_bounds__(NTHR, 2) hybrid_fwd(Args args) {
    extern __shared__ __attribute__((aligned(16))) unsigned char lds_raw[];
    Ctx C;
    C.lds = (LAS unsigned char*)lds_raw;
    C.tid = threadIdx.x; C.lane = C.tid & 63; C.wave = __builtin_amdgcn_readfirstlane(C.tid >> 6);
    C.G = gridDim.x; C.bid = blockIdx.x;
    C.inp = (const GAS float* const __attribute__((address_space(4)))*)__builtin_amdgcn_kernarg_segment_ptr();
    C.X = args.out; C.ws = args.ws;
    volatile LAS unsigned* MISC = (volatile LAS unsigned*)(C.lds + MISC_OFF);
    for (int u = C.tid; u < (LDS_BYTES - RING_BYTES) / 4; u += NTHR) ((LAS unsigned*)(C.lds + RING_BYTES))[u] = 0u;
    __syncthreads();
    __builtin_amdgcn_fence(__ATOMIC_ACQUIRE, "agent"); asm volatile("s_waitcnt vmcnt(0)" ::: "memory");
    __syncthreads();
    const int lo = args.ph_lo, hi = args.ph_hi;
    XcdBarrier bar; bar.bar = (unsigned*)(C.ws + WS_CTL) + 4096; bar.x = 0; bar.st = nullptr;
    if (hi - lo > 1) bar = xcd_barrier_post((unsigned*)(C.ws + WS_CTL) + 4096, MISC + 8);
    int pc = 0;
#define PH_ON (C.launder(), pc >= lo && pc < hi)
#define PH_END_NB do { ++pc; } while (0)
#define PH_END do { if (pc >= lo && pc + 1 < hi) { xcd_barrier(bar); if (TIMEDUP & 4096) xcd_barrier(bar); } ++pc; } while (0)

    for (int step = 0; step < 2 * NLAYER; ++step) {
        const int l = step >> 1, f = step & 1;
        if (PH_ON) {
            if (step == 0) phase_init(C);
            if (f == 0) for (int rep = (TIMEDUP & 128) ? 0 : 1; rep < 2; ++rep) phase_prep_weights(C, l);
            for (int rep = (TIMEDUP & 8) ? 0 : 1; rep < 2; ++rep) phase_norm(C, (f ? C.in(19) : C.in(1)) + (size_t)l * DM, step == 0 ? C.in(0) : (const float*)C.X);
        }
        PH_END;
        if (PH_ON) {
            pg8::Gemm g{(const bf16*)(C.ws + WS_XN), (const bf16*)(C.ws + (f ? WS_WGU2 : WS_WGU1)), T, 2 * DFF, DM};
            pg8::StaticOrder S; S.init(T, 2 * DFF, C.G, C.bid);
            pg8::EpiSwiGLU E{(bf16*)(C.ws + WS_HID), DFF};
            for (int rep = (TIMEDUP & 4) ? 0 : 1; rep < 2; ++rep) pg8::gemm_phase<pg8::EpiSwiGLU, pg8::StaticOrder, false>(C.lds, g, S, E, nullptr);
        }
        PH_END;
        if (PH_ON) {
            pg8::Gemm g{(const bf16*)(C.ws + WS_HID), (const bf16*)(C.ws + (f ? WS_WDN2 : WS_WDN1)), T, DM, DFF};
            pg8::StaticOrder S; S.init(T, DM, C.G, C.bid);
            for (int rep = (TIMEDUP & 8192) ? 0 : 1; rep < 2; ++rep) {
            pg8::EpiResid E{C.X, DM, rep == 1 ? 0.5f : 0.f, (step == 0 && !(rep == 1 && (TIMEDUP & 8192))) ? C.in(0) : (const float*)C.X};
            pg8::gemm_phase<pg8::EpiResid, pg8::StaticOrder, false>(C.lds, g, S, E, nullptr); }
        }
        PH_END;
        if (f == 0) {
            MIXER_PHASES
        }
    }
#undef PH_ON
#undef PH_END
#undef PH_END_NB
    asm volatile("s_waitcnt vmcnt(0)" ::: "memory");
    __syncthreads();
    if (C.tid == 0) { __builtin_amdgcn_fence(__ATOMIC_RELEASE, "agent"); asm volatile("s_waitcnt vmcnt(0)" ::: "memory"); }
}

extern "C" void kernel_launch(void* const* d_in, const int* in_sizes, int n_in, void* d_out, int out_size, void* d_ws, size_t ws_size, hipStream_t stream) {
    static int grid = 0;
    if (grid == 0) {
        if (n_in != 23 || out_size != T * DM || ws_size < WS_END) { fprintf(stderr, "kernel_launch: unexpected shapes (n_in %d out %d ws %zu, need %zu)\n", n_in, out_size, ws_size, (size_t)WS_END); grid = -1; return; }
        int dev = 0, cus = 0, per_cu = 0;
        if (hipGetDevice(&dev) != hipSuccess || hipDeviceGetAttribute(&cus, hipDeviceAttributeMultiprocessorCount, dev) != hipSuccess) { grid = -1; return; }
        if (hipFuncSetAttribute((const void*)hybrid_fwd, hipFuncAttributeMaxDynamicSharedMemorySize, LDS_BYTES) != hipSuccess) { fprintf(stderr, "kernel_launch: hipFuncSetAttribute failed\n"); grid = -1; return; }
        if (hipOccupancyMaxActiveBlocksPerMultiprocessor(&per_cu, (const void*)hybrid_fwd, NTHR, LDS_BYTES) != hipSuccess || per_cu < 1) { fprintf(stderr, "kernel_launch: occupancy query says %d blocks per CU\n", per_cu); }
        (void)hipGetLastError();
        grid = cus;
    }
    if (grid < 0) return;
    (void)hipMemsetAsync((char*)d_ws + WS_CTL, 0, CTL_ZERO_BYTES, stream);
    Args a{};
    for (int i = 0; i < 23; ++i) a.in[i] = (const float*)d_in[i];
    a.out = (float*)d_out; a.ws = (unsigned char*)d_ws;
#if ONE_LAUNCH
    a.ph_lo = 0; a.ph_hi = N_PHASES;
    hipLaunchKernelGGL(hybrid_fwd, dim3(grid), dim3(NTHR), LDS_BYTES, stream, a);
#else
    for (int p = 0; p < N_PHASES; ++p) { a.ph_lo = p; a.ph_hi = p + 1; hipLaunchKernelGGL(hybrid_fwd, dim3(grid), dim3(NTHR), LDS_BYTES, stream, a); }
#endif
}
```

```cpp
#include <hip/hip_runtime.h>
#include <cstdio>
#include <cstdint>

#ifndef ABL_ZERO
#define ABL_ZERO 0
#endif
#ifndef SCL_A
#define SCL_A 1.0f
#define SCL_B 1.0f
#define SCL_C 1.0f
#endif
#ifndef TIMEDUP
#define TIMEDUP 0
#endif
#ifndef ONE_LAUNCH
#define ONE_LAUNCH 1
#endif

#define GAS __attribute__((address_space(1)))
#define LAS __attribute__((address_space(3)))
typedef unsigned short bf16;
typedef unsigned v4u __attribute__((ext_vector_type(4)));
typedef unsigned v2u __attribute__((ext_vector_type(2)));
typedef float f32x4 __attribute__((ext_vector_type(4)));
typedef float f32x2 __attribute__((ext_vector_type(2)));
typedef short bf16x8 __attribute__((ext_vector_type(8)));
typedef short bf16x4 __attribute__((ext_vector_type(4)));

constexpr int NB = 2, SEQ = 16384, T = NB * SEQ, DM = 1024, DFF = 2816, NLAYER = 4;
constexpr int N_IN = 7472;
constexpr int NWAVES = 8, NTHR = 512;
constexpr float RMS_EPS = 1e-6f;
constexpr int NCH = SEQ / 64;

constexpr size_t MiB = 1u << 20;
constexpr size_t WS_CTL = 0, CTL_ZERO_BYTES = 1 * MiB;
constexpr size_t WS_ROPE = 1 * MiB;
constexpr size_t WS_VEC = 5 * MiB;
constexpr size_t WS_WGU1 = 6 * MiB;
constexpr size_t WS_WDN1 = 17 * MiB;
constexpr size_t WS_WGU2 = 23 * MiB;
constexpr size_t WS_WDN2 = 34 * MiB;
constexpr size_t WS_WIN = 40 * MiB;
constexpr size_t WS_WGT = 49 * MiB;
constexpr size_t WS_WBR = 55 * MiB;
constexpr size_t WS_WOUT = 58 * MiB;
constexpr size_t WS_CW1 = 60 * MiB;
constexpr size_t WS_CW2 = 62 * MiB;
constexpr size_t WS_XN = 64 * MiB;
constexpr size_t WS_R = 128 * MiB;
constexpr size_t WS_HID = WS_R;
constexpr size_t WS_QKA = WS_R;
constexpr size_t WS_VA = WS_R + 32 * MiB;
constexpr size_t WS_RA = WS_R + 64 * MiB;
constexpr size_t WS_QB = WS_R + 96 * MiB;
constexpr size_t WS_KVC = WS_R + 128 * MiB;
constexpr size_t WS_KVS = WS_R + 144 * MiB;
constexpr size_t WS_KVW = WS_R + 160 * MiB;
constexpr size_t WS_QKC = WS_R + 176 * MiB;
constexpr size_t WS_VC = WS_R + 208 * MiB;
constexpr size_t WS_OC = WS_R + 240 * MiB;
constexpr size_t WS_SMALL = WS_R + 272 * MiB;
constexpr size_t WS_VST = WS_R + 280 * MiB;
constexpr size_t WS_VWT = WS_R + 288 * MiB;
constexpr size_t WS_KCMP = WS_R + 296 * MiB;
constexpr size_t WS_VCT = WS_KCMP + MiB / 2;
constexpr size_t WS_CMPH = WS_R + 297 * MiB;
constexpr size_t WS_GST = WS_R + 302 * MiB;
constexpr size_t WS_GDEC = WS_R + 334 * MiB;
constexpr size_t WS_MSC = WS_GDEC + MiB / 2;
constexpr size_t WS_MST = WS_R + 335 * MiB;
constexpr size_t WS_MN = WS_R + 367 * MiB;
constexpr size_t WS_G0 = WS_QKA, WS_G1 = WS_QKC, WS_G2 = WS_GST;
constexpr size_t WS_G = WS_G0;
constexpr size_t WS_Y = WS_XN;
constexpr size_t WS_END = WS_R + 368 * MiB;

constexpr int VEC_BINP = 0;
constexpr int VEC_CB1 = 8192;

#define LDS_WAIT() asm volatile("s_waitcnt lgkmcnt(0)" ::: "memory")
#define VM_WAIT() asm volatile("s_waitcnt vmcnt(0)" ::: "memory")
__device__ __forceinline__ unsigned f2bf(float f) { unsigned u = __builtin_bit_cast(unsigned, f); return (u + 0x7fffu + ((u >> 16) & 1u)) >> 16; }
typedef __bf16 bf2_t __attribute__((ext_vector_type(2)));
__device__ __forceinline__ unsigned pk2(float lo, float hi) { const f32x2 v = {lo, hi}; return __builtin_bit_cast(unsigned, __builtin_convertvector(v, bf2_t)); }
__device__ __forceinline__ float bf2f(unsigned v) { return __builtin_bit_cast(float, (v & 0xffffu) << 16); }
__device__ __forceinline__ float bflo(unsigned w) { return __builtin_bit_cast(float, w << 16); }
__device__ __forceinline__ float bfhi(unsigned w) { return __builtin_bit_cast(float, w & 0xffff0000u); }
__device__ __forceinline__ float fexp(float x) { return __builtin_amdgcn_exp2f(x * 1.44269504089f); }
__device__ __forceinline__ float sigmoidf_(float x) { return 1.0f / (1.0f + __expf(-x)); }
__device__ __forceinline__ float siluf_(float x) { return x / (1.0f + __expf(-x)); }
__device__ __forceinline__ float logsigmoidf_(float x) { return fminf(x, 0.f) - __logf(1.0f + __expf(-fabsf(x))); }
__device__ __forceinline__ float wave_sum(float v) {
#pragma unroll
    for (int o = 1; o < 64; o <<= 1) v += __shfl_xor(v, o);
    return v;
}
__device__ __forceinline__ float wave_max(float v) {
#pragma unroll
    for (int o = 1; o < 64; o <<= 1) v = fmaxf(v, __shfl_xor(v, o));
    return v;
}

#define XB_TMO      128
#define XB_XCNT(j)  (256  + 64 * (j))
#define XB_XSUB(j)  (1280 + 64 * (j))
#define XB_XGEN(j)  (2304 + 64 * (j))
#define XB_TOP      3328
#define XB_TOPGEN   3392
#define XCD_BAR_WORDS 3456
#define XB_SPIN_CAP (1u << 24)

__device__ __forceinline__ unsigned xb_ld(unsigned* p)              { return __hip_atomic_load(p, __ATOMIC_RELAXED, __HIP_MEMORY_SCOPE_AGENT); }
__device__ __forceinline__ unsigned xb_add(unsigned* p, unsigned v) { return __hip_atomic_fetch_add(p, v, __ATOMIC_RELAXED, __HIP_MEMORY_SCOPE_AGENT); }
__device__ __forceinline__ unsigned xb_xcc_id() { return (unsigned)__builtin_amdgcn_s_getreg((3 << 11) | 20) & 0xFu; }
#define XB_SPIN(cond, bar) do { unsigned _sp = 0; while (cond) { __builtin_amdgcn_s_sleep(1); \
    if ((++_sp & 255u) == 0u) { if (xb_ld(&(bar)[XB_TMO])) break; if (_sp > XB_SPIN_CAP) { atomicAdd(&(bar)[XB_TMO], 1u); break; } } } } while (0)

struct XcdBarrier {
    unsigned* bar; unsigned x;
    volatile LAS unsigned* st;
};
__device__ __forceinline__ XcdBarrier xcd_barrier_post(unsigned* bar, volatile LAS unsigned* st) {
    XcdBarrier b; b.bar = bar; b.x = xb_xcc_id(); b.st = st;
    if (threadIdx.x == 0) (void)xb_add(&bar[XB_XCNT(b.x)], 1u);
    return b;
}
__device__ __forceinline__ void xcd_barrier_complete(unsigned* bar, unsigned x, unsigned& nloc, unsigned& nx) {
    const unsigned G = gridDim.x * gridDim.y * gridDim.z;
    unsigned sum, cnt, mine, sp = 0u;
    for (;;) {
        sum = 0u; cnt = 0u; mine = 0u;
#pragma unroll
        for (unsigned j = 0; j < 16; ++j) { const unsigned c = xb_ld(&bar[XB_XCNT(j)]); sum += c; cnt += (c > 0u) ? 1u : 0u; mine = (j == x) ? c : mine; }
        if (sum == G) break;
        __builtin_amdgcn_s_sleep(1);
        if ((++sp & 255u) == 0u) { if (xb_ld(&bar[XB_TMO])) break; if (sp > XB_SPIN_CAP) { atomicAdd(&bar[XB_TMO], 1u); break; } }
    }
    nloc = mine > 0u ? mine : 1u; nx = cnt > 0u ? cnt : 1u;
}
__device__ __forceinline__ void xcd_barrier(const XcdBarrier& b) {
    asm volatile("s_waitcnt vmcnt(0)" ::: "memory");
    __syncthreads();
    if (threadIdx.x == 0) {
        unsigned* bar = b.bar;
        __builtin_amdgcn_s_waitcnt(0);
        unsigned nloc = b.st[0], nx = b.st[1];
        if (nloc == 0u) { xcd_barrier_complete(bar, b.x, nloc, nx); b.st[0] = nloc; b.st[1] = nx; }
        const unsigned old = xb_add(&bar[XB_XSUB(b.x)], 1u);
        const unsigned gen = old / nloc;
        if (old + 1u == (gen + 1u) * nloc) {
            __builtin_amdgcn_fence(__ATOMIC_RELEASE, "agent");
            asm volatile("s_waitcnt vmcnt(0)" ::: "memory");
            const unsigned og = xb_add(&bar[XB_TOP], 1u);
            const unsigned tg = og / nx;
            if (og + 1u == (tg + 1u) * nx) xb_add(&bar[XB_TOPGEN], 1u);
            else XB_SPIN(xb_ld(&bar[XB_TOPGEN]) == tg, bar);
            __builtin_amdgcn_fence(__ATOMIC_ACQUIRE, "agent");
            xb_add(&bar[XB_XGEN(b.x)], 1u);
            asm volatile("s_waitcnt vmcnt(0)" ::: "memory");
        } else {
            XB_SPIN(xb_ld(&bar[XB_XGEN(b.x)]) == gen, bar);
            __builtin_amdgcn_fence(__ATOMIC_ACQUIRE, "agent");
            asm volatile("s_waitcnt vmcnt(0)" ::: "memory");
        }
    }
    __syncthreads();
}

namespace pg8 {
#define PG8_LAS __attribute__((address_space(3)))
typedef unsigned short bf16_t;
typedef short bf16x8 __attribute__((ext_vector_type(8)));
typedef float f32x4 __attribute__((ext_vector_type(4)));
typedef unsigned u32x4 __attribute__((ext_vector_type(4)));
constexpr int BM = 256, BK = 64, HALF = 128, HTB = HALF * BK * 2  , STAGE_BYTES = 8 * HTB, NXCD = 8, WGM = 8;

__host__ __device__ __forceinline__ int lds_byte(int r, int c) { const int st = (r >> 4) * 2 + (c >> 5), rr = r & 15, cc = c & 31, ob = rr * 64 + cc * 2; return st * 1024 + (ob ^ (((ob >> 9) & 1) << 5)); }
__host__ __device__ __forceinline__ void stage_rc(int b, int& R, int& C) { const int st = b / 1024, sb = b % 1024, swz = sb ^ (((sb >> 9) & 1) << 5); R = (st >> 1) * 16 + swz / 64; C = (st & 1) * 32 + (swz % 64) / 2; }
__host__ __device__ __forceinline__ int perm32(int rho) { const int n = rho >> 4, i = rho & 15; return 8 * (i >> 2) + 4 * n + (i & 3); }

struct Unit { int pm, pn; };
struct Gemm { const bf16_t* A; const bf16_t* Bt; int M, N, K; };

struct StaticOrder {
    int nM, nN, nwg, G, c;
    __host__ __device__ void init(int M, int N, int G_, int c_) { nM = M / BM; nN = N / BM; nwg = nM * nN; G = G_; c = c_; }
    __host__ __device__ bool next(int i, Unit& u) const {
        const long L = (long)i * G + c; if (L >= nwg) return false;
        int wgid = (int)L; { const int q = nwg / NXCD, r = nwg % NXCD, xcd = wgid % NXCD, off = wgid / NXCD; wgid = (xcd < r ? xcd * (q + 1) : r * (q + 1) + (xcd - r) * q) + off; }
        const int nig = WGM * nN, gid = wgid / nig, fm = gid * WGM, gsz = (nM - fm) < WGM ? (nM - fm) : WGM;
        u.pm = fm + ((wgid % nig) % gsz); u.pn = (wgid % nig) / gsz; return true;
    }
    __device__ __forceinline__ void a_ready(const Unit&) const {}
    __device__ __forceinline__ void done(const Unit&) const {}
};
struct CountedOrder : StaticOrder {
    const unsigned* ready; unsigned need; unsigned* tmo;
    __device__ __forceinline__ void a_ready(const Unit& u) const {
        if (threadIdx.x < 64) {
            const unsigned long long t0 = __builtin_amdgcn_s_memrealtime(); unsigned polls = 0;
            while ((unsigned)__builtin_amdgcn_readfirstlane(__hip_atomic_load(ready + 64 * u.pm, __ATOMIC_RELAXED, __HIP_MEMORY_SCOPE_AGENT)) < need) {
                if ((++polls & 255u) == 0u && __builtin_amdgcn_readfirstlane(__hip_atomic_load(tmo, __ATOMIC_RELAXED, __HIP_MEMORY_SCOPE_AGENT)) != 0u) break;
                if (__builtin_amdgcn_s_memrealtime() - t0 > 2000000ull) {
                    if (threadIdx.x == 0) { unsigned expect = 0u; __hip_atomic_compare_exchange_strong(tmo + 1, &expect, 0x600u | (unsigned)(u.pm & 0xff), __ATOMIC_RELAXED, __ATOMIC_RELAXED, __HIP_MEMORY_SCOPE_AGENT); __hip_atomic_store(tmo, 1u, __ATOMIC_RELAXED, __HIP_MEMORY_SCOPE_AGENT); }
                    break; }
                __builtin_amdgcn_s_sleep(2); }
            __builtin_amdgcn_fence(__ATOMIC_ACQUIRE, "agent");
            asm volatile("s_waitcnt vmcnt(0)" ::: "memory");
        }
#if !defined(BROKEN_HOOK_NO_BARRIER)
        asm volatile("" ::: "memory"); __builtin_amdgcn_s_barrier(); asm volatile("" ::: "memory");
#endif
    }
};

__device__ __forceinline__ unsigned cvt_pk_bf16(float lo, float hi) { unsigned r; asm volatile("v_cvt_pk_bf16_f32 %0, %1, %2" : "=v"(r) : "v"(lo), "v"(hi)); return r; }
typedef float f32x2 __attribute__((ext_vector_type(2)));
__device__ __forceinline__ f32x2 gelu_pk(f32x2 v) {
    const f32x2 av = __builtin_elementwise_abs(v), d = av * 0.2316418882f + 1.0f;
    f32x2 t; t.x = __builtin_amdgcn_rcpf(d.x); t.y = __builtin_amdgcn_rcpf(d.y);
    f32x2 q = t * 0.5307027145f + (-0.7265760135f); q = q * t + 0.7107068705f; q = q * t + (-0.142248368f); q = q * t + 0.127414796f; q = q * t;
    const f32x2 s = (v * v) * (-0.72134752044f);
    f32x2 e; e.x = __builtin_amdgcn_exp2f(s.x); e.y = __builtin_amdgcn_exp2f(s.y);
    const f32x2 m = v * (q * e), r = v - m;
    f32x2 o; o.x = v.x < 0.f ? m.x : r.x; o.y = v.y < 0.f ? m.y : r.y; return o;
}

struct EpiF32 {
    static constexpr bool PERM = false, AFTER_DRAIN = false;
    float* C; int ldc; const float* bias;
    __device__ __forceinline__ void operator()(const f32x4 (&acc)[2][2][4][2], const Unit& u, int wr, int wc, int fr, int fq) const {
        const int row0 = u.pm * BM + wr * 64 + fr, col0 = u.pn * BM + wc * 32 + 4 * fq;
        f32x4 bv[2][2];
#pragma unroll
        for (int bj = 0; bj < 2; ++bj)
#pragma unroll
            for (int n = 0; n < 2; ++n) bv[bj][n] = bias ? *(const f32x4*)(bias + col0 + bj * HALF + n * 16) : (f32x4){0.f, 0.f, 0.f, 0.f};
#pragma unroll
        for (int ai = 0; ai < 2; ++ai)
#pragma unroll
            for (int m = 0; m < 4; ++m) { float* rowp = C + (size_t)(row0 + ai * HALF + m * 16) * ldc + col0;
#pragma unroll
                for (int bj = 0; bj < 2; ++bj)
#pragma unroll
                    for (int n = 0; n < 2; ++n) *(f32x4*)(rowp + bj * HALF + n * 16) = acc[ai][bj][m][n] + bv[bj][n]; }
    }
};
template <int ACT  > struct EpiBf16 {
    static constexpr bool PERM = true, AFTER_DRAIN = false;
    bf16_t* O; int ldc; const float* bias; int split_cols; size_t split_stride;
    __device__ __forceinline__ void operator()(const f32x4 (&acc)[2][2][4][2], const Unit& u, int wr, int wc, int fr, int fq) const {
        const int row0 = u.pm * BM + wr * 64 + fr; int colt = u.pn * BM; bf16_t* base = O;
        if (split_cols) { const int t = colt / split_cols; base += (size_t)t * split_stride; colt -= t * split_cols; }
        const int col0 = colt + wc * 32 + 8 * fq, bcol0 = u.pn * BM + wc * 32 + 8 * fq;
        f32x4 bv[2][2];
#pragma unroll
        for (int bj = 0; bj < 2; ++bj)
#pragma unroll
            for (int n = 0; n < 2; ++n) bv[bj][n] = bias ? *(const f32x4*)(bias + bcol0 + bj * HALF + 4 * n) : (f32x4){0.f, 0.f, 0.f, 0.f};
#pragma unroll
        for (int ai = 0; ai < 2; ++ai)
#pragma unroll
            for (int m = 0; m < 4; ++m) { bf16_t* rowp = base + (size_t)(row0 + ai * HALF + m * 16) * ldc + col0;
#pragma unroll
                for (int bj = 0; bj < 2; ++bj) { f32x4 v0 = acc[ai][bj][m][0] + bv[bj][0], v1 = acc[ai][bj][m][1] + bv[bj][1];
                    if (ACT == 1) { f32x2 a = gelu_pk((f32x2){v0[0], v0[1]}), b = gelu_pk((f32x2){v0[2], v0[3]}), c = gelu_pk((f32x2){v1[0], v1[1]}), d = gelu_pk((f32x2){v1[2], v1[3]});
                        v0 = (f32x4){a.x, a.y, b.x, b.y}; v1 = (f32x4){c.x, c.y, d.x, d.y}; }
                    if (ACT == 2) {
#pragma unroll
                        for (int j = 0; j < 4; ++j) { v0[j] = 0.5f * v0[j] * (1.0f + erff(v0[j] * 0.70710678f)); v1[j] = 0.5f * v1[j] * (1.0f + erff(v1[j] * 0.70710678f)); } }
                    u32x4 w; w.x = cvt_pk_bf16(v0[0], v0[1]); w.y = cvt_pk_bf16(v0[2], v0[3]); w.z = cvt_pk_bf16(v1[0], v1[1]); w.w = cvt_pk_bf16(v1[2], v1[3]);
                    *(u32x4*)(rowp + bj * HALF) = w; } }
    }
};

struct PanelStats {
    unsigned* xbuf;
    unsigned* cnt;
    unsigned* tmo;
    int ntn; float eps;
    unsigned code;
    __device__ __forceinline__ bool run(const f32x4 (&v)[2][2][4][2], const Unit& u, int wr, int wc, int fr, int fq, PG8_LAS unsigned char* lds, int wid, int lane) const {
        typedef float f32x2v __attribute__((ext_vector_type(2)));
        PG8_LAS f32x2v* P = (PG8_LAS f32x2v*)lds;
        PG8_LAS f32x2v* S = (PG8_LAS f32x2v*)(lds + 8192);
        PG8_LAS unsigned* flag = (PG8_LAS unsigned*)(lds + 8192 + 2048);
#pragma unroll
        for (int ai = 0; ai < 2; ++ai)
#pragma unroll
            for (int m = 0; m < 4; ++m) {
                float s = 0.f;
#pragma unroll
                for (int bj = 0; bj < 2; ++bj)
#pragma unroll
                    for (int n = 0; n < 2; ++n) { const f32x4 x = v[ai][bj][m][n]; s += (x[0] + x[1]) + (x[2] + x[3]); }
                s += __shfl_xor(s, 16); s += __shfl_xor(s, 32);
                const float mw = s * (1.0f / 64.0f); float q = 0.f;
#pragma unroll
                for (int bj = 0; bj < 2; ++bj)
#pragma unroll
                    for (int n = 0; n < 2; ++n) { const f32x4 d = v[ai][bj][m][n] - mw; q += (d[0] * d[0] + d[1] * d[1]) + (d[2] * d[2] + d[3] * d[3]); }
                q += __shfl_xor(q, 16); q += __shfl_xor(q, 32);
                if (fq == 0) P[(ai * HALF + wr * 64 + m * 16 + fr) * 4 + wc] = (f32x2v){mw, q};
            }
        asm volatile("s_waitcnt lgkmcnt(0)" ::: "memory"); __builtin_amdgcn_s_barrier(); asm volatile("" ::: "memory");
#if defined(BROKEN_NO_WAIT)
        if (blockIdx.x >= 64) { const long long t0 = clock64(); while (clock64() - t0 < 60000) __builtin_amdgcn_s_sleep(8); }
#endif
        const int row = wid * 32 + (lane & 31);
        if (lane < 32) {
            const f32x2v a = P[row * 4 + 0], b = P[row * 4 + 1], c = P[row * 4 + 2], d = P[row * 4 + 3];
            const float mt = (a.x + b.x + c.x + d.x) * 0.25f;
            const float da = a.x - mt, db = b.x - mt, dc = c.x - mt, dd = d.x - mt;
            const float m2 = (a.y + b.y) + (c.y + d.y) + 64.0f * ((da * da + db * db) + (dc * dc + dd * dd));
            unsigned long long* slot = (unsigned long long*)xbuf + ((size_t)(u.pm * BM + row) * 4 + u.pn);
            __hip_atomic_store(slot, ((unsigned long long)__float_as_uint(m2) << 32) | __float_as_uint(mt), __ATOMIC_RELAXED, __HIP_MEMORY_SCOPE_AGENT);
        }
        asm volatile("s_waitcnt vmcnt(0)" ::: "memory");
        if (lane == 0) __hip_atomic_fetch_add(cnt + 64 * u.pm, 1u, __ATOMIC_RELAXED, __HIP_MEMORY_SCOPE_AGENT);
        if (wid == 0) {
            bool dead = false; const unsigned long long t0 = __builtin_amdgcn_s_memrealtime(); const unsigned want = 8u * (unsigned)ntn;
            for (;;) {
#if defined(BROKEN_NO_WAIT)
                break;
#endif
                if ((unsigned)__builtin_amdgcn_readfirstlane(__hip_atomic_load(cnt + 64 * u.pm, __ATOMIC_RELAXED, __HIP_MEMORY_SCOPE_AGENT)) >= want) break;
                if (__builtin_amdgcn_s_memrealtime() - t0 > 2000000ull) {
                    if (lane == 0) { unsigned expect = 0u; __hip_atomic_compare_exchange_strong(tmo + 1, &expect, code | (unsigned)(u.pm & 0xff), __ATOMIC_RELAXED, __ATOMIC_RELAXED, __HIP_MEMORY_SCOPE_AGENT);
                                     __hip_atomic_store(tmo, 1u, __ATOMIC_RELAXED, __HIP_MEMORY_SCOPE_AGENT); }
                    dead = true; break; }
                __builtin_amdgcn_s_sleep(2);
            }
            __builtin_amdgcn_fence(__ATOMIC_ACQUIRE, "agent");
            if (lane == 0) flag[0] = dead ? 1u : 0u;
        }
        asm volatile("s_waitcnt vmcnt(0) lgkmcnt(0)" ::: "memory"); __builtin_amdgcn_s_barrier(); asm volatile("" ::: "memory");
        const bool bad = flag[0] != 0u;
        if (lane < 32) {
            const unsigned long long* slot = (const unsigned long long*)xbuf + (size_t)(u.pm * BM + row) * 4; float mt[4], m2[4]; float ms = 0.f;
#pragma unroll
            for (int t = 0; t < 4; ++t) { if (t < ntn) { const unsigned long long w = __hip_atomic_load(slot + t, __ATOMIC_RELAXED, __HIP_MEMORY_SCOPE_AGENT); mt[t] = __uint_as_float((unsigned)w); m2[t] = __uint_as_float((unsigned)(w >> 32)); } else { mt[t] = 0.f; m2[t] = 0.f; } ms += mt[t]; }
            const float mean = ms / (float)ntn; float q = 0.f;
#pragma unroll
            for (int t = 0; t < 4; ++t) if (t < ntn) { const float dm = mt[t] - mean; q += m2[t] + 256.0f * dm * dm; }
            S[row] = (f32x2v){mean, 1.0f / sqrtf(q / (256.0f * (float)ntn) + eps)};
        }
        asm volatile("s_waitcnt lgkmcnt(0)" ::: "memory"); __builtin_amdgcn_s_barrier(); asm volatile("" ::: "memory");
        return bad;
    }
};
struct EpiLnRes {
    static constexpr bool PERM = false, AFTER_DRAIN = true;
    const float* base; float* out; int ldc; const float* bias; PanelStats st; unsigned poison;
    __device__ __forceinline__ void refuse(size_t i0, size_t stride, int M, int N) const { const float q = __builtin_nanf(""); for (size_t i = i0; i < (size_t)M * N; i += stride) out[(i / N) * ldc + i % N] = q;
        if (i0 == 0) { unsigned expect = 0u; __hip_atomic_compare_exchange_strong(st.tmo + 1, &expect, 0x7f0u, __ATOMIC_RELAXED, __ATOMIC_RELAXED, __HIP_MEMORY_SCOPE_AGENT); __hip_atomic_store(st.tmo, 1u, __ATOMIC_RELAXED, __HIP_MEMORY_SCOPE_AGENT); } }
    __device__ __forceinline__ void fused(f32x4 (&acc)[2][2][4][2], const Unit& u, int wr, int wc, int fr, int fq, PG8_LAS unsigned char* lds, int wid, int lane) const {
        typedef float f32x2v __attribute__((ext_vector_type(2)));
        const PG8_LAS f32x2v* S = (const PG8_LAS f32x2v*)(lds + 8192);
        const int col0 = u.pn * BM + wc * 32 + 4 * fq;
#pragma unroll
        for (int bj = 0; bj < 2; ++bj)
#pragma unroll
            for (int n = 0; n < 2; ++n) { const f32x4 bv = bias ? *(const f32x4*)(bias + col0 + bj * HALF + n * 16) : (f32x4){0.f, 0.f, 0.f, 0.f};
#pragma unroll
                for (int ai = 0; ai < 2; ++ai)
#pragma unroll
                    for (int m = 0; m < 4; ++m) acc[ai][bj][m][n] += bv; }
        const bool bad = st.run(acc, u, wr, wc, fr, fq, lds, wid, lane) || poison != 0u;
        const float qnan = __builtin_nanf("");
#pragma unroll
        for (int ai = 0; ai < 2; ++ai)
#pragma unroll
            for (int m = 0; m < 4; ++m) { const int r = ai * HALF + wr * 64 + m * 16 + fr; const f32x2v sr = S[r]; const size_t off = (size_t)(u.pm * BM + r) * ldc + col0;
#pragma unroll
                for (int bj = 0; bj < 2; ++bj)
#pragma unroll
                    for (int n = 0; n < 2; ++n) { const f32x4 bs = *(const f32x4*)(base + off + bj * HALF + n * 16); f32x4 o = bs + (acc[ai][bj][m][n] - sr.x) * sr.y;
                        if (bad) o = (f32x4){qnan, qnan, qnan, qnan}; *(f32x4*)(out + off + bj * HALF + n * 16) = o; }
                asm volatile("" ::: "memory"); }
    }
};
struct EpiLnResLn {
    static constexpr bool PERM = false, AFTER_DRAIN = true;
    const float* base; float* out; bf16_t* xn; int ldc; const float* bias; PanelStats st1, st2; unsigned poison;
    __device__ __forceinline__ void refuse(size_t i0, size_t stride, int M, int N) const { const float q = __builtin_nanf(""); for (size_t i = i0; i < (size_t)M * N; i += stride) { const size_t o = (i / N) * ldc + i % N; out[o] = q; xn[o] = (bf16_t)0x7fc0u; }
        if (i0 == 0) { unsigned expect = 0u; __hip_atomic_compare_exchange_strong(st1.tmo + 1, &expect, 0x7f0u, __ATOMIC_RELAXED, __ATOMIC_RELAXED, __HIP_MEMORY_SCOPE_AGENT); __hip_atomic_store(st1.tmo, 1u, __ATOMIC_RELAXED, __HIP_MEMORY_SCOPE_AGENT); } }
    __device__ __forceinline__ void fused(f32x4 (&acc)[2][2][4][2], const Unit& u, int wr, int wc, int fr, int fq, PG8_LAS unsigned char* lds, int wid, int lane) const {
        typedef float f32x2v __attribute__((ext_vector_type(2))); typedef unsigned u32x2v __attribute__((ext_vector_type(2)));
        const PG8_LAS f32x2v* S = (const PG8_LAS f32x2v*)(lds + 8192);
        const int col0 = u.pn * BM + wc * 32 + 4 * fq;
#pragma unroll
        for (int bj = 0; bj < 2; ++bj)
#pragma unroll
            for (int n = 0; n < 2; ++n) { const f32x4 bv = bias ? *(const f32x4*)(bias + col0 + bj * HALF + n * 16) : (f32x4){0.f, 0.f, 0.f, 0.f};
#pragma unroll
                for (int ai = 0; ai < 2; ++ai)
#pragma unroll
                    for (int m = 0; m < 4; ++m) acc[ai][bj][m][n] += bv; }
        bool bad = st1.run(acc, u, wr, wc, fr, fq, lds, wid, lane) || poison != 0u;
        const float qnan = __builtin_nanf("");
#pragma unroll
        for (int ai = 0; ai < 2; ++ai)
#pragma unroll
            for (int m = 0; m < 4; ++m) { const int r = ai * HALF + wr * 64 + m * 16 + fr; const f32x2v sr = S[r]; const size_t off = (size_t)(u.pm * BM + r) * ldc + col0;
#pragma unroll
                for (int bj = 0; bj < 2; ++bj)
#pragma unroll
                    for (int n = 0; n < 2; ++n) { const f32x4 bs = *(const f32x4*)(base + off + bj * HALF + n * 16); acc[ai][bj][m][n] = bs + (acc[ai][bj][m][n] - sr.x) * sr.y; }
                asm volatile("" : "+v"(acc[ai][0][m][0]), "+v"(acc[ai][0][m][1]), "+v"(acc[ai][1][m][0]), "+v"(acc[ai][1][m][1]));
                if (m & 1) asm volatile("" ::: "memory"); }
        const bool bad1 = bad;
        bad = st2.run(acc, u, wr, wc, fr, fq, lds, wid, lane) || bad;
#pragma unroll
        for (int ai = 0; ai < 2; ++ai)
#pragma unroll
            for (int m = 0; m < 4; ++m) { const int r = ai * HALF + wr * 64 + m * 16 + fr; const f32x2v sr = S[r]; const size_t off = (size_t)(u.pm * BM + r) * ldc + col0;
#pragma unroll
                for (int bj = 0; bj < 2; ++bj)
#pragma unroll
                    for (int n = 0; n < 2; ++n) { const f32x4 x1 = acc[ai][bj][m][n]; *(f32x4*)(out + off + bj * HALF + n * 16) = bad1 ? (f32x4){qnan, qnan, qnan, qnan} : x1;
                        const f32x4 o = (x1 - sr.x) * sr.y; u32x2v w; w.x = cvt_pk_bf16(o[0], o[1]); w.y = cvt_pk_bf16(o[2], o[3]);
                        if (bad) { w.x = 0x7fc07fc0u; w.y = 0x7fc07fc0u; } *(u32x2v*)(xn + off + bj * HALF + n * 16) = w; }
                asm volatile("" ::: "memory"); }
    }
};

template <class Epi, class Sched, bool STAMP = false>
__device__ __forceinline__ void gemm_phase(PG8_LAS unsigned char* lds, const Gemm g, const Sched& S, const Epi& E, unsigned long long* stamps) {
    int tid_ = threadIdx.x; asm volatile("" : "+v"(tid_));
    const int tid = tid_, wid = __builtin_amdgcn_readfirstlane(tid >> 6), lane = tid & 63, wr = wid >> 2, wc = wid & 3, fr = lane & 15, fq = lane >> 4;
    const int K = g.K, nt = K / BK;
    int ts_lo = 0, ts_hi = 0, nts = 0; const unsigned long long rt_entry = STAMP ? (unsigned long long)wall_clock64() : 0ull;
#define PG8_STAMP() do { if (STAMP && wid == 0 && nts < 64) { const unsigned long long _c = (unsigned long long)clock64(); \
        ts_lo = (lane == nts) ? (int)(unsigned)_c : ts_lo; ts_hi = (lane == nts) ? (int)(unsigned)(_c >> 32) : ts_hi; ++nts; } } while (0)
    PG8_STAMP();
    unsigned voffA[2], voffB[2];
#pragma unroll
    for (int i = 0; i < 2; ++i) { int R, C; stage_rc(tid * 16 + i * 8192, R, C); const int Rb = Epi::PERM ? ((R & ~31) + perm32(R & 31)) : R;
        voffA[i] = (unsigned)(R * K + C) * 2u; voffB[i] = (unsigned)(Rb * K + C) * 2u; }
    const size_t kstep = (size_t)(BK * 2);
    const size_t hstep = (size_t)HALF * K * 2;
    const size_t tstep = 2 * hstep;
    const unsigned ldsw = (unsigned)wid * 1024u;
    const int aoff = lds_byte(wr * 64 + fr, fq * 8), boff = lds_byte(wc * 32 + fr, fq * 8);
#define PG8_SA(b, h) (((b) * 2 + (h)) * HTB)
#define PG8_SB(b, h) ((4 + (b) * 2 + (h)) * HTB)
#define PG8_STAGE(bufoff, gbase, voff) do { _Pragma("unroll") for (int _i = 0; _i < 2; ++_i) \
        __builtin_amdgcn_global_load_lds((const unsigned*)((const char*)(gbase) + (voff)[_i]), (PG8_LAS unsigned*)(lds + (bufoff) + ldsw + _i * 8192), 16, 0, 0); } while (0)
#define PG8_LDA(dst, b, h) do { _Pragma("unroll") for (int m = 0; m < 4; ++m) _Pragma("unroll") for (int k = 0; k < 2; ++k) dst[m][k] = *(const PG8_LAS bf16x8*)(lds + PG8_SA(b, h) + aoff + m * 2048 + k * 1024); } while (0)
#define PG8_LDB(dst, b, h) do { _Pragma("unroll") for (int n = 0; n < 2; ++n) _Pragma("unroll") for (int k = 0; k < 2; ++k) dst[n][k] = *(const PG8_LAS bf16x8*)(lds + PG8_SB(b, h) + boff + n * 2048 + k * 1024); } while (0)
#define PG8_MMA(ai, bj, At, Bt) do { __builtin_amdgcn_s_setprio(1); _Pragma("unroll") for (int m = 0; m < 4; ++m) _Pragma("unroll") for (int n = 0; n < 2; ++n) _Pragma("unroll") for (int k = 0; k < 2; ++k) \
        acc[ai][bj][m][n] = __builtin_amdgcn_mfma_f32_16x16x32_bf16(Bt[n][k], At[m][k], acc[ai][bj][m][n], 0, 0, 0); __builtin_amdgcn_s_setprio(0); } while (0)
#define PG8_WAIT_V(n) asm volatile("s_waitcnt vmcnt(" #n ")" ::: "memory")
#define PG8_WAIT_L(n) asm volatile("s_waitcnt lgkmcnt(" #n ")" ::: "memory")
#define PG8_BAR __builtin_amdgcn_s_barrier()
#define PG8_SCHED __builtin_amdgcn_sched_barrier(0)
    Unit cur, nxt; int ui = 0;
    if (!S.next(0, cur)) return;
    f32x4 acc[2][2][4][2];
#pragma unroll
    for (int a = 0; a < 2; ++a)
#pragma unroll
        for (int b = 0; b < 2; ++b)
#pragma unroll
            for (int m = 0; m < 4; ++m)
#pragma unroll
                for (int n = 0; n < 2; ++n) acc[a][b][m][n] = (f32x4){0.f, 0.f, 0.f, 0.f};
    bf16x8 At[4][2], B0[2][2], B1[2][2];
    const char* cA = (const char*)g.A + (size_t)cur.pm * tstep; const char* cB = (const char*)g.Bt + (size_t)cur.pn * tstep;
    S.a_ready(cur);
    PG8_STAGE(PG8_SB(0, 0), cB, voffB); PG8_STAGE(PG8_SA(0, 0), cA, voffA); PG8_STAGE(PG8_SB(0, 1), cB + hstep, voffB); PG8_STAGE(PG8_SA(0, 1), cA + hstep, voffA);
    if (wr == 1) PG8_BAR;
    PG8_WAIT_V(4); PG8_BAR;
    PG8_STAGE(PG8_SB(1, 0), cB + kstep, voffB); PG8_STAGE(PG8_SA(1, 0), cA + kstep, voffA); PG8_STAGE(PG8_SB(1, 1), cB + hstep + kstep, voffB);
    PG8_WAIT_V(6); PG8_BAR;
    PG8_STAMP();
    for (;;) {
        const bool has_next = S.next(ui + 1, nxt);
        const char* nA = has_next ? (const char*)g.A + (size_t)nxt.pm * tstep : cA; const char* nB = has_next ? (const char*)g.Bt + (size_t)nxt.pn * tstep : cB;
        for (int t = 0; t < nt; t += 2) {
            const bool last = (t == nt - 2);
            const char* a1 = cA + (size_t)(t + 1) * kstep;
            const char* a2 = last ? nA : cA + (size_t)(t + 2) * kstep; const char* b2 = last ? nB : cB + (size_t)(t + 2) * kstep;
            const char* a3 = a2 + kstep; const char* b3 = b2 + kstep;
            if (last && has_next) S.a_ready(nxt);
            PG8_LDB(B0, 0, 0); PG8_SCHED; PG8_LDA(At, 0, 0); PG8_STAGE(PG8_SA(1, 1), a1 + hstep, voffA);
            PG8_WAIT_L(8); PG8_BAR; PG8_WAIT_L(0); PG8_MMA(0, 0, At, B0); PG8_BAR; PG8_SCHED;
            PG8_LDB(B1, 0, 1); PG8_STAGE(PG8_SB(0, 0), b2, voffB);
            PG8_BAR; PG8_WAIT_L(0); PG8_MMA(0, 1, At, B1); PG8_BAR;
            PG8_LDA(At, 0, 1); PG8_STAGE(PG8_SA(0, 0), a2, voffA);
            PG8_BAR; PG8_WAIT_L(0); PG8_MMA(1, 0, At, B0); PG8_BAR; PG8_SCHED;
            PG8_STAGE(PG8_SB(0, 1), b2 + hstep, voffB);
            PG8_WAIT_V(6); PG8_BAR; PG8_MMA(1, 1, At, B1); PG8_BAR;
            PG8_LDB(B0, 1, 0); PG8_SCHED; PG8_LDA(At, 1, 0); PG8_STAGE(PG8_SA(0, 1), a2 + hstep, voffA);
            PG8_WAIT_L(8); PG8_BAR; PG8_WAIT_L(0); PG8_MMA(0, 0, At, B0); PG8_BAR; PG8_SCHED;
            PG8_LDB(B1, 1, 1); PG8_STAGE(PG8_SB(1, 0), b3, voffB);
            PG8_BAR; PG8_WAIT_L(0); PG8_MMA(0, 1, At, B1); PG8_BAR;
            PG8_LDA(At, 1, 1); PG8_STAGE(PG8_SA(1, 0), a3, voffA);
            PG8_BAR; PG8_WAIT_L(0); PG8_MMA(1, 0, At, B0); PG8_BAR; PG8_SCHED;
            PG8_STAGE(PG8_SB(1, 1), b3 + hstep, voffB);
            PG8_WAIT_V(6); PG8_BAR; PG8_MMA(1, 1, At, B1); PG8_BAR;
        }
        PG8_STAMP();
        if constexpr (!Epi::AFTER_DRAIN) { E(acc, cur, wr, wc, fr, fq); S.done(cur); }
        PG8_STAMP();
        if (!has_next) break;
#pragma unroll
        for (int a = 0; a < 2; ++a)
#pragma unroll
            for (int b = 0; b < 2; ++b)
#pragma unroll
                for (int m = 0; m < 4; ++m)
#pragma unroll
                    for (int n = 0; n < 2; ++n) acc[a][b][m][n] = (f32x4){0.f, 0.f, 0.f, 0.f};
        cur = nxt; cA = nA; cB = nB; ++ui;
    }
    PG8_WAIT_V(0);
    if (wr == 0) PG8_BAR;
    PG8_BAR;
    if constexpr (Epi::AFTER_DRAIN) { E.fused(acc, cur, wr, wc, fr, fq, lds, wid, lane); S.done(cur); }
    PG8_STAMP();
    if (STAMP && wid == 0) { stamps[lane] = lane < nts ? (((unsigned long long)(unsigned)ts_hi << 32) | (unsigned)ts_lo) : 0ull;
        if (lane == 62) stamps[62] = rt_entry; if (lane == 63) stamps[63] = (unsigned long long)wall_clock64(); }
#undef PG8_STAMP
#undef PG8_SA
#undef PG8_SB
#undef PG8_STAGE
#undef PG8_LDA
#undef PG8_LDB
#undef PG8_MMA
#undef PG8_WAIT_V
#undef PG8_WAIT_L
#undef PG8_BAR
#undef PG8_SCHED
}
}

namespace pg8 {
__device__ __forceinline__ float fast_sigmoid(float x) { return __builtin_amdgcn_rcpf(1.0f + __builtin_amdgcn_exp2f(-1.44269504089f * x)); }
struct EpiSwiGLU {
    static constexpr bool PERM = true, AFTER_DRAIN = false;
    bf16_t* H; int ldh; int cheap;
    __device__ __forceinline__ void operator()(const f32x4 (&acc)[2][2][4][2], const Unit& u, int wr, int wc, int fr, int fq) const {
        const int row0 = u.pm * BM + wr * 64 + fr, hc0 = u.pn * 128 + wc * 32 + 8 * fq;
#pragma unroll
        for (int ai = 0; ai < 2; ++ai)
#pragma unroll
            for (int m = 0; m < 4; ++m) {
                bf16_t* rowp = H + (size_t)(row0 + ai * HALF + m * 16) * ldh + hc0;
                float v[8];
#pragma unroll
                for (int n = 0; n < 2; ++n)
#pragma unroll
                    for (int j = 0; j < 4; ++j) { const float g = acc[ai][0][m][n][j], up = acc[ai][1][m][n][j]; v[n * 4 + j] = cheap ? g * up : g * fast_sigmoid(g) * up; }
                u32x4 w; w.x = cvt_pk_bf16(v[0], v[1]); w.y = cvt_pk_bf16(v[2], v[3]); w.z = cvt_pk_bf16(v[4], v[5]); w.w = cvt_pk_bf16(v[6], v[7]);
                *(u32x4*)rowp = w;
            }
    }
};
struct EpiResid {
    static constexpr bool PERM = false, AFTER_DRAIN = false;
    float* X; int ldc; float alpha; const float* Xsrc;
    __device__ __forceinline__ void operator()(const f32x4 (&acc)[2][2][4][2], const Unit& u, int wr, int wc, int fr, int fq) const {
        const int row0 = u.pm * BM + wr * 64 + fr, col0 = u.pn * BM + wc * 32 + 4 * fq;
#pragma unroll
        for (int ai = 0; ai < 2; ++ai)
#pragma unroll
            for (int m = 0; m < 4; ++m) { const size_t ro = (size_t)(row0 + ai * HALF + m * 16) * ldc + col0;
#pragma unroll
                for (int bj = 0; bj < 2; ++bj)
#pragma unroll
                    for (int n = 0; n < 2; ++n) { const f32x4 old = *(const f32x4*)(Xsrc + ro + bj * HALF + n * 16); *(f32x4*)(X + ro + bj * HALF + n * 16) = old + acc[ai][bj][m][n] * alpha; } }
    }
};
struct EpiWin {
    static constexpr bool PERM = true, AFTER_DRAIN = false;
    unsigned char* zbase; const float* bias; float* small_out;
    __device__ __forceinline__ void operator()(const f32x4 (&acc)[2][2][4][2], const Unit& u, int wr, int wc, int fr, int fq) const {
        const int row0 = u.pm * BM + wr * 64 + fr; const int pn = u.pn;
        const int bcol0 = pn * BM + wc * 32 + 8 * fq;
        f32x4 bv[2][2];
#pragma unroll
        for (int bj = 0; bj < 2; ++bj)
#pragma unroll
            for (int n = 0; n < 2; ++n) bv[bj][n] = *(const f32x4*)(bias + bcol0 + bj * HALF + 4 * n);
        if (pn == 17) {
            if (wc < 2) {
#pragma unroll
                for (int ai = 0; ai < 2; ++ai)
#pragma unroll
                    for (int m = 0; m < 4; ++m) { float* rowp = small_out + (size_t)(row0 + ai * HALF + m * 16) * 64 + wc * 32 + 8 * fq;
#pragma unroll
                        for (int n = 0; n < 2; ++n) *(f32x4*)(rowp + 4 * n) = acc[ai][0][m][n] + bv[0][n]; }
            }
            return;
        }
        size_t base; int ld, c0;
        if (pn < 8) { base = (size_t)(pn >> 1) * ((size_t)T * 512 * 2); ld = 512; c0 = (pn & 1) * 256; }
        else if (pn < 11) { base = (size_t)4 * T * 512 * 2 + (size_t)(pn - 8) * ((size_t)T * 256 * 2); ld = 256; c0 = 0; }
        else { base = (size_t)4 * T * 512 * 2 + (size_t)3 * T * 256 * 2 + (size_t)((pn - 11) >> 1) * ((size_t)T * 512 * 2); ld = 512; c0 = ((pn - 11) & 1) * 256; }
        bf16_t* O = (bf16_t*)(zbase + base);
        const int col0 = c0 + wc * 32 + 8 * fq;
#pragma unroll
        for (int ai = 0; ai < 2; ++ai)
#pragma unroll
            for (int m = 0; m < 4; ++m) { bf16_t* rowp = O + (size_t)(row0 + ai * HALF + m * 16) * ld + col0;
#pragma unroll
                for (int bj = 0; bj < 2; ++bj) { const f32x4 v0 = acc[ai][bj][m][0] + bv[bj][0], v1 = acc[ai][bj][m][1] + bv[bj][1];
                    u32x4 w; w.x = cvt_pk_bf16(v0[0], v0[1]); w.y = cvt_pk_bf16(v0[2], v0[3]); w.z = cvt_pk_bf16(v1[0], v1[1]); w.w = cvt_pk_bf16(v1[2], v1[3]);
                    *(u32x4*)(rowp + bj * HALF) = w; } }
    }
};
struct EpiGate {
    static constexpr bool PERM = true, AFTER_DRAIN = false;
    unsigned char* ws; int ldc; const float* bias;
    __device__ __forceinline__ void operator()(const f32x4 (&acc)[2][2][4][2], const Unit& u, int wr, int wc, int fr, int fq) const {
        const int br = u.pn >> 2;
        bf16_t* G = (bf16_t*)(ws + WS_G0 + (size_t)(br >= 1) * (WS_G1 - WS_G0) + (size_t)(br >= 2) * (WS_G2 - WS_G1));
        const int row0 = u.pm * BM + wr * 64 + fr, col0 = (u.pn & 3) * BM + wc * 32 + 8 * fq, bcol0 = u.pn * BM + wc * 32 + 8 * fq;
        f32x4 bv[2][2];
#pragma unroll
        for (int bj = 0; bj < 2; ++bj)
#pragma unroll
            for (int n = 0; n < 2; ++n) bv[bj][n] = *(const f32x4*)(bias + bcol0 + bj * HALF + 4 * n);
#pragma unroll
        for (int ai = 0; ai < 2; ++ai)
#pragma unroll
            for (int m = 0; m < 4; ++m) { bf16_t* rowp = G + (size_t)(row0 + ai * HALF + m * 16) * ldc + col0;
#pragma unroll
                for (int bj = 0; bj < 2; ++bj) { f32x4 v0 = acc[ai][bj][m][0] + bv[bj][0], v1 = acc[ai][bj][m][1] + bv[bj][1];
                    u32x4 w; w.x = cvt_pk_bf16(v0[0], v0[1]); w.y = cvt_pk_bf16(v0[2], v0[3]); w.z = cvt_pk_bf16(v1[0], v1[1]); w.w = cvt_pk_bf16(v1[2], v1[3]);
                    *(u32x4*)(rowp + bj * HALF) = w; } }
    }
};
struct EpiBranch {
    static constexpr bool PERM = true, AFTER_DRAIN = false;
    bf16_t* Y; const bf16_t* G; int ldc; int first;
    __device__ __forceinline__ void operator()(const f32x4 (&acc)[2][2][4][2], const Unit& u, int wr, int wc, int fr, int fq) const {
        const int row0 = u.pm * BM + wr * 64 + fr, col0 = u.pn * BM + wc * 32 + 8 * fq;
#pragma unroll
        for (int ai = 0; ai < 2; ++ai)
#pragma unroll
            for (int m = 0; m < 4; ++m) { const size_t off = (size_t)(row0 + ai * HALF + m * 16) * ldc + col0;
#pragma unroll
                for (int bj = 0; bj < 2; ++bj) {
                    const u32x4 g = *(const u32x4*)(G + off + bj * HALF);
                    u32x4 y = (u32x4){0u, 0u, 0u, 0u}; if (!first) y = *(const u32x4*)(Y + off + bj * HALF);
                    const f32x4 a0 = acc[ai][bj][m][0], a1 = acc[ai][bj][m][1];
                    float o[8];
#pragma unroll
                    for (int q = 0; q < 4; ++q) { const unsigned gw = g[q], yw = y[q]; const float al = q < 2 ? a0[2 * q] : a1[2 * q - 4], ah = q < 2 ? a0[2 * q + 1] : a1[2 * q - 3];
                        o[2 * q] = __builtin_bit_cast(float, yw << 16) + fast_sigmoid(__builtin_bit_cast(float, gw << 16)) * al;
                        o[2 * q + 1] = __builtin_bit_cast(float, yw & 0xffff0000u) + fast_sigmoid(__builtin_bit_cast(float, gw & 0xffff0000u)) * ah; }
                    u32x4 w; w.x = cvt_pk_bf16(o[0], o[1]); w.y = cvt_pk_bf16(o[2], o[3]); w.z = cvt_pk_bf16(o[4], o[5]); w.w = cvt_pk_bf16(o[6], o[7]);
                    if (first == 2) asm volatile("" :: "v"(w)); else *(u32x4*)(Y + off + bj * HALF) = w; } }
    }
};
}

constexpr int RING_BYTES = 131072;
constexpr int MISC_OFF = RING_BYTES + 320;
constexpr int LDS_BYTES = 147456;

__constant__ float ROPE_FREQ[32] = {
1.000000000e+00f, 7.498942614e-01f, 5.623413324e-01f, 4.216965139e-01f, 3.162277639e-01f, 2.371373773e-01f, 1.778279394e-01f, 1.333521307e-01f, 1.000000015e-01f, 7.498941571e-02f, 5.623413250e-02f, 4.216965288e-02f, 3.162277490e-02f, 2.371373773e-02f, 1.778279431e-02f, 1.333521493e-02f, 9.999999776e-03f, 7.498941850e-03f, 5.623413250e-03f, 4.216964822e-03f, 3.162277630e-03f, 2.371373586e-03f, 1.778279431e-03f, 1.333521446e-03f, 1.000000047e-03f, 7.498942432e-04f, 5.623413017e-04f, 4.216965172e-04f, 3.162277571e-04f, 2.371373703e-04f, 1.778279402e-04f, 1.333521504e-04f};

struct Args { const float* in[23]; float* out; unsigned char* ws; int ph_lo, ph_hi; };

struct Ctx {
    LAS unsigned char* lds;
    int tid, lane, wave, G, bid;
    __device__ __forceinline__ void launder() { asm volatile("" : "+v"(tid)); lane = tid & 63; asm volatile("" : "+s"(inp));
        GAS unsigned char* g = (GAS unsigned char*)ws; asm volatile("" : "+s"(g)); ws = (unsigned char*)g;
        GAS float* gx = (GAS float*)X; asm volatile("" : "+s"(gx)); X = (float*)gx; }
    const GAS float* const __attribute__((address_space(4)))* inp; float* X; unsigned char* ws;
    __device__ __forceinline__ const float* in(int k) const { return (const float*)inp[k]; }
};

__device__ __forceinline__ void transpose_item(const float* W, int ldw, int src_col0, bf16* WT, int K, int dst_row0, int kb, LAS float* scr, int lane) {
    const int k0 = 64 * kb;
#pragma unroll 8
    for (int i = 0; i < 32; ++i) { const int kk = 2 * i + (lane >> 5); scr[kk * 33 + (lane & 31)] = W[(size_t)(k0 + kk) * ldw + src_col0 + (lane & 31)]; }
    LDS_WAIT(); asm volatile("" ::: "memory");
    const int c = lane & 7;
#pragma unroll
    for (int j = 0; j < 4; ++j) { const int n = (lane >> 3) + 8 * j; const LAS float* s = scr + (8 * c) * 33 + n;
        v4u o; o.x = pk2(s[0 * 33], s[1 * 33]); o.y = pk2(s[2 * 33], s[3 * 33]); o.z = pk2(s[4 * 33], s[5 * 33]); o.w = pk2(s[6 * 33], s[7 * 33]);
        *(v4u*)(WT + (size_t)(dst_row0 + n) * K + k0 + 8 * c) = o; }
    LDS_WAIT(); asm volatile("" ::: "memory");
}
__device__ __forceinline__ int win_small_src(int i) { return i < 16 ? 1536 + i : i < 40 ? 2832 + (i - 16) : i < 44 ? 4392 + (i - 40) : i < 48 ? 4396 + (i - 44) : -1; }
__device__ __forceinline__ int win_src_col(int n) { return n < 1536 ? n : n < 2816 ? n + 16 : n < 4352 ? n + 40 : win_small_src(n - 4352); }

__device__ __forceinline__ void phase_prep_weights(const Ctx& C, int l) {
    LAS float* scr = (LAS float*)(C.lds + C.wave * 16384);
    const int gw = C.bid * NWAVES + C.wave, NGW = C.G * NWAVES;
    unsigned char* ws = C.ws;
    constexpr int I_GU = 16 * 88, I_DN = 44 * 32, I_WIN = 16 * 136, I_GT = 16 * 96, I_BR = 3 * 8 * 32, I_OUT = 16 * 32, I_C1 = 2 * 32 * 8, I_C2 = 2 * 4 * 2;
    constexpr int I_FFN = 2 * I_GU + I_DN;
    constexpr int NITEMS = 2 * I_FFN + I_WIN + I_GT + I_BR + I_OUT + I_C1 + I_C2;
    for (int it = gw; it < NITEMS; it += NGW) {
        int r = it;
        if (r < 2 * I_FFN) {
            const int f = r / I_FFN; r -= f * I_FFN;
            const float* wg = (f ? C.in(20) : C.in(2)) + (size_t)l * DM * DFF; const float* wu = (f ? C.in(21) : C.in(3)) + (size_t)l * DM * DFF; const float* wd = (f ? C.in(22) : C.in(4)) + (size_t)l * DFF * DM;
            bf16* WGU = (bf16*)(ws + (f ? WS_WGU2 : WS_WGU1)); bf16* WDN = (bf16*)(ws + (f ? WS_WDN2 : WS_WDN1));
            if (r < I_GU) { const int kb = r / 88, col = 32 * (r % 88); transpose_item(wg, DFF, col, WGU, DM, 256 * (col >> 7) + (col & 127), kb, scr, C.lane); }
            else if (r < 2 * I_GU) { r -= I_GU; const int kb = r / 88, col = 32 * (r % 88); transpose_item(wu, DFF, col, WGU, DM, 256 * (col >> 7) + 128 + (col & 127), kb, scr, C.lane); }
            else { r -= 2 * I_GU; const int kb = r / 32, col = 32 * (r % 32); transpose_item(wd, DM, col, WDN, DFF, col, kb, scr, C.lane); }
            continue;
        }
        r -= 2 * I_FFN;
        const float* win = C.in(6) + (size_t)l * DM * N_IN;
        if (r < I_WIN) { const int kb = r / 136, n = 32 * (r % 136); transpose_item(win, N_IN, win_src_col(n), (bf16*)(ws + WS_WIN), DM, n, kb, scr, C.lane); continue; } r -= I_WIN;
        if (r < I_GT) { const int kb = r / 96, n = 32 * (r % 96); transpose_item(win, N_IN, 4400 + n, (bf16*)(ws + WS_WGT), DM, n, kb, scr, C.lane); continue; } r -= I_GT;
        if (r < I_BR) { const int i = r / 256, rr = r % 256, kb = rr / 32, n = 32 * (rr % 32);
            transpose_item(C.in(17) + ((size_t)l * 3 + i) * 512 * DM, DM, n, (bf16*)(ws + WS_WBR) + (size_t)i * DM * 512, 512, n, kb, scr, C.lane); continue; } r -= I_BR;
        if (r < I_OUT) { const int kb = r / 32, n = 32 * (r % 32); transpose_item(C.in(18) + (size_t)l * DM * DM, DM, n, (bf16*)(ws + WS_WOUT), DM, n, kb, scr, C.lane); continue; } r -= I_OUT;
        if (r < I_C1) { const int kv = r / 256, rr = r % 256, kb = rr / 8, n = 32 * (rr % 8);
            transpose_item(C.in(13) + ((size_t)l * 2 + kv) * 2048 * 256, 256, n, (bf16*)(ws + WS_CW1) + (size_t)kv * 256 * 2048, 2048, n, kb, scr, C.lane); continue; } r -= I_C1;
        { const int kv = r / 8, rr = r % 8, kb = rr / 2, n = 32 * (rr % 2);
            transpose_item(C.in(14) + ((size_t)l * 2 + kv) * 256 * 64, 64, n, (bf16*)(ws + WS_CW2) + (size_t)kv * 64 * 256, 256, n, kb, scr, C.lane); }
    }
    const int gt = C.bid * NTHR + C.tid, NGT = C.G * NTHR;
    {
        const float* win = C.in(6) + (size_t)l * DM * N_IN; bf16* WIN = (bf16*)(ws + WS_WIN);
        for (int idx = gt; idx < 256 * 128; idx += NGT) { const int i = idx & 255, kc = idx >> 8; const int sc = win_small_src(i);
            v4u o = (v4u){0u, 0u, 0u, 0u};
            if (sc >= 0) { float v[8];
#pragma unroll
                for (int j = 0; j < 8; ++j) v[j] = win[(size_t)(kc * 8 + j) * N_IN + sc];
                o.x = pk2(v[0], v[1]); o.y = pk2(v[2], v[3]); o.z = pk2(v[4], v[5]); o.w = pk2(v[6], v[7]); }
            *(v4u*)(WIN + (size_t)(4352 + i) * DM + kc * 8) = o; }
        float* vec = (float*)(ws + WS_VEC); const float* bin = C.in(7) + (size_t)l * N_IN;
        for (int n = gt; n < 4608; n += NGT) { const int sc = win_src_col(n); vec[VEC_BINP + n] = sc >= 0 ? bin[sc] : 0.f; }
        for (int it = gw; it < 512; it += NGW) { const int kv = it >> 8, n = it & 255;
            const float* pe = C.in(12) + ((size_t)l * 2 + kv) * 2048; const float* w1 = C.in(13) + ((size_t)l * 2 + kv) * 2048 * 256;
            float s = 0.f;
            for (int k = C.lane; k < 2048; k += 64) s += pe[k] * w1[(size_t)k * 256 + n];
            s = wave_sum(s);
            if (C.lane == 0) vec[VEC_CB1 + it] = s; }
    }
}

__device__ __forceinline__ void phase_init(const Ctx& C) {
    const int gt = C.bid * NTHR + C.tid, NGT = C.G * NTHR;
    f32x2* rope = (f32x2*)(C.ws + WS_ROPE);
    for (int i = gt; i < SEQ * 32; i += NGT) { const int pos = i >> 5, fi = i & 31;
        const float ang = (float)pos * ROPE_FREQ[fi];
        double rev = (double)ang * 0.15915494309189533577; rev -= floor(rev);
        const float rf = (float)rev;
        rope[i] = (f32x2){__builtin_amdgcn_cosf(rf), __builtin_amdgcn_sinf(rf)}; }
}

__device__ __forceinline__ void phase_norm(const Ctx& C, const float* gain, const float* Xsrc) {
    const int gw = C.bid * NWAVES + C.wave, NGW = C.G * NWAVES;
    bf16* XN = (bf16*)(C.ws + WS_XN);
    f32x4 g[4];
#pragma unroll
    for (int j = 0; j < 4; ++j) g[j] = ((const f32x4*)gain)[C.lane + 64 * j];
    for (int m = gw; m < T; m += NGW) {
        const f32x4* xr = (const f32x4*)(Xsrc + (size_t)m * DM) + C.lane;
        f32x4 v[4]; float s = 0.f;
#pragma unroll
        for (int j = 0; j < 4; ++j) { v[j] = xr[64 * j]; s += (v[j].x * v[j].x + v[j].y * v[j].y) + (v[j].z * v[j].z + v[j].w * v[j].w); }
        const float r = 1.0f / sqrtf(wave_sum(s) * (1.f / DM) + RMS_EPS);
        unsigned long long* o8 = (unsigned long long*)(XN + (size_t)m * DM) + C.lane;
#pragma unroll
        for (int j = 0; j < 4; ++j) { const f32x4 w = v[j] * r * g[j]; o8[64 * j] = (unsigned long long)pk2(w.x, w.y) | ((unsigned long long)pk2(w.z, w.w) << 32); }
    }
}

template <int KSTEPS, class PA, class PB>
__device__ __forceinline__ f32x4 mma_tile(PA A, int lda, PB Bt, int ldb, f32x4 acc, int lane) {
    const int r = lane & 15, q = lane >> 4;
#pragma unroll
    for (int kk = 0; kk < KSTEPS; ++kk) {
        const bf16x8 a = *(const bf16x8*)(A + r * lda + kk * 32 + 8 * q);
        const bf16x8 b = *(const bf16x8*)(Bt + r * ldb + kk * 32 + 8 * q);
        acc = __builtin_amdgcn_mfma_f32_16x16x32_bf16(a, b, acc, 0, 0, 0);
    }
    return acc;
}
__device__ __forceinline__ float wave_scan_sum(float v, int lane) {
#pragma unroll
    for (int o = 1; o < 64; o <<= 1) { const float t = __shfl_up(v, o); if (lane >= o) v += t; }
    return v;
}
__device__ __forceinline__ float wave_scan_max(float v, int lane) {
#pragma unroll
    for (int o = 1; o < 64; o <<= 1) { const float t = __shfl_up(v, o); if (lane >= o) v = fmaxf(v, t); }
    return v;
}

__device__ __forceinline__ void lds_frag2(const LAS bf16* tile, int row0, int lane, bf16x8 (&f)[2]) {
    const LAS bf16* p = tile + (row0 + (lane & 15)) * 72 + 8 * (lane >> 4);
    f[0] = *(const LAS bf16x8*)p; f[1] = *(const LAS bf16x8*)(p + 32);
}
constexpr int CU_ALR = 0;
constexpr int CU_GT = 4096;
constexpr int CU_VEC = 6144;
constexpr int CU_KT = 8192;
constexpr int CU_VT = 17408;
constexpr int CU_Q = 35840;
constexpr int CU_AT = 45056;
constexpr int CU_O = 54272;
constexpr int CU_END = 88064;
constexpr int CU_WA = 110592;

__device__ __forceinline__ void load_vt(const Ctx& C, const bf16* V, int t0, int h) {
    LAS bf16* VT = (LAS bf16*)(C.lds + CU_VT);
    const int dv = C.tid & 127, jq = C.tid >> 7;
    const bf16* src = V + (size_t)(t0 + 16 * jq) * 512 + h * 128 + dv;
    unsigned w[8];
#pragma unroll
    for (int jj = 0; jj < 8; ++jj) { const unsigned lo = src[(size_t)(2 * jj) * 512], hi = src[(size_t)(2 * jj + 1) * 512]; w[jj] = lo | (hi << 16); }
    *(LAS v4u*)(VT + dv * 72 + 16 * jq) = (v4u){w[0], w[1], w[2], w[3]};
    *(LAS v4u*)(VT + dv * 72 + 16 * jq + 8) = (v4u){w[4], w[5], w[6], w[7]};
}

__device__ __forceinline__ void gla_stage_alpha(const Ctx& C, int l) {
    LAS float* WA = (LAS float*)(C.lds + CU_WA);
    const float* wa = C.in(8) + (size_t)l * 16 * 256; const float* ba = C.in(9) + (size_t)l * 256;
    for (int i = C.tid; i < 16 * 256 + 256; i += NTHR) WA[i] = i < 4096 ? wa[i] : ba[i - 4096];
}
__device__ __forceinline__ float gla_cumsum(const Ctx& C, int l, int t0, int h, float (&b)[8]) {
    LAS float* ALR = (LAS float*)(C.lds + CU_ALR); LAS float* GT = (LAS float*)(C.lds + CU_GT);
    const float* SMALL = (const float*)(C.ws + WS_SMALL);
    if (C.tid < 256) { const int j = C.tid >> 2, c4 = C.tid & 3; *(LAS f32x4*)(ALR + j * 16 + 4 * c4) = *(const f32x4*)(SMALL + (size_t)(t0 + j) * 64 + 4 * c4); }
    const int dk = C.tid & 63, jg = C.tid >> 6;
    const LAS float* WA = (const LAS float*)(C.lds + CU_WA) + h * 64 + dk; (void)l;
    __syncthreads();
    float w[16];
#pragma unroll
    for (int r = 0; r < 16; ++r) w[r] = WA[r * 256];
    const float ba = WA[16 * 256];
    float run = 0.f;
#pragma unroll
    for (int jj = 0; jj < 8; ++jj) { const int j = 8 * jg + jj; float x = ba;
#pragma unroll
        for (int r = 0; r < 16; ++r) x += ALR[j * 16 + r] * w[r];
        run += logsigmoidf_(x) * (1.0f / 16.0f); b[jj] = run; }
    GT[jg * 64 + dk] = run;
    __syncthreads();
    float pre = 0.f, tot = 0.f;
#pragma unroll
    for (int g2 = 0; g2 < 8; ++g2) { const float v = GT[g2 * 64 + dk]; tot += v; if (g2 < jg) pre += v; }
#pragma unroll
    for (int jj = 0; jj < 8; ++jj) b[jj] += pre;
    return tot;
}

__device__ __forceinline__ void gla_unit_a(const Ctx& C, int l, int ci) {
    const int bh = ci >> 8, c = ci & 255, bb = bh >> 2, h = bh & 3, t0 = bb * SEQ + c * 64;
    const bf16* QKA = (const bf16*)(C.ws + WS_QKA);
    load_vt(C, (const bf16*)(C.ws + WS_VA), t0, h);
    const int dk = C.tid & 63, jg = C.tid >> 6;
    unsigned kraw[8];
#pragma unroll
    for (int jj = 0; jj < 8; ++jj) kraw[jj] = QKA[(size_t)(t0 + 8 * jg + jj) * 512 + 256 + h * 64 + dk];
    float b[8]; const float btot = gla_cumsum(C, l, t0, h, b);
    LAS bf16* KT = (LAS bf16*)(C.lds + CU_KT);
    float kd[8];
#pragma unroll
    for (int jj = 0; jj < 8; ++jj) { const float k = bf2f(kraw[jj]); kd[jj] = k * fexp(btot - b[jj]); }
    *(LAS v4u*)(KT + dk * 72 + 8 * jg) = (v4u){pk2(kd[0], kd[1]), pk2(kd[2], kd[3]), pk2(kd[4], kd[5]), pk2(kd[6], kd[7])};
    if (jg == 0) ((float*)(C.ws + WS_GDEC))[(size_t)ci * 64 + dk] = fexp(btot);
    __syncthreads();
    const LAS bf16* VT = (const LAS bf16*)(C.lds + CU_VT);
    bf16* GST = (bf16*)(C.ws + WS_GST) + (size_t)ci * 8192;
    const int q = C.lane >> 4, fr = C.lane & 15;
    {
        bf16x8 av[2], bk[4][2]; lds_frag2(VT, 16 * C.wave, C.lane, av);
#pragma unroll
        for (int nt = 0; nt < 4; ++nt) lds_frag2((const LAS bf16*)KT, 16 * nt, C.lane, bk[nt]);
        f32x4 acc[4];
#pragma unroll
        for (int nt = 0; nt < 4; ++nt) acc[nt] = __builtin_amdgcn_mfma_f32_16x16x32_bf16(av[0], bk[nt][0], (f32x4){0.f, 0.f, 0.f, 0.f}, 0, 0, 0);
#pragma unroll
        for (int nt = 0; nt < 4; ++nt) acc[nt] = __builtin_amdgcn_mfma_f32_16x16x32_bf16(av[1], bk[nt][1], acc[nt], 0, 0, 0);
#pragma unroll
        for (int nt = 0; nt < 4; ++nt)
#pragma unroll
            for (int r = 0; r < 4; ++r) GST[(16 * C.wave + 4 * q + r) * 64 + 16 * nt + fr] = (bf16)f2bf(acc[nt][r]);
    }
    __syncthreads();
}

__device__ __forceinline__ void gla_unit_c(const Ctx& C, int l, int ci, bool DRY) {
    const int bh = ci >> 8, c = ci & 255, bb = bh >> 2, h = bh & 3, t0 = bb * SEQ + c * 64;
    const bf16* QKA = (const bf16*)(C.ws + WS_QKA);
    load_vt(C, (const bf16*)(C.ws + WS_VA), t0, h);
    const int dk = C.tid & 63, jg = C.tid >> 6;
    unsigned qraw[8], kraw[8];
#pragma unroll
    for (int jj = 0; jj < 8; ++jj) { const bf16* p = QKA + (size_t)(t0 + 8 * jg + jj) * 512 + h * 64 + dk; qraw[jj] = p[0]; kraw[jj] = p[256]; }
    bf16x8 stf[4][2];
    { const bf16* ST = (const bf16*)(C.ws + WS_GST) + (size_t)ci * 8192 + (size_t)(16 * 4 * (C.wave >> 2) + (C.lane & 15)) * 64 + 8 * (C.lane >> 4);
#pragma unroll
      for (int u = 0; u < 4; ++u) { stf[u][0] = *(const bf16x8*)(ST + u * 16 * 64); stf[u][1] = *(const bf16x8*)(ST + u * 16 * 64 + 32); } }
    v4u ar0, ar1;
    { const bf16* RAp = (const bf16*)(C.ws + WS_RA) + (size_t)(t0 + (C.tid >> 3)) * 512 + h * 128 + 16 * (C.tid & 7); ar0 = *(const v4u*)RAp; ar1 = *(const v4u*)(RAp + 8); }
    float b[8]; (void)gla_cumsum(C, l, t0, h, b);
    LAS bf16* KT = (LAS bf16*)(C.lds + CU_KT); LAS bf16* QT = (LAS bf16*)(C.lds + CU_Q); LAS bf16* AT = (LAS bf16*)(C.lds + CU_AT);
#pragma unroll
    for (int jj = 0; jj < 8; ++jj) { const int j = 8 * jg + jj;
        const float qv = bf2f(qraw[jj]) * 0.125f, kv = bf2f(kraw[jj]);
        QT[j * 72 + dk] = (bf16)f2bf(qv * fexp(b[jj])); KT[j * 72 + dk] = (bf16)f2bf(kv * fexp(fminf(-b[jj], 80.f))); }
    __syncthreads();
    const int q = C.lane >> 4, fr = C.lane & 15;
    {
        const int it = C.wave >> 1;
        bf16x8 bq[2], ak[2][2]; lds_frag2((const LAS bf16*)QT, 16 * it, C.lane, bq);
#pragma unroll
        for (int u = 0; u < 2; ++u) lds_frag2((const LAS bf16*)KT, 16 * (2 * (C.wave & 1) + u), C.lane, ak[u]);
        f32x4 acc2[2];
#pragma unroll
        for (int u = 0; u < 2; ++u) acc2[u] = __builtin_amdgcn_mfma_f32_16x16x32_bf16(ak[u][0], bq[0], (f32x4){0.f, 0.f, 0.f, 0.f}, 0, 0, 0);
#pragma unroll
        for (int u = 0; u < 2; ++u) acc2[u] = __builtin_amdgcn_mfma_f32_16x16x32_bf16(ak[u][1], bq[1], acc2[u], 0, 0, 0);
#pragma unroll
        for (int u = 0; u < 2; ++u) { const int jt = 2 * (C.wave & 1) + u;
            const int i = 16 * it + fr;
            float v[4];
#pragma unroll
            for (int r = 0; r < 4; ++r) { const int j = 16 * jt + 4 * q + r; v[r] = (j <= i) ? acc2[u][r] : 0.f; }
            *(LAS v2u*)(AT + i * 72 + 16 * jt + 4 * q) = (v2u){pk2(v[0], v[1]), pk2(v[2], v[3])}; }
    }
    __syncthreads();
    {
        const int it = C.wave & 3; LAS float* O = (LAS float*)(C.lds + CU_O);
        const LAS bf16* VT = (const LAS bf16*)(C.lds + CU_VT);
        bf16x8 qa[2], aa[2], bv[4][2]; lds_frag2((const LAS bf16*)QT, 16 * it, C.lane, qa); lds_frag2((const LAS bf16*)AT, 16 * it, C.lane, aa);
#pragma unroll
        for (int u = 0; u < 4; ++u) lds_frag2(VT, 16 * (4 * (C.wave >> 2) + u), C.lane, bv[u]);
        f32x4 acc4[4];
#pragma unroll
        for (int u = 0; u < 4; ++u) acc4[u] = __builtin_amdgcn_mfma_f32_16x16x32_bf16(qa[0], stf[u][0], (f32x4){0.f, 0.f, 0.f, 0.f}, 0, 0, 0);
#pragma unroll
        for (int u = 0; u < 4; ++u) acc4[u] = __builtin_amdgcn_mfma_f32_16x16x32_bf16(qa[1], stf[u][1], acc4[u], 0, 0, 0);
#pragma unroll
        for (int u = 0; u < 4; ++u) acc4[u] = __builtin_amdgcn_mfma_f32_16x16x32_bf16(aa[0], bv[u][0], acc4[u], 0, 0, 0);
#pragma unroll
        for (int u = 0; u < 4; ++u) acc4[u] = __builtin_amdgcn_mfma_f32_16x16x32_bf16(aa[1], bv[u][1], acc4[u], 0, 0, 0);
#pragma unroll
        for (int u = 0; u < 4; ++u) { const int dvt = 4 * (C.wave >> 2) + u;
#pragma unroll
            for (int r = 0; r < 4; ++r) O[(16 * it + 4 * q + r) * 132 + 16 * dvt + fr] = acc4[u][r]; }
    }
    __syncthreads();
    {
        const int i = C.tid >> 3, s = C.tid & 7; const LAS float* O = (const LAS float*)(C.lds + CU_O) + i * 132 + 16 * s;
        float o[16]; float ss = 0.f;
#pragma unroll
        for (int k = 0; k < 16; ++k) { o[k] = O[k]; ss += o[k] * o[k]; }
        ss += __shfl_xor(ss, 1); ss += __shfl_xor(ss, 2); ss += __shfl_xor(ss, 4);
        const float rinv = 1.0f / sqrtf(ss * (1.0f / 128.0f) + RMS_EPS);
        bf16* RA = (bf16*)(C.ws + WS_RA) + (size_t)(t0 + i) * 512 + h * 128 + 16 * s;
        const float* gn = C.in(10) + (size_t)l * 128 + 16 * s;
        const v4u r0 = ar0, r1 = ar1;
        unsigned rw[8] = {r0.x, r0.y, r0.z, r0.w, r1.x, r1.y, r1.z, r1.w}; unsigned ow[8];
#pragma unroll
        for (int k = 0; k < 8; ++k) { const float a = SCL_A * o[2 * k] * rinv * gn[2 * k] * siluf_(bflo(rw[k])), bq = SCL_A * o[2 * k + 1] * rinv * gn[2 * k + 1] * siluf_(bfhi(rw[k])); ow[k] = (ABL_ZERO & 1) ? 0u : pk2(a, bq); }
        if (DRY) { asm volatile("" :: "v"(ow[0]), "v"(ow[1]), "v"(ow[2]), "v"(ow[3]), "v"(ow[4]), "v"(ow[5]), "v"(ow[6]), "v"(ow[7])); } else {
        *(v4u*)RA = (v4u){ow[0], ow[1], ow[2], ow[3]}; *(v4u*)(RA + 8) = (v4u){ow[4], ow[5], ow[6], ow[7]}; }
    }
    __syncthreads();
}

__device__ __forceinline__ void conv_silu8(const Ctx& C, int l, int t0, int c, int ch, int jg, float (&out)[8]) {
    const bf16* X = (const bf16*)(C.ws + WS_QKC);
    const float* cw = C.in(15) + (size_t)l * 4 * 512 + ch; const float cb = C.in(16)[(size_t)l * 512 + ch];
    const float w0 = cw[0], w1 = cw[512], w2 = cw[1024], w3 = cw[1536];
    float x[11];
#pragma unroll
    for (int k = 0; k < 11; ++k) { const int j = 8 * jg + k - 3; const int s = c * 64 + j; x[k] = (s >= 0) ? bf2f(X[(size_t)(t0 + j) * 512 + ch]) : 0.f; }
#pragma unroll
    for (int jj = 0; jj < 8; ++jj) out[jj] = siluf_(cb + w0 * x[jj] + w1 * x[jj + 1] + w2 * x[jj + 2] + w3 * x[jj + 3]);
}

__device__ __forceinline__ void mlstm_unit_a(const Ctx& C, int l, int ci) {
    const int bh = ci >> 8, c = ci & 255, bb = bh >> 2, h = bh & 3, t0 = bb * SEQ + c * 64;
    LAS float* VEC = (LAS float*)(C.lds + CU_VEC); LAS float* GT = (LAS float*)(C.lds + CU_GT);
    load_vt(C, (const bf16*)(C.ws + WS_VC), t0, h);
    const int dk = C.tid & 63, jg = C.tid >> 6;
    float k[8]; conv_silu8(C, l, t0, c, 256 + h * 64 + dk, jg, k);
    if (C.wave == 0) {
        const float* sm = (const float*)(C.ws + WS_SMALL) + (size_t)(t0 + C.lane) * 64;
        const float ip = sm[40 + h], lf = logsigmoidf_(sm[44 + h]);
        const float bj = wave_scan_sum(lf, C.lane); const float a = ip - bj; const float amax = wave_max(a);
        VEC[C.lane] = fexp(a - amax);
        if (C.lane == 63) { float* msc = (float*)(C.ws + WS_MSC) + (size_t)ci * 4; msc[0] = bj; msc[1] = amax; }
    }
    __syncthreads();
    LAS bf16* KT = (LAS bf16*)(C.lds + CU_KT);
    float kw[8]; float ns = 0.f;
#pragma unroll
    for (int jj = 0; jj < 8; ++jj) { kw[jj] = k[jj] * 0.125f * VEC[8 * jg + jj]; ns += kw[jj]; }
    *(LAS v4u*)(KT + dk * 72 + 8 * jg) = (v4u){pk2(kw[0], kw[1]), pk2(kw[2], kw[3]), pk2(kw[4], kw[5]), pk2(kw[6], kw[7])};
    GT[jg * 64 + dk] = ns;
    __syncthreads();
    if (C.tid < 64) { float s = 0.f;
#pragma unroll
        for (int g2 = 0; g2 < 8; ++g2) s += GT[g2 * 64 + C.tid];
        ((float*)(C.ws + WS_MN))[(size_t)ci * 64 + C.tid] = s; }
    const LAS bf16* VT = (const LAS bf16*)(C.lds + CU_VT);
    bf16* MST = (bf16*)(C.ws + WS_MST) + (size_t)ci * 8192;
    const int q = C.lane >> 4, fr = C.lane & 15;
    {
        bf16x8 av[2], bk[4][2]; lds_frag2(VT, 16 * C.wave, C.lane, av);
#pragma unroll
        for (int nt = 0; nt < 4; ++nt) lds_frag2((const LAS bf16*)KT, 16 * nt, C.lane, bk[nt]);
        f32x4 acc[4];
#pragma unroll
        for (int nt = 0; nt < 4; ++nt) acc[nt] = __builtin_amdgcn_mfma_f32_16x16x32_bf16(av[0], bk[nt][0], (f32x4){0.f, 0.f, 0.f, 0.f}, 0, 0, 0);
#pragma unroll
        for (int nt = 0; nt < 4; ++nt) acc[nt] = __builtin_amdgcn_mfma_f32_16x16x32_bf16(av[1], bk[nt][1], acc[nt], 0, 0, 0);
#pragma unroll
        for (int nt = 0; nt < 4; ++nt)
#pragma unroll
            for (int r = 0; r < 4; ++r) MST[(16 * C.wave + 4 * q + r) * 64 + 16 * nt + fr] = (bf16)f2bf(acc[nt][r]);
    }
    __syncthreads();
}

__device__ __forceinline__ void mlstm_unit_c(const Ctx& C, int l, int ci, bool DRY) {
    const int bh = ci >> 8, c = ci & 255, bb = bh >> 2, h = bh & 3, t0 = bb * SEQ + c * 64;
    LAS float* VEC = (LAS float*)(C.lds + CU_VEC);
    LAS float* AJ = VEC + 64, *MI = VEC + 128, *WI = VEC + 192, *EM = VEC + 256, *QN = VEC + 384; LAS float* DENP = (LAS float*)(C.lds + CU_GT);
    load_vt(C, (const bf16*)(C.ws + WS_VC), t0, h);
    const int dk = C.tid & 63, jg = C.tid >> 6;
    LAS bf16* KT = (LAS bf16*)(C.lds + CU_KT); LAS bf16* QT = (LAS bf16*)(C.lds + CU_Q); LAS bf16* AT = (LAS bf16*)(C.lds + CU_AT);
    bf16x8 stf[4][2];
    { const bf16* ST = (const bf16*)(C.ws + WS_MST) + (size_t)ci * 8192 + (size_t)(16 * 4 * (C.wave >> 2) + (C.lane & 15)) * 64 + 8 * (C.lane >> 4);
#pragma unroll
      for (int u = 0; u < 4; ++u) { stf[u][0] = *(const bf16x8*)(ST + u * 16 * 64); stf[u][1] = *(const bf16x8*)(ST + u * 16 * 64 + 32); } }
    v4u co0, co1; f32x4 nst0, nst1;
    { const bf16* OCp = (const bf16*)(C.ws + WS_OC) + (size_t)(t0 + (C.tid >> 3)) * 512 + h * 128 + 16 * (C.tid & 7); co0 = *(const v4u*)OCp; co1 = *(const v4u*)(OCp + 8);
      const float* np = (const float*)(C.ws + WS_MN) + (size_t)ci * 64 + 8 * (C.tid & 7); nst0 = *(const f32x4*)np; nst1 = *(const f32x4*)(np + 4); }
    {
        float qv[8], kv[8]; conv_silu8(C, l, t0, c, h * 64 + dk, jg, qv); conv_silu8(C, l, t0, c, 256 + h * 64 + dk, jg, kv);
#pragma unroll
        for (int jj = 0; jj < 8; ++jj) { const int j = 8 * jg + jj; QT[j * 72 + dk] = (bf16)f2bf(qv[jj]); KT[j * 72 + dk] = (bf16)f2bf(kv[jj] * 0.125f); }
    }
    if (C.wave == 0) {
        const float* sm = (const float*)(C.ws + WS_SMALL) + (size_t)(t0 + C.lane) * 64;
        const float ip = sm[40 + h], lf = logsigmoidf_(sm[44 + h]);
        const float bj = wave_scan_sum(lf, C.lane); const float a = ip - bj; const float arun = wave_scan_max(a, C.lane);
        const float mst = ((const float*)(C.ws + WS_MSC))[(size_t)ci * 4 + 2];
        const float mi = fmaxf(mst, arun);
        AJ[C.lane] = a; MI[C.lane] = mi; WI[C.lane] = fexp(mst - mi); EM[C.lane] = fexp(-(bj + mi));
    }
    __syncthreads();
    const int q = C.lane >> 4, fr = C.lane & 15;
    {
        const int it = C.wave >> 1;
        bf16x8 bq[2], ak[2][2]; lds_frag2((const LAS bf16*)QT, 16 * it, C.lane, bq);
#pragma unroll
        for (int u = 0; u < 2; ++u) lds_frag2((const LAS bf16*)KT, 16 * (2 * (C.wave & 1) + u), C.lane, ak[u]);
        f32x4 acc2[2];
#pragma unroll
        for (int u = 0; u < 2; ++u) acc2[u] = __builtin_amdgcn_mfma_f32_16x16x32_bf16(ak[u][0], bq[0], (f32x4){0.f, 0.f, 0.f, 0.f}, 0, 0, 0);
#pragma unroll
        for (int u = 0; u < 2; ++u) acc2[u] = __builtin_amdgcn_mfma_f32_16x16x32_bf16(ak[u][1], bq[1], acc2[u], 0, 0, 0);
#pragma unroll
        for (int u = 0; u < 2; ++u) { const int jt = 2 * (C.wave & 1) + u; const f32x4 acc = acc2[u];
            const int i = 16 * it + fr; const float mi = MI[i];
            float v[4]; float ds = 0.f;
#pragma unroll
            for (int r = 0; r < 4; ++r) { const int j = 16 * jt + 4 * q + r; v[r] = (j <= i) ? acc[r] * fexp(AJ[j] - mi) : 0.f; ds += v[r]; }
            ds += __shfl_xor(ds, 16); ds += __shfl_xor(ds, 32);
            if (q == 0) DENP[jt * 64 + i] = ds;
            *(LAS v2u*)(AT + i * 72 + 16 * jt + 4 * q) = (v2u){pk2(v[0], v[1]), pk2(v[2], v[3])}; }
    }
    {
        const int i = C.tid >> 3, s = C.tid & 7; const float nst[8] = {nst0[0], nst0[1], nst0[2], nst0[3], nst1[0], nst1[1], nst1[2], nst1[3]};
        float a = 0.f;
#pragma unroll
        for (int k = 0; k < 8; ++k) a += bf2f(QT[i * 72 + 8 * s + k]) * nst[k];
        a += __shfl_xor(a, 1); a += __shfl_xor(a, 2); a += __shfl_xor(a, 4);
        if (s == 0) QN[i] = a;
    }
    __syncthreads();
    {
        const int it = C.wave & 3; LAS float* O = (LAS float*)(C.lds + CU_O);
        const LAS bf16* VT = (const LAS bf16*)(C.lds + CU_VT);
        bf16x8 qa[2], aa[2], bv[4][2]; lds_frag2((const LAS bf16*)QT, 16 * it, C.lane, qa); lds_frag2((const LAS bf16*)AT, 16 * it, C.lane, aa);
#pragma unroll
        for (int u = 0; u < 4; ++u) lds_frag2(VT, 16 * (4 * (C.wave >> 2) + u), C.lane, bv[u]);
        f32x4 a1[4], a2[4];
#pragma unroll
        for (int u = 0; u < 4; ++u) { a1[u] = __builtin_amdgcn_mfma_f32_16x16x32_bf16(qa[0], stf[u][0], (f32x4){0.f, 0.f, 0.f, 0.f}, 0, 0, 0); a2[u] = __builtin_amdgcn_mfma_f32_16x16x32_bf16(aa[0], bv[u][0], (f32x4){0.f, 0.f, 0.f, 0.f}, 0, 0, 0); }
#pragma unroll
        for (int u = 0; u < 4; ++u) { a1[u] = __builtin_amdgcn_mfma_f32_16x16x32_bf16(qa[1], stf[u][1], a1[u], 0, 0, 0); a2[u] = __builtin_amdgcn_mfma_f32_16x16x32_bf16(aa[1], bv[u][1], a2[u], 0, 0, 0); }
        float wi4[4];
#pragma unroll
        for (int r = 0; r < 4; ++r) wi4[r] = WI[16 * it + 4 * q + r];
#pragma unroll
        for (int u = 0; u < 4; ++u) { const int dvt = 4 * (C.wave >> 2) + u;
#pragma unroll
            for (int r = 0; r < 4; ++r) { const int i = 16 * it + 4 * q + r; O[i * 132 + 16 * dvt + fr] = wi4[r] * a1[u][r] + a2[u][r]; } }
    }
    __syncthreads();
    {
        const int i = C.tid >> 3, s = C.tid & 7; const LAS float* O = (const LAS float*)(C.lds + CU_O) + i * 132 + 16 * s;
        const float den = WI[i] * QN[i] + ((DENP[i] + DENP[64 + i]) + (DENP[128 + i] + DENP[192 + i])); const float dinv = 1.0f / fmaxf(fabsf(den), EM[i]);
        bf16* OC = (bf16*)(C.ws + WS_OC) + (size_t)(t0 + i) * 512 + h * 128 + 16 * s;
        const v4u r0 = co0, r1 = co1;
        unsigned rw[8] = {r0.x, r0.y, r0.z, r0.w, r1.x, r1.y, r1.z, r1.w}; unsigned ow[8];
#pragma unroll
        for (int k = 0; k < 8; ++k) ow[k] = (ABL_ZERO & 4) ? 0u : pk2(SCL_C * O[2 * k] * dinv * sigmoidf_(bflo(rw[k])), SCL_C * O[2 * k + 1] * dinv * sigmoidf_(bfhi(rw[k])));
        if (DRY) { asm volatile("" :: "v"(ow[0]), "v"(ow[1]), "v"(ow[2]), "v"(ow[3]), "v"(ow[4]), "v"(ow[5]), "v"(ow[6]), "v"(ow[7])); } else {
        *(v4u*)OC = (v4u){ow[0], ow[1], ow[2], ow[3]}; *(v4u*)(OC + 8) = (v4u){ow[4], ow[5], ow[6], ow[7]}; }
    }
    __syncthreads();
}

__device__ __forceinline__ void phase_scan(const Ctx& C, bool DRY) {
    const int gt = C.bid * NTHR + C.tid, NGT = C.G * NTHR;
    for (int e = gt; e < 65536 + 65536; e += NGT) {
        if (e < 65536) {
            const int bh = e >> 13, el = e & 8191, dk = el & 63;
            bf16* st = (bf16*)(C.ws + WS_GST) + (size_t)bh * 256 * 8192 + el; const float* dec = (const float*)(C.ws + WS_GDEC) + (size_t)bh * 256 * 64 + dk;
            float s = 0.f;
            for (int c0 = 0; c0 < 256; c0 += 8) { float L[8], d[8];
#pragma unroll
                for (int k = 0; k < 8; ++k) { L[k] = bf2f(st[(size_t)(c0 + k) * 8192]); d[k] = dec[(c0 + k) * 64]; }
#pragma unroll
                for (int k = 0; k < 8; ++k) { if (!DRY) st[(size_t)(c0 + k) * 8192] = (bf16)f2bf(s); s = d[k] * s + L[k]; } }
            if (DRY) asm volatile("" :: "v"(s));
        } else {
            const int e2 = e - 65536, bh = e2 >> 13, el = e2 & 8191; const bool hasn = el < 64;
            bf16* st = (bf16*)(C.ws + WS_MST) + (size_t)bh * 256 * 8192 + el; float* nv = (float*)(C.ws + WS_MN) + (size_t)bh * 256 * 64 + (hasn ? el : 0);
            float* msc = (float*)(C.ws + WS_MSC) + (size_t)bh * 256 * 4;
            float s = 0.f, sn = 0.f, m = 0.f;
            for (int c0 = 0; c0 < 256; c0 += 8) { float L[8], Ln[8], bl[8], am[8];
#pragma unroll
                for (int k = 0; k < 8; ++k) { L[k] = bf2f(st[(size_t)(c0 + k) * 8192]); Ln[k] = hasn ? nv[(c0 + k) * 64] : 0.f; bl[k] = msc[(c0 + k) * 4]; am[k] = msc[(c0 + k) * 4 + 1]; }
#pragma unroll
                for (int k = 0; k < 8; ++k) {
                    const float mn = bl[k] + fmaxf(m, am[k]); const float al = fexp(bl[k] + m - mn), be = fexp(bl[k] + am[k] - mn);
                    if (!DRY) { st[(size_t)(c0 + k) * 8192] = (bf16)f2bf(s);
                    if (hasn) { nv[(c0 + k) * 64] = sn; if (el == 0) msc[(c0 + k) * 4 + 2] = m; } }
                    s = al * s + be * L[k]; sn = al * sn + be * Ln[k]; m = mn; } }
            if (DRY) asm volatile("" :: "v"(s), "v"(sn));
        }
    }
}

__device__ __forceinline__ float gelu_tanh(float x) { const float u = 0.7978845608f * (x + 0.044715f * x * x * x); const float e = __expf(2.0f * u); return 0.5f * x * (2.0f - 2.0f / (1.0f + e)); }

__device__ __forceinline__ void nsa_prep_rows(const float* gain, const f32x2* rope_row, float scale, bf16* p, int c8, bool DRY) {
    const v4u raw = *(const v4u*)p;
    float x[8]; x[0] = bflo(raw.x); x[1] = bfhi(raw.x); x[2] = bflo(raw.y); x[3] = bfhi(raw.y); x[4] = bflo(raw.z); x[5] = bfhi(raw.z); x[6] = bflo(raw.w); x[7] = bfhi(raw.w);
    float ss = 0.f;
#pragma unroll
    for (int k = 0; k < 8; ++k) ss += x[k] * x[k];
    ss += __shfl_xor(ss, 1); ss += __shfl_xor(ss, 2); ss += __shfl_xor(ss, 4);
    const float rinv = 1.0f / sqrtf(ss * (1.0f / 64.0f) + RMS_EPS);
    const f32x4 g0 = *(const f32x4*)(gain + 8 * c8), g1 = *(const f32x4*)(gain + 8 * c8 + 4);
    float y[8], pr[8];
#pragma unroll
    for (int k = 0; k < 8; ++k) y[k] = x[k] * rinv * (k < 4 ? g0[k] : g1[k - 4]);
#pragma unroll
    for (int k = 0; k < 8; ++k) pr[k] = __shfl_xor(y[k], 4);
    const f32x2* cs = rope_row + 8 * (c8 & 3);
    float o[8];
#pragma unroll
    for (int k = 0; k < 8; ++k) { const f32x2 c = cs[k]; o[k] = ((c8 < 4) ? (y[k] * c.x - pr[k] * c.y) : (pr[k] * c.y + y[k] * c.x)) * scale; }
    const v4u w = (v4u){pk2(o[0], o[1]), pk2(o[2], o[3]), pk2(o[4], o[5]), pk2(o[6], o[7])};
    if (DRY) asm volatile("" :: "v"(w)); else *(v4u*)p = w;
}
__device__ __forceinline__ void nsa_prep_token(const Ctx& C, int l, int tp, bool DRY) {
    const float* gn = C.in(11) + (size_t)l * 4 * 64;
    const int c8 = C.lane & 7, row = C.lane >> 3;
    const f32x2* rope = (const f32x2*)(C.ws + WS_ROPE);
#pragma unroll
    for (int h2 = 0; h2 < 2; ++h2) { const int t = 2 * tp + h2;
        nsa_prep_rows(gn, rope + (size_t)(t & (SEQ - 1)) * 32, 0.125f, (bf16*)(C.ws + WS_QB) + (size_t)t * 512 + row * 64 + 8 * c8, c8, DRY); }
    {
        const int t = 2 * tp + (row >> 2), kind = (row >> 1) & 1, g = row & 1;
        bf16* p = (bf16*)(C.ws + (kind ? WS_KVW : WS_KVS)) + (size_t)t * 256 + g * 64 + 8 * c8;
        nsa_prep_rows(gn + (kind ? 192 : 128), rope + (size_t)(t & (SEQ - 1)) * 32, 1.0f, p, c8, DRY); }
}
__device__ __forceinline__ void nsa_vtrans_item(const Ctx& C, int item) {
    const int which = item >> 10, bg = (item >> 8) & 3, blk = item & 255, b = bg >> 1, g = bg & 1;
    const bf16* src = (const bf16*)(C.ws + (which ? WS_KVW : WS_KVS)) + (size_t)(b * SEQ + blk * 64 + C.lane) * 256 + 128 + g * 64;
    bf16* dst = (bf16*)(C.ws + (which ? WS_VWT : WS_VST)) + (size_t)(bg * 256 + blk) * 4096 + C.lane;
    v4u w[8];
#pragma unroll
    for (int k = 0; k < 8; ++k) w[k] = ((const v4u*)src)[k];
#pragma unroll
    for (int k = 0; k < 8; ++k)
#pragma unroll
        for (int e = 0; e < 4; ++e) { const unsigned x = w[k][e]; dst[(size_t)(8 * k + 2 * e) * 64] = (bf16)(x & 0xffffu); dst[(size_t)(8 * k + 2 * e + 1) * 64] = (bf16)(x >> 16); }
}
__device__ __forceinline__ void nsa_cmp1_item(const Ctx& C, int item) {
    const int kv = item >> 10, rt = (item >> 2) & 255, ng = item & 3;
    const int fr = C.lane & 15, q = C.lane >> 4;
    const int ri = rt * 16 + fr, b = ri >> 11, g = (ri >> 10) & 1, c = ri & 1023, cc = c < 1023 ? c : 1022;
    const bf16* arow = (const bf16*)(C.ws + WS_KVC) + (size_t)(b * SEQ + 16 * cc) * 256 + kv * 128 + g * 64 + 8 * q;
    const bf16* brow = (const bf16*)(C.ws + WS_CW1) + (size_t)kv * 256 * 2048 + (size_t)(ng * 64 + fr) * 2048 + 8 * q;
    f32x4 acc[4];
#pragma unroll
    for (int nt = 0; nt < 4; ++nt) acc[nt] = (f32x4){0.f, 0.f, 0.f, 0.f};
#pragma unroll 4
    for (int kk = 0; kk < 64; ++kk) {
        const bf16x8 a = *(const bf16x8*)(arow + (kk >> 1) * 256 + (kk & 1) * 32);
#pragma unroll
        for (int nt = 0; nt < 4; ++nt) { const bf16x8 bv = *(const bf16x8*)(brow + (size_t)nt * 16 * 2048 + kk * 32); acc[nt] = __builtin_amdgcn_mfma_f32_16x16x32_bf16(a, bv, acc[nt], 0, 0, 0); }
    }
    const float* cb1 = (const float*)(C.ws + WS_VEC) + VEC_CB1 + kv * 256;
    bf16* H1 = (bf16*)(C.ws + WS_CMPH) + (size_t)kv * 4096 * 256;
#pragma unroll
    for (int nt = 0; nt < 4; ++nt) { const int n = ng * 64 + nt * 16 + fr; const float bia = cb1[n];
#pragma unroll
        for (int r = 0; r < 4; ++r) H1[(size_t)(rt * 16 + 4 * q + r) * 256 + n] = (bf16)f2bf(gelu_tanh(acc[nt][r] + bia)); }
}
__device__ __forceinline__ void nsa_cmp2_item(const Ctx& C, int l, int item) {
    const int kv = item >> 8, rt = item & 255;
    const int fr = C.lane & 15, q = C.lane >> 4;
    const bf16* H1 = (const bf16*)(C.ws + WS_CMPH) + (size_t)kv * 4096 * 256 + (size_t)rt * 16 * 256;
    const bf16* W2 = (const bf16*)(C.ws + WS_CW2) + (size_t)kv * 64 * 256;
    f32x4 acc[4];
#pragma unroll
    for (int nt = 0; nt < 4; ++nt) { acc[nt] = (f32x4){0.f, 0.f, 0.f, 0.f}; acc[nt] = mma_tile<8>(H1, 256, W2 + nt * 16 * 256, 256, acc[nt], C.lane); }
    if (kv == 0) {
        const float* gn = C.in(11) + (size_t)l * 4 * 64 + 64;
        bf16* KC = (bf16*)(C.ws + WS_KCMP);
#pragma unroll
        for (int r = 0; r < 4; ++r) {
            float ss = 0.f;
#pragma unroll
            for (int nt = 0; nt < 4; ++nt) ss += acc[nt][r] * acc[nt][r];
            ss += __shfl_xor(ss, 1); ss += __shfl_xor(ss, 2); ss += __shfl_xor(ss, 4); ss += __shfl_xor(ss, 8);
            const float rinv = 1.0f / sqrtf(ss * (1.0f / 64.0f) + RMS_EPS);
            float y[4];
#pragma unroll
            for (int nt = 0; nt < 4; ++nt) y[nt] = acc[nt][r] * rinv * gn[nt * 16 + fr];
            const int ri = rt * 16 + 4 * q + r, c = ri & 1023; int pos = 16 * c + 31; pos = pos < SEQ ? pos : SEQ - 1;
            const f32x2* rr = (const f32x2*)(C.ws + WS_ROPE) + (size_t)pos * 32;
            const f32x2 c0 = rr[fr], c1 = rr[16 + fr];
            bf16* o = KC + (size_t)ri * 64;
            o[fr] = (bf16)f2bf(y[0] * c0.x - y[2] * c0.y); o[16 + fr] = (bf16)f2bf(y[1] * c1.x - y[3] * c1.y);
            o[32 + fr] = (bf16)f2bf(y[0] * c0.y + y[2] * c0.x); o[48 + fr] = (bf16)f2bf(y[1] * c1.y + y[3] * c1.x);
        }
    } else {
        bf16* VCT = (bf16*)(C.ws + WS_VCT);
        const int ri0 = rt * 16, bg = ri0 >> 10, c0 = (ri0 & 1023) + 4 * q;
#pragma unroll
        for (int nt = 0; nt < 4; ++nt) { const int d = nt * 16 + fr;
            *(v2u*)(VCT + (size_t)(bg * 64 + d) * 1024 + c0) = (v2u){pk2(acc[nt][0], acc[nt][1]), pk2(acc[nt][2], acc[nt][3])}; }
    }
}

constexpr int NQ = 32;
constexpr int NU_IMP = 0;
constexpr int NU_SEL = 32768;
constexpr int NU_UM = 33792;
constexpr int NU_UL = 33824;
constexpr int NU_KV = 35072;
constexpr int NU_TILE = 18432;
constexpr int NU_END = NU_KV + 4 * NU_TILE;
constexpr float LOG2E = 1.44269504089f;

struct TileSrc { const bf16* k; int kld; const bf16* v; int vld; };

__device__ __forceinline__ void nsa_fetch(const Ctx& C, const TileSrc& ts, bool on, v4u& kr, v4u& vr) {
    const int r = C.tid >> 3, ch = C.tid & 7; (void)on;
    kr = *(const v4u*)(ts.k + (size_t)r * ts.kld + ch * 8); vr = *(const v4u*)(ts.v + (size_t)r * ts.vld + ch * 8);
}
__device__ __forceinline__ void nsa_commit(const Ctx& C, int j, bool on, const v4u& kr, const v4u& vr) {
    LAS bf16* KT = (LAS bf16*)(C.lds + NU_KV + j * NU_TILE); LAS bf16* VT = KT + 64 * 72;
    const int r = C.tid >> 3, ch = C.tid & 7; (void)on;
    *(LAS v4u*)(KT + r * 72 + ch * 8) = kr; *(LAS v4u*)(VT + r * 72 + ch * 8) = vr;
}
__device__ __forceinline__ void nsa_scores(const Ctx& C, int j, const bf16x8 (&qf)[2], f32x4 (&s)[4]) {
    const LAS bf16* KT = (const LAS bf16*)(C.lds + NU_KV + j * NU_TILE);
    const int fr = C.lane & 15, q = C.lane >> 4;
    bf16x8 a[4][2];
#pragma unroll
    for (int kt = 0; kt < 4; ++kt)
#pragma unroll
        for (int ks = 0; ks < 2; ++ks) a[kt][ks] = *(const LAS bf16x8*)(KT + (16 * kt + fr) * 72 + ks * 32 + 8 * q);
#pragma unroll
    for (int kt = 0; kt < 4; ++kt) s[kt] = __builtin_amdgcn_mfma_f32_16x16x32_bf16(a[kt][0], qf[0], (f32x4){0.f, 0.f, 0.f, 0.f}, 0, 0, 0);
#pragma unroll
    for (int kt = 0; kt < 4; ++kt) s[kt] = __builtin_amdgcn_mfma_f32_16x16x32_bf16(a[kt][1], qf[1], s[kt], 0, 0, 0);
}
__device__ __forceinline__ void nsa_vfrag(const Ctx& C, int j, v4u (&vf)[4][2]) {
    const LAS bf16* VT = (const LAS bf16*)(C.lds + NU_KV + j * NU_TILE) + 64 * 72;
    const int fr = C.lane & 15, q = C.lane >> 4;
#pragma unroll
    for (int dt = 0; dt < 4; ++dt)
#pragma unroll
        for (int k2 = 0; k2 < 2; ++k2) { const LAS bf16* vr = VT + (16 * dt + fr) * 72 + 32 * k2 + 4 * q;
            const v2u lo = *(const LAS v2u*)vr, hi = *(const LAS v2u*)(vr + 16); vf[dt][k2] = (v4u){lo.x, lo.y, hi.x, hi.y}; }
}
__device__ __forceinline__ void nsa_pv(const Ctx& C, int j, const f32x4 (&p)[4], f32x4 (&o)[4], const v4u (&vf)[4][2]) {
    bf16x8 pf[2];
#pragma unroll
    for (int k2 = 0; k2 < 2; ++k2) { v4u w; w.x = pk2(p[2 * k2][0], p[2 * k2][1]); w.y = pk2(p[2 * k2][2], p[2 * k2][3]); w.z = pk2(p[2 * k2 + 1][0], p[2 * k2 + 1][1]); w.w = pk2(p[2 * k2 + 1][2], p[2 * k2 + 1][3]);
        pf[k2] = __builtin_bit_cast(bf16x8, w); }
#pragma unroll
    for (int k2 = 0; k2 < 2; ++k2)
#pragma unroll
        for (int dt = 0; dt < 4; ++dt) o[dt] = __builtin_amdgcn_mfma_f32_16x16x32_bf16(__builtin_bit_cast(bf16x8, vf[dt][k2]), pf[k2], o[dt], 0, 0, 0);
}
__device__ __forceinline__ float nsa_exp(f32x4 (&s)[4], float ml2) {
    float ps = 0.f;
#pragma unroll
    for (int kt = 0; kt < 4; ++kt)
#pragma unroll
        for (int r = 0; r < 4; ++r) { const float p = __builtin_amdgcn_exp2f(s[kt][r] * LOG2E - ml2); s[kt][r] = p; ps += p; }
    return ps;
}

__device__ __forceinline__ void nsa_attn_unit(const Ctx& C, int l, int u, bool DRY) {
    const int half = u & 1, bg = (u >> 1) & 3, b = bg >> 1, g = bg & 1;
    const int qb = 255 - (u >> 3);
    const int q0 = 32 * half;
    const int t0 = b * SEQ + qb * 64;
    const int fr = C.lane & 15, q = C.lane >> 4, qq = fr >> 2, hh = fr & 3;
    LAS float* IMP = (LAS float*)(C.lds + NU_IMP);
    LAS unsigned long long* SEL = (LAS unsigned long long*)(C.lds + NU_SEL);
    LAS unsigned long long* UM = (LAS unsigned long long*)(C.lds + NU_UM);
    LAS int* UL = (LAS int*)(C.lds + NU_UL);
    for (int i = C.tid; i < NQ * 256; i += NTHR) IMP[i] = 0.f;
    float mc2, ms2, mw2;
    { const float* gn = C.in(11) + (size_t)l * 256;
      const float gq = wave_max(fabsf(gn[C.lane])), g1 = wave_max(fabsf(gn[64 + C.lane])), g2 = wave_max(fabsf(gn[128 + C.lane])), g3 = wave_max(fabsf(gn[192 + C.lane]));
      mc2 = 8.0f * gq * g1 * LOG2E; ms2 = 8.0f * gq * g2 * LOG2E; mw2 = 8.0f * gq * g3 * LOG2E; }
    bf16* QB = (bf16*)(C.ws + WS_QB);
    const int iq = q0 + 4 * C.wave + qq;
    bf16x8 qf[2]; float gate[3];
    { const bf16* qp = QB + (size_t)(t0 + iq) * 512 + (g * 4 + hh) * 64 + 8 * q;
      qf[0] = *(const bf16x8*)qp; qf[1] = *(const bf16x8*)(qp + 32);
      const float* sm = (const float*)(C.ws + WS_SMALL) + (size_t)(t0 + iq) * 64 + 16 + (g * 4 + hh) * 3;
#pragma unroll
      for (int k = 0; k < 3; ++k) gate[k] = ((ABL_ZERO & 2) || (ABL_ZERO & (8 << k))) ? 0.f : SCL_B * sigmoidf_(sm[k]); }
    f32x4 out[4];
#pragma unroll
    for (int dt = 0; dt < 4; ++dt) out[dt] = (f32x4){0.f, 0.f, 0.f, 0.f};
    v4u kr[4], vr[4];

    const bf16* KC = (const bf16*)(C.ws + WS_KCMP) + (size_t)bg * 1024 * 64;
    const bf16* VCT = (const bf16*)(C.ws + WS_VCT) + (size_t)bg * 64 * 1024;
    const int nct = (4 * qb + 3 + 63) >> 6, ncs = (nct + 3) >> 2;
    const int cmax = (64 * qb + iq - 31) >> 4, cmin = (64 * qb + q0 + 4 * C.wave - 31) >> 4;
    float cl = 0.f, cinv = 0.f;
    for (int rep = (TIMEDUP & 2048) ? 0 : 1; rep < 2; ++rep) { cl = 0.f;
    for (int pass = 0; pass < 2; ++pass) {
        f32x4 ao[4];
#pragma unroll
        for (int dt = 0; dt < 4; ++dt) ao[dt] = (f32x4){0.f, 0.f, 0.f, 0.f};
        if (pass == 1) { float lt = cl; lt += __shfl_xor(lt, 16); lt += __shfl_xor(lt, 32); cinv = lt > 0.f ? 1.0f / lt : 0.f; }
#pragma unroll
        for (int j = 0; j < 4; ++j) { const int tl = j < nct ? j : nct - 1; const TileSrc ts{KC + (size_t)tl * 64 * 64, 64, VCT + tl * 64, 1024}; nsa_fetch(C, ts, true, kr[j], vr[j]); }
        for (int st = 0; st < ncs; ++st) {
            __syncthreads();
#pragma unroll
            for (int j = 0; j < 4; ++j) nsa_commit(C, j, 4 * st + j < nct, kr[j], vr[j]);
            __syncthreads();
            if (st + 1 < ncs) {
#pragma unroll
                for (int j = 0; j < 4; ++j) { const int t4 = 4 * (st + 1) + j, tl = t4 < nct ? t4 : nct - 1; const TileSrc ts{KC + (size_t)tl * 64 * 64, 64, VCT + tl * 64, 1024}; nsa_fetch(C, ts, true, kr[j], vr[j]); }
            }
#pragma unroll
            for (int j = 0; j < 4; ++j) {
                const int tl = 4 * st + j;
                if (tl < nct) {
                    f32x4 s[4]; v4u vf[4][2]; nsa_scores(C, j, qf, s); if (pass == 1) nsa_vfrag(C, j, vf);
                    if (64 * tl + 63 > cmin) {
#pragma unroll
                    for (int kt = 0; kt < 4; ++kt)
#pragma unroll
                        for (int r = 0; r < 4; ++r) { const int c = 64 * tl + 16 * kt + 4 * q + r; if (c > cmax) s[kt][r] = -INFINITY; }
                    }
                    const float ps = nsa_exp(s, mc2);
                    if (pass == 0) cl += ps;
                    else {
#pragma unroll
                        for (int kt = 0; kt < 4; ++kt) {
#pragma unroll
                            for (int r = 0; r < 4; ++r) s[kt][r] *= cinv;
                            float gs = (s[kt][0] + s[kt][1]) + (s[kt][2] + s[kt][3]), es = s[kt][3];
                            gs += __shfl_xor(gs, 1); gs += __shfl_xor(gs, 2); es += __shfl_xor(es, 1); es += __shfl_xor(es, 2);
                            if (hh == 0) { const int n = 16 * tl + 4 * kt + q;
                                if (n < 256) { atomicAdd((float*)(IMP + (iq - q0) * 256 + n), gs); if (n + 1 < 256) atomicAdd((float*)(IMP + (iq - q0) * 256 + n + 1), es); } }
                        }
                        nsa_pv(C, j, s, ao, vf);
                    }
                }
            }
        }
        if (pass == 1) {
#pragma unroll
            for (int dt = 0; dt < 4; ++dt) out[dt] += ao[dt] * (rep == 1 ? gate[0] : 0.f);
        }
        __syncthreads();
    } }

    for (int rep = (TIMEDUP & 256) ? 0 : 1; rep < 2; ++rep) {
        unsigned key[4][4]; unsigned long long selw[4][4];
        const int nforced = qb >= 2 ? 3 : qb + 1; const int ncand = qb + 1 - nforced;
        int need = 16 - nforced; if (need > ncand) need = ncand;
#pragma unroll
        for (int k4 = 0; k4 < 4; ++k4)
#pragma unroll
            for (int k = 0; k < 4; ++k) { const int n = C.lane + 64 * k; const bool valid = n <= qb; const bool forced = valid && (n == 0 || n == qb || n == qb - 1);
                key[k4][k] = (valid && !forced) ? (__builtin_bit_cast(unsigned, fmaxf(IMP[(4 * C.wave + k4) * 256 + n], 0.f)) + 1u) : 0u;
                selw[k4][k] = __ballot(forced); }
        if (need == ncand) {
#pragma unroll
            for (int k4 = 0; k4 < 4; ++k4)
#pragma unroll
                for (int k = 0; k < 4; ++k) selw[k4][k] |= __ballot(key[k4][k] != 0u);
        } else {
            unsigned thr[4] = {0u, 0u, 0u, 0u};
            for (int bit = 31; bit >= 12; --bit) {
#pragma unroll
                for (int k4 = 0; k4 < 4; ++k4) { const unsigned cand = thr[k4] | (1u << bit); int cnt = 0;
#pragma unroll
                    for (int k = 0; k < 4; ++k) cnt += __builtin_popcountll(__ballot(key[k4][k] >= cand));
                    if (cnt >= need) thr[k4] = cand; } }
#pragma unroll
            for (int k4 = 0; k4 < 4; ++k4) { int left = need; const unsigned hi = thr[k4] + 0xfffu;
#pragma unroll
                for (int k = 0; k < 4; ++k) { const unsigned long long gt = __ballot(key[k4][k] > hi); selw[k4][k] |= gt; left -= __builtin_popcountll(gt); }
#pragma unroll
                for (int k = 0; k < 4; ++k) { unsigned long long eq = __ballot(key[k4][k] != 0u && key[k4][k] >= thr[k4] && key[k4][k] <= hi);
                    while (left > 0 && eq) { const unsigned long long low = eq & (0ull - eq); selw[k4][k] |= low; eq ^= low; --left; } } }
        }
#pragma unroll
        for (int k4 = 0; k4 < 4; ++k4)
            if (C.lane < 4) SEL[(4 * C.wave + k4) * 4 + C.lane] = C.lane == 0 ? selw[k4][0] : C.lane == 1 ? selw[k4][1] : C.lane == 2 ? selw[k4][2] : selw[k4][3];
    }
    __syncthreads();
    if (C.tid < 4) { unsigned long long um = 0ull; for (int i = 0; i < NQ; ++i) um |= SEL[i * 4 + C.tid]; UM[C.tid] = um; }
    __syncthreads();
    int ucnt;
    {
        const unsigned long long u0 = UM[0], u1 = UM[1], u2 = UM[2], u3 = UM[3];
        const int c0 = __builtin_popcountll(u0), c1 = __builtin_popcountll(u1), c2 = __builtin_popcountll(u2), c3 = __builtin_popcountll(u3);
        ucnt = c0 + c1 + c2 + c3;
        if (C.tid < 256) { const int w = C.tid >> 6, bit = C.tid & 63; const unsigned long long uw = w == 0 ? u0 : w == 1 ? u1 : w == 2 ? u2 : u3;
            if ((uw >> bit) & 1ull) { const int pos = (w > 0 ? c0 : 0) + (w > 1 ? c1 : 0) + (w > 2 ? c2 : 0) + __builtin_popcountll(uw & ((1ull << bit) - 1ull)); UL[pos] = C.tid; } }
    }
    __syncthreads();

    for (int rep = (TIMEDUP & 1024) ? 0 : 1; rep < 2; ++rep) {
        f32x4 ao[4]; float al = 0.f;
#pragma unroll
        for (int dt = 0; dt < 4; ++dt) ao[dt] = (f32x4){0.f, 0.f, 0.f, 0.f};
        const bf16* KS = (const bf16*)(C.ws + WS_KVS) + (size_t)(b * SEQ) * 256 + g * 64;
        const bf16* VST = (const bf16*)(C.ws + WS_VST) + (size_t)bg * 256 * 4096;
        const int nss = (ucnt + 3) >> 2;
        const unsigned long long my0 = SEL[(iq - q0) * 4 + 0], my1 = SEL[(iq - q0) * 4 + 1], my2 = SEL[(iq - q0) * 4 + 2], my3 = SEL[(iq - q0) * 4 + 3];
#define SLC_FETCH(STG, KR, VR) do { _Pragma("unroll") for (int j = 0; j < 4; ++j) { const int ix = 4 * (STG) + j; const int n = ix < ucnt ? UL[ix] : 0; \
            const TileSrc ts{KS + (size_t)n * 64 * 256, 256, VST + (size_t)n * 4096, 64}; nsa_fetch(C, ts, ix < ucnt, KR[j], VR[j]); } } while (0)
#define SLC_STAGE(STG, KR, VR) do { \
            __syncthreads(); \
            _Pragma("unroll") for (int j = 0; j < 4; ++j) nsa_commit(C, j, 4 * (STG) + j < ucnt, KR[j], VR[j]); \
            __syncthreads(); \
            if ((STG) + 1 < nss) SLC_FETCH((STG) + 1, KR, VR); \
            _Pragma("unroll") for (int j = 0; j < 4; ++j) { \
                const int ix = 4 * (STG) + j; \
                if (ix < ucnt) { \
                    const int n = UL[ix]; \
                    const unsigned long long mw = (n >> 6) == 0 ? my0 : (n >> 6) == 1 ? my1 : (n >> 6) == 2 ? my2 : my3; \
                    const bool mysel = (mw >> (n & 63)) & 1ull; \
                    if (__ballot(mysel) != 0ull) { \
                        f32x4 s[4]; v4u vf[4][2]; nsa_scores(C, j, qf, s); nsa_vfrag(C, j, vf); \
                        if (n == qb) { _Pragma("unroll") for (int kt = 0; kt < 4; ++kt) _Pragma("unroll") for (int r = 0; r < 4; ++r) { const int key = 16 * kt + 4 * q + r; if (key > iq) s[kt][r] = -INFINITY; } } \
                        al += nsa_exp(s, mysel ? ms2 : INFINITY); \
                        nsa_pv(C, j, s, ao, vf); \
                    } } } } while (0)
        SLC_FETCH(0, kr, vr);
        for (int st = 0; st < nss; ++st) SLC_STAGE(st, kr, vr);
#undef SLC_FETCH
#undef SLC_STAGE
        float lt = al; lt += __shfl_xor(lt, 16); lt += __shfl_xor(lt, 32); const float inv = (lt > 0.f && rep == 1) ? gate[1] / lt : 0.f;
#pragma unroll
        for (int dt = 0; dt < 4; ++dt) out[dt] += ao[dt] * inv;
    }
    for (int rep = (TIMEDUP & 512) ? 0 : 1; rep < 2; ++rep) {
        f32x4 ao[4]; float al = 0.f;
#pragma unroll
        for (int dt = 0; dt < 4; ++dt) ao[dt] = (f32x4){0.f, 0.f, 0.f, 0.f};
        const bf16* KW = (const bf16*)(C.ws + WS_KVW) + (size_t)(b * SEQ) * 256 + g * 64;
        const bf16* VWT = (const bf16*)(C.ws + WS_VWT) + (size_t)bg * 256 * 4096;
        const int nfirst = qb >= 8 ? qb - 8 : 0, nw = qb - nfirst + 1, nws = (nw + 3) >> 2;
#pragma unroll
        for (int j = 0; j < 4; ++j) { const int n = nfirst + (j < nw ? j : 0); const TileSrc ts{KW + (size_t)n * 64 * 256, 256, VWT + (size_t)n * 4096, 64}; nsa_fetch(C, ts, true, kr[j], vr[j]); }
        for (int st = 0; st < nws; ++st) {
            __syncthreads();
#pragma unroll
            for (int j = 0; j < 4; ++j) nsa_commit(C, j, 4 * st + j < nw, kr[j], vr[j]);
            __syncthreads();
            if (st + 1 < nws) {
#pragma unroll
                for (int j = 0; j < 4; ++j) { const int ix = 4 * (st + 1) + j; const int n = nfirst + (ix < nw ? ix : 0); const TileSrc ts{KW + (size_t)n * 64 * 256, 256, VWT + (size_t)n * 4096, 64}; nsa_fetch(C, ts, ix < nw, kr[j], vr[j]); }
            }
#pragma unroll
            for (int j = 0; j < 4; ++j) {
                const int ix = 4 * st + j;
                if (ix < nw) {
                    const int delta = qb - (nfirst + ix);
                    f32x4 s[4]; v4u vf[4][2]; nsa_scores(C, j, qf, s); nsa_vfrag(C, j, vf);
                    if (delta == 0 || delta == 8) {
#pragma unroll
                        for (int kt = 0; kt < 4; ++kt)
#pragma unroll
                            for (int r = 0; r < 4; ++r) { const int key = 16 * kt + 4 * q + r; const bool ok = delta == 0 ? (key <= iq) : (key > iq); if (!ok) s[kt][r] = -INFINITY; }
                    }
                    al += nsa_exp(s, mw2);
                    nsa_pv(C, j, s, ao, vf);
                }
            }
        }
        float lt = al; lt += __shfl_xor(lt, 16); lt += __shfl_xor(lt, 32); const float inv = (lt > 0.f && rep == 1) ? gate[2] / lt : 0.f;
#pragma unroll
        for (int dt = 0; dt < 4; ++dt) out[dt] += ao[dt] * inv;
    }
    if (DRY) {
#pragma unroll
      for (int dt = 0; dt < 4; ++dt) asm volatile("" :: "v"(out[dt]));
    } else { bf16* op = QB + (size_t)(t0 + iq) * 512 + (g * 4 + hh) * 64 + 4 * q;
#pragma unroll
      for (int dt = 0; dt < 4; ++dt) *(v2u*)(op + 16 * dt) = (v2u){pk2(out[dt][0], out[dt][1]), pk2(out[dt][2], out[dt][3])}; }
    __syncthreads();
}


constexpr int N6_IMP = 0;
constexpr int N6_KVC = 65536;
constexpr int N6_SEL = 120832;
constexpr int N6_UM = 122880;
constexpr int N6_UL = 122912;
constexpr int N6_KV = 0;

__device__ __forceinline__ void n6_commit(const Ctx& C, int base, int j, const v4u& kr, const v4u& vr) {
    LAS bf16* KT = (LAS bf16*)(C.lds + base + j * NU_TILE); LAS bf16* VT = KT + 64 * 72;
    const int r = C.tid >> 3, ch = C.tid & 7;
    *(LAS v4u*)(KT + r * 72 + ch * 8) = kr; *(LAS v4u*)(VT + r * 72 + ch * 8) = vr;
}
__device__ __forceinline__ void n6_kfrag(const Ctx& C, int toff, bf16x8 (&a)[4][2]) {
    const LAS bf16* KT = (const LAS bf16*)(C.lds + toff);
    const int fr = C.lane & 15, q = C.lane >> 4;
#pragma unroll
    for (int kt = 0; kt < 4; ++kt)
#pragma unroll
        for (int ks = 0; ks < 2; ++ks) a[kt][ks] = *(const LAS bf16x8*)(KT + (16 * kt + fr) * 72 + ks * 32 + 8 * q);
}
__device__ __forceinline__ void n6_vfrag(const Ctx& C, int toff, v4u (&vf)[4][2]) {
    const LAS bf16* VT = (const LAS bf16*)(C.lds + toff) + 64 * 72;
    const int fr = C.lane & 15, q = C.lane >> 4;
#pragma unroll
    for (int dt = 0; dt < 4; ++dt)
#pragma unroll
        for (int k2 = 0; k2 < 2; ++k2) { const LAS bf16* vr = VT + (16 * dt + fr) * 72 + 32 * k2 + 4 * q;
            const v2u lo = *(const LAS v2u*)vr, hi = *(const LAS v2u*)(vr + 16); vf[dt][k2] = (v4u){lo.x, lo.y, hi.x, hi.y}; }
}
__device__ __forceinline__ void n6_scores(const bf16x8 (&a)[4][2], const bf16x8 (&qf)[2], f32x4 (&s)[4]) {
#pragma unroll
    for (int kt = 0; kt < 4; ++kt) s[kt] = __builtin_amdgcn_mfma_f32_16x16x32_bf16(a[kt][0], qf[0], (f32x4){0.f, 0.f, 0.f, 0.f}, 0, 0, 0);
#pragma unroll
    for (int kt = 0; kt < 4; ++kt) s[kt] = __builtin_amdgcn_mfma_f32_16x16x32_bf16(a[kt][1], qf[1], s[kt], 0, 0, 0);
}

__device__ __forceinline__ void nsa_attn_unit64(const Ctx& C, int l, int u, bool DRY) {
    const int bg = u & 3, b = bg >> 1, g = bg & 1, qb = 255 - (u >> 2);
    const int t0 = b * SEQ + qb * 64;
    const int fr = C.lane & 15, q = C.lane >> 4, qq = fr >> 2, hh = fr & 3;
    LAS float* IMP = (LAS float*)(C.lds + N6_IMP);
    LAS unsigned long long* SEL = (LAS unsigned long long*)(C.lds + N6_SEL);
    LAS unsigned long long* UM = (LAS unsigned long long*)(C.lds + N6_UM);
    LAS int* UL = (LAS int*)(C.lds + N6_UL);
    for (int i = C.tid; i < 64 * 256; i += NTHR) IMP[i] = 0.f;
    float mc2, ms2, mw2;
    { const float* gn = C.in(11) + (size_t)l * 256;
      const float gq = wave_max(fabsf(gn[C.lane])), g1 = wave_max(fabsf(gn[64 + C.lane])), g2 = wave_max(fabsf(gn[128 + C.lane])), g3 = wave_max(fabsf(gn[192 + C.lane]));
      mc2 = 8.0f * gq * g1 * LOG2E; ms2 = 8.0f * gq * g2 * LOG2E; mw2 = 8.0f * gq * g3 * LOG2E; }
    bf16* QB = (bf16*)(C.ws + WS_QB);
    const int iq0 = 8 * C.wave + qq;
    bf16x8 qf[2][2]; float gate[2][3];
#pragma unroll
    for (int ct = 0; ct < 2; ++ct) {
        const bf16* qp = QB + (size_t)(t0 + iq0 + 4 * ct) * 512 + (g * 4 + hh) * 64 + 8 * q;
        qf[ct][0] = *(const bf16x8*)qp; qf[ct][1] = *(const bf16x8*)(qp + 32);
        const float* sm = (const float*)(C.ws + WS_SMALL) + (size_t)(t0 + iq0 + 4 * ct) * 64 + 16 + (g * 4 + hh) * 3;
#pragma unroll
        for (int k = 0; k < 3; ++k) gate[ct][k] = sigmoidf_(sm[k]); }
#define N6_ACCUM(ct, ao, scale, first) do { bf16* op_ = QB + (size_t)(t0 + iq0 + 4 * (ct)) * 512 + (g * 4 + hh) * 64 + 4 * q; \
        _Pragma("unroll") for (int dt = 0; dt < 4; ++dt) { f32x4 v_ = (ao)[dt] * (scale); \
            if (!(first)) { const v2u o_ = *(const v2u*)(op_ + 16 * dt); v_[0] += bflo(o_.x); v_[1] += bfhi(o_.x); v_[2] += bflo(o_.y); v_[3] += bfhi(o_.y); } \
            if (DRY) asm volatile("" :: "v"(v_)); else *(v2u*)(op_ + 16 * dt) = (v2u){pk2(v_[0], v_[1]), pk2(v_[2], v_[3])}; } } while (0)
    v4u kr[3], vr[3];
    const int r8 = C.tid >> 3, ch8 = C.tid & 7;
#define N6_FETCH(j, kptr, kld, vptr, vld) do { kr[j] = *(const v4u*)((kptr) + (size_t)r8 * (kld) + ch8 * 8); vr[j] = *(const v4u*)((vptr) + (size_t)r8 * (vld) + ch8 * 8); } while (0)

    const bf16* KC = (const bf16*)(C.ws + WS_KCMP) + (size_t)bg * 1024 * 64;
    const bf16* VCT = (const bf16*)(C.ws + WS_VCT) + (size_t)bg * 64 * 1024;
    const int nct = (4 * qb + 3 + 63) >> 6, ncs = (nct + 2) / 3;
    const int cmin = (64 * qb + 8 * C.wave - 31) >> 4;
    float cl[2] = {0.f, 0.f}, cinv[2] = {0.f, 0.f};
    for (int pass = 0; pass < 2; ++pass) {
        f32x4 ao[2][4];
#pragma unroll
        for (int ct = 0; ct < 2; ++ct)
#pragma unroll
            for (int dt = 0; dt < 4; ++dt) ao[ct][dt] = (f32x4){0.f, 0.f, 0.f, 0.f};
        if (pass == 1) {
#pragma unroll
            for (int ct = 0; ct < 2; ++ct) { float lt = cl[ct]; lt += __shfl_xor(lt, 16); lt += __shfl_xor(lt, 32); cinv[ct] = lt > 0.f ? 1.0f / lt : 0.f; } }
#pragma unroll
        for (int j = 0; j < 3; ++j) { const int tl = j < nct ? j : nct - 1; N6_FETCH(j, KC + (size_t)tl * 64 * 64, 64, VCT + tl * 64, 1024); }
        for (int st = 0; st < ncs; ++st) {
            __syncthreads();
#pragma unroll
            for (int j = 0; j < 3; ++j) n6_commit(C, N6_KVC, j, kr[j], vr[j]);
            __syncthreads();
            if (st + 1 < ncs) {
#pragma unroll
                for (int j = 0; j < 3; ++j) { const int t3 = 3 * (st + 1) + j, tl = t3 < nct ? t3 : nct - 1; N6_FETCH(j, KC + (size_t)tl * 64 * 64, 64, VCT + tl * 64, 1024); } }
#pragma unroll 1
            for (int j = 0; j < 3; ++j) {
                const int tl = 3 * st + j;
                if (tl < nct) {
                    const int toff = N6_KVC + j * NU_TILE;
                    bf16x8 a[4][2]; v4u vf[4][2]; n6_kfrag(C, toff, a); if (pass == 1) n6_vfrag(C, toff, vf);
#pragma unroll
                    for (int ct = 0; ct < 2; ++ct) {
                        f32x4 s[4]; n6_scores(a, qf[ct], s);
                        if (64 * tl + 63 > cmin) { const int cmax = (64 * qb + iq0 + 4 * ct - 31) >> 4;
#pragma unroll
                            for (int kt = 0; kt < 4; ++kt)
#pragma unroll
                                for (int r = 0; r < 4; ++r) { const int c = 64 * tl + 16 * kt + 4 * q + r; if (c > cmax) s[kt][r] = -INFINITY; } }
                        const float ps = nsa_exp(s, mc2);
                        if (pass == 0) cl[ct] += ps;
                        else {
#pragma unroll
                            for (int kt = 0; kt < 4; ++kt) {
#pragma unroll
                                for (int r = 0; r < 4; ++r) s[kt][r] *= cinv[ct];
                                float gs = (s[kt][0] + s[kt][1]) + (s[kt][2] + s[kt][3]), es = s[kt][3];
                                gs += __shfl_xor(gs, 1); gs += __shfl_xor(gs, 2); es += __shfl_xor(es, 1); es += __shfl_xor(es, 2);
                                if (hh == 0) { const int n = 16 * tl + 4 * kt + q;
                                    if (n < 256) { atomicAdd((float*)(IMP + (iq0 + 4 * ct) * 256 + n), gs); if (n + 1 < 256) atomicAdd((float*)(IMP + (iq0 + 4 * ct) * 256 + n + 1), es); } }
                            }
                            nsa_pv(C, j, s, ao[ct], vf);
                        }
                    }
                }
            }
        }
        if (pass == 1) {
#pragma unroll
            for (int ct = 0; ct < 2; ++ct) N6_ACCUM(ct, ao[ct], gate[ct][0], true); }
        __syncthreads();
    }

    {
        const int nforced = qb >= 2 ? 3 : qb + 1; const int ncand = qb + 1 - nforced;
        int need = 16 - nforced; if (need > ncand) need = ncand;
#pragma unroll 1
        for (int grp = 0; grp < 2; ++grp) {
            unsigned key[4][4]; unsigned long long selw[4][4];
#pragma unroll
            for (int k4 = 0; k4 < 4; ++k4)
#pragma unroll
                for (int k = 0; k < 4; ++k) { const int n = C.lane + 64 * k; const bool valid = n <= qb; const bool forced = valid && (n == 0 || n == qb || n == qb - 1);
                    key[k4][k] = (valid && !forced) ? (__builtin_bit_cast(unsigned, fmaxf(IMP[(8 * C.wave + 4 * grp + k4) * 256 + n], 0.f)) + 1u) : 0u;
                    selw[k4][k] = __ballot(forced); }
            if (need == ncand) {
#pragma unroll
                for (int k4 = 0; k4 < 4; ++k4)
#pragma unroll
                    for (int k = 0; k < 4; ++k) selw[k4][k] |= __ballot(key[k4][k] != 0u);
            } else {
                unsigned thr[4] = {0u, 0u, 0u, 0u};
                for (int bit = 31; bit >= 12; --bit) {
#pragma unroll
                    for (int k4 = 0; k4 < 4; ++k4) { const unsigned cand = thr[k4] | (1u << bit); int cnt = 0;
#pragma unroll
                        for (int k = 0; k < 4; ++k) cnt += __builtin_popcountll(__ballot(key[k4][k] >= cand));
                        if (cnt >= need) thr[k4] = cand; } }
#pragma unroll
                for (int k4 = 0; k4 < 4; ++k4) { int left = need; const unsigned hi = thr[k4] + 0xfffu;
#pragma unroll
                    for (int k = 0; k < 4; ++k) { const unsigned long long gt = __ballot(key[k4][k] > hi); selw[k4][k] |= gt; left -= __builtin_popcountll(gt); }
#pragma unroll
                    for (int k = 0; k < 4; ++k) { unsigned long long eq = __ballot(key[k4][k] != 0u && key[k4][k] >= thr[k4] && key[k4][k] <= hi);
                        while (left > 0 && eq) { const unsigned long long low = eq & (0ull - eq); selw[k4][k] |= low; eq ^= low; --left; } } }
            }
#pragma unroll
            for (int k4 = 0; k4 < 4; ++k4)
                if (C.lane < 4) SEL[(8 * C.wave + 4 * grp + k4) * 4 + C.lane] = C.lane == 0 ? selw[k4][0] : C.lane == 1 ? selw[k4][1] : C.lane == 2 ? selw[k4][2] : selw[k4][3];
        }
    }
    __syncthreads();
    if (C.tid < 4) { unsigned long long um = 0ull; for (int i = 0; i < 64; ++i) um |= SEL[i * 4 + C.tid]; UM[C.tid] = um; }
    __syncthreads();
    int ucnt;
    {
        const unsigned long long u0 = UM[0], u1 = UM[1], u2 = UM[2], u3 = UM[3];
        const int c0 = __builtin_popcountll(u0), c1 = __builtin_popcountll(u1), c2 = __builtin_popcountll(u2), c3 = __builtin_popcountll(u3);
        ucnt = c0 + c1 + c2 + c3;
        if (C.tid < 256) { const int w = C.tid >> 6, bit = C.tid & 63; const unsigned long long uw = w == 0 ? u0 : w == 1 ? u1 : w == 2 ? u2 : u3;
            if ((uw >> bit) & 1ull) { const int pos = (w > 0 ? c0 : 0) + (w > 1 ? c1 : 0) + (w > 2 ? c2 : 0) + __builtin_popcountll(uw & ((1ull << bit) - 1ull)); UL[pos] = C.tid; } }
    }
    __syncthreads();

    {
        f32x4 ao[2][4]; float al[2] = {0.f, 0.f};
#pragma unroll
        for (int ct = 0; ct < 2; ++ct)
#pragma unroll
            for (int dt = 0; dt < 4; ++dt) ao[ct][dt] = (f32x4){0.f, 0.f, 0.f, 0.f};
        const bf16* KS = (const bf16*)(C.ws + WS_KVS) + (size_t)(b * SEQ) * 256 + g * 64;
        const bf16* VST = (const bf16*)(C.ws + WS_VST) + (size_t)bg * 256 * 4096;
        const int nss = (ucnt + 2) / 3;
#pragma unroll
        for (int j = 0; j < 3; ++j) { const int n = j < ucnt ? UL[j] : 0; N6_FETCH(j, KS + (size_t)n * 64 * 256, 256, VST + (size_t)n * 4096, 64); }
        for (int st = 0; st < nss; ++st) {
            __syncthreads();
#pragma unroll
            for (int j = 0; j < 3; ++j) n6_commit(C, N6_KV, j, kr[j], vr[j]);
            __syncthreads();
            if (st + 1 < nss) {
#pragma unroll
                for (int j = 0; j < 3; ++j) { const int ix = 3 * (st + 1) + j; const int n = ix < ucnt ? UL[ix] : 0; N6_FETCH(j, KS + (size_t)n * 64 * 256, 256, VST + (size_t)n * 4096, 64); } }
#pragma unroll 1
            for (int j = 0; j < 3; ++j) {
                const int ix = 3 * st + j;
                if (ix < ucnt) {
                    const int n = UL[ix];
                    const bool sel0 = (SEL[iq0 * 4 + (n >> 6)] >> (n & 63)) & 1ull, sel1 = (SEL[(iq0 + 4) * 4 + (n >> 6)] >> (n & 63)) & 1ull;
                    const bool act0 = __ballot(sel0) != 0ull, act1 = __ballot(sel1) != 0ull;
                    if (act0 || act1) {
                        const int toff = N6_KV + j * NU_TILE;
                        bf16x8 a[4][2]; v4u vf[4][2]; n6_kfrag(C, toff, a); n6_vfrag(C, toff, vf);
#pragma unroll
                        for (int ct = 0; ct < 2; ++ct) {
                            if (ct == 0 ? act0 : act1) {
                                f32x4 s[4]; n6_scores(a, qf[ct], s);
                                if (n == qb) {
#pragma unroll
                                    for (int kt = 0; kt < 4; ++kt)
#pragma unroll
                                        for (int r = 0; r < 4; ++r) { const int key = 16 * kt + 4 * q + r; if (key > iq0 + 4 * ct) s[kt][r] = -INFINITY; } }
                                al[ct] += nsa_exp(s, (ct == 0 ? sel0 : sel1) ? ms2 : INFINITY);
                                nsa_pv(C, j, s, ao[ct], vf);
                            } }
                    } } }
        }
#pragma unroll
        for (int ct = 0; ct < 2; ++ct) { float lt = al[ct]; lt += __shfl_xor(lt, 16); lt += __shfl_xor(lt, 32); const float inv = lt > 0.f ? gate[ct][1] / lt : 0.f;
            N6_ACCUM(ct, ao[ct], inv, false); }
    }
    {
        f32x4 ao[2][4]; float al[2] = {0.f, 0.f};
#pragma unroll
        for (int ct = 0; ct < 2; ++ct)
#pragma unroll
            for (int dt = 0; dt < 4; ++dt) ao[ct][dt] = (f32x4){0.f, 0.f, 0.f, 0.f};
        const bf16* KW = (const bf16*)(C.ws + WS_KVW) + (size_t)(b * SEQ) * 256 + g * 64;
        const bf16* VWT = (const bf16*)(C.ws + WS_VWT) + (size_t)bg * 256 * 4096;
        const int nfirst = qb >= 8 ? qb - 8 : 0, nw = qb - nfirst + 1, nws = (nw + 2) / 3;
#pragma unroll
        for (int j = 0; j < 3; ++j) { const int n = nfirst + (j < nw ? j : 0); N6_FETCH(j, KW + (size_t)n * 64 * 256, 256, VWT + (size_t)n * 4096, 64); }
        for (int st = 0; st < nws; ++st) {
            __syncthreads();
#pragma unroll
            for (int j = 0; j < 3; ++j) n6_commit(C, N6_KV, j, kr[j], vr[j]);
            __syncthreads();
            if (st + 1 < nws) {
#pragma unroll
                for (int j = 0; j < 3; ++j) { const int ix = 3 * (st + 1) + j; const int n = nfirst + (ix < nw ? ix : 0); N6_FETCH(j, KW + (size_t)n * 64 * 256, 256, VWT + (size_t)n * 4096, 64); } }
#pragma unroll 1
            for (int j = 0; j < 3; ++j) {
                const int ix = 3 * st + j;
                if (ix < nw) {
                    const int delta = qb - (nfirst + ix); const int toff = N6_KV + j * NU_TILE;
                    bf16x8 a[4][2]; v4u vf[4][2]; n6_kfrag(C, toff, a); n6_vfrag(C, toff, vf);
#pragma unroll
                    for (int ct = 0; ct < 2; ++ct) {
                        f32x4 s[4]; n6_scores(a, qf[ct], s);
                        if (delta == 0 || delta == 8) {
#pragma unroll
                            for (int kt = 0; kt < 4; ++kt)
#pragma unroll
                                for (int r = 0; r < 4; ++r) { const int key = 16 * kt + 4 * q + r; const bool ok = delta == 0 ? (key <= iq0 + 4 * ct) : (key > iq0 + 4 * ct); if (!ok) s[kt][r] = -INFINITY; } }
                        al[ct] += nsa_exp(s, mw2);
                        nsa_pv(C, j, s, ao[ct], vf);
                    }
                }
            }
        }
#pragma unroll
        for (int ct = 0; ct < 2; ++ct) { float lt = al[ct]; lt += __shfl_xor(lt, 16); lt += __shfl_xor(lt, 32); const float inv = lt > 0.f ? gate[ct][2] / lt : 0.f;
            N6_ACCUM(ct, ao[ct], inv, false); }
    }
#undef N6_FETCH
#undef N6_ACCUM
    __syncthreads();
}

__device__ __forceinline__ void phase_mix1(const Ctx& C, int l) {
    const int gw = C.bid * NWAVES + C.wave, NGW = C.G * NWAVES;
    for (int rep = (TIMEDUP & 32) ? 0 : 1; rep < 2; ++rep) {
    for (int it = gw; it < 2048; it += NGW) nsa_cmp1_item(C, it);
    for (int it = gw; it < 2048; it += NGW) nsa_vtrans_item(C, it); }
    for (int rep = (TIMEDUP & 262144) ? 0 : 1; rep < 2; ++rep) for (int tp = gw; tp < T / 2; tp += NGW) nsa_prep_token(C, l, tp, rep == 0);
    gla_stage_alpha(C, l);
    __syncthreads();
    for (int rep = (TIMEDUP & 16) ? 0 : 1; rep < 2; ++rep) for (int u = C.bid; u < 4096; u += C.G) { if (u < 2048) gla_unit_a(C, l, u); else mlstm_unit_a(C, l, u - 2048); }
}
__device__ __forceinline__ void phase_mix2(const Ctx& C, int l) {
    const int gw = C.bid * NWAVES + C.wave, NGW = C.G * NWAVES;
    for (int rep = (TIMEDUP & 1048576) ? 0 : 1; rep < 2; ++rep) for (int it = gw; it < 512; it += NGW) nsa_cmp2_item(C, l, it);
    for (int rep = (TIMEDUP & 524288) ? 0 : 1; rep < 2; ++rep) phase_scan(C, rep == 0);
}
__device__ __forceinline__ void phase_mix3(const Ctx& C, int l) {
    for (int rep = (TIMEDUP & 1) ? 0 : 1; rep < 2; ++rep) for (int i = C.bid; i < 1024; i += C.G) {
        const_cast<Ctx&>(C).launder();
        const int r = i / C.G, w = i % C.G; const int pos = (r & 1) ? (1023 - ((r >> 1) * C.G + w)) : ((r >> 1) * C.G + w);
        nsa_attn_unit64(C, l, pos, rep == 0); }
    const_cast<Ctx&>(C).launder(); const Ctx& D = C;
    gla_stage_alpha(D, l);
    for (int rep = (TIMEDUP & 2) ? 0 : 1; rep < 2; ++rep) for (int u = D.bid; u < 4096; u += D.G) { if (u < 2048) gla_unit_c(D, l, u, rep == 0); else mlstm_unit_c(D, l, u - 2048, rep == 0); }
}

constexpr int MIX_PHASES = 10;
#define MIXER_PHASES \
    if (PH_ON) for (int rep = (TIMEDUP & 131072) ? 0 : 1; rep < 2; ++rep) phase_norm(C, C.in(5) + (size_t)l * DM, C.X); \
    PH_END; \
    if (PH_ON) { \
        pg8::Gemm g{(const bf16*)(C.ws + WS_XN), (const bf16*)(C.ws + WS_WIN), T, 4608, DM}; \
        pg8::StaticOrder S; S.init(T, 4608, C.G, C.bid); \
        pg8::EpiWin E{C.ws + WS_R, (const float*)(C.ws + WS_VEC) + VEC_BINP, (float*)(C.ws + WS_SMALL)}; \
        for (int rep = (TIMEDUP & 64) ? 0 : 1; rep < 2; ++rep) pg8::gemm_phase<pg8::EpiWin, pg8::StaticOrder, false>(C.lds, g, S, E, nullptr); \
    } \
    PH_END; \
    if (PH_ON) phase_mix1(C, l); \
    PH_END; \
    if (PH_ON) phase_mix2(C, l); \
    PH_END; \
    if (PH_ON) phase_mix3(C, l); \
    PH_END; \
    if (PH_ON) { \
        pg8::Gemm g{(const bf16*)(C.ws + WS_XN), (const bf16*)(C.ws + WS_WGT), T, 3 * DM, DM}; \
        pg8::StaticOrder S; S.init(T, 3 * DM, C.G, C.bid); \
        pg8::EpiGate E{C.ws, DM, C.in(7) + (size_t)l * N_IN + 4400}; \
        for (int rep = (TIMEDUP & 16384) ? 0 : 1; rep < 2; ++rep) pg8::gemm_phase<pg8::EpiGate, pg8::StaticOrder, false>(C.lds, g, S, E, nullptr); \
    } \
    PH_END; \
    for (int br = 0; br < 3; ++br) { \
        if (PH_ON) { \
            const bf16* Asrc = (const bf16*)(C.ws + (br == 0 ? WS_RA : br == 1 ? WS_QB : WS_OC)); \
            pg8::Gemm g{Asrc, (const bf16*)(C.ws + WS_WBR) + (size_t)br * DM * 512, T, DM, 512}; \
            pg8::StaticOrder S; S.init(T, DM, C.G, C.bid); \
            for (int rep = (TIMEDUP & 32768) ? 0 : 1; rep < 2; ++rep) { \
            pg8::EpiBranch E{(bf16*)(C.ws + WS_Y), (const bf16*)(C.ws + WS_G0 + (size_t)(br >= 1) * (WS_G1 - WS_G0) + (size_t)(br >= 2) * (WS_G2 - WS_G1)), DM, rep == 0 ? 2 : (br == 0 ? 1 : 0)}; \
            pg8::gemm_phase<pg8::EpiBranch, pg8::StaticOrder, false>(C.lds, g, S, E, nullptr); } \
        } \
        PH_END; \
    } \
    if (PH_ON) { \
        pg8::Gemm g{(const bf16*)(C.ws + WS_Y), (const bf16*)(C.ws + WS_WOUT), T, DM, DM}; \
        pg8::StaticOrder S; S.init(T, DM, C.G, C.bid); \
        for (int rep = (TIMEDUP & 65536) ? 0 : 1; rep < 2; ++rep) { \
        pg8::EpiResid E{C.X, DM, rep == 1 ? 1.0f : 0.f, C.X}; \
        pg8::gemm_phase<pg8::EpiResid, pg8::StaticOrder, false>(C.lds, g, S, E, nullptr); } \
    } \
    PH_END;

constexpr int N_PHASES = 8 * 3 + 4 * MIX_PHASES;

__global__ void __launch_bounds__(NTHR, 2) hybrid_fwd(Args args) {
    extern __shared__ __attribute__((aligned(16))) unsigned char lds_raw[];
    Ctx C;
    C.lds = (LAS unsigned char*)lds_raw;
    C.tid = threadIdx.x; C.lane = C.tid & 63; C.wave = __builtin_amdgcn_readfirstlane(C.tid >> 6);
    C.G = gridDim.x; C.bid = blockIdx.x;
    C.inp = (const GAS float* const __attribute__((address_space(4)))*)__builtin_amdgcn_kernarg_segment_ptr();
    C.X = args.out; C.ws = args.ws;
    volatile LAS unsigned* MISC = (volatile LAS unsigned*)(C.lds + MISC_OFF);
    for (int u = C.tid; u < (LDS_BYTES - RING_BYTES) / 4; u += NTHR) ((LAS unsigned*)(C.lds + RING_BYTES))[u] = 0u;
    __syncthreads();
    __builtin_amdgcn_fence(__ATOMIC_ACQUIRE, "agent"); asm volatile("s_waitcnt vmcnt(0)" ::: "memory");
    __syncthreads();
    const int lo = args.ph_lo, hi = args.ph_hi;
    XcdBarrier bar; bar.bar = (unsigned*)(C.ws + WS_CTL) + 4096; bar.x = 0; bar.st = nullptr;
    if (hi - lo > 1) bar = xcd_barrier_post((unsigned*)(C.ws + WS_CTL) + 4096, MISC + 8);
    int pc = 0;
#define PH_ON (C.launder(), pc >= lo && pc < hi)
#define PH_END_NB do { ++pc; } while (0)
#define PH_END do { if (pc >= lo && pc + 1 < hi) { xcd_barrier(bar); if (TIMEDUP & 4096) xcd_barrier(bar); } ++pc; } while (0)

    for (int step = 0; step < 2 * NLAYER; ++step) {
        const int l = step >> 1, f = step & 1;
        if (PH_ON) {
            if (step == 0) phase_init(C);
            if (f == 0) for (int rep = (TIMEDUP & 128) ? 0 : 1; rep < 2; ++rep) phase_prep_weights(C, l);
            for (int rep = (TIMEDUP & 8) ? 0 : 1; rep < 2; ++rep) phase_norm(C, (f ? C.in(19) : C.in(1)) + (size_t)l * DM, step == 0 ? C.in(0) : (const float*)C.X);
        }
        PH_END;
        if (PH_ON) {
            pg8::Gemm g{(const bf16*)(C.ws + WS_XN), (const bf16*)(C.ws + (f ? WS_WGU2 : WS_WGU1)), T, 2 * DFF, DM};
            pg8::StaticOrder S; S.init(T, 2 * DFF, C.G, C.bid);
            for (int rep = (TIMEDUP & (4 | 4194304)) ? 0 : 1; rep < 2; ++rep) {
            pg8::EpiSwiGLU E{(bf16*)(C.ws + WS_HID), DFF, ((TIMEDUP & 4194304) && rep == 0) ? 1 : 0};
            pg8::gemm_phase<pg8::EpiSwiGLU, pg8::StaticOrder, false>(C.lds, g, S, E, nullptr); }
        }
        PH_END;
        if (PH_ON) {
            pg8::Gemm g{(const bf16*)(C.ws + WS_HID), (const bf16*)(C.ws + (f ? WS_WDN2 : WS_WDN1)), T, DM, DFF};
            pg8::StaticOrder S; S.init(T, DM, C.G, C.bid);
            for (int rep = (TIMEDUP & 8192) ? 0 : 1; rep < 2; ++rep) {
            pg8::EpiResid E{C.X, DM, rep == 1 ? 0.5f : 0.f, (step == 0 && !(rep == 1 && (TIMEDUP & 8192))) ? C.in(0) : (const float*)C.X};
            pg8::gemm_phase<pg8::EpiResid, pg8::StaticOrder, false>(C.lds, g, S, E, nullptr); }
        }
        PH_END;
        if (f == 0) {
            MIXER_PHASES
        }
    }
#undef PH_ON
#undef PH_END
#undef PH_END_NB
    asm volatile("s_waitcnt vmcnt(0)" ::: "memory");
    __syncthreads();
    if (C.tid == 0) { __builtin_amdgcn_fence(__ATOMIC_RELEASE, "agent"); asm volatile("s_waitcnt vmcnt(0)" ::: "memory"); }
}

extern "C" void kernel_launch(void* const* d_in, const int* in_sizes, int n_in, void* d_out, int out_size, void* d_ws, size_t ws_size, hipStream_t stream) {
    static int grid = 0;
    if (grid == 0) {
        if (n_in != 23 || out_size != T * DM || ws_size < WS_END) { fprintf(stderr, "kernel_launch: unexpected shapes (n_in %d out %d ws %zu, need %zu)\n", n_in, out_size, ws_size, (size_t)WS_END); grid = -1; return; }
        int dev = 0, cus = 0, per_cu = 0;
        if (hipGetDevice(&dev) != hipSuccess || hipDeviceGetAttribute(&cus, hipDeviceAttributeMultiprocessorCount, dev) != hipSuccess) { grid = -1; return; }
        if (hipFuncSetAttribute((const void*)hybrid_fwd, hipFuncAttributeMaxDynamicSharedMemorySize, LDS_BYTES) != hipSuccess) { fprintf(stderr, "kernel_launch: hipFuncSetAttribute failed\n"); grid = -1; return; }
        if (hipOccupancyMaxActiveBlocksPerMultiprocessor(&per_cu, (const void*)hybrid_fwd, NTHR, LDS_BYTES) != hipSuccess || per_cu < 1) { fprintf(stderr, "kernel_launch: occupancy query says %d blocks per CU\n", per_cu); }
        (void)hipGetLastError();
        grid = cus;
    }
    if (grid < 0) return;
    (void)hipMemsetAsync((char*)d_ws + WS_CTL, 0, CTL_ZERO_BYTES, stream);
    Args a{};
    for (int i = 0; i < 23; ++i) a.in[i] = (const float*)d_in[i];
    a.out = (float*)d_out; a.ws = (unsigned char*)d_ws;
#if ONE_LAUNCH
    a.ph_lo = 0; a.ph_hi = N_PHASES;
    hipLaunchKernelGGL(hybrid_fwd, dim3(grid), dim3(NTHR), LDS_BYTES, stream, a);
#else
    for (int p = 0; p < N_PHASES; ++p) { a.ph_lo = p; a.ph_hi = p + 1; hipLaunchKernelGGL(hybrid_fwd, dim3(grid), dim3(NTHR), LDS_BYTES, stream, a); }
#endif
}
```

```cpp
#include <hip/hip_runtime.h>
#include <cstdio>
#include <cstdint>

#ifndef ABL_ZERO
#define ABL_ZERO 0
#endif
#ifndef SCL_A
#define SCL_A 1.0f
#define SCL_B 1.0f
#define SCL_C 1.0f
#endif
#ifndef TIMEDUP
#define TIMEDUP 0
#endif
#ifndef ONE_LAUNCH
#define ONE_LAUNCH 1
#endif

#define GAS __attribute__((address_space(1)))
#define LAS __attribute__((address_space(3)))
typedef unsigned short bf16;
typedef unsigned v4u __attribute__((ext_vector_type(4)));
typedef unsigned v2u __attribute__((ext_vector_type(2)));
typedef float f32x4 __attribute__((ext_vector_type(4)));
typedef float f32x2 __attribute__((ext_vector_type(2)));
typedef short bf16x8 __attribute__((ext_vector_type(8)));
typedef short bf16x4 __attribute__((ext_vector_type(4)));

constexpr int NB = 2, SEQ = 16384, T = NB * SEQ, DM = 1024, DFF = 2816, NLAYER = 4;
constexpr int N_IN = 7472;
constexpr int NWAVES = 8, NTHR = 512;
constexpr float RMS_EPS = 1e-6f;
constexpr int NCH = SEQ / 64;

constexpr size_t MiB = 1u << 20;
constexpr size_t WS_CTL = 0, CTL_ZERO_BYTES = 1 * MiB;
constexpr size_t WS_ROPE = 1 * MiB;
constexpr size_t WS_VEC = 5 * MiB;
constexpr size_t WS_WGU1 = 6 * MiB;
constexpr size_t WS_WDN1 = 17 * MiB;
constexpr size_t WS_WGU2 = 23 * MiB;
constexpr size_t WS_WDN2 = 34 * MiB;
constexpr size_t WS_WIN = 40 * MiB;
constexpr size_t WS_WGT = 49 * MiB;
constexpr size_t WS_WBR = 55 * MiB;
constexpr size_t WS_WOUT = 58 * MiB;
constexpr size_t WS_CW1 = 60 * MiB;
constexpr size_t WS_CW2 = 62 * MiB;
constexpr size_t WS_XN = 64 * MiB;
constexpr size_t WS_R = 128 * MiB;
constexpr size_t WS_HID = WS_R;
constexpr size_t WS_QKA = WS_R;
constexpr size_t WS_VA = WS_R + 32 * MiB;
constexpr size_t WS_RA = WS_R + 64 * MiB;
constexpr size_t WS_QB = WS_R + 96 * MiB;
constexpr size_t WS_KVC = WS_R + 128 * MiB;
constexpr size_t WS_KVS = WS_R + 144 * MiB;
constexpr size_t WS_KVW = WS_R + 160 * MiB;
constexpr size_t WS_QKC = WS_R + 176 * MiB;
constexpr size_t WS_VC = WS_R + 208 * MiB;
constexpr size_t WS_OC = WS_R + 240 * MiB;
constexpr size_t WS_SMALL = WS_R + 272 * MiB;
constexpr size_t WS_VST = WS_R + 280 * MiB;
constexpr size_t WS_VWT = WS_R + 288 * MiB;
constexpr size_t WS_KCMP = WS_R + 296 * MiB;
constexpr size_t WS_VCT = WS_KCMP + MiB / 2;
constexpr size_t WS_CMPH = WS_R + 297 * MiB;
constexpr size_t WS_GST = WS_R + 302 * MiB;
constexpr size_t WS_GDEC = WS_R + 334 * MiB;
constexpr size_t WS_MSC = WS_GDEC + MiB / 2;
constexpr size_t WS_MST = WS_R + 335 * MiB;
constexpr size_t WS_MN = WS_R + 367 * MiB;
constexpr size_t WS_G0 = WS_QKA, WS_G1 = WS_QKC, WS_G2 = WS_GST;
constexpr size_t WS_G = WS_G0;
constexpr size_t WS_Y = WS_XN;
constexpr size_t WS_END = WS_R + 368 * MiB;

constexpr int VEC_BINP = 0;
constexpr int VEC_CB1 = 8192;

#define LDS_WAIT() asm volatile("s_waitcnt lgkmcnt(0)" ::: "memory")
#define VM_WAIT() asm volatile("s_waitcnt vmcnt(0)" ::: "memory")
__device__ __forceinline__ unsigned f2bf(float f) { unsigned u = __builtin_bit_cast(unsigned, f); return (u + 0x7fffu + ((u >> 16) & 1u)) >> 16; }
typedef __bf16 bf2_t __attribute__((ext_vector_type(2)));
__device__ __forceinline__ unsigned pk2(float lo, float hi) { const f32x2 v = {lo, hi}; return __builtin_bit_cast(unsigned, __builtin_convertvector(v, bf2_t)); }
__device__ __forceinline__ float bf2f(unsigned v) { return __builtin_bit_cast(float, (v & 0xffffu) << 16); }
__device__ __forceinline__ float bflo(unsigned w) { return __builtin_bit_cast(float, w << 16); }
__device__ __forceinline__ float bfhi(unsigned w) { return __builtin_bit_cast(float, w & 0xffff0000u); }
__device__ __forceinline__ float fexp(float x) { return __builtin_amdgcn_exp2f(x * 1.44269504089f); }
__device__ __forceinline__ float sigmoidf_(float x) { return 1.0f / (1.0f + __expf(-x)); }
__device__ __forceinline__ float siluf_(float x) { return x / (1.0f + __expf(-x)); }
__device__ __forceinline__ float logsigmoidf_(float x) { return fminf(x, 0.f) - __logf(1.0f + __expf(-fabsf(x))); }
__device__ __forceinline__ float wave_sum(float v) {
#pragma unroll
    for (int o = 1; o < 64; o <<= 1) v += __shfl_xor(v, o);
    return v;
}
__device__ __forceinline__ float wave_max(float v) {
#pragma unroll
    for (int o = 1; o < 64; o <<= 1) v = fmaxf(v, __shfl_xor(v, o));
    return v;
}

#define XB_TMO      128
#define XB_XCNT(j)  (256  + 64 * (j))
#define XB_XSUB(j)  (1280 + 64 * (j))
#define XB_XGEN(j)  (2304 + 64 * (j))
#define XB_TOP      3328
#define XB_TOPGEN   3392
#define XCD_BAR_WORDS 3456
#define XB_SPIN_CAP (1u << 24)

__device__ __forceinline__ unsigned xb_ld(unsigned* p)              { return __hip_atomic_load(p, __ATOMIC_RELAXED, __HIP_MEMORY_SCOPE_AGENT); }
__device__ __forceinline__ unsigned xb_add(unsigned* p, unsigned v) { return __hip_atomic_fetch_add(p, v, __ATOMIC_RELAXED, __HIP_MEMORY_SCOPE_AGENT); }
__device__ __forceinline__ unsigned xb_xcc_id() { return (unsigned)__builtin_amdgcn_s_getreg((3 << 11) | 20) & 0xFu; }
#define XB_SPIN(cond, bar) do { unsigned _sp = 0; while (cond) { __builtin_amdgcn_s_sleep(1); \
    if ((++_sp & 255u) == 0u) { if (xb_ld(&(bar)[XB_TMO])) break; if (_sp > XB_SPIN_CAP) { atomicAdd(&(bar)[XB_TMO], 1u); break; } } } } while (0)

struct XcdBarrier {
    unsigned* bar; unsigned x;
    volatile LAS unsigned* st;
};
__device__ __forceinline__ XcdBarrier xcd_barrier_post(unsigned* bar, volatile LAS unsigned* st) {
    XcdBarrier b; b.bar = bar; b.x = xb_xcc_id(); b.st = st;
    if (threadIdx.x == 0) (void)xb_add(&bar[XB_XCNT(b.x)], 1u);
    return b;
}
__device__ __forceinline__ void xcd_barrier_complete(unsigned* bar, unsigned x, unsigned& nloc, unsigned& nx) {
    const unsigned G = gridDim.x * gridDim.y * gridDim.z;
    unsigned sum, cnt, mine, sp = 0u;
    for (;;) {
        sum = 0u; cnt = 0u; mine = 0u;
#pragma unroll
        for (unsigned j = 0; j < 16; ++j) { const unsigned c = xb_ld(&bar[XB_XCNT(j)]); sum += c; cnt += (c > 0u) ? 1u : 0u; mine = (j == x) ? c : mine; }
        if (sum == G) break;
        __builtin_amdgcn_s_sleep(1);
        if ((++sp & 255u) == 0u) { if (xb_ld(&bar[XB_TMO])) break; if (sp > XB_SPIN_CAP) { atomicAdd(&bar[XB_TMO], 1u); break; } }
    }
    nloc = mine > 0u ? mine : 1u; nx = cnt > 0u ? cnt : 1u;
}
__device__ __forceinline__ void xcd_barrier(const XcdBarrier& b) {
    asm volatile("s_waitcnt vmcnt(0)" ::: "memory");
    __syncthreads();
    if (threadIdx.x == 0) {
        unsigned* bar = b.bar;
        __builtin_amdgcn_s_waitcnt(0);
        unsigned nloc = b.st[0], nx = b.st[1];
        if (nloc == 0u) { xcd_barrier_complete(bar, b.x, nloc, nx); b.st[0] = nloc; b.st[1] = nx; }
        const unsigned old = xb_add(&bar[XB_XSUB(b.x)], 1u);
        const unsigned gen = old / nloc;
        if (old + 1u == (gen + 1u) * nloc) {
            __builtin_amdgcn_fence(__ATOMIC_RELEASE, "agent");
            asm volatile("s_waitcnt vmcnt(0)" ::: "memory");
            const unsigned og = xb_add(&bar[XB_TOP], 1u);
            const unsigned tg = og / nx;
            if (og + 1u == (tg + 1u) * nx) xb_add(&bar[XB_TOPGEN], 1u);
            else XB_SPIN(xb_ld(&bar[XB_TOPGEN]) == tg, bar);
            __builtin_amdgcn_fence(__ATOMIC_ACQUIRE, "agent");
            xb_add(&bar[XB_XGEN(b.x)], 1u);
            asm volatile("s_waitcnt vmcnt(0)" ::: "memory");
        } else {
            XB_SPIN(xb_ld(&bar[XB_XGEN(b.x)]) == gen, bar);
            __builtin_amdgcn_fence(__ATOMIC_ACQUIRE, "agent");
            asm volatile("s_waitcnt vmcnt(0)" ::: "memory");
        }
    }
    __syncthreads();
}

namespace pg8 {
#define PG8_LAS __attribute__((address_space(3)))
typedef unsigned short bf16_t;
typedef short bf16x8 __attribute__((ext_vector_type(8)));
typedef float f32x4 __attribute__((ext_vector_type(4)));
typedef unsigned u32x4 __attribute__((ext_vector_type(4)));
constexpr int BM = 256, BK = 64, HALF = 128, HTB = HALF * BK * 2  , STAGE_BYTES = 8 * HTB, NXCD = 8, WGM = 8;

__host__ __device__ __forceinline__ int lds_byte(int r, int c) { const int st = (r >> 4) * 2 + (c >> 5), rr = r & 15, cc = c & 31, ob = rr * 64 + cc * 2; return st * 1024 + (ob ^ (((ob >> 9) & 1) << 5)); }
__host__ __device__ __forceinline__ void stage_rc(int b, int& R, int& C) { const int st = b / 1024, sb = b % 1024, swz = sb ^ (((sb >> 9) & 1) << 5); R = (st >> 1) * 16 + swz / 64; C = (st & 1) * 32 + (swz % 64) / 2; }
__host__ __device__ __forceinline__ int perm32(int rho) { const int n = rho >> 4, i = rho & 15; return 8 * (i >> 2) + 4 * n + (i & 3); }

struct Unit { int pm, pn; };
struct Gemm { const bf16_t* A; const bf16_t* Bt; int M, N, K; };

struct StaticOrder {
    int nM, nN, nwg, G, c;
    __host__ __device__ void init(int M, int N, int G_, int c_) { nM = M / BM; nN = N / BM; nwg = nM * nN; G = G_; c = c_; }
    __host__ __device__ bool next(int i, Unit& u) const {
        const long L = (long)i * G + c; if (L >= nwg) return false;
        int wgid = (int)L; { const int q = nwg / NXCD, r = nwg % NXCD, xcd = wgid % NXCD, off = wgid / NXCD; wgid = (xcd < r ? xcd * (q + 1) : r * (q + 1) + (xcd - r) * q) + off; }
        const int nig = WGM * nN, gid = wgid / nig, fm = gid * WGM, gsz = (nM - fm) < WGM ? (nM - fm) : WGM;
        u.pm = fm + ((wgid % nig) % gsz); u.pn = (wgid % nig) / gsz; return true;
    }
    __device__ __forceinline__ void a_ready(const Unit&) const {}
    __device__ __forceinline__ void done(const Unit&) const {}
};
struct CountedOrder : StaticOrder {
    const unsigned* ready; unsigned need; unsigned* tmo;
    __device__ __forceinline__ void a_ready(const Unit& u) const {
        if (threadIdx.x < 64) {
            const unsigned long long t0 = __builtin_amdgcn_s_memrealtime(); unsigned polls = 0;
            while ((unsigned)__builtin_amdgcn_readfirstlane(__hip_atomic_load(ready + 64 * u.pm, __ATOMIC_RELAXED, __HIP_MEMORY_SCOPE_AGENT)) < need) {
                if ((++polls & 255u) == 0u && __builtin_amdgcn_readfirstlane(__hip_atomic_load(tmo, __ATOMIC_RELAXED, __HIP_MEMORY_SCOPE_AGENT)) != 0u) break;
                if (__builtin_amdgcn_s_memrealtime() - t0 > 2000000ull) {
                    if (threadIdx.x == 0) { unsigned expect = 0u; __hip_atomic_compare_exchange_strong(tmo + 1, &expect, 0x600u | (unsigned)(u.pm & 0xff), __ATOMIC_RELAXED, __ATOMIC_RELAXED, __HIP_MEMORY_SCOPE_AGENT); __hip_atomic_store(tmo, 1u, __ATOMIC_RELAXED, __HIP_MEMORY_SCOPE_AGENT); }
                    break; }
                __builtin_amdgcn_s_sleep(2); }
            __builtin_amdgcn_fence(__ATOMIC_ACQUIRE, "agent");
            asm volatile("s_waitcnt vmcnt(0)" ::: "memory");
        }
#if !defined(BROKEN_HOOK_NO_BARRIER)
        asm volatile("" ::: "memory"); __builtin_amdgcn_s_barrier(); asm volatile("" ::: "memory");
#endif
    }
};

__device__ __forceinline__ unsigned cvt_pk_bf16(float lo, float hi) { unsigned r; asm volatile("v_cvt_pk_bf16_f32 %0, %1, %2" : "=v"(r) : "v"(lo), "v"(hi)); return r; }
typedef float f32x2 __attribute__((ext_vector_type(2)));
__device__ __forceinline__ f32x2 gelu_pk(f32x2 v) {
    const f32x2 av = __builtin_elementwise_abs(v), d = av * 0.2316418882f + 1.0f;
    f32x2 t; t.x = __builtin_amdgcn_rcpf(d.x); t.y = __builtin_amdgcn_rcpf(d.y);
    f32x2 q = t * 0.5307027145f + (-0.7265760135f); q = q * t + 0.7107068705f; q = q * t + (-0.142248368f); q = q * t + 0.127414796f; q = q * t;
    const f32x2 s = (v * v) * (-0.72134752044f);
    f32x2 e; e.x = __builtin_amdgcn_exp2f(s.x); e.y = __builtin_amdgcn_exp2f(s.y);
    const f32x2 m = v * (q * e), r = v - m;
    f32x2 o; o.x = v.x < 0.f ? m.x : r.x; o.y = v.y < 0.f ? m.y : r.y; return o;
}

struct EpiF32 {
    static constexpr bool PERM = false, AFTER_DRAIN = false;
    float* C; int ldc; const float* bias;
    __device__ __forceinline__ void operator()(const f32x4 (&acc)[2][2][4][2], const Unit& u, int wr, int wc, int fr, int fq) const {
        const int row0 = u.pm * BM + wr * 64 + fr, col0 = u.pn * BM + wc * 32 + 4 * fq;
        f32x4 bv[2][2];
#pragma unroll
        for (int bj = 0; bj < 2; ++bj)
#pragma unroll
            for (int n = 0; n < 2; ++n) bv[bj][n] = bias ? *(const f32x4*)(bias + col0 + bj * HALF + n * 16) : (f32x4){0.f, 0.f, 0.f, 0.f};
#pragma unroll
        for (int ai = 0; ai < 2; ++ai)
#pragma unroll
            for (int m = 0; m < 4; ++m) { float* rowp = C + (size_t)(row0 + ai * HALF + m * 16) * ldc + col0;
#pragma unroll
                for (int bj = 0; bj < 2; ++bj)
#pragma unroll
                    for (int n = 0; n < 2; ++n) *(f32x4*)(rowp + bj * HALF + n * 16) = acc[ai][bj][m][n] + bv[bj][n]; }
    }
};
template <int ACT  > struct EpiBf16 {
    static constexpr bool PERM = true, AFTER_DRAIN = false;
    bf16_t* O; int ldc; const float* bias; int split_cols; size_t split_stride;
    __device__ __forceinline__ void operator()(const f32x4 (&acc)[2][2][4][2], const Unit& u, int wr, int wc, int fr, int fq) const {
        const int row0 = u.pm * BM + wr * 64 + fr; int colt = u.pn * BM; bf16_t* base = O;
        if (split_cols) { const int t = colt / split_cols; base += (size_t)t * split_stride; colt -= t * split_cols; }
        const int col0 = colt + wc * 32 + 8 * fq, bcol0 = u.pn * BM + wc * 32 + 8 * fq;
        f32x4 bv[2][2];
#pragma unroll
        for (int bj = 0; bj < 2; ++bj)
#pragma unroll
            for (int n = 0; n < 2; ++n) bv[bj][n] = bias ? *(const f32x4*)(bias + bcol0 + bj * HALF + 4 * n) : (f32x4){0.f, 0.f, 0.f, 0.f};
#pragma unroll
        for (int ai = 0; ai < 2; ++ai)
#pragma unroll
            for (int m = 0; m < 4; ++m) { bf16_t* rowp = base + (size_t)(row0 + ai * HALF + m * 16) * ldc + col0;
#pragma unroll
                for (int bj = 0; bj < 2; ++bj) { f32x4 v0 = acc[ai][bj][m][0] + bv[bj][0], v1 = acc[ai][bj][m][1] + bv[bj][1];
                    if (ACT == 1) { f32x2 a = gelu_pk((f32x2){v0[0], v0[1]}), b = gelu_pk((f32x2){v0[2], v0[3]}), c = gelu_pk((f32x2){v1[0], v1[1]}), d = gelu_pk((f32x2){v1[2], v1[3]});
                        v0 = (f32x4){a.x, a.y, b.x, b.y}; v1 = (f32x4){c.x, c.y, d.x, d.y}; }
                    if (ACT == 2) {
#pragma unroll
                        for (int j = 0; j < 4; ++j) { v0[j] = 0.5f * v0[j] * (1.0f + erff(v0[j] * 0.70710678f)); v1[j] = 0.5f * v1[j] * (1.0f + erff(v1[j] * 0.70710678f)); } }
                    u32x4 w; w.x = cvt_pk_bf16(v0[0], v0[1]); w.y = cvt_pk_bf16(v0[2], v0[3]); w.z = cvt_pk_bf16(v1[0], v1[1]); w.w = cvt_pk_bf16(v1[2], v1[3]);
                    *(u32x4*)(rowp + bj * HALF) = w; } }
    }
};

struct PanelStats {
    unsigned* xbuf;
    unsigned* cnt;
    unsigned* tmo;
    int ntn; float eps;
    unsigned code;
    __device__ __forceinline__ bool run(const f32x4 (&v)[2][2][4][2], const Unit& u, int wr, int wc, int fr, int fq, PG8_LAS unsigned char* lds, int wid, int lane) const {
        typedef float f32x2v __attribute__((ext_vector_type(2)));
        PG8_LAS f32x2v* P = (PG8_LAS f32x2v*)lds;
        PG8_LAS f32x2v* S = (PG8_LAS f32x2v*)(lds + 8192);
        PG8_LAS unsigned* flag = (PG8_LAS unsigned*)(lds + 8192 + 2048);
#pragma unroll
        for (int ai = 0; ai < 2; ++ai)
#pragma unroll
            for (int m = 0; m < 4; ++m) {
                float s = 0.f;
#pragma unroll
                for (int bj = 0; bj < 2; ++bj)
#pragma unroll
                    for (int n = 0; n < 2; ++n) { const f32x4 x = v[ai][bj][m][n]; s += (x[0] + x[1]) + (x[2] + x[3]); }
                s += __shfl_xor(s, 16); s += __shfl_xor(s, 32);
                const float mw = s * (1.0f / 64.0f); float q = 0.f;
#pragma unroll
                for (int bj = 0; bj < 2; ++bj)
#pragma unroll
                    for (int n = 0; n < 2; ++n) { const f32x4 d = v[ai][bj][m][n] - mw; q += (d[0] * d[0] + d[1] * d[1]) + (d[2] * d[2] + d[3] * d[3]); }
                q += __shfl_xor(q, 16); q += __shfl_xor(q, 32);
                if (fq == 0) P[(ai * HALF + wr * 64 + m * 16 + fr) * 4 + wc] = (f32x2v){mw, q};
            }
        asm volatile("s_waitcnt lgkmcnt(0)" ::: "memory"); __builtin_amdgcn_s_barrier(); asm volatile("" ::: "memory");
#if defined(BROKEN_NO_WAIT)
        if (blockIdx.x >= 64) { const long long t0 = clock64(); while (clock64() - t0 < 60000) __builtin_amdgcn_s_sleep(8); }
#endif
        const int row = wid * 32 + (lane & 31);
        if (lane < 32) {
            const f32x2v a = P[row * 4 + 0], b = P[row * 4 + 1], c = P[row * 4 + 2], d = P[row * 4 + 3];
            const float mt = (a.x + b.x + c.x + d.x) * 0.25f;
            const float da = a.x - mt, db = b.x - mt, dc = c.x - mt, dd = d.x - mt;
            const float m2 = (a.y + b.y) + (c.y + d.y) + 64.0f * ((da * da + db * db) + (dc * dc + dd * dd));
            unsigned long long* slot = (unsigned long long*)xbuf + ((size_t)(u.pm * BM + row) * 4 + u.pn);
            __hip_atomic_store(slot, ((unsigned long long)__float_as_uint(m2) << 32) | __float_as_uint(mt), __ATOMIC_RELAXED, __HIP_MEMORY_SCOPE_AGENT);
        }
        asm volatile("s_waitcnt vmcnt(0)" ::: "memory");
        if (lane == 0) __hip_atomic_fetch_add(cnt + 64 * u.pm, 1u, __ATOMIC_RELAXED, __HIP_MEMORY_SCOPE_AGENT);
        if (wid == 0) {
            bool dead = false; const unsigned long long t0 = __builtin_amdgcn_s_memrealtime(); const unsigned want = 8u * (unsigned)ntn;
            for (;;) {
#if defined(BROKEN_NO_WAIT)
                break;
#endif
                if ((unsigned)__builtin_amdgcn_readfirstlane(__hip_atomic_load(cnt + 64 * u.pm, __ATOMIC_RELAXED, __HIP_MEMORY_SCOPE_AGENT)) >= want) break;
                if (__builtin_amdgcn_s_memrealtime() - t0 > 2000000ull) {
                    if (lane == 0) { unsigned expect = 0u; __hip_atomic_compare_exchange_strong(tmo + 1, &expect, code | (unsigned)(u.pm & 0xff), __ATOMIC_RELAXED, __ATOMIC_RELAXED, __HIP_MEMORY_SCOPE_AGENT);
                                     __hip_atomic_store(tmo, 1u, __ATOMIC_RELAXED, __HIP_MEMORY_SCOPE_AGENT); }
                    dead = true; break; }
                __builtin_amdgcn_s_sleep(2);
            }
            __builtin_amdgcn_fence(__ATOMIC_ACQUIRE, "agent");
            if (lane == 0) flag[0] = dead ? 1u : 0u;
        }
        asm volatile("s_waitcnt vmcnt(0) lgkmcnt(0)" ::: "memory"); __builtin_amdgcn_s_barrier(); asm volatile("" ::: "memory");
        const bool bad = flag[0] != 0u;
        if (lane < 32) {
            const unsigned long long* slot = (const unsigned long long*)xbuf + (size_t)(u.pm * BM + row) * 4; float mt[4], m2[4]; float ms = 0.f;
#pragma unroll
            for (int t = 0; t < 4; ++t) { if (t < ntn) { const unsigned long long w = __hip_atomic_load(slot + t, __ATOMIC_RELAXED, __HIP_MEMORY_SCOPE_AGENT); mt[t] = __uint_as_float((unsigned)w); m2[t] = __uint_as_float((unsigned)(w >> 32)); } else { mt[t] = 0.f; m2[t] = 0.f; } ms += mt[t]; }
            const float mean = ms / (float)ntn; float q = 0.f;
#pragma unroll
            for (int t = 0; t < 4; ++t) if (t < ntn) { const float dm = mt[t] - mean; q += m2[t] + 256.0f * dm * dm; }
            S[row] = (f32x2v){mean, 1.0f / sqrtf(q / (256.0f * (float)ntn) + eps)};
        }
        asm volatile("s_waitcnt lgkmcnt(0)" ::: "memory"); __builtin_amdgcn_s_barrier(); asm volatile("" ::: "memory");
        return bad;
    }
};
struct EpiLnRes {
    static constexpr bool PERM = false, AFTER_DRAIN = true;
    const float* base; float* out; int ldc; const float* bias; PanelStats st; unsigned poison;
    __device__ __forceinline__ void refuse(size_t i0, size_t stride, int M, int N) const { const float q = __builtin_nanf(""); for (size_t i = i0; i < (size_t)M * N; i += stride) out[(i / N) * ldc + i % N] = q;
        if (i0 == 0) { unsigned expect = 0u; __hip_atomic_compare_exchange_strong(st.tmo + 1, &expect, 0x7f0u, __ATOMIC_RELAXED, __ATOMIC_RELAXED, __HIP_MEMORY_SCOPE_AGENT); __hip_atomic_store(st.tmo, 1u, __ATOMIC_RELAXED, __HIP_MEMORY_SCOPE_AGENT); } }
    __device__ __forceinline__ void fused(f32x4 (&acc)[2][2][4][2], const Unit& u, int wr, int wc, int fr, int fq, PG8_LAS unsigned char* lds, int wid, int lane) const {
        typedef float f32x2v __attribute__((ext_vector_type(2)));
        const PG8_LAS f32x2v* S = (const PG8_LAS f32x2v*)(lds + 8192);
        const int col0 = u.pn * BM + wc * 32 + 4 * fq;
#pragma unroll
        for (int bj = 0; bj < 2; ++bj)
#pragma unroll
            for (int n = 0; n < 2; ++n) { const f32x4 bv = bias ? *(const f32x4*)(bias + col0 + bj * HALF + n * 16) : (f32x4){0.f, 0.f, 0.f, 0.f};
#pragma unroll
                for (int ai = 0; ai < 2; ++ai)
#pragma unroll
                    for (int m = 0; m < 4; ++m) acc[ai][bj][m][n] += bv; }
        const bool bad = st.run(acc, u, wr, wc, fr, fq, lds, wid, lane) || poison != 0u;
        const float qnan = __builtin_nanf("");
#pragma unroll
        for (int ai = 0; ai < 2; ++ai)
#pragma unroll
            for (int m = 0; m < 4; ++m) { const int r = ai * HALF + wr * 64 + m * 16 + fr; const f32x2v sr = S[r]; const size_t off = (size_t)(u.pm * BM + r) * ldc + col0;
#pragma unroll
                for (int bj = 0; bj < 2; ++bj)
#pragma unroll
                    for (int n = 0; n < 2; ++n) { const f32x4 bs = *(const f32x4*)(base + off + bj * HALF + n * 16); f32x4 o = bs + (acc[ai][bj][m][n] - sr.x) * sr.y;
                        if (bad) o = (f32x4){qnan, qnan, qnan, qnan}; *(f32x4*)(out + off + bj * HALF + n * 16) = o; }
                asm volatile("" ::: "memory"); }
    }
};
struct EpiLnResLn {
    static constexpr bool PERM = false, AFTER_DRAIN = true;
    const float* base; float* out; bf16_t* xn; int ldc; const float* bias; PanelStats st1, st2; unsigned poison;
    __device__ __forceinline__ void refuse(size_t i0, size_t stride, int M, int N) const { const float q = __builtin_nanf(""); for (size_t i = i0; i < (size_t)M * N; i += stride) { const size_t o = (i / N) * ldc + i % N; out[o] = q; xn[o] = (bf16_t)0x7fc0u; }
        if (i0 == 0) { unsigned expect = 0u; __hip_atomic_compare_exchange_strong(st1.tmo + 1, &expect, 0x7f0u, __ATOMIC_RELAXED, __ATOMIC_RELAXED, __HIP_MEMORY_SCOPE_AGENT); __hip_atomic_store(st1.tmo, 1u, __ATOMIC_RELAXED, __HIP_MEMORY_SCOPE_AGENT); } }
    __device__ __forceinline__ void fused(f32x4 (&acc)[2][2][4][2], const Unit& u, int wr, int wc, int fr, int fq, PG8_LAS unsigned char* lds, int wid, int lane) const {
        typedef float f32x2v __attribute__((ext_vector_type(2))); typedef unsigned u32x2v __attribute__((ext_vector_type(2)));
        const PG8_LAS f32x2v* S = (const PG8_LAS f32x2v*)(lds + 8192);
        const int col0 = u.pn * BM + wc * 32 + 4 * fq;
#pragma unroll
        for (int bj = 0; bj < 2; ++bj)
#pragma unroll
            for (int n = 0; n < 2; ++n) { const f32x4 bv = bias ? *(const f32x4*)(bias + col0 + bj * HALF + n * 16) : (f32x4){0.f, 0.f, 0.f, 0.f};
#pragma unroll
                for (int ai = 0; ai < 2; ++ai)
#pragma unroll
                    for (int m = 0; m < 4; ++m) acc[ai][bj][m][n] += bv; }
        bool bad = st1.run(acc, u, wr, wc, fr, fq, lds, wid, lane) || poison != 0u;
        const float qnan = __builtin_nanf("");
#pragma unroll
        for (int ai = 0; ai < 2; ++ai)
#pragma unroll
            for (int m = 0; m < 4; ++m) { const int r = ai * HALF + wr * 64 + m * 16 + fr; const f32x2v sr = S[r]; const size_t off = (size_t)(u.pm * BM + r) * ldc + col0;
#pragma unroll
                for (int bj = 0; bj < 2; ++bj)
#pragma unroll
                    for (int n = 0; n < 2; ++n) { const f32x4 bs = *(const f32x4*)(base + off + bj * HALF + n * 16); acc[ai][bj][m][n] = bs + (acc[ai][bj][m][n] - sr.x) * sr.y; }
                asm volatile("" : "+v"(acc[ai][0][m][0]), "+v"(acc[ai][0][m][1]), "+v"(acc[ai][1][m][0]), "+v"(acc[ai][1][m][1]));
                if (m & 1) asm volatile("" ::: "memory"); }
        const bool bad1 = bad;
        bad = st2.run(acc, u, wr, wc, fr, fq, lds, wid, lane) || bad;
#pragma unroll
        for (int ai = 0; ai < 2; ++ai)
#pragma unroll
            for (int m = 0; m < 4; ++m) { const int r = ai * HALF + wr * 64 + m * 16 + fr; const f32x2v sr = S[r]; const size_t off = (size_t)(u.pm * BM + r) * ldc + col0;
#pragma unroll
                for (int bj = 0; bj < 2; ++bj)
#pragma unroll
                    for (int n = 0; n < 2; ++n) { const f32x4 x1 = acc[ai][bj][m][n]; *(f32x4*)(out + off + bj * HALF + n * 16) = bad1 ? (f32x4){qnan, qnan, qnan, qnan} : x1;
                        const f32x4 o = (x1 - sr.x) * sr.y; u32x2v w; w.x = cvt_pk_bf16(o[0], o[1]); w.y = cvt_pk_bf16(o[2], o[3]);
                        if (bad) { w.x = 0x7fc07fc0u; w.y = 0x7fc07fc0u; } *(u32x2v*)(xn + off + bj * HALF + n * 16) = w; }
                asm volatile("" ::: "memory"); }
    }
};

template <class Epi, class Sched, bool STAMP = false>
__device__ __forceinline__ void gemm_phase(PG8_LAS unsigned char* lds, const Gemm g, const Sched& S, const Epi& E, unsigned long long* stamps) {
    int tid_ = threadIdx.x; asm volatile("" : "+v"(tid_));
    const int tid = tid_, wid = __builtin_amdgcn_readfirstlane(tid >> 6), lane = tid & 63, wr = wid >> 2, wc = wid & 3, fr = lane & 15, fq = lane >> 4;
    const int K = g.K, nt = K / BK;
    int ts_lo = 0, ts_hi = 0, nts = 0; const unsigned long long rt_entry = STAMP ? (unsigned long long)wall_clock64() : 0ull;
#define PG8_STAMP() do { if (STAMP && wid == 0 && nts < 64) { const unsigned long long _c = (unsigned long long)clock64(); \
        ts_lo = (lane == nts) ? (int)(unsigned)_c : ts_lo; ts_hi = (lane == nts) ? (int)(unsigned)(_c >> 32) : ts_hi; ++nts; } } while (0)
    PG8_STAMP();
    unsigned voffA[2], voffB[2];
#pragma unroll
    for (int i = 0; i < 2; ++i) { int R, C; stage_rc(tid * 16 + i * 8192, R, C); const int Rb = Epi::PERM ? ((R & ~31) + perm32(R & 31)) : R;
        voffA[i] = (unsigned)(R * K + C) * 2u; voffB[i] = (unsigned)(Rb * K + C) * 2u; }
    const size_t kstep = (size_t)(BK * 2);
    const size_t hstep = (size_t)HALF * K * 2;
    const size_t tstep = 2 * hstep;
    const unsigned ldsw = (unsigned)wid * 1024u;
    const int aoff = lds_byte(wr * 64 + fr, fq * 8), boff = lds_byte(wc * 32 + fr, fq * 8);
#define PG8_SA(b, h) (((b) * 2 + (h)) * HTB)
#define PG8_SB(b, h) ((4 + (b) * 2 + (h)) * HTB)
#define PG8_STAGE(bufoff, gbase, voff) do { _Pragma("unroll") for (int _i = 0; _i < 2; ++_i) \
        __builtin_amdgcn_global_load_lds((const unsigned*)((const char*)(gbase) + (voff)[_i]), (PG8_LAS unsigned*)(lds + (bufoff) + ldsw + _i * 8192), 16, 0, 0); } while (0)
#define PG8_LDA(dst, b, h) do { _Pragma("unroll") for (int m = 0; m < 4; ++m) _Pragma("unroll") for (int k = 0; k < 2; ++k) dst[m][k] = *(const PG8_LAS bf16x8*)(lds + PG8_SA(b, h) + aoff + m * 2048 + k * 1024); } while (0)
#define PG8_LDB(dst, b, h) do { _Pragma("unroll") for (int n = 0; n < 2; ++n) _Pragma("unroll") for (int k = 0; k < 2; ++k) dst[n][k] = *(const PG8_LAS bf16x8*)(lds + PG8_SB(b, h) + boff + n * 2048 + k * 1024); } while (0)
#define PG8_MMA(ai, bj, At, Bt) do { __builtin_amdgcn_s_setprio(1); _Pragma("unroll") for (int m = 0; m < 4; ++m) _Pragma("unroll") for (int n = 0; n < 2; ++n) _Pragma("unroll") for (int k = 0; k < 2; ++k) \
        acc[ai][bj][m][n] = __builtin_amdgcn_mfma_f32_16x16x32_bf16(Bt[n][k], At[m][k], acc[ai][bj][m][n], 0, 0, 0); __builtin_amdgcn_s_setprio(0); } while (0)
#define PG8_WAIT_V(n) asm volatile("s_waitcnt vmcnt(" #n ")" ::: "memory")
#define PG8_WAIT_L(n) asm volatile("s_waitcnt lgkmcnt(" #n ")" ::: "memory")
#define PG8_BAR __builtin_amdgcn_s_barrier()
#define PG8_SCHED __builtin_amdgcn_sched_barrier(0)
    Unit cur, nxt; int ui = 0;
    if (!S.next(0, cur)) return;
    f32x4 acc[2][2][4][2];
#pragma unroll
    for (int a = 0; a < 2; ++a)
#pragma unroll
        for (int b = 0; b < 2; ++b)
#pragma unroll
            for (int m = 0; m < 4; ++m)
#pragma unroll
                for (int n = 0; n < 2; ++n) acc[a][b][m][n] = (f32x4){0.f, 0.f, 0.f, 0.f};
    bf16x8 At[4][2], B0[2][2], B1[2][2];
    const char* cA = (const char*)g.A + (size_t)cur.pm * tstep; const char* cB = (const char*)g.Bt + (size_t)cur.pn * tstep;
    S.a_ready(cur);
    PG8_STAGE(PG8_SB(0, 0), cB, voffB); PG8_STAGE(PG8_SA(0, 0), cA, voffA); PG8_STAGE(PG8_SB(0, 1), cB + hstep, voffB); PG8_STAGE(PG8_SA(0, 1), cA + hstep, voffA);
    if (wr == 1) PG8_BAR;
    PG8_WAIT_V(4); PG8_BAR;
    PG8_STAGE(PG8_SB(1, 0), cB + kstep, voffB); PG8_STAGE(PG8_SA(1, 0), cA + kstep, voffA); PG8_STAGE(PG8_SB(1, 1), cB + hstep + kstep, voffB);
    PG8_WAIT_V(6); PG8_BAR;
    PG8_STAMP();
    for (;;) {
        const bool has_next = S.next(ui + 1, nxt);
        const char* nA = has_next ? (const char*)g.A + (size_t)nxt.pm * tstep : cA; const char* nB = has_next ? (const char*)g.Bt + (size_t)nxt.pn * tstep : cB;
        for (int t = 0; t < nt; t += 2) {
            const bool last = (t == nt - 2);
            const char* a1 = cA + (size_t)(t + 1) * kstep;
            const char* a2 = last ? nA : cA + (size_t)(t + 2) * kstep; const char* b2 = last ? nB : cB + (size_t)(t + 2) * kstep;
            const char* a3 = a2 + kstep; const char* b3 = b2 + kstep;
            if (last && has_next) S.a_ready(nxt);
            PG8_LDB(B0, 0, 0); PG8_SCHED; PG8_LDA(At, 0, 0); PG8_STAGE(PG8_SA(1, 1), a1 + hstep, voffA);
            PG8_WAIT_L(8); PG8_BAR; PG8_WAIT_L(0); PG8_MMA(0, 0, At, B0); PG8_BAR; PG8_SCHED;
            PG8_LDB(B1, 0, 1); PG8_STAGE(PG8_SB(0, 0), b2, voffB);
            PG8_BAR; PG8_WAIT_L(0); PG8_MMA(0, 1, At, B1); PG8_BAR;
            PG8_LDA(At, 0, 1); PG8_STAGE(PG8_SA(0, 0), a2, voffA);
            PG8_BAR; PG8_WAIT_L(0); PG8_MMA(1, 0, At, B0); PG8_BAR; PG8_SCHED;
            PG8_STAGE(PG8_SB(0, 1), b2 + hstep, voffB);
            PG8_WAIT_V(6); PG8_BAR; PG8_MMA(1, 1, At, B1); PG8_BAR;
            PG8_LDB(B0, 1, 0); PG8_SCHED; PG8_LDA(At, 1, 0); PG8_STAGE(PG8_SA(0, 1), a2 + hstep, voffA);
            PG8_WAIT_L(8); PG8_BAR; PG8_WAIT_L(0); PG8_MMA(0, 0, At, B0); PG8_BAR; PG8_SCHED;
            PG8_LDB(B1, 1, 1); PG8_STAGE(PG8_SB(1, 0), b3, voffB);
            PG8_BAR; PG8_WAIT_L(0); PG8_MMA(0, 1, At, B1); PG8_BAR;
            PG8_LDA(At, 1, 1); PG8_STAGE(PG8_SA(1, 0), a3, voffA);
            PG8_BAR; PG8_WAIT_L(0); PG8_MMA(1, 0, At, B0); PG8_BAR; PG8_SCHED;
            PG8_STAGE(PG8_SB(1, 1), b3 + hstep, voffB);
            PG8_WAIT_V(6); PG8_BAR; PG8_MMA(1, 1, At, B1); PG8_BAR;
        }
        PG8_STAMP();
        if constexpr (!Epi::AFTER_DRAIN) { E(acc, cur, wr, wc, fr, fq); S.done(cur); }
        PG8_STAMP();
        if (!has_next) break;
#pragma unroll
        for (int a = 0; a < 2; ++a)
#pragma unroll
            for (int b = 0; b < 2; ++b)
#pragma unroll
                for (int m = 0; m < 4; ++m)
#pragma unroll
                    for (int n = 0; n < 2; ++n) acc[a][b][m][n] = (f32x4){0.f, 0.f, 0.f, 0.f};
        cur = nxt; cA = nA; cB = nB; ++ui;
    }
    PG8_WAIT_V(0);
    if (wr == 0) PG8_BAR;
    PG8_BAR;
    if constexpr (Epi::AFTER_DRAIN) { E.fused(acc, cur, wr, wc, fr, fq, lds, wid, lane); S.done(cur); }
    PG8_STAMP();
    if (STAMP && wid == 0) { stamps[lane] = lane < nts ? (((unsigned long long)(unsigned)ts_hi << 32) | (unsigned)ts_lo) : 0ull;
        if (lane == 62) stamps[62] = rt_entry; if (lane == 63) stamps[63] = (unsigned long long)wall_clock64(); }
#undef PG8_STAMP
#undef PG8_SA
#undef PG8_SB
#undef PG8_STAGE
#undef PG8_LDA
#undef PG8_LDB
#undef PG8_MMA
#undef PG8_WAIT_V
#undef PG8_WAIT_L
#undef PG8_BAR
#undef PG8_SCHED
}
}

namespace pg8 {
__device__ __forceinline__ float fast_sigmoid(float x) { return __builtin_amdgcn_rcpf(1.0f + __builtin_amdgcn_exp2f(-1.44269504089f * x)); }
struct EpiSwiGLU {
    static constexpr bool PERM = true, AFTER_DRAIN = false;
    bf16_t* H; int ldh; int cheap;
    __device__ __forceinline__ void operator()(const f32x4 (&acc)[2][2][4][2], const Unit& u, int wr, int wc, int fr, int fq) const {
        const int row0 = u.pm * BM + wr * 64 + fr, hc0 = u.pn * 128 + wc * 32 + 8 * fq;
#pragma unroll
        for (int ai = 0; ai < 2; ++ai)
#pragma unroll
            for (int m = 0; m < 4; ++m) {
                bf16_t* rowp = H + (size_t)(row0 + ai * HALF + m * 16) * ldh + hc0;
                float v[8];
#pragma unroll
                for (int n = 0; n < 2; ++n)
#pragma unroll
                    for (int j = 0; j < 4; ++j) { const float g = acc[ai][0][m][n][j], up = acc[ai][1][m][n][j]; v[n * 4 + j] = cheap ? g * up : g * fast_sigmoid(g) * up; }
                u32x4 w; w.x = cvt_pk_bf16(v[0], v[1]); w.y = cvt_pk_bf16(v[2], v[3]); w.z = cvt_pk_bf16(v[4], v[5]); w.w = cvt_pk_bf16(v[6], v[7]);
                *(u32x4*)rowp = w;
            }
    }
};
struct EpiResid {
    static constexpr bool PERM = false, AFTER_DRAIN = false;
    float* X; int ldc; float alpha; const float* Xsrc;
    __device__ __forceinline__ void operator()(const f32x4 (&acc)[2][2][4][2], const Unit& u, int wr, int wc, int fr, int fq) const {
        const int row0 = u.pm * BM + wr * 64 + fr, col0 = u.pn * BM + wc * 32 + 4 * fq;
#pragma unroll
        for (int ai = 0; ai < 2; ++ai)
#pragma unroll
            for (int m = 0; m < 4; ++m) { const size_t ro = (size_t)(row0 + ai * HALF + m * 16) * ldc + col0;
#pragma unroll
                for (int bj = 0; bj < 2; ++bj)
#pragma unroll
                    for (int n = 0; n < 2; ++n) { const f32x4 old = *(const f32x4*)(Xsrc + ro + bj * HALF + n * 16); *(f32x4*)(X + ro + bj * HALF + n * 16) = old + acc[ai][bj][m][n] * alpha; } }
    }
};
struct EpiWin {
    static constexpr bool PERM = true, AFTER_DRAIN = false;
    unsigned char* zbase; const float* bias; float* small_out;
    __device__ __forceinline__ void operator()(const f32x4 (&acc)[2][2][4][2], const Unit& u, int wr, int wc, int fr, int fq) const {
        const int row0 = u.pm * BM + wr * 64 + fr; const int pn = u.pn;
        const int bcol0 = pn * BM + wc * 32 + 8 * fq;
        f32x4 bv[2][2];
#pragma unroll
        for (int bj = 0; bj < 2; ++bj)
#pragma unroll
            for (int n = 0; n < 2; ++n) bv[bj][n] = *(const f32x4*)(bias + bcol0 + bj * HALF + 4 * n);
        if (pn == 17) {
            if (wc < 2) {
#pragma unroll
                for (int ai = 0; ai < 2; ++ai)
#pragma unroll
                    for (int m = 0; m < 4; ++m) { float* rowp = small_out + (size_t)(row0 + ai * HALF + m * 16) * 64 + wc * 32 + 8 * fq;
#pragma unroll
                        for (int n = 0; n < 2; ++n) *(f32x4*)(rowp + 4 * n) = acc[ai][0][m][n] + bv[0][n]; }
            }
            return;
        }
        size_t base; int ld, c0;
        if (pn < 8) { base = (size_t)(pn >> 1) * ((size_t)T * 512 * 2); ld = 512; c0 = (pn & 1) * 256; }
        else if (pn < 11) { base = (size_t)4 * T * 512 * 2 + (size_t)(pn - 8) * ((size_t)T * 256 * 2); ld = 256; c0 = 0; }
        else { base = (size_t)4 * T * 512 * 2 + (size_t)3 * T * 256 * 2 + (size_t)((pn - 11) >> 1) * ((size_t)T * 512 * 2); ld = 512; c0 = ((pn - 11) & 1) * 256; }
        bf16_t* O = (bf16_t*)(zbase + base);
        const int col0 = c0 + wc * 32 + 8 * fq;
#pragma unroll
        for (int ai = 0; ai < 2; ++ai)
#pragma unroll
            for (int m = 0; m < 4; ++m) { bf16_t* rowp = O + (size_t)(row0 + ai * HALF + m * 16) * ld + col0;
#pragma unroll
                for (int bj = 0; bj < 2; ++bj) { const f32x4 v0 = acc[ai][bj][m][0] + bv[bj][0], v1 = acc[ai][bj][m][1] + bv[bj][1];
                    u32x4 w; w.x = cvt_pk_bf16(v0[0], v0[1]); w.y = cvt_pk_bf16(v0[2], v0[3]); w.z = cvt_pk_bf16(v1[0], v1[1]); w.w = cvt_pk_bf16(v1[2], v1[3]);
                    *(u32x4*)(rowp + bj * HALF) = w; } }
    }
};
struct EpiGate {
    static constexpr bool PERM = true, AFTER_DRAIN = false;
    unsigned char* ws; int ldc; const float* bias;
    __device__ __forceinline__ void operator()(const f32x4 (&acc)[2][2][4][2], const Unit& u, int wr, int wc, int fr, int fq) const {
        const int br = u.pn >> 2;
        bf16_t* G = (bf16_t*)(ws + WS_G0 + (size_t)(br >= 1) * (WS_G1 - WS_G0) + (size_t)(br >= 2) * (WS_G2 - WS_G1));
        const int row0 = u.pm * BM + wr * 64 + fr, col0 = (u.pn & 3) * BM + wc * 32 + 8 * fq, bcol0 = u.pn * BM + wc * 32 + 8 * fq;
        f32x4 bv[2][2];
#pragma unroll
        for (int bj = 0; bj < 2; ++bj)
#pragma unroll
            for (int n = 0; n < 2; ++n) bv[bj][n] = *(const f32x4*)(bias + bcol0 + bj * HALF + 4 * n);
#pragma unroll
        for (int ai = 0; ai < 2; ++ai)
#pragma unroll
            for (int m = 0; m < 4; ++m) { bf16_t* rowp = G + (size_t)(row0 + ai * HALF + m * 16) * ldc + col0;
#pragma unroll
                for (int bj = 0; bj < 2; ++bj) { f32x4 v0 = acc[ai][bj][m][0] + bv[bj][0], v1 = acc[ai][bj][m][1] + bv[bj][1];
                    u32x4 w; w.x = cvt_pk_bf16(v0[0], v0[1]); w.y = cvt_pk_bf16(v0[2], v0[3]); w.z = cvt_pk_bf16(v1[0], v1[1]); w.w = cvt_pk_bf16(v1[2], v1[3]);
                    *(u32x4*)(rowp + bj * HALF) = w; } }
    }
};
struct EpiBranch {
    static constexpr bool PERM = true, AFTER_DRAIN = false;
    bf16_t* Y; const bf16_t* G; int ldc; int first;
    __device__ __forceinline__ void operator()(const f32x4 (&acc)[2][2][4][2], const Unit& u, int wr, int wc, int fr, int fq) const {
        const int row0 = u.pm * BM + wr * 64 + fr, col0 = u.pn * BM + wc * 32 + 8 * fq;
#pragma unroll
        for (int ai = 0; ai < 2; ++ai)
#pragma unroll
            for (int m = 0; m < 4; ++m) { const size_t off = (size_t)(row0 + ai * HALF + m * 16) * ldc + col0;
#pragma unroll
                for (int bj = 0; bj < 2; ++bj) {
                    const u32x4 g = *(const u32x4*)(G + off + bj * HALF);
                    u32x4 y = (u32x4){0u, 0u, 0u, 0u}; if (!first) y = *(const u32x4*)(Y + off + bj * HALF);
                    const f32x4 a0 = acc[ai][bj][m][0], a1 = acc[ai][bj][m][1];
                    float o[8];
#pragma unroll
                    for (int q = 0; q < 4; ++q) { const unsigned gw = g[q], yw = y[q]; const float al = q < 2 ? a0[2 * q] : a1[2 * q - 4], ah = q < 2 ? a0[2 * q + 1] : a1[2 * q - 3];
                        o[2 * q] = __builtin_bit_cast(float, yw << 16) + fast_sigmoid(__builtin_bit_cast(float, gw << 16)) * al;
                        o[2 * q + 1] = __builtin_bit_cast(float, yw & 0xffff0000u) + fast_sigmoid(__builtin_bit_cast(float, gw & 0xffff0000u)) * ah; }
                    u32x4 w; w.x = cvt_pk_bf16(o[0], o[1]); w.y = cvt_pk_bf16(o[2], o[3]); w.z = cvt_pk_bf16(o[4], o[5]); w.w = cvt_pk_bf16(o[6], o[7]);
                    if (first == 2) asm volatile("" :: "v"(w)); else *(u32x4*)(Y + off + bj * HALF) = w; } }
    }
};
}

constexpr int RING_BYTES = 131072;
constexpr int MISC_OFF = RING_BYTES + 320;
constexpr int LDS_BYTES = 147456;

__constant__ float ROPE_FREQ[32] = {
1.000000000e+00f, 7.498942614e-01f, 5.623413324e-01f, 4.216965139e-01f, 3.162277639e-01f, 2.371373773e-01f, 1.778279394e-01f, 1.333521307e-01f, 1.000000015e-01f, 7.498941571e-02f, 5.623413250e-02f, 4.216965288e-02f, 3.162277490e-02f, 2.371373773e-02f, 1.778279431e-02f, 1.333521493e-02f, 9.999999776e-03f, 7.498941850e-03f, 5.623413250e-03f, 4.216964822e-03f, 3.162277630e-03f, 2.371373586e-03f, 1.778279431e-03f, 1.333521446e-03f, 1.000000047e-03f, 7.498942432e-04f, 5.623413017e-04f, 4.216965172e-04f, 3.162277571e-04f, 2.371373703e-04f, 1.778279402e-04f, 1.333521504e-04f};

struct Args { const float* in[23]; float* out; unsigned char* ws; int ph_lo, ph_hi; };

struct Ctx {
    LAS unsigned char* lds;
    int tid, lane, wave, G, bid;
    __device__ __forceinline__ void launder() { asm volatile("" : "+v"(tid)); lane = tid & 63; asm volatile("" : "+s"(inp));
        GAS unsigned char* g = (GAS unsigned char*)ws; asm volatile("" : "+s"(g)); ws = (unsigned char*)g;
        GAS float* gx = (GAS float*)X; asm volatile("" : "+s"(gx)); X = (float*)gx; }
    const GAS float* const __attribute__((address_space(4)))* inp; float* X; unsigned char* ws;
    __device__ __forceinline__ const float* in(int k) const { return (const float*)inp[k]; }
};

__device__ __forceinline__ void transpose_item(const float* W, int ldw, int src_col0, bf16* WT, int K, int dst_row0, int kb, LAS float* scr, int lane) {
    const int k0 = 64 * kb;
#pragma unroll 8
    for (int i = 0; i < 32; ++i) { const int kk = 2 * i + (lane >> 5); scr[kk * 33 + (lane & 31)] = W[(size_t)(k0 + kk) * ldw + src_col0 + (lane & 31)]; }
    LDS_WAIT(); asm volatile("" ::: "memory");
    const int c = lane & 7;
#pragma unroll
    for (int j = 0; j < 4; ++j) { const int n = (lane >> 3) + 8 * j; const LAS float* s = scr + (8 * c) * 33 + n;
        v4u o; o.x = pk2(s[0 * 33], s[1 * 33]); o.y = pk2(s[2 * 33], s[3 * 33]); o.z = pk2(s[4 * 33], s[5 * 33]); o.w = pk2(s[6 * 33], s[7 * 33]);
        *(v4u*)(WT + (size_t)(dst_row0 + n) * K + k0 + 8 * c) = o; }
    LDS_WAIT(); asm volatile("" ::: "memory");
}
__device__ __forceinline__ int win_small_src(int i) { return i < 16 ? 1536 + i : i < 40 ? 2832 + (i - 16) : i < 44 ? 4392 + (i - 40) : i < 48 ? 4396 + (i - 44) : -1; }
__device__ __forceinline__ int win_src_col(int n) { return n < 1536 ? n : n < 2816 ? n + 16 : n < 4352 ? n + 40 : win_small_src(n - 4352); }

__device__ __forceinline__ void phase_prep_weights(const Ctx& C, int l) {
    LAS float* scr = (LAS float*)(C.lds + C.wave * 16384);
    const int gw = C.bid * NWAVES + C.wave, NGW = C.G * NWAVES;
    unsigned char* ws = C.ws;
    constexpr int I_GU = 16 * 88, I_DN = 44 * 32, I_WIN = 16 * 136, I_GT = 16 * 96, I_BR = 3 * 8 * 32, I_OUT = 16 * 32, I_C1 = 2 * 32 * 8, I_C2 = 2 * 4 * 2;
    constexpr int I_FFN = 2 * I_GU + I_DN;
    constexpr int NITEMS = 2 * I_FFN + I_WIN + I_GT + I_BR + I_OUT + I_C1 + I_C2;
    for (int it = gw; it < NITEMS; it += NGW) {
        int r = it;
        if (r < 2 * I_FFN) {
            const int f = r / I_FFN; r -= f * I_FFN;
            const float* wg = (f ? C.in(20) : C.in(2)) + (size_t)l * DM * DFF; const float* wu = (f ? C.in(21) : C.in(3)) + (size_t)l * DM * DFF; const float* wd = (f ? C.in(22) : C.in(4)) + (size_t)l * DFF * DM;
            bf16* WGU = (bf16*)(ws + (f ? WS_WGU2 : WS_WGU1)); bf16* WDN = (bf16*)(ws + (f ? WS_WDN2 : WS_WDN1));
            if (r < I_GU) { const int kb = r / 88, col = 32 * (r % 88); transpose_item(wg, DFF, col, WGU, DM, 256 * (col >> 7) + (col & 127), kb, scr, C.lane); }
            else if (r < 2 * I_GU) { r -= I_GU; const int kb = r / 88, col = 32 * (r % 88); transpose_item(wu, DFF, col, WGU, DM, 256 * (col >> 7) + 128 + (col & 127), kb, scr, C.lane); }
            else { r -= 2 * I_GU; const int kb = r / 32, col = 32 * (r % 32); transpose_item(wd, DM, col, WDN, DFF, col, kb, scr, C.lane); }
            continue;
        }
        r -= 2 * I_FFN;
        const float* win = C.in(6) + (size_t)l * DM * N_IN;
        if (r < I_WIN) { const int kb = r / 136, n = 32 * (r % 136); transpose_item(win, N_IN, win_src_col(n), (bf16*)(ws + WS_WIN), DM, n, kb, scr, C.lane); continue; } r -= I_WIN;
        if (r < I_GT) { const int kb = r / 96, n = 32 * (r % 96); transpose_item(win, N_IN, 4400 + n, (bf16*)(ws + WS_WGT), DM, n, kb, scr, C.lane); continue; } r -= I_GT;
        if (r < I_BR) { const int i = r / 256, rr = r % 256, kb = rr / 32, n = 32 * (rr % 32);
            transpose_item(C.in(17) + ((size_t)l * 3 + i) * 512 * DM, DM, n, (bf16*)(ws + WS_WBR) + (size_t)i * DM * 512, 512, n, kb, scr, C.lane); continue; } r -= I_BR;
        if (r < I_OUT) { const int kb = r / 32, n = 32 * (r % 32); transpose_item(C.in(18) + (size_t)l * DM * DM, DM, n, (bf16*)(ws + WS_WOUT), DM, n, kb, scr, C.lane); continue; } r -= I_OUT;
        if (r < I_C1) { const int kv = r / 256, rr = r % 256, kb = rr / 8, n = 32 * (rr % 8);
            transpose_item(C.in(13) + ((size_t)l * 2 + kv) * 2048 * 256, 256, n, (bf16*)(ws + WS_CW1) + (size_t)kv * 256 * 2048, 2048, n, kb, scr, C.lane); continue; } r -= I_C1;
        { const int kv = r / 8, rr = r % 8, kb = rr / 2, n = 32 * (rr % 2);
            transpose_item(C.in(14) + ((size_t)l * 2 + kv) * 256 * 64, 64, n, (bf16*)(ws + WS_CW2) + (size_t)kv * 64 * 256, 256, n, kb, scr, C.lane); }
    }
    const int gt = C.bid * NTHR + C.tid, NGT = C.G * NTHR;
    {
        const float* win = C.in(6) + (size_t)l * DM * N_IN; bf16* WIN = (bf16*)(ws + WS_WIN);
        for (int idx = gt; idx < 256 * 128; idx += NGT) { const int i = idx & 255, kc = idx >> 8; const int sc = win_small_src(i);
            v4u o = (v4u){0u, 0u, 0u, 0u};
            if (sc >= 0) { float v[8];
#pragma unroll
                for (int j = 0; j < 8; ++j) v[j] = win[(size_t)(kc * 8 + j) * N_IN + sc];
                o.x = pk2(v[0], v[1]); o.y = pk2(v[2], v[3]); o.z = pk2(v[4], v[5]); o.w = pk2(v[6], v[7]); }
            *(v4u*)(WIN + (size_t)(4352 + i) * DM + kc * 8) = o; }
        float* vec = (float*)(ws + WS_VEC); const float* bin = C.in(7) + (size_t)l * N_IN;
        for (int n = gt; n < 4608; n += NGT) { const int sc = win_src_col(n); vec[VEC_BINP + n] = sc >= 0 ? bin[sc] : 0.f; }
        for (int it = gw; it < 512; it += NGW) { const int kv = it >> 8, n = it & 255;
            const float* pe = C.in(12) + ((size_t)l * 2 + kv) * 2048; const float* w1 = C.in(13) + ((size_t)l * 2 + kv) * 2048 * 256;
            float s = 0.f;
            for (int k = C.lane; k < 2048; k += 64) s += pe[k] * w1[(size_t)k * 256 + n];
            s = wave_sum(s);
            if (C.lane == 0) vec[VEC_CB1 + it] = s; }
    }
}

__device__ __forceinline__ void phase_init(const Ctx& C) {
    const int gt = C.bid * NTHR + C.tid, NGT = C.G * NTHR;
    f32x2* rope = (f32x2*)(C.ws + WS_ROPE);
    for (int i = gt; i < SEQ * 32; i += NGT) { const int pos = i >> 5, fi = i & 31;
        const float ang = (float)pos * ROPE_FREQ[fi];
        double rev = (double)ang * 0.15915494309189533577; rev -= floor(rev);
        const float rf = (float)rev;
        rope[i] = (f32x2){__builtin_amdgcn_cosf(rf), __builtin_amdgcn_sinf(rf)}; }
}

__device__ __forceinline__ void phase_norm(const Ctx& C, const float* gain, const float* Xsrc) {
    const int gw = C.bid * NWAVES + C.wave, NGW = C.G * NWAVES;
    bf16* XN = (bf16*)(C.ws + WS_XN);
    f32x4 g[4];
#pragma unroll
    for (int j = 0; j < 4; ++j) g[j] = ((const f32x4*)gain)[C.lane + 64 * j];
    for (int m = gw; m < T; m += NGW) {
        const f32x4* xr = (const f32x4*)(Xsrc + (size_t)m * DM) + C.lane;
        f32x4 v[4]; float s = 0.f;
#pragma unroll
        for (int j = 0; j < 4; ++j) { v[j] = xr[64 * j]; s += (v[j].x * v[j].x + v[j].y * v[j].y) + (v[j].z * v[j].z + v[j].w * v[j].w); }
        const float r = 1.0f / sqrtf(wave_sum(s) * (1.f / DM) + RMS_EPS);
        unsigned long long* o8 = (unsigned long long*)(XN + (size_t)m * DM) + C.lane;
#pragma unroll
        for (int j = 0; j < 4; ++j) { const f32x4 w = v[j] * r * g[j]; o8[64 * j] = (unsigned long long)pk2(w.x, w.y) | ((unsigned long long)pk2(w.z, w.w) << 32); }
    }
}

template <int KSTEPS, class PA, class PB>
__device__ __forceinline__ f32x4 mma_tile(PA A, int lda, PB Bt, int ldb, f32x4 acc, int lane) {
    const int r = lane & 15, q = lane >> 4;
#pragma unroll
    for (int kk = 0; kk < KSTEPS; ++kk) {
        const bf16x8 a = *(const bf16x8*)(A + r * lda + kk * 32 + 8 * q);
        const bf16x8 b = *(const bf16x8*)(Bt + r * ldb + kk * 32 + 8 * q);
        acc = __builtin_amdgcn_mfma_f32_16x16x32_bf16(a, b, acc, 0, 0, 0);
    }
    return acc;
}
__device__ __forceinline__ float wave_scan_sum(float v, int lane) {
#pragma unroll
    for (int o = 1; o < 64; o <<= 1) { const float t = __shfl_up(v, o); if (lane >= o) v += t; }
    return v;
}
__device__ __forceinline__ float wave_scan_max(float v, int lane) {
#pragma unroll
    for (int o = 1; o < 64; o <<= 1) { const float t = __shfl_up(v, o); if (lane >= o) v = fmaxf(v, t); }
    return v;
}

__device__ __forceinline__ void lds_frag2(const LAS bf16* tile, int row0, int lane, bf16x8 (&f)[2]) {
    const LAS bf16* p = tile + (row0 + (lane & 15)) * 72 + 8 * (lane >> 4);
    f[0] = *(const LAS bf16x8*)p; f[1] = *(const LAS bf16x8*)(p + 32);
}
constexpr int CU_ALR = 0;
constexpr int CU_GT = 4096;
constexpr int CU_VEC = 6144;
constexpr int CU_KT = 8192;
constexpr int CU_VT = 17408;
constexpr int CU_Q = 35840;
constexpr int CU_AT = 45056;
constexpr int CU_O = 54272;
constexpr int CU_END = 88064;
constexpr int CU_WA = 110592;

__device__ __forceinline__ void load_vt(const Ctx& C, const bf16* V, int t0, int h) {
    LAS bf16* VT = (LAS bf16*)(C.lds + CU_VT);
    const int dv = C.tid & 127, jq = C.tid >> 7;
    const bf16* src = V + (size_t)(t0 + 16 * jq) * 512 + h * 128 + dv;
    unsigned w[8];
#pragma unroll
    for (int jj = 0; jj < 8; ++jj) { const unsigned lo = src[(size_t)(2 * jj) * 512], hi = src[(size_t)(2 * jj + 1) * 512]; w[jj] = lo | (hi << 16); }
    *(LAS v4u*)(VT + dv * 72 + 16 * jq) = (v4u){w[0], w[1], w[2], w[3]};
    *(LAS v4u*)(VT + dv * 72 + 16 * jq + 8) = (v4u){w[4], w[5], w[6], w[7]};
}

__device__ __forceinline__ void gla_stage_alpha(const Ctx& C, int l) {
    LAS float* WA = (LAS float*)(C.lds + CU_WA);
    const float* wa = C.in(8) + (size_t)l * 16 * 256; const float* ba = C.in(9) + (size_t)l * 256;
    for (int i = C.tid; i < 16 * 256 + 256; i += NTHR) WA[i] = i < 4096 ? wa[i] : ba[i - 4096];
}
__device__ __forceinline__ float gla_cumsum(const Ctx& C, int l, int t0, int h, float (&b)[8]) {
    LAS float* ALR = (LAS float*)(C.lds + CU_ALR); LAS float* GT = (LAS float*)(C.lds + CU_GT);
    const float* SMALL = (const float*)(C.ws + WS_SMALL);
    if (C.tid < 256) { const int j = C.tid >> 2, c4 = C.tid & 3; *(LAS f32x4*)(ALR + j * 16 + 4 * c4) = *(const f32x4*)(SMALL + (size_t)(t0 + j) * 64 + 4 * c4); }
    const int dk = C.tid & 63, jg = C.tid >> 6;
    const LAS float* WA = (const LAS float*)(C.lds + CU_WA) + h * 64 + dk; (void)l;
    __syncthreads();
    float w[16];
#pragma unroll
    for (int r = 0; r < 16; ++r) w[r] = WA[r * 256];
    const float ba = WA[16 * 256];
    float run = 0.f;
#pragma unroll
    for (int jj = 0; jj < 8; ++jj) { const int j = 8 * jg + jj; float x = ba;
#pragma unroll
        for (int r = 0; r < 16; ++r) x += ALR[j * 16 + r] * w[r];
        run += logsigmoidf_(x) * (1.0f / 16.0f); b[jj] = run; }
    GT[jg * 64 + dk] = run;
    __syncthreads();
    float pre = 0.f, tot = 0.f;
#pragma unroll
    for (int g2 = 0; g2 < 8; ++g2) { const float v = GT[g2 * 64 + dk]; tot += v; if (g2 < jg) pre += v; }
#pragma unroll
    for (int jj = 0; jj < 8; ++jj) b[jj] += pre;
    return tot;
}

__device__ __forceinline__ void gla_unit_a(const Ctx& C, int l, int ci) {
    const int bh = ci >> 8, c = ci & 255, bb = bh >> 2, h = bh & 3, t0 = bb * SEQ + c * 64;
    const bf16* QKA = (const bf16*)(C.ws + WS_QKA);
    load_vt(C, (const bf16*)(C.ws + WS_VA), t0, h);
    const int dk = C.tid & 63, jg = C.tid >> 6;
    unsigned kraw[8];
#pragma unroll
    for (int jj = 0; jj < 8; ++jj) kraw[jj] = QKA[(size_t)(t0 + 8 * jg + jj) * 512 + 256 + h * 64 + dk];
    float b[8]; const float btot = gla_cumsum(C, l, t0, h, b);
    LAS bf16* KT = (LAS bf16*)(C.lds + CU_KT);
    float kd[8];
#pragma unroll
    for (int jj = 0; jj < 8; ++jj) { const float k = bf2f(kraw[jj]); kd[jj] = k * fexp(btot - b[jj]); }
    *(LAS v4u*)(KT + dk * 72 + 8 * jg) = (v4u){pk2(kd[0], kd[1]), pk2(kd[2], kd[3]), pk2(kd[4], kd[5]), pk2(kd[6], kd[7])};
    if (jg == 0) ((float*)(C.ws + WS_GDEC))[(size_t)ci * 64 + dk] = fexp(btot);
    __syncthreads();
    const LAS bf16* VT = (const LAS bf16*)(C.lds + CU_VT);
    bf16* GST = (bf16*)(C.ws + WS_GST) + (size_t)ci * 8192;
    const int q = C.lane >> 4, fr = C.lane & 15;
    {
        bf16x8 av[2], bk[4][2]; lds_frag2(VT, 16 * C.wave, C.lane, av);
#pragma unroll
        for (int nt = 0; nt < 4; ++nt) lds_frag2((const LAS bf16*)KT, 16 * nt, C.lane, bk[nt]);
        f32x4 acc[4];
#pragma unroll
        for (int nt = 0; nt < 4; ++nt) acc[nt] = __builtin_amdgcn_mfma_f32_16x16x32_bf16(av[0], bk[nt][0], (f32x4){0.f, 0.f, 0.f, 0.f}, 0, 0, 0);
#pragma unroll
        for (int nt = 0; nt < 4; ++nt) acc[nt] = __builtin_amdgcn_mfma_f32_16x16x32_bf16(av[1], bk[nt][1], acc[nt], 0, 0, 0);
#pragma unroll
        for (int nt = 0; nt < 4; ++nt)
#pragma unroll
            for (int r = 0; r < 4; ++r) GST[(16 * C.wave + 4 * q + r) * 64 + 16 * nt + fr] = (bf16)f2bf(acc[nt][r]);
    }
    __syncthreads();
}

__device__ __forceinline__ void gla_unit_c(const Ctx& C, int l, int ci, bool DRY) {
    const int bh = ci >> 8, c = ci & 255, bb = bh >> 2, h = bh & 3, t0 = bb * SEQ + c * 64;
    const bf16* QKA = (const bf16*)(C.ws + WS_QKA);
    load_vt(C, (const bf16*)(C.ws + WS_VA), t0, h);
    const int dk = C.tid & 63, jg = C.tid >> 6;
    unsigned qraw[8], kraw[8];
#pragma unroll
    for (int jj = 0; jj < 8; ++jj) { const bf16* p = QKA + (size_t)(t0 + 8 * jg + jj) * 512 + h * 64 + dk; qraw[jj] = p[0]; kraw[jj] = p[256]; }
    bf16x8 stf[4][2];
    { const bf16* ST = (const bf16*)(C.ws + WS_GST) + (size_t)ci * 8192 + (size_t)(16 * 4 * (C.wave >> 2) + (C.lane & 15)) * 64 + 8 * (C.lane >> 4);
#pragma unroll
      for (int u = 0; u < 4; ++u) { stf[u][0] = *(const bf16x8*)(ST + u * 16 * 64); stf[u][1] = *(const bf16x8*)(ST + u * 16 * 64 + 32); } }
    v4u ar0, ar1;
    { const bf16* RAp = (const bf16*)(C.ws + WS_RA) + (size_t)(t0 + (C.tid >> 3)) * 512 + h * 128 + 16 * (C.tid & 7); ar0 = *(const v4u*)RAp; ar1 = *(const v4u*)(RAp + 8); }
    float b[8]; (void)gla_cumsum(C, l, t0, h, b);
    LAS bf16* KT = (LAS bf16*)(C.lds + CU_KT); LAS bf16* QT = (LAS bf16*)(C.lds + CU_Q); LAS bf16* AT = (LAS bf16*)(C.lds + CU_AT);
#pragma unroll
    for (int jj = 0; jj < 8; ++jj) { const int j = 8 * jg + jj;
        const float qv = bf2f(qraw[jj]) * 0.125f, kv = bf2f(kraw[jj]);
        QT[j * 72 + dk] = (bf16)f2bf(qv * fexp(b[jj])); KT[j * 72 + dk] = (bf16)f2bf(kv * fexp(fminf(-b[jj], 80.f))); }
    __syncthreads();
    const int q = C.lane >> 4, fr = C.lane & 15;
    {
        const int it = C.wave >> 1;
        bf16x8 bq[2], ak[2][2]; lds_frag2((const LAS bf16*)QT, 16 * it, C.lane, bq);
#pragma unroll
        for (int u = 0; u < 2; ++u) lds_frag2((const LAS bf16*)KT, 16 * (2 * (C.wave & 1) + u), C.lane, ak[u]);
        f32x4 acc2[2];
#pragma unroll
        for (int u = 0; u < 2; ++u) acc2[u] = __builtin_amdgcn_mfma_f32_16x16x32_bf16(ak[u][0], bq[0], (f32x4){0.f, 0.f, 0.f, 0.f}, 0, 0, 0);
#pragma unroll
        for (int u = 0; u < 2; ++u) acc2[u] = __builtin_amdgcn_mfma_f32_16x16x32_bf16(ak[u][1], bq[1], acc2[u], 0, 0, 0);
#pragma unroll
        for (int u = 0; u < 2; ++u) { const int jt = 2 * (C.wave & 1) + u;
            const int i = 16 * it + fr;
            float v[4];
#pragma unroll
            for (int r = 0; r < 4; ++r) { const int j = 16 * jt + 4 * q + r; v[r] = (j <= i) ? acc2[u][r] : 0.f; }
            *(LAS v2u*)(AT + i * 72 + 16 * jt + 4 * q) = (v2u){pk2(v[0], v[1]), pk2(v[2], v[3])}; }
    }
    __syncthreads();
    {
        const int it = C.wave & 3; LAS float* O = (LAS float*)(C.lds + CU_O);
        const LAS bf16* VT = (const LAS bf16*)(C.lds + CU_VT);
        bf16x8 qa[2], aa[2], bv[4][2]; lds_frag2((const LAS bf16*)QT, 16 * it, C.lane, qa); lds_frag2((const LAS bf16*)AT, 16 * it, C.lane, aa);
#pragma unroll
        for (int u = 0; u < 4; ++u) lds_frag2(VT, 16 * (4 * (C.wave >> 2) + u), C.lane, bv[u]);
        f32x4 acc4[4];
#pragma unroll
        for (int u = 0; u < 4; ++u) acc4[u] = __builtin_amdgcn_mfma_f32_16x16x32_bf16(qa[0], stf[u][0], (f32x4){0.f, 0.f, 0.f, 0.f}, 0, 0, 0);
#pragma unroll
        for (int u = 0; u < 4; ++u) acc4[u] = __builtin_amdgcn_mfma_f32_16x16x32_bf16(qa[1], stf[u][1], acc4[u], 0, 0, 0);
#pragma unroll
        for (int u = 0; u < 4; ++u) acc4[u] = __builtin_amdgcn_mfma_f32_16x16x32_bf16(aa[0], bv[u][0], acc4[u], 0, 0, 0);
#pragma unroll
        for (int u = 0; u < 4; ++u) acc4[u] = __builtin_amdgcn_mfma_f32_16x16x32_bf16(aa[1], bv[u][1], acc4[u], 0, 0, 0);
#pragma unroll
        for (int u = 0; u < 4; ++u) { const int dvt = 4 * (C.wave >> 2) + u;
#pragma unroll
            for (int r = 0; r < 4; ++r) O[(16 * it + 4 * q + r) * 132 + 16 * dvt + fr] = acc4[u][r]; }
    }
    __syncthreads();
    {
        const int i = C.tid >> 3, s = C.tid & 7; const LAS float* O = (const LAS float*)(C.lds + CU_O) + i * 132 + 16 * s;
        float o[16]; float ss = 0.f;
#pragma unroll
        for (int k = 0; k < 16; ++k) { o[k] = O[k]; ss += o[k] * o[k]; }
        ss += __shfl_xor(ss, 1); ss += __shfl_xor(ss, 2); ss += __shfl_xor(ss, 4);
        const float rinv = 1.0f / sqrtf(ss * (1.0f / 128.0f) + RMS_EPS);
        bf16* RA = (bf16*)(C.ws + WS_RA) + (size_t)(t0 + i) * 512 + h * 128 + 16 * s;
        const float* gn = C.in(10) + (size_t)l * 128 + 16 * s;
        const v4u r0 = ar0, r1 = ar1;
        unsigned rw[8] = {r0.x, r0.y, r0.z, r0.w, r1.x, r1.y, r1.z, r1.w}; unsigned ow[8];
#pragma unroll
        for (int k = 0; k < 8; ++k) { const float a = SCL_A * o[2 * k] * rinv * gn[2 * k] * siluf_(bflo(rw[k])), bq = SCL_A * o[2 * k + 1] * rinv * gn[2 * k + 1] * siluf_(bfhi(rw[k])); ow[k] = (ABL_ZERO & 1) ? 0u : pk2(a, bq); }
        if (DRY) { asm volatile("" :: "v"(ow[0]), "v"(ow[1]), "v"(ow[2]), "v"(ow[3]), "v"(ow[4]), "v"(ow[5]), "v"(ow[6]), "v"(ow[7])); } else {
        *(v4u*)RA = (v4u){ow[0], ow[1], ow[2], ow[3]}; *(v4u*)(RA + 8) = (v4u){ow[4], ow[5], ow[6], ow[7]}; }
    }
    __syncthreads();
}

__device__ __forceinline__ void conv_silu8(const Ctx& C, int l, int t0, int c, int ch, int jg, float (&out)[8]) {
    const bf16* X = (const bf16*)(C.ws + WS_QKC);
    const float* cw = C.in(15) + (size_t)l * 4 * 512 + ch; const float cb = C.in(16)[(size_t)l * 512 + ch];
    const float w0 = cw[0], w1 = cw[512], w2 = cw[1024], w3 = cw[1536];
    float x[11];
#pragma unroll
    for (int k = 0; k < 11; ++k) { const int j = 8 * jg + k - 3; const int s = c * 64 + j; x[k] = (s >= 0) ? bf2f(X[(size_t)(t0 + j) * 512 + ch]) : 0.f; }
#pragma unroll
    for (int jj = 0; jj < 8; ++jj) out[jj] = siluf_(cb + w0 * x[jj] + w1 * x[jj + 1] + w2 * x[jj + 2] + w3 * x[jj + 3]);
}

__device__ __forceinline__ void mlstm_unit_a(const Ctx& C, int l, int ci) {
    const int bh = ci >> 8, c = ci & 255, bb = bh >> 2, h = bh & 3, t0 = bb * SEQ + c * 64;
    LAS float* VEC = (LAS float*)(C.lds + CU_VEC); LAS float* GT = (LAS float*)(C.lds + CU_GT);
    load_vt(C, (const bf16*)(C.ws + WS_VC), t0, h);
    const int dk = C.tid & 63, jg = C.tid >> 6;
    float k[8]; conv_silu8(C, l, t0, c, 256 + h * 64 + dk, jg, k);
    if (C.wave == 0) {
        const float* sm = (const float*)(C.ws + WS_SMALL) + (size_t)(t0 + C.lane) * 64;
        const float ip = sm[40 + h], lf = logsigmoidf_(sm[44 + h]);
        const float bj = wave_scan_sum(lf, C.lane); const float a = ip - bj; const float amax = wave_max(a);
        VEC[C.lane] = fexp(a - amax);
        if (C.lane == 63) { float* msc = (float*)(C.ws + WS_MSC) + (size_t)ci * 4; msc[0] = bj; msc[1] = amax; }
    }
    __syncthreads();
    LAS bf16* KT = (LAS bf16*)(C.lds + CU_KT);
    float kw[8]; float ns = 0.f;
#pragma unroll
    for (int jj = 0; jj < 8; ++jj) { kw[jj] = k[jj] * 0.125f * VEC[8 * jg + jj]; ns += kw[jj]; }
    *(LAS v4u*)(KT + dk * 72 + 8 * jg) = (v4u){pk2(kw[0], kw[1]), pk2(kw[2], kw[3]), pk2(kw[4], kw[5]), pk2(kw[6], kw[7])};
    GT[jg * 64 + dk] = ns;
    __syncthreads();
    if (C.tid < 64) { float s = 0.f;
#pragma unroll
        for (int g2 = 0; g2 < 8; ++g2) s += GT[g2 * 64 + C.tid];
        ((float*)(C.ws + WS_MN))[(size_t)ci * 64 + C.tid] = s; }
    const LAS bf16* VT = (const LAS bf16*)(C.lds + CU_VT);
    bf16* MST = (bf16*)(C.ws + WS_MST) + (size_t)ci * 8192;
    const int q = C.lane >> 4, fr = C.lane & 15;
    {
        bf16x8 av[2], bk[4][2]; lds_frag2(VT, 16 * C.wave, C.lane, av);
#pragma unroll
        for (int nt = 0; nt < 4; ++nt) lds_frag2((const LAS bf16*)KT, 16 * nt, C.lane, bk[nt]);
        f32x4 acc[4];
#pragma unroll
        for (int nt = 0; nt < 4; ++nt) acc[nt] = __builtin_amdgcn_mfma_f32_16x16x32_bf16(av[0], bk[nt][0], (f32x4){0.f, 0.f, 0.f, 0.f}, 0, 0, 0);
#pragma unroll
        for (int nt = 0; nt < 4; ++nt) acc[nt] = __builtin_amdgcn_mfma_f32_16x16x32_bf16(av[1], bk[nt][1], acc[nt], 0, 0, 0);
#pragma unroll
        for (int nt = 0; nt < 4; ++nt)
#pragma unroll
            for (int r = 0; r < 4; ++r) MST[(16 * C.wave + 4 * q + r) * 64 + 16 * nt + fr] = (bf16)f2bf(acc[nt][r]);
    }
    __syncthreads();
}

__device__ __forceinline__ void mlstm_unit_c(const Ctx& C, int l, int ci, bool DRY) {
    const int bh = ci >> 8, c = ci & 255, bb = bh >> 2, h = bh & 3, t0 = bb * SEQ + c * 64;
    LAS float* VEC = (LAS float*)(C.lds + CU_VEC);
    LAS float* AJ = VEC + 64, *MI = VEC + 128, *WI = VEC + 192, *EM = VEC + 256, *QN = VEC + 384; LAS float* DENP = (LAS float*)(C.lds + CU_GT);
    load_vt(C, (const bf16*)(C.ws + WS_VC), t0, h);
    const int dk = C.tid & 63, jg = C.tid >> 6;
    LAS bf16* KT = (LAS bf16*)(C.lds + CU_KT); LAS bf16* QT = (LAS bf16*)(C.lds + CU_Q); LAS bf16* AT = (LAS bf16*)(C.lds + CU_AT);
    bf16x8 stf[4][2];
    { const bf16* ST = (const bf16*)(C.ws + WS_MST) + (size_t)ci * 8192 + (size_t)(16 * 4 * (C.wave >> 2) + (C.lane & 15)) * 64 + 8 * (C.lane >> 4);
#pragma unroll
      for (int u = 0; u < 4; ++u) { stf[u][0] = *(const bf16x8*)(ST + u * 16 * 64); stf[u][1] = *(const bf16x8*)(ST + u * 16 * 64 + 32); } }
    v4u co0, co1; f32x4 nst0, nst1;
    { const bf16* OCp = (const bf16*)(C.ws + WS_OC) + (size_t)(t0 + (C.tid >> 3)) * 512 + h * 128 + 16 * (C.tid & 7); co0 = *(const v4u*)OCp; co1 = *(const v4u*)(OCp + 8);
      const float* np = (const float*)(C.ws + WS_MN) + (size_t)ci * 64 + 8 * (C.tid & 7); nst0 = *(const f32x4*)np; nst1 = *(const f32x4*)(np + 4); }
    {
        float qv[8], kv[8]; conv_silu8(C, l, t0, c, h * 64 + dk, jg, qv); conv_silu8(C, l, t0, c, 256 + h * 64 + dk, jg, kv);
#pragma unroll
        for (int jj = 0; jj < 8; ++jj) { const int j = 8 * jg + jj; QT[j * 72 + dk] = (bf16)f2bf(qv[jj]); KT[j * 72 + dk] = (bf16)f2bf(kv[jj] * 0.125f); }
    }
    if (C.wave == 0) {
        const float* sm = (const float*)(C.ws + WS_SMALL) + (size_t)(t0 + C.lane) * 64;
        const float ip = sm[40 + h], lf = logsigmoidf_(sm[44 + h]);
        const float bj = wave_scan_sum(lf, C.lane); const float a = ip - bj; const float arun = wave_scan_max(a, C.lane);
        const float mst = ((const float*)(C.ws + WS_MSC))[(size_t)ci * 4 + 2];
        const float mi = fmaxf(mst, arun);
        AJ[C.lane] = a; MI[C.lane] = mi; WI[C.lane] = fexp(mst - mi); EM[C.lane] = fexp(-(bj + mi));
    }
    __syncthreads();
    const int q = C.lane >> 4, fr = C.lane & 15;
    {
        const int it = C.wave >> 1;
        bf16x8 bq[2], ak[2][2]; lds_frag2((const LAS bf16*)QT, 16 * it, C.lane, bq);
#pragma unroll
        for (int u = 0; u < 2; ++u) lds_frag2((const LAS bf16*)KT, 16 * (2 * (C.wave & 1) + u), C.lane, ak[u]);
        f32x4 acc2[2];
#pragma unroll
        for (int u = 0; u < 2; ++u) acc2[u] = __builtin_amdgcn_mfma_f32_16x16x32_bf16(ak[u][0], bq[0], (f32x4){0.f, 0.f, 0.f, 0.f}, 0, 0, 0);
#pragma unroll
        for (int u = 0; u < 2; ++u) acc2[u] = __builtin_amdgcn_mfma_f32_16x16x32_bf16(ak[u][1], bq[1], acc2[u], 0, 0, 0);
#pragma unroll
        for (int u = 0; u < 2; ++u) { const int jt = 2 * (C.wave & 1) + u; const f32x4 acc = acc2[u];
            const int i = 16 * it + fr; const float mi = MI[i];
            float v[4]; float ds = 0.f;
#pragma unroll
            for (int r = 0; r < 4; ++r) { const int j = 16 * jt + 4 * q + r; v[r] = (j <= i) ? acc[r] * fexp(AJ[j] - mi) : 0.f; ds += v[r]; }
            ds += __shfl_xor(ds, 16); ds += __shfl_xor(ds, 32);
            if (q == 0) DENP[jt * 64 + i] = ds;
            *(LAS v2u*)(AT + i * 72 + 16 * jt + 4 * q) = (v2u){pk2(v[0], v[1]), pk2(v[2], v[3])}; }
    }
    {
        const int i = C.tid >> 3, s = C.tid & 7; const float nst[8] = {nst0[0], nst0[1], nst0[2], nst0[3], nst1[0], nst1[1], nst1[2], nst1[3]};
        float a = 0.f;
#pragma unroll
        for (int k = 0; k < 8; ++k) a += bf2f(QT[i * 72 + 8 * s + k]) * nst[k];
        a += __shfl_xor(a, 1); a += __shfl_xor(a, 2); a += __shfl_xor(a, 4);
        if (s == 0) QN[i] = a;
    }
    __syncthreads();
    {
        const int it = C.wave & 3; LAS float* O = (LAS float*)(C.lds + CU_O);
        const LAS bf16* VT = (const LAS bf16*)(C.lds + CU_VT);
        bf16x8 qa[2], aa[2], bv[4][2]; lds_frag2((const LAS bf16*)QT, 16 * it, C.lane, qa); lds_frag2((const LAS bf16*)AT, 16 * it, C.lane, aa);
#pragma unroll
        for (int u = 0; u < 4; ++u) lds_frag2(VT, 16 * (4 * (C.wave >> 2) + u), C.lane, bv[u]);
        f32x4 a1[4], a2[4];
#pragma unroll
        for (int u = 0; u < 4; ++u) { a1[u] = __builtin_amdgcn_mfma_f32_16x16x32_bf16(qa[0], stf[u][0], (f32x4){0.f, 0.f, 0.f, 0.f}, 0, 0, 0); a2[u] = __builtin_amdgcn_mfma_f32_16x16x32_bf16(aa[0], bv[u][0], (f32x4){0.f, 0.f, 0.f, 0.f}, 0, 0, 0); }
#pragma unroll
        for (int u = 0; u < 4; ++u) { a1[u] = __builtin_amdgcn_mfma_f32_16x16x32_bf16(qa[1], stf[u][1], a1[u], 0, 0, 0); a2[u] = __builtin_amdgcn_mfma_f32_16x16x32_bf16(aa[1], bv[u][1], a2[u], 0, 0, 0); }
        float wi4[4];
#pragma unroll
        for (int r = 0; r < 4; ++r) wi4[r] = WI[16 * it + 4 * q + r];
#pragma unroll
        for (int u = 0; u < 4; ++u) { const int dvt = 4 * (C.wave >> 2) + u;
#pragma unroll
            for (int r = 0; r < 4; ++r) { const int i = 16 * it + 4 * q + r; O[i * 132 + 16 * dvt + fr] = wi4[r] * a1[u][r] + a2[u][r]; } }
    }
    __syncthreads();
    {
        const int i = C.tid >> 3, s = C.tid & 7; const LAS float* O = (const LAS float*)(C.lds + CU_O) + i * 132 + 16 * s;
        const float den = WI[i] * QN[i] + ((DENP[i] + DENP[64 + i]) + (DENP[128 + i] + DENP[192 + i])); const float dinv = 1.0f / fmaxf(fabsf(den), EM[i]);
        bf16* OC = (bf16*)(C.ws + WS_OC) + (size_t)(t0 + i) * 512 + h * 128 + 16 * s;
        const v4u r0 = co0, r1 = co1;
        unsigned rw[8] = {r0.x, r0.y, r0.z, r0.w, r1.x, r1.y, r1.z, r1.w}; unsigned ow[8];
#pragma unroll
        for (int k = 0; k < 8; ++k) ow[k] = (ABL_ZERO & 4) ? 0u : pk2(SCL_C * O[2 * k] * dinv * sigmoidf_(bflo(rw[k])), SCL_C * O[2 * k + 1] * dinv * sigmoidf_(bfhi(rw[k])));
        if (DRY) { asm volatile("" :: "v"(ow[0]), "v"(ow[1]), "v"(ow[2]), "v"(ow[3]), "v"(ow[4]), "v"(ow[5]), "v"(ow[6]), "v"(ow[7])); } else {
        *(v4u*)OC = (v4u){ow[0], ow[1], ow[2], ow[3]}; *(v4u*)(OC + 8) = (v4u){ow[4], ow[5], ow[6], ow[7]}; }
    }
    __syncthreads();
}

__device__ __forceinline__ void phase_scan(const Ctx& C, bool DRY) {
    const int gt = C.bid * NTHR + C.tid, NGT = C.G * NTHR;
    for (int e = gt; e < 65536 + 65536; e += NGT) {
        if (e < 65536) {
            const int bh = e >> 13, el = e & 8191, dk = el & 63;
            bf16* st = (bf16*)(C.ws + WS_GST) + (size_t)bh * 256 * 8192 + el; const float* dec = (const float*)(C.ws + WS_GDEC) + (size_t)bh * 256 * 64 + dk;
            float s = 0.f;
            for (int c0 = 0; c0 < 256; c0 += 8) { float L[8], d[8];
#pragma unroll
                for (int k = 0; k < 8; ++k) { L[k] = bf2f(st[(size_t)(c0 + k) * 8192]); d[k] = dec[(c0 + k) * 64]; }
#pragma unroll
                for (int k = 0; k < 8; ++k) { if (!DRY) st[(size_t)(c0 + k) * 8192] = (bf16)f2bf(s); s = d[k] * s + L[k]; } }
            if (DRY) asm volatile("" :: "v"(s));
        } else {
            const int e2 = e - 65536, bh = e2 >> 13, el = e2 & 8191; const bool hasn = el < 64;
            bf16* st = (bf16*)(C.ws + WS_MST) + (size_t)bh * 256 * 8192 + el; float* nv = (float*)(C.ws + WS_MN) + (size_t)bh * 256 * 64 + (hasn ? el : 0);
            float* msc = (float*)(C.ws + WS_MSC) + (size_t)bh * 256 * 4;
            float s = 0.f, sn = 0.f, m = 0.f;
            for (int c0 = 0; c0 < 256; c0 += 8) { float L[8], Ln[8], bl[8], am[8];
#pragma unroll
                for (int k = 0; k < 8; ++k) { L[k] = bf2f(st[(size_t)(c0 + k) * 8192]); Ln[k] = hasn ? nv[(c0 + k) * 64] : 0.f; bl[k] = msc[(c0 + k) * 4]; am[k] = msc[(c0 + k) * 4 + 1]; }
#pragma unroll
                for (int k = 0; k < 8; ++k) {
                    const float mn = bl[k] + fmaxf(m, am[k]); const float al = fexp(bl[k] + m - mn), be = fexp(bl[k] + am[k] - mn);
                    if (!DRY) { st[(size_t)(c0 + k) * 8192] = (bf16)f2bf(s);
                    if (hasn) { nv[(c0 + k) * 64] = sn; if (el == 0) msc[(c0 + k) * 4 + 2] = m; } }
                    s = al * s + be * L[k]; sn = al * sn + be * Ln[k]; m = mn; } }
            if (DRY) asm volatile("" :: "v"(s), "v"(sn));
        }
    }
}

__device__ __forceinline__ float gelu_tanh(float x) { const float u = 0.7978845608f * (x + 0.044715f * x * x * x); const float e = __expf(2.0f * u); return 0.5f * x * (2.0f - 2.0f / (1.0f + e)); }

__device__ __forceinline__ void nsa_prep_rows(const float* gain, const f32x2* rope_row, float scale, bf16* p, int c8, bool DRY) {
    const v4u raw = *(const v4u*)p;
    float x[8]; x[0] = bflo(raw.x); x[1] = bfhi(raw.x); x[2] = bflo(raw.y); x[3] = bfhi(raw.y); x[4] = bflo(raw.z); x[5] = bfhi(raw.z); x[6] = bflo(raw.w); x[7] = bfhi(raw.w);
    float ss = 0.f;
#pragma unroll
    for (int k = 0; k < 8; ++k) ss += x[k] * x[k];
    ss += __shfl_xor(ss, 1); ss += __shfl_xor(ss, 2); ss += __shfl_xor(ss, 4);
    const float rinv = 1.0f / sqrtf(ss * (1.0f / 64.0f) + RMS_EPS);
    const f32x4 g0 = *(const f32x4*)(gain + 8 * c8), g1 = *(const f32x4*)(gain + 8 * c8 + 4);
    float y[8], pr[8];
#pragma unroll
    for (int k = 0; k < 8; ++k) y[k] = x[k] * rinv * (k < 4 ? g0[k] : g1[k - 4]);
#pragma unroll
    for (int k = 0; k < 8; ++k) pr[k] = __shfl_xor(y[k], 4);
    const f32x2* cs = rope_row + 8 * (c8 & 3);
    float o[8];
#pragma unroll
    for (int k = 0; k < 8; ++k) { const f32x2 c = cs[k]; o[k] = ((c8 < 4) ? (y[k] * c.x - pr[k] * c.y) : (pr[k] * c.y + y[k] * c.x)) * scale; }
    const v4u w = (v4u){pk2(o[0], o[1]), pk2(o[2], o[3]), pk2(o[4], o[5]), pk2(o[6], o[7])};
    if (DRY) asm volatile("" :: "v"(w)); else *(v4u*)p = w;
}
__device__ __forceinline__ void nsa_prep_token(const Ctx& C, int l, int tp, bool DRY) {
    const float* gn = C.in(11) + (size_t)l * 4 * 64;
    const int c8 = C.lane & 7, row = C.lane >> 3;
    const f32x2* rope = (const f32x2*)(C.ws + WS_ROPE);
#pragma unroll
    for (int h2 = 0; h2 < 2; ++h2) { const int t = 2 * tp + h2;
        nsa_prep_rows(gn, rope + (size_t)(t & (SEQ - 1)) * 32, 0.125f, (bf16*)(C.ws + WS_QB) + (size_t)t * 512 + row * 64 + 8 * c8, c8, DRY); }
    {
        const int t = 2 * tp + (row >> 2), kind = (row >> 1) & 1, g = row & 1;
        bf16* p = (bf16*)(C.ws + (kind ? WS_KVW : WS_KVS)) + (size_t)t * 256 + g * 64 + 8 * c8;
        nsa_prep_rows(gn + (kind ? 192 : 128), rope + (size_t)(t & (SEQ - 1)) * 32, 1.0f, p, c8, DRY); }
}
__device__ __forceinline__ void nsa_vtrans_item(const Ctx& C, int item) {
    const int which = item >> 10, bg = (item >> 8) & 3, blk = item & 255, b = bg >> 1, g = bg & 1;
    const bf16* src = (const bf16*)(C.ws + (which ? WS_KVW : WS_KVS)) + (size_t)(b * SEQ + blk * 64 + C.lane) * 256 + 128 + g * 64;
    bf16* dst = (bf16*)(C.ws + (which ? WS_VWT : WS_VST)) + (size_t)(bg * 256 + blk) * 4096 + C.lane;
    v4u w[8];
#pragma unroll
    for (int k = 0; k < 8; ++k) w[k] = ((const v4u*)src)[k];
#pragma unroll
    for (int k = 0; k < 8; ++k)
#pragma unroll
        for (int e = 0; e < 4; ++e) { const unsigned x = w[k][e]; dst[(size_t)(8 * k + 2 * e) * 64] = (bf16)(x & 0xffffu); dst[(size_t)(8 * k + 2 * e + 1) * 64] = (bf16)(x >> 16); }
}
__device__ __forceinline__ void nsa_cmp1_unit(const Ctx& C, int unit) {
    const int kv = unit >> 7, rb = (unit >> 2) & 31, ng = unit & 3;
    const int fr = C.lane & 15, q = C.lane >> 4;
    const int rt = rb * 8 + C.wave;
    const int ri = rt * 16 + fr, b = ri >> 11, g = (ri >> 10) & 1, c = ri & 1023, cc = c < 1023 ? c : 1022;
    const bf16* arow = (const bf16*)(C.ws + WS_KVC) + (size_t)(b * SEQ + 16 * cc) * 256 + kv * 128 + g * 64 + 8 * q;
    const bf16* bsrc = (const bf16*)(C.ws + WS_CW1) + (size_t)kv * 256 * 2048 + (size_t)(ng * 64 + (C.tid >> 3)) * 2048 + (C.tid & 7) * 8;
    LAS bf16* Bs = (LAS bf16*)C.lds;
    f32x4 acc[4];
#pragma unroll
    for (int nt = 0; nt < 4; ++nt) acc[nt] = (f32x4){0.f, 0.f, 0.f, 0.f};
    v4u breg = *(const v4u*)bsrc; bf16x8 areg[2] = {*(const bf16x8*)arow, *(const bf16x8*)(arow + 32)};
    for (int kc = 0; kc < 32; ++kc) {
        *(LAS v4u*)(Bs + (kc & 1) * 64 * 72 + (C.tid >> 3) * 72 + (C.tid & 7) * 8) = breg;
        __syncthreads();
        bf16x8 anext[2] = {areg[0], areg[1]};
        if (kc + 1 < 32) { breg = *(const v4u*)(bsrc + (kc + 1) * 64); anext[0] = *(const bf16x8*)(arow + (kc + 1) * 256); anext[1] = *(const bf16x8*)(arow + (kc + 1) * 256 + 32); }
        const LAS bf16* Bc = Bs + (kc & 1) * 64 * 72;
        bf16x8 bf[4][2];
#pragma unroll
        for (int nt = 0; nt < 4; ++nt) { bf[nt][0] = *(const LAS bf16x8*)(Bc + (16 * nt + fr) * 72 + 8 * q); bf[nt][1] = *(const LAS bf16x8*)(Bc + (16 * nt + fr) * 72 + 32 + 8 * q); }
#pragma unroll
        for (int nt = 0; nt < 4; ++nt) acc[nt] = __builtin_amdgcn_mfma_f32_16x16x32_bf16(areg[0], bf[nt][0], acc[nt], 0, 0, 0);
#pragma unroll
        for (int nt = 0; nt < 4; ++nt) acc[nt] = __builtin_amdgcn_mfma_f32_16x16x32_bf16(areg[1], bf[nt][1], acc[nt], 0, 0, 0);
        areg[0] = anext[0]; areg[1] = anext[1];
    }
    const float* cb1 = (const float*)(C.ws + WS_VEC) + VEC_CB1 + kv * 256;
    bf16* H1 = (bf16*)(C.ws + WS_CMPH) + (size_t)kv * 4096 * 256;
#pragma unroll
    for (int nt = 0; nt < 4; ++nt) { const int n = ng * 64 + nt * 16 + fr; const float bia = cb1[n];
#pragma unroll
        for (int r = 0; r < 4; ++r) H1[(size_t)(rt * 16 + 4 * q + r) * 256 + n] = (bf16)f2bf(gelu_tanh(acc[nt][r] + bia)); }
    __syncthreads();
}
__device__ __forceinline__ void nsa_cmp2_item(const Ctx& C, int l, int item) {
    const int kv = item >> 8, rt = item & 255;
    const int fr = C.lane & 15, q = C.lane >> 4;
    const bf16* H1 = (const bf16*)(C.ws + WS_CMPH) + (size_t)kv * 4096 * 256 + (size_t)rt * 16 * 256;
    const bf16* W2 = (const bf16*)(C.ws + WS_CW2) + (size_t)kv * 64 * 256;
    f32x4 acc[4];
#pragma unroll
    for (int nt = 0; nt < 4; ++nt) { acc[nt] = (f32x4){0.f, 0.f, 0.f, 0.f}; acc[nt] = mma_tile<8>(H1, 256, W2 + nt * 16 * 256, 256, acc[nt], C.lane); }
    if (kv == 0) {
        const float* gn = C.in(11) + (size_t)l * 4 * 64 + 64;
        bf16* KC = (bf16*)(C.ws + WS_KCMP);
#pragma unroll
        for (int r = 0; r < 4; ++r) {
            float ss = 0.f;
#pragma unroll
            for (int nt = 0; nt < 4; ++nt) ss += acc[nt][r] * acc[nt][r];
            ss += __shfl_xor(ss, 1); ss += __shfl_xor(ss, 2); ss += __shfl_xor(ss, 4); ss += __shfl_xor(ss, 8);
            const float rinv = 1.0f / sqrtf(ss * (1.0f / 64.0f) + RMS_EPS);
            float y[4];
#pragma unroll
            for (int nt = 0; nt < 4; ++nt) y[nt] = acc[nt][r] * rinv * gn[nt * 16 + fr];
            const int ri = rt * 16 + 4 * q + r, c = ri & 1023; int pos = 16 * c + 31; pos = pos < SEQ ? pos : SEQ - 1;
            const f32x2* rr = (const f32x2*)(C.ws + WS_ROPE) + (size_t)pos * 32;
            const f32x2 c0 = rr[fr], c1 = rr[16 + fr];
            bf16* o = KC + (size_t)ri * 64;
            o[fr] = (bf16)f2bf(y[0] * c0.x - y[2] * c0.y); o[16 + fr] = (bf16)f2bf(y[1] * c1.x - y[3] * c1.y);
            o[32 + fr] = (bf16)f2bf(y[0] * c0.y + y[2] * c0.x); o[48 + fr] = (bf16)f2bf(y[1] * c1.y + y[3] * c1.x);
        }
    } else {
        bf16* VCT = (bf16*)(C.ws + WS_VCT);
        const int ri0 = rt * 16, bg = ri0 >> 10, c0 = (ri0 & 1023) + 4 * q;
#pragma unroll
        for (int nt = 0; nt < 4; ++nt) { const int d = nt * 16 + fr;
            *(v2u*)(VCT + (size_t)(bg * 64 + d) * 1024 + c0) = (v2u){pk2(acc[nt][0], acc[nt][1]), pk2(acc[nt][2], acc[nt][3])}; }
    }
}

constexpr int NQ = 32;
constexpr int NU_IMP = 0;
constexpr int NU_SEL = 32768;
constexpr int NU_UM = 33792;
constexpr int NU_UL = 33824;
constexpr int NU_KV = 35072;
constexpr int NU_TILE = 18432;
constexpr int NU_END = NU_KV + 4 * NU_TILE;
constexpr float LOG2E = 1.44269504089f;

struct TileSrc { const bf16* k; int kld; const bf16* v; int vld; };

__device__ __forceinline__ void nsa_fetch(const Ctx& C, const TileSrc& ts, bool on, v4u& kr, v4u& vr) {
    const int r = C.tid >> 3, ch = C.tid & 7; (void)on;
    kr = *(const v4u*)(ts.k + (size_t)r * ts.kld + ch * 8); vr = *(const v4u*)(ts.v + (size_t)r * ts.vld + ch * 8);
}
__device__ __forceinline__ void nsa_commit(const Ctx& C, int j, bool on, const v4u& kr, const v4u& vr) {
    LAS bf16* KT = (LAS bf16*)(C.lds + NU_KV + j * NU_TILE); LAS bf16* VT = KT + 64 * 72;
    const int r = C.tid >> 3, ch = C.tid & 7; (void)on;
    *(LAS v4u*)(KT + r * 72 + ch * 8) = kr; *(LAS v4u*)(VT + r * 72 + ch * 8) = vr;
}
__device__ __forceinline__ void nsa_scores(const Ctx& C, int j, const bf16x8 (&qf)[2], f32x4 (&s)[4]) {
    const LAS bf16* KT = (const LAS bf16*)(C.lds + NU_KV + j * NU_TILE);
    const int fr = C.lane & 15, q = C.lane >> 4;
    bf16x8 a[4][2];
#pragma unroll
    for (int kt = 0; kt < 4; ++kt)
#pragma unroll
        for (int ks = 0; ks < 2; ++ks) a[kt][ks] = *(const LAS bf16x8*)(KT + (16 * kt + fr) * 72 + ks * 32 + 8 * q);
#pragma unroll
    for (int kt = 0; kt < 4; ++kt) s[kt] = __builtin_amdgcn_mfma_f32_16x16x32_bf16(a[kt][0], qf[0], (f32x4){0.f, 0.f, 0.f, 0.f}, 0, 0, 0);
#pragma unroll
    for (int kt = 0; kt < 4; ++kt) s[kt] = __builtin_amdgcn_mfma_f32_16x16x32_bf16(a[kt][1], qf[1], s[kt], 0, 0, 0);
}
__device__ __forceinline__ void nsa_vfrag(const Ctx& C, int j, v4u (&vf)[4][2]) {
    const LAS bf16* VT = (const LAS bf16*)(C.lds + NU_KV + j * NU_TILE) + 64 * 72;
    const int fr = C.lane & 15, q = C.lane >> 4;
#pragma unroll
    for (int dt = 0; dt < 4; ++dt)
#pragma unroll
        for (int k2 = 0; k2 < 2; ++k2) { const LAS bf16* vr = VT + (16 * dt + fr) * 72 + 32 * k2 + 4 * q;
            const v2u lo = *(const LAS v2u*)vr, hi = *(const LAS v2u*)(vr + 16); vf[dt][k2] = (v4u){lo.x, lo.y, hi.x, hi.y}; }
}
__device__ __forceinline__ void nsa_pv(const Ctx& C, int j, const f32x4 (&p)[4], f32x4 (&o)[4], const v4u (&vf)[4][2]) {
    bf16x8 pf[2];
#pragma unroll
    for (int k2 = 0; k2 < 2; ++k2) { v4u w; w.x = pk2(p[2 * k2][0], p[2 * k2][1]); w.y = pk2(p[2 * k2][2], p[2 * k2][3]); w.z = pk2(p[2 * k2 + 1][0], p[2 * k2 + 1][1]); w.w = pk2(p[2 * k2 + 1][2], p[2 * k2 + 1][3]);
        pf[k2] = __builtin_bit_cast(bf16x8, w); }
#pragma unroll
    for (int k2 = 0; k2 < 2; ++k2)
#pragma unroll
        for (int dt = 0; dt < 4; ++dt) o[dt] = __builtin_amdgcn_mfma_f32_16x16x32_bf16(__builtin_bit_cast(bf16x8, vf[dt][k2]), pf[k2], o[dt], 0, 0, 0);
}
__device__ __forceinline__ float nsa_exp(f32x4 (&s)[4], float ml2) {
    float ps = 0.f;
#pragma unroll
    for (int kt = 0; kt < 4; ++kt)
#pragma unroll
        for (int r = 0; r < 4; ++r) { const float p = __builtin_amdgcn_exp2f(s[kt][r] * LOG2E - ml2); s[kt][r] = p; ps += p; }
    return ps;
}

__device__ __forceinline__ void nsa_attn_unit(const Ctx& C, int l, int u, bool DRY) {
    const int half = u & 1, bg = (u >> 1) & 3, b = bg >> 1, g = bg & 1;
    const int qb = 255 - (u >> 3);
    const int q0 = 32 * half;
    const int t0 = b * SEQ + qb * 64;
    const int fr = C.lane & 15, q = C.lane >> 4, qq = fr >> 2, hh = fr & 3;
    LAS float* IMP = (LAS float*)(C.lds + NU_IMP);
    LAS unsigned long long* SEL = (LAS unsigned long long*)(C.lds + NU_SEL);
    LAS unsigned long long* UM = (LAS unsigned long long*)(C.lds + NU_UM);
    LAS int* UL = (LAS int*)(C.lds + NU_UL);
    for (int i = C.tid; i < NQ * 256; i += NTHR) IMP[i] = 0.f;
    float mc2, ms2, mw2;
    { const float* gn = C.in(11) + (size_t)l * 256;
      const float gq = wave_max(fabsf(gn[C.lane])), g1 = wave_max(fabsf(gn[64 + C.lane])), g2 = wave_max(fabsf(gn[128 + C.lane])), g3 = wave_max(fabsf(gn[192 + C.lane]));
      mc2 = 8.0f * gq * g1 * LOG2E; ms2 = 8.0f * gq * g2 * LOG2E; mw2 = 8.0f * gq * g3 * LOG2E; }
    bf16* QB = (bf16*)(C.ws + WS_QB);
    const int iq = q0 + 4 * C.wave + qq;
    bf16x8 qf[2]; float gate[3];
    { const bf16* qp = QB + (size_t)(t0 + iq) * 512 + (g * 4 + hh) * 64 + 8 * q;
      qf[0] = *(const bf16x8*)qp; qf[1] = *(const bf16x8*)(qp + 32);
      const float* sm = (const float*)(C.ws + WS_SMALL) + (size_t)(t0 + iq) * 64 + 16 + (g * 4 + hh) * 3;
#pragma unroll
      for (int k = 0; k < 3; ++k) gate[k] = ((ABL_ZERO & 2) || (ABL_ZERO & (8 << k))) ? 0.f : SCL_B * sigmoidf_(sm[k]); }
    f32x4 out[4];
#pragma unroll
    for (int dt = 0; dt < 4; ++dt) out[dt] = (f32x4){0.f, 0.f, 0.f, 0.f};
    v4u kr[4], vr[4];

    const bf16* KC = (const bf16*)(C.ws + WS_KCMP) + (size_t)bg * 1024 * 64;
    const bf16* VCT = (const bf16*)(C.ws + WS_VCT) + (size_t)bg * 64 * 1024;
    const int nct = (4 * qb + 3 + 63) >> 6, ncs = (nct + 3) >> 2;
    const int cmax = (64 * qb + iq - 31) >> 4, cmin = (64 * qb + q0 + 4 * C.wave - 31) >> 4;
    float cl = 0.f, cinv = 0.f;
    for (int rep = (TIMEDUP & 2048) ? 0 : 1; rep < 2; ++rep) { cl = 0.f;
    for (int pass = 0; pass < 2; ++pass) {
        f32x4 ao[4];
#pragma unroll
        for (int dt = 0; dt < 4; ++dt) ao[dt] = (f32x4){0.f, 0.f, 0.f, 0.f};
        if (pass == 1) { float lt = cl; lt += __shfl_xor(lt, 16); lt += __shfl_xor(lt, 32); cinv = lt > 0.f ? 1.0f / lt : 0.f; }
#pragma unroll
        for (int j = 0; j < 4; ++j) { const int tl = j < nct ? j : nct - 1; const TileSrc ts{KC + (size_t)tl * 64 * 64, 64, VCT + tl * 64, 1024}; nsa_fetch(C, ts, true, kr[j], vr[j]); }
        for (int st = 0; st < ncs; ++st) {
            __syncthreads();
#pragma unroll
            for (int j = 0; j < 4; ++j) nsa_commit(C, j, 4 * st + j < nct, kr[j], vr[j]);
            __syncthreads();
            if (st + 1 < ncs) {
#pragma unroll
                for (int j = 0; j < 4; ++j) { const int t4 = 4 * (st + 1) + j, tl = t4 < nct ? t4 : nct - 1; const TileSrc ts{KC + (size_t)tl * 64 * 64, 64, VCT + tl * 64, 1024}; nsa_fetch(C, ts, true, kr[j], vr[j]); }
            }
#pragma unroll
            for (int j = 0; j < 4; ++j) {
                const int tl = 4 * st + j;
                if (tl < nct) {
                    f32x4 s[4]; v4u vf[4][2]; nsa_scores(C, j, qf, s); if (pass == 1) nsa_vfrag(C, j, vf);
                    if (64 * tl + 63 > cmin) {
#pragma unroll
                    for (int kt = 0; kt < 4; ++kt)
#pragma unroll
                        for (int r = 0; r < 4; ++r) { const int c = 64 * tl + 16 * kt + 4 * q + r; if (c > cmax) s[kt][r] = -INFINITY; }
                    }
                    const float ps = nsa_exp(s, mc2);
                    if (pass == 0) cl += ps;
                    else {
#pragma unroll
                        for (int kt = 0; kt < 4; ++kt) {
#pragma unroll
                            for (int r = 0; r < 4; ++r) s[kt][r] *= cinv;
                            float gs = (s[kt][0] + s[kt][1]) + (s[kt][2] + s[kt][3]), es = s[kt][3];
                            gs += __shfl_xor(gs, 1); gs += __shfl_xor(gs, 2); es += __shfl_xor(es, 1); es += __shfl_xor(es, 2);
                            if (hh == 0) { const int n = 16 * tl + 4 * kt + q;
                                if (n < 256) { atomicAdd((float*)(IMP + (iq - q0) * 256 + n), gs); if (n + 1 < 256) atomicAdd((float*)(IMP + (iq - q0) * 256 + n + 1), es); } }
                        }
                        nsa_pv(C, j, s, ao, vf);
                    }
                }
            }
        }
        if (pass == 1) {
#pragma unroll
            for (int dt = 0; dt < 4; ++dt) out[dt] += ao[dt] * (rep == 1 ? gate[0] : 0.f);
        }
        __syncthreads();
    } }

    for (int rep = (TIMEDUP & 256) ? 0 : 1; rep < 2; ++rep) {
        unsigned key[4][4]; unsigned long long selw[4][4];
        const int nforced = qb >= 2 ? 3 : qb + 1; const int ncand = qb + 1 - nforced;
        int need = 16 - nforced; if (need > ncand) need = ncand;
#pragma unroll
        for (int k4 = 0; k4 < 4; ++k4)
#pragma unroll
            for (int k = 0; k < 4; ++k) { const int n = C.lane + 64 * k; const bool valid = n <= qb; const bool forced = valid && (n == 0 || n == qb || n == qb - 1);
                key[k4][k] = (valid && !forced) ? (__builtin_bit_cast(unsigned, fmaxf(IMP[(4 * C.wave + k4) * 256 + n], 0.f)) + 1u) : 0u;
                selw[k4][k] = __ballot(forced); }
        if (need == ncand) {
#pragma unroll
            for (int k4 = 0; k4 < 4; ++k4)
#pragma unroll
                for (int k = 0; k < 4; ++k) selw[k4][k] |= __ballot(key[k4][k] != 0u);
        } else {
            unsigned thr[4] = {0u, 0u, 0u, 0u};
            for (int bit = 31; bit >= 12; --bit) {
#pragma unroll
                for (int k4 = 0; k4 < 4; ++k4) { const unsigned cand = thr[k4] | (1u << bit); int cnt = 0;
#pragma unroll
                    for (int k = 0; k < 4; ++k) cnt += __builtin_popcountll(__ballot(key[k4][k] >= cand));
                    if (cnt >= need) thr[k4] = cand; } }
#pragma unroll
            for (int k4 = 0; k4 < 4; ++k4) { int left = need; const unsigned hi = thr[k4] + 0xfffu;
#pragma unroll
                for (int k = 0; k < 4; ++k) { const unsigned long long gt = __ballot(key[k4][k] > hi); selw[k4][k] |= gt; left -= __builtin_popcountll(gt); }
#pragma unroll
                for (int k = 0; k < 4; ++k) { unsigned long long eq = __ballot(key[k4][k] != 0u && key[k4][k] >= thr[k4] && key[k4][k] <= hi);
                    while (left > 0 && eq) { const unsigned long long low = eq & (0ull - eq); selw[k4][k] |= low; eq ^= low; --left; } } }
        }
#pragma unroll
        for (int k4 = 0; k4 < 4; ++k4)
            if (C.lane < 4) SEL[(4 * C.wave + k4) * 4 + C.lane] = C.lane == 0 ? selw[k4][0] : C.lane == 1 ? selw[k4][1] : C.lane == 2 ? selw[k4][2] : selw[k4][3];
    }
    __syncthreads();
    if (C.tid < 4) { unsigned long long um = 0ull; for (int i = 0; i < NQ; ++i) um |= SEL[i * 4 + C.tid]; UM[C.tid] = um; }
    __syncthreads();
    int ucnt;
    {
        const unsigned long long u0 = UM[0], u1 = UM[1], u2 = UM[2], u3 = UM[3];
        const int c0 = __builtin_popcountll(u0), c1 = __builtin_popcountll(u1), c2 = __builtin_popcountll(u2), c3 = __builtin_popcountll(u3);
        ucnt = c0 + c1 + c2 + c3;
        if (C.tid < 256) { const int w = C.tid >> 6, bit = C.tid & 63; const unsigned long long uw = w == 0 ? u0 : w == 1 ? u1 : w == 2 ? u2 : u3;
            if ((uw >> bit) & 1ull) { const int pos = (w > 0 ? c0 : 0) + (w > 1 ? c1 : 0) + (w > 2 ? c2 : 0) + __builtin_popcountll(uw & ((1ull << bit) - 1ull)); UL[pos] = C.tid; } }
    }
    __syncthreads();

    for (int rep = (TIMEDUP & 1024) ? 0 : 1; rep < 2; ++rep) {
        f32x4 ao[4]; float al = 0.f;
#pragma unroll
        for (int dt = 0; dt < 4; ++dt) ao[dt] = (f32x4){0.f, 0.f, 0.f, 0.f};
        const bf16* KS = (const bf16*)(C.ws + WS_KVS) + (size_t)(b * SEQ) * 256 + g * 64;
        const bf16* VST = (const bf16*)(C.ws + WS_VST) + (size_t)bg * 256 * 4096;
        const int nss = (ucnt + 3) >> 2;
        const unsigned long long my0 = SEL[(iq - q0) * 4 + 0], my1 = SEL[(iq - q0) * 4 + 1], my2 = SEL[(iq - q0) * 4 + 2], my3 = SEL[(iq - q0) * 4 + 3];
#define SLC_FETCH(STG, KR, VR) do { _Pragma("unroll") for (int j = 0; j < 4; ++j) { const int ix = 4 * (STG) + j; const int n = ix < ucnt ? UL[ix] : 0; \
            const TileSrc ts{KS + (size_t)n * 64 * 256, 256, VST + (size_t)n * 4096, 64}; nsa_fetch(C, ts, ix < ucnt, KR[j], VR[j]); } } while (0)
#define SLC_STAGE(STG, KR, VR) do { \
            __syncthreads(); \
            _Pragma("unroll") for (int j = 0; j < 4; ++j) nsa_commit(C, j, 4 * (STG) + j < ucnt, KR[j], VR[j]); \
            __syncthreads(); \
            if ((STG) + 1 < nss) SLC_FETCH((STG) + 1, KR, VR); \
            _Pragma("unroll") for (int j = 0; j < 4; ++j) { \
                const int ix = 4 * (STG) + j; \
                if (ix < ucnt) { \
                    const int n = UL[ix]; \
                    const unsigned long long mw = (n >> 6) == 0 ? my0 : (n >> 6) == 1 ? my1 : (n >> 6) == 2 ? my2 : my3; \
                    const bool mysel = (mw >> (n & 63)) & 1ull; \
                    if (__ballot(mysel) != 0ull) { \
                        f32x4 s[4]; v4u vf[4][2]; nsa_scores(C, j, qf, s); nsa_vfrag(C, j, vf); \
                        if (n == qb) { _Pragma("unroll") for (int kt = 0; kt < 4; ++kt) _Pragma("unroll") for (int r = 0; r < 4; ++r) { const int key = 16 * kt + 4 * q + r; if (key > iq) s[kt][r] = -INFINITY; } } \
                        al += nsa_exp(s, mysel ? ms2 : INFINITY); \
                        nsa_pv(C, j, s, ao, vf); \
                    } } } } while (0)
        SLC_FETCH(0, kr, vr);
        for (int st = 0; st < nss; ++st) SLC_STAGE(st, kr, vr);
#undef SLC_FETCH
#undef SLC_STAGE
        float lt = al; lt += __shfl_xor(lt, 16); lt += __shfl_xor(lt, 32); const float inv = (lt > 0.f && rep == 1) ? gate[1] / lt : 0.f;
#pragma unroll
        for (int dt = 0; dt < 4; ++dt) out[dt] += ao[dt] * inv;
    }
    for (int rep = (TIMEDUP & 512) ? 0 : 1; rep < 2; ++rep) {
        f32x4 ao[4]; float al = 0.f;
#pragma unroll
        for (int dt = 0; dt < 4; ++dt) ao[dt] = (f32x4){0.f, 0.f, 0.f, 0.f};
        const bf16* KW = (const bf16*)(C.ws + WS_KVW) + (size_t)(b * SEQ) * 256 + g * 64;
        const bf16* VWT = (const bf16*)(C.ws + WS_VWT) + (size_t)bg * 256 * 4096;
        const int nfirst = qb >= 8 ? qb - 8 : 0, nw = qb - nfirst + 1, nws = (nw + 3) >> 2;
#pragma unroll
        for (int j = 0; j < 4; ++j) { const int n = nfirst + (j < nw ? j : 0); const TileSrc ts{KW + (size_t)n * 64 * 256, 256, VWT + (size_t)n * 4096, 64}; nsa_fetch(C, ts, true, kr[j], vr[j]); }
        for (int st = 0; st < nws; ++st) {
            __syncthreads();
#pragma unroll
            for (int j = 0; j < 4; ++j) nsa_commit(C, j, 4 * st + j < nw, kr[j], vr[j]);
            __syncthreads();
            if (st + 1 < nws) {
#pragma unroll
                for (int j = 0; j < 4; ++j) { const int ix = 4 * (st + 1) + j; const int n = nfirst + (ix < nw ? ix : 0); const TileSrc ts{KW + (size_t)n * 64 * 256, 256, VWT + (size_t)n * 4096, 64}; nsa_fetch(C, ts, ix < nw, kr[j], vr[j]); }
            }
#pragma unroll
            for (int j = 0; j < 4; ++j) {
                const int ix = 4 * st + j;
                if (ix < nw) {
                    const int delta = qb - (nfirst + ix);
                    f32x4 s[4]; v4u vf[4][2]; nsa_scores(C, j, qf, s); nsa_vfrag(C, j, vf);
                    if (delta == 0 || delta == 8) {
#pragma unroll
                        for (int kt = 0; kt < 4; ++kt)
#pragma unroll
                            for (int r = 0; r < 4; ++r) { const int key = 16 * kt + 4 * q + r; const bool ok = delta == 0 ? (key <= iq) : (key > iq); if (!ok) s[kt][r] = -INFINITY; }
                    }
                    al += nsa_exp(s, mw2);
                    nsa_pv(C, j, s, ao, vf);
                }
            }
        }
        float lt = al; lt += __shfl_xor(lt, 16); lt += __shfl_xor(lt, 32); const float inv = (lt > 0.f && rep == 1) ? gate[2] / lt : 0.f;
#pragma unroll
        for (int dt = 0; dt < 4; ++dt) out[dt] += ao[dt] * inv;
    }
    if (DRY) {
#pragma unroll
      for (int dt = 0; dt < 4; ++dt) asm volatile("" :: "v"(out[dt]));
    } else { bf16* op = QB + (size_t)(t0 + iq) * 512 + (g * 4 + hh) * 64 + 4 * q;
#pragma unroll
      for (int dt = 0; dt < 4; ++dt) *(v2u*)(op + 16 * dt) = (v2u){pk2(out[dt][0], out[dt][1]), pk2(out[dt][2], out[dt][3])}; }
    __syncthreads();
}


constexpr int N6_IMP = 0;
constexpr int N6_KVC = 65536;
constexpr int N6_SEL = 120832;
constexpr int N6_UM = 122880;
constexpr int N6_UL = 122912;
constexpr int N6_KV = 0;

__device__ __forceinline__ void n6_commit(const Ctx& C, int base, int j, const v4u& kr, const v4u& vr) {
    LAS bf16* KT = (LAS bf16*)(C.lds + base + j * NU_TILE); LAS bf16* VT = KT + 64 * 72;
    const int r = C.tid >> 3, ch = C.tid & 7;
    *(LAS v4u*)(KT + r * 72 + ch * 8) = kr; *(LAS v4u*)(VT + r * 72 + ch * 8) = vr;
}
__device__ __forceinline__ void n6_kfrag(const Ctx& C, int toff, bf16x8 (&a)[4][2]) {
    const LAS bf16* KT = (const LAS bf16*)(C.lds + toff);
    const int fr = C.lane & 15, q = C.lane >> 4;
#pragma unroll
    for (int kt = 0; kt < 4; ++kt)
#pragma unroll
        for (int ks = 0; ks < 2; ++ks) a[kt][ks] = *(const LAS bf16x8*)(KT + (16 * kt + fr) * 72 + ks * 32 + 8 * q);
}
__device__ __forceinline__ void n6_vfrag(const Ctx& C, int toff, v4u (&vf)[4][2]) {
    const LAS bf16* VT = (const LAS bf16*)(C.lds + toff) + 64 * 72;
    const int fr = C.lane & 15, q = C.lane >> 4;
#pragma unroll
    for (int dt = 0; dt < 4; ++dt)
#pragma unroll
        for (int k2 = 0; k2 < 2; ++k2) { const LAS bf16* vr = VT + (16 * dt + fr) * 72 + 32 * k2 + 4 * q;
            const v2u lo = *(const LAS v2u*)vr, hi = *(const LAS v2u*)(vr + 16); vf[dt][k2] = (v4u){lo.x, lo.y, hi.x, hi.y}; }
}
__device__ __forceinline__ void n6_scores(const bf16x8 (&a)[4][2], const bf16x8 (&qf)[2], f32x4 (&s)[4]) {
#pragma unroll
    for (int kt = 0; kt < 4; ++kt) s[kt] = __builtin_amdgcn_mfma_f32_16x16x32_bf16(a[kt][0], qf[0], (f32x4){0.f, 0.f, 0.f, 0.f}, 0, 0, 0);
#pragma unroll
    for (int kt = 0; kt < 4; ++kt) s[kt] = __builtin_amdgcn_mfma_f32_16x16x32_bf16(a[kt][1], qf[1], s[kt], 0, 0, 0);
}

__device__ __forceinline__ void nsa_attn_unit64(const Ctx& C, int l, int u, bool DRY) {
    const int bg = u & 3, b = bg >> 1, g = bg & 1, qb = 255 - (u >> 2);
    const int t0 = b * SEQ + qb * 64;
    const int fr = C.lane & 15, q = C.lane >> 4, qq = fr >> 2, hh = fr & 3;
    LAS float* IMP = (LAS float*)(C.lds + N6_IMP);
    LAS unsigned long long* SEL = (LAS unsigned long long*)(C.lds + N6_SEL);
    LAS unsigned long long* UM = (LAS unsigned long long*)(C.lds + N6_UM);
    LAS int* UL = (LAS int*)(C.lds + N6_UL);
    for (int i = C.tid; i < 64 * 256; i += NTHR) IMP[i] = 0.f;
    float mc2, ms2, mw2;
    { const float* gn = C.in(11) + (size_t)l * 256;
      const float gq = wave_max(fabsf(gn[C.lane])), g1 = wave_max(fabsf(gn[64 + C.lane])), g2 = wave_max(fabsf(gn[128 + C.lane])), g3 = wave_max(fabsf(gn[192 + C.lane]));
      mc2 = 8.0f * gq * g1 * LOG2E; ms2 = 8.0f * gq * g2 * LOG2E; mw2 = 8.0f * gq * g3 * LOG2E; }
    bf16* QB = (bf16*)(C.ws + WS_QB);
    const int iq0 = 8 * C.wave + qq;
    bf16x8 qf[2][2]; float gate[2][3];
#pragma unroll
    for (int ct = 0; ct < 2; ++ct) {
        const bf16* qp = QB + (size_t)(t0 + iq0 + 4 * ct) * 512 + (g * 4 + hh) * 64 + 8 * q;
        qf[ct][0] = *(const bf16x8*)qp; qf[ct][1] = *(const bf16x8*)(qp + 32);
        const float* sm = (const float*)(C.ws + WS_SMALL) + (size_t)(t0 + iq0 + 4 * ct) * 64 + 16 + (g * 4 + hh) * 3;
#pragma unroll
        for (int k = 0; k < 3; ++k) gate[ct][k] = sigmoidf_(sm[k]); }
#define N6_ACCUM(ct, ao, scale, first) do { bf16* op_ = QB + (size_t)(t0 + iq0 + 4 * (ct)) * 512 + (g * 4 + hh) * 64 + 4 * q; \
        _Pragma("unroll") for (int dt = 0; dt < 4; ++dt) { f32x4 v_ = (ao)[dt] * (scale); \
            if (!(first)) { const v2u o_ = *(const v2u*)(op_ + 16 * dt); v_[0] += bflo(o_.x); v_[1] += bfhi(o_.x); v_[2] += bflo(o_.y); v_[3] += bfhi(o_.y); } \
            if (DRY) asm volatile("" :: "v"(v_)); else *(v2u*)(op_ + 16 * dt) = (v2u){pk2(v_[0], v_[1]), pk2(v_[2], v_[3])}; } } while (0)
    v4u kr[4], vr[4];
    const int r8 = C.tid >> 3, ch8 = C.tid & 7;
#define N6_FETCH(j, kptr, kld, vptr, vld) do { kr[j] = *(const v4u*)((kptr) + (size_t)r8 * (kld) + ch8 * 8); vr[j] = *(const v4u*)((vptr) + (size_t)r8 * (vld) + ch8 * 8); } while (0)

    const bf16* KC = (const bf16*)(C.ws + WS_KCMP) + (size_t)bg * 1024 * 64;
    const bf16* VCT = (const bf16*)(C.ws + WS_VCT) + (size_t)bg * 64 * 1024;
    const int nct = (4 * qb + 3 + 63) >> 6, ncs = (nct + 2) / 3;
    const int cmin = (64 * qb + 8 * C.wave - 31) >> 4;
    float cl[2] = {0.f, 0.f}, cinv[2] = {0.f, 0.f};
    for (int pass = 0; pass < 2; ++pass) {
        f32x4 ao[2][4];
#pragma unroll
        for (int ct = 0; ct < 2; ++ct)
#pragma unroll
            for (int dt = 0; dt < 4; ++dt) ao[ct][dt] = (f32x4){0.f, 0.f, 0.f, 0.f};
        if (pass == 1) {
#pragma unroll
            for (int ct = 0; ct < 2; ++ct) { float lt = cl[ct]; lt += __shfl_xor(lt, 16); lt += __shfl_xor(lt, 32); cinv[ct] = lt > 0.f ? 1.0f / lt : 0.f; } }
#pragma unroll
        for (int j = 0; j < 3; ++j) { const int tl = j < nct ? j : nct - 1; N6_FETCH(j, KC + (size_t)tl * 64 * 64, 64, VCT + tl * 64, 1024); }
        for (int st = 0; st < ncs; ++st) {
            __syncthreads();
#pragma unroll
            for (int j = 0; j < 3; ++j) n6_commit(C, N6_KVC, j, kr[j], vr[j]);
            __syncthreads();
            if (st + 1 < ncs) {
#pragma unroll
                for (int j = 0; j < 3; ++j) { const int t3 = 3 * (st + 1) + j, tl = t3 < nct ? t3 : nct - 1; N6_FETCH(j, KC + (size_t)tl * 64 * 64, 64, VCT + tl * 64, 1024); } }
#pragma unroll 1
            for (int j = 0; j < 3; ++j) {
                const int tl = 3 * st + j;
                if (tl < nct) {
                    const int toff = N6_KVC + j * NU_TILE;
                    bf16x8 a[4][2]; v4u vf[4][2]; n6_kfrag(C, toff, a); if (pass == 1) n6_vfrag(C, toff, vf);
#pragma unroll
                    for (int ct = 0; ct < 2; ++ct) {
                        f32x4 s[4]; n6_scores(a, qf[ct], s);
                        if (64 * tl + 63 > cmin) { const int cmax = (64 * qb + iq0 + 4 * ct - 31) >> 4;
#pragma unroll
                            for (int kt = 0; kt < 4; ++kt)
#pragma unroll
                                for (int r = 0; r < 4; ++r) { const int c = 64 * tl + 16 * kt + 4 * q + r; if (c > cmax) s[kt][r] = -INFINITY; } }
                        const float ps = nsa_exp(s, mc2);
                        if (pass == 0) cl[ct] += ps;
                        else {
#pragma unroll
                            for (int kt = 0; kt < 4; ++kt) {
#pragma unroll
                                for (int r = 0; r < 4; ++r) s[kt][r] *= cinv[ct];
                                float gs = (s[kt][0] + s[kt][1]) + (s[kt][2] + s[kt][3]), es = s[kt][3];
                                gs += __shfl_xor(gs, 1); gs += __shfl_xor(gs, 2); es += __shfl_xor(es, 1); es += __shfl_xor(es, 2);
                                if (hh == 0) { const int n = 16 * tl + 4 * kt + q;
                                    if (n < 256) { atomicAdd((float*)(IMP + (iq0 + 4 * ct) * 256 + n), gs); if (n + 1 < 256) atomicAdd((float*)(IMP + (iq0 + 4 * ct) * 256 + n + 1), es); } }
                            }
                            nsa_pv(C, j, s, ao[ct], vf);
                        }
                    }
                }
            }
        }
        if (pass == 1) {
#pragma unroll
            for (int ct = 0; ct < 2; ++ct) N6_ACCUM(ct, ao[ct], gate[ct][0], true); }
        __syncthreads();
    }

    {
        const int nforced = qb >= 2 ? 3 : qb + 1; const int ncand = qb + 1 - nforced;
        int need = 16 - nforced; if (need > ncand) need = ncand;
#pragma unroll 1
        for (int grp = 0; grp < 2; ++grp) {
            unsigned key[4][4]; unsigned long long selw[4][4];
#pragma unroll
            for (int k4 = 0; k4 < 4; ++k4)
#pragma unroll
                for (int k = 0; k < 4; ++k) { const int n = C.lane + 64 * k; const bool valid = n <= qb; const bool forced = valid && (n == 0 || n == qb || n == qb - 1);
                    key[k4][k] = (valid && !forced) ? (__builtin_bit_cast(unsigned, fmaxf(IMP[(8 * C.wave + 4 * grp + k4) * 256 + n], 0.f)) + 1u) : 0u;
                    selw[k4][k] = __ballot(forced); }
            if (need == ncand) {
#pragma unroll
                for (int k4 = 0; k4 < 4; ++k4)
#pragma unroll
                    for (int k = 0; k < 4; ++k) selw[k4][k] |= __ballot(key[k4][k] != 0u);
            } else {
                unsigned thr[4] = {0u, 0u, 0u, 0u};
                for (int bit = 31; bit >= 12; --bit) {
#pragma unroll
                    for (int k4 = 0; k4 < 4; ++k4) { const unsigned cand = thr[k4] | (1u << bit); int cnt = 0;
#pragma unroll
                        for (int k = 0; k < 4; ++k) cnt += __builtin_popcountll(__ballot(key[k4][k] >= cand));
                        if (cnt >= need) thr[k4] = cand; } }
#pragma unroll
                for (int k4 = 0; k4 < 4; ++k4) { int left = need; const unsigned hi = thr[k4] + 0xfffu;
#pragma unroll
                    for (int k = 0; k < 4; ++k) { const unsigned long long gt = __ballot(key[k4][k] > hi); selw[k4][k] |= gt; left -= __builtin_popcountll(gt); }
#pragma unroll
                    for (int k = 0; k < 4; ++k) { unsigned long long eq = __ballot(key[k4][k] != 0u && key[k4][k] >= thr[k4] && key[k4][k] <= hi);
                        while (left > 0 && eq) { const unsigned long long low = eq & (0ull - eq); selw[k4][k] |= low; eq ^= low; --left; } } }
            }
#pragma unroll
            for (int k4 = 0; k4 < 4; ++k4)
                if (C.lane < 4) SEL[(8 * C.wave + 4 * grp + k4) * 4 + C.lane] = C.lane == 0 ? selw[k4][0] : C.lane == 1 ? selw[k4][1] : C.lane == 2 ? selw[k4][2] : selw[k4][3];
        }
    }
    __syncthreads();
    if (C.tid < 4) { unsigned long long um = 0ull; for (int i = 0; i < 64; ++i) um |= SEL[i * 4 + C.tid]; UM[C.tid] = um; }
    __syncthreads();
    int ucnt;
    {
        const unsigned long long u0 = UM[0], u1 = UM[1], u2 = UM[2], u3 = UM[3];
        const int c0 = __builtin_popcountll(u0), c1 = __builtin_popcountll(u1), c2 = __builtin_popcountll(u2), c3 = __builtin_popcountll(u3);
        ucnt = c0 + c1 + c2 + c3;
        if (C.tid < 256) { const int w = C.tid >> 6, bit = C.tid & 63; const unsigned long long uw = w == 0 ? u0 : w == 1 ? u1 : w == 2 ? u2 : u3;
            if ((uw >> bit) & 1ull) { const int pos = (w > 0 ? c0 : 0) + (w > 1 ? c1 : 0) + (w > 2 ? c2 : 0) + __builtin_popcountll(uw & ((1ull << bit) - 1ull)); UL[pos] = C.tid; } }
    }
    __syncthreads();

    {
        f32x4 ao[2][4]; float al[2] = {0.f, 0.f};
#pragma unroll
        for (int ct = 0; ct < 2; ++ct)
#pragma unroll
            for (int dt = 0; dt < 4; ++dt) ao[ct][dt] = (f32x4){0.f, 0.f, 0.f, 0.f};
        const bf16* KS = (const bf16*)(C.ws + WS_KVS) + (size_t)(b * SEQ) * 256 + g * 64;
        const bf16* VST = (const bf16*)(C.ws + WS_VST) + (size_t)bg * 256 * 4096;
        const int nss = (ucnt + 3) >> 2;
#pragma unroll
        for (int j = 0; j < 4; ++j) { const int n = j < ucnt ? UL[j] : 0; N6_FETCH(j, KS + (size_t)n * 64 * 256, 256, VST + (size_t)n * 4096, 64); }
        for (int st = 0; st < nss; ++st) {
            __syncthreads();
#pragma unroll
            for (int j = 0; j < 4; ++j) n6_commit(C, N6_KV, j, kr[j], vr[j]);
            __syncthreads();
            if (st + 1 < nss) {
#pragma unroll
                for (int j = 0; j < 4; ++j) { const int ix = 4 * (st + 1) + j; const int n = ix < ucnt ? UL[ix] : 0; N6_FETCH(j, KS + (size_t)n * 64 * 256, 256, VST + (size_t)n * 4096, 64); } }
#pragma unroll 1
            for (int j = 0; j < 4; ++j) {
                const int ix = 4 * st + j;
                if (ix < ucnt) {
                    const int n = UL[ix];
                    const bool sel0 = (SEL[iq0 * 4 + (n >> 6)] >> (n & 63)) & 1ull, sel1 = (SEL[(iq0 + 4) * 4 + (n >> 6)] >> (n & 63)) & 1ull;
                    const bool act0 = __ballot(sel0) != 0ull, act1 = __ballot(sel1) != 0ull;
                    if (act0 || act1) {
                        const int toff = N6_KV + j * NU_TILE;
                        bf16x8 a[4][2]; v4u vf[4][2]; n6_kfrag(C, toff, a); n6_vfrag(C, toff, vf);
#pragma unroll
                        for (int ct = 0; ct < 2; ++ct) {
                            if (ct == 0 ? act0 : act1) {
                                f32x4 s[4]; n6_scores(a, qf[ct], s);
                                if (n == qb) {
#pragma unroll
                                    for (int kt = 0; kt < 4; ++kt)
#pragma unroll
                                        for (int r = 0; r < 4; ++r) { const int key = 16 * kt + 4 * q + r; if (key > iq0 + 4 * ct) s[kt][r] = -INFINITY; } }
                                al[ct] += nsa_exp(s, (ct == 0 ? sel0 : sel1) ? ms2 : INFINITY);
                                nsa_pv(C, j, s, ao[ct], vf);
                            } }
                    } } }
        }
#pragma unroll
        for (int ct = 0; ct < 2; ++ct) { float lt = al[ct]; lt += __shfl_xor(lt, 16); lt += __shfl_xor(lt, 32); const float inv = lt > 0.f ? gate[ct][1] / lt : 0.f;
            N6_ACCUM(ct, ao[ct], inv, false); }
    }
    {
        f32x4 ao[2][4]; float al[2] = {0.f, 0.f};
#pragma unroll
        for (int ct = 0; ct < 2; ++ct)
#pragma unroll
            for (int dt = 0; dt < 4; ++dt) ao[ct][dt] = (f32x4){0.f, 0.f, 0.f, 0.f};
        const bf16* KW = (const bf16*)(C.ws + WS_KVW) + (size_t)(b * SEQ) * 256 + g * 64;
        const bf16* VWT = (const bf16*)(C.ws + WS_VWT) + (size_t)bg * 256 * 4096;
        const int nfirst = qb >= 8 ? qb - 8 : 0, nw = qb - nfirst + 1, nws = (nw + 3) >> 2;
#pragma unroll
        for (int j = 0; j < 4; ++j) { const int n = nfirst + (j < nw ? j : 0); N6_FETCH(j, KW + (size_t)n * 64 * 256, 256, VWT + (size_t)n * 4096, 64); }
        for (int st = 0; st < nws; ++st) {
            __syncthreads();
#pragma unroll
            for (int j = 0; j < 4; ++j) n6_commit(C, N6_KV, j, kr[j], vr[j]);
            __syncthreads();
            if (st + 1 < nws) {
#pragma unroll
                for (int j = 0; j < 4; ++j) { const int ix = 4 * (st + 1) + j; const int n = nfirst + (ix < nw ? ix : 0); N6_FETCH(j, KW + (size_t)n * 64 * 256, 256, VWT + (size_t)n * 4096, 64); } }
#pragma unroll 1
            for (int j = 0; j < 4; ++j) {
                const int ix = 4 * st + j;
                if (ix < nw) {
                    const int delta = qb - (nfirst + ix); const int toff = N6_KV + j * NU_TILE;
                    bf16x8 a[4][2]; v4u vf[4][2]; n6_kfrag(C, toff, a); n6_vfrag(C, toff, vf);
#pragma unroll
                    for (int ct = 0; ct < 2; ++ct) {
                        f32x4 s[4]; n6_scores(a, qf[ct], s);
                        if (delta == 0 || delta == 8) {
#pragma unroll
                            for (int kt = 0; kt < 4; ++kt)
#pragma unroll
                                for (int r = 0; r < 4; ++r) { const int key = 16 * kt + 4 * q + r; const bool ok = delta == 0 ? (key <= iq0 + 4 * ct) : (key > iq0 + 4 * ct); if (!ok) s[kt][r] = -INFINITY; } }
                        al[ct] += nsa_exp(s, mw2);
                        nsa_pv(C, j, s, ao[ct], vf);
                    }
                }
            }
        }
#pragma unroll
        for (int ct = 0; ct < 2; ++ct) { float lt = al[ct]; lt += __shfl_xor(lt, 16); lt += __shfl_xor(lt, 32); const float inv = lt > 0.f ? gate[ct][2] / lt : 0.f;
            N6_ACCUM(ct, ao[ct], inv, false); }
    }
#undef N6_FETCH
#undef N6_ACCUM
    __syncthreads();
}

__device__ __forceinline__ void phase_mix1(const Ctx& C, int l) {
    const int gw = C.bid * NWAVES + C.wave, NGW = C.G * NWAVES;
    for (int rep = (TIMEDUP & 32) ? 0 : 1; rep < 2; ++rep) {
    for (int un = C.bid; un < 256; un += C.G) nsa_cmp1_unit(C, un);
    for (int it = gw; it < 2048; it += NGW) nsa_vtrans_item(C, it); }
    for (int rep = (TIMEDUP & 262144) ? 0 : 1; rep < 2; ++rep) for (int tp = gw; tp < T / 2; tp += NGW) nsa_prep_token(C, l, tp, rep == 0);
    gla_stage_alpha(C, l);
    __syncthreads();
    for (int rep = (TIMEDUP & 16) ? 0 : 1; rep < 2; ++rep) for (int u = C.bid; u < 4096; u += C.G) { if (u < 2048) gla_unit_a(C, l, u); else mlstm_unit_a(C, l, u - 2048); }
}
__device__ __forceinline__ void phase_mix2(const Ctx& C, int l) {
    const int gw = C.bid * NWAVES + C.wave, NGW = C.G * NWAVES;
    for (int rep = (TIMEDUP & 1048576) ? 0 : 1; rep < 2; ++rep) for (int it = gw; it < 512; it += NGW) nsa_cmp2_item(C, l, it);
    for (int rep = (TIMEDUP & 524288) ? 0 : 1; rep < 2; ++rep) phase_scan(C, rep == 0);
}
__device__ __forceinline__ void phase_mix3(const Ctx& C, int l) {
    for (int rep = (TIMEDUP & 1) ? 0 : 1; rep < 2; ++rep) for (int i = C.bid; i < 1024; i += C.G) {
        const_cast<Ctx&>(C).launder();
        const int r = i / C.G, w = i % C.G; const int pos = (r & 1) ? (1023 - ((r >> 1) * C.G + w)) : ((r >> 1) * C.G + w);
        nsa_attn_unit64(C, l, pos, rep == 0); }
    const_cast<Ctx&>(C).launder(); const Ctx& D = C;
    gla_stage_alpha(D, l);
    for (int rep = (TIMEDUP & 2) ? 0 : 1; rep < 2; ++rep) for (int u = D.bid; u < 4096; u += D.G) { if (u < 2048) gla_unit_c(D, l, u, rep == 0); else mlstm_unit_c(D, l, u - 2048, rep == 0); }
}

constexpr int MIX_PHASES = 10;
#define MIXER_PHASES \
    if (PH_ON) for (int rep = (TIMEDUP & 131072) ? 0 : 1; rep < 2; ++rep) phase_norm(C, C.in(5) + (size_t)l * DM, C.X); \
    PH_END; \
    if (PH_ON) { \
        pg8::Gemm g{(const bf16*)(C.ws + WS_XN), (const bf16*)(C.ws + WS_WIN), T, 4608, DM}; \
        pg8::StaticOrder S; S.init(T, 4608, C.G, C.bid); \
        pg8::EpiWin E{C.ws + WS_R, (const float*)(C.ws + WS_VEC) + VEC_BINP, (float*)(C.ws + WS_SMALL)}; \
        for (int rep = (TIMEDUP & 64) ? 0 : 1; rep < 2; ++rep) pg8::gemm_phase<pg8::EpiWin, pg8::StaticOrder, false>(C.lds, g, S, E, nullptr); \
    } \
    PH_END; \
    if (PH_ON) phase_mix1(C, l); \
    PH_END; \
    if (PH_ON) phase_mix2(C, l); \
    PH_END; \
    if (PH_ON) phase_mix3(C, l); \
    PH_END; \
    if (PH_ON) { \
        pg8::Gemm g{(const bf16*)(C.ws + WS_XN), (const bf16*)(C.ws + WS_WGT), T, 3 * DM, DM}; \
        pg8::StaticOrder S; S.init(T, 3 * DM, C.G, C.bid); \
        pg8::EpiGate E{C.ws, DM, C.in(7) + (size_t)l * N_IN + 4400}; \
        for (int rep = (TIMEDUP & 16384) ? 0 : 1; rep < 2; ++rep) pg8::gemm_phase<pg8::EpiGate, pg8::StaticOrder, false>(C.lds, g, S, E, nullptr); \
    } \
    PH_END; \
    for (int br = 0; br < 3; ++br) { \
        if (PH_ON) { \
            const bf16* Asrc = (const bf16*)(C.ws + (br == 0 ? WS_RA : br == 1 ? WS_QB : WS_OC)); \
            pg8::Gemm g{Asrc, (const bf16*)(C.ws + WS_WBR) + (size_t)br * DM * 512, T, DM, 512}; \
            pg8::StaticOrder S; S.init(T, DM, C.G, C.bid); \
            for (int rep = (TIMEDUP & 32768) ? 0 : 1; rep < 2; ++rep) { \
            pg8::EpiBranch E{(bf16*)(C.ws + WS_Y), (const bf16*)(C.ws + WS_G0 + (size_t)(br >= 1) * (WS_G1 - WS_G0) + (size_t)(br >= 2) * (WS_G2 - WS_G1)), DM, rep == 0 ? 2 : (br == 0 ? 1 : 0)}; \
            pg8::gemm_phase<pg8::EpiBranch, pg8::StaticOrder, false>(C.lds, g, S, E, nullptr); } \
        } \
        PH_END; \
    } \
    if (PH_ON) { \
        pg8::Gemm g{(const bf16*)(C.ws + WS_Y), (const bf16*)(C.ws + WS_WOUT), T, DM, DM}; \
        pg8::StaticOrder S; S.init(T, DM, C.G, C.bid); \
        for (int rep = (TIMEDUP & 65536) ? 0 : 1; rep < 2; ++rep) { \
        pg8::EpiResid E{C.X, DM, rep == 1 ? 1.0f : 0.f, C.X}; \
        pg8::gemm_phase<pg8::EpiResid, pg8::StaticOrder, false>(C.lds, g, S, E, nullptr); } \
    } \
    PH_END;

constexpr int N_PHASES = 8 * 3 + 4 * MIX_PHASES;

__global__ void __launch_bounds__(NTHR, 2) hybrid_fwd(Args args) {
    extern __shared__ __attribute__((aligned(16))) unsigned char lds_raw[];
    Ctx C;
    C.lds = (LAS unsigned char*)lds_raw;
    C.tid = threadIdx.x; C.lane = C.tid & 63; C.wave = __builtin_amdgcn_readfirstlane(C.tid >> 6);
    C.G = gridDim.x; C.bid = blockIdx.x;
    C.inp = (const GAS float* const __attribute__((address_space(4)))*)__builtin_amdgcn_kernarg_segment_ptr();
    C.X = args.out; C.ws = args.ws;
    volatile LAS unsigned* MISC = (volatile LAS unsigned*)(C.lds + MISC_OFF);
    for (int u = C.tid; u < (LDS_BYTES - RING_BYTES) / 4; u += NTHR) ((LAS unsigned*)(C.lds + RING_BYTES))[u] = 0u;
    __syncthreads();
    __builtin_amdgcn_fence(__ATOMIC_ACQUIRE, "agent"); asm volatile("s_waitcnt vmcnt(0)" ::: "memory");
    __syncthreads();
    const int lo = args.ph_lo, hi = args.ph_hi;
    XcdBarrier bar; bar.bar = (unsigned*)(C.ws + WS_CTL) + 4096; bar.x = 0; bar.st = nullptr;
    if (hi - lo > 1) bar = xcd_barrier_post((unsigned*)(C.ws + WS_CTL) + 4096, MISC + 8);
    int pc = 0;
#define PH_ON (C.launder(), pc >= lo && pc < hi)
#define PH_END_NB do { ++pc; } while (0)
#define PH_END do { if (pc >= lo && pc + 1 < hi) { xcd_barrier(bar); if (TIMEDUP & 4096) xcd_barrier(bar); } ++pc; } while (0)

    for (int step = 0; step < 2 * NLAYER; ++step) {
        const int l = step >> 1, f = step & 1;
        if (PH_ON) {
            if (step == 0) phase_init(C);
            if (f == 0) for (int rep = (TIMEDUP & 128) ? 0 : 1; rep < 2; ++rep) phase_prep_weights(C, l);
            for (int rep = (TIMEDUP & 8) ? 0 : 1; rep < 2; ++rep) phase_norm(C, (f ? C.in(19) : C.in(1)) + (size_t)l * DM, step == 0 ? C.in(0) : (const float*)C.X);
        }
        PH_END;
        if (PH_ON) {
            pg8::Gemm g{(const bf16*)(C.ws + WS_XN), (const bf16*)(C.ws + (f ? WS_WGU2 : WS_WGU1)), T, 2 * DFF, DM};
            pg8::StaticOrder S; S.init(T, 2 * DFF, C.G, C.bid);
            for (int rep = (TIMEDUP & (4 | 4194304)) ? 0 : 1; rep < 2; ++rep) {
            pg8::EpiSwiGLU E{(bf16*)(C.ws + WS_HID), DFF, ((TIMEDUP & 4194304) && rep == 0) ? 1 : 0};
            pg8::gemm_phase<pg8::EpiSwiGLU, pg8::StaticOrder, false>(C.lds, g, S, E, nullptr); }
        }
        PH_END;
        if (PH_ON) {
            pg8::Gemm g{(const bf16*)(C.ws + WS_HID), (const bf16*)(C.ws + (f ? WS_WDN2 : WS_WDN1)), T, DM, DFF};
            pg8::StaticOrder S; S.init(T, DM, C.G, C.bid);
            for (int rep = (TIMEDUP & 8192) ? 0 : 1; rep < 2; ++rep) {
            pg8::EpiResid E{C.X, DM, rep == 1 ? 0.5f : 0.f, (step == 0 && !(rep == 1 && (TIMEDUP & 8192))) ? C.in(0) : (const float*)C.X};
            pg8::gemm_phase<pg8::EpiResid, pg8::StaticOrder, false>(C.lds, g, S, E, nullptr); }
        }
        PH_END;
        if (f == 0) {
            MIXER_PHASES
        }
    }
#undef PH_ON
#undef PH_END
#undef PH_END_NB
    asm volatile("s_waitcnt vmcnt(0)" ::: "memory");
    __syncthreads();
    if (C.tid == 0) { __builtin_amdgcn_fence(__ATOMIC_RELEASE, "agent"); asm volatile("s_waitcnt vmcnt(0)" ::: "memory"); }
}

extern "C" void kernel_launch(void* const* d_in, const int* in_sizes, int n_in, void* d_out, int out_size, void* d_ws, size_t ws_size, hipStream_t stream) {
    static int grid = 0;
    if (grid == 0) {
        if (n_in != 23 || out_size != T * DM || ws_size < WS_END) { fprintf(stderr, "kernel_launch: unexpected shapes (n_in %d out %d ws %zu, need %zu)\n", n_in, out_size, ws_size, (size_t)WS_END); grid = -1; return; }
        int dev = 0, cus = 0, per_cu = 0;
        if (hipGetDevice(&dev) != hipSuccess || hipDeviceGetAttribute(&cus, hipDeviceAttributeMultiprocessorCount, dev) != hipSuccess) { grid = -1; return; }
        if (hipFuncSetAttribute((const void*)hybrid_fwd, hipFuncAttributeMaxDynamicSharedMemorySize, LDS_BYTES) != hipSuccess) { fprintf(stderr, "kernel_launch: hipFuncSetAttribute failed\n"); grid = -1; return; }
        if (hipOccupancyMaxActiveBlocksPerMultiprocessor(&per_cu, (const void*)hybrid_fwd, NTHR, LDS_BYTES) != hipSuccess || per_cu < 1) { fprintf(stderr, "kernel_launch: occupancy query says %d blocks per CU\n", per_cu); }
        (void)hipGetLastError();
        grid = cus;
    }
    if (grid < 0) return;
    (void)hipMemsetAsync((char*)d_ws + WS_CTL, 0, CTL_ZERO_BYTES, stream);
    Args a{};
    for (int i = 0; i < 23; ++i) a.in[i] = (const float*)d_in[i];
    a.out = (float*)d_out; a.ws = (unsigned char*)d_ws;
#if ONE_LAUNCH
    a.ph_lo = 0; a.ph_hi = N_PHASES;
    hipLaunchKernelGGL(hybrid_fwd, dim3(grid), dim3(NTHR), LDS_BYTES, stream, a);
#else
    for (int p = 0; p < N_PHASES; ++p) { a.ph_lo = p; a.ph_hi = p + 1; hipLaunchKernelGGL(hybrid_fwd, dim3(grid), dim3(NTHR), LDS_BYTES, stream, a); }
#endif
}
```

```cpp
#include <hip/hip_runtime.h>
#include <cstdio>
#include <cstdint>

#ifndef ABL_ZERO
#define ABL_ZERO 0
#endif
#ifndef SCL_A
#define SCL_A 1.0f
#define SCL_B 1.0f
#define SCL_C 1.0f
#endif
#ifndef TIMEDUP
#define TIMEDUP 0
#endif
#ifndef ONE_LAUNCH
#define ONE_LAUNCH 1
#endif

#define GAS __attribute__((address_space(1)))
#define LAS __attribute__((address_space(3)))
typedef unsigned short bf16;
typedef unsigned v4u __attribute__((ext_vector_type(4)));
typedef unsigned v2u __attribute__((ext_vector_type(2)));
typedef float f32x4 __attribute__((ext_vector_type(4)));
typedef float f32x2 __attribute__((ext_vector_type(2)));
typedef short bf16x8 __attribute__((ext_vector_type(8)));
typedef short bf16x4 __attribute__((ext_vector_type(4)));

constexpr int NB = 2, SEQ = 16384, T = NB * SEQ, DM = 1024, DFF = 2816, NLAYER = 4;
constexpr int N_IN = 7472;
constexpr int NWAVES = 8, NTHR = 512;
constexpr float RMS_EPS = 1e-6f;
constexpr int NCH = SEQ / 64;

constexpr size_t MiB = 1u << 20;
constexpr size_t WS_CTL = 0, CTL_ZERO_BYTES = 1 * MiB;
constexpr size_t WS_ROPE = 1 * MiB;
constexpr size_t WS_VEC = 5 * MiB;
constexpr size_t WS_WGU1 = 6 * MiB;
constexpr size_t WS_WDN1 = 17 * MiB;
constexpr size_t WS_WGU2 = 23 * MiB;
constexpr size_t WS_WDN2 = 34 * MiB;
constexpr size_t WS_WIN = 40 * MiB;
constexpr size_t WS_WGT = 49 * MiB;
constexpr size_t WS_WBR = 55 * MiB;
constexpr size_t WS_WOUT = 58 * MiB;
constexpr size_t WS_CW1 = 60 * MiB;
constexpr size_t WS_CW2 = 62 * MiB;
constexpr size_t WS_XN = 64 * MiB;
constexpr size_t WS_R = 128 * MiB;
constexpr size_t WS_HID = WS_R;
constexpr size_t WS_QKA = WS_R;
constexpr size_t WS_VA = WS_R + 32 * MiB;
constexpr size_t WS_RA = WS_R + 64 * MiB;
constexpr size_t WS_QB = WS_R + 96 * MiB;
constexpr size_t WS_KVC = WS_R + 128 * MiB;
constexpr size_t WS_KVS = WS_R + 144 * MiB;
constexpr size_t WS_KVW = WS_R + 160 * MiB;
constexpr size_t WS_QKC = WS_R + 176 * MiB;
constexpr size_t WS_VC = WS_R + 208 * MiB;
constexpr size_t WS_OC = WS_R + 240 * MiB;
constexpr size_t WS_SMALL = WS_R + 272 * MiB;
constexpr size_t WS_VST = WS_R + 280 * MiB;
constexpr size_t WS_VWT = WS_R + 288 * MiB;
constexpr size_t WS_KCMP = WS_R + 296 * MiB;
constexpr size_t WS_VCT = WS_KCMP + MiB / 2;
constexpr size_t WS_CMPH = WS_R + 297 * MiB;
constexpr size_t WS_GST = WS_R + 302 * MiB;
constexpr size_t WS_GDEC = WS_R + 334 * MiB;
constexpr size_t WS_MSC = WS_GDEC + MiB / 2;
constexpr size_t WS_MST = WS_R + 335 * MiB;
constexpr size_t WS_MN = WS_R + 367 * MiB;
constexpr size_t WS_G0 = WS_QKA, WS_G1 = WS_QKC, WS_G2 = WS_GST;
constexpr size_t WS_G = WS_G0;
constexpr size_t WS_Y = WS_XN;
constexpr size_t WS_END = WS_R + 368 * MiB;

constexpr int VEC_BINP = 0;
constexpr int VEC_CB1 = 8192;

#define LDS_WAIT() asm volatile("s_waitcnt lgkmcnt(0)" ::: "memory")
#define VM_WAIT() asm volatile("s_waitcnt vmcnt(0)" ::: "memory")
__device__ __forceinline__ unsigned f2bf(float f) { unsigned u = __builtin_bit_cast(unsigned, f); return (u + 0x7fffu + ((u >> 16) & 1u)) >> 16; }
typedef __bf16 bf2_t __attribute__((ext_vector_type(2)));
__device__ __forceinline__ unsigned pk2(float lo, float hi) { const f32x2 v = {lo, hi}; return __builtin_bit_cast(unsigned, __builtin_convertvector(v, bf2_t)); }
__device__ __forceinline__ float bf2f(unsigned v) { return __builtin_bit_cast(float, (v & 0xffffu) << 16); }
__device__ __forceinline__ float bflo(unsigned w) { return __builtin_bit_cast(float, w << 16); }
__device__ __forceinline__ float bfhi(unsigned w) { return __builtin_bit_cast(float, w & 0xffff0000u); }
__device__ __forceinline__ float fexp(float x) { return __builtin_amdgcn_exp2f(x * 1.44269504089f); }
__device__ __forceinline__ float sigmoidf_(float x) { return 1.0f / (1.0f + __expf(-x)); }
__device__ __forceinline__ float siluf_(float x) { return x / (1.0f + __expf(-x)); }
__device__ __forceinline__ float logsigmoidf_(float x) { return fminf(x, 0.f) - __logf(1.0f + __expf(-fabsf(x))); }
__device__ __forceinline__ float wave_sum(float v) {
#pragma unroll
    for (int o = 1; o < 64; o <<= 1) v += __shfl_xor(v, o);
    return v;
}
__device__ __forceinline__ float wave_max(float v) {
#pragma unroll
    for (int o = 1; o < 64; o <<= 1) v = fmaxf(v, __shfl_xor(v, o));
    return v;
}

#define XB_TMO      128
#define XB_XCNT(j)  (256  + 64 * (j))
#define XB_XSUB(j)  (1280 + 64 * (j))
#define XB_XGEN(j)  (2304 + 64 * (j))
#define XB_TOP      3328
#define XB_TOPGEN   3392
#define XCD_BAR_WORDS 3456
#define XB_SPIN_CAP (1u << 24)

__device__ __forceinline__ unsigned xb_ld(unsigned* p)              { return __hip_atomic_load(p, __ATOMIC_RELAXED, __HIP_MEMORY_SCOPE_AGENT); }
__device__ __forceinline__ unsigned xb_add(unsigned* p, unsigned v) { return __hip_atomic_fetch_add(p, v, __ATOMIC_RELAXED, __HIP_MEMORY_SCOPE_AGENT); }
__device__ __forceinline__ unsigned xb_xcc_id() { return (unsigned)__builtin_amdgcn_s_getreg((3 << 11) | 20) & 0xFu; }
#define XB_SPIN(cond, bar) do { unsigned _sp = 0; while (cond) { __builtin_amdgcn_s_sleep(1); \
    if ((++_sp & 255u) == 0u) { if (xb_ld(&(bar)[XB_TMO])) break; if (_sp > XB_SPIN_CAP) { atomicAdd(&(bar)[XB_TMO], 1u); break; } } } } while (0)

struct XcdBarrier {
    unsigned* bar; unsigned x;
    volatile LAS unsigned* st;
};
__device__ __forceinline__ XcdBarrier xcd_barrier_post(unsigned* bar, volatile LAS unsigned* st) {
    XcdBarrier b; b.bar = bar; b.x = xb_xcc_id(); b.st = st;
    if (threadIdx.x == 0) (void)xb_add(&bar[XB_XCNT(b.x)], 1u);
    return b;
}
__device__ __forceinline__ void xcd_barrier_complete(unsigned* bar, unsigned x, unsigned& nloc, unsigned& nx) {
    const unsigned G = gridDim.x * gridDim.y * gridDim.z;
    unsigned sum, cnt, mine, sp = 0u;
    for (;;) {
        sum = 0u; cnt = 0u; mine = 0u;
#pragma unroll
        for (unsigned j = 0; j < 16; ++j) { const unsigned c = xb_ld(&bar[XB_XCNT(j)]); sum += c; cnt += (c > 0u) ? 1u : 0u; mine = (j == x) ? c : mine; }
        if (sum == G) break;
        __builtin_amdgcn_s_sleep(1);
        if ((++sp & 255u) == 0u) { if (xb_ld(&bar[XB_TMO])) break; if (sp > XB_SPIN_CAP) { atomicAdd(&bar[XB_TMO], 1u); break; } }
    }
    nloc = mine > 0u ? mine : 1u; nx = cnt > 0u ? cnt : 1u;
}
__device__ __forceinline__ void xcd_barrier(const XcdBarrier& b) {
    asm volatile("s_waitcnt vmcnt(0)" ::: "memory");
    __syncthreads();
    if (threadIdx.x == 0) {
        unsigned* bar = b.bar;
        __builtin_amdgcn_s_waitcnt(0);
        unsigned nloc = b.st[0], nx = b.st[1];
        if (nloc == 0u) { xcd_barrier_complete(bar, b.x, nloc, nx); b.st[0] = nloc; b.st[1] = nx; }
        const unsigned old = xb_add(&bar[XB_XSUB(b.x)], 1u);
        const unsigned gen = old / nloc;
        if (old + 1u == (gen + 1u) * nloc) {
            __builtin_amdgcn_fence(__ATOMIC_RELEASE, "agent");
            asm volatile("s_waitcnt vmcnt(0)" ::: "memory");
            const unsigned og = xb_add(&bar[XB_TOP], 1u);
            const unsigned tg = og / nx;
            if (og + 1u == (tg + 1u) * nx) xb_add(&bar[XB_TOPGEN], 1u);
            else XB_SPIN(xb_ld(&bar[XB_TOPGEN]) == tg, bar);
            __builtin_amdgcn_fence(__ATOMIC_ACQUIRE, "agent");
            xb_add(&bar[XB_XGEN(b.x)], 1u);
            asm volatile("s_waitcnt vmcnt(0)" ::: "memory");
        } else {
            XB_SPIN(xb_ld(&bar[XB_XGEN(b.x)]) == gen, bar);
            __builtin_amdgcn_fence(__ATOMIC_ACQUIRE, "agent");
            asm volatile("s_waitcnt vmcnt(0)" ::: "memory");
        }
    }
    __syncthreads();
}

namespace pg8 {
#define PG8_LAS __attribute__((address_space(3)))
typedef unsigned short bf16_t;
typedef short bf16x8 __attribute__((ext_vector_type(8)));
typedef float f32x4 __attribute__((ext_vector_type(4)));
typedef unsigned u32x4 __attribute__((ext_vector_type(4)));
constexpr int BM = 256, BK = 64, HALF = 128, HTB = HALF * BK * 2  , STAGE_BYTES = 8 * HTB, NXCD = 8, WGM = 8;

__host__ __device__ __forceinline__ int lds_byte(int r, int c) { const int st = (r >> 4) * 2 + (c >> 5), rr = r & 15, cc = c & 31, ob = rr * 64 + cc * 2; return st * 1024 + (ob ^ (((ob >> 9) & 1) << 5)); }
__host__ __device__ __forceinline__ void stage_rc(int b, int& R, int& C) { const int st = b / 1024, sb = b % 1024, swz = sb ^ (((sb >> 9) & 1) << 5); R = (st >> 1) * 16 + swz / 64; C = (st & 1) * 32 + (swz % 64) / 2; }
__host__ __device__ __forceinline__ int perm32(int rho) { const int n = rho >> 4, i = rho & 15; return 8 * (i >> 2) + 4 * n + (i & 3); }

struct Unit { int pm, pn; };
struct Gemm { const bf16_t* A; const bf16_t* Bt; int M, N, K; };

struct StaticOrder {
    int nM, nN, nwg, G, c;
    __host__ __device__ void init(int M, int N, int G_, int c_) { nM = M / BM; nN = N / BM; nwg = nM * nN; G = G_; c = c_; }
    __host__ __device__ bool next(int i, Unit& u) const {
        const long L = (long)i * G + c; if (L >= nwg) return false;
        int wgid = (int)L; { const int q = nwg / NXCD, r = nwg % NXCD, xcd = wgid % NXCD, off = wgid / NXCD; wgid = (xcd < r ? xcd * (q + 1) : r * (q + 1) + (xcd - r) * q) + off; }
        const int nig = WGM * nN, gid = wgid / nig, fm = gid * WGM, gsz = (nM - fm) < WGM ? (nM - fm) : WGM;
        u.pm = fm + ((wgid % nig) % gsz); u.pn = (wgid % nig) / gsz; return true;
    }
    __device__ __forceinline__ void a_ready(const Unit&) const {}
    __device__ __forceinline__ void done(const Unit&) const {}
};
struct CountedOrder : StaticOrder {
    const unsigned* ready; unsigned need; unsigned* tmo;
    __device__ __forceinline__ void a_ready(const Unit& u) const {
        if (threadIdx.x < 64) {
            const unsigned long long t0 = __builtin_amdgcn_s_memrealtime(); unsigned polls = 0;
            while ((unsigned)__builtin_amdgcn_readfirstlane(__hip_atomic_load(ready + 64 * u.pm, __ATOMIC_RELAXED, __HIP_MEMORY_SCOPE_AGENT)) < need) {
                if ((++polls & 255u) == 0u && __builtin_amdgcn_readfirstlane(__hip_atomic_load(tmo, __ATOMIC_RELAXED, __HIP_MEMORY_SCOPE_AGENT)) != 0u) break;
                if (__builtin_amdgcn_s_memrealtime() - t0 > 2000000ull) {
                    if (threadIdx.x == 0) { unsigned expect = 0u; __hip_atomic_compare_exchange_strong(tmo + 1, &expect, 0x600u | (unsigned)(u.pm & 0xff), __ATOMIC_RELAXED, __ATOMIC_RELAXED, __HIP_MEMORY_SCOPE_AGENT); __hip_atomic_store(tmo, 1u, __ATOMIC_RELAXED, __HIP_MEMORY_SCOPE_AGENT); }
                    break; }
                __builtin_amdgcn_s_sleep(2); }
            __builtin_amdgcn_fence(__ATOMIC_ACQUIRE, "agent");
            asm volatile("s_waitcnt vmcnt(0)" ::: "memory");
        }
#if !defined(BROKEN_HOOK_NO_BARRIER)
        asm volatile("" ::: "memory"); __builtin_amdgcn_s_barrier(); asm volatile("" ::: "memory");
#endif
    }
};

__device__ __forceinline__ unsigned cvt_pk_bf16(float lo, float hi) { unsigned r; asm volatile("v_cvt_pk_bf16_f32 %0, %1, %2" : "=v"(r) : "v"(lo), "v"(hi)); return r; }
typedef float f32x2 __attribute__((ext_vector_type(2)));
__device__ __forceinline__ f32x2 gelu_pk(f32x2 v) {
    const f32x2 av = __builtin_elementwise_abs(v), d = av * 0.2316418882f + 1.0f;
    f32x2 t; t.x = __builtin_amdgcn_rcpf(d.x); t.y = __builtin_amdgcn_rcpf(d.y);
    f32x2 q = t * 0.5307027145f + (-0.7265760135f); q = q * t + 0.7107068705f; q = q * t + (-0.142248368f); q = q * t + 0.127414796f; q = q * t;
    const f32x2 s = (v * v) * (-0.72134752044f);
    f32x2 e; e.x = __builtin_amdgcn_exp2f(s.x); e.y = __builtin_amdgcn_exp2f(s.y);
    const f32x2 m = v * (q * e), r = v - m;
    f32x2 o; o.x = v.x < 0.f ? m.x : r.x; o.y = v.y < 0.f ? m.y : r.y; return o;
}

struct EpiF32 {
    static constexpr bool PERM = false, AFTER_DRAIN = false;
    float* C; int ldc; const float* bias;
    __device__ __forceinline__ void operator()(const f32x4 (&acc)[2][2][4][2], const Unit& u, int wr, int wc, int fr, int fq) const {
        const int row0 = u.pm * BM + wr * 64 + fr, col0 = u.pn * BM + wc * 32 + 4 * fq;
        f32x4 bv[2][2];
#pragma unroll
        for (int bj = 0; bj < 2; ++bj)
#pragma unroll
            for (int n = 0; n < 2; ++n) bv[bj][n] = bias ? *(const f32x4*)(bias + col0 + bj * HALF + n * 16) : (f32x4){0.f, 0.f, 0.f, 0.f};
#pragma unroll
        for (int ai = 0; ai < 2; ++ai)
#pragma unroll
            for (int m = 0; m < 4; ++m) { float* rowp = C + (size_t)(row0 + ai * HALF + m * 16) * ldc + col0;
#pragma unroll
                for (int bj = 0; bj < 2; ++bj)
#pragma unroll
                    for (int n = 0; n < 2; ++n) *(f32x4*)(rowp + bj * HALF + n * 16) = acc[ai][bj][m][n] + bv[bj][n]; }
    }
};
template <int ACT  > struct EpiBf16 {
    static constexpr bool PERM = true, AFTER_DRAIN = false;
    bf16_t* O; int ldc; const float* bias; int split_cols; size_t split_stride;
    __device__ __forceinline__ void operator()(const f32x4 (&acc)[2][2][4][2], const Unit& u, int wr, int wc, int fr, int fq) const {
        const int row0 = u.pm * BM + wr * 64 + fr; int colt = u.pn * BM; bf16_t* base = O;
        if (split_cols) { const int t = colt / split_cols; base += (size_t)t * split_stride; colt -= t * split_cols; }
        const int col0 = colt + wc * 32 + 8 * fq, bcol0 = u.pn * BM + wc * 32 + 8 * fq;
        f32x4 bv[2][2];
#pragma unroll
        for (int bj = 0; bj < 2; ++bj)
#pragma unroll
            for (int n = 0; n < 2; ++n) bv[bj][n] = bias ? *(const f32x4*)(bias + bcol0 + bj * HALF + 4 * n) : (f32x4){0.f, 0.f, 0.f, 0.f};
#pragma unroll
        for (int ai = 0; ai < 2; ++ai)
#pragma unroll
            for (int m = 0; m < 4; ++m) { bf16_t* rowp = base + (size_t)(row0 + ai * HALF + m * 16) * ldc + col0;
#pragma unroll
                for (int bj = 0; bj < 2; ++bj) { f32x4 v0 = acc[ai][bj][m][0] + bv[bj][0], v1 = acc[ai][bj][m][1] + bv[bj][1];
                    if (ACT == 1) { f32x2 a = gelu_pk((f32x2){v0[0], v0[1]}), b = gelu_pk((f32x2){v0[2], v0[3]}), c = gelu_pk((f32x2){v1[0], v1[1]}), d = gelu_pk((f32x2){v1[2], v1[3]});
                        v0 = (f32x4){a.x, a.y, b.x, b.y}; v1 = (f32x4){c.x, c.y, d.x, d.y}; }
                    if (ACT == 2) {
#pragma unroll
                        for (int j = 0; j < 4; ++j) { v0[j] = 0.5f * v0[j] * (1.0f + erff(v0[j] * 0.70710678f)); v1[j] = 0.5f * v1[j] * (1.0f + erff(v1[j] * 0.70710678f)); } }
                    u32x4 w; w.x = cvt_pk_bf16(v0[0], v0[1]); w.y = cvt_pk_bf16(v0[2], v0[3]); w.z = cvt_pk_bf16(v1[0], v1[1]); w.w = cvt_pk_bf16(v1[2], v1[3]);
                    *(u32x4*)(rowp + bj * HALF) = w; } }
    }
};

struct PanelStats {
    unsigned* xbuf;
    unsigned* cnt;
    unsigned* tmo;
    int ntn; float eps;
    unsigned code;
    __device__ __forceinline__ bool run(const f32x4 (&v)[2][2][4][2], const Unit& u, int wr, int wc, int fr, int fq, PG8_LAS unsigned char* lds, int wid, int lane) const {
        typedef float f32x2v __attribute__((ext_vector_type(2)));
        PG8_LAS f32x2v* P = (PG8_LAS f32x2v*)lds;
        PG8_LAS f32x2v* S = (PG8_LAS f32x2v*)(lds + 8192);
        PG8_LAS unsigned* flag = (PG8_LAS unsigned*)(lds + 8192 + 2048);
#pragma unroll
        for (int ai = 0; ai < 2; ++ai)
#pragma unroll
            for (int m = 0; m < 4; ++m) {
                float s = 0.f;
#pragma unroll
                for (int bj = 0; bj < 2; ++bj)
#pragma unroll
                    for (int n = 0; n < 2; ++n) { const f32x4 x = v[ai][bj][m][n]; s += (x[0] + x[1]) + (x[2] + x[3]); }
                s += __shfl_xor(s, 16); s += __shfl_xor(s, 32);
                const float mw = s * (1.0f / 64.0f); float q = 0.f;
#pragma unroll
                for (int bj = 0; bj < 2; ++bj)
#pragma unroll
                    for (int n = 0; n < 2; ++n) { const f32x4 d = v[ai][bj][m][n] - mw; q += (d[0] * d[0] + d[1] * d[1]) + (d[2] * d[2] + d[3] * d[3]); }
                q += __shfl_xor(q, 16); q += __shfl_xor(q, 32);
                if (fq == 0) P[(ai * HALF + wr * 64 + m * 16 + fr) * 4 + wc] = (f32x2v){mw, q};
            }
        asm volatile("s_waitcnt lgkmcnt(0)" ::: "memory"); __builtin_amdgcn_s_barrier(); asm volatile("" ::: "memory");
#if defined(BROKEN_NO_WAIT)
        if (blockIdx.x >= 64) { const long long t0 = clock64(); while (clock64() - t0 < 60000) __builtin_amdgcn_s_sleep(8); }
#endif
        const int row = wid * 32 + (lane & 31);
        if (lane < 32) {
            const f32x2v a = P[row * 4 + 0], b = P[row * 4 + 1], c = P[row * 4 + 2], d = P[row * 4 + 3];
            const float mt = (a.x + b.x + c.x + d.x) * 0.25f;
            const float da = a.x - mt, db = b.x - mt, dc = c.x - mt, dd = d.x - mt;
            const float m2 = (a.y + b.y) + (c.y + d.y) + 64.0f * ((da * da + db * db) + (dc * dc + dd * dd));
            unsigned long long* slot = (unsigned long long*)xbuf + ((size_t)(u.pm * BM + row) * 4 + u.pn);
            __hip_atomic_store(slot, ((unsigned long long)__float_as_uint(m2) << 32) | __float_as_uint(mt), __ATOMIC_RELAXED, __HIP_MEMORY_SCOPE_AGENT);
        }
        asm volatile("s_waitcnt vmcnt(0)" ::: "memory");
        if (lane == 0) __hip_atomic_fetch_add(cnt + 64 * u.pm, 1u, __ATOMIC_RELAXED, __HIP_MEMORY_SCOPE_AGENT);
        if (wid == 0) {
            bool dead = false; const unsigned long long t0 = __builtin_amdgcn_s_memrealtime(); const unsigned want = 8u * (unsigned)ntn;
            for (;;) {
#if defined(BROKEN_NO_WAIT)
                break;
#endif
                if ((unsigned)__builtin_amdgcn_readfirstlane(__hip_atomic_load(cnt + 64 * u.pm, __ATOMIC_RELAXED, __HIP_MEMORY_SCOPE_AGENT)) >= want) break;
                if (__builtin_amdgcn_s_memrealtime() - t0 > 2000000ull) {
                    if (lane == 0) { unsigned expect = 0u; __hip_atomic_compare_exchange_strong(tmo + 1, &expect, code | (unsigned)(u.pm & 0xff), __ATOMIC_RELAXED, __ATOMIC_RELAXED, __HIP_MEMORY_SCOPE_AGENT);
                                     __hip_atomic_store(tmo, 1u, __ATOMIC_RELAXED, __HIP_MEMORY_SCOPE_AGENT); }
                    dead = true; break; }
                __builtin_amdgcn_s_sleep(2);
            }
            __builtin_amdgcn_fence(__ATOMIC_ACQUIRE, "agent");
            if (lane == 0) flag[0] = dead ? 1u : 0u;
        }
        asm volatile("s_waitcnt vmcnt(0) lgkmcnt(0)" ::: "memory"); __builtin_amdgcn_s_barrier(); asm volatile("" ::: "memory");
        const bool bad = flag[0] != 0u;
        if (lane < 32) {
            const unsigned long long* slot = (const unsigned long long*)xbuf + (size_t)(u.pm * BM + row) * 4; float mt[4], m2[4]; float ms = 0.f;
#pragma unroll
            for (int t = 0; t < 4; ++t) { if (t < ntn) { const unsigned long long w = __hip_atomic_load(slot + t, __ATOMIC_RELAXED, __HIP_MEMORY_SCOPE_AGENT); mt[t] = __uint_as_float((unsigned)w); m2[t] = __uint_as_float((unsigned)(w >> 32)); } else { mt[t] = 0.f; m2[t] = 0.f; } ms += mt[t]; }
            const float mean = ms / (float)ntn; float q = 0.f;
#pragma unroll
            for (int t = 0; t < 4; ++t) if (t < ntn) { const float dm = mt[t] - mean; q += m2[t] + 256.0f * dm * dm; }
            S[row] = (f32x2v){mean, 1.0f / sqrtf(q / (256.0f * (float)ntn) + eps)};
        }
        asm volatile("s_waitcnt lgkmcnt(0)" ::: "memory"); __builtin_amdgcn_s_barrier(); asm volatile("" ::: "memory");
        return bad;
    }
};
struct EpiLnRes {
    static constexpr bool PERM = false, AFTER_DRAIN = true;
    const float* base; float* out; int ldc; const float* bias; PanelStats st; unsigned poison;
    __device__ __forceinline__ void refuse(size_t i0, size_t stride, int M, int N) const { const float q = __builtin_nanf(""); for (size_t i = i0; i < (size_t)M * N; i += stride) out[(i / N) * ldc + i % N] = q;
        if (i0 == 0) { unsigned expect = 0u; __hip_atomic_compare_exchange_strong(st.tmo + 1, &expect, 0x7f0u, __ATOMIC_RELAXED, __ATOMIC_RELAXED, __HIP_MEMORY_SCOPE_AGENT); __hip_atomic_store(st.tmo, 1u, __ATOMIC_RELAXED, __HIP_MEMORY_SCOPE_AGENT); } }
    __device__ __forceinline__ void fused(f32x4 (&acc)[2][2][4][2], const Unit& u, int wr, int wc, int fr, int fq, PG8_LAS unsigned char* lds, int wid, int lane) const {
        typedef float f32x2v __attribute__((ext_vector_type(2)));
        const PG8_LAS f32x2v* S = (const PG8_LAS f32x2v*)(lds + 8192);
        const int col0 = u.pn * BM + wc * 32 + 4 * fq;
#pragma unroll
        for (int bj = 0; bj < 2; ++bj)
#pragma unroll
            for (int n = 0; n < 2; ++n) { const f32x4 bv = bias ? *(const f32x4*)(bias + col0 + bj * HALF + n * 16) : (f32x4){0.f, 0.f, 0.f, 0.f};
#pragma unroll
                for (int ai = 0; ai < 2; ++ai)
#pragma unroll
                    for (int m = 0; m < 4; ++m) acc[ai][bj][m][n] += bv; }
        const bool bad = st.run(acc, u, wr, wc, fr, fq, lds, wid, lane) || poison != 0u;
        const float qnan = __builtin_nanf("");
#pragma unroll
        for (int ai = 0; ai < 2; ++ai)
#pragma unroll
            for (int m = 0; m < 4; ++m) { const int r = ai * HALF + wr * 64 + m * 16 + fr; const f32x2v sr = S[r]; const size_t off = (size_t)(u.pm * BM + r) * ldc + col0;
#pragma unroll
                for (int bj = 0; bj < 2; ++bj)
#pragma unroll
                    for (int n = 0; n < 2; ++n) { const f32x4 bs = *(const f32x4*)(base + off + bj * HALF + n * 16); f32x4 o = bs + (acc[ai][bj][m][n] - sr.x) * sr.y;
                        if (bad) o = (f32x4){qnan, qnan, qnan, qnan}; *(f32x4*)(out + off + bj * HALF + n * 16) = o; }
                asm volatile("" ::: "memory"); }
    }
};
struct EpiLnResLn {
    static constexpr bool PERM = false, AFTER_DRAIN = true;
    const float* base; float* out; bf16_t* xn; int ldc; const float* bias; PanelStats st1, st2; unsigned poison;
    __device__ __forceinline__ void refuse(size_t i0, size_t stride, int M, int N) const { const float q = __builtin_nanf(""); for (size_t i = i0; i < (size_t)M * N; i += stride) { const size_t o = (i / N) * ldc + i % N; out[o] = q; xn[o] = (bf16_t)0x7fc0u; }
        if (i0 == 0) { unsigned expect = 0u; __hip_atomic_compare_exchange_strong(st1.tmo + 1, &expect, 0x7f0u, __ATOMIC_RELAXED, __ATOMIC_RELAXED, __HIP_MEMORY_SCOPE_AGENT); __hip_atomic_store(st1.tmo, 1u, __ATOMIC_RELAXED, __HIP_MEMORY_SCOPE_AGENT); } }
    __device__ __forceinline__ void fused(f32x4 (&acc)[2][2][4][2], const Unit& u, int wr, int wc, int fr, int fq, PG8_LAS unsigned char* lds, int wid, int lane) const {
        typedef float f32x2v __attribute__((ext_vector_type(2))); typedef unsigned u32x2v __attribute__((ext_vector_type(2)));
        const PG8_LAS f32x2v* S = (const PG8_LAS f32x2v*)(lds + 8192);
        const int col0 = u.pn * BM + wc * 32 + 4 * fq;
#pragma unroll
        for (int bj = 0; bj < 2; ++bj)
#pragma unroll
            for (int n = 0; n < 2; ++n) { const f32x4 bv = bias ? *(const f32x4*)(bias + col0 + bj * HALF + n * 16) : (f32x4){0.f, 0.f, 0.f, 0.f};
#pragma unroll
                for (int ai = 0; ai < 2; ++ai)
#pragma unroll
                    for (int m = 0; m < 4; ++m) acc[ai][bj][m][n] += bv; }
        bool bad = st1.run(acc, u, wr, wc, fr, fq, lds, wid, lane) || poison != 0u;
        const float qnan = __builtin_nanf("");
#pragma unroll
        for (int ai = 0; ai < 2; ++ai)
#pragma unroll
            for (int m = 0; m < 4; ++m) { const int r = ai * HALF + wr * 64 + m * 16 + fr; const f32x2v sr = S[r]; const size_t off = (size_t)(u.pm * BM + r) * ldc + col0;
#pragma unroll
                for (int bj = 0; bj < 2; ++bj)
#pragma unroll
                    for (int n = 0; n < 2; ++n) { const f32x4 bs = *(const f32x4*)(base + off + bj * HALF + n * 16); acc[ai][bj][m][n] = bs + (acc[ai][bj][m][n] - sr.x) * sr.y; }
                asm volatile("" : "+v"(acc[ai][0][m][0]), "+v"(acc[ai][0][m][1]), "+v"(acc[ai][1][m][0]), "+v"(acc[ai][1][m][1]));
                if (m & 1) asm volatile("" ::: "memory"); }
        const bool bad1 = bad;
        bad = st2.run(acc, u, wr, wc, fr, fq, lds, wid, lane) || bad;
#pragma unroll
        for (int ai = 0; ai < 2; ++ai)
#pragma unroll
            for (int m = 0; m < 4; ++m) { const int r = ai * HALF + wr * 64 + m * 16 + fr; const f32x2v sr = S[r]; const size_t off = (size_t)(u.pm * BM + r) * ldc + col0;
#pragma unroll
                for (int bj = 0; bj < 2; ++bj)
#pragma unroll
                    for (int n = 0; n < 2; ++n) { const f32x4 x1 = acc[ai][bj][m][n]; *(f32x4*)(out + off + bj * HALF + n * 16) = bad1 ? (f32x4){qnan, qnan, qnan, qnan} : x1;
                        const f32x4 o = (x1 - sr.x) * sr.y; u32x2v w; w.x = cvt_pk_bf16(o[0], o[1]); w.y = cvt_pk_bf16(o[2], o[3]);
                        if (bad) { w.x = 0x7fc07fc0u; w.y = 0x7fc07fc0u; } *(u32x2v*)(xn + off + bj * HALF + n * 16) = w; }
                asm volatile("" ::: "memory"); }
    }
};

template <class Epi, class Sched, bool STAMP = false>
__device__ __forceinline__ void gemm_phase(PG8_LAS unsigned char* lds, const Gemm g, const Sched& S, const Epi& E, unsigned long long* stamps) {
    int tid_ = threadIdx.x; asm volatile("" : "+v"(tid_));
    const int tid = tid_, wid = __builtin_amdgcn_readfirstlane(tid >> 6), lane = tid & 63, wr = wid >> 2, wc = wid & 3, fr = lane & 15, fq = lane >> 4;
    const int K = g.K, nt = K / BK;
    int ts_lo = 0, ts_hi = 0, nts = 0; const unsigned long long rt_entry = STAMP ? (unsigned long long)wall_clock64() : 0ull;
#define PG8_STAMP() do { if (STAMP && wid == 0 && nts < 64) { const unsigned long long _c = (unsigned long long)clock64(); \
        ts_lo = (lane == nts) ? (int)(unsigned)_c : ts_lo; ts_hi = (lane == nts) ? (int)(unsigned)(_c >> 32) : ts_hi; ++nts; } } while (0)
    PG8_STAMP();
    unsigned voffA[2], voffB[2];
#pragma unroll
    for (int i = 0; i < 2; ++i) { int R, C; stage_rc(tid * 16 + i * 8192, R, C); const int Rb = Epi::PERM ? ((R & ~31) + perm32(R & 31)) : R;
        voffA[i] = (unsigned)(R * K + C) * 2u; voffB[i] = (unsigned)(Rb * K + C) * 2u; }
    const size_t kstep = (size_t)(BK * 2);
    const size_t hstep = (size_t)HALF * K * 2;
    const size_t tstep = 2 * hstep;
    const unsigned ldsw = (unsigned)wid * 1024u;
    const int aoff = lds_byte(wr * 64 + fr, fq * 8), boff = lds_byte(wc * 32 + fr, fq * 8);
#define PG8_SA(b, h) (((b) * 2 + (h)) * HTB)
#define PG8_SB(b, h) ((4 + (b) * 2 + (h)) * HTB)
#define PG8_STAGE(bufoff, gbase, voff) do { _Pragma("unroll") for (int _i = 0; _i < 2; ++_i) \
        __builtin_amdgcn_global_load_lds((const unsigned*)((const char*)(gbase) + (voff)[_i]), (PG8_LAS unsigned*)(lds + (bufoff) + ldsw + _i * 8192), 16, 0, 0); } while (0)
#define PG8_LDA(dst, b, h) do { _Pragma("unroll") for (int m = 0; m < 4; ++m) _Pragma("unroll") for (int k = 0; k < 2; ++k) dst[m][k] = *(const PG8_LAS bf16x8*)(lds + PG8_SA(b, h) + aoff + m * 2048 + k * 1024); } while (0)
#define PG8_LDB(dst, b, h) do { _Pragma("unroll") for (int n = 0; n < 2; ++n) _Pragma("unroll") for (int k = 0; k < 2; ++k) dst[n][k] = *(const PG8_LAS bf16x8*)(lds + PG8_SB(b, h) + boff + n * 2048 + k * 1024); } while (0)
#define PG8_MMA(ai, bj, At, Bt) do { __builtin_amdgcn_s_setprio(1); _Pragma("unroll") for (int m = 0; m < 4; ++m) _Pragma("unroll") for (int n = 0; n < 2; ++n) _Pragma("unroll") for (int k = 0; k < 2; ++k) \
        acc[ai][bj][m][n] = __builtin_amdgcn_mfma_f32_16x16x32_bf16(Bt[n][k], At[m][k], acc[ai][bj][m][n], 0, 0, 0); __builtin_amdgcn_s_setprio(0); } while (0)
#define PG8_WAIT_V(n) asm volatile("s_waitcnt vmcnt(" #n ")" ::: "memory")
#define PG8_WAIT_L(n) asm volatile("s_waitcnt lgkmcnt(" #n ")" ::: "memory")
#define PG8_BAR __builtin_amdgcn_s_barrier()
#define PG8_SCHED __builtin_amdgcn_sched_barrier(0)
    Unit cur, nxt; int ui = 0;
    if (!S.next(0, cur)) return;
    f32x4 acc[2][2][4][2];
#pragma unroll
    for (int a = 0; a < 2; ++a)
#pragma unroll
        for (int b = 0; b < 2; ++b)
#pragma unroll
            for (int m = 0; m < 4; ++m)
#pragma unroll
                for (int n = 0; n < 2; ++n) acc[a][b][m][n] = (f32x4){0.f, 0.f, 0.f, 0.f};
    bf16x8 At[4][2], B0[2][2], B1[2][2];
    const char* cA = (const char*)g.A + (size_t)cur.pm * tstep; const char* cB = (const char*)g.Bt + (size_t)cur.pn * tstep;
    S.a_ready(cur);
    PG8_STAGE(PG8_SB(0, 0), cB, voffB); PG8_STAGE(PG8_SA(0, 0), cA, voffA); PG8_STAGE(PG8_SB(0, 1), cB + hstep, voffB); PG8_STAGE(PG8_SA(0, 1), cA + hstep, voffA);
    if (wr == 1) PG8_BAR;
    PG8_WAIT_V(4); PG8_BAR;
    PG8_STAGE(PG8_SB(1, 0), cB + kstep, voffB); PG8_STAGE(PG8_SA(1, 0), cA + kstep, voffA); PG8_STAGE(PG8_SB(1, 1), cB + hstep + kstep, voffB);
    PG8_WAIT_V(6); PG8_BAR;
    PG8_STAMP();
    for (;;) {
        const bool has_next = S.next(ui + 1, nxt);
        const char* nA = has_next ? (const char*)g.A + (size_t)nxt.pm * tstep : cA; const char* nB = has_next ? (const char*)g.Bt + (size_t)nxt.pn * tstep : cB;
        for (int t = 0; t < nt; t += 2) {
            const bool last = (t == nt - 2);
            const char* a1 = cA + (size_t)(t + 1) * kstep;
            const char* a2 = last ? nA : cA + (size_t)(t + 2) * kstep; const char* b2 = last ? nB : cB + (size_t)(t + 2) * kstep;
            const char* a3 = a2 + kstep; const char* b3 = b2 + kstep;
            if (last && has_next) S.a_ready(nxt);
            PG8_LDB(B0, 0, 0); PG8_SCHED; PG8_LDA(At, 0, 0); PG8_STAGE(PG8_SA(1, 1), a1 + hstep, voffA);
            PG8_WAIT_L(8); PG8_BAR; PG8_WAIT_L(0); PG8_MMA(0, 0, At, B0); PG8_BAR; PG8_SCHED;
            PG8_LDB(B1, 0, 1); PG8_STAGE(PG8_SB(0, 0), b2, voffB);
            PG8_BAR; PG8_WAIT_L(0); PG8_MMA(0, 1, At, B1); PG8_BAR;
            PG8_LDA(At, 0, 1); PG8_STAGE(PG8_SA(0, 0), a2, voffA);
            PG8_BAR; PG8_WAIT_L(0); PG8_MMA(1, 0, At, B0); PG8_BAR; PG8_SCHED;
            PG8_STAGE(PG8_SB(0, 1), b2 + hstep, voffB);
            PG8_WAIT_V(6); PG8_BAR; PG8_MMA(1, 1, At, B1); PG8_BAR;
            PG8_LDB(B0, 1, 0); PG8_SCHED; PG8_LDA(At, 1, 0); PG8_STAGE(PG8_SA(0, 1), a2 + hstep, voffA);
            PG8_WAIT_L(8); PG8_BAR; PG8_WAIT_L(0); PG8_MMA(0, 0, At, B0); PG8_BAR; PG8_SCHED;
            PG8_LDB(B1, 1, 1); PG8_STAGE(PG8_SB(1, 0), b3, voffB);
            PG8_BAR; PG8_WAIT_L(0); PG8_MMA(0, 1, At, B1); PG8_BAR;
            PG8_LDA(At, 1, 1); PG8_STAGE(PG8_SA(1, 0), a3, voffA);
            PG8_BAR; PG8_WAIT_L(0); PG8_MMA(1, 0, At, B0); PG8_BAR; PG8_SCHED;
            PG8_STAGE(PG8_SB(1, 1), b3 + hstep, voffB);
            PG8_WAIT_V(6); PG8_BAR; PG8_MMA(1, 1, At, B1); PG8_BAR;
        }
        PG8_STAMP();
        if constexpr (!Epi::AFTER_DRAIN) { E(acc, cur, wr, wc, fr, fq); S.done(cur); }
        PG8_STAMP();
        if (!has_next) break;
#pragma unroll
        for (int a = 0; a < 2; ++a)
#pragma unroll
            for (int b = 0; b < 2; ++b)
#pragma unroll
                for (int m = 0; m < 4; ++m)
#pragma unroll
                    for (int n = 0; n < 2; ++n) acc[a][b][m][n] = (f32x4){0.f, 0.f, 0.f, 0.f};
        cur = nxt; cA = nA; cB = nB; ++ui;
    }
    PG8_WAIT_V(0);
    if (wr == 0) PG8_BAR;
    PG8_BAR;
    if constexpr (Epi::AFTER_DRAIN) { E.fused(acc, cur, wr, wc, fr, fq, lds, wid, lane); S.done(cur); }
    PG8_STAMP();
    if (STAMP && wid == 0) { stamps[lane] = lane < nts ? (((unsigned long long)(unsigned)ts_hi << 32) | (unsigned)ts_lo) : 0ull;
        if (lane == 62) stamps[62] = rt_entry; if (lane == 63) stamps[63] = (unsigned long long)wall_clock64(); }
#undef PG8_STAMP
#undef PG8_SA
#undef PG8_SB
#undef PG8_STAGE
#undef PG8_LDA
#undef PG8_LDB
#undef PG8_MMA
#undef PG8_WAIT_V
#undef PG8_WAIT_L
#undef PG8_BAR
#undef PG8_SCHED
}
}

namespace pg8 {
__device__ __forceinline__ float fast_sigmoid(float x) { return __builtin_amdgcn_rcpf(1.0f + __builtin_amdgcn_exp2f(-1.44269504089f * x)); }
struct EpiSwiGLU {
    static constexpr bool PERM = true, AFTER_DRAIN = false;
    bf16_t* H; int ldh; int cheap;
    __device__ __forceinline__ void operator()(const f32x4 (&acc)[2][2][4][2], const Unit& u, int wr, int wc, int fr, int fq) const {
        const int row0 = u.pm * BM + wr * 64 + fr, hc0 = u.pn * 128 + wc * 32 + 8 * fq;
#pragma unroll
        for (int ai = 0; ai < 2; ++ai)
#pragma unroll
            for (int m = 0; m < 4; ++m) {
                bf16_t* rowp = H + (size_t)(row0 + ai * HALF + m * 16) * ldh + hc0;
                float v[8];
#pragma unroll
                for (int n = 0; n < 2; ++n)
#pragma unroll
                    for (int j = 0; j < 4; ++j) { const float g = acc[ai][0][m][n][j], up = acc[ai][1][m][n][j]; v[n * 4 + j] = cheap ? g * up : g * fast_sigmoid(g) * up; }
                u32x4 w; w.x = cvt_pk_bf16(v[0], v[1]); w.y = cvt_pk_bf16(v[2], v[3]); w.z = cvt_pk_bf16(v[4], v[5]); w.w = cvt_pk_bf16(v[6], v[7]);
                *(u32x4*)rowp = w;
            }
    }
};
struct EpiResid {
    static constexpr bool PERM = false, AFTER_DRAIN = false;
    float* X; int ldc; float alpha; const float* Xsrc;
    __device__ __forceinline__ void operator()(const f32x4 (&acc)[2][2][4][2], const Unit& u, int wr, int wc, int fr, int fq) const {
        const int row0 = u.pm * BM + wr * 64 + fr, col0 = u.pn * BM + wc * 32 + 4 * fq;
#pragma unroll
        for (int ai = 0; ai < 2; ++ai)
#pragma unroll
            for (int m = 0; m < 4; ++m) { const size_t ro = (size_t)(row0 + ai * HALF + m * 16) * ldc + col0;
#pragma unroll
                for (int bj = 0; bj < 2; ++bj)
#pragma unroll
                    for (int n = 0; n < 2; ++n) { const f32x4 old = *(const f32x4*)(Xsrc + ro + bj * HALF + n * 16); *(f32x4*)(X + ro + bj * HALF + n * 16) = old + acc[ai][bj][m][n] * alpha; } }
    }
};
struct EpiWin {
    static constexpr bool PERM = true, AFTER_DRAIN = false;
    unsigned char* zbase; const float* bias; float* small_out;
    __device__ __forceinline__ void operator()(const f32x4 (&acc)[2][2][4][2], const Unit& u, int wr, int wc, int fr, int fq) const {
        const int row0 = u.pm * BM + wr * 64 + fr; const int pn = u.pn;
        const int bcol0 = pn * BM + wc * 32 + 8 * fq;
        f32x4 bv[2][2];
#pragma unroll
        for (int bj = 0; bj < 2; ++bj)
#pragma unroll
            for (int n = 0; n < 2; ++n) bv[bj][n] = *(const f32x4*)(bias + bcol0 + bj * HALF + 4 * n);
        if (pn == 17) {
            if (wc < 2) {
#pragma unroll
                for (int ai = 0; ai < 2; ++ai)
#pragma unroll
                    for (int m = 0; m < 4; ++m) { float* rowp = small_out + (size_t)(row0 + ai * HALF + m * 16) * 64 + wc * 32 + 8 * fq;
#pragma unroll
                        for (int n = 0; n < 2; ++n) *(f32x4*)(rowp + 4 * n) = acc[ai][0][m][n] + bv[0][n]; }
            }
            return;
        }
        size_t base; int ld, c0;
        if (pn < 8) { base = (size_t)(pn >> 1) * ((size_t)T * 512 * 2); ld = 512; c0 = (pn & 1) * 256; }
        else if (pn < 11) { base = (size_t)4 * T * 512 * 2 + (size_t)(pn - 8) * ((size_t)T * 256 * 2); ld = 256; c0 = 0; }
        else { base = (size_t)4 * T * 512 * 2 + (size_t)3 * T * 256 * 2 + (size_t)((pn - 11) >> 1) * ((size_t)T * 512 * 2); ld = 512; c0 = ((pn - 11) & 1) * 256; }
        bf16_t* O = (bf16_t*)(zbase + base);
        const int col0 = c0 + wc * 32 + 8 * fq;
#pragma unroll
        for (int ai = 0; ai < 2; ++ai)
#pragma unroll
            for (int m = 0; m < 4; ++m) { bf16_t* rowp = O + (size_t)(row0 + ai * HALF + m * 16) * ld + col0;
#pragma unroll
                for (int bj = 0; bj < 2; ++bj) { const f32x4 v0 = acc[ai][bj][m][0] + bv[bj][0], v1 = acc[ai][bj][m][1] + bv[bj][1];
                    u32x4 w; w.x = cvt_pk_bf16(v0[0], v0[1]); w.y = cvt_pk_bf16(v0[2], v0[3]); w.z = cvt_pk_bf16(v1[0], v1[1]); w.w = cvt_pk_bf16(v1[2], v1[3]);
                    *(u32x4*)(rowp + bj * HALF) = w; } }
    }
};
struct EpiGate {
    static constexpr bool PERM = true, AFTER_DRAIN = false;
    unsigned char* ws; int ldc; const float* bias;
    __device__ __forceinline__ void operator()(const f32x4 (&acc)[2][2][4][2], const Unit& u, int wr, int wc, int fr, int fq) const {
        const int br = u.pn >> 2;
        bf16_t* G = (bf16_t*)(ws + WS_G0 + (size_t)(br >= 1) * (WS_G1 - WS_G0) + (size_t)(br >= 2) * (WS_G2 - WS_G1));
        const int row0 = u.pm * BM + wr * 64 + fr, col0 = (u.pn & 3) * BM + wc * 32 + 8 * fq, bcol0 = u.pn * BM + wc * 32 + 8 * fq;
        f32x4 bv[2][2];
#pragma unroll
        for (int bj = 0; bj < 2; ++bj)
#pragma unroll
            for (int n = 0; n < 2; ++n) bv[bj][n] = *(const f32x4*)(bias + bcol0 + bj * HALF + 4 * n);
#pragma unroll
        for (int ai = 0; ai < 2; ++ai)
#pragma unroll
            for (int m = 0; m < 4; ++m) { bf16_t* rowp = G + (size_t)(row0 + ai * HALF + m * 16) * ldc + col0;
#pragma unroll
                for (int bj = 0; bj < 2; ++bj) { f32x4 v0 = acc[ai][bj][m][0] + bv[bj][0], v1 = acc[ai][bj][m][1] + bv[bj][1];
                    u32x4 w; w.x = cvt_pk_bf16(v0[0], v0[1]); w.y = cvt_pk_bf16(v0[2], v0[3]); w.z = cvt_pk_bf16(v1[0], v1[1]); w.w = cvt_pk_bf16(v1[2], v1[3]);
                    *(u32x4*)(rowp + bj * HALF) = w; } }
    }
};
struct EpiBranch {
    static constexpr bool PERM = true, AFTER_DRAIN = false;
    bf16_t* Y; const bf16_t* G; int ldc; int first;
    __device__ __forceinline__ void operator()(const f32x4 (&acc)[2][2][4][2], const Unit& u, int wr, int wc, int fr, int fq) const {
        const int row0 = u.pm * BM + wr * 64 + fr, col0 = u.pn * BM + wc * 32 + 8 * fq;
#pragma unroll
        for (int ai = 0; ai < 2; ++ai)
#pragma unroll
            for (int m = 0; m < 4; ++m) { const size_t off = (size_t)(row0 + ai * HALF + m * 16) * ldc + col0;
#pragma unroll
                for (int bj = 0; bj < 2; ++bj) {
                    const u32x4 g = *(const u32x4*)(G + off + bj * HALF);
                    u32x4 y = (u32x4){0u, 0u, 0u, 0u}; if (!first) y = *(const u32x4*)(Y + off + bj * HALF);
                    const f32x4 a0 = acc[ai][bj][m][0], a1 = acc[ai][bj][m][1];
                    float o[8];
#pragma unroll
                    for (int q = 0; q < 4; ++q) { const unsigned gw = g[q], yw = y[q]; const float al = q < 2 ? a0[2 * q] : a1[2 * q - 4], ah = q < 2 ? a0[2 * q + 1] : a1[2 * q - 3];
                        o[2 * q] = __builtin_bit_cast(float, yw << 16) + fast_sigmoid(__builtin_bit_cast(float, gw << 16)) * al;
                        o[2 * q + 1] = __builtin_bit_cast(float, yw & 0xffff0000u) + fast_sigmoid(__builtin_bit_cast(float, gw & 0xffff0000u)) * ah; }
                    u32x4 w; w.x = cvt_pk_bf16(o[0], o[1]); w.y = cvt_pk_bf16(o[2], o[3]); w.z = cvt_pk_bf16(o[4], o[5]); w.w = cvt_pk_bf16(o[6], o[7]);
                    if (first == 2) asm volatile("" :: "v"(w)); else *(u32x4*)(Y + off + bj * HALF) = w; } }
    }
};
}

constexpr int RING_BYTES = 131072;
constexpr int MISC_OFF = RING_BYTES + 320;
constexpr int LDS_BYTES = 147456;

__constant__ float ROPE_FREQ[32] = {
1.000000000e+00f, 7.498942614e-01f, 5.623413324e-01f, 4.216965139e-01f, 3.162277639e-01f, 2.371373773e-01f, 1.778279394e-01f, 1.333521307e-01f, 1.000000015e-01f, 7.498941571e-02f, 5.623413250e-02f, 4.216965288e-02f, 3.162277490e-02f, 2.371373773e-02f, 1.778279431e-02f, 1.333521493e-02f, 9.999999776e-03f, 7.498941850e-03f, 5.623413250e-03f, 4.216964822e-03f, 3.162277630e-03f, 2.371373586e-03f, 1.778279431e-03f, 1.333521446e-03f, 1.000000047e-03f, 7.498942432e-04f, 5.623413017e-04f, 4.216965172e-04f, 3.162277571e-04f, 2.371373703e-04f, 1.778279402e-04f, 1.333521504e-04f};

struct Args { const float* in[23]; float* out; unsigned char* ws; int ph_lo, ph_hi; };

struct Ctx {
    LAS unsigned char* lds;
    int tid, lane, wave, G, bid;
    __device__ __forceinline__ void launder() { asm volatile("" : "+v"(tid)); lane = tid & 63; asm volatile("" : "+s"(inp));
        GAS unsigned char* g = (GAS unsigned char*)ws; asm volatile("" : "+s"(g)); ws = (unsigned char*)g;
        GAS float* gx = (GAS float*)X; asm volatile("" : "+s"(gx)); X = (float*)gx; }
    const GAS float* const __attribute__((address_space(4)))* inp; float* X; unsigned char* ws;
    __device__ __forceinline__ const float* in(int k) const { return (const float*)inp[k]; }
};

__device__ __forceinline__ void transpose_item(const float* W, int ldw, int src_col0, bf16* WT, int K, int dst_row0, int kb, LAS float* scr, int lane) {
    const int k0 = 64 * kb;
#pragma unroll 8
    for (int i = 0; i < 32; ++i) { const int kk = 2 * i + (lane >> 5); scr[kk * 33 + (lane & 31)] = W[(size_t)(k0 + kk) * ldw + src_col0 + (lane & 31)]; }
    LDS_WAIT(); asm volatile("" ::: "memory");
    const int c = lane & 7;
#pragma unroll
    for (int j = 0; j < 4; ++j) { const int n = (lane >> 3) + 8 * j; const LAS float* s = scr + (8 * c) * 33 + n;
        v4u o; o.x = pk2(s[0 * 33], s[1 * 33]); o.y = pk2(s[2 * 33], s[3 * 33]); o.z = pk2(s[4 * 33], s[5 * 33]); o.w = pk2(s[6 * 33], s[7 * 33]);
        *(v4u*)(WT + (size_t)(dst_row0 + n) * K + k0 + 8 * c) = o; }
    LDS_WAIT(); asm volatile("" ::: "memory");
}
__device__ __forceinline__ int win_small_src(int i) { return i < 16 ? 1536 + i : i < 40 ? 2832 + (i - 16) : i < 44 ? 4392 + (i - 40) : i < 48 ? 4396 + (i - 44) : -1; }
__device__ __forceinline__ int win_src_col(int n) { return n < 1536 ? n : n < 2816 ? n + 16 : n < 4352 ? n + 40 : win_small_src(n - 4352); }

__device__ __forceinline__ void phase_prep_weights(const Ctx& C, int l) {
    LAS float* scr = (LAS float*)(C.lds + C.wave * 16384);
    const int gw = C.bid * NWAVES + C.wave, NGW = C.G * NWAVES;
    unsigned char* ws = C.ws;
    constexpr int I_GU = 16 * 88, I_DN = 44 * 32, I_WIN = 16 * 136, I_GT = 16 * 96, I_BR = 3 * 8 * 32, I_OUT = 16 * 32, I_C1 = 2 * 32 * 8, I_C2 = 2 * 4 * 2;
    constexpr int I_FFN = 2 * I_GU + I_DN;
    constexpr int NITEMS = 2 * I_FFN + I_WIN + I_GT + I_BR + I_OUT + I_C1 + I_C2;
    for (int it = gw; it < NITEMS; it += NGW) {
        int r = it;
        if (r < 2 * I_FFN) {
            const int f = r / I_FFN; r -= f * I_FFN;
            const float* wg = (f ? C.in(20) : C.in(2)) + (size_t)l * DM * DFF; const float* wu = (f ? C.in(21) : C.in(3)) + (size_t)l * DM * DFF; const float* wd = (f ? C.in(22) : C.in(4)) + (size_t)l * DFF * DM;
            bf16* WGU = (bf16*)(ws + (f ? WS_WGU2 : WS_WGU1)); bf16* WDN = (bf16*)(ws + (f ? WS_WDN2 : WS_WDN1));
            if (r < I_GU) { const int kb = r / 88, col = 32 * (r % 88); transpose_item(wg, DFF, col, WGU, DM, 256 * (col >> 7) + (col & 127), kb, scr, C.lane); }
            else if (r < 2 * I_GU) { r -= I_GU; const int kb = r / 88, col = 32 * (r % 88); transpose_item(wu, DFF, col, WGU, DM, 256 * (col >> 7) + 128 + (col & 127), kb, scr, C.lane); }
            else { r -= 2 * I_GU; const int kb = r / 32, col = 32 * (r % 32); transpose_item(wd, DM, col, WDN, DFF, col, kb, scr, C.lane); }
            continue;
        }
        r -= 2 * I_FFN;
        const float* win = C.in(6) + (size_t)l * DM * N_IN;
        if (r < I_WIN) { const int kb = r / 136, n = 32 * (r % 136); transpose_item(win, N_IN, win_src_col(n), (bf16*)(ws + WS_WIN), DM, n, kb, scr, C.lane); continue; } r -= I_WIN;
        if (r < I_GT) { const int kb = r / 96, n = 32 * (r % 96); transpose_item(win, N_IN, 4400 + n, (bf16*)(ws + WS_WGT), DM, n, kb, scr, C.lane); continue; } r -= I_GT;
        if (r < I_BR) { const int i = r / 256, rr = r % 256, kb = rr / 32, n = 32 * (rr % 32);
            transpose_item(C.in(17) + ((size_t)l * 3 + i) * 512 * DM, DM, n, (bf16*)(ws + WS_WBR) + (size_t)i * DM * 512, 512, n, kb, scr, C.lane); continue; } r -= I_BR;
        if (r < I_OUT) { const int kb = r / 32, n = 32 * (r % 32); transpose_item(C.in(18) + (size_t)l * DM * DM, DM, n, (bf16*)(ws + WS_WOUT), DM, n, kb, scr, C.lane); continue; } r -= I_OUT;
        if (r < I_C1) { const int kv = r / 256, rr = r % 256, kb = rr / 8, n = 32 * (rr % 8);
            transpose_item(C.in(13) + ((size_t)l * 2 + kv) * 2048 * 256, 256, n, (bf16*)(ws + WS_CW1) + (size_t)kv * 256 * 2048, 2048, n, kb, scr, C.lane); continue; } r -= I_C1;
        { const int kv = r / 8, rr = r % 8, kb = rr / 2, n = 32 * (rr % 2);
            transpose_item(C.in(14) + ((size_t)l * 2 + kv) * 256 * 64, 64, n, (bf16*)(ws + WS_CW2) + (size_t)kv * 64 * 256, 256, n, kb, scr, C.lane); }
    }
    const int gt = C.bid * NTHR + C.tid, NGT = C.G * NTHR;
    {
        const float* win = C.in(6) + (size_t)l * DM * N_IN; bf16* WIN = (bf16*)(ws + WS_WIN);
        for (int idx = gt; idx < 256 * 128; idx += NGT) { const int i = idx & 255, kc = idx >> 8; const int sc = win_small_src(i);
            v4u o = (v4u){0u, 0u, 0u, 0u};
            if (sc >= 0) { float v[8];
#pragma unroll
                for (int j = 0; j < 8; ++j) v[j] = win[(size_t)(kc * 8 + j) * N_IN + sc];
                o.x = pk2(v[0], v[1]); o.y = pk2(v[2], v[3]); o.z = pk2(v[4], v[5]); o.w = pk2(v[6], v[7]); }
            *(v4u*)(WIN + (size_t)(4352 + i) * DM + kc * 8) = o; }
        float* vec = (float*)(ws + WS_VEC); const float* bin = C.in(7) + (size_t)l * N_IN;
        for (int n = gt; n < 4608; n += NGT) { const int sc = win_src_col(n); vec[VEC_BINP + n] = sc >= 0 ? bin[sc] : 0.f; }
        for (int it = gw; it < 512; it += NGW) { const int kv = it >> 8, n = it & 255;
            const float* pe = C.in(12) + ((size_t)l * 2 + kv) * 2048; const float* w1 = C.in(13) + ((size_t)l * 2 + kv) * 2048 * 256;
            float s = 0.f;
            for (int k = C.lane; k < 2048; k += 64) s += pe[k] * w1[(size_t)k * 256 + n];
            s = wave_sum(s);
            if (C.lane == 0) vec[VEC_CB1 + it] = s; }
    }
}

__device__ __forceinline__ void phase_init(const Ctx& C) {
    const int gt = C.bid * NTHR + C.tid, NGT = C.G * NTHR;
    f32x2* rope = (f32x2*)(C.ws + WS_ROPE);
    for (int i = gt; i < SEQ * 32; i += NGT) { const int pos = i >> 5, fi = i & 31;
        const float ang = (float)pos * ROPE_FREQ[fi];
        double rev = (double)ang * 0.15915494309189533577; rev -= floor(rev);
        const float rf = (float)rev;
        rope[i] = (f32x2){__builtin_amdgcn_cosf(rf), __builtin_amdgcn_sinf(rf)}; }
}

__device__ __forceinline__ void phase_norm(const Ctx& C, const float* gain, const float* Xsrc) {
    const int gw = C.bid * NWAVES + C.wave, NGW = C.G * NWAVES;
    bf16* XN = (bf16*)(C.ws + WS_XN);
    f32x4 g[4];
#pragma unroll
    for (int j = 0; j < 4; ++j) g[j] = ((const f32x4*)gain)[C.lane + 64 * j];
    for (int m = gw; m < T; m += NGW) {
        const f32x4* xr = (const f32x4*)(Xsrc + (size_t)m * DM) + C.lane;
        f32x4 v[4]; float s = 0.f;
#pragma unroll
        for (int j = 0; j < 4; ++j) { v[j] = xr[64 * j]; s += (v[j].x * v[j].x + v[j].y * v[j].y) + (v[j].z * v[j].z + v[j].w * v[j].w); }
        const float r = 1.0f / sqrtf(wave_sum(s) * (1.f / DM) + RMS_EPS);
        unsigned long long* o8 = (unsigned long long*)(XN + (size_t)m * DM) + C.lane;
#pragma unroll
        for (int j = 0; j < 4; ++j) { const f32x4 w = v[j] * r * g[j]; o8[64 * j] = (unsigned long long)pk2(w.x, w.y) | ((unsigned long long)pk2(w.z, w.w) << 32); }
    }
}

template <int KSTEPS, class PA, class PB>
__device__ __forceinline__ f32x4 mma_tile(PA A, int lda, PB Bt, int ldb, f32x4 acc, int lane) {
    const int r = lane & 15, q = lane >> 4;
#pragma unroll
    for (int kk = 0; kk < KSTEPS; ++kk) {
        const bf16x8 a = *(const bf16x8*)(A + r * lda + kk * 32 + 8 * q);
        const bf16x8 b = *(const bf16x8*)(Bt + r * ldb + kk * 32 + 8 * q);
        acc = __builtin_amdgcn_mfma_f32_16x16x32_bf16(a, b, acc, 0, 0, 0);
    }
    return acc;
}
__device__ __forceinline__ float wave_scan_sum(float v, int lane) {
#pragma unroll
    for (int o = 1; o < 64; o <<= 1) { const float t = __shfl_up(v, o); if (lane >= o) v += t; }
    return v;
}
__device__ __forceinline__ float wave_scan_max(float v, int lane) {
#pragma unroll
    for (int o = 1; o < 64; o <<= 1) { const float t = __shfl_up(v, o); if (lane >= o) v = fmaxf(v, t); }
    return v;
}

__device__ __forceinline__ void lds_frag2(const LAS bf16* tile, int row0, int lane, bf16x8 (&f)[2]) {
    const LAS bf16* p = tile + (row0 + (lane & 15)) * 72 + 8 * (lane >> 4);
    f[0] = *(const LAS bf16x8*)p; f[1] = *(const LAS bf16x8*)(p + 32);
}
constexpr int CU_ALR = 0;
constexpr int CU_GT = 4096;
constexpr int CU_VEC = 6144;
constexpr int CU_KT = 8192;
constexpr int CU_VT = 17408;
constexpr int CU_Q = 35840;
constexpr int CU_AT = 45056;
constexpr int CU_O = 54272;
constexpr int CU_END = 88064;
constexpr int CU_WA = 110592;

__device__ __forceinline__ void load_vt(const Ctx& C, const bf16* V, int t0, int h) {
    LAS bf16* VT = (LAS bf16*)(C.lds + CU_VT);
    const int dv = C.tid & 127, jq = C.tid >> 7;
    const bf16* src = V + (size_t)(t0 + 16 * jq) * 512 + h * 128 + dv;
    unsigned w[8];
#pragma unroll
    for (int jj = 0; jj < 8; ++jj) { const unsigned lo = src[(size_t)(2 * jj) * 512], hi = src[(size_t)(2 * jj + 1) * 512]; w[jj] = lo | (hi << 16); }
    *(LAS v4u*)(VT + dv * 72 + 16 * jq) = (v4u){w[0], w[1], w[2], w[3]};
    *(LAS v4u*)(VT + dv * 72 + 16 * jq + 8) = (v4u){w[4], w[5], w[6], w[7]};
}

__device__ __forceinline__ void gla_stage_alpha(const Ctx& C, int l) {
    LAS float* WA = (LAS float*)(C.lds + CU_WA);
    const float* wa = C.in(8) + (size_t)l * 16 * 256; const float* ba = C.in(9) + (size_t)l * 256;
    for (int i = C.tid; i < 16 * 256 + 256; i += NTHR) WA[i] = i < 4096 ? wa[i] : ba[i - 4096];
}
__device__ __forceinline__ float gla_cumsum(const Ctx& C, int l, int t0, int h, float (&b)[8]) {
    LAS float* ALR = (LAS float*)(C.lds + CU_ALR); LAS float* GT = (LAS float*)(C.lds + CU_GT);
    const float* SMALL = (const float*)(C.ws + WS_SMALL);
    if (C.tid < 256) { const int j = C.tid >> 2, c4 = C.tid & 3; *(LAS f32x4*)(ALR + j * 16 + 4 * c4) = *(const f32x4*)(SMALL + (size_t)(t0 + j) * 64 + 4 * c4); }
    const int dk = C.tid & 63, jg = C.tid >> 6;
    const LAS float* WA = (const LAS float*)(C.lds + CU_WA) + h * 64 + dk; (void)l;
    __syncthreads();
    float w[16];
#pragma unroll
    for (int r = 0; r < 16; ++r) w[r] = WA[r * 256];
    const float ba = WA[16 * 256];
    float run = 0.f;
#pragma unroll
    for (int jj = 0; jj < 8; ++jj) { const int j = 8 * jg + jj; float x = ba;
#pragma unroll
        for (int r = 0; r < 16; ++r) x += ALR[j * 16 + r] * w[r];
        run += logsigmoidf_(x) * (1.0f / 16.0f); b[jj] = run; }
    GT[jg * 64 + dk] = run;
    __syncthreads();
    float pre = 0.f, tot = 0.f;
#pragma unroll
    for (int g2 = 0; g2 < 8; ++g2) { const float v = GT[g2 * 64 + dk]; tot += v; if (g2 < jg) pre += v; }
#pragma unroll
    for (int jj = 0; jj < 8; ++jj) b[jj] += pre;
    return tot;
}

__device__ __forceinline__ void gla_unit_a(const Ctx& C, int l, int ci) {
    const int bh = ci >> 8, c = ci & 255, bb = bh >> 2, h = bh & 3, t0 = bb * SEQ + c * 64;
    const bf16* QKA = (const bf16*)(C.ws + WS_QKA);
    load_vt(C, (const bf16*)(C.ws + WS_VA), t0, h);
    const int dk = C.tid & 63, jg = C.tid >> 6;
    unsigned kraw[8];
#pragma unroll
    for (int jj = 0; jj < 8; ++jj) kraw[jj] = QKA[(size_t)(t0 + 8 * jg + jj) * 512 + 256 + h * 64 + dk];
    float b[8]; const float btot = gla_cumsum(C, l, t0, h, b);
    LAS bf16* KT = (LAS bf16*)(C.lds + CU_KT);
    float kd[8];
#pragma unroll
    for (int jj = 0; jj < 8; ++jj) { const float k = bf2f(kraw[jj]); kd[jj] = k * fexp(btot - b[jj]); }
    *(LAS v4u*)(KT + dk * 72 + 8 * jg) = (v4u){pk2(kd[0], kd[1]), pk2(kd[2], kd[3]), pk2(kd[4], kd[5]), pk2(kd[6], kd[7])};
    if (jg == 0) ((float*)(C.ws + WS_GDEC))[(size_t)ci * 64 + dk] = fexp(btot);
    __syncthreads();
    const LAS bf16* VT = (const LAS bf16*)(C.lds + CU_VT);
    bf16* GST = (bf16*)(C.ws + WS_GST) + (size_t)ci * 8192;
    const int q = C.lane >> 4, fr = C.lane & 15;
    {
        bf16x8 av[2], bk[4][2]; lds_frag2(VT, 16 * C.wave, C.lane, av);
#pragma unroll
        for (int nt = 0; nt < 4; ++nt) lds_frag2((const LAS bf16*)KT, 16 * nt, C.lane, bk[nt]);
        f32x4 acc[4];
#pragma unroll
        for (int nt = 0; nt < 4; ++nt) acc[nt] = __builtin_amdgcn_mfma_f32_16x16x32_bf16(av[0], bk[nt][0], (f32x4){0.f, 0.f, 0.f, 0.f}, 0, 0, 0);
#pragma unroll
        for (int nt = 0; nt < 4; ++nt) acc[nt] = __builtin_amdgcn_mfma_f32_16x16x32_bf16(av[1], bk[nt][1], acc[nt], 0, 0, 0);
#pragma unroll
        for (int nt = 0; nt < 4; ++nt)
#pragma unroll
            for (int r = 0; r < 4; ++r) GST[(16 * C.wave + 4 * q + r) * 64 + 16 * nt + fr] = (bf16)f2bf(acc[nt][r]);
    }
    __syncthreads();
}

__device__ __forceinline__ void gla_unit_c(const Ctx& C, int l, int ci, bool DRY) {
    const int bh = ci >> 8, c = ci & 255, bb = bh >> 2, h = bh & 3, t0 = bb * SEQ + c * 64;
    const bf16* QKA = (const bf16*)(C.ws + WS_QKA);
    load_vt(C, (const bf16*)(C.ws + WS_VA), t0, h);
    const int dk = C.tid & 63, jg = C.tid >> 6;
    unsigned qraw[8], kraw[8];
#pragma unroll
    for (int jj = 0; jj < 8; ++jj) { const bf16* p = QKA + (size_t)(t0 + 8 * jg + jj) * 512 + h * 64 + dk; qraw[jj] = p[0]; kraw[jj] = p[256]; }
    bf16x8 stf[4][2];
    { const bf16* ST = (const bf16*)(C.ws + WS_GST) + (size_t)ci * 8192 + (size_t)(16 * 4 * (C.wave >> 2) + (C.lane & 15)) * 64 + 8 * (C.lane >> 4);
#pragma unroll
      for (int u = 0; u < 4; ++u) { stf[u][0] = *(const bf16x8*)(ST + u * 16 * 64); stf[u][1] = *(const bf16x8*)(ST + u * 16 * 64 + 32); } }
    v4u ar0, ar1;
    { const bf16* RAp = (const bf16*)(C.ws + WS_RA) + (size_t)(t0 + (C.tid >> 3)) * 512 + h * 128 + 16 * (C.tid & 7); ar0 = *(const v4u*)RAp; ar1 = *(const v4u*)(RAp + 8); }
    float b[8]; (void)gla_cumsum(C, l, t0, h, b);
    LAS bf16* KT = (LAS bf16*)(C.lds + CU_KT); LAS bf16* QT = (LAS bf16*)(C.lds + CU_Q); LAS bf16* AT = (LAS bf16*)(C.lds + CU_AT);
#pragma unroll
    for (int jj = 0; jj < 8; ++jj) { const int j = 8 * jg + jj;
        const float qv = bf2f(qraw[jj]) * 0.125f, kv = bf2f(kraw[jj]);
        QT[j * 72 + dk] = (bf16)f2bf(qv * fexp(b[jj])); KT[j * 72 + dk] = (bf16)f2bf(kv * fexp(fminf(-b[jj], 80.f))); }
    __syncthreads();
    const int q = C.lane >> 4, fr = C.lane & 15;
    {
        const int it = C.wave >> 1;
        bf16x8 bq[2], ak[2][2]; lds_frag2((const LAS bf16*)QT, 16 * it, C.lane, bq);
#pragma unroll
        for (int u = 0; u < 2; ++u) lds_frag2((const LAS bf16*)KT, 16 * (2 * (C.wave & 1) + u), C.lane, ak[u]);
        f32x4 acc2[2];
#pragma unroll
        for (int u = 0; u < 2; ++u) acc2[u] = __builtin_amdgcn_mfma_f32_16x16x32_bf16(ak[u][0], bq[0], (f32x4){0.f, 0.f, 0.f, 0.f}, 0, 0, 0);
#pragma unroll
        for (int u = 0; u < 2; ++u) acc2[u] = __builtin_amdgcn_mfma_f32_16x16x32_bf16(ak[u][1], bq[1], acc2[u], 0, 0, 0);
#pragma unroll
        for (int u = 0; u < 2; ++u) { const int jt = 2 * (C.wave & 1) + u;
            const int i = 16 * it + fr;
            float v[4];
#pragma unroll
            for (int r = 0; r < 4; ++r) { const int j = 16 * jt + 4 * q + r; v[r] = (j <= i) ? acc2[u][r] : 0.f; }
            *(LAS v2u*)(AT + i * 72 + 16 * jt + 4 * q) = (v2u){pk2(v[0], v[1]), pk2(v[2], v[3])}; }
    }
    __syncthreads();
    {
        const int it = C.wave & 3; LAS float* O = (LAS float*)(C.lds + CU_O);
        const LAS bf16* VT = (const LAS bf16*)(C.lds + CU_VT);
        bf16x8 qa[2], aa[2], bv[4][2]; lds_frag2((const LAS bf16*)QT, 16 * it, C.lane, qa); lds_frag2((const LAS bf16*)AT, 16 * it, C.lane, aa);
#pragma unroll
        for (int u = 0; u < 4; ++u) lds_frag2(VT, 16 * (4 * (C.wave >> 2) + u), C.lane, bv[u]);
        f32x4 acc4[4];
#pragma unroll
        for (int u = 0; u < 4; ++u) acc4[u] = __builtin_amdgcn_mfma_f32_16x16x32_bf16(qa[0], stf[u][0], (f32x4){0.f, 0.f, 0.f, 0.f}, 0, 0, 0);
#pragma unroll
        for (int u = 0; u < 4; ++u) acc4[u] = __builtin_amdgcn_mfma_f32_16x16x32_bf16(qa[1], stf[u][1], acc4[u], 0, 0, 0);
#pragma unroll
        for (int u = 0; u < 4; ++u) acc4[u] = __builtin_amdgcn_mfma_f32_16x16x32_bf16(aa[0], bv[u][0], acc4[u], 0, 0, 0);
#pragma unroll
        for (int u = 0; u < 4; ++u) acc4[u] = __builtin_amdgcn_mfma_f32_16x16x32_bf16(aa[1], bv[u][1], acc4[u], 0, 0, 0);
#pragma unroll
        for (int u = 0; u < 4; ++u) { const int dvt = 4 * (C.wave >> 2) + u;
#pragma unroll
            for (int r = 0; r < 4; ++r) O[(16 * it + 4 * q + r) * 132 + 16 * dvt + fr] = acc4[u][r]; }
    }
    __syncthreads();
    {
        const int i = C.tid >> 3, s = C.tid & 7; const LAS float* O = (const LAS float*)(C.lds + CU_O) + i * 132 + 16 * s;
        float o[16]; float ss = 0.f;
#pragma unroll
        for (int k = 0; k < 16; ++k) { o[k] = O[k]; ss += o[k] * o[k]; }
        ss += __shfl_xor(ss, 1); ss += __shfl_xor(ss, 2); ss += __shfl_xor(ss, 4);
        const float rinv = 1.0f / sqrtf(ss * (1.0f / 128.0f) + RMS_EPS);
        bf16* RA = (bf16*)(C.ws + WS_RA) + (size_t)(t0 + i) * 512 + h * 128 + 16 * s;
        const float* gn = C.in(10) + (size_t)l * 128 + 16 * s;
        const v4u r0 = ar0, r1 = ar1;
        unsigned rw[8] = {r0.x, r0.y, r0.z, r0.w, r1.x, r1.y, r1.z, r1.w}; unsigned ow[8];
#pragma unroll
        for (int k = 0; k < 8; ++k) { const float a = SCL_A * o[2 * k] * rinv * gn[2 * k] * siluf_(bflo(rw[k])), bq = SCL_A * o[2 * k + 1] * rinv * gn[2 * k + 1] * siluf_(bfhi(rw[k])); ow[k] = (ABL_ZERO & 1) ? 0u : pk2(a, bq); }
        if (DRY) { asm volatile("" :: "v"(ow[0]), "v"(ow[1]), "v"(ow[2]), "v"(ow[3]), "v"(ow[4]), "v"(ow[5]), "v"(ow[6]), "v"(ow[7])); } else {
        *(v4u*)RA = (v4u){ow[0], ow[1], ow[2], ow[3]}; *(v4u*)(RA + 8) = (v4u){ow[4], ow[5], ow[6], ow[7]}; }
    }
    __syncthreads();
}

__device__ __forceinline__ void conv_silu8(const Ctx& C, int l, int t0, int c, int ch, int jg, float (&out)[8]) {
    const bf16* X = (const bf16*)(C.ws + WS_QKC);
    const float* cw = C.in(15) + (size_t)l * 4 * 512 + ch; const float cb = C.in(16)[(size_t)l * 512 + ch];
    const float w0 = cw[0], w1 = cw[512], w2 = cw[1024], w3 = cw[1536];
    float x[11];
#pragma unroll
    for (int k = 0; k < 11; ++k) { const int j = 8 * jg + k - 3; const int s = c * 64 + j; const float xv = bf2f(X[(size_t)(t0 + (s >= 0 ? j : 0)) * 512 + ch]);
        x[k] = (s >= 0) ? xv : 0.f; }
#pragma unroll
    for (int jj = 0; jj < 8; ++jj) out[jj] = siluf_(cb + w0 * x[jj] + w1 * x[jj + 1] + w2 * x[jj + 2] + w3 * x[jj + 3]);
}

__device__ __forceinline__ void mlstm_unit_a(const Ctx& C, int l, int ci) {
    const int bh = ci >> 8, c = ci & 255, bb = bh >> 2, h = bh & 3, t0 = bb * SEQ + c * 64;
    LAS float* VEC = (LAS float*)(C.lds + CU_VEC); LAS float* GT = (LAS float*)(C.lds + CU_GT);
    load_vt(C, (const bf16*)(C.ws + WS_VC), t0, h);
    const int dk = C.tid & 63, jg = C.tid >> 6;
    float k[8]; conv_silu8(C, l, t0, c, 256 + h * 64 + dk, jg, k);
    if (C.wave == 0) {
        const float* sm = (const float*)(C.ws + WS_SMALL) + (size_t)(t0 + C.lane) * 64;
        const float ip = sm[40 + h], lf = logsigmoidf_(sm[44 + h]);
        const float bj = wave_scan_sum(lf, C.lane); const float a = ip - bj; const float amax = wave_max(a);
        VEC[C.lane] = fexp(a - amax);
        if (C.lane == 63) { float* msc = (float*)(C.ws + WS_MSC) + (size_t)ci * 4; msc[0] = bj; msc[1] = amax; }
    }
    __syncthreads();
    LAS bf16* KT = (LAS bf16*)(C.lds + CU_KT);
    float kw[8]; float ns = 0.f;
#pragma unroll
    for (int jj = 0; jj < 8; ++jj) { kw[jj] = k[jj] * 0.125f * VEC[8 * jg + jj]; ns += kw[jj]; }
    *(LAS v4u*)(KT + dk * 72 + 8 * jg) = (v4u){pk2(kw[0], kw[1]), pk2(kw[2], kw[3]), pk2(kw[4], kw[5]), pk2(kw[6], kw[7])};
    GT[jg * 64 + dk] = ns;
    __syncthreads();
    if (C.tid < 64) { float s = 0.f;
#pragma unroll
        for (int g2 = 0; g2 < 8; ++g2) s += GT[g2 * 64 + C.tid];
        ((float*)(C.ws + WS_MN))[(size_t)ci * 64 + C.tid] = s; }
    const LAS bf16* VT = (const LAS bf16*)(C.lds + CU_VT);
    bf16* MST = (bf16*)(C.ws + WS_MST) + (size_t)ci * 8192;
    const int q = C.lane >> 4, fr = C.lane & 15;
    {
        bf16x8 av[2], bk[4][2]; lds_frag2(VT, 16 * C.wave, C.lane, av);
#pragma unroll
        for (int nt = 0; nt < 4; ++nt) lds_frag2((const LAS bf16*)KT, 16 * nt, C.lane, bk[nt]);
        f32x4 acc[4];
#pragma unroll
        for (int nt = 0; nt < 4; ++nt) acc[nt] = __builtin_amdgcn_mfma_f32_16x16x32_bf16(av[0], bk[nt][0], (f32x4){0.f, 0.f, 0.f, 0.f}, 0, 0, 0);
#pragma unroll
        for (int nt = 0; nt < 4; ++nt) acc[nt] = __builtin_amdgcn_mfma_f32_16x16x32_bf16(av[1], bk[nt][1], acc[nt], 0, 0, 0);
#pragma unroll
        for (int nt = 0; nt < 4; ++nt)
#pragma unroll
            for (int r = 0; r < 4; ++r) MST[(16 * C.wave + 4 * q + r) * 64 + 16 * nt + fr] = (bf16)f2bf(acc[nt][r]);
    }
    __syncthreads();
}

__device__ __forceinline__ void mlstm_unit_c(const Ctx& C, int l, int ci, bool DRY) {
    const int bh = ci >> 8, c = ci & 255, bb = bh >> 2, h = bh & 3, t0 = bb * SEQ + c * 64;
    LAS float* VEC = (LAS float*)(C.lds + CU_VEC);
    LAS float* AJ = VEC + 64, *MI = VEC + 128, *WI = VEC + 192, *EM = VEC + 256, *QN = VEC + 384; LAS float* DENP = (LAS float*)(C.lds + CU_GT);
    load_vt(C, (const bf16*)(C.ws + WS_VC), t0, h);
    const int dk = C.tid & 63, jg = C.tid >> 6;
    LAS bf16* KT = (LAS bf16*)(C.lds + CU_KT); LAS bf16* QT = (LAS bf16*)(C.lds + CU_Q); LAS bf16* AT = (LAS bf16*)(C.lds + CU_AT);
    bf16x8 stf[4][2];
    { const bf16* ST = (const bf16*)(C.ws + WS_MST) + (size_t)ci * 8192 + (size_t)(16 * 4 * (C.wave >> 2) + (C.lane & 15)) * 64 + 8 * (C.lane >> 4);
#pragma unroll
      for (int u = 0; u < 4; ++u) { stf[u][0] = *(const bf16x8*)(ST + u * 16 * 64); stf[u][1] = *(const bf16x8*)(ST + u * 16 * 64 + 32); } }
    v4u co0, co1; f32x4 nst0, nst1;
    { const bf16* OCp = (const bf16*)(C.ws + WS_OC) + (size_t)(t0 + (C.tid >> 3)) * 512 + h * 128 + 16 * (C.tid & 7); co0 = *(const v4u*)OCp; co1 = *(const v4u*)(OCp + 8);
      const float* np = (const float*)(C.ws + WS_MN) + (size_t)ci * 64 + 8 * (C.tid & 7); nst0 = *(const f32x4*)np; nst1 = *(const f32x4*)(np + 4); }
    {
        float qv[8], kv[8]; conv_silu8(C, l, t0, c, h * 64 + dk, jg, qv); conv_silu8(C, l, t0, c, 256 + h * 64 + dk, jg, kv);
#pragma unroll
        for (int jj = 0; jj < 8; ++jj) { const int j = 8 * jg + jj; QT[j * 72 + dk] = (bf16)f2bf(qv[jj]); KT[j * 72 + dk] = (bf16)f2bf(kv[jj] * 0.125f); }
    }
    if (C.wave == 0) {
        const float* sm = (const float*)(C.ws + WS_SMALL) + (size_t)(t0 + C.lane) * 64;
        const float ip = sm[40 + h], lf = logsigmoidf_(sm[44 + h]);
        const float bj = wave_scan_sum(lf, C.lane); const float a = ip - bj; const float arun = wave_scan_max(a, C.lane);
        const float mst = ((const float*)(C.ws + WS_MSC))[(size_t)ci * 4 + 2];
        const float mi = fmaxf(mst, arun);
        AJ[C.lane] = a; MI[C.lane] = mi; WI[C.lane] = fexp(mst - mi); EM[C.lane] = fexp(-(bj + mi));
    }
    __syncthreads();
    const int q = C.lane >> 4, fr = C.lane & 15;
    {
        const int it = C.wave >> 1;
        bf16x8 bq[2], ak[2][2]; lds_frag2((const LAS bf16*)QT, 16 * it, C.lane, bq);
#pragma unroll
        for (int u = 0; u < 2; ++u) lds_frag2((const LAS bf16*)KT, 16 * (2 * (C.wave & 1) + u), C.lane, ak[u]);
        f32x4 acc2[2];
#pragma unroll
        for (int u = 0; u < 2; ++u) acc2[u] = __builtin_amdgcn_mfma_f32_16x16x32_bf16(ak[u][0], bq[0], (f32x4){0.f, 0.f, 0.f, 0.f}, 0, 0, 0);
#pragma unroll
        for (int u = 0; u < 2; ++u) acc2[u] = __builtin_amdgcn_mfma_f32_16x16x32_bf16(ak[u][1], bq[1], acc2[u], 0, 0, 0);
#pragma unroll
        for (int u = 0; u < 2; ++u) { const int jt = 2 * (C.wave & 1) + u; const f32x4 acc = acc2[u];
            const int i = 16 * it + fr; const float mi = MI[i];
            const f32x4 aj = *(const LAS f32x4*)(AJ + 16 * jt + 4 * q);
            float v[4]; float ds = 0.f;
#pragma unroll
            for (int r = 0; r < 4; ++r) { const int j = 16 * jt + 4 * q + r; const float e = fexp(fminf(aj[r] - mi, 0.f)); v[r] = (j <= i) ? acc[r] * e : 0.f; ds += v[r]; }
            ds += __shfl_xor(ds, 16); ds += __shfl_xor(ds, 32);
            if (q == 0) DENP[jt * 64 + i] = ds;
            *(LAS v2u*)(AT + i * 72 + 16 * jt + 4 * q) = (v2u){pk2(v[0], v[1]), pk2(v[2], v[3])}; }
    }
    {
        const int i = C.tid >> 3, s = C.tid & 7; const float nst[8] = {nst0[0], nst0[1], nst0[2], nst0[3], nst1[0], nst1[1], nst1[2], nst1[3]};
        float a = 0.f;
#pragma unroll
        for (int k = 0; k < 8; ++k) a += bf2f(QT[i * 72 + 8 * s + k]) * nst[k];
        a += __shfl_xor(a, 1); a += __shfl_xor(a, 2); a += __shfl_xor(a, 4);
        if (s == 0) QN[i] = a;
    }
    __syncthreads();
    {
        const int it = C.wave & 3; LAS float* O = (LAS float*)(C.lds + CU_O);
        const LAS bf16* VT = (const LAS bf16*)(C.lds + CU_VT);
        bf16x8 qa[2], aa[2], bv[4][2]; lds_frag2((const LAS bf16*)QT, 16 * it, C.lane, qa); lds_frag2((const LAS bf16*)AT, 16 * it, C.lane, aa);
#pragma unroll
        for (int u = 0; u < 4; ++u) lds_frag2(VT, 16 * (4 * (C.wave >> 2) + u), C.lane, bv[u]);
        f32x4 a1[4], a2[4];
#pragma unroll
        for (int u = 0; u < 4; ++u) { a1[u] = __builtin_amdgcn_mfma_f32_16x16x32_bf16(qa[0], stf[u][0], (f32x4){0.f, 0.f, 0.f, 0.f}, 0, 0, 0); a2[u] = __builtin_amdgcn_mfma_f32_16x16x32_bf16(aa[0], bv[u][0], (f32x4){0.f, 0.f, 0.f, 0.f}, 0, 0, 0); }
#pragma unroll
        for (int u = 0; u < 4; ++u) { a1[u] = __builtin_amdgcn_mfma_f32_16x16x32_bf16(qa[1], stf[u][1], a1[u], 0, 0, 0); a2[u] = __builtin_amdgcn_mfma_f32_16x16x32_bf16(aa[1], bv[u][1], a2[u], 0, 0, 0); }
        float wi4[4];
#pragma unroll
        for (int r = 0; r < 4; ++r) wi4[r] = WI[16 * it + 4 * q + r];
#pragma unroll
        for (int u = 0; u < 4; ++u) { const int dvt = 4 * (C.wave >> 2) + u;
#pragma unroll
            for (int r = 0; r < 4; ++r) { const int i = 16 * it + 4 * q + r; O[i * 132 + 16 * dvt + fr] = wi4[r] * a1[u][r] + a2[u][r]; } }
    }
    __syncthreads();
    {
        const int i = C.tid >> 3, s = C.tid & 7; const LAS float* O = (const LAS float*)(C.lds + CU_O) + i * 132 + 16 * s;
        const float den = WI[i] * QN[i] + ((DENP[i] + DENP[64 + i]) + (DENP[128 + i] + DENP[192 + i])); const float dinv = 1.0f / fmaxf(fabsf(den), EM[i]);
        bf16* OC = (bf16*)(C.ws + WS_OC) + (size_t)(t0 + i) * 512 + h * 128 + 16 * s;
        const v4u r0 = co0, r1 = co1;
        unsigned rw[8] = {r0.x, r0.y, r0.z, r0.w, r1.x, r1.y, r1.z, r1.w}; unsigned ow[8];
#pragma unroll
        for (int k = 0; k < 8; ++k) ow[k] = (ABL_ZERO & 4) ? 0u : pk2(SCL_C * O[2 * k] * dinv * sigmoidf_(bflo(rw[k])), SCL_C * O[2 * k + 1] * dinv * sigmoidf_(bfhi(rw[k])));
        if (DRY) { asm volatile("" :: "v"(ow[0]), "v"(ow[1]), "v"(ow[2]), "v"(ow[3]), "v"(ow[4]), "v"(ow[5]), "v"(ow[6]), "v"(ow[7])); } else {
        *(v4u*)OC = (v4u){ow[0], ow[1], ow[2], ow[3]}; *(v4u*)(OC + 8) = (v4u){ow[4], ow[5], ow[6], ow[7]}; }
    }
    __syncthreads();
}

__device__ __forceinline__ void phase_scan(const Ctx& C, bool DRY) {
    const int gt = C.bid * NTHR + C.tid, NGT = C.G * NTHR;
    for (int e = gt; e < 65536 + 65536; e += NGT) {
        if (e < 65536) {
            const int bh = e >> 13, el = e & 8191, dk = el & 63;
            bf16* st = (bf16*)(C.ws + WS_GST) + (size_t)bh * 256 * 8192 + el; const float* dec = (const float*)(C.ws + WS_GDEC) + (size_t)bh * 256 * 64 + dk;
            float s = 0.f;
            for (int c0 = 0; c0 < 256; c0 += 8) { float L[8], d[8];
#pragma unroll
                for (int k = 0; k < 8; ++k) { L[k] = bf2f(st[(size_t)(c0 + k) * 8192]); d[k] = dec[(c0 + k) * 64]; }
#pragma unroll
                for (int k = 0; k < 8; ++k) { if (!DRY) st[(size_t)(c0 + k) * 8192] = (bf16)f2bf(s); s = d[k] * s + L[k]; } }
            if (DRY) asm volatile("" :: "v"(s));
        } else {
            const int e2 = e - 65536, bh = e2 >> 13, el = e2 & 8191; const bool hasn = el < 64;
            bf16* st = (bf16*)(C.ws + WS_MST) + (size_t)bh * 256 * 8192 + el; float* nv = (float*)(C.ws + WS_MN) + (size_t)bh * 256 * 64 + (hasn ? el : 0);
            float* msc = (float*)(C.ws + WS_MSC) + (size_t)bh * 256 * 4;
            float s = 0.f, sn = 0.f, m = 0.f;
            for (int c0 = 0; c0 < 256; c0 += 8) { float L[8], Ln[8], bl[8], am[8];
#pragma unroll
                for (int k = 0; k < 8; ++k) { L[k] = bf2f(st[(size_t)(c0 + k) * 8192]); Ln[k] = nv[(c0 + k) * 64]; bl[k] = msc[(c0 + k) * 4]; am[k] = msc[(c0 + k) * 4 + 1]; }
                float sno[8], mo[8];
#pragma unroll
                for (int k = 0; k < 8; ++k) {
                    const float mn = bl[k] + fmaxf(m, am[k]); const float al = fexp(bl[k] + m - mn), be = fexp(bl[k] + am[k] - mn);
                    if (!DRY) st[(size_t)(c0 + k) * 8192] = (bf16)f2bf(s);
                    sno[k] = sn; mo[k] = m;
                    s = al * s + be * L[k]; sn = al * sn + be * Ln[k]; m = mn; }
                if (hasn && !DRY) {
#pragma unroll
                    for (int k = 0; k < 8; ++k) { nv[(c0 + k) * 64] = sno[k]; if (el == 0) msc[(c0 + k) * 4 + 2] = mo[k]; } } }
            if (DRY) asm volatile("" :: "v"(s), "v"(sn));
        }
    }
}

__device__ __forceinline__ float gelu_tanh(float x) { const float u = 0.7978845608f * (x + 0.044715f * x * x * x); const float e = __expf(2.0f * u); return 0.5f * x * (2.0f - 2.0f / (1.0f + e)); }

__device__ __forceinline__ void nsa_prep_rows(const float* gain, const f32x2* rope_row, float scale, bf16* p, int c8, bool DRY) {
    const v4u raw = *(const v4u*)p;
    float x[8]; x[0] = bflo(raw.x); x[1] = bfhi(raw.x); x[2] = bflo(raw.y); x[3] = bfhi(raw.y); x[4] = bflo(raw.z); x[5] = bfhi(raw.z); x[6] = bflo(raw.w); x[7] = bfhi(raw.w);
    float ss = 0.f;
#pragma unroll
    for (int k = 0; k < 8; ++k) ss += x[k] * x[k];
    ss += __shfl_xor(ss, 1); ss += __shfl_xor(ss, 2); ss += __shfl_xor(ss, 4);
    const float rinv = 1.0f / sqrtf(ss * (1.0f / 64.0f) + RMS_EPS);
    const f32x4 g0 = *(const f32x4*)(gain + 8 * c8), g1 = *(const f32x4*)(gain + 8 * c8 + 4);
    float y[8], pr[8];
#pragma unroll
    for (int k = 0; k < 8; ++k) y[k] = x[k] * rinv * (k < 4 ? g0[k] : g1[k - 4]);
#pragma unroll
    for (int k = 0; k < 8; ++k) pr[k] = __shfl_xor(y[k], 4);
    const f32x2* cs = rope_row + 8 * (c8 & 3);
    float o[8];
#pragma unroll
    for (int k = 0; k < 8; ++k) { const f32x2 c = cs[k]; o[k] = ((c8 < 4) ? (y[k] * c.x - pr[k] * c.y) : (pr[k] * c.y + y[k] * c.x)) * scale; }
    const v4u w = (v4u){pk2(o[0], o[1]), pk2(o[2], o[3]), pk2(o[4], o[5]), pk2(o[6], o[7])};
    if (DRY) asm volatile("" :: "v"(w)); else *(v4u*)p = w;
}
__device__ __forceinline__ void nsa_prep_token(const Ctx& C, int l, int tp, bool DRY) {
    const float* gn = C.in(11) + (size_t)l * 4 * 64;
    const int c8 = C.lane & 7, row = C.lane >> 3;
    const f32x2* rope = (const f32x2*)(C.ws + WS_ROPE);
#pragma unroll
    for (int h2 = 0; h2 < 2; ++h2) { const int t = 2 * tp + h2;
        nsa_prep_rows(gn, rope + (size_t)(t & (SEQ - 1)) * 32, 0.125f, (bf16*)(C.ws + WS_QB) + (size_t)t * 512 + row * 64 + 8 * c8, c8, DRY); }
    {
        const int t = 2 * tp + (row >> 2), kind = (row >> 1) & 1, g = row & 1;
        bf16* p = (bf16*)(C.ws + (kind ? WS_KVW : WS_KVS)) + (size_t)t * 256 + g * 64 + 8 * c8;
        nsa_prep_rows(gn + (kind ? 192 : 128), rope + (size_t)(t & (SEQ - 1)) * 32, 1.0f, p, c8, DRY); }
}
__device__ __forceinline__ void nsa_vtrans_item(const Ctx& C, int item) {
    const int which = item >> 10, bg = (item >> 8) & 3, blk = item & 255, b = bg >> 1, g = bg & 1;
    const bf16* src = (const bf16*)(C.ws + (which ? WS_KVW : WS_KVS)) + (size_t)(b * SEQ + blk * 64 + C.lane) * 256 + 128 + g * 64;
    bf16* dst = (bf16*)(C.ws + (which ? WS_VWT : WS_VST)) + (size_t)(bg * 256 + blk) * 4096 + C.lane;
    v4u w[8];
#pragma unroll
    for (int k = 0; k < 8; ++k) w[k] = ((const v4u*)src)[k];
#pragma unroll
    for (int k = 0; k < 8; ++k)
#pragma unroll
        for (int e = 0; e < 4; ++e) { const unsigned x = w[k][e]; dst[(size_t)(8 * k + 2 * e) * 64] = (bf16)(x & 0xffffu); dst[(size_t)(8 * k + 2 * e + 1) * 64] = (bf16)(x >> 16); }
}
__device__ __forceinline__ void nsa_cmp1_unit(const Ctx& C, int unit) {
    const int kv = unit >> 7, rb = (unit >> 2) & 31, ng = unit & 3;
    const int fr = C.lane & 15, q = C.lane >> 4;
    const int rt = rb * 8 + C.wave;
    const int ri = rt * 16 + fr, b = ri >> 11, g = (ri >> 10) & 1, c = ri & 1023, cc = c < 1023 ? c : 1022;
    const bf16* arow = (const bf16*)(C.ws + WS_KVC) + (size_t)(b * SEQ + 16 * cc) * 256 + kv * 128 + g * 64 + 8 * q;
    const bf16* bsrc = (const bf16*)(C.ws + WS_CW1) + (size_t)kv * 256 * 2048 + (size_t)(ng * 64 + (C.tid >> 3)) * 2048 + (C.tid & 7) * 8;
    LAS bf16* Bs = (LAS bf16*)C.lds;
    f32x4 acc[4];
#pragma unroll
    for (int nt = 0; nt < 4; ++nt) acc[nt] = (f32x4){0.f, 0.f, 0.f, 0.f};
    v4u breg = *(const v4u*)bsrc; bf16x8 areg[2] = {*(const bf16x8*)arow, *(const bf16x8*)(arow + 32)};
    for (int kc = 0; kc < 32; ++kc) {
        *(LAS v4u*)(Bs + (kc & 1) * 64 * 72 + (C.tid >> 3) * 72 + (C.tid & 7) * 8) = breg;
        __syncthreads();
        bf16x8 anext[2] = {areg[0], areg[1]};
        if (kc + 1 < 32) { breg = *(const v4u*)(bsrc + (kc + 1) * 64); anext[0] = *(const bf16x8*)(arow + (kc + 1) * 256); anext[1] = *(const bf16x8*)(arow + (kc + 1) * 256 + 32); }
        const LAS bf16* Bc = Bs + (kc & 1) * 64 * 72;
        bf16x8 bf[4][2];
#pragma unroll
        for (int nt = 0; nt < 4; ++nt) { bf[nt][0] = *(const LAS bf16x8*)(Bc + (16 * nt + fr) * 72 + 8 * q); bf[nt][1] = *(const LAS bf16x8*)(Bc + (16 * nt + fr) * 72 + 32 + 8 * q); }
#pragma unroll
        for (int nt = 0; nt < 4; ++nt) acc[nt] = __builtin_amdgcn_mfma_f32_16x16x32_bf16(areg[0], bf[nt][0], acc[nt], 0, 0, 0);
#pragma unroll
        for (int nt = 0; nt < 4; ++nt) acc[nt] = __builtin_amdgcn_mfma_f32_16x16x32_bf16(areg[1], bf[nt][1], acc[nt], 0, 0, 0);
        areg[0] = anext[0]; areg[1] = anext[1];
    }
    const float* cb1 = (const float*)(C.ws + WS_VEC) + VEC_CB1 + kv * 256;
    bf16* H1 = (bf16*)(C.ws + WS_CMPH) + (size_t)kv * 4096 * 256;
#pragma unroll
    for (int nt = 0; nt < 4; ++nt) { const int n = ng * 64 + nt * 16 + fr; const float bia = cb1[n];
#pragma unroll
        for (int r = 0; r < 4; ++r) H1[(size_t)(rt * 16 + 4 * q + r) * 256 + n] = (bf16)f2bf(gelu_tanh(acc[nt][r] + bia)); }
    __syncthreads();
}
__device__ __forceinline__ void nsa_cmp2_item(const Ctx& C, int l, int item) {
    const int kv = item >> 8, rt = item & 255;
    const int fr = C.lane & 15, q = C.lane >> 4;
    const bf16* H1 = (const bf16*)(C.ws + WS_CMPH) + (size_t)kv * 4096 * 256 + (size_t)rt * 16 * 256;
    const bf16* W2 = (const bf16*)(C.ws + WS_CW2) + (size_t)kv * 64 * 256;
    f32x4 acc[4];
#pragma unroll
    for (int nt = 0; nt < 4; ++nt) { acc[nt] = (f32x4){0.f, 0.f, 0.f, 0.f}; acc[nt] = mma_tile<8>(H1, 256, W2 + nt * 16 * 256, 256, acc[nt], C.lane); }
    if (kv == 0) {
        const float* gn = C.in(11) + (size_t)l * 4 * 64 + 64;
        bf16* KC = (bf16*)(C.ws + WS_KCMP);
#pragma unroll
        for (int r = 0; r < 4; ++r) {
            float ss = 0.f;
#pragma unroll
            for (int nt = 0; nt < 4; ++nt) ss += acc[nt][r] * acc[nt][r];
            ss += __shfl_xor(ss, 1); ss += __shfl_xor(ss, 2); ss += __shfl_xor(ss, 4); ss += __shfl_xor(ss, 8);
            const float rinv = 1.0f / sqrtf(ss * (1.0f / 64.0f) + RMS_EPS);
            float y[4];
#pragma unroll
            for (int nt = 0; nt < 4; ++nt) y[nt] = acc[nt][r] * rinv * gn[nt * 16 + fr];
            const int ri = rt * 16 + 4 * q + r, c = ri & 1023; int pos = 16 * c + 31; pos = pos < SEQ ? pos : SEQ - 1;
            const f32x2* rr = (const f32x2*)(C.ws + WS_ROPE) + (size_t)pos * 32;
            const f32x2 c0 = rr[fr], c1 = rr[16 + fr];
            bf16* o = KC + (size_t)ri * 64;
            o[fr] = (bf16)f2bf(y[0] * c0.x - y[2] * c0.y); o[16 + fr] = (bf16)f2bf(y[1] * c1.x - y[3] * c1.y);
            o[32 + fr] = (bf16)f2bf(y[0] * c0.y + y[2] * c0.x); o[48 + fr] = (bf16)f2bf(y[1] * c1.y + y[3] * c1.x);
        }
    } else {
        bf16* VCT = (bf16*)(C.ws + WS_VCT);
        const int ri0 = rt * 16, bg = ri0 >> 10, c0 = (ri0 & 1023) + 4 * q;
#pragma unroll
        for (int nt = 0; nt < 4; ++nt) { const int d = nt * 16 + fr;
            *(v2u*)(VCT + (size_t)(bg * 64 + d) * 1024 + c0) = (v2u){pk2(acc[nt][0], acc[nt][1]), pk2(acc[nt][2], acc[nt][3])}; }
    }
}

constexpr int NQ = 32;
constexpr int NU_IMP = 0;
constexpr int NU_SEL = 32768;
constexpr int NU_UM = 33792;
constexpr int NU_UL = 33824;
constexpr int NU_KV = 35072;
constexpr int NU_TILE = 18432;
constexpr int NU_END = NU_KV + 4 * NU_TILE;
constexpr float LOG2E = 1.44269504089f;

struct TileSrc { const bf16* k; int kld; const bf16* v; int vld; };

__device__ __forceinline__ void nsa_fetch(const Ctx& C, const TileSrc& ts, bool on, v4u& kr, v4u& vr) {
    const int r = C.tid >> 3, ch = C.tid & 7; (void)on;
    kr = *(const v4u*)(ts.k + (size_t)r * ts.kld + ch * 8); vr = *(const v4u*)(ts.v + (size_t)r * ts.vld + ch * 8);
}
__device__ __forceinline__ void nsa_commit(const Ctx& C, int j, bool on, const v4u& kr, const v4u& vr) {
    LAS bf16* KT = (LAS bf16*)(C.lds + NU_KV + j * NU_TILE); LAS bf16* VT = KT + 64 * 72;
    const int r = C.tid >> 3, ch = C.tid & 7; (void)on;
    *(LAS v4u*)(KT + r * 72 + ch * 8) = kr; *(LAS v4u*)(VT + r * 72 + ch * 8) = vr;
}
__device__ __forceinline__ void nsa_scores(const Ctx& C, int j, const bf16x8 (&qf)[2], f32x4 (&s)[4]) {
    const LAS bf16* KT = (const LAS bf16*)(C.lds + NU_KV + j * NU_TILE);
    const int fr = C.lane & 15, q = C.lane >> 4;
    bf16x8 a[4][2];
#pragma unroll
    for (int kt = 0; kt < 4; ++kt)
#pragma unroll
        for (int ks = 0; ks < 2; ++ks) a[kt][ks] = *(const LAS bf16x8*)(KT + (16 * kt + fr) * 72 + ks * 32 + 8 * q);
#pragma unroll
    for (int kt = 0; kt < 4; ++kt) s[kt] = __builtin_amdgcn_mfma_f32_16x16x32_bf16(a[kt][0], qf[0], (f32x4){0.f, 0.f, 0.f, 0.f}, 0, 0, 0);
#pragma unroll
    for (int kt = 0; kt < 4; ++kt) s[kt] = __builtin_amdgcn_mfma_f32_16x16x32_bf16(a[kt][1], qf[1], s[kt], 0, 0, 0);
}
__device__ __forceinline__ void nsa_vfrag(const Ctx& C, int j, v4u (&vf)[4][2]) {
    const LAS bf16* VT = (const LAS bf16*)(C.lds + NU_KV + j * NU_TILE) + 64 * 72;
    const int fr = C.lane & 15, q = C.lane >> 4;
#pragma unroll
    for (int dt = 0; dt < 4; ++dt)
#pragma unroll
        for (int k2 = 0; k2 < 2; ++k2) { const LAS bf16* vr = VT + (16 * dt + fr) * 72 + 32 * k2 + 4 * q;
            const v2u lo = *(const LAS v2u*)vr, hi = *(const LAS v2u*)(vr + 16); vf[dt][k2] = (v4u){lo.x, lo.y, hi.x, hi.y}; }
}
__device__ __forceinline__ void nsa_pv(const Ctx& C, int j, const f32x4 (&p)[4], f32x4 (&o)[4], const v4u (&vf)[4][2]) {
    bf16x8 pf[2];
#pragma unroll
    for (int k2 = 0; k2 < 2; ++k2) { v4u w; w.x = pk2(p[2 * k2][0], p[2 * k2][1]); w.y = pk2(p[2 * k2][2], p[2 * k2][3]); w.z = pk2(p[2 * k2 + 1][0], p[2 * k2 + 1][1]); w.w = pk2(p[2 * k2 + 1][2], p[2 * k2 + 1][3]);
        pf[k2] = __builtin_bit_cast(bf16x8, w); }
#pragma unroll
    for (int k2 = 0; k2 < 2; ++k2)
#pragma unroll
        for (int dt = 0; dt < 4; ++dt) o[dt] = __builtin_amdgcn_mfma_f32_16x16x32_bf16(__builtin_bit_cast(bf16x8, vf[dt][k2]), pf[k2], o[dt], 0, 0, 0);
}
__device__ __forceinline__ float nsa_exp(f32x4 (&s)[4], float ml2) {
    float ps = 0.f;
#pragma unroll
    for (int kt = 0; kt < 4; ++kt)
#pragma unroll
        for (int r = 0; r < 4; ++r) { const float p = __builtin_amdgcn_exp2f(s[kt][r] * LOG2E - ml2); s[kt][r] = p; ps += p; }
    return ps;
}

constexpr int N6_IMP = 0;
constexpr int N6_KVC = 65536;
constexpr int N6_SEL = 120832;
constexpr int N6_UM = 122880;
constexpr int N6_UL = 122912;
constexpr int N6_KV = 0;

__device__ __forceinline__ void n6_commit(const Ctx& C, int base, int j, const v4u& kr, const v4u& vr) {
    LAS bf16* KT = (LAS bf16*)(C.lds + base + j * NU_TILE); LAS bf16* VT = KT + 64 * 72;
    const int r = C.tid >> 3, ch = C.tid & 7;
    *(LAS v4u*)(KT + r * 72 + ch * 8) = kr; *(LAS v4u*)(VT + r * 72 + ch * 8) = vr;
}
__device__ __forceinline__ void n6_kfrag(const Ctx& C, int toff, bf16x8 (&a)[4][2]) {
    const LAS bf16* KT = (const LAS bf16*)(C.lds + toff);
    const int fr = C.lane & 15, q = C.lane >> 4;
#pragma unroll
    for (int kt = 0; kt < 4; ++kt)
#pragma unroll
        for (int ks = 0; ks < 2; ++ks) a[kt][ks] = *(const LAS bf16x8*)(KT + (16 * kt + fr) * 72 + ks * 32 + 8 * q);
}
__device__ __forceinline__ void n6_vfrag(const Ctx& C, int toff, v4u (&vf)[4][2]) {
    const LAS bf16* VT = (const LAS bf16*)(C.lds + toff) + 64 * 72;
    const int fr = C.lane & 15, q = C.lane >> 4;
#pragma unroll
    for (int dt = 0; dt < 4; ++dt)
#pragma unroll
        for (int k2 = 0; k2 < 2; ++k2) { const LAS bf16* vr = VT + (16 * dt + fr) * 72 + 32 * k2 + 4 * q;
            const v2u lo = *(const LAS v2u*)vr, hi = *(const LAS v2u*)(vr + 16); vf[dt][k2] = (v4u){lo.x, lo.y, hi.x, hi.y}; }
}
__device__ __forceinline__ void n6_scores(const bf16x8 (&a)[4][2], const bf16x8 (&qf)[2], f32x4 (&s)[4]) {
#pragma unroll
    for (int kt = 0; kt < 4; ++kt) s[kt] = __builtin_amdgcn_mfma_f32_16x16x32_bf16(a[kt][0], qf[0], (f32x4){0.f, 0.f, 0.f, 0.f}, 0, 0, 0);
#pragma unroll
    for (int kt = 0; kt < 4; ++kt) s[kt] = __builtin_amdgcn_mfma_f32_16x16x32_bf16(a[kt][1], qf[1], s[kt], 0, 0, 0);
}

__device__ __forceinline__ void nsa_attn_unit64(const Ctx& C, int l, int u, bool DRY) {
    const int bg = u & 3, b = bg >> 1, g = bg & 1, qb = 255 - (u >> 2);
    const int t0 = b * SEQ + qb * 64;
    const int fr = C.lane & 15, q = C.lane >> 4, qq = fr >> 2, hh = fr & 3;
    LAS float* IMP = (LAS float*)(C.lds + N6_IMP);
    LAS unsigned long long* SEL = (LAS unsigned long long*)(C.lds + N6_SEL);
    LAS unsigned long long* UM = (LAS unsigned long long*)(C.lds + N6_UM);
    LAS int* UL = (LAS int*)(C.lds + N6_UL);
    for (int i = C.tid; i < 64 * 256; i += NTHR) IMP[i] = 0.f;
    float mc2, ms2, mw2;
    { const float* gn = C.in(11) + (size_t)l * 256;
      const float gq = wave_max(fabsf(gn[C.lane])), g1 = wave_max(fabsf(gn[64 + C.lane])), g2 = wave_max(fabsf(gn[128 + C.lane])), g3 = wave_max(fabsf(gn[192 + C.lane]));
      mc2 = 8.0f * gq * g1 * LOG2E; ms2 = 8.0f * gq * g2 * LOG2E; mw2 = 8.0f * gq * g3 * LOG2E; }
    bf16* QB = (bf16*)(C.ws + WS_QB);
    const int iq0 = 8 * C.wave + qq;
    bf16x8 qf[2][2]; float gate[2][3];
#pragma unroll
    for (int ct = 0; ct < 2; ++ct) {
        const bf16* qp = QB + (size_t)(t0 + iq0 + 4 * ct) * 512 + (g * 4 + hh) * 64 + 8 * q;
        qf[ct][0] = *(const bf16x8*)qp; qf[ct][1] = *(const bf16x8*)(qp + 32);
        const float* sm = (const float*)(C.ws + WS_SMALL) + (size_t)(t0 + iq0 + 4 * ct) * 64 + 16 + (g * 4 + hh) * 3;
#pragma unroll
        for (int k = 0; k < 3; ++k) gate[ct][k] = sigmoidf_(sm[k]); }
#define N6_ACCUM(ct, ao, scale, first) do { bf16* op_ = QB + (size_t)(t0 + iq0 + 4 * (ct)) * 512 + (g * 4 + hh) * 64 + 4 * q; \
        _Pragma("unroll") for (int dt = 0; dt < 4; ++dt) { f32x4 v_ = (ao)[dt] * (scale); \
            if (!(first)) { const v2u o_ = *(const v2u*)(op_ + 16 * dt); v_[0] += bflo(o_.x); v_[1] += bfhi(o_.x); v_[2] += bflo(o_.y); v_[3] += bfhi(o_.y); } \
            if (DRY) asm volatile("" :: "v"(v_)); else *(v2u*)(op_ + 16 * dt) = (v2u){pk2(v_[0], v_[1]), pk2(v_[2], v_[3])}; } } while (0)
    v4u kr[4], vr[4];
    const int r8 = C.tid >> 3, ch8 = C.tid & 7;
#define N6_FETCH(j, kptr, kld, vptr, vld) do { kr[j] = *(const v4u*)((kptr) + (size_t)r8 * (kld) + ch8 * 8); vr[j] = *(const v4u*)((vptr) + (size_t)r8 * (vld) + ch8 * 8); } while (0)

    const bf16* KC = (const bf16*)(C.ws + WS_KCMP) + (size_t)bg * 1024 * 64;
    const bf16* VCT = (const bf16*)(C.ws + WS_VCT) + (size_t)bg * 64 * 1024;
    const int nct = (4 * qb + 3 + 63) >> 6, ncs = (nct + 2) / 3;
    const int cmin = (64 * qb + 8 * C.wave - 31) >> 4;
    float cl[2] = {0.f, 0.f}, cinv[2] = {0.f, 0.f};
    for (int pass = 0; pass < 2; ++pass) {
        f32x4 ao[2][4];
#pragma unroll
        for (int ct = 0; ct < 2; ++ct)
#pragma unroll
            for (int dt = 0; dt < 4; ++dt) ao[ct][dt] = (f32x4){0.f, 0.f, 0.f, 0.f};
        if (pass == 1) {
#pragma unroll
            for (int ct = 0; ct < 2; ++ct) { float lt = cl[ct]; lt += __shfl_xor(lt, 16); lt += __shfl_xor(lt, 32); cinv[ct] = lt > 0.f ? 1.0f / lt : 0.f; } }
#pragma unroll
        for (int j = 0; j < 3; ++j) { const int tl = j < nct ? j : nct - 1; N6_FETCH(j, KC + (size_t)tl * 64 * 64, 64, VCT + tl * 64, 1024); }
        for (int st = 0; st < ncs; ++st) {
            __syncthreads();
#pragma unroll
            for (int j = 0; j < 3; ++j) n6_commit(C, N6_KVC, j, kr[j], vr[j]);
            __syncthreads();
            if (st + 1 < ncs) {
#pragma unroll
                for (int j = 0; j < 3; ++j) { const int t3 = 3 * (st + 1) + j, tl = t3 < nct ? t3 : nct - 1; N6_FETCH(j, KC + (size_t)tl * 64 * 64, 64, VCT + tl * 64, 1024); } }
#pragma unroll 1
            for (int j = 0; j < 3; ++j) {
                const int tl = 3 * st + j;
                if (tl < nct) {
                    const int toff = N6_KVC + j * NU_TILE;
                    bf16x8 a[4][2]; v4u vf[4][2]; n6_kfrag(C, toff, a); if (pass == 1) n6_vfrag(C, toff, vf);
#pragma unroll
                    for (int ct = 0; ct < 2; ++ct) {
                        f32x4 s[4]; n6_scores(a, qf[ct], s);
                        if (64 * tl + 63 > cmin) { const int cmax = (64 * qb + iq0 + 4 * ct - 31) >> 4;
#pragma unroll
                            for (int kt = 0; kt < 4; ++kt)
#pragma unroll
                                for (int r = 0; r < 4; ++r) { const int c = 64 * tl + 16 * kt + 4 * q + r; if (c > cmax) s[kt][r] = -INFINITY; } }
                        const float ps = nsa_exp(s, mc2);
                        if (pass == 0) cl[ct] += ps;
                        else {
#pragma unroll
                            for (int kt = 0; kt < 4; ++kt) {
#pragma unroll
                                for (int r = 0; r < 4; ++r) s[kt][r] *= cinv[ct];
                                float gs = (s[kt][0] + s[kt][1]) + (s[kt][2] + s[kt][3]), es = s[kt][3];
                                gs += __shfl_xor(gs, 1); gs += __shfl_xor(gs, 2); es += __shfl_xor(es, 1); es += __shfl_xor(es, 2);
                                if (hh == 0) { const int n = 16 * tl + 4 * kt + q;
                                    if (n < 256) { atomicAdd((float*)(IMP + (iq0 + 4 * ct) * 256 + n), gs); if (n + 1 < 256) atomicAdd((float*)(IMP + (iq0 + 4 * ct) * 256 + n + 1), es); } }
                            }
                            nsa_pv(C, j, s, ao[ct], vf);
                        }
                    }
                }
            }
        }
        if (pass == 1) {
#pragma unroll
            for (int ct = 0; ct < 2; ++ct) N6_ACCUM(ct, ao[ct], gate[ct][0], true); }
        __syncthreads();
    }

    {
        const int nforced = qb >= 2 ? 3 : qb + 1; const int ncand = qb + 1 - nforced;
        int need = 16 - nforced; if (need > ncand) need = ncand;
#pragma unroll 1
        for (int grp = 0; grp < 2; ++grp) {
            unsigned key[4][4]; unsigned long long selw[4][4];
#pragma unroll
            for (int k4 = 0; k4 < 4; ++k4)
#pragma unroll
                for (int k = 0; k < 4; ++k) { const int n = C.lane + 64 * k; const bool valid = n <= qb; const bool forced = valid && (n == 0 || n == qb || n == qb - 1);
                    const float impv = IMP[(8 * C.wave + 4 * grp + k4) * 256 + n];
                    key[k4][k] = (valid && !forced) ? (__builtin_bit_cast(unsigned, fmaxf(impv, 0.f)) + 1u) : 0u;
                    selw[k4][k] = __ballot(forced); }
            if (need == ncand) {
#pragma unroll
                for (int k4 = 0; k4 < 4; ++k4)
#pragma unroll
                    for (int k = 0; k < 4; ++k) selw[k4][k] |= __ballot(key[k4][k] != 0u);
            } else {
                unsigned thr[4] = {0u, 0u, 0u, 0u};
                for (int bit = 31; bit >= 12; --bit) {
#pragma unroll
                    for (int k4 = 0; k4 < 4; ++k4) { const unsigned cand = thr[k4] | (1u << bit); int cnt = 0;
#pragma unroll
                        for (int k = 0; k < 4; ++k) cnt += __builtin_popcountll(__ballot(key[k4][k] >= cand));
                        if (cnt >= need) thr[k4] = cand; } }
#pragma unroll
                for (int k4 = 0; k4 < 4; ++k4) { int left = need; const unsigned hi = thr[k4] + 0xfffu;
#pragma unroll
                    for (int k = 0; k < 4; ++k) { const unsigned long long gt = __ballot(key[k4][k] > hi); selw[k4][k] |= gt; left -= __builtin_popcountll(gt); }
#pragma unroll
                    for (int k = 0; k < 4; ++k) { unsigned long long eq = __ballot(key[k4][k] != 0u && key[k4][k] >= thr[k4] && key[k4][k] <= hi);
                        while (left > 0 && eq) { const unsigned long long low = eq & (0ull - eq); selw[k4][k] |= low; eq ^= low; --left; } } }
            }
#pragma unroll
            for (int k4 = 0; k4 < 4; ++k4)
                if (C.lane < 4) SEL[(8 * C.wave + 4 * grp + k4) * 4 + C.lane] = C.lane == 0 ? selw[k4][0] : C.lane == 1 ? selw[k4][1] : C.lane == 2 ? selw[k4][2] : selw[k4][3];
        }
    }
    __syncthreads();
    if (C.tid < 4) { unsigned long long um = 0ull; for (int i = 0; i < 64; ++i) um |= SEL[i * 4 + C.tid]; UM[C.tid] = um; }
    __syncthreads();
    int ucnt;
    {
        const unsigned long long u0 = UM[0], u1 = UM[1], u2 = UM[2], u3 = UM[3];
        const int c0 = __builtin_popcountll(u0), c1 = __builtin_popcountll(u1), c2 = __builtin_popcountll(u2), c3 = __builtin_popcountll(u3);
        ucnt = c0 + c1 + c2 + c3;
        if (C.tid < 256) { const int w = C.tid >> 6, bit = C.tid & 63; const unsigned long long uw = w == 0 ? u0 : w == 1 ? u1 : w == 2 ? u2 : u3;
            if ((uw >> bit) & 1ull) { const int pos = (w > 0 ? c0 : 0) + (w > 1 ? c1 : 0) + (w > 2 ? c2 : 0) + __builtin_popcountll(uw & ((1ull << bit) - 1ull)); UL[pos] = C.tid; } }
    }
    __syncthreads();

    {
        f32x4 ao[2][4]; float al[2] = {0.f, 0.f};
#pragma unroll
        for (int ct = 0; ct < 2; ++ct)
#pragma unroll
            for (int dt = 0; dt < 4; ++dt) ao[ct][dt] = (f32x4){0.f, 0.f, 0.f, 0.f};
        const bf16* KS = (const bf16*)(C.ws + WS_KVS) + (size_t)(b * SEQ) * 256 + g * 64;
        const bf16* VST = (const bf16*)(C.ws + WS_VST) + (size_t)bg * 256 * 4096;
        const int nss = (ucnt + 3) >> 2;
#pragma unroll
        for (int j = 0; j < 4; ++j) { const int n = j < ucnt ? UL[j] : 0; N6_FETCH(j, KS + (size_t)n * 64 * 256, 256, VST + (size_t)n * 4096, 64); }
        for (int st = 0; st < nss; ++st) {
            __syncthreads();
#pragma unroll
            for (int j = 0; j < 4; ++j) n6_commit(C, N6_KV, j, kr[j], vr[j]);
            __syncthreads();
            if (st + 1 < nss) {
#pragma unroll
                for (int j = 0; j < 4; ++j) { const int ix = 4 * (st + 1) + j; const int n = ix < ucnt ? UL[ix] : 0; N6_FETCH(j, KS + (size_t)n * 64 * 256, 256, VST + (size_t)n * 4096, 64); } }
#pragma unroll 1
            for (int j = 0; j < 4; ++j) {
                const int ix = 4 * st + j;
                if (ix < ucnt) {
                    const int n = UL[ix];
                    const bool sel0 = (SEL[iq0 * 4 + (n >> 6)] >> (n & 63)) & 1ull, sel1 = (SEL[(iq0 + 4) * 4 + (n >> 6)] >> (n & 63)) & 1ull;
                    const bool act0 = __ballot(sel0) != 0ull, act1 = __ballot(sel1) != 0ull;
                    if (act0 || act1) {
                        const int toff = N6_KV + j * NU_TILE;
                        bf16x8 a[4][2]; v4u vf[4][2]; n6_kfrag(C, toff, a); n6_vfrag(C, toff, vf);
#pragma unroll
                        for (int ct = 0; ct < 2; ++ct) {
                            if (ct == 0 ? act0 : act1) {
                                f32x4 s[4]; n6_scores(a, qf[ct], s);
                                if (n == qb) {
#pragma unroll
                                    for (int kt = 0; kt < 4; ++kt)
#pragma unroll
                                        for (int r = 0; r < 4; ++r) { const int key = 16 * kt + 4 * q + r; if (key > iq0 + 4 * ct) s[kt][r] = -INFINITY; } }
                                al[ct] += nsa_exp(s, (ct == 0 ? sel0 : sel1) ? ms2 : INFINITY);
                                nsa_pv(C, j, s, ao[ct], vf);
                            } }
                    } } }
        }
#pragma unroll
        for (int ct = 0; ct < 2; ++ct) { float lt = al[ct]; lt += __shfl_xor(lt, 16); lt += __shfl_xor(lt, 32); const float inv = lt > 0.f ? gate[ct][1] / lt : 0.f;
            N6_ACCUM(ct, ao[ct], inv, false); }
    }
    {
        f32x4 ao[2][4]; float al[2] = {0.f, 0.f};
#pragma unroll
        for (int ct = 0; ct < 2; ++ct)
#pragma unroll
            for (int dt = 0; dt < 4; ++dt) ao[ct][dt] = (f32x4){0.f, 0.f, 0.f, 0.f};
        const bf16* KW = (const bf16*)(C.ws + WS_KVW) + (size_t)(b * SEQ) * 256 + g * 64;
        const bf16* VWT = (const bf16*)(C.ws + WS_VWT) + (size_t)bg * 256 * 4096;
        const int nfirst = qb >= 8 ? qb - 8 : 0, nw = qb - nfirst + 1, nws = (nw + 3) >> 2;
#pragma unroll
        for (int j = 0; j < 4; ++j) { const int n = nfirst + (j < nw ? j : 0); N6_FETCH(j, KW + (size_t)n * 64 * 256, 256, VWT + (size_t)n * 4096, 64); }
        for (int st = 0; st < nws; ++st) {
            __syncthreads();
#pragma unroll
            for (int j = 0; j < 4; ++j) n6_commit(C, N6_KV, j, kr[j], vr[j]);
            __syncthreads();
            if (st + 1 < nws) {
#pragma unroll
                for (int j = 0; j < 4; ++j) { const int ix = 4 * (st + 1) + j; const int n = nfirst + (ix < nw ? ix : 0); N6_FETCH(j, KW + (size_t)n * 64 * 256, 256, VWT + (size_t)n * 4096, 64); } }
#pragma unroll 1
            for (int j = 0; j < 4; ++j) {
                const int ix = 4 * st + j;
                if (ix < nw) {
                    const int delta = qb - (nfirst + ix); const int toff = N6_KV + j * NU_TILE;
                    bf16x8 a[4][2]; v4u vf[4][2]; n6_kfrag(C, toff, a); n6_vfrag(C, toff, vf);
#pragma unroll
                    for (int ct = 0; ct < 2; ++ct) {
                        f32x4 s[4]; n6_scores(a, qf[ct], s);
                        if (delta == 0 || delta == 8) {
#pragma unroll
                            for (int kt = 0; kt < 4; ++kt)
#pragma unroll
                                for (int r = 0; r < 4; ++r) { const int key = 16 * kt + 4 * q + r; const bool ok = delta == 0 ? (key <= iq0 + 4 * ct) : (key > iq0 + 4 * ct); if (!ok) s[kt][r] = -INFINITY; } }
                        al[ct] += nsa_exp(s, mw2);
                        nsa_pv(C, j, s, ao[ct], vf);
                    }
                }
            }
        }
#pragma unroll
        for (int ct = 0; ct < 2; ++ct) { float lt = al[ct]; lt += __shfl_xor(lt, 16); lt += __shfl_xor(lt, 32); const float inv = lt > 0.f ? gate[ct][2] / lt : 0.f;
            N6_ACCUM(ct, ao[ct], inv, false); }
    }
#undef N6_FETCH
#undef N6_ACCUM
    __syncthreads();
}

__device__ __forceinline__ void phase_mix1(const Ctx& C, int l) {
    const int gw = C.bid * NWAVES + C.wave, NGW = C.G * NWAVES;
    for (int rep = (TIMEDUP & 32) ? 0 : 1; rep < 2; ++rep) {
    for (int un = C.bid; un < 256; un += C.G) nsa_cmp1_unit(C, un);
    for (int it = gw; it < 2048; it += NGW) nsa_vtrans_item(C, it); }
    for (int rep = (TIMEDUP & 262144) ? 0 : 1; rep < 2; ++rep) for (int tp = gw; tp < T / 2; tp += NGW) nsa_prep_token(C, l, tp, rep == 0);
    gla_stage_alpha(C, l);
    __syncthreads();
    for (int rep = (TIMEDUP & 16) ? 0 : 1; rep < 2; ++rep) for (int u = C.bid; u < 4096; u += C.G) { if (u < 2048) gla_unit_a(C, l, u); else mlstm_unit_a(C, l, u - 2048); }
}
__device__ __forceinline__ void phase_mix2(const Ctx& C, int l) {
    const int gw = C.bid * NWAVES + C.wave, NGW = C.G * NWAVES;
    for (int rep = (TIMEDUP & 1048576) ? 0 : 1; rep < 2; ++rep) for (int it = gw; it < 512; it += NGW) nsa_cmp2_item(C, l, it);
    for (int rep = (TIMEDUP & 524288) ? 0 : 1; rep < 2; ++rep) phase_scan(C, rep == 0);
}
__device__ __forceinline__ void phase_mix3(const Ctx& C, int l) {
    for (int rep = (TIMEDUP & 1) ? 0 : 1; rep < 2; ++rep) for (int i = C.bid; i < 1024; i += C.G) {
        const_cast<Ctx&>(C).launder();
        const int r = i / C.G, w = i % C.G; const int pos = (r & 1) ? (1023 - ((r >> 1) * C.G + w)) : ((r >> 1) * C.G + w);
        nsa_attn_unit64(C, l, pos, rep == 0); }
    const_cast<Ctx&>(C).launder(); const Ctx& D = C;
    gla_stage_alpha(D, l);
    __syncthreads();
    for (int rep = (TIMEDUP & 2) ? 0 : 1; rep < 2; ++rep) for (int u = D.bid; u < 4096; u += D.G) { if (u < 2048) gla_unit_c(D, l, u, rep == 0); else mlstm_unit_c(D, l, u - 2048, rep == 0); }
}

constexpr int MIX_PHASES = 10;
#define MIXER_PHASES \
    if (PH_ON) for (int rep = (TIMEDUP & 131072) ? 0 : 1; rep < 2; ++rep) phase_norm(C, C.in(5) + (size_t)l * DM, C.X); \
    PH_END; \
    if (PH_ON) { \
        pg8::Gemm g{(const bf16*)(C.ws + WS_XN), (const bf16*)(C.ws + WS_WIN), T, 4608, DM}; \
        pg8::StaticOrder S; S.init(T, 4608, C.G, C.bid); \
        pg8::EpiWin E{C.ws + WS_R, (const float*)(C.ws + WS_VEC) + VEC_BINP, (float*)(C.ws + WS_SMALL)}; \
        for (int rep = (TIMEDUP & 64) ? 0 : 1; rep < 2; ++rep) pg8::gemm_phase<pg8::EpiWin, pg8::StaticOrder, false>(C.lds, g, S, E, nullptr); \
    } \
    PH_END; \
    if (PH_ON) phase_mix1(C, l); \
    PH_END; \
    if (PH_ON) phase_mix2(C, l); \
    PH_END; \
    if (PH_ON) phase_mix3(C, l); \
    PH_END; \
    if (PH_ON) { \
        pg8::Gemm g{(const bf16*)(C.ws + WS_XN), (const bf16*)(C.ws + WS_WGT), T, 3 * DM, DM}; \
        pg8::StaticOrder S; S.init(T, 3 * DM, C.G, C.bid); \
        pg8::EpiGate E{C.ws, DM, C.in(7) + (size_t)l * N_IN + 4400}; \
        for (int rep = (TIMEDUP & 16384) ? 0 : 1; rep < 2; ++rep) pg8::gemm_phase<pg8::EpiGate, pg8::StaticOrder, false>(C.lds, g, S, E, nullptr); \
    } \
    PH_END; \
    for (int br = 0; br < 3; ++br) { \
        if (PH_ON) { \
            const bf16* Asrc = (const bf16*)(C.ws + (br == 0 ? WS_RA : br == 1 ? WS_QB : WS_OC)); \
            pg8::Gemm g{Asrc, (const bf16*)(C.ws + WS_WBR) + (size_t)br * DM * 512, T, DM, 512}; \
            pg8::StaticOrder S; S.init(T, DM, C.G, C.bid); \
            for (int rep = (TIMEDUP & 32768) ? 0 : 1; rep < 2; ++rep) { \
            pg8::EpiBranch E{(bf16*)(C.ws + WS_Y), (const bf16*)(C.ws + WS_G0 + (size_t)(br >= 1) * (WS_G1 - WS_G0) + (size_t)(br >= 2) * (WS_G2 - WS_G1)), DM, rep == 0 ? 2 : (br == 0 ? 1 : 0)}; \
            pg8::gemm_phase<pg8::EpiBranch, pg8::StaticOrder, false>(C.lds, g, S, E, nullptr); } \
        } \
        PH_END; \
    } \
    if (PH_ON) { \
        pg8::Gemm g{(const bf16*)(C.ws + WS_Y), (const bf16*)(C.ws + WS_WOUT), T, DM, DM}; \
        pg8::StaticOrder S; S.init(T, DM, C.G, C.bid); \
        for (int rep = (TIMEDUP & 65536) ? 0 : 1; rep < 2; ++rep) { \
        pg8::EpiResid E{C.X, DM, rep == 1 ? 1.0f : 0.f, C.X}; \
        pg8::gemm_phase<pg8::EpiResid, pg8::StaticOrder, false>(C.lds, g, S, E, nullptr); } \
    } \
    PH_END;

constexpr int N_PHASES = 8 * 3 + 4 * MIX_PHASES;

__global__ void __launch_bounds__(NTHR, 2) hybrid_fwd(Args args) {
    extern __shared__ __attribute__((aligned(16))) unsigned char lds_raw[];
    Ctx C;
    C.lds = (LAS unsigned char*)lds_raw;
    C.tid = threadIdx.x; C.lane = C.tid & 63; C.wave = __builtin_amdgcn_readfirstlane(C.tid >> 6);
    C.G = gridDim.x; C.bid = blockIdx.x;
    C.inp = (const GAS float* const __attribute__((address_space(4)))*)__builtin_amdgcn_kernarg_segment_ptr();
    C.X = args.out; C.ws = args.ws;
    volatile LAS unsigned* MISC = (volatile LAS unsigned*)(C.lds + MISC_OFF);
    for (int u = C.tid; u < (LDS_BYTES - RING_BYTES) / 4; u += NTHR) ((LAS unsigned*)(C.lds + RING_BYTES))[u] = 0u;
    __syncthreads();
    __builtin_amdgcn_fence(__ATOMIC_ACQUIRE, "agent"); asm volatile("s_waitcnt vmcnt(0)" ::: "memory");
    __syncthreads();
    const int lo = args.ph_lo, hi = args.ph_hi;
    XcdBarrier bar; bar.bar = (unsigned*)(C.ws + WS_CTL) + 4096; bar.x = 0; bar.st = nullptr;
    if (hi - lo > 1) bar = xcd_barrier_post((unsigned*)(C.ws + WS_CTL) + 4096, MISC + 8);
    int pc = 0;
#define PH_ON (C.launder(), pc >= lo && pc < hi)
#define PH_END_NB do { ++pc; } while (0)
#define PH_END do { if (pc >= lo && pc + 1 < hi) { xcd_barrier(bar); if (TIMEDUP & 4096) xcd_barrier(bar); } ++pc; } while (0)

    for (int step = 0; step < 2 * NLAYER; ++step) {
        const int l = step >> 1, f = step & 1;
        if (PH_ON) {
            if (step == 0) phase_init(C);
            if (f == 0) for (int rep = (TIMEDUP & 128) ? 0 : 1; rep < 2; ++rep) phase_prep_weights(C, l);
            for (int rep = (TIMEDUP & 8) ? 0 : 1; rep < 2; ++rep) phase_norm(C, (f ? C.in(19) : C.in(1)) + (size_t)l * DM, step == 0 ? C.in(0) : (const float*)C.X);
        }
        PH_END;
        if (PH_ON) {
            pg8::Gemm g{(const bf16*)(C.ws + WS_XN), (const bf16*)(C.ws + (f ? WS_WGU2 : WS_WGU1)), T, 2 * DFF, DM};
            pg8::StaticOrder S; S.init(T, 2 * DFF, C.G, C.bid);
            for (int rep = (TIMEDUP & (4 | 4194304)) ? 0 : 1; rep < 2; ++rep) {
            pg8::EpiSwiGLU E{(bf16*)(C.ws + WS_HID), DFF, ((TIMEDUP & 4194304) && rep == 0) ? 1 : 0};
            pg8::gemm_phase<pg8::EpiSwiGLU, pg8::StaticOrder, false>(C.lds, g, S, E, nullptr); }
        }
        PH_END;
        if (PH_ON) {
            pg8::Gemm g{(const bf16*)(C.ws + WS_HID), (const bf16*)(C.ws + (f ? WS_WDN2 : WS_WDN1)), T, DM, DFF};
            pg8::StaticOrder S; S.init(T, DM, C.G, C.bid);
            for (int rep = (TIMEDUP & 8192) ? 0 : 1; rep < 2; ++rep) {
            pg8::EpiResid E{C.X, DM, rep == 1 ? 0.5f : 0.f, (step == 0 && !(rep == 1 && (TIMEDUP & 8192))) ? C.in(0) : (const float*)C.X};
            pg8::gemm_phase<pg8::EpiResid, pg8::StaticOrder, false>(C.lds, g, S, E, nullptr); }
        }
        PH_END;
        if (f == 0) {
            MIXER_PHASES
        }
    }
#undef PH_ON
#undef PH_END
#undef PH_END_NB
    asm volatile("s_waitcnt vmcnt(0)" ::: "memory");
    __syncthreads();
    if (C.tid == 0) { __builtin_amdgcn_fence(__ATOMIC_RELEASE, "agent"); asm volatile("s_waitcnt vmcnt(0)" ::: "memory"); }
}

extern "C" void kernel_launch(void* const* d_in, const int* in_sizes, int n_in, void* d_out, int out_size, void* d_ws, size_t ws_size, hipStream_t stream) {
    static int grid = 0;
    if (grid == 0) {
        if (n_in != 23 || out_size != T * DM || ws_size < WS_END) { fprintf(stderr, "kernel_launch: unexpected shapes (n_in %d out %d ws %zu, need %zu)\n", n_in, out_size, ws_size, (size_t)WS_END); grid = -1; return; }
        int dev = 0, cus = 0, per_cu = 0;
        if (hipGetDevice(&dev) != hipSuccess || hipDeviceGetAttribute(&cus, hipDeviceAttributeMultiprocessorCount, dev) != hipSuccess) { grid = -1; return; }
        if (hipFuncSetAttribute((const void*)hybrid_fwd, hipFuncAttributeMaxDynamicSharedMemorySize, LDS_BYTES) != hipSuccess) { fprintf(stderr, "kernel_launch: hipFuncSetAttribute failed\n"); grid = -1; return; }
        if (hipOccupancyMaxActiveBlocksPerMultiprocessor(&per_cu, (const void*)hybrid_fwd, NTHR, LDS_BYTES) != hipSuccess || per_cu < 1) { fprintf(stderr, "kernel_launch: occupancy query says %d blocks per CU\n", per_cu); }
        (void)hipGetLastError();
        grid = cus;
    }
    if (grid < 0) return;
    (void)hipMemsetAsync((char*)d_ws + WS_CTL, 0, CTL_ZERO_BYTES, stream);
    Args a{};
    for (int i = 0; i < 23; ++i) a.in[i] = (const float*)d_in[i];
    a.out = (float*)d_out; a.ws = (unsigned char*)d_ws;
#if ONE_LAUNCH
    a.ph_lo = 0; a.ph_hi = N_PHASES;
    hipLaunchKernelGGL(hybrid_fwd, dim3(grid), dim3(NTHR), LDS_BYTES, stream, a);
#else
    for (int p = 0; p < N_PHASES; ++p) { a.ph_lo = p; a.ph_hi = p + 1; hipLaunchKernelGGL(hybrid_fwd, dim3(grid), dim3(NTHR), LDS_BYTES, stream, a); }
#endif
}
```
